# Optimizing an MI355X kernel written in HIP

```python
import math
import jax
import jax.numpy as jnp
from jax import lax
import numpy as np

D_MODEL = 2048
BATCH = 16
SEQ = 256
DEPTH = 4
DEC_BATCH = 2
DEC_SEQ = 4096
PAST_LEN = 256

GRID_W = 64
N_MOD = 9
D_FF = 5632
N_EVEN = (DEPTH + 1) // 2
N_ODD = DEPTH // 2
D_RWKV = D_MODEL // 2
RWKV_HEAD = 64
H_RWKV = D_RWKV // RWKV_HEAD
W_LORA = 64
A_LORA = 64
G_LORA = 160
RWKV_PROJ = 3 * D_RWKV + W_LORA + A_LORA + G_LORA
RWKV_SPLITS = [D_RWKV, 2 * D_RWKV, 3 * D_RWKV, 3 * D_RWKV + W_LORA, 3 * D_RWKV + W_LORA + A_LORA]
RWKV_GN_EPS = 64e-5
H_MLA = D_MODEL // 256
QK_NOPE = 128
QK_ROPE = 64
V_HEAD = 128
Q_RANK = D_MODEL // 4
KV_RANK = D_MODEL // 8
MLA_PROJ = Q_RANK + KV_RANK + QK_ROPE
IN_EVEN = RWKV_PROJ + MLA_PROJ
MIX_EVEN = D_RWKV + H_MLA * V_HEAD
ROPE_THETA = 10000.0
Q_BLOCK = 128
D_HYENA = D_MODEL
HYENA_ORDER = 2
POS_EMB = 33
FILT_HIDDEN = 64
HYENA_TARGET = 1e-2
FAST_DECAY_PCT = 0.3
SLOW_DECAY_PCT = 1.5

kernel_name = 'hybrid_rwkv7_mla_hyena_diffusion_step'


def rmsnorm(x, g, eps=1e-6):
    xf = x.astype(jnp.float32)
    y = xf * lax.rsqrt(jnp.mean(xf * xf, axis=-1, keepdims=True) + eps)
    return y.astype(x.dtype) * g


def modulate(h, shift, scale):
    return h * (1.0 + scale) + shift


def shift_prev(x):
    return jnp.pad(x[:, :-1], ((0, 0), (1, 0), (0, 0)))


def shift_next(x):
    return jnp.pad(x[:, 1:], ((0, 0), (0, 1), (0, 0)))


def swiglu(h, w_in, w_out):
    gate, up = jnp.split(h @ w_in, 2, axis=-1)
    return (jax.nn.silu(gate) * up) @ w_out


def grid_angles(L):
    rows = L // GRID_W
    row = jnp.repeat(jnp.arange(rows, dtype=jnp.float32), GRID_W)
    col = jnp.tile(jnp.arange(GRID_W, dtype=jnp.float32), rows)
    half = QK_ROPE // 2
    inv = 1.0 / (ROPE_THETA ** (jnp.arange(0, half, 2, dtype=jnp.float32) / half))
    return row[:, None] * inv[None, :], col[:, None] * inv[None, :]


def rope_half(x, ang):
    c = jnp.cos(ang)[None, :, None, :].astype(x.dtype)
    s = jnp.sin(ang)[None, :, None, :].astype(x.dtype)
    x1, x2 = jnp.split(x, 2, axis=-1)
    return jnp.concatenate([x1 * c - x2 * s, x2 * c + x1 * s], axis=-1)


def axial_rope(x):
    ang_r, ang_c = grid_angles(x.shape[1])
    xr, xc = jnp.split(x, 2, axis=-1)
    return jnp.concatenate([rope_half(xr, ang_r), rope_half(xc, ang_c)], axis=-1)


def attend(q, k, v, scale):
    B, Tq, H, dq = q.shape
    blk = min(Q_BLOCK, Tq)
    nb = Tq // blk
    qb = jnp.moveaxis(q.reshape(B, nb, blk, H, dq), 1, 0)

    def one_block(q_blk):
        s = jnp.einsum('bqhd,bkhd->bhqk', q_blk, k, preferred_element_type=jnp.float32) * scale
        p = jax.nn.softmax(s, axis=-1)
        return jnp.einsum('bhqk,bkhd->bqhd', p.astype(v.dtype), v)

    o = lax.map(one_block, qb)
    return jnp.moveaxis(o, 0, 1).reshape(B, Tq, H, v.shape[-1])


def rwkv_scan(S0, r, w, k, v, kk, a, reverse):
    seq = tuple(jnp.swapaxes(t, 0, 1) for t in (r, w, k, v, kk, a))

    def step(S, inp):
        r_t, w_t, k_t, v_t, kk_t, a_t = inp
        sa = jnp.einsum('bhvk,bhk->bhv', S, -kk_t)
        S = (S * w_t[:, :, None, :] + sa[..., None] * (kk_t * a_t)[:, :, None, :]
             + v_t[..., None] * k_t[:, :, None, :])
        return S, jnp.einsum('bhvk,bhk->bhv', S, r_t)

    S_fin, y = lax.scan(step, S0.astype(jnp.float32), seq, reverse=reverse)
    return jnp.swapaxes(y, 0, 1), S_fin


def rwkv_branch(z, p, S0):
    B, T, _ = z.shape
    f32 = jnp.float32
    z = z + p['mu_prev'] * (shift_prev(z) - z) + p['mu_next'] * (shift_next(z) - z)
    r, k, v, xw, xa, xg = jnp.split(z, RWKV_SPLITS, axis=-1)
    heads = lambda t: t.reshape(B, T, H_RWKV, RWKV_HEAD).astype(f32)
    kk = heads(k * p['k_k'])
    kk = kk / jnp.maximum(jnp.sqrt(jnp.sum(kk * kk, axis=-1, keepdims=True)), 1e-12)
    g = jax.nn.sigmoid(xg) @ p['g2']
    tw = jnp.tanh(xw)
    rh, vh = heads(r), heads(v)
    y_dirs, s_dirs, bonus = [], [], 0.0
    for d in range(2):
        wl = -jax.nn.softplus(-(p['w0'][d] + tw @ p['w2'][d]).astype(f32)) - 0.5
        decay = jnp.exp(-jnp.exp(wl))
        a = jax.nn.sigmoid(p['a0'][d] + xa @ p['a2'][d])
        kd = heads(k * (1.0 + (a - 1.0) * p['k_a']))
        y_d, s_d = rwkv_scan(S0[:, d], rh, heads(decay), kd, vh, kk, heads(a), reverse=(d == 1))
        y_dirs.append(y_d)
        s_dirs.append(s_d)
        bonus = bonus + jnp.sum(rh * kd * p['r_k'].astype(f32), axis=-1, keepdims=True) * vh
    y = y_dirs[0] + y_dirs[1]
    mu = jnp.mean(y, axis=-1, keepdims=True)
    var = jnp.mean(jnp.square(y - mu), axis=-1, keepdims=True)
    y = ((y - mu) * lax.rsqrt(var + RWKV_GN_EPS)).reshape(B, T, D_RWKV)
    y = y * p['gn_w'] + p['gn_b'] + bonus.reshape(B, T, D_RWKV)
    return y.astype(z.dtype) * g, jnp.stack(s_dirs, axis=1)


def mla_branch(z, p, ckv_ctx, kr_ctx):
    B, T, _ = z.shape
    cq, ckv, kr = jnp.split(z, [Q_RANK, Q_RANK + KV_RANK], axis=-1)
    cq = rmsnorm(cq, p['q_norm'])
    ckv = rmsnorm(ckv, p['kv_norm'])
    q = (cq @ p['w_qb']).reshape(B, T, H_MLA, QK_NOPE + QK_ROPE)
    q_nope, q_rope = jnp.split(q, [QK_NOPE], axis=-1)
    kr_h = kr[:, :, None, :]
    if ckv_ctx is None:
        keys_ckv, keys_kr = ckv, kr_h
    else:
        q_rope = axial_rope(q_rope)
        keys_ckv = jnp.concatenate([ckv, ckv_ctx], axis=1)
        keys_kr = jnp.concatenate([axial_rope(kr_h), kr_ctx[:, :, None, :]], axis=1)
    Tk = keys_ckv.shape[1]
    kv = (keys_ckv @ p['w_kvb']).reshape(B, Tk, H_MLA, QK_NOPE + V_HEAD)
    k_nope, v = jnp.split(kv, [QK_NOPE], axis=-1)
    k = jnp.concatenate([k_nope, jnp.broadcast_to(keys_kr, (B, Tk, H_MLA, QK_ROPE))], axis=-1)
    o = attend(jnp.concatenate([q_nope, q_rope], axis=-1), k, v, (QK_NOPE + QK_ROPE) ** -0.5)
    return o.reshape(B, T, H_MLA * V_HEAD), ckv, kr


def even_mixer(h, p, ctx):
    z = h @ p['w_in']
    z_rwkv, z_mla = jnp.split(z, [RWKV_PROJ], axis=-1)
    if ctx is None:
        S0 = jnp.zeros((h.shape[0], 2, H_RWKV, RWKV_HEAD, RWKV_HEAD), jnp.float32)
        y_r, S = rwkv_branch(z_rwkv, p, S0)
        y_m, ckv, kr = mla_branch(z_mla, p, None, None)
        state = (S, ckv, kr)
    else:
        ckv_ctx, kr_ctx, S0 = ctx
        y_r, _ = rwkv_branch(z_rwkv, p, S0)
        y_m, _, _ = mla_branch(z_mla, p, ckv_ctx, kr_ctx)
        state = None
    return jnp.concatenate([y_r, y_m], axis=-1) @ p['w_out'], state


def hyena_filters(L, p):
    f32 = jnp.float32
    t = jnp.arange(L, dtype=f32)
    t_norm = t / max(L - 1, 1)
    bands = (POS_EMB - 1) // 2
    freqs = jnp.linspace(1e-4, bands - 1, bands, dtype=f32)
    ang = (2.0 * math.pi / L) * t[:, None] * freqs[None, :]
    z = jnp.concatenate([t_norm[:, None], jnp.cos(ang), -jnp.sin(ang)], axis=-1).astype(p['filt_w1'].dtype)
    h = jnp.sin(p['filt_freq'][0] * (z @ p['filt_w1'] + p['filt_b1']))
    h = jnp.sin(p['filt_freq'][1] * (h @ p['filt_w2'] + p['filt_b2']))
    h = (h @ p['filt_w3']).astype(f32).reshape(L, HYENA_ORDER, 2, D_HYENA)
    deltas = jnp.linspace(abs(math.log(HYENA_TARGET)) / SLOW_DECAY_PCT,
                          abs(math.log(HYENA_TARGET)) / FAST_DECAY_PCT, D_HYENA, dtype=f32)
    h = h * jnp.exp(-t_norm[:, None] * deltas[None, :])[:, None, None, :]
    kern = jnp.concatenate([h[:, :, 0], jnp.zeros((1, HYENA_ORDER, D_HYENA), f32), h[1:, :, 1][::-1]], axis=0)
    kern = kern / jnp.sum(jnp.abs(kern), axis=0, keepdims=True)
    return jnp.fft.rfft(kern, axis=0)


def fftconv(u, K, bias):
    T = u.shape[1]
    uf = u.astype(jnp.float32)
    U = jnp.fft.rfft(uf, n=2 * T, axis=1)
    y = jnp.fft.irfft(U * K[None], n=2 * T, axis=1)[:, :T]
    return (y + uf * bias.astype(jnp.float32)).astype(u.dtype)


def hyena_mixer(h, p):
    z = h @ p['w_in']
    cw = p['conv_w']
    z = cw[0] * shift_prev(z) + cw[1] * z + cw[2] * shift_next(z) + p['conv_b']
    x1, x2, v = jnp.split(z, 3, axis=-1)
    K = hyena_filters(h.shape[1], p)
    y = v
    for n, gate in enumerate((x1, x2)):
        y = gate * fftconv(y, K[:, n], p['bias'][n])
    return y @ p['w_out'], None


def trunk_layer(x, mod, norm_g, ffn_in, ffn_out, mixer):
    sh1, sc1, g1, sh2, sc2, g2, sh3, sc3, g3 = jnp.split(mod, N_MOD, axis=-1)
    x = x + 0.5 * g1 * swiglu(modulate(rmsnorm(x, norm_g[0]), sh1, sc1), ffn_in[0], ffn_out[0])
    y, state = mixer(modulate(rmsnorm(x, norm_g[1]), sh2, sc2))
    x = x + g2 * y
    x = x + 0.5 * g3 * swiglu(modulate(rmsnorm(x, norm_g[2]), sh3, sc3), ffn_in[1], ffn_out[1])
    return x, state


def setup_inputs(seed: int = 0) -> dict:
    key = jax.random.key(seed)
    ks = iter(jax.random.split(key, 64))
    f32 = jnp.float32

    def nrm(shape, scale):
        return jax.random.normal(next(ks), shape, f32) * scale

    def unif(shape, lo, hi):
        return jax.random.uniform(next(ks), shape, f32, lo, hi)

    D = D_MODEL
    return {
        'x_prompt': nrm((BATCH, SEQ, D), 1.0),
        'x_sample': nrm((DEC_BATCH, DEC_SEQ, D), 1.0),
        'cache_mla_ckv': nrm((DEC_BATCH, N_EVEN, PAST_LEN, KV_RANK), 1.0),
        'cache_mla_krope': nrm((DEC_BATCH, N_EVEN, PAST_LEN, QK_ROPE), 1.0),
        'state_rwkv': nrm((DEC_BATCH, N_EVEN, 2, H_RWKV, RWKV_HEAD, RWKV_HEAD), 0.3),
        'c': nrm((DEC_BATCH, D), 1.0),
        'c_ctx': nrm((D,), 1.0),
        'w_mod': nrm((DEPTH, D, N_MOD * D), 0.5 * D ** -0.5),
        'b_mod': nrm((DEPTH, N_MOD * D), 0.02),
        'norm_g': 1.0 + nrm((DEPTH, 3, D), 0.05),
        'w_ffn_in': nrm((DEPTH, 2, D, 2 * D_FF), D ** -0.5),
        'w_ffn_out': nrm((DEPTH, 2, D_FF, D), D_FF ** -0.5),
        'final_norm_g': 1.0 + nrm((D,), 0.05),
        'w_in_even': nrm((N_EVEN, D, IN_EVEN), D ** -0.5),
        'mu_prev': unif((N_EVEN, RWKV_PROJ), 0.0, 0.5),
        'mu_next': unif((N_EVEN, RWKV_PROJ), 0.0, 0.5),
        'rwkv_w0': unif((N_EVEN, 2, D_RWKV), -6.0, -1.0),
        'rwkv_w2': nrm((N_EVEN, 2, W_LORA, D_RWKV), 0.5 * W_LORA ** -0.5),
        'rwkv_a0': nrm((N_EVEN, 2, D_RWKV), 0.5),
        'rwkv_a2': nrm((N_EVEN, 2, A_LORA, D_RWKV), 0.5 * A_LORA ** -0.5),
        'rwkv_g2': nrm((N_EVEN, G_LORA, D_RWKV), G_LORA ** -0.5),
        'rwkv_kk': 0.85 + nrm((N_EVEN, D_RWKV), 0.05),
        'rwkv_ka': 1.0 + nrm((N_EVEN, D_RWKV), 0.05),
        'rwkv_rk': nrm((N_EVEN, H_RWKV, RWKV_HEAD), 0.1),
        'rwkv_gn_w': 1.0 + nrm((N_EVEN, D_RWKV), 0.05),
        'rwkv_gn_b': nrm((N_EVEN, D_RWKV), 0.02),
        'mla_q_norm': 1.0 + nrm((N_EVEN, Q_RANK), 0.05),
        'mla_kv_norm': 1.0 + nrm((N_EVEN, KV_RANK), 0.05),
        'mla_w_qb': nrm((N_EVEN, Q_RANK, H_MLA * (QK_NOPE + QK_ROPE)), Q_RANK ** -0.5),
        'mla_w_kvb': nrm((N_EVEN, KV_RANK, H_MLA * (QK_NOPE + V_HEAD)), KV_RANK ** -0.5),
        'w_out_even': nrm((N_EVEN, MIX_EVEN, D), MIX_EVEN ** -0.5),
        'w_in_odd': nrm((N_ODD, D, 3 * D_HYENA), D ** -0.5),
        'hy_conv_w': nrm((N_ODD, 3, 3 * D_HYENA), 3.0 ** -0.5),
        'hy_conv_b': nrm((N_ODD, 3 * D_HYENA), 0.02),
        'hy_filt_w1': nrm((N_ODD, POS_EMB, FILT_HIDDEN), POS_EMB ** -0.5),
        'hy_filt_b1': nrm((N_ODD, FILT_HIDDEN), 0.1),
        'hy_filt_w2': nrm((N_ODD, FILT_HIDDEN, FILT_HIDDEN), FILT_HIDDEN ** -0.5),
        'hy_filt_b2': nrm((N_ODD, FILT_HIDDEN), 0.1),
        'hy_filt_w3': nrm((N_ODD, FILT_HIDDEN, HYENA_ORDER * 2 * D_HYENA), FILT_HIDDEN ** -0.5),
        'hy_filt_freq': 1.0 + nrm((N_ODD, 2, FILT_HIDDEN), 0.1),
        'hy_bias': nrm((N_ODD, HYENA_ORDER, D_HYENA), 0.5),
        'w_out_odd': nrm((N_ODD, D_HYENA, D), D_HYENA ** -0.5),
    }


def reference(x_prompt, x_sample, cache_mla_ckv, cache_mla_krope, state_rwkv, c, c_ctx,
              w_mod, b_mod, norm_g, w_ffn_in, w_ffn_out, final_norm_g,
              w_in_even, mu_prev, mu_next, rwkv_w0, rwkv_w2, rwkv_a0, rwkv_a2, rwkv_g2,
              rwkv_kk, rwkv_ka, rwkv_rk, rwkv_gn_w, rwkv_gn_b,
              mla_q_norm, mla_kv_norm, mla_w_qb, mla_w_kvb, w_out_even,
              w_in_odd, hy_conv_w, hy_conv_b, hy_filt_w1, hy_filt_b1, hy_filt_w2, hy_filt_b2,
              hy_filt_w3, hy_filt_freq, hy_bias, w_out_odd):
    xp, xs = x_prompt, x_sample
    new_ckv, new_kr, new_s = [], [], []
    for l in range(DEPTH):
        mod_p = (jax.nn.silu(c_ctx) @ w_mod[l] + b_mod[l])[None, None, :]
        mod_s = (jax.nn.silu(c) @ w_mod[l] + b_mod[l])[:, None, :]
        ffn = (norm_g[l], w_ffn_in[l], w_ffn_out[l])
        if l % 2 == 0:
            e = l // 2
            p = {'w_in': w_in_even[e], 'mu_prev': mu_prev[e], 'mu_next': mu_next[e],
                 'w0': rwkv_w0[e], 'w2': rwkv_w2[e], 'a0': rwkv_a0[e], 'a2': rwkv_a2[e],
                 'g2': rwkv_g2[e], 'k_k': rwkv_kk[e], 'k_a': rwkv_ka[e], 'r_k': rwkv_rk[e],
                 'gn_w': rwkv_gn_w[e], 'gn_b': rwkv_gn_b[e],
                 'q_norm': mla_q_norm[e], 'kv_norm': mla_kv_norm[e],
                 'w_qb': mla_w_qb[e], 'w_kvb': mla_w_kvb[e], 'w_out': w_out_even[e]}
            ctx = (cache_mla_ckv[:, e], cache_mla_krope[:, e], state_rwkv[:, e])
            xp, st = trunk_layer(xp, mod_p, *ffn, lambda h: even_mixer(h, p, None))
            xs, _ = trunk_layer(xs, mod_s, *ffn, lambda h: even_mixer(h, p, ctx))
            s_rwkv, ckv, kr = st
            new_s.append(s_rwkv.astype(x_prompt.dtype))
            new_ckv.append(ckv)
            new_kr.append(kr)
        else:
            o = l // 2
            p = {'w_in': w_in_odd[o], 'conv_w': hy_conv_w[o], 'conv_b': hy_conv_b[o],
                 'filt_w1': hy_filt_w1[o], 'filt_b1': hy_filt_b1[o],
                 'filt_w2': hy_filt_w2[o], 'filt_b2': hy_filt_b2[o],
                 'filt_w3': hy_filt_w3[o], 'filt_freq': hy_filt_freq[o],
                 'bias': hy_bias[o], 'w_out': w_out_odd[o]}
            xp, _ = trunk_layer(xp, mod_p, *ffn, lambda h: hyena_mixer(h, p))
            xs, _ = trunk_layer(xs, mod_s, *ffn, lambda h: hyena_mixer(h, p))
    y_prompt = rmsnorm(xp, final_norm_g)
    y_sample = rmsnorm(xs, final_norm_g)
    new_mla_ckv = jnp.stack(new_ckv, axis=1)
    new_mla_krope = jnp.stack(new_kr, axis=1)
    new_rwkv_state = jnp.stack(new_s, axis=1)
    return (y_prompt, y_sample, new_mla_ckv, new_mla_krope, new_rwkv_state)
```

```cpp
#include <hip/hip_runtime.h>
#include <cstdio>
#include <cstdint>
#include <utility>
#define DI __device__ __forceinline__
#define GAS __attribute__((address_space(1)))
#define LAS __attribute__((address_space(3)))
#define CAS __attribute__((address_space(4)))
typedef unsigned short bf16;
typedef unsigned v4u __attribute__((ext_vector_type(4)));
typedef unsigned v2u __attribute__((ext_vector_type(2)));
typedef float f32x4v __attribute__((ext_vector_type(4)));
typedef float f32x2v __attribute__((ext_vector_type(2)));
typedef float f32x16v __attribute__((ext_vector_type(16)));
typedef short s16x8v __attribute__((ext_vector_type(8)));
typedef short s16x4v __attribute__((ext_vector_type(4)));

constexpr int D = 2048, MP = 4096, MS = 8192, MT = 12288, MKV = 12800;
constexpr int DFF = 5632, NFF1 = 11264;
constexpr int ZE_N = 4192, ZE_P = 4352;
constexpr int SCAN_P = 9 * 1024;
constexpr int NCH = 32, CHL = 4096 / NCH;
constexpr int MODL = 3 * 18432;

DI int lane_id_v() { int l; asm volatile("v_mbcnt_lo_u32_b32 %0, -1, 0\n\tv_mbcnt_hi_u32_b32 %0, -1, %0" : "=v"(l)); return l; }
DI unsigned f2bf(float f) { unsigned u = __builtin_bit_cast(unsigned, f); return (u + 0x7fffu + ((u >> 16) & 1u)) >> 16; }
DI unsigned pk2(float lo, float hi) { unsigned r; asm("v_cvt_pk_bf16_f32 %0, %1, %2" : "=v"(r) : "v"(lo), "v"(hi)); return r; }
DI float bf2f(unsigned short b) { return __builtin_bit_cast(float, ((unsigned)b) << 16); }
template <int CTRL> DI float dpp_f(float v) { return __builtin_bit_cast(float, __builtin_amdgcn_update_dpp(0, __builtin_bit_cast(int, v), CTRL, 0xf, 0xf, true)); }
DI float shfl_idx(float v, int src) { return __builtin_bit_cast(float, __builtin_amdgcn_ds_bpermute(src << 2, __builtin_bit_cast(int, v))); }
DI float wave_sum(float v) {
    v += dpp_f<0xB1>(v); v += dpp_f<0x4E>(v); v += dpp_f<0x141>(v); v += dpp_f<0x140>(v);
    v += __builtin_bit_cast(float, __builtin_amdgcn_ds_swizzle(__builtin_bit_cast(int, v), 0x401F));
    return __builtin_bit_cast(float, __builtin_amdgcn_readlane(__builtin_bit_cast(int, v), 0)) + __builtin_bit_cast(float, __builtin_amdgcn_readlane(__builtin_bit_cast(int, v), 32));
}
DI float sigmoid_f(float x) { return __builtin_amdgcn_rcpf(1.f + __expf(-x)); }
DI float silu_f(float x) { return x * sigmoid_f(x); }
DI int scan_perm(int j) { return 4 * (j & 15) + (j >> 4); }
DI int row_mod_j(int row) { return row < MP ? 0 : 1 + ((row - MP) >> 12); }
namespace pg8 {
#define PG8_LAS __attribute__((address_space(3)))
typedef unsigned short bf16_t;
typedef short bf16x8 __attribute__((ext_vector_type(8)));
typedef float f32x4 __attribute__((ext_vector_type(4)));
typedef unsigned u32x4 __attribute__((ext_vector_type(4)));
constexpr int BM = 256, BK = 64, HALF = 128, HTB = HALF * BK * 2  , STAGE_BYTES = 8 * HTB, NXCD = 8, WGM = 8;

__host__ __device__ __forceinline__ int lds_byte(int r, int c) { const int st = (r >> 4) * 2 + (c >> 5), rr = r & 15, cc = c & 31, ob = rr * 64 + cc * 2; return st * 1024 + (ob ^ (((ob >> 9) & 1) << 5)); }
__host__ __device__ __forceinline__ void stage_rc(int b, int& R, int& C) { const int st = b / 1024, sb = b % 1024, swz = sb ^ (((sb >> 9) & 1) << 5); R = (st >> 1) * 16 + swz / 64; C = (st & 1) * 32 + (swz % 64) / 2; }
__host__ __device__ __forceinline__ int perm32(int rho) { const int n = rho >> 4, i = rho & 15; return 8 * (i >> 2) + 4 * n + (i & 3); }

struct Unit { int pm, pn; int kt0, nkt, mode, slot; };
struct Gemm { const bf16_t* A; const bf16_t* Bt; int M, N, K; };
struct StaticOrder {
    static constexpr int SPLITK = 0;
    int nM, nN, nwg, G, c;
    __host__ __device__ __forceinline__ void init(int M, int N, int G_, int c_) { nM = M / BM; nN = N / BM; nwg = nM * nN; G = G_; c = c_; }
    __host__ __device__ __forceinline__ bool next(int i, Unit& u) const {
        const long L = (long)i * G + c; if (L >= nwg) return false;
        int wgid = (int)L; { const int q = nwg / NXCD, r = nwg % NXCD, xcd = wgid % NXCD, off = wgid / NXCD; wgid = (xcd < r ? xcd * (q + 1) : r * (q + 1) + (xcd - r) * q) + off; }
        const int nig = WGM * nN, gid = wgid / nig, fm = gid * WGM, gsz = (nM - fm) < WGM ? (nM - fm) : WGM;
        u.pm = fm + ((wgid % nig) % gsz); u.pn = (wgid % nig) / gsz; u.kt0 = 0; u.nkt = 0; u.mode = 0; u.slot = 0; return true;
    }
    __device__ __forceinline__ void a_ready(const Unit&) const {}
    __device__ __forceinline__ void done(const Unit&) const {}
    __device__ __forceinline__ void publish(const f32x4 (&)[2][2][4][2], const Unit&, int, int) const {}
    __device__ __forceinline__ void consume(f32x4 (&)[2][2][4][2], const Unit&, int, int) const {}
};

template <int PART> struct PairOrder {
    static constexpr int SPLITK = PART;
    StaticOrder so; int R, rem, nt; bool paired;
    float* scratch; unsigned* flags; unsigned target;
    __device__ __forceinline__ void init(int M, int N, int K, int G_, int c_, float* scr, unsigned* fl, unsigned tgt) { so.init(M, N, G_, 0); so.c = 0; so.G = 1; R = so.nwg / G_; rem = so.nwg % G_; nt = K / BK;
        paired = (2 * rem == G_) && ((nt / 2) % 2 == 0); c = c_; G = G_; scratch = scr; flags = fl; target = tgt; }
    int c, G;
    __device__ __forceinline__ bool tile(int t, Unit& u) const { return so.next(t, u); }
    __device__ __forceinline__ bool next(int i, Unit& u) const {
        int t = -1, kt0 = 0, nk = nt, mode = 0, slot = 0;
        if (!paired) { if (PART == 1) { const long L = (long)i * G + c; if (L < so.nwg) t = (int)L; } }
        else if (PART == 1) {
            if (c < rem) { if (i == 0) { t = R * G + c; nk = nt / 2; mode = 1; slot = c; } else if (i <= R) t = (i - 1) * G + c; }
            else if (i < R) t = i * G + c;
        }
        else if (c >= rem && i == 0) { t = R * G + (c - rem); kt0 = nt / 2; nk = nt - nt / 2; mode = 2; slot = c - rem; }
        if (t < 0) return false;
        tile(t, u); u.kt0 = kt0; u.nkt = nk; u.mode = mode; u.slot = slot; return true;
    }
    __device__ __forceinline__ void a_ready(const Unit&) const {}
    __device__ __forceinline__ void done(const Unit&) const {}
    __device__ __forceinline__ void publish(const f32x4 (&acc)[2][2][4][2], const Unit& u, int wid, int lane) const {
        const __amdgpu_buffer_rsrc_t rs = __builtin_amdgcn_make_buffer_rsrc((void*)scratch, 0, 0x7fffffff, 0x00020000);
        const int so_ = __builtin_amdgcn_readfirstlane(u.slot * 262144 + wid * 32768), vo = lane * 16;
#pragma unroll
        for (int ai = 0; ai < 2; ++ai)
#pragma unroll
            for (int bj = 0; bj < 2; ++bj)
#pragma unroll
                for (int m = 0; m < 4; ++m)
#pragma unroll
                    for (int n = 0; n < 2; ++n) { const int r = ((ai * 2 + bj) * 4 + m) * 2 + n;
                        __builtin_amdgcn_raw_buffer_store_b128(__builtin_bit_cast(u32x4, acc[ai][bj][m][n]), rs, vo, so_ + r * 1024, 16); }
        asm volatile("s_waitcnt vmcnt(0)" ::: "memory");
        if (lane == 0) __hip_atomic_fetch_add(flags + 64 * u.slot, 1u, __ATOMIC_RELAXED, __HIP_MEMORY_SCOPE_AGENT);
    }
    __device__ __forceinline__ void consume(f32x4 (&acc)[2][2][4][2], const Unit& u, int wid, int lane) const {
        unsigned spins = 0;
        while ((unsigned)__builtin_amdgcn_readfirstlane((int)__hip_atomic_load(flags + 64 * u.slot, __ATOMIC_RELAXED, __HIP_MEMORY_SCOPE_AGENT)) < target) { __builtin_amdgcn_s_sleep(2); if (++spins > (1u << 22)) break; }
        __builtin_amdgcn_fence(__ATOMIC_ACQUIRE, "agent");
        asm volatile("s_waitcnt vmcnt(0)" ::: "memory");
        const __amdgpu_buffer_rsrc_t rs = __builtin_amdgcn_make_buffer_rsrc((void*)scratch, 0, 0x7fffffff, 0x00020000);
        const int so_ = __builtin_amdgcn_readfirstlane(u.slot * 262144 + wid * 32768), vo = lane * 16;
#pragma unroll
        for (int ai = 0; ai < 2; ++ai)
#pragma unroll
            for (int bj = 0; bj < 2; ++bj)
#pragma unroll
                for (int mh = 0; mh < 2; ++mh) {
                    f32x4 t[4];
#pragma unroll
                    for (int q = 0; q < 4; ++q) { const int m = mh * 2 + (q >> 1), n = q & 1; const int r = ((ai * 2 + bj) * 4 + m) * 2 + n; t[q] = __builtin_bit_cast(f32x4, __builtin_amdgcn_raw_buffer_load_b128(rs, vo, so_ + r * 1024, 16)); }
#pragma unroll
                    for (int q = 0; q < 4; ++q) { const int m = mh * 2 + (q >> 1), n = q & 1; acc[ai][bj][m][n] += t[q]; }
                    asm volatile("" ::: "memory");
                }
    }
};
__device__ __forceinline__ unsigned cvt_pk_bf16(float lo, float hi) { unsigned r; asm volatile("v_cvt_pk_bf16_f32 %0, %1, %2" : "=v"(r) : "v"(lo), "v"(hi)); return r; }
typedef float f32x2 __attribute__((ext_vector_type(2)));
#define EPI_LOOP_AIM _Pragma("unroll") for (int ai = 0; ai < 2; ++ai) _Pragma("unroll") for (int m = 0; m < 4; ++m)
#define EPI_LOOP_BJN _Pragma("unroll") for (int bj = 0; bj < 2; ++bj) _Pragma("unroll") for (int n = 0; n < 2; ++n)
struct EpiF32 {
    static constexpr bool PERM = false, AFTER_DRAIN = false;
    float* C; int ldc;
    __device__ __forceinline__ void operator()(const f32x4 (&acc)[2][2][4][2], const Unit& u, int wr, int wc, int fr, int fq) const {
        const int row0 = u.pm * BM + wr * 64 + fr, col0 = u.pn * BM + wc * 32 + 4 * fq;
        EPI_LOOP_AIM { float* rowp = C + (size_t)(row0 + ai * HALF + m * 16) * ldc + col0;
            EPI_LOOP_BJN *(f32x4*)(rowp + bj * HALF + n * 16) = acc[ai][bj][m][n]; }
    }
};
struct EpiBf16Plain {
    static constexpr bool PERM = true, AFTER_DRAIN = false;
    bf16_t* O; int ldc;
    __device__ __forceinline__ void operator()(const f32x4 (&acc)[2][2][4][2], const Unit& u, int wr, int wc, int fr, int fq) const {
        const int row0 = u.pm * BM + wr * 64 + fr, col0 = u.pn * BM + wc * 32 + 8 * fq;
        EPI_LOOP_AIM { bf16_t* rowp = O + (size_t)(row0 + ai * HALF + m * 16) * ldc + col0;
#pragma unroll
            for (int bj = 0; bj < 2; ++bj) { const f32x4 v0 = acc[ai][bj][m][0], v1 = acc[ai][bj][m][1];
                u32x4 w; w.x = cvt_pk_bf16(v0[0], v0[1]); w.y = cvt_pk_bf16(v0[2], v0[3]); w.z = cvt_pk_bf16(v1[0], v1[1]); w.w = cvt_pk_bf16(v1[2], v1[3]);
                *(u32x4*)(rowp + bj * HALF) = w; } }
    }
};
struct EpiSwiGLU {
    static constexpr bool PERM = true, AFTER_DRAIN = false;
    bf16_t* O; int ldc;
    __device__ __forceinline__ void operator()(const f32x4 (&acc)[2][2][4][2], const Unit& u, int wr, int wc, int fr, int fq) const {
        const int row0 = u.pm * BM + wr * 64 + fr, col0 = u.pn * HALF + wc * 32 + 8 * fq;
        EPI_LOOP_AIM { bf16_t* rowp = O + (size_t)(row0 + ai * HALF + m * 16) * ldc + col0;
            float o[8];
#pragma unroll
            for (int n = 0; n < 2; ++n)
#pragma unroll
                for (int i = 0; i < 4; ++i) { const float g = acc[ai][0][m][n][i], up = acc[ai][1][m][n][i]; o[n * 4 + i] = g * __builtin_amdgcn_rcpf(1.f + __expf(-g)) * up; }
            u32x4 w; w.x = cvt_pk_bf16(o[0], o[1]); w.y = cvt_pk_bf16(o[2], o[3]); w.z = cvt_pk_bf16(o[4], o[5]); w.w = cvt_pk_bf16(o[6], o[7]);
            *(u32x4*)rowp = w; }
    }
};
struct EpiRes {
    static constexpr bool PERM = false, AFTER_DRAIN = false;
    float* X; const float* gate; float coef;
    __device__ __forceinline__ void operator()(const f32x4 (&acc)[2][2][4][2], const Unit& u, int wr, int wc, int fr, int fq) const {
        const int row0 = u.pm * BM + wr * 64 + fr, col0 = u.pn * BM + wc * 32 + 4 * fq;
        const int rt = u.pm * BM; const int j = rt < 4096 ? 0 : 1 + ((rt - 4096) >> 12);
        const float* g = gate + j * 18432 + col0;
        f32x4 gv[2][2];
        EPI_LOOP_BJN gv[bj][n] = *(const f32x4*)(g + bj * HALF + n * 16) * coef;
        EPI_LOOP_AIM { float* rowp = X + (size_t)(row0 + ai * HALF + m * 16) * 2048 + col0;
            EPI_LOOP_BJN { f32x4 x = *(const f32x4*)(rowp + bj * HALF + n * 16); x += gv[bj][n] * acc[ai][bj][m][n]; *(f32x4*)(rowp + bj * HALF + n * 16) = x; }
            asm volatile("" ::: "memory"); }
    }
};
struct EpiZT {
    static constexpr bool PERM = false, AFTER_DRAIN = false;
    float* ZTp; float* ZTs;
    __device__ __forceinline__ void operator()(const f32x4 (&acc)[2][2][4][2], const Unit& u, int wr, int wc, int fr, int fq) const {
        const int ch0 = u.pm * BM + wr * 64 + fr, tok0 = u.pn * BM;
        float* base; int pitch, toff;
        if (tok0 < 4096) { base = ZTp + (size_t)(tok0 >> 8) * 6144 * 256; pitch = 256; toff = 0; }
        else { const int tk = tok0 - 4096; base = ZTs + (size_t)(tk >> 12) * 6144 * 4096; pitch = 4096; toff = tk & 4095; }
        const int c0 = toff + wc * 32 + 4 * fq;
        EPI_LOOP_AIM { float* rowp = base + (size_t)(ch0 + ai * HALF + m * 16) * pitch + c0;
            EPI_LOOP_BJN *(f32x4*)(rowp + bj * HALF + n * 16) = acc[ai][bj][m][n]; }
    }
};
struct EpiVT {
    static constexpr bool PERM = true, AFTER_DRAIN = false;
    bf16_t* VTp; size_t s_off;
    __device__ __forceinline__ void operator()(const f32x4 (&acc)[2][2][4][2], const Unit& u, int wr, int wc, int fr, int fq) const {
        const int ch0 = u.pm * BM + wr * 64 + fr, tok0 = u.pn * BM;
        bf16_t* base; int pitch, toff; bf16_t* VTs = VTp + s_off;
        if (tok0 < 4096) { base = VTp + (size_t)(tok0 >> 8) * 1024 * 256; pitch = 256; toff = 0; }
        else if (tok0 < 12288) { const int tk = tok0 - 4096; base = VTs + (size_t)(tk >> 12) * 1024 * 4352; pitch = 4352; toff = tk & 4095; }
        else { const int tk = tok0 - 12288; base = VTs + (size_t)(tk >> 8) * 1024 * 4352; pitch = 4352; toff = 4096; }
        const int c0 = toff + wc * 32 + 8 * fq;
        EPI_LOOP_AIM { bf16_t* rowp = base + (size_t)(ch0 + ai * HALF + m * 16) * pitch + c0;
#pragma unroll
            for (int bj = 0; bj < 2; ++bj) { const f32x4 v0 = acc[ai][bj][m][0], v1 = acc[ai][bj][m][1];
                u32x4 w; w.x = cvt_pk_bf16(v0[0], v0[1]); w.y = cvt_pk_bf16(v0[2], v0[3]); w.z = cvt_pk_bf16(v1[0], v1[1]); w.w = cvt_pk_bf16(v1[2], v1[3]);
                *(u32x4*)(rowp + bj * HALF) = w; } }
    }
};
struct EpiQ {
    static constexpr bool PERM = true, AFTER_DRAIN = false;
    bf16_t* Q; const float* rope; float qs;
    __device__ __forceinline__ void operator()(const f32x4 (&acc)[2][2][4][2], const Unit& u, int wr, int wc, int fr, int fq) const {
        const int row0 = u.pm * BM + wr * 64 + fr;
        EPI_LOOP_AIM { const int row = row0 + ai * HALF + m * 16; const bool smp = row >= 4096; const int t = (row - 4096) & 4095;
#pragma unroll
            for (int bj = 0; bj < 2; ++bj) { const int c0 = u.pn * BM + bj * HALF + wc * 32 + 8 * fq; const int within = c0 % 192;
                float o[8];
#pragma unroll
                for (int n = 0; n < 2; ++n)
#pragma unroll
                    for (int i = 0; i < 4; ++i) o[n * 4 + i] = acc[ai][bj][m][n][i];
                if (within >= 128 && smp) { const int ri = within - 128;
#pragma unroll
                    for (int q = 0; q < 4; ++q) { const int idx = ri + 2 * q, hf = idx >> 5, j = (idx & 31) >> 1; const int pos = hf ? (t & 63) : (t >> 6);
                        const float2 cs = *(const float2*)(rope + (pos * 16 + j) * 2); const float x1 = o[2 * q], x2 = o[2 * q + 1];
                        o[2 * q] = x1 * cs.x - x2 * cs.y; o[2 * q + 1] = x2 * cs.x + x1 * cs.y; } }
                u32x4 w; w.x = cvt_pk_bf16(o[0] * qs, o[1] * qs); w.y = cvt_pk_bf16(o[2] * qs, o[3] * qs); w.z = cvt_pk_bf16(o[4] * qs, o[5] * qs); w.w = cvt_pk_bf16(o[6] * qs, o[7] * qs);
                *(u32x4*)(Q + (size_t)row * 1536 + c0) = w; } }
    }
};
struct EpiLora {
    static constexpr bool PERM = false, AFTER_DRAIN = false;
    unsigned char* wsb; const float* w0; const float* a0; const float* ka; size_t off_sc, off_kb, off_gb;
    __device__ __forceinline__ void operator()(const f32x4 (&acc)[2][2][4][2], const Unit& u, int wr, int wc, int fr, int fq) const {
        const int row0 = u.pm * BM + wr * 64 + fr; const int seg = u.pn >> 2; const int cb = (u.pn & 3) * BM + wc * 32 + 4 * fq;
        float* SC = (float*)(wsb + off_sc); const float* KB = (const float*)(wsb + off_kb); float* GB = (float*)(wsb + off_gb);
        EPI_LOOP_AIM { const int row = row0 + ai * HALF + m * 16; float* sc = SC + (size_t)row * 9216;
            EPI_LOOP_BJN { const int c = cb + bj * HALF + n * 16; const f32x4 a = acc[ai][bj][m][n];
                if (seg < 2) { const f32x4 wv = *(const f32x4*)(w0 + seg * 1024 + c); f32x4 o;
#pragma unroll
                    for (int i = 0; i < 4; ++i) { const float x = wv[i] + a[i]; const float sp = __logf(1.f + __expf(-x)); o[i] = __expf(-__expf(-sp - 0.5f)); }
                    *(f32x4*)(sc + (3 + seg) * 1024 + c) = o; }
                else if (seg < 4) { const int d = seg - 2; const f32x4 av = *(const f32x4*)(a0 + d * 1024 + c), kav = *(const f32x4*)(ka + c);
                    const f32x4 kk = *(const f32x4*)(sc + 2 * 1024 + c), kr = *(const f32x4*)(KB + (size_t)row * 1024 + c); f32x4 o1, o2;
#pragma unroll
                    for (int i = 0; i < 4; ++i) { const float s = __builtin_amdgcn_rcpf(1.f + __expf(-(av[i] + a[i]))); o1[i] = kk[i] * s; o2[i] = kr[i] * (1.f + (s - 1.f) * kav[i]); }
                    *(f32x4*)(sc + (5 + d) * 1024 + c) = o1; *(f32x4*)(sc + (7 + d) * 1024 + c) = o2; }
                else *(f32x4*)(GB + (size_t)row * 1024 + c) = a; }
            asm volatile("" ::: "memory"); }
    }
};
template <class Epi, class Sched, bool ALIGN_EPI = false, bool SP2 = false>
__device__ __forceinline__ void gemm_phase(PG8_LAS unsigned char* lds, const Gemm g, const Sched& S, const Epi& E, int wave_id) {
    const int tid_l_ = wave_id * 64 + lane_id_v();
    const int tid = tid_l_, wid = __builtin_amdgcn_readfirstlane(tid >> 6), lane = tid & 63, wr = wid >> 2, wc = wid & 3, fr = lane & 15, fq = lane >> 4;
    const int K = g.K, nt = K / BK;
    unsigned voffA[2], voffB[2];
#pragma unroll
    for (int i = 0; i < 2; ++i) { int R, C; stage_rc(tid * 16 + i * 8192, R, C); const int Rb = Epi::PERM ? ((R & ~31) + perm32(R & 31)) : R;
        voffA[i] = (unsigned)(R * K + C) * 2u; voffB[i] = (unsigned)(Rb * K + C) * 2u; }
    const size_t kstep = (size_t)(BK * 2);
    const size_t hstep = (size_t)HALF * K * 2;
    const size_t tstep = 2 * hstep;
    const unsigned ldsw = (unsigned)wid * 1024u;
    const int aoff = lds_byte(wr * 64 + fr, fq * 8), boff = lds_byte(wc * 32 + fr, fq * 8);
#define PG8_SA(b, h) (((b) * 2 + (h)) * HTB)
#define PG8_SB(b, h) ((4 + (b) * 2 + (h)) * HTB)
#define PG8_STAGE(bufoff, gbase, voff) do { _Pragma("unroll") for (int _i = 0; _i < 2; ++_i) \
        __builtin_amdgcn_global_load_lds((const unsigned*)((const char*)(gbase) + (voff)[_i]), (PG8_LAS unsigned*)(lds + (bufoff) + ldsw + _i * 8192), 16, 0, 0); } while (0)
#define PG8_LDA(dst, b, h) do { _Pragma("unroll") for (int m = 0; m < 4; ++m) _Pragma("unroll") for (int k = 0; k < 2; ++k) dst[m][k] = *(const PG8_LAS bf16x8*)(lds + PG8_SA(b, h) + aoff + m * 2048 + k * 1024); } while (0)
#define PG8_LDB(dst, b, h) do { _Pragma("unroll") for (int n = 0; n < 2; ++n) _Pragma("unroll") for (int k = 0; k < 2; ++k) dst[n][k] = *(const PG8_LAS bf16x8*)(lds + PG8_SB(b, h) + boff + n * 2048 + k * 1024); } while (0)
#define PG8_MMA(ai, bj, At, Bt) do { __builtin_amdgcn_s_setprio(1); _Pragma("unroll") for (int m = 0; m < 4; ++m) _Pragma("unroll") for (int n = 0; n < 2; ++n) _Pragma("unroll") for (int k = 0; k < 2; ++k) \
        acc[ai][bj][m][n] = __builtin_amdgcn_mfma_f32_16x16x32_bf16(Bt[n][k], At[m][k], acc[ai][bj][m][n], 0, 0, 0); __builtin_amdgcn_s_setprio(0); } while (0)
#define PG8_WAIT_V(n) asm volatile("s_waitcnt vmcnt(" #n ")" ::: "memory")
#define PG8_WAIT_L(n) asm volatile("s_waitcnt lgkmcnt(" #n ")" ::: "memory")
#define PG8_BAR __builtin_amdgcn_s_barrier()
#define PG8_SCHED __builtin_amdgcn_sched_barrier(0)
    Unit cur, nxt; int ui = 0;
    if (!S.next(0, cur)) return;
    f32x4 acc[2][2][4][2];
#pragma unroll
    for (int a = 0; a < 2; ++a)
#pragma unroll
        for (int b = 0; b < 2; ++b)
#pragma unroll
            for (int m = 0; m < 4; ++m)
#pragma unroll
                for (int n = 0; n < 2; ++n) acc[a][b][m][n] = (f32x4){0.f, 0.f, 0.f, 0.f};
    bf16x8 At[4][2], B0[2][2], B1[2][2];
    const char* cA = (const char*)g.A + (size_t)cur.pm * tstep; const char* cB = (const char*)g.Bt + (size_t)cur.pn * tstep;
    if constexpr (Sched::SPLITK != 0) { cA += (size_t)cur.kt0 * kstep; cB += (size_t)cur.kt0 * kstep; }
    S.a_ready(cur);
    if constexpr (SP2) {
        PG8_STAGE(PG8_SB(0, 0), cB, voffB); PG8_STAGE(PG8_SB(0, 1), cB + hstep, voffB); PG8_STAGE(PG8_SA(0, 0), cA, voffA); PG8_STAGE(PG8_SA(0, 1), cA + hstep, voffA);
        if (wr == 1) PG8_BAR;
        PG8_WAIT_V(2); PG8_BAR;
        PG8_STAGE(PG8_SB(1, 0), cB + kstep, voffB); PG8_STAGE(PG8_SA(1, 0), cA + kstep, voffA); PG8_STAGE(PG8_SB(1, 1), cB + hstep + kstep, voffB);
        PG8_WAIT_V(6); PG8_BAR;
    } else {
        PG8_STAGE(PG8_SB(0, 0), cB, voffB); PG8_STAGE(PG8_SA(0, 0), cA, voffA); PG8_STAGE(PG8_SB(0, 1), cB + hstep, voffB); PG8_STAGE(PG8_SA(0, 1), cA + hstep, voffA);
        if (wr == 1) PG8_BAR;
        PG8_WAIT_V(4); PG8_BAR;
        PG8_STAGE(PG8_SB(1, 0), cB + kstep, voffB); PG8_STAGE(PG8_SA(1, 0), cA + kstep, voffA); PG8_STAGE(PG8_SB(1, 1), cB + hstep + kstep, voffB);
        PG8_WAIT_V(6); PG8_BAR;
    }
    for (;;) {
        const bool has_next = S.next(ui + 1, nxt);
        const char* nA = has_next ? (const char*)g.A + (size_t)nxt.pm * tstep : cA; const char* nB = has_next ? (const char*)g.Bt + (size_t)nxt.pn * tstep : cB;
        if constexpr (Sched::SPLITK != 0) { if (has_next) { nA += (size_t)nxt.kt0 * kstep; nB += (size_t)nxt.kt0 * kstep; } }
        const int cnt = Sched::SPLITK != 0 ? cur.nkt : nt;
        for (int t = 0; t < cnt; t += 2) {
            const bool last = (t == cnt - 2);
            const char* a1 = cA + (size_t)(t + 1) * kstep;
            const char* a2 = last ? nA : cA + (size_t)(t + 2) * kstep; const char* b2 = last ? nB : cB + (size_t)(t + 2) * kstep;
            const char* a3 = a2 + kstep; const char* b3 = b2 + kstep;
            if (last && has_next) S.a_ready(nxt);
            if constexpr (SP2) {
            PG8_LDB(B0, 0, 0); PG8_LDB(B1, 0, 1); PG8_SCHED; PG8_LDA(At, 0, 0); PG8_STAGE(PG8_SA(1, 1), a1 + hstep, voffA);
            PG8_WAIT_V(8); PG8_WAIT_L(0); PG8_BAR; PG8_MMA(0, 0, At, B0); PG8_MMA(0, 1, At, B1); PG8_BAR; PG8_SCHED;
            PG8_LDA(At, 0, 1); PG8_STAGE(PG8_SB(0, 0), b2, voffB); PG8_STAGE(PG8_SB(0, 1), b2 + hstep, voffB); PG8_STAGE(PG8_SA(0, 0), a2, voffA);
            PG8_WAIT_V(8); PG8_WAIT_L(0); PG8_BAR; PG8_MMA(1, 0, At, B0); PG8_MMA(1, 1, At, B1); PG8_BAR; PG8_SCHED;
            PG8_LDB(B0, 1, 0); PG8_LDB(B1, 1, 1); PG8_SCHED; PG8_LDA(At, 1, 0); PG8_STAGE(PG8_SA(0, 1), a2 + hstep, voffA);
            PG8_WAIT_V(8); PG8_WAIT_L(0); PG8_BAR; PG8_MMA(0, 0, At, B0); PG8_MMA(0, 1, At, B1); PG8_BAR; PG8_SCHED;
            PG8_LDA(At, 1, 1); PG8_STAGE(PG8_SB(1, 0), b3, voffB); PG8_STAGE(PG8_SB(1, 1), b3 + hstep, voffB); PG8_STAGE(PG8_SA(1, 0), a3, voffA);
            PG8_WAIT_V(8); PG8_WAIT_L(0); PG8_BAR; PG8_MMA(1, 0, At, B0); PG8_MMA(1, 1, At, B1); PG8_BAR; PG8_SCHED;
            } else {
            PG8_LDB(B0, 0, 0); PG8_SCHED; PG8_LDA(At, 0, 0); PG8_STAGE(PG8_SA(1, 1), a1 + hstep, voffA);
            PG8_WAIT_L(8); PG8_BAR; PG8_WAIT_L(0); PG8_MMA(0, 0, At, B0); PG8_BAR; PG8_SCHED;
            PG8_LDB(B1, 0, 1); PG8_STAGE(PG8_SB(0, 0), b2, voffB);
            PG8_BAR; PG8_WAIT_L(0); PG8_MMA(0, 1, At, B1); PG8_BAR;
            PG8_LDA(At, 0, 1); PG8_STAGE(PG8_SA(0, 0), a2, voffA);
            PG8_BAR; PG8_WAIT_L(0); PG8_MMA(1, 0, At, B0); PG8_BAR; PG8_SCHED;
            PG8_STAGE(PG8_SB(0, 1), b2 + hstep, voffB);
            PG8_WAIT_V(6); PG8_BAR; PG8_MMA(1, 1, At, B1); PG8_BAR;
            PG8_LDB(B0, 1, 0); PG8_SCHED; PG8_LDA(At, 1, 0); PG8_STAGE(PG8_SA(0, 1), a2 + hstep, voffA);
            PG8_WAIT_L(8); PG8_BAR; PG8_WAIT_L(0); PG8_MMA(0, 0, At, B0); PG8_BAR; PG8_SCHED;
            PG8_LDB(B1, 1, 1); PG8_STAGE(PG8_SB(1, 0), b3, voffB);
            PG8_BAR; PG8_WAIT_L(0); PG8_MMA(0, 1, At, B1); PG8_BAR;
            PG8_LDA(At, 1, 1); PG8_STAGE(PG8_SA(1, 0), a3, voffA);
            PG8_BAR; PG8_WAIT_L(0); PG8_MMA(1, 0, At, B0); PG8_BAR; PG8_SCHED;
            PG8_STAGE(PG8_SB(1, 1), b3 + hstep, voffB);
            PG8_WAIT_V(6); PG8_BAR; PG8_MMA(1, 1, At, B1); PG8_BAR;
            }
        }
        if constexpr (ALIGN_EPI) { if (wr == 0) PG8_BAR; }
        if constexpr (Sched::SPLITK == 1) { if (cur.mode == 1) S.publish(acc, cur, wid, lane); else E(acc, cur, wr, wc, fr, fq); S.done(cur); }
        else if constexpr (Sched::SPLITK == 2) { S.consume(acc, cur, wid, lane); E(acc, cur, wr, wc, fr, fq); S.done(cur); }
        else if constexpr (!Epi::AFTER_DRAIN) { E(acc, cur, wr, wc, fr, fq); S.done(cur); }
        if (!has_next) break;
#pragma unroll
        for (int a = 0; a < 2; ++a)
#pragma unroll
            for (int b = 0; b < 2; ++b)
#pragma unroll
                for (int m = 0; m < 4; ++m)
#pragma unroll
                    for (int n = 0; n < 2; ++n) acc[a][b][m][n] = (f32x4){0.f, 0.f, 0.f, 0.f};
        cur = nxt; cA = nA; cB = nB; ++ui;
        if constexpr (ALIGN_EPI) { if (wr == 1) PG8_BAR; }
    }
    PG8_WAIT_V(0);
    if constexpr (!ALIGN_EPI) { if (wr == 0) PG8_BAR; }
    PG8_BAR;
    if constexpr (Epi::AFTER_DRAIN) { E.fused(acc, cur, wr, wc, fr, fq, lds, wid, lane); S.done(cur); }
#undef PG8_SA
#undef PG8_SB
#undef PG8_STAGE
#undef PG8_LDA
#undef PG8_LDB
#undef PG8_MMA
#undef PG8_WAIT_V
#undef PG8_WAIT_L
#undef PG8_BAR
#undef PG8_SCHED
}
}
#define XB_TMO      128
#define XB_XCNT(j)  (256  + 64 * (j))
#define XB_XSUB(j)  (1280 + 64 * (j))
#define XB_XGEN(j)  (2304 + 64 * (j))
#define XB_TOP      3328
#define XB_TOPGEN   3392
#define XCD_BAR_WORDS 3456
#define XB_SPIN_CAP (1u << 18)

__device__ __forceinline__ unsigned xb_ld(unsigned* p)              { return __hip_atomic_load(p, __ATOMIC_RELAXED, __HIP_MEMORY_SCOPE_AGENT); }
__device__ __forceinline__ unsigned xb_add(unsigned* p, unsigned v) { return __hip_atomic_fetch_add(p, v, __ATOMIC_RELAXED, __HIP_MEMORY_SCOPE_AGENT); }
__device__ __forceinline__ unsigned xb_xcc_id() { return (unsigned)__builtin_amdgcn_s_getreg((3 << 11) | 20) & 0xFu; }
#define XB_SPIN(cond, bar) do { unsigned _sp = 0; while (cond) { __builtin_amdgcn_s_sleep(1); \
    if ((++_sp & 255u) == 0u) { if (xb_ld(&(bar)[XB_TMO])) break; if (_sp > XB_SPIN_CAP) { atomicAdd(&(bar)[XB_TMO], 1u); break; } } } } while (0)

struct XcdBarrier {
    unsigned* bar; unsigned x;
    volatile LAS unsigned* st;
};

__device__ __forceinline__ XcdBarrier xcd_barrier_post(unsigned* bar, volatile LAS unsigned* st, int tid_) {
    XcdBarrier b; b.bar = bar; b.x = xb_xcc_id(); b.st = st;
    if (tid_ == 0) (void)xb_add(&bar[XB_XCNT(b.x)], 1u);
    return b;
}
__device__ __forceinline__ void xcd_barrier_complete(unsigned* bar, unsigned x, unsigned& nloc, unsigned& nx) {
    const unsigned G = gridDim.x * gridDim.y * gridDim.z;
    unsigned sum, cnt, mine, sp = 0u;
    for (;;) {
        sum = 0u; cnt = 0u; mine = 0u;
#pragma unroll
        for (unsigned j = 0; j < 16; ++j) { const unsigned c = xb_ld(&bar[XB_XCNT(j)]); sum += c; cnt += (c > 0u) ? 1u : 0u; mine = (j == x) ? c : mine; }
        if (sum == G) break;
        __builtin_amdgcn_s_sleep(1);
        if ((++sp & 255u) == 0u) { if (xb_ld(&bar[XB_TMO])) break; if (sp > XB_SPIN_CAP) { atomicAdd(&bar[XB_TMO], 1u); break; } }
    }
    nloc = mine > 0u ? mine : 1u; nx = cnt > 0u ? cnt : 1u;
}

__device__ __forceinline__ void xcd_barrier(const XcdBarrier& b, int tid_) {
    asm volatile("s_waitcnt vmcnt(0)" ::: "memory");
    __syncthreads();
    if (tid_ == 0) {
        unsigned* bar = b.bar;
        __builtin_amdgcn_s_waitcnt(0);
        unsigned nloc = b.st[0], nx = b.st[1];
        if (nloc == 0u) { xcd_barrier_complete(bar, b.x, nloc, nx); b.st[0] = nloc; b.st[1] = nx; }
        const unsigned old = xb_add(&bar[XB_XSUB(b.x)], 1u);
        const unsigned gen = old / nloc;
        if (old + 1u == (gen + 1u) * nloc) {
            __builtin_amdgcn_fence(__ATOMIC_RELEASE, "agent");
            asm volatile("s_waitcnt vmcnt(0)" ::: "memory");
            const unsigned og = xb_add(&bar[XB_TOP], 1u);
            const unsigned tg = og / nx;
            if (og + 1u == (tg + 1u) * nx) xb_add(&bar[XB_TOPGEN], 1u);
            else XB_SPIN(xb_ld(&bar[XB_TOPGEN]) == tg, bar);
            __builtin_amdgcn_fence(__ATOMIC_ACQUIRE, "agent");
            xb_add(&bar[XB_XGEN(b.x)], 1u);
            asm volatile("s_waitcnt vmcnt(0)" ::: "memory");
        } else {
            XB_SPIN(xb_ld(&bar[XB_XGEN(b.x)]) == gen, bar);
            __builtin_amdgcn_fence(__ATOMIC_ACQUIRE, "agent");
            asm volatile("s_waitcnt vmcnt(0)" ::: "memory");
        }
    }
    __syncthreads();
}

constexpr size_t MiB = 1u << 20;
constexpr size_t WS_CTL = 0, CTL_ZERO_BYTES = 2 * MiB;
constexpr size_t WS_MOD = 2 * MiB;
constexpr size_t WS_PMOD = WS_MOD + 2 * MiB;
constexpr size_t WS_ROPE = WS_PMOD + 8 * MiB;
constexpr size_t WS_W1T = WS_ROPE + 2 * MiB;
constexpr size_t WS_W2T = WS_W1T + 352 * MiB;
constexpr size_t WS_WINE = WS_W2T + 176 * MiB;
constexpr size_t WS_WOUTE = WS_WINE + 34 * MiB;
constexpr size_t WS_WINO = WS_WOUTE + 16 * MiB;
constexpr size_t WS_WOUTO = WS_WINO + 48 * MiB;
constexpr size_t WS_WQ = WS_WOUTO + 16 * MiB;
constexpr size_t WS_WKN = WS_WQ + 4 * MiB;
constexpr size_t WS_WV = WS_WKN + 2 * MiB;
constexpr size_t WS_WLORA = WS_WV + 2 * MiB;
constexpr size_t WS_W3T = WS_WLORA + 8 * MiB;
constexpr size_t WS_H2 = WS_W3T + 8 * MiB;
constexpr size_t WS_X = WS_H2 + 4 * MiB;
constexpr size_t WS_H = WS_X + 96 * MiB;
constexpr size_t WS_ACT = WS_H + 48 * MiB;
constexpr size_t WS_Z = WS_ACT + 132 * MiB;
constexpr size_t WS_SCAN = WS_Z + 288 * MiB;
constexpr size_t SCAN_BYTES = 432 * MiB;
constexpr size_t WS_KBUF = WS_SCAN + 2 * SCAN_BYTES;
constexpr size_t WS_LA = WS_KBUF + 48 * MiB;
constexpr size_t WS_GB = WS_LA + 10 * MiB;
constexpr size_t WS_CQ = WS_GB + 48 * MiB;
constexpr size_t WS_CKV = WS_CQ + 12 * MiB;
constexpr size_t WS_KR = WS_CKV + 8 * MiB;
constexpr size_t WS_Q = WS_KR + 2 * MiB;
constexpr size_t WS_KN = WS_Q + 36 * MiB;
constexpr size_t WS_VT = WS_KN + 26 * MiB;
constexpr size_t WS_YSC = WS_VT + 26 * MiB;
constexpr size_t WS_PQ = WS_ACT;
constexpr size_t WS_SST = WS_ACT + 64 * MiB;
constexpr size_t WS_PST = WS_ACT + 96 * MiB;
constexpr size_t WS_MIX = WS_YSC + 96 * MiB;
constexpr size_t WS_KSS = WS_MIX + 48 * MiB;
constexpr size_t WS_KSP = WS_KSS + 258 * MiB;
constexpr size_t WS_END = WS_KSP + 18 * MiB;
static_assert((size_t)NCH * 64 * 2 * 16384 <= 64 * MiB && (size_t)NCH * 64 * 16384 <= 32 * MiB, "PQ / SST inside the ACT region");
constexpr size_t ZT_S_OFF = (size_t)16 * 6144 * 256 * 4;
constexpr size_t VT_S_OFF = (size_t)16 * 1024 * 256 * 2;

constexpr size_t OUT_YS = (size_t)MP * D, OUT_CKV = (size_t)MT * D, OUT_KR = OUT_CKV + 16 * 2 * 256 * 256, OUT_ST = OUT_KR + 16 * 2 * 256 * 64, OUT_END = OUT_ST + (size_t)16 * 2 * 2 * 16 * 64 * 64;

constexpr int LDS_RING = 131072, LDS_BYTES = 147456, LDS_CTL = LDS_BYTES - 512;

struct KArgs { const float* in[42]; float* out; unsigned char* ws; int ph_lo, ph_hi; };
enum { I_XP = 0, I_XS, I_CCKV, I_CKR, I_ST, I_C, I_CCTX, I_WMOD, I_BMOD, I_NG, I_WFI, I_WFO, I_FNG, I_WINE, I_MUP, I_MUN, I_W0, I_W2, I_A0, I_A2, I_G2, I_KK, I_KA, I_RK, I_GNW, I_GNB,
       I_QN, I_KVN, I_WQB, I_WKVB, I_WOE, I_WINO, I_CW, I_CB, I_FW1, I_FB1, I_FW2, I_FB2, I_FW3, I_FFR, I_HB, I_WOO };

struct Ctx {
    LAS unsigned char* lds; unsigned char* ws; const float* const* in; float* out;
    int tid, lane, wave, G, gw, NGW, vb, bx, zs;
};

DI void tr_item(const float* W, int ldw, int K, bf16* WT, int dstrow0, int srccol0, int k0, LAS float* scr, int lane) {
    float v[32];
#pragma unroll
    for (int i = 0; i < 32; ++i) v[i] = W[(size_t)(k0 + 2 * i + (lane >> 5)) * ldw + srccol0 + (lane & 31)];
#pragma unroll
    for (int i = 0; i < 32; ++i) scr[(2 * i + (lane >> 5)) * 33 + (lane & 31)] = v[i];
    asm volatile("s_waitcnt lgkmcnt(0)" ::: "memory");
    const int c = lane & 7;
#pragma unroll
    for (int j = 0; j < 4; ++j) { const int n = (lane >> 3) + 8 * j; const LAS float* s = scr + (8 * c) * 33 + n;
        v4u o; o.x = pk2(s[0 * 33], s[1 * 33]); o.y = pk2(s[2 * 33], s[3 * 33]); o.z = pk2(s[4 * 33], s[5 * 33]); o.w = pk2(s[6 * 33], s[7 * 33]);
        *(v4u*)(WT + (size_t)(dstrow0 + n) * K + k0 + 8 * c) = o; }
    asm volatile("s_waitcnt lgkmcnt(0)" ::: "memory");
}
template <int MODE> DI void tr_matrix(Ctx& C, const float* W, int ldw, int K, bf16* WT, int ndst, int nsrc, int gw, int NGW, int it0 = 0, int it1 = 0x7fffffff) {
    LAS float* scr = (LAS float*)(C.lds + C.wave * 8704);
    const int nkb = K / 64, nnb = ndst / 32, nit = nkb * nnb;
    for (int it = it0 + gw; it < (nit < it1 ? nit : it1); it += NGW) {
        const int kb = it / nnb, nb = it % nnb, dr = nb * 32;
        int sc = dr;
        if (MODE == 1) { const int p = dr >> 8, sg = (dr >> 7) & 1, j = dr & 127; sc = sg * 5632 + 128 * p + j; }
        if (MODE == 2 && dr >= nsrc) {
            const int c = C.lane & 7;
#pragma unroll
            for (int j = 0; j < 4; ++j) { const int n = (C.lane >> 3) + 8 * j; *(v4u*)(WT + (size_t)(dr + n) * K + kb * 64 + 8 * c) = (v4u){0u, 0u, 0u, 0u}; }
            continue;
        }
        tr_item(W, ldw, K, WT, dr, sc, kb * 64, scr, C.lane);
    }
}
template <class Fn> DI void cvt_small(Ctx& C, bf16* dst, int N, int K, Fn f) {
    const int total = N * (K / 8);
    for (int idx = C.bx * 512 + C.tid; idx < total; idx += C.G * 512) {
        const int n = idx % N, k8 = idx / N; float v[8];
#pragma unroll
        for (int i = 0; i < 8; ++i) v[i] = f(n, k8 * 8 + i);
        v4u o; o.x = pk2(v[0], v[1]); o.y = pk2(v[2], v[3]); o.z = pk2(v[4], v[5]); o.w = pk2(v[6], v[7]);
        *(v4u*)(dst + (size_t)n * K + k8 * 8) = o;
    }
}

DI void phase_prologue(Ctx& C) {
    const float* const* in = C.in; unsigned char* ws = C.ws;
    tr_matrix<1>(C, in[I_WFI], NFF1, 2048, (bf16*)(ws + WS_W1T), NFF1, NFF1, C.gw, C.NGW);
    tr_matrix<0>(C, in[I_WFO], 2048, DFF, (bf16*)(ws + WS_W2T), 2048, 2048, C.gw, C.NGW);
    for (int i = 0; i < 2; ++i) tr_matrix<2>(C, in[I_WINE] + (size_t)i * 2048 * ZE_N, ZE_N, 2048, (bf16*)(ws + WS_WINE) + (size_t)i * ZE_P * 2048, ZE_P, ZE_N, C.gw, C.NGW);
    for (int i = 0; i < 2; ++i) tr_matrix<0>(C, in[I_WOE] + (size_t)i * 2048 * 2048, 2048, 2048, (bf16*)(ws + WS_WOUTE) + (size_t)i * 2048 * 2048, 2048, 2048, C.gw, C.NGW);
    for (int i = 0; i < 2; ++i) tr_matrix<0>(C, in[I_WINO] + (size_t)i * 2048 * 6144, 6144, 2048, (bf16*)(ws + WS_WINO) + (size_t)i * 6144 * 2048, 6144, 6144, C.gw, C.NGW);
    for (int i = 0; i < 2; ++i) tr_matrix<0>(C, in[I_WOO] + (size_t)i * 2048 * 2048, 2048, 2048, (bf16*)(ws + WS_WOUTO) + (size_t)i * 2048 * 2048, 2048, 2048, C.gw, C.NGW);
    for (int e = 0; e < 2; ++e) {
        const float* wqb = in[I_WQB] + (size_t)e * 512 * 1536;
        cvt_small(C, (bf16*)(ws + WS_WQ) + (size_t)e * 1536 * 512, 1536, 512, [=](int n, int k) { const int hd = n / 192, wi = n % 192; int sc;
            if (wi < 128) sc = wi; else { const int idx = wi - 128, hf = idx >> 5, r = idx & 31; sc = 128 + 32 * hf + 16 * (r & 1) + (r >> 1); }
            return wqb[(size_t)k * 1536 + hd * 192 + sc]; });
        const float* wkv = in[I_WKVB] + (size_t)e * 256 * 2048;
        cvt_small(C, (bf16*)(ws + WS_WKN) + (size_t)e * 1024 * 256, 1024, 256, [=](int n, int k) { return wkv[(size_t)k * 2048 + (n >> 7) * 256 + (n & 127)]; });
        cvt_small(C, (bf16*)(ws + WS_WV) + (size_t)e * 1024 * 256, 1024, 256, [=](int n, int k) { return wkv[(size_t)k * 2048 + (n >> 7) * 256 + 128 + (n & 127)]; });
        const float* w2 = in[I_W2] + (size_t)e * 2 * 64 * 1024; const float* a2 = in[I_A2] + (size_t)e * 2 * 64 * 1024; const float* g2 = in[I_G2] + (size_t)e * 160 * 1024;
        cvt_small(C, (bf16*)(ws + WS_WLORA) + (size_t)e * 5120 * 384, 5120, 384, [=](int n, int k) { const int seg = n >> 10, c = n & 1023; float v = 0.f;
            if (seg < 2) { if (k < 64) v = w2[((size_t)seg * 64 + k) * 1024 + c]; }
            else if (seg < 4) { if (k >= 64 && k < 128) v = a2[((size_t)(seg - 2) * 64 + (k - 64)) * 1024 + c]; }
            else { if (k >= 128 && k < 288) v = g2[(size_t)(k - 128) * 1024 + c]; }
            return v; });
    }
    { const float* w3 = in[I_FW3];
      cvt_small(C, (bf16*)(ws + WS_W3T), 16384, 256, [=](int n, int k) { const int o = n >> 13, col = n & 8191; float v = 0.f; if ((k >> 6) == o) v = w3[((size_t)o * 64 + (k & 63)) * 8192 + col]; return v; }); }
    { LAS float* sl = (LAS float*)(C.lds + 8 * 8704);
      for (int it = C.bx; it < 4 * 8 * 9; it += C.G) {
          const int l = it / 72, kc = (it / 9) % 8, cc = it % 9;
          __syncthreads();
          for (int i = C.tid; i < 768; i += 512) { const int j = i >> 8, k = kc * 256 + (i & 255); const float cv = j == 0 ? in[I_CCTX][k] : in[I_C][(j - 1) * 2048 + k]; sl[i] = silu_f(cv); }
          __syncthreads();
          const int col = cc * 2048 + 4 * C.tid; const float* wp = in[I_WMOD] + ((size_t)l * 2048 + kc * 256) * 18432 + col;
          f32x4v a0 = {0.f, 0.f, 0.f, 0.f}, a1 = a0, a2 = a0;
#pragma unroll 4
          for (int k = 0; k < 256; ++k) { const f32x4v w = *(const f32x4v*)(wp + (size_t)k * 18432); a0 += w * sl[k]; a1 += w * sl[256 + k]; a2 += w * sl[512 + k]; }
          float* pm = (float*)(ws + WS_PMOD) + ((size_t)(kc * 4 + l) * 3) * 18432 + col;
          *(f32x4v*)(pm) = a0; *(f32x4v*)(pm + 18432) = a1; *(f32x4v*)(pm + 2 * 18432) = a2;
      }
      __syncthreads(); }
    { const f32x4v* s0 = (const f32x4v*)in[I_XP]; const f32x4v* s1 = (const f32x4v*)in[I_XS]; f32x4v* x = (f32x4v*)(ws + WS_X);
      const size_t n0 = (size_t)MP * D / 4, n1 = (size_t)MS * D / 4;
      for (size_t i = (size_t)C.bx * 512 + C.tid; i < n0 + n1; i += (size_t)C.G * 512) x[i] = i < n0 ? s0[i] : s1[i - n0]; }
    if (C.bx == 0) for (int i = C.tid; i < 1024; i += 512) { const int pos = i >> 4, j = i & 15; const float inv = 1.0f / powf(10000.0f, (float)(2 * j) / 32.0f); const float a = (float)pos * inv;
        float* r = (float*)(ws + WS_ROPE) + i * 2; r[0] = cosf(a); r[1] = sinf(a); }
    { bf16* H2 = (bf16*)(ws + WS_H2);
      for (int it = C.gw; it < 2 * 4352; it += C.NGW) {
          const int o = it / 4352, rr = it % 4352; const int L = rr < 256 ? 256 : 4096, t = rr < 256 ? rr : rr - 256; const int lane = C.lane;
          float zf = 0.f;
          if (lane == 0) zf = (float)t / (float)(L - 1);
          else if (lane < 33) { const int b = (lane - 1) & 15; const float fr = 1e-4f + (15.0f - 1e-4f) * ((float)b / 15.0f); const float ang = ((float)(2.0 * 3.14159265358979323846 / (double)L) * (float)t) * fr; zf = lane < 17 ? cosf(ang) : -sinf(ang); }
          const float* w1 = in[I_FW1] + (size_t)o * 33 * 64; const float* w2 = in[I_FW2] + (size_t)o * 64 * 64;
          float s = in[I_FB1][o * 64 + lane];
          for (int i = 0; i < 33; ++i) s += shfl_idx(zf, i) * w1[i * 64 + lane];
          const float h1 = sinf(in[I_FFR][(o * 2 + 0) * 64 + lane] * s);
          float s2 = in[I_FB2][o * 64 + lane];
          for (int i = 0; i < 64; ++i) s2 += shfl_idx(h1, i) * w2[i * 64 + lane];
          const float h2 = sinf(in[I_FFR][(o * 2 + 1) * 64 + lane] * s2);
          H2[(size_t)rr * 256 + o * 64 + lane] = (bf16)f2bf(h2);
          if (o == 0) { H2[(size_t)rr * 256 + 128 + lane] = 0; H2[(size_t)rr * 256 + 192 + lane] = 0; }
      } }
}
DI void phase_mod_reduce(Ctx& C) {
    const float* pm = (const float*)(C.ws + WS_PMOD); float* mod = (float*)(C.ws + WS_MOD); const float* bm = C.in[I_BMOD];
    for (int i = C.bx * 512 + C.tid; i < 4 * 3 * 18432; i += C.G * 512) { const int l = i / MODL, n = i % 18432; float s = bm[l * 18432 + n];
#pragma unroll
        for (int kc = 0; kc < 8; ++kc) s += pm[(size_t)kc * 4 * MODL + i];
        mod[i] = s; }
}
DI void phase_norm_mod(Ctx& C, const float* g, const float* modl, int s) {
    const float* X = (const float*)(C.ws + WS_X); bf16* H = (bf16*)(C.ws + WS_H);
    for (int row = C.gw; row < MT; row += C.NGW) {
        const float* sh = modl + row_mod_j(row) * 18432 + (3 * s) * 2048; const float* scl = sh + 2048;
        const f32x4v* xr = (const f32x4v*)(X + (size_t)row * D) + C.lane; f32x4v v[8]; float ss = 0.f;
#pragma unroll
        for (int i = 0; i < 8; ++i) { v[i] = xr[64 * i]; ss += (v[i].x * v[i].x + v[i].y * v[i].y) + (v[i].z * v[i].z + v[i].w * v[i].w); }
        const float rstd = 1.0f / sqrtf(wave_sum(ss) * (1.0f / D) + 1e-6f);
        v2u* o = (v2u*)(H + (size_t)row * D) + C.lane;
#pragma unroll
        for (int i = 0; i < 8; ++i) { const int c = 4 * C.lane + 256 * i; const f32x4v gg = *(const f32x4v*)(g + c), sc = *(const f32x4v*)(scl + c), sf = *(const f32x4v*)(sh + c);
            const f32x4v y = (v[i] * rstd * gg) * (sc + 1.0f) + sf; v2u w; w.x = pk2(y.x, y.y); w.y = pk2(y.z, y.w); o[64 * i] = w; }
    }
}
DI void phase_final_norm(Ctx& C) {
    const float* X = (const float*)(C.ws + WS_X); const float* g = C.in[I_FNG];
    for (int row = C.gw; row < MT; row += C.NGW) {
        const f32x4v* xr = (const f32x4v*)(X + (size_t)row * D) + C.lane; f32x4v v[8]; float ss = 0.f;
#pragma unroll
        for (int i = 0; i < 8; ++i) { v[i] = xr[64 * i]; ss += (v[i].x * v[i].x + v[i].y * v[i].y) + (v[i].z * v[i].z + v[i].w * v[i].w); }
        const float rstd = 1.0f / sqrtf(wave_sum(ss) * (1.0f / D) + 1e-6f);
        f32x4v* o = (f32x4v*)(C.out + (size_t)row * D) + C.lane;
#pragma unroll
        for (int i = 0; i < 8; ++i) { const f32x4v gg = *(const f32x4v*)(g + 4 * C.lane + 256 * i); o[64 * i] = v[i] * rstd * gg; }
    }
}

DI int rope_src(int p) { const int hf = p >> 5, r = p & 31; return 32 * hf + 16 * (r & 1) + (r >> 1); }
DI void phase_even_prep(Ctx& C, int e) {
    const float* const* in = C.in; unsigned char* ws = C.ws; const int lane = C.lane;
    const float* Z = (const float*)(ws + WS_Z); float* SC = (float*)(ws + WS_SCAN + (size_t)e * SCAN_BYTES); float* KB = (float*)(ws + WS_KBUF); bf16* LA = (bf16*)(ws + WS_LA);
    bf16* CQ = (bf16*)(ws + WS_CQ); bf16* CKV = (bf16*)(ws + WS_CKV); bf16* KR = (bf16*)(ws + WS_KR); const float* rope = (const float*)(ws + WS_ROPE);
    const float* mup = in[I_MUP] + e * 3360; const float* mun = in[I_MUN] + e * 3360; const float* kkw = in[I_KK] + e * 1024;
    const float* qn = in[I_QN] + e * 512; const float* kvn = in[I_KVN] + e * 256;
    for (int row = C.gw; row < MKV; row += C.NGW) {
        if (row >= MT) {
            const int rr = row - MT, b = rr >> 8, p = rr & 255;
            const float* cs = in[I_CCKV] + ((size_t)(b * 2 + e) * 256 + p) * 256;
#pragma unroll
            for (int i = 0; i < 4; ++i) CKV[(size_t)row * 256 + 64 * i + lane] = (bf16)f2bf(cs[64 * i + lane]);
            KR[(size_t)row * 64 + lane] = (bf16)f2bf(in[I_CKR][((size_t)(b * 2 + e) * 256 + p) * 64 + rope_src(lane)]);
            continue;
        }
        const bool smp = row >= MP; const int T = smp ? 4096 : 256; const int t = smp ? ((row - MP) & 4095) : (row & 255);
        const float* z = Z + (size_t)row * ZE_P; const bool hp = t > 0, hn = t < T - 1;
        float* sc = SC + (size_t)row * SCAN_P;
#define ZMIX4(c) ({ const f32x4v zc_ = *(const f32x4v*)(z + (c)); const f32x4v zp_ = hp ? *(const f32x4v*)(z + (c) - ZE_P) : (f32x4v){0.f, 0.f, 0.f, 0.f}; const f32x4v zn_ = hn ? *(const f32x4v*)(z + (c) + ZE_P) : (f32x4v){0.f, 0.f, 0.f, 0.f}; \
            zc_ + *(const f32x4v*)(mup + (c)) * (zp_ - zc_) + *(const f32x4v*)(mun + (c)) * (zn_ - zc_); })
#define ZMIX(c) ({ const float zc_ = z[c]; const float zp_ = hp ? z[(c) - ZE_P] : 0.f; const float zn_ = hn ? z[(c) + ZE_P] : 0.f; zc_ + mup[c] * (zp_ - zc_) + mun[c] * (zn_ - zc_); })
#pragma unroll
        for (int i = 0; i < 4; ++i) { const int c = 256 * i + 4 * lane;
            *(f32x4v*)(sc + c) = ZMIX4(c);
            *(f32x4v*)(sc + 1024 + c) = ZMIX4(2048 + c);
            const f32x4v k = ZMIX4(1024 + c); *(f32x4v*)(KB + (size_t)row * 1024 + c) = k;
            const f32x4v kk = k * *(const f32x4v*)(kkw + c); float ss = (kk.x * kk.x + kk.y * kk.y) + (kk.z * kk.z + kk.w * kk.w);
            ss += dpp_f<0xB1>(ss); ss += dpp_f<0x4E>(ss); ss += dpp_f<0x141>(ss); ss += dpp_f<0x140>(ss);
            *(f32x4v*)(sc + 2048 + c) = kk * (1.0f / fmaxf(sqrtf(ss), 1e-12f)); }
        bf16* la = LA + (size_t)row * 384;
        la[lane] = (bf16)f2bf(tanhf(ZMIX(3072 + lane)));
        la[64 + lane] = (bf16)f2bf(ZMIX(3136 + lane));
        la[128 + lane] = (bf16)f2bf(sigmoid_f(ZMIX(3200 + lane)));
        la[192 + lane] = (bf16)f2bf(sigmoid_f(ZMIX(3264 + lane)));
        { float xg = 0.f; if (lane < 32) xg = sigmoid_f(ZMIX(3328 + lane)); la[256 + lane] = (bf16)(lane < 32 ? f2bf(xg) : 0u); la[320 + lane] = 0; }
#undef ZMIX4
#undef ZMIX
        float cq[8], ss = 0.f;
#pragma unroll
        for (int i = 0; i < 8; ++i) { cq[i] = z[3360 + 64 * i + lane]; ss += cq[i] * cq[i]; }
        float rstd = 1.0f / sqrtf(wave_sum(ss) * (1.0f / 512.0f) + 1e-6f);
#pragma unroll
        for (int i = 0; i < 8; ++i) CQ[(size_t)row * 512 + 64 * i + lane] = (bf16)f2bf(cq[i] * rstd * qn[64 * i + lane]);
        float ck[4]; ss = 0.f;
#pragma unroll
        for (int i = 0; i < 4; ++i) { ck[i] = z[3872 + 64 * i + lane]; ss += ck[i] * ck[i]; }
        rstd = 1.0f / sqrtf(wave_sum(ss) * (1.0f / 256.0f) + 1e-6f);
#pragma unroll
        for (int i = 0; i < 4; ++i) { const float y = ck[i] * rstd * kvn[64 * i + lane]; CKV[(size_t)row * 256 + 64 * i + lane] = (bf16)f2bf(y);
            if (!smp) C.out[OUT_CKV + ((size_t)((row >> 8) * 2 + e) * 256 + t) * 256 + 64 * i + lane] = y; }
        const float kr = z[4128 + lane];
        if (!smp) { C.out[OUT_KR + ((size_t)((row >> 8) * 2 + e) * 256 + t) * 64 + lane] = kr; KR[(size_t)row * 64 + lane] = (bf16)f2bf(shfl_idx(kr, rope_src(lane))); }
        else { const int hf = lane >> 5, jj = lane & 15, e2 = (lane >> 4) & 1; const int pos = hf ? (t & 63) : (t >> 6);
            const float xo = shfl_idx(kr, lane ^ 16); const float2 cs = *(const float2*)(rope + (pos * 16 + jj) * 2);
            const float rot = e2 == 0 ? kr * cs.x - xo * cs.y : kr * cs.x + xo * cs.y;
            KR[(size_t)row * 64 + lane] = (bf16)f2bf(shfl_idx(rot, rope_src(lane))); }
    }
}

template <int N> DI float fmac_bc(float acc, float op, float s) { asm("v_fmac_f32_dpp %0, %1, %2 row_newbcast:%3 row_mask:0xf bank_mask:0xf" : "+v"(acc) : "v"(op), "v"(s), "n"(N)); return acc; }
template <int N> DI float mul_bc(float op, float s) { float r; asm("v_mul_f32_dpp %0, %1, %2 row_newbcast:%3 row_mask:0xf bank_mask:0xf" : "=v"(r) : "v"(op), "v"(s), "n"(N)); return r; }
struct ScanOps { f32x4v kk, w, kka, kd, r; float vv; };
typedef __attribute__((__vector_size__(4 * sizeof(int)))) int rsrc_t;
DI f32x4v bl128(__amdgpu_buffer_rsrc_t r, unsigned vo, unsigned so) { return __builtin_bit_cast(f32x4v, __builtin_amdgcn_raw_buffer_load_b128(r, (int)vo, (int)so, 0)); }
DI float bl32(__amdgpu_buffer_rsrc_t r, unsigned vo, unsigned so) { return __builtin_bit_cast(float, __builtin_amdgcn_raw_buffer_load_b32(r, (int)vo, (int)so, 0)); }
template <int MODE> DI ScanOps scan_load(__amdgpu_buffer_rsrc_t rs, unsigned so, unsigned lo, unsigned lv, int d) {
    ScanOps o;
    o.kk = bl128(rs, lo + 2u * 4096u, so); o.w = bl128(rs, lo + (3u + (unsigned)d) * 4096u, so); o.kka = bl128(rs, lo + (5u + (unsigned)d) * 4096u, so);
    if (MODE != 0) { o.kd = bl128(rs, lo + (7u + (unsigned)d) * 4096u, so); o.vv = bl32(rs, lv + 4096u, so); } else { o.kd = (f32x4v){0.f, 0.f, 0.f, 0.f}; o.vv = 0.f; }
    if (MODE == 2) o.r = bl128(rs, lo, so); else o.r = (f32x4v){0.f, 0.f, 0.f, 0.f};
    return o;
}
template <int MODE, int J> DI void scan_col_a(const ScanOps& o, const float (&S)[64], float (&sa)[4]) { sa[J & 3] = fmac_bc<(J >> 2)>(sa[J & 3], o.kk[J & 3], S[J]); }
template <int MODE, int J> DI void scan_col_b(const ScanOps& o, float (&S)[64], float sa, float (&y)[4]) {
    float t = mul_bc<(J >> 2)>(o.w[J & 3], S[J]);
    t = fmac_bc<(J >> 2)>(t, o.kka[J & 3], sa);
    if (MODE != 0) t = fmac_bc<(J >> 2)>(t, o.kd[J & 3], o.vv);
    S[J] = t;
    if (MODE == 2) y[J & 3] = fmac_bc<(J >> 2)>(y[J & 3], o.r[J & 3], t);
}
template <int MODE, int... Js> DI float scan_step(const ScanOps& o, float (&S)[64], std::integer_sequence<int, Js...>) {
    float sa[4] = {0.f, 0.f, 0.f, 0.f}, y[4] = {0.f, 0.f, 0.f, 0.f};
    (scan_col_a<MODE, Js>(o, S, sa), ...);
    const float sat = -((sa[0] + sa[1]) + (sa[2] + sa[3]));
    (scan_col_b<MODE, Js>(o, S, sat, y), ...);
    return (y[0] + y[1]) + (y[2] + y[3]);
}
template <int MODE> DI void scan_wave(const float* SCp, int row0, int rstep, int nsteps, int h, int d, float (&S)[64], float* yout, int lane) {
    const __amdgpu_buffer_rsrc_t rs = __builtin_amdgcn_make_buffer_rsrc((void*)SCp, 0, (int)((size_t)MT * SCAN_P * 4), 0x00020000);
    const __amdgpu_buffer_rsrc_t ry = __builtin_amdgcn_make_buffer_rsrc((void*)yout, 0, (int)((size_t)MT * 1024 * 4), 0x00020000);
    const int so0 = (row0 * SCAN_P + h * 64) * 4, sstep = rstep * SCAN_P * 4, last = nsteps - 1;
    int yo = (row0 * 1024 + h * 64) * 4; const int ystep = rstep * 4096;
    const unsigned lo = 16u * (unsigned)(lane & 15), lv = 4u * (unsigned)lane;
#define SC_LD(s_) scan_load<MODE>(rs, (unsigned)(so0 + ((s_) < last ? (s_) : last) * sstep), lo, lv, d)
#define SC_ST(o_) do { const float y_ = scan_step<MODE>(o_, S, std::make_integer_sequence<int, 64>{}); if (MODE == 2) __builtin_amdgcn_raw_buffer_store_b32(__builtin_bit_cast(unsigned, y_), ry, (int)lv, yo, 0); yo += ystep; } while (0)
    ScanOps o0 = SC_LD(0), o1 = SC_LD(1), o2 = SC_LD(2), o3;
    for (int s = 0; s < nsteps; s += 4) {
        o3 = SC_LD(s + 3); SC_ST(o0);
        o0 = SC_LD(s + 4); SC_ST(o1);
        o1 = SC_LD(s + 5); SC_ST(o2);
        o2 = SC_LD(s + 6); SC_ST(o3);
    }
#undef SC_LD
#undef SC_ST
}
DI void phase_scan1(Ctx& C, int e, int qslot) {
    const float* SCp = (const float*)(C.ws + WS_SCAN + (size_t)e * SCAN_BYTES); float* PQ = (float*)(C.ws + WS_PQ); float* Y = (float*)(C.ws + WS_YSC);
    const int nit = 512 + 64 * NCH * 2;
    unsigned* qctr = (unsigned*)(C.ws + WS_CTL) + 8192 + 64 * (e + 2 * qslot);
    for (;;) {
        unsigned itu = 0; if (C.lane == 0) itu = __hip_atomic_fetch_add(qctr, 1u, __ATOMIC_RELAXED, __HIP_MEMORY_SCOPE_AGENT);
        const int it = __builtin_amdgcn_readfirstlane((int)itu); if (it >= nit) break;
        int lane = C.lane; asm volatile("" : "+v"(lane));
        float S[64];
        if (it >= 512) { const int si = it - 512;
            const int kind = si & 1, c = (si >> 1) % NCH, sidx = (si >> 1) / NCH; const int d = sidx & 1, h = (sidx >> 1) & 15, b = sidx >> 5;
            const int t0 = d ? 4095 - c * CHL : c * CHL; const int row0 = MP + b * 4096 + t0;
            float fl = (float)lane; asm volatile("" : "+v"(fl)); const float kf = kind == 0 ? 1.f : 0.f;
#pragma unroll
            for (int j = 0; j < 64; ++j) { S[j] = kf * fmaxf(0.f, 1.f - fabsf(fl - (float)j)); }
            if (kind == 0) scan_wave<0>(SCp, row0, d ? -1 : 1, CHL, h, d, S, nullptr, lane); else scan_wave<1>(SCp, row0, d ? -1 : 1, CHL, h, d, S, nullptr, lane);
            float* dst = PQ + (((size_t)sidx * NCH + c) * 2 + kind) * 4096 + lane * 64;
#pragma unroll
            for (int j = 0; j < 16; ++j) *(f32x4v*)(dst + 4 * j) = (f32x4v){S[4 * j], S[4 * j + 1], S[4 * j + 2], S[4 * j + 3]};
        } else {
            const int pi = it; const int d = pi & 1, h = (pi >> 1) & 15, b = pi >> 5;
#pragma unroll
            for (int j = 0; j < 64; ++j) S[j] = 0.f;
            scan_wave<2>(SCp, b * 256 + (d ? 255 : 0), d ? -1 : 1, 128, h, d, S, Y + (size_t)d * MT * 1024, lane);
            float* dst = (float*)(C.ws + WS_PST) + (size_t)pi * 4096 + lane * 64;
#pragma unroll
            for (int j = 0; j < 16; ++j) *(f32x4v*)(dst + 4 * j) = (f32x4v){S[4 * j], S[4 * j + 1], S[4 * j + 2], S[4 * j + 3]};
        }
    }
}
DI void phase_scan_carry(Ctx& C, int e, int nsw) {
    const float* PQ = (const float*)(C.ws + WS_PQ); float* SST = (float*)(C.ws + WS_SST);
    LAS float* Ss = (LAS float*)C.lds;
    LAS float* Ps = (LAS float*)(C.lds + 64 * 65 * 4 + 64);
    for (int sidx = C.bx; sidx < 64; sidx += C.G) {
        const int d = sidx & 1, h = (sidx >> 1) & 15, b = sidx >> 5; const int row = C.tid & 63, cg = C.wave;
        const float* s0 = C.in[I_ST] + ((((size_t)b * 2 + e) * 2 + d) * 16 + h) * 4096;
        __syncthreads();
        for (int i = C.tid; i < 4096; i += 512) { const float v = s0[i]; Ss[(i >> 6) * 65 + (i & 63)] = v; SST[((size_t)sidx * NCH) * 4096 + i] = v; }
        const float* PQs = PQ + (size_t)sidx * NCH * 2 * 4096;
        f32x4v pp0 = *(const f32x4v*)(PQs + 4 * C.tid), pp1 = *(const f32x4v*)(PQs + 2048 + 4 * C.tid);
        f32x4v qq0 = *(const f32x4v*)(PQs + 4096 + row * 64 + cg * 8), qq1 = *(const f32x4v*)(PQs + 4096 + row * 64 + cg * 8 + 4);
        for (int c = 0; c + 1 < NCH; ++c) {
            __syncthreads();
            *(LAS f32x4v*)(Ps + 4 * C.tid) = pp0; *(LAS f32x4v*)(Ps + 2048 + 4 * C.tid) = pp1;
            float o[8] = {qq0.x, qq0.y, qq0.z, qq0.w, qq1.x, qq1.y, qq1.z, qq1.w};
            if (c + 2 < NCH) { const float* nx = PQs + (size_t)(c + 1) * 2 * 4096;
                pp0 = *(const f32x4v*)(nx + 4 * C.tid); pp1 = *(const f32x4v*)(nx + 2048 + 4 * C.tid);
                qq0 = *(const f32x4v*)(nx + 4096 + row * 64 + cg * 8); qq1 = *(const f32x4v*)(nx + 4096 + row * 64 + cg * 8 + 4); }
            __syncthreads();
            for (int k = 0; k < 64; ++k) { const float sv = Ss[row * 65 + k]; const f32x4v p0 = *(const LAS f32x4v*)(Ps + k * 64 + cg * 8), p1 = *(const LAS f32x4v*)(Ps + k * 64 + cg * 8 + 4);
                o[0] += sv * p0.x; o[1] += sv * p0.y; o[2] += sv * p0.z; o[3] += sv * p0.w; o[4] += sv * p1.x; o[5] += sv * p1.y; o[6] += sv * p1.z; o[7] += sv * p1.w; }
            __syncthreads();
            float* dst = SST + ((size_t)sidx * NCH + c + 1) * 4096 + row * 64 + cg * 8;
#pragma unroll
            for (int i = 0; i < 8; ++i) Ss[row * 65 + cg * 8 + i] = o[i];
            *(f32x4v*)dst = (f32x4v){o[0], o[1], o[2], o[3]}; *(f32x4v*)(dst + 4) = (f32x4v){o[4], o[5], o[6], o[7]};
        }
    }
    {
        const int nb0 = C.G > 64 ? 64 : 0; const float* SCp = (const float*)(C.ws + WS_SCAN + (size_t)e * SCAN_BYTES); float* Y = (float*)(C.ws + WS_YSC);
        if (C.bx >= nb0 && C.wave < nsw) for (int pi = (C.bx - nb0) * nsw + C.wave; pi < 512; pi += (C.G - nb0) * nsw) {
            int lane = C.lane; asm volatile("" : "+v"(lane));
            const int d = pi & 1, h = (pi >> 1) & 15, b = pi >> 5;
            float S[64]; const float* src = (const float*)(C.ws + WS_PST) + (size_t)pi * 4096 + lane * 64;
#pragma unroll
            for (int j = 0; j < 16; ++j) { const f32x4v t = *(const f32x4v*)(src + 4 * j); S[4 * j] = t.x; S[4 * j + 1] = t.y; S[4 * j + 2] = t.z; S[4 * j + 3] = t.w; }
            scan_wave<2>(SCp, b * 256 + (d ? 127 : 128), d ? -1 : 1, 128, h, d, S, Y + (size_t)d * MT * 1024, lane);
            float* dst = C.out + OUT_ST + ((((size_t)b * 2 + e) * 2 + d) * 16 + h) * 4096 + lane * 64;
#pragma unroll
            for (int j = 0; j < 16; ++j) *(f32x4v*)(dst + 4 * j) = (f32x4v){S[4 * j], S[4 * j + 1], S[4 * j + 2], S[4 * j + 3]};
        }
    }
}
DI void phase_scan3(Ctx& C, int e) {
    const float* SCp = (const float*)(C.ws + WS_SCAN + (size_t)e * SCAN_BYTES); const float* SST = (const float*)(C.ws + WS_SST); float* Y = (float*)(C.ws + WS_YSC);
    for (int it = C.gw; it < 64 * NCH; it += C.NGW) {
        int lane = C.lane; asm volatile("" : "+v"(lane));
        const int c = it % NCH, sidx = it / NCH; const int d = sidx & 1, h = (sidx >> 1) & 15, b = sidx >> 5;
        const int t0 = d ? 4095 - c * CHL : c * CHL; const int row0 = MP + b * 4096 + t0;
        float S[64]; const float* src = SST + ((size_t)sidx * NCH + c) * 4096 + lane * 64;
#pragma unroll
        for (int j = 0; j < 16; ++j) { const f32x4v t = *(const f32x4v*)(src + 4 * j); S[4 * j] = t.x; S[4 * j + 1] = t.y; S[4 * j + 2] = t.z; S[4 * j + 3] = t.w; }
        scan_wave<2>(SCp, row0, d ? -1 : 1, CHL, h, d, S, Y + (size_t)d * MT * 1024, lane);
    }
}
DI float row16_sum(float v) { v += dpp_f<0xB1>(v); v += dpp_f<0x4E>(v); v += dpp_f<0x141>(v); v += dpp_f<0x140>(v); return v; }
DI void phase_rwkv_post(Ctx& C, int e) {
    const float* SCp = (const float*)(C.ws + WS_SCAN + (size_t)e * SCAN_BYTES); const float* Y = (const float*)(C.ws + WS_YSC); const float* GB = (const float*)(C.ws + WS_GB); bf16* MIX = (bf16*)(C.ws + WS_MIX);
    const float* rk = C.in[I_RK] + e * 1024; const float* gw = C.in[I_GNW] + e * 1024; const float* gb = C.in[I_GNB] + e * 1024; const int lane = C.lane;
    for (int row = C.gw; row < MT; row += C.NGW) {
        const float* sc = SCp + (size_t)row * SCAN_P;
#pragma unroll
        for (int i = 0; i < 4; ++i) { const int c = 256 * i + 4 * lane;
            const f32x4v y = *(const f32x4v*)(Y + (size_t)row * 1024 + c) + *(const f32x4v*)(Y + ((size_t)MT + row) * 1024 + c);
            const float mu = row16_sum((y.x + y.y) + (y.z + y.w)) * (1.0f / 64.0f); const f32x4v dl = y - mu;
            const float var = row16_sum((dl.x * dl.x + dl.y * dl.y) + (dl.z * dl.z + dl.w * dl.w)) * (1.0f / 64.0f);
            const f32x4v yn = dl * (1.0f / sqrtf(var + 64e-5f));
            const f32x4v rr = *(const f32x4v*)(sc + c), kd = *(const f32x4v*)(sc + 7 * 1024 + c) + *(const f32x4v*)(sc + 8 * 1024 + c), rkv = *(const f32x4v*)(rk + c); const f32x4v pb = rr * kd * rkv;
            const float bs = row16_sum((pb.x + pb.y) + (pb.z + pb.w));
            const f32x4v o = (yn * *(const f32x4v*)(gw + c) + *(const f32x4v*)(gb + c) + *(const f32x4v*)(sc + 1024 + c) * bs) * *(const f32x4v*)(GB + (size_t)row * 1024 + c);
            v2u w; w.x = pk2(o.x, o.y); w.y = pk2(o.z, o.w); *(v2u*)(MIX + (size_t)row * 2048 + c) = w; }
    }
}

constexpr int AT_KP = 200, AT_VP = 72, AT_KB = 64 * AT_KP * 2, AT_VB = 128 * AT_VP * 2, AT_BUF = AT_KB + AT_VB;
DI void attn_unit(Ctx& C, const bf16* Qb, const bf16* KN, const bf16* KRb, const bf16* VTh  , int vpitch, bf16* MIX, int qrow0, int h, int krow0, int nlat, int crow0, int ntile) {
    int tid = C.tid; asm volatile("" : "+v"(tid)); const int lane = tid & 63, r = lane & 31, hh = lane >> 5;
    LAS unsigned char* lds = C.lds;
    s16x8v qf[12];
    { const bf16* qp = Qb + (size_t)(qrow0 + C.wave * 32 + r) * 1536 + h * 192 + 8 * hh;
#pragma unroll
      for (int s = 0; s < 12; ++s) qf[s] = *(const s16x8v*)(qp + 16 * s); }
    f32x16v o[4];
#pragma unroll
    for (int vb = 0; vb < 4; ++vb)
#pragma unroll
        for (int i = 0; i < 16; ++i) o[vb][i] = 0.f;
    float mrun = -INFINITY, lsum = 0.f;
    v4u pre[5];
    auto issue = [&](int j) {
        const int k0 = 64 * j; const int rbase = k0 < nlat ? krow0 + k0 : crow0 + (k0 - nlat);
#pragma unroll
        for (int i = 0; i < 3; ++i) { const int p = tid + 512 * i, key = p / 24, pc = p % 24; const size_t rw = (size_t)(rbase + key);
            pre[i] = pc < 16 ? *(const v4u*)(KN + rw * 1024 + h * 128 + pc * 8) : *(const v4u*)(KRb + rw * 64 + (pc - 16) * 8); }
#pragma unroll
        for (int i = 0; i < 2; ++i) { const int p = tid + 512 * i, dv = p >> 3, pc = p & 7; pre[3 + i] = *(const v4u*)(VTh + (size_t)dv * vpitch + k0 + pc * 8); }
    };
    auto commit = [&](int buf) {
        LAS unsigned char* kb = lds + buf * AT_BUF; LAS unsigned char* vbp = kb + AT_KB;
#pragma unroll
        for (int i = 0; i < 3; ++i) { const int p = tid + 512 * i, key = p / 24, pc = p % 24; *(LAS v4u*)(kb + key * (AT_KP * 2) + pc * 16) = pre[i]; }
#pragma unroll
        for (int i = 0; i < 2; ++i) { const int p = tid + 512 * i, dv = p >> 3, pc = p & 7; *(LAS v4u*)(vbp + dv * (AT_VP * 2) + pc * 16) = pre[3 + i]; }
    };
    __syncthreads();
    issue(0); commit(0); __syncthreads();
    for (int j = 0; j < ntile; ++j) {
        if (j + 1 < ntile) issue(j + 1);
        const LAS unsigned char* kb = lds + (j & 1) * AT_BUF; const LAS unsigned char* vbp = kb + AT_KB;
        f32x16v st[2];
        __builtin_amdgcn_s_setprio(1);
#pragma unroll
        for (int kbk = 0; kbk < 2; ++kbk) {
#pragma unroll
            for (int i = 0; i < 16; ++i) st[kbk][i] = 0.f;
#pragma unroll
            for (int s = 0; s < 12; ++s) { const s16x8v a = *(const LAS s16x8v*)(kb + (32 * kbk + r) * (AT_KP * 2) + (16 * s + 8 * hh) * 2);
                st[kbk] = __builtin_amdgcn_mfma_f32_32x32x16_bf16(a, qf[s], st[kbk], 0, 0, 0); }
        }
        __builtin_amdgcn_s_setprio(0);
        float mx = st[0][0];
#pragma unroll
        for (int i = 1; i < 16; ++i) mx = fmaxf(mx, st[0][i]);
#pragma unroll
        for (int i = 0; i < 16; ++i) mx = fmaxf(mx, st[1][i]);
        mx = fmaxf(mx, shfl_idx(mx, lane ^ 32));
        const float mnew = fmaxf(mrun, mx); const float alpha = __builtin_amdgcn_exp2f(mrun - mnew); mrun = mnew;
        float ps = 0.f;
#pragma unroll
        for (int kbk = 0; kbk < 2; ++kbk)
#pragma unroll
            for (int i = 0; i < 16; ++i) { const float p = __builtin_amdgcn_exp2f(st[kbk][i] - mnew); st[kbk][i] = p; ps += p; }
        lsum = lsum * alpha + ps;
        if (__builtin_amdgcn_ballot_w64(alpha != 1.0f) != 0ull) {
#pragma unroll
            for (int vb = 0; vb < 4; ++vb)
#pragma unroll
                for (int i = 0; i < 16; ++i) o[vb][i] *= alpha; }
        __builtin_amdgcn_s_setprio(1);
#pragma unroll
        for (int kbk = 0; kbk < 2; ++kbk)
#pragma unroll
            for (int s2 = 0; s2 < 2; ++s2) {
                v4u pw; pw.x = pg8::cvt_pk_bf16(st[kbk][8 * s2 + 0], st[kbk][8 * s2 + 1]); pw.y = pg8::cvt_pk_bf16(st[kbk][8 * s2 + 2], st[kbk][8 * s2 + 3]); pw.z = pg8::cvt_pk_bf16(st[kbk][8 * s2 + 4], st[kbk][8 * s2 + 5]); pw.w = pg8::cvt_pk_bf16(st[kbk][8 * s2 + 6], st[kbk][8 * s2 + 7]);
                const s16x8v pf = __builtin_bit_cast(s16x8v, pw);
#pragma unroll
                for (int vb = 0; vb < 4; ++vb) { const LAS unsigned char* vp = vbp + (32 * vb + r) * (AT_VP * 2) + (32 * kbk + 16 * s2 + 4 * hh) * 2;
                    const v2u lo = *(const LAS v2u*)vp, hi = *(const LAS v2u*)(vp + 16); const v4u av = {lo.x, lo.y, hi.x, hi.y};
                    o[vb] = __builtin_amdgcn_mfma_f32_32x32x16_bf16(__builtin_bit_cast(s16x8v, av), pf, o[vb], 0, 0, 0); }
            }
        __builtin_amdgcn_s_setprio(0);
        if (j + 1 < ntile) commit((j + 1) & 1);
        __syncthreads();
    }
    const float inv = 1.0f / (lsum + shfl_idx(lsum, lane ^ 32));
    bf16* op = MIX + (size_t)(qrow0 + C.wave * 32 + r) * 2048 + 1024 + h * 128 + 4 * hh;
#pragma unroll
    for (int vb = 0; vb < 4; ++vb)
#pragma unroll
        for (int g = 0; g < 4; ++g) { v2u w; w.x = pk2(o[vb][4 * g] * inv, o[vb][4 * g + 1] * inv); w.y = pk2(o[vb][4 * g + 2] * inv, o[vb][4 * g + 3] * inv);
            *(v2u*)(op + 32 * vb + 8 * g) = w; }
}
DI void phase_attention(Ctx& C) {
    unsigned char* ws = C.ws; const bf16* Qb = (const bf16*)(ws + WS_Q); const bf16* KN = (const bf16*)(ws + WS_KN); const bf16* KRb = (const bf16*)(ws + WS_KR); bf16* MIX = (bf16*)(ws + WS_MIX);
    const bf16* VTp = (const bf16*)(ws + WS_VT); const bf16* VTs = (const bf16*)(ws + WS_VT + VT_S_OFF);
    for (int u = C.bx; u < 256 + 128; u += C.G) {
        if (u < 256) { const int qb = u & 15, h = (u >> 4) & 7, b = u >> 7;
            attn_unit(C, Qb, KN, KRb, VTs + ((size_t)b * 1024 + h * 128) * 4352, 4352, MIX, MP + b * 4096 + qb * 256, h, MP + b * 4096, 4096, MT + b * 256, 68); }
        else { const int v = u - 256, h = v & 7, b = v >> 3;
            attn_unit(C, Qb, KN, KRb, VTp + ((size_t)b * 1024 + h * 128) * 256, 256, MIX, b * 256, h, b * 256, 256, 0, 4); }
    }
    __syncthreads();
}

DI f32x2v mk2(float a, float b) { return (f32x2v){a, b}; }
DI f32x2v cmul(f32x2v a, f32x2v b) { const f32x2v t = {-b.y, b.x}; return a.x * b + a.y * t; }
DI f32x2v cmulc(f32x2v a, f32x2v b) { const f32x2v t = {b.y, -b.x}; return a.x * b + a.y * t; }
DI f32x2v mul_mi(f32x2v a) { return mk2(a.y, -a.x); }
DI f32x2v mul_pi(f32x2v a) { return mk2(-a.y, a.x); }
DI f32x2v twid(int p, int den) { const float fr = (float)p / (float)den; return mk2(__builtin_amdgcn_cosf(fr), __builtin_amdgcn_sinf(fr)); }
DI int PD(int i) { return i + ((i >> 5) << 1); }
constexpr int FFT_BS = 8192 + 512, FFT_BUF_BYTES = FFT_BS * 8;
DI void bf4_fwd(f32x2v& x0, f32x2v& x1, f32x2v& x2, f32x2v& x3, f32x2v w0, f32x2v wm) {
    const f32x2v a0 = x0 + x2, a2 = cmul(x0 - x2, w0), a1 = x1 + x3, a3 = cmul(x1 - x3, mul_mi(w0));
    x0 = a0 + a1; x1 = cmul(a0 - a1, wm); x2 = a2 + a3; x3 = cmul(a2 - a3, wm);
}
DI void bf4_inv(f32x2v& x0, f32x2v& x1, f32x2v& x2, f32x2v& x3, f32x2v wa, f32x2v w) {
    const f32x2v t1 = cmul(x1, w), t3 = cmul(x3, w);
    const f32x2v a0 = x0 + t1, a1 = x0 - t1, a2 = x2 + t3, a3 = x2 - t3;
    const f32x2v t2 = cmul(a2, wa), t3b = cmul(a3, mul_pi(wa));
    x0 = a0 + t2; x1 = a1 + t3b; x2 = a0 - t2; x3 = a1 - t3b;
}
template <int N, int M, int NI = 1> DI void fft_fwd_pass(LAS f32x2v* buf, int tid) {
    constexpr int S = M / 8;
    const int tr = tid / (N / 16), u = tid % (N / 16), g = u / S, p = u % S; const int base = tr * N + g * 2 * M + p;
    f32x2v e[NI][16];
#pragma unroll
    for (int j = 0; j < NI; ++j)
#pragma unroll
        for (int k = 0; k < 16; ++k) e[j][k] = buf[j * FFT_BS + PD(base + k * S)];
    const f32x2v bc = twid(p, 2 * M); const f32x2v b1 = mk2(bc.x, -bc.y), b2 = cmul(b1, b1), b4 = cmul(b2, b2), b8 = cmul(b4, b4);
    constexpr float C1 = 0.92387953251128674f, S1 = 0.38268343236508977f, R2 = 0.70710678118654752f;
    const f32x2v w1a = cmul(b1, mk2(C1, -S1)), w1b = cmul(b2, mk2(R2, -R2)), w2a = cmul(b1, mk2(R2, -R2)), w2b = mul_mi(b2), w3a = cmul(b1, mk2(S1, -C1)), w3b = cmul(b2, mk2(-R2, -R2));
#pragma unroll
    for (int j = 0; j < NI; ++j) {
        bf4_fwd(e[j][0], e[j][4], e[j][8], e[j][12], b1, b2);
        bf4_fwd(e[j][1], e[j][5], e[j][9], e[j][13], w1a, w1b);
        bf4_fwd(e[j][2], e[j][6], e[j][10], e[j][14], w2a, w2b);
        bf4_fwd(e[j][3], e[j][7], e[j][11], e[j][15], w3a, w3b);
#pragma unroll
        for (int q = 0; q < 4; ++q) bf4_fwd(e[j][4 * q], e[j][4 * q + 1], e[j][4 * q + 2], e[j][4 * q + 3], b4, b8);
#pragma unroll
        for (int k = 0; k < 16; ++k) buf[j * FFT_BS + PD(base + k * S)] = e[j][k];
    }
    __syncthreads();
    if constexpr (M / 16 >= 32) fft_fwd_pass<N, M / 16, NI>(buf, tid);
}
constexpr float c32q(int k) { return k == 0 ? 1.f : k == 1 ? 0.98078528040323043f : k == 2 ? 0.92387953251128674f : k == 3 ? 0.83146961230254524f : k == 4 ? 0.70710678118654752f : k == 5 ? 0.55557023301960218f : k == 6 ? 0.38268343236508977f : k == 7 ? 0.19509032201612825f : 0.f; }
constexpr float c32(int k) { return k <= 8 ? c32q(k) : -c32q(16 - k); }
constexpr float s32(int k) { return k <= 8 ? c32q(8 - k) : c32q(k - 8); }
DI void bf4_fwd_t(f32x2v& x0, f32x2v& x1, f32x2v& x2, f32x2v& x3) {
    const f32x2v a0 = x0 + x2, a2 = x0 - x2, a1 = x1 + x3, a3 = mul_mi(x1 - x3);
    x0 = a0 + a1; x1 = a0 - a1; x2 = a2 + a3; x3 = a2 - a3;
}
DI void bf4_fwd_b1(f32x2v& x0, f32x2v& x1, f32x2v& x2, f32x2v& x3) {
    constexpr float R2 = 0.70710678118654752f;
    const f32x2v a0 = x0 + x2, a2 = cmul(x0 - x2, mk2(R2, -R2)), a1 = x1 + x3, a3 = cmul(x1 - x3, mk2(-R2, -R2));
    x0 = a0 + a1; x1 = mul_mi(a0 - a1); x2 = a2 + a3; x3 = mul_mi(a2 - a3);
}
DI void bf4_inv_t(f32x2v& x0, f32x2v& x1, f32x2v& x2, f32x2v& x3) {
    const f32x2v a0 = x0 + x1, a1 = x0 - x1, a2 = x2 + x3, a3 = x2 - x3; const f32x2v t3b = mul_pi(a3);
    x0 = a0 + a2; x1 = a1 + t3b; x2 = a0 - a2; x3 = a1 - t3b;
}
DI void bf4_inv_b1(f32x2v& x0, f32x2v& x1, f32x2v& x2, f32x2v& x3) {
    constexpr float R2 = 0.70710678118654752f;
    const f32x2v t1 = mul_pi(x1), t3 = mul_pi(x3); const f32x2v a0 = x0 + t1, a1 = x0 - t1, a2 = x2 + t3, a3 = x2 - t3;
    const f32x2v t2 = cmul(a2, mk2(R2, R2)), t3b = cmul(a3, mk2(-R2, R2));
    x0 = a0 + t2; x1 = a1 + t3b; x2 = a0 - t2; x3 = a1 - t3b;
}
template <int NI> DI void fft_r32_fwd(LAS f32x2v* buf, int tid) {
    const int img = tid >> 8, g = tid & 255;
    if (img < NI) {
        LAS f32x4v* p = (LAS f32x4v*)(buf + img * FFT_BS + 34 * g);
        f32x2v r[32];
#pragma unroll
        for (int m = 0; m < 16; ++m) { const f32x4v v = p[m]; r[2 * m] = mk2(v.x, v.y); r[2 * m + 1] = mk2(v.z, v.w); }
        bf4_fwd_t(r[0], r[8], r[16], r[24]);
#pragma unroll
        for (int j = 1; j < 8; ++j) bf4_fwd(r[j], r[j + 8], r[j + 16], r[j + 24], mk2(c32(j), -s32(j)), mk2(c32(2 * j), -s32(2 * j)));
#pragma unroll
        for (int q = 0; q < 4; ++q) { bf4_fwd_t(r[8 * q], r[8 * q + 2], r[8 * q + 4], r[8 * q + 6]); bf4_fwd_b1(r[8 * q + 1], r[8 * q + 3], r[8 * q + 5], r[8 * q + 7]); }
#pragma unroll
        for (int m = 0; m < 16; ++m) { const f32x2v a = r[2 * m] + r[2 * m + 1], b = r[2 * m] - r[2 * m + 1]; p[m] = (f32x4v){a.x, a.y, b.x, b.y}; }
    }
    __syncthreads();
}
template <int NI> DI void fft_r32_inv(LAS f32x2v* buf, int tid) {
    const int img = tid >> 8, g = tid & 255;
    if (img < NI) {
        LAS f32x4v* p = (LAS f32x4v*)(buf + img * FFT_BS + 34 * g);
        f32x2v r[32];
#pragma unroll
        for (int m = 0; m < 16; ++m) { const f32x4v v = p[m]; r[2 * m] = mk2(v.x + v.z, v.y + v.w); r[2 * m + 1] = mk2(v.x - v.z, v.y - v.w); }
#pragma unroll
        for (int q = 0; q < 4; ++q) { bf4_inv_t(r[8 * q], r[8 * q + 2], r[8 * q + 4], r[8 * q + 6]); bf4_inv_b1(r[8 * q + 1], r[8 * q + 3], r[8 * q + 5], r[8 * q + 7]); }
        bf4_inv_t(r[0], r[8], r[16], r[24]);
#pragma unroll
        for (int j = 1; j < 8; ++j) bf4_inv(r[j], r[j + 8], r[j + 16], r[j + 24], mk2(c32(j), s32(j)), mk2(c32(2 * j), s32(2 * j)));
#pragma unroll
        for (int m = 0; m < 16; ++m) p[m] = (f32x4v){r[2 * m].x, r[2 * m].y, r[2 * m + 1].x, r[2 * m + 1].y};
    }
    __syncthreads();
}
template <int N, int NI = 1> DI void fft_fwd(LAS f32x2v* buf, int tid) {
    asm volatile("" : "+v"(tid));
    fft_fwd_pass<N, N / 2, NI>(buf, tid);
    fft_r32_fwd<NI>(buf, tid);
}
template <int N, int M, int NI = 1, bool REC = true> DI void fft_inv_pass(LAS f32x2v* buf, int tid) {
    const int tr = tid / (N / 16), u = tid % (N / 16), g = u / M, p = u % M; const int base = tr * N + g * 16 * M + p;
    f32x2v e[NI][16];
#pragma unroll
    for (int j = 0; j < NI; ++j)
#pragma unroll
        for (int k = 0; k < 16; ++k) e[j][k] = buf[j * FFT_BS + PD(base + k * M)];
    const f32x2v a1 = twid(p, 16 * M), a2 = cmul(a1, a1), a4 = cmul(a2, a2), a8 = cmul(a4, a4);
    constexpr float C1 = 0.92387953251128674f, S1 = 0.38268343236508977f, R2 = 0.70710678118654752f;
    const f32x2v v1a = cmul(a1, mk2(C1, S1)), v1b = cmul(a2, mk2(R2, R2)), v2a = cmul(a1, mk2(R2, R2)), v2b = mul_pi(a2), v3a = cmul(a1, mk2(S1, C1)), v3b = cmul(a2, mk2(-R2, R2));
#pragma unroll
    for (int j = 0; j < NI; ++j) {
#pragma unroll
        for (int q = 0; q < 4; ++q) bf4_inv(e[j][4 * q], e[j][4 * q + 1], e[j][4 * q + 2], e[j][4 * q + 3], a4, a8);
        bf4_inv(e[j][0], e[j][4], e[j][8], e[j][12], a1, a2);
        bf4_inv(e[j][1], e[j][5], e[j][9], e[j][13], v1a, v1b);
        bf4_inv(e[j][2], e[j][6], e[j][10], e[j][14], v2a, v2b);
        bf4_inv(e[j][3], e[j][7], e[j][11], e[j][15], v3a, v3b);
#pragma unroll
        for (int k = 0; k < 16; ++k) buf[j * FFT_BS + PD(base + k * M)] = e[j][k];
    }
    __syncthreads();
    if constexpr (REC && 16 * M < N) fft_inv_pass<N, 16 * M, NI>(buf, tid);
}
template <int N, int NI = 1> DI void fft_inv(LAS f32x2v* buf, int tid) {
    asm volatile("" : "+v"(tid));
    fft_r32_inv<NI>(buf, tid);
    fft_inv_pass<N, 32, NI>(buf, tid);
}
template <int N> DI int ks_perm(int e) { if constexpr (N == 8192) return e < 4096 ? (((e & 63) << 6) | (e >> 6)) : e; else return e; }
template <int N, int NI> DI void fft_pairmul_pre(LAS f32x2v* buf, const f32x4v (&ksr)[8], const f32x4v* KS, int tid) {
    asm volatile("" : "+v"(tid));
    constexpr int LOG = (N == 8192) ? 13 : 9, NB = 8192 / N, NK = N / 2 + 1;
#pragma unroll
    for (int r = 0; r < 9; ++r) {
        const int idx = tid + 512 * r;
        if (r == 8 && idx >= NB * NK) break;
        f32x4v ks; if (r < 8) ks = ksr[r]; else ks = KS[idx];
        const int tr = idx / NK, k = ks_perm<N>(idx % NK);
        const int pk = PD(tr * N + (int)(__brev((unsigned)k) >> (32 - LOG))), pn = PD(tr * N + (int)(__brev((unsigned)((N - k) & (N - 1))) >> (32 - LOG)));
#pragma unroll
        for (int j = 0; j < NI; ++j) {
            const f32x2v zk = buf[j * FFT_BS + pk], zn = buf[j * FFT_BS + pn];
            const f32x2v u1 = mk2(0.5f * (zk.x + zn.x), 0.5f * (zk.y - zn.y)), u2 = mk2(0.5f * (zk.y + zn.y), -0.5f * (zk.x - zn.x));
            const f32x2v y1 = cmul(u1, mk2(ks.x, ks.y)), y2 = cmul(u2, mk2(ks.z, ks.w));
            buf[j * FFT_BS + pk] = mk2(y1.x - y2.y, y1.y + y2.x);
            if (pn != pk) buf[j * FFT_BS + pn] = mk2(y1.x + y2.y, -y1.y + y2.x);
        }
    }
}
template <int N, int NI> DI void fft_fwd_first(LAS f32x2v* buf, int tid, const float (&u0)[NI][8], const float (&u1)[NI][8]) {
    asm volatile("" : "+v"(tid));
    constexpr int M = N / 2, S = M / 8;
    const int tr = tid / (N / 16), p = tid % (N / 16); const int base = tr * N + p;
    const f32x2v bc = twid(p, 2 * M); const f32x2v b1 = mk2(bc.x, -bc.y), b2 = cmul(b1, b1), b4 = cmul(b2, b2), b8 = cmul(b4, b4);
    constexpr float C1 = 0.92387953251128674f, S1 = 0.38268343236508977f, R2 = 0.70710678118654752f;
    const f32x2v w1a = cmul(b1, mk2(C1, -S1)), w1b = cmul(b2, mk2(R2, -R2)), w2a = cmul(b1, mk2(R2, -R2)), w2b = mul_mi(b2), w3a = cmul(b1, mk2(S1, -C1)), w3b = cmul(b2, mk2(-R2, -R2));
    __syncthreads();
#pragma unroll
    for (int j = 0; j < NI; ++j) {
        f32x2v e[16];
#define FFT_HALF_FWD(i, w0, wm) { const f32x2v x0 = mk2(u0[j][i], u1[j][i]), x1 = mk2(u0[j][i + 4], u1[j][i + 4]); const f32x2v a2 = cmul(x0, w0), a3 = cmul(x1, mul_mi(w0)); \
            e[i] = x0 + x1; e[i + 4] = cmul(x0 - x1, wm); e[i + 8] = a2 + a3; e[i + 12] = cmul(a2 - a3, wm); }
        FFT_HALF_FWD(0, b1, b2) FFT_HALF_FWD(1, w1a, w1b) FFT_HALF_FWD(2, w2a, w2b) FFT_HALF_FWD(3, w3a, w3b)
#undef FFT_HALF_FWD
#pragma unroll
        for (int q = 0; q < 4; ++q) bf4_fwd(e[4 * q], e[4 * q + 1], e[4 * q + 2], e[4 * q + 3], b4, b8);
#pragma unroll
        for (int k = 0; k < 16; ++k) buf[j * FFT_BS + PD(base + k * S)] = e[k];
    }
    __syncthreads();
}
template <int N, int NI> DI void fft_inv_last(LAS f32x2v* buf, int tid, f32x2v (&out)[NI][8]) {
    asm volatile("" : "+v"(tid));
    constexpr int M = N / 16;
    const int tr = tid / (N / 16), p = tid % (N / 16); const int base = tr * N + p;
    const f32x2v a1 = twid(p, 16 * M), a2 = cmul(a1, a1), a4 = cmul(a2, a2), a8 = cmul(a4, a4);
    constexpr float C1 = 0.92387953251128674f, S1 = 0.38268343236508977f, R2 = 0.70710678118654752f;
    const f32x2v v1a = cmul(a1, mk2(C1, S1)), v1b = cmul(a2, mk2(R2, R2)), v2a = cmul(a1, mk2(R2, R2)), v2b = mul_pi(a2), v3a = cmul(a1, mk2(S1, C1)), v3b = cmul(a2, mk2(-R2, R2));
#pragma unroll
    for (int j = 0; j < NI; ++j) {
        f32x2v e[16];
#pragma unroll
        for (int k = 0; k < 16; ++k) e[k] = buf[j * FFT_BS + PD(base + k * M)];
#pragma unroll
        for (int q = 0; q < 4; ++q) bf4_inv(e[4 * q], e[4 * q + 1], e[4 * q + 2], e[4 * q + 3], a4, a8);
#define FFT_HALF_INV(i, wa, w) { const f32x2v t1 = cmul(e[i + 4], w), t3 = cmul(e[i + 12], w); const f32x2v a0 = e[i] + t1, a1_ = e[i] - t1, a2_ = e[i + 8] + t3, a3 = e[i + 8] - t3; \
            out[j][i] = a0 + cmul(a2_, wa); out[j][i + 4] = a1_ + cmul(a3, mul_pi(wa)); }
        FFT_HALF_INV(0, a1, a2) FFT_HALF_INV(1, v1a, v1b) FFT_HALF_INV(2, v2a, v2b) FFT_HALF_INV(3, v3a, v3b)
#undef FFT_HALF_INV
    }
}
template <int N, int NI = 1, bool SH = false> DI void fft_pairmul(LAS f32x2v* buf, const f32x4v* const (&KS)[NI]  , int tid) {
    asm volatile("" : "+v"(tid));
    constexpr int LOG = (N == 8192) ? 13 : 9, NB = 8192 / N, NK = N / 2 + 1;
    for (int idx = tid; idx < NB * NK; idx += 512) {
        const int tr = idx / NK, k = ks_perm<N>(idx % NK);
        const int pk = PD(tr * N + (int)(__brev((unsigned)k) >> (32 - LOG))), pn = PD(tr * N + (int)(__brev((unsigned)((N - k) & (N - 1))) >> (32 - LOG)));
        f32x4v ks0 = {0.f, 0.f, 0.f, 0.f}; if (SH) ks0 = KS[0][idx];
#pragma unroll
        for (int j = 0; j < NI; ++j) {
            const f32x2v zk = buf[j * FFT_BS + pk], zn = buf[j * FFT_BS + pn]; const f32x4v ks = SH ? ks0 : KS[j][idx];
            const f32x2v u1 = mk2(0.5f * (zk.x + zn.x), 0.5f * (zk.y - zn.y)), u2 = mk2(0.5f * (zk.y + zn.y), -0.5f * (zk.x - zn.x));
            const f32x2v y1 = cmul(u1, mk2(ks.x, ks.y)), y2 = cmul(u2, mk2(ks.z, ks.w));
            buf[j * FFT_BS + pk] = mk2(y1.x - y2.y, y1.y + y2.x);
            if (pn != pk) buf[j * FFT_BS + pn] = mk2(y1.x + y2.y, -y1.y + y2.x);
        }
    }
}
template <int T> DI void hyena_filter_item(Ctx& C, int o, int n, int pair0) {
    constexpr int N = 2 * T, NB = 4096 / T, LOG = (N == 8192) ? 13 : 9, NK = N / 2 + 1;
    const float* KT = (const float*)(C.ws + WS_SCAN); LAS f32x2v* buf = (LAS f32x2v*)C.lds; LAS float* red = (LAS float*)(C.lds + FFT_BUF_BYTES + 1024);
    int tid = C.tid; asm volatile("" : "+v"(tid)); const int toff = T == 256 ? 0 : 256;
    const float dmin = 4.605170185988092f / 1.5f, dmax = 4.605170185988092f / 0.3f;
    __syncthreads();
    if (tid < 2 * NB) red[tid] = 0.f;
    __syncthreads();
    float k0[16], k1[16];
#pragma unroll
    for (int i = 0; i < 16; ++i) { const int idx = tid + 512 * i, tr = idx / N, pos = idx % N; const int c = 2 * (pair0 + tr);
        float a = 0.f, b = 0.f;
        if (pos != T) { const int side = pos > T ? 1 : 0, tt = pos > T ? N - pos : pos; const float tn = (float)tt / (float)(T - 1);
            const float* kr = KT + ((size_t)o * 8192 + (n * 2 + side) * 2048 + c) * 4352 + toff + tt;
            const float d0 = dmin + (dmax - dmin) * ((float)c / 2047.0f), d1 = dmin + (dmax - dmin) * ((float)(c + 1) / 2047.0f);
            a = kr[0] * expf(-tn * d0); b = kr[4352] * expf(-tn * d1); }
        k0[i] = a; k1[i] = b;
        const float sa = wave_sum(fabsf(a)), sb = wave_sum(fabsf(b));
        if (C.lane == 0) { __hip_atomic_fetch_add(&red[2 * tr], sa, __ATOMIC_RELAXED, __HIP_MEMORY_SCOPE_WORKGROUP); __hip_atomic_fetch_add(&red[2 * tr + 1], sb, __ATOMIC_RELAXED, __HIP_MEMORY_SCOPE_WORKGROUP); } }
    __syncthreads();
    int tl = tid; asm volatile("" : "+v"(tl));
#pragma unroll
    for (int i = 0; i < 16; ++i) { const int idx = tl + 512 * i, tr = idx / N; f32x2v kv = mk2(k0[i] / red[2 * tr], k1[i] / red[2 * tr + 1]);
        if (idx % N == 0) { const float* hb = C.in[I_HB] + (size_t)(o * 2 + n) * 2048 + 2 * (pair0 + tr); kv.x += hb[0]; kv.y += hb[1]; }
        buf[PD(idx)] = kv; }
    __syncthreads();
    fft_fwd<N>(buf, tid);
    f32x4v* KS = (f32x4v*)(C.ws + (T == 256 ? WS_KSP : WS_KSS)) + ((size_t)(o * 2 + n) * 1024 + pair0) * NK;
    const float sc = 1.0f / (float)N;
    for (int idx = tid; idx < NB * NK; idx += 512) { const int tr = idx / NK, k = ks_perm<N>(idx % NK);
        const int pk = tr * N + (int)(__brev((unsigned)k) >> (32 - LOG)), pn = tr * N + (int)(__brev((unsigned)((N - k) & (N - 1))) >> (32 - LOG));
        const f32x2v zk = buf[PD(pk)], zn = buf[PD(pn)];
        KS[idx] = (f32x4v){0.5f * (zk.x + zn.x) * sc, 0.5f * (zk.y - zn.y) * sc, 0.5f * (zk.y + zn.y) * sc, -0.5f * (zk.x - zn.x) * sc}; }
}
DI void phase_hyena_filters(Ctx& C) {
    for (int it = C.vb; it < 4 * 1024 + 4 * 64; it += C.G) {
        if (it < 4096) hyena_filter_item<4096>(C, it >> 11, (it >> 10) & 1, it & 1023);
        else { const int v = it - 4096; hyena_filter_item<256>(C, v >> 7, (v >> 6) & 1, (v & 63) * 16); }
    }
    __syncthreads();
}
template <int T, int NI, int PROBE = 0, bool SH = false> DI void hyena_conv_item(Ctx& C, int o, const int (&seq)[NI], const int (&pair0)[NI]) {
    constexpr int N = 2 * T, NB = 4096 / T, NK = N / 2 + 1;
    LAS f32x2v* buf = (LAS f32x2v*)C.lds; const int tid = C.tid;
    const float* cw = C.in[I_CW] + (size_t)o * 3 * 6144; const float* cb = C.in[I_CB] + (size_t)o * 6144;
    bf16* Y = (bf16*)(C.ws + WS_MIX);
    const float* ZT[NI]; const f32x4v* KS0[NI]; const f32x4v* KS1[NI]; int rowbase[NI];
#pragma unroll
    for (int j = 0; j < NI; ++j) { ZT[j] = (const float*)(C.ws + WS_Z + (T == 256 ? 0 : ZT_S_OFF)) + (size_t)seq[j] * 6144 * T;
        KS0[j] = (const f32x4v*)(C.ws + (T == 256 ? WS_KSP : WS_KSS)) + ((size_t)(o * 2 + 0) * 1024 + pair0[j]) * NK; KS1[j] = KS0[j] + (size_t)1024 * NK;
        rowbase[j] = T == 256 ? seq[j] * 256 : MP + seq[j] * 4096; }
    constexpr int NQ = SH ? 1 : NI;
    float wq[NQ][6][4];
    if constexpr (T == 4096) {
        auto sg = [](float v) { return __builtin_bit_cast(float, __builtin_amdgcn_readfirstlane(__builtin_bit_cast(int, v))); };
#pragma unroll
        for (int j = 0; j < NQ; ++j) {
#pragma unroll
            for (int gq = 0; gq < 6; ++gq) { const int ch = (gq >> 1) * 2048 + 2 * pair0[j] + (gq & 1); wq[j][gq][0] = sg(cw[ch]); wq[j][gq][1] = sg(cw[6144 + ch]); wq[j][gq][2] = sg(cw[2 * 6144 + ch]); wq[j][gq][3] = sg(cb[ch]); }
        }
    }
    auto conv3 = [&](int j, int grp, int jj, int c, int t) { const int ch = grp * 2048 + c + jj; const float* zr = ZT[j] + (size_t)ch * T + t; const float zc = zr[0], zp = t > 0 ? zr[-1] : 0.f, zn = t < T - 1 ? zr[1] : 0.f;
        if constexpr (T == 4096) { const int jq = SH ? 0 : j; return wq[jq][grp * 2 + jj][0] * zp + wq[jq][grp * 2 + jj][1] * zc + wq[jq][grp * 2 + jj][2] * zn + wq[jq][grp * 2 + jj][3]; }
        else return cw[ch] * zp + cw[6144 + ch] * zc + cw[2 * 6144 + ch] * zn + cb[ch]; };
    float u0[NI][8], u1[NI][8]; f32x2v cv[NI][8];
    int tl = tid; asm volatile("" : "+v"(tl));
#pragma unroll
    for (int j = 0; j < NI; ++j)
#pragma unroll
        for (int i = 0; i < 8; ++i) { const int tr = tl / (N / 16), t = tl % (N / 16) + (N / 16) * i, c = 2 * (pair0[j] + tr);
            u0[j][i] = conv3(j, 2, 0, c, t); u1[j][i] = conv3(j, 2, 1, c, t); }
    f32x4v ksr[8];
    if constexpr (SH) {
#pragma unroll
        for (int r = 0; r < 8; ++r) ksr[r] = KS0[0][tl + 512 * r]; }
    fft_fwd_first<N, NI>(buf, tid, u0, u1);
    if constexpr (N == 8192) { int tf = tid; asm volatile("" : "+v"(tf)); fft_fwd_pass<N, 256, NI>(buf, tf); }
    { int tf = tid; asm volatile("" : "+v"(tf)); fft_r32_fwd<NI>(buf, tf); }
    if constexpr (SH) fft_pairmul_pre<N, NI>(buf, ksr, KS0[0], tid); else fft_pairmul<N, NI, SH>(buf, KS0, tid);
    __syncthreads();
    { int tf = tid; asm volatile("" : "+v"(tf)); fft_r32_inv<NI>(buf, tf); }
    if constexpr (N == 8192) { int tf = tid; asm volatile("" : "+v"(tf)); fft_inv_pass<N, 32, NI, false>(buf, tf); }
    fft_inv_last<N, NI>(buf, tid, cv);
    tl = tid; asm volatile("" : "+v"(tl));
#pragma unroll
    for (int j = 0; j < NI; ++j)
#pragma unroll
        for (int i = 0; i < 8; ++i) { const int tr = tl / (N / 16), t = tl % (N / 16) + (N / 16) * i, c = 2 * (pair0[j] + tr);
            u0[j][i] = conv3(j, 0, 0, c, t) * cv[j][i].x; u1[j][i] = conv3(j, 0, 1, c, t) * cv[j][i].y; }
    if constexpr (SH) {
#pragma unroll
        for (int r = 0; r < 8; ++r) ksr[r] = KS1[0][tl + 512 * r]; }
    fft_fwd_first<N, NI>(buf, tid, u0, u1);
    if constexpr (N == 8192) { int tf = tid; asm volatile("" : "+v"(tf)); fft_fwd_pass<N, 256, NI>(buf, tf); }
    { int tf = tid; asm volatile("" : "+v"(tf)); fft_r32_fwd<NI>(buf, tf); }
    if constexpr (SH) fft_pairmul_pre<N, NI>(buf, ksr, KS1[0], tid); else fft_pairmul<N, NI, SH>(buf, KS1, tid);
    __syncthreads();
    { int tf = tid; asm volatile("" : "+v"(tf)); fft_r32_inv<NI>(buf, tf); }
    if constexpr (N == 8192) { int tf = tid; asm volatile("" : "+v"(tf)); fft_inv_pass<N, 32, NI, false>(buf, tf); }
    fft_inv_last<N, NI>(buf, tid, cv);
    tl = tid; asm volatile("" : "+v"(tl));
#pragma unroll
    for (int j = 0; j < NI; ++j)
#pragma unroll
        for (int i = 0; i < 8; ++i) { const int tr = tl / (N / 16), t = tl % (N / 16) + (N / 16) * i, c = 2 * (pair0[j] + tr);
            const float y0 = conv3(j, 1, 0, c, t) * cv[j][i].x, y1 = conv3(j, 1, 1, c, t) * cv[j][i].y;
            *(unsigned*)(Y + (size_t)(rowbase[j] + t) * 2048 + c) = pk2(y0, y1); }
}
template <int PROBE = 0> DI void phase_hyena_conv(Ctx& C, int o) {
    if (C.G == 256) {
        for (int it = C.vb; it < 1024 + 512; it += C.G) {
            if (it < 1024) { const int sq[2] = {0, 1}, pr[2] = {it, it}; hyena_conv_item<4096, 2, PROBE, true>(C, o, sq, pr); }
            else { const int v = it - 1024; const int sq[2] = {2 * (v >> 6), 2 * (v >> 6) + 1}, pr[2] = {(v & 63) * 16, (v & 63) * 16}; hyena_conv_item<256, 2, PROBE, true>(C, o, sq, pr); }
        }
    } else {
        for (int it = C.vb; it < 2048 + 1024; it += C.G) {
            if (it < 2048) { const int sq[1] = {it >> 10}, pr[1] = {it & 1023}; hyena_conv_item<4096, 1, PROBE>(C, o, sq, pr); }
            else { const int v = it - 2048; const int sq[1] = {v >> 6}, pr[1] = {(v & 63) * 16}; hyena_conv_item<256, 1, PROBE>(C, o, sq, pr); }
        }
    }
    __syncthreads();
}

#ifndef ONE_LAUNCH
#define ONE_LAUNCH 1
#endif
#ifndef SKIP_FFN
#define SKIP_FFN 0
#endif
#ifndef SKIP_EVEN
#define SKIP_EVEN 0
#endif
#ifndef SKIP_ODD
#define SKIP_ODD 0
#endif
#ifndef DUP_FFN
#define DUP_FFN 0
#endif
#ifndef DUP_EVEN
#define DUP_EVEN 0
#endif
#ifndef DUP_ODD
#define DUP_ODD 0
#endif
#ifndef DUP_PRO
#define DUP_PRO 0
#endif
#ifndef DUP_E
#define DUP_E 0
#endif
#ifndef DUP_O
#define DUP_O 0
#endif
constexpr int NPH_MAX = 96;
template <int V> struct IntC { static constexpr int value = V; };
DI void launder(Ctx& C, const KArgs& a) { const int t = lane_id_v(); C.lane = t; C.tid = C.wave * 64 + t;
    int z = 0; asm volatile("" : "+v"(z)); const int zs = __builtin_amdgcn_readfirstlane(z);
    C.ws = a.ws + zs; C.in = a.in + zs; C.out = a.out + zs;
    C.zs = zs; C.G = (int)gridDim.x + zs; C.bx = (int)blockIdx.x + zs; C.gw = C.bx * 8 + C.wave; C.NGW = C.G * 8; C.vb = (C.G % 8 == 0) ? (C.bx % 8) * (C.G / 8) + C.bx / 8 : C.bx; }
__global__ void __launch_bounds__(512, 2) mega_fwd(KArgs args) {
    extern __shared__ __attribute__((aligned(16))) unsigned char lds_raw[];
    Ctx C;
    C.lds = (LAS unsigned char*)lds_raw; C.ws = args.ws; C.in = args.in; C.out = args.out;
    C.wave = __builtin_amdgcn_readfirstlane((int)threadIdx.x >> 6); C.lane = lane_id_v(); C.tid = C.wave * 64 + C.lane;
    C.zs = 0; C.G = 0; C.bx = 0; C.gw = 0; C.NGW = 0; C.vb = 0;
    for (int u = C.tid; u < (LDS_BYTES - LDS_CTL) / 4; u += 512) ((LAS unsigned*)(C.lds + LDS_CTL))[u] = 0u;
    __syncthreads();
    (void)xcd_barrier_post((unsigned*)(args.ws + WS_CTL) + 4096, (volatile LAS unsigned*)(C.lds + LDS_CTL + 64), C.tid);
#if ONE_LAUNCH
    constexpr int lo = 0, hi = 1 << 20; int ph = 0;
#else
    const int lo = args.ph_lo, hi = args.ph_hi; int ph = 0;
#endif
#define PH_IF if (ph >= lo && ph < hi) if (launder(C, args), true)
#define PH_NEXT do { const bool both_ = (ph >= lo) && (ph + 1 < hi); ++ph; if (both_) { launder(C, args); XcdBarrier b_; b_.bar = (unsigned*)(C.ws + WS_CTL) + 4096; b_.x = xb_xcc_id() + (unsigned)C.zs; b_.st = (volatile LAS unsigned*)(C.lds + LDS_CTL + 64); xcd_barrier(b_, C.tid); } } while (0)
#define HOST_MIX (C.G == 256 && !SKIP_EVEN && !SKIP_ODD)
#define ring C.lds
#define MOD ((const float*)(C.ws + WS_MOD))
#define X ((float*)(C.ws + WS_X))

#if DUP_PRO == 1
    PH_IF { phase_prologue(C); } PH_NEXT;
#endif
    PH_IF {
#ifndef NO_PROLOGUE
 phase_prologue(C);
#endif
 } PH_NEXT;
    PH_IF { phase_mod_reduce(C);
        pg8::Gemm g{(const bf16*)(C.ws + WS_W3T), (const bf16*)(C.ws + WS_H2), 16384, 4352, 256}; pg8::StaticOrder S; S.init(16384, 4352, C.G, C.bx);
        pg8::EpiF32 E{(float*)(C.ws + WS_SCAN), 4352};
        pg8::gemm_phase<pg8::EpiF32, pg8::StaticOrder, true, true>(ring, g, S, E, C.wave); } PH_NEXT;
#if DUP_PRO == 2
    PH_IF { phase_hyena_filters(C); } PH_NEXT;
#endif
    PH_IF {
#ifndef NO_HYENA
 phase_hyena_filters(C);
#endif
 } PH_NEXT;

#define FFN_BLOCK(l, fi, s, cf) do { \
    if (!SKIP_FFN) { \
    PH_IF { phase_norm_mod(C, C.in[I_NG] + ((l) * 3 + (s)) * 2048, MOD + (size_t)(l) * MODL, (s)); } PH_NEXT; \
    PH_IF { pg8::Gemm g{(const bf16*)(C.ws + WS_H), (const bf16*)(C.ws + WS_W1T) + (size_t)((l) * 2 + (fi)) * NFF1 * 2048, MT, NFF1, 2048}; pg8::StaticOrder S; S.init(MT, NFF1, C.G, C.bx); \
        pg8::EpiSwiGLU E{(bf16*)(C.ws + WS_ACT), DFF}; pg8::gemm_phase<pg8::EpiSwiGLU, pg8::StaticOrder, false, true>(ring, g, S, E, C.wave); \
        { const int nf_ = (l) * 2 + (fi) + 1, idle0_ = (MT / 256) * (NFF1 / 256) % C.G; if ((cf) != 0.0f && nf_ < 8 && C.bx >= idle0_) { launder(C, args); \
            tr_matrix<0>(C, C.in[I_WFO] + (size_t)nf_ * DFF * 2048, 2048, DFF, (bf16*)(C.ws + WS_W2T) + (size_t)nf_ * 2048 * DFF, 2048, 2048, (C.bx - idle0_) * 8 + C.wave, (C.G - idle0_) * 8); } } } PH_NEXT; \
    PH_IF { pg8::Gemm g{(const bf16*)(C.ws + WS_ACT), (const bf16*)(C.ws + WS_W2T) + (size_t)((l) * 2 + (fi)) * 2048 * DFF, MT, 2048, DFF}; \
        pg8::EpiRes E{X, MOD + (size_t)(l) * MODL + (3 * (s) + 2) * 2048, (cf)}; \
        { pg8::PairOrder<1> S; S.init(MT, 2048, DFF, C.G, C.bx, (float*)(C.ws + WS_Z), (unsigned*)(C.ws + WS_CTL) + 16384, (DUP_FFN ? 8u * (unsigned)(2 * ((l) * 2 + (fi)) + ((cf) != 0.0f ? 2 : 1)) : 8u * (unsigned)((l) * 2 + (fi) + 1))); \
          pg8::gemm_phase<pg8::EpiRes, pg8::PairOrder<1>, false, true>(ring, g, S, E, C.wave); } \
        { launder(C, args); pg8::PairOrder<2> S; S.init(MT, 2048, DFF, C.G, C.bx, (float*)(C.ws + WS_Z), (unsigned*)(C.ws + WS_CTL) + 16384, (DUP_FFN ? 8u * (unsigned)(2 * ((l) * 2 + (fi)) + ((cf) != 0.0f ? 2 : 1)) : 8u * (unsigned)((l) * 2 + (fi) + 1))); \
          pg8::Gemm g2{(const bf16*)(C.ws + WS_ACT), (const bf16*)(C.ws + WS_W2T) + (size_t)((l) * 2 + (fi)) * 2048 * DFF, MT, 2048, DFF}; pg8::EpiRes E2{X, MOD + (size_t)(l) * MODL + (3 * (s) + 2) * 2048, (cf)}; \
          pg8::gemm_phase<pg8::EpiRes, pg8::PairOrder<2>, true, true>(ring, g2, S, E2, C.wave); } \
        { const int nf_ = (l) * 2 + (fi) + 1; if ((cf) != 0.0f && nf_ < 8 && !(C.G >= 235 && !SKIP_EVEN && ((l) & 1) == 0 && (fi) == 0) && !(C.G == 256 && !SKIP_EVEN && ((l) & 1) == 0 && (fi) == 1) && !(HOST_MIX && ((l) & 1) == 1 && (fi) == 0)) { launder(C, args); \
            tr_matrix<1>(C, C.in[I_WFI] + (size_t)nf_ * 2048 * NFF1, NFF1, 2048, (bf16*)(C.ws + WS_W1T) + (size_t)nf_ * NFF1 * 2048, NFF1, NFF1, C.gw, C.NGW, (HOST_MIX && ((l) & 1) == 1 && (fi) == 1) ? 5632 : 0); } } } PH_NEXT; \
    } } while (0)

    auto layer_pair = [&](auto PC) __attribute__((always_inline)) {
        constexpr int p = decltype(PC)::value; constexpr int le = 2 * p, lod = 2 * p + 1;
#if DUP_FFN
        FFN_BLOCK(le, 0, 0, 0.0f);
#endif
        FFN_BLOCK(le, 0, 0, 0.5f);
        auto even_mix = [&](float cf, int qslot) __attribute__((always_inline)) {
            const int e = p;
            PH_IF { phase_norm_mod(C, C.in[I_NG] + (le * 3 + 1) * 2048, MOD + (size_t)le * MODL, 1); } PH_NEXT;
            PH_IF { pg8::Gemm g{(const bf16*)(C.ws + WS_H), (const bf16*)(C.ws + WS_WINE) + (size_t)e * ZE_P * 2048, MT, ZE_P, 2048}; pg8::StaticOrder S; S.init(MT, ZE_P, C.G, C.bx);
                pg8::EpiF32 E{(float*)(C.ws + WS_Z), ZE_P}; pg8::gemm_phase<pg8::EpiF32, pg8::StaticOrder, true, true>(ring, g, S, E, C.wave);
                { const int nf_ = le * 2 + 2, idle0_ = (MT / 256) * (ZE_P / 256) % C.G;
                  if (cf != 0.0f && C.G == 256 && C.bx >= idle0_) { launder(C, args);
                    tr_matrix<1>(C, C.in[I_WFI] + (size_t)nf_ * 2048 * NFF1, NFF1, 2048, (bf16*)(C.ws + WS_W1T) + (size_t)nf_ * NFF1 * 2048, NFF1, NFF1, (C.bx - idle0_) * 8 + C.wave, (C.G - idle0_) * 8); } } } PH_NEXT;
#if DUP_E == 5
            PH_IF { phase_even_prep(C, e); } PH_NEXT;
#endif
            PH_IF { phase_even_prep(C, e); } PH_NEXT;
#if DUP_E == 7
            PH_IF {
                { pg8::Gemm g{(const bf16*)(C.ws + WS_LA), (const bf16*)(C.ws + WS_WLORA) + (size_t)e * 5120 * 384, MT, 5120, 384}; pg8::StaticOrder S; S.init(MT, 5120, C.G, C.bx);
                  pg8::EpiLora E{C.ws, C.in[I_W0] + e * 2048, C.in[I_A0] + e * 2048, C.in[I_KA] + e * 1024, WS_SCAN + (size_t)e * SCAN_BYTES, WS_KBUF, WS_GB};
                  pg8::gemm_phase<pg8::EpiLora, pg8::StaticOrder, true, true>(ring, g, S, E, C.wave); }
                launder(C, args);
                { pg8::Gemm g{(const bf16*)(C.ws + WS_CQ), (const bf16*)(C.ws + WS_WQ) + (size_t)e * 1536 * 512, MT, 1536, 512}; pg8::StaticOrder S; S.init(MT, 1536, C.G, C.bx);
                  pg8::EpiQ E{(bf16*)(C.ws + WS_Q), (const float*)(C.ws + WS_ROPE), 0.07216878364870322f * 1.4426950408889634f};
                  pg8::gemm_phase<pg8::EpiQ, pg8::StaticOrder, true, true>(ring, g, S, E, C.wave); }
                launder(C, args);
                { pg8::Gemm g{(const bf16*)(C.ws + WS_CKV), (const bf16*)(C.ws + WS_WKN) + (size_t)e * 1024 * 256, MKV, 1024, 256}; pg8::StaticOrder S; S.init(MKV, 1024, C.G, C.bx);
                  pg8::EpiBf16Plain E{(bf16*)(C.ws + WS_KN), 1024};
                  pg8::gemm_phase<pg8::EpiBf16Plain, pg8::StaticOrder, false, false>(ring, g, S, E, C.wave); }
                launder(C, args);
                { pg8::Gemm g{(const bf16*)(C.ws + WS_WV) + (size_t)e * 1024 * 256, (const bf16*)(C.ws + WS_CKV), 1024, MKV, 256}; pg8::StaticOrder S; S.init(1024, MKV, C.G, C.bx);
                  pg8::EpiVT E{(bf16*)(C.ws + WS_VT), VT_S_OFF / 2};
                  pg8::gemm_phase<pg8::EpiVT, pg8::StaticOrder, false, false>(ring, g, S, E, C.wave); }
            } PH_NEXT;
#endif
            PH_IF {
                { pg8::Gemm g{(const bf16*)(C.ws + WS_LA), (const bf16*)(C.ws + WS_WLORA) + (size_t)e * 5120 * 384, MT, 5120, 384}; pg8::StaticOrder S; S.init(MT, 5120, C.G, C.bx);
                  pg8::EpiLora E{C.ws, C.in[I_W0] + e * 2048, C.in[I_A0] + e * 2048, C.in[I_KA] + e * 1024, WS_SCAN + (size_t)e * SCAN_BYTES, WS_KBUF, WS_GB};
                  pg8::gemm_phase<pg8::EpiLora, pg8::StaticOrder, true, true>(ring, g, S, E, C.wave); }
                launder(C, args);
                { pg8::Gemm g{(const bf16*)(C.ws + WS_CQ), (const bf16*)(C.ws + WS_WQ) + (size_t)e * 1536 * 512, MT, 1536, 512}; pg8::StaticOrder S; S.init(MT, 1536, C.G, C.bx);
                  pg8::EpiQ E{(bf16*)(C.ws + WS_Q), (const float*)(C.ws + WS_ROPE), 0.07216878364870322f * 1.4426950408889634f};
                  pg8::gemm_phase<pg8::EpiQ, pg8::StaticOrder, true, true>(ring, g, S, E, C.wave); }
                launder(C, args);
                { pg8::Gemm g{(const bf16*)(C.ws + WS_CKV), (const bf16*)(C.ws + WS_WKN) + (size_t)e * 1024 * 256, MKV, 1024, 256}; pg8::StaticOrder S; S.init(MKV, 1024, C.G, C.bx);
                  pg8::EpiBf16Plain E{(bf16*)(C.ws + WS_KN), 1024};
                  pg8::gemm_phase<pg8::EpiBf16Plain, pg8::StaticOrder, false, false>(ring, g, S, E, C.wave); }
                launder(C, args);
                { pg8::Gemm g{(const bf16*)(C.ws + WS_WV) + (size_t)e * 1024 * 256, (const bf16*)(C.ws + WS_CKV), 1024, MKV, 256}; pg8::StaticOrder S; S.init(1024, MKV, C.G, C.bx);
                  pg8::EpiVT E{(bf16*)(C.ws + WS_VT), VT_S_OFF / 2};
                  pg8::gemm_phase<pg8::EpiVT, pg8::StaticOrder, false, false>(ring, g, S, E, C.wave); }
            } PH_NEXT;
#if DUP_E == 1
            PH_IF { phase_scan1(C, e, 2); } PH_NEXT;
#endif
            PH_IF {
#ifndef NO_SCAN
 phase_scan1(C, e, qslot);
#endif
 } PH_NEXT;
#if DUP_E == 2
            PH_IF { phase_scan_carry(C, e, 8); __syncthreads(); } PH_NEXT;
#endif
            PH_IF { const bool host_ = cf != 0.0f && C.G >= 235; phase_scan_carry(C, e, host_ ? 3 : 8);
                if (host_ && C.bx >= 64 && C.wave >= 3) { launder(C, args); const int nf_ = le * 2 + 1;
                    tr_matrix<1>(C, C.in[I_WFI] + (size_t)nf_ * 2048 * NFF1, NFF1, 2048, (bf16*)(C.ws + WS_W1T) + (size_t)nf_ * NFF1 * 2048, NFF1, NFF1, (C.bx - 64) * 5 + C.wave - 3, (C.G - 64) * 5); }
                __syncthreads(); } PH_NEXT;
#if DUP_E == 3
            PH_IF { phase_scan3(C, e); } PH_NEXT;
#endif
#if DUP_E == 4
            PH_IF { phase_attention(C); } PH_NEXT;
#endif
            PH_IF {
#ifndef NO_SCAN
 phase_scan3(C, e);
#endif
#ifndef NO_ATTN
 phase_attention(C);
#endif
 } PH_NEXT;
#if DUP_E == 6
            PH_IF { phase_rwkv_post(C, e); } PH_NEXT;
#endif
            PH_IF { phase_rwkv_post(C, e); } PH_NEXT;
            PH_IF { pg8::Gemm g{(const bf16*)(C.ws + WS_MIX), (const bf16*)(C.ws + WS_WOUTE) + (size_t)e * 2048 * 2048, MT, 2048, 2048}; pg8::StaticOrder S; S.init(MT, 2048, C.G, C.bx);
                pg8::EpiRes E{X, MOD + (size_t)le * MODL + (3 * 1 + 2) * 2048, cf}; pg8::gemm_phase<pg8::EpiRes, pg8::StaticOrder, false, true>(ring, g, S, E, C.wave);
                if (cf != 0.0f && HOST_MIX && C.bx >= 128) { launder(C, args); const int nf_ = le * 2 + 3;
                    tr_matrix<1>(C, C.in[I_WFI] + (size_t)nf_ * 2048 * NFF1, NFF1, 2048, (bf16*)(C.ws + WS_W1T) + (size_t)nf_ * NFF1 * 2048, NFF1, NFF1, (C.bx - 128) * 8 + C.wave, (C.G - 128) * 8, 0, 5632); } } PH_NEXT;
        };
#if DUP_EVEN
        even_mix(0.0f, 1);
#endif
        if (!SKIP_EVEN) even_mix(1.0f, 0);
#if DUP_FFN
        FFN_BLOCK(le, 1, 2, 0.0f);
#endif
        FFN_BLOCK(le, 1, 2, 0.5f);
#if DUP_FFN
        FFN_BLOCK(lod, 0, 0, 0.0f);
#endif
        FFN_BLOCK(lod, 0, 0, 0.5f);
        auto odd_mix = [&](float cf) __attribute__((always_inline)) {
            const int o = p;
            PH_IF { phase_norm_mod(C, C.in[I_NG] + (lod * 3 + 1) * 2048, MOD + (size_t)lod * MODL, 1); } PH_NEXT;
            PH_IF { pg8::Gemm g{(const bf16*)(C.ws + WS_WINO) + (size_t)o * 6144 * 2048, (const bf16*)(C.ws + WS_H), 6144, MT, 2048}; pg8::StaticOrder S; S.init(6144, MT, C.G, C.bx);
                pg8::EpiZT E{(float*)(C.ws + WS_Z), (float*)(C.ws + WS_Z + ZT_S_OFF)}; pg8::gemm_phase<pg8::EpiZT, pg8::StaticOrder, false, true>(ring, g, S, E, C.wave);
                if (cf != 0.0f && HOST_MIX && C.bx >= 128) { launder(C, args); const int nf_ = le * 2 + 3;
                    tr_matrix<1>(C, C.in[I_WFI] + (size_t)nf_ * 2048 * NFF1, NFF1, 2048, (bf16*)(C.ws + WS_W1T) + (size_t)nf_ * NFF1 * 2048, NFF1, NFF1, (C.bx - 128) * 8 + C.wave, (C.G - 128) * 8, 5632); } } PH_NEXT;
#if DUP_O == 1
            PH_IF { phase_hyena_conv(C, o); } PH_NEXT;
#endif
#if DUP_O == 2
            PH_IF { phase_hyena_conv<1>(C, o); } PH_NEXT;
#endif
            PH_IF {
#ifndef NO_HYENA
 phase_hyena_conv(C, o);
#endif
 } PH_NEXT;
            PH_IF { pg8::Gemm g{(const bf16*)(C.ws + WS_MIX), (const bf16*)(C.ws + WS_WOUTO) + (size_t)o * 2048 * 2048, MT, 2048, 2048}; pg8::StaticOrder S; S.init(MT, 2048, C.G, C.bx);
                pg8::EpiRes E{X, MOD + (size_t)lod * MODL + (3 * 1 + 2) * 2048, cf}; pg8::gemm_phase<pg8::EpiRes, pg8::StaticOrder, false, true>(ring, g, S, E, C.wave);
                if (cf != 0.0f && HOST_MIX && le * 2 + 4 < 8 && C.bx >= 128) { launder(C, args); const int nf_ = le * 2 + 4;
                    tr_matrix<1>(C, C.in[I_WFI] + (size_t)nf_ * 2048 * NFF1, NFF1, 2048, (bf16*)(C.ws + WS_W1T) + (size_t)nf_ * NFF1 * 2048, NFF1, NFF1, (C.bx - 128) * 8 + C.wave, (C.G - 128) * 8, 0, 5632); } } PH_NEXT;
        };
#if DUP_ODD
        odd_mix(0.0f);
#endif
        if (!SKIP_ODD) odd_mix(1.0f);
#if DUP_FFN
        FFN_BLOCK(lod, 1, 2, 0.0f);
#endif
        FFN_BLOCK(lod, 1, 2, 0.5f);
    };
    layer_pair(IntC<0>{}); layer_pair(IntC<1>{});
    PH_IF { phase_final_norm(C); } PH_NEXT;
#undef MOD
#undef X
#undef ring
}

extern "C" void kernel_launch(void* const* d_in, const int* in_sizes, int n_in, void* d_out, int out_size, void* d_ws, size_t ws_size, hipStream_t stream) {
    static int grid = 0;
    if (grid == 0) {
        if (n_in != 42 || (size_t)out_size != OUT_END || ws_size < WS_END) { fprintf(stderr, "kernel_launch: unexpected sizes n_in %d out %d ws %zu (need %zu)\n", n_in, out_size, ws_size, (size_t)WS_END); grid = -1; return; }
        int dev = 0, cus = 0, per_cu = 0;
        if (hipGetDevice(&dev) != hipSuccess || hipDeviceGetAttribute(&cus, hipDeviceAttributeMultiprocessorCount, dev) != hipSuccess) { grid = -1; return; }
        if (hipFuncSetAttribute((const void*)mega_fwd, hipFuncAttributeMaxDynamicSharedMemorySize, LDS_BYTES) != hipSuccess) { fprintf(stderr, "kernel_launch: hipFuncSetAttribute failed\n"); grid = -1; return; }
        if (hipOccupancyMaxActiveBlocksPerMultiprocessor(&per_cu, (const void*)mega_fwd, 512, LDS_BYTES) != hipSuccess || per_cu < 1) fprintf(stderr, "kernel_launch: occupancy query says %d\n", per_cu);
        (void)hipGetLastError();
        grid = cus;
    }
    if (grid < 0) return;
    (void)hipMemsetAsync((char*)d_ws + WS_CTL, 0, CTL_ZERO_BYTES, stream);
    KArgs a{};
    for (int i = 0; i < 42; ++i) a.in[i] = (const float*)d_in[i];
    a.out = (float*)d_out; a.ws = (unsigned char*)d_ws;
#if ONE_LAUNCH
    a.ph_lo = 0; a.ph_hi = 1 << 20;
    hipLaunchKernelGGL(mega_fwd, dim3(grid), dim3(512), LDS_BYTES, stream, a);
#else
    for (int i = 0; i < NPH_MAX; ++i) { a.ph_lo = i; a.ph_hi = i + 1; hipLaunchKernelGGL(mega_fwd, dim3(grid), dim3(512), LDS_BYTES, stream, a); }
#endif
}
```

```cpp
#include <hip/hip_runtime.h>
#include <cstdio>
#include <cstdint>
#include <utility>
#define DI __device__ __forceinline__
#define GAS __attribute__((address_space(1)))
#define LAS __attribute__((address_space(3)))
#define CAS __attribute__((address_space(4)))
typedef unsigned short bf16;
typedef unsigned v4u __attribute__((ext_vector_type(4)));
typedef unsigned v2u __attribute__((ext_vector_type(2)));
typedef float f32x4v __attribute__((ext_vector_type(4)));
typedef float f32x2v __attribute__((ext_vector_type(2)));
typedef float f32x16v __attribute__((ext_vector_type(16)));
typedef short s16x8v __attribute__((ext_vector_type(8)));
typedef short s16x4v __attribute__((ext_vector_type(4)));

constexpr int D = 2048, MP = 4096, MS = 8192, MT = 12288, MKV = 12800;
constexpr int DFF = 5632, NFF1 = 11264;
constexpr int ZE_N = 4192, ZE_P = 4352;
constexpr int SCAN_P = 9 * 1024;
constexpr int NCH = 32, CHL = 4096 / NCH;
constexpr int MODL = 3 * 18432;

DI int lane_id_v() { int l; asm volatile("v_mbcnt_lo_u32_b32 %0, -1, 0\n\tv_mbcnt_hi_u32_b32 %0, -1, %0" : "=v"(l)); return l; }
DI unsigned f2bf(float f) { unsigned u = __builtin_bit_cast(unsigned, f); return (u + 0x7fffu + ((u >> 16) & 1u)) >> 16; }
DI unsigned pk2(float lo, float hi) { unsigned r; asm("v_cvt_pk_bf16_f32 %0, %1, %2" : "=v"(r) : "v"(lo), "v"(hi)); return r; }
DI float bf2f(unsigned short b) { return __builtin_bit_cast(float, ((unsigned)b) << 16); }
template <int CTRL> DI float dpp_f(float v) { return __builtin_bit_cast(float, __builtin_amdgcn_update_dpp(0, __builtin_bit_cast(int, v), CTRL, 0xf, 0xf, true)); }
DI float shfl_idx(float v, int src) { return __builtin_bit_cast(float, __builtin_amdgcn_ds_bpermute(src << 2, __builtin_bit_cast(int, v))); }
DI float wave_sum(float v) {
    v += dpp_f<0xB1>(v); v += dpp_f<0x4E>(v); v += dpp_f<0x141>(v); v += dpp_f<0x140>(v);
    v += __builtin_bit_cast(float, __builtin_amdgcn_ds_swizzle(__builtin_bit_cast(int, v), 0x401F));
    return __builtin_bit_cast(float, __builtin_amdgcn_readlane(__builtin_bit_cast(int, v), 0)) + __builtin_bit_cast(float, __builtin_amdgcn_readlane(__builtin_bit_cast(int, v), 32));
}
DI float sigmoid_f(float x) { return __builtin_amdgcn_rcpf(1.f + __expf(-x)); }
DI float silu_f(float x) { return x * sigmoid_f(x); }
DI int scan_perm(int j) { return 4 * (j & 15) + (j >> 4); }
DI int row_mod_j(int row) { return row < MP ? 0 : 1 + ((row - MP) >> 12); }
namespace pg8 {
#define PG8_LAS __attribute__((address_space(3)))
typedef unsigned short bf16_t;
typedef short bf16x8 __attribute__((ext_vector_type(8)));
typedef float f32x4 __attribute__((ext_vector_type(4)));
typedef unsigned u32x4 __attribute__((ext_vector_type(4)));
constexpr int BM = 256, BK = 64, HALF = 128, HTB = HALF * BK * 2  , STAGE_BYTES = 8 * HTB, NXCD = 8, WGM = 8;

__host__ __device__ __forceinline__ int lds_byte(int r, int c) { const int st = (r >> 4) * 2 + (c >> 5), rr = r & 15, cc = c & 31, ob = rr * 64 + cc * 2; return st * 1024 + (ob ^ (((ob >> 9) & 1) << 5)); }
__host__ __device__ __forceinline__ void stage_rc(int b, int& R, int& C) { const int st = b / 1024, sb = b % 1024, swz = sb ^ (((sb >> 9) & 1) << 5); R = (st >> 1) * 16 + swz / 64; C = (st & 1) * 32 + (swz % 64) / 2; }
__host__ __device__ __forceinline__ int perm32(int rho) { const int n = rho >> 4, i = rho & 15; return 8 * (i >> 2) + 4 * n + (i & 3); }

struct Unit { int pm, pn; int kt0, nkt, mode, slot; };
struct Gemm { const bf16_t* A; const bf16_t* Bt; int M, N, K; };
struct StaticOrder {
    static constexpr int SPLITK = 0;
    int nM, nN, nwg, G, c;
    __host__ __device__ __forceinline__ void init(int M, int N, int G_, int c_) { nM = M / BM; nN = N / BM; nwg = nM * nN; G = G_; c = c_; }
    __host__ __device__ __forceinline__ bool next(int i, Unit& u) const {
        const long L = (long)i * G + c; if (L >= nwg) return false;
        int wgid = (int)L; { const int q = nwg / NXCD, r = nwg % NXCD, xcd = wgid % NXCD, off = wgid / NXCD; wgid = (xcd < r ? xcd * (q + 1) : r * (q + 1) + (xcd - r) * q) + off; }
        const int nig = WGM * nN, gid = wgid / nig, fm = gid * WGM, gsz = (nM - fm) < WGM ? (nM - fm) : WGM;
        u.pm = fm + ((wgid % nig) % gsz); u.pn = (wgid % nig) / gsz; u.kt0 = 0; u.nkt = 0; u.mode = 0; u.slot = 0; return true;
    }
    __device__ __forceinline__ void a_ready(const Unit&) const {}
    __device__ __forceinline__ void done(const Unit&) const {}
    __device__ __forceinline__ void publish(const f32x4 (&)[2][2][4][2], const Unit&, int, int) const {}
    __device__ __forceinline__ void consume(f32x4 (&)[2][2][4][2], const Unit&, int, int) const {}
};

template <int PART> struct PairOrder {
    static constexpr int SPLITK = PART;
    StaticOrder so; int R, rem, nt; bool paired;
    float* scratch; unsigned* flags; unsigned target;
    __device__ __forceinline__ void init(int M, int N, int K, int G_, int c_, float* scr, unsigned* fl, unsigned tgt) { so.init(M, N, G_, 0); so.c = 0; so.G = 1; R = so.nwg / G_; rem = so.nwg % G_; nt = K / BK;
        paired = (2 * rem == G_) && ((nt / 2) % 2 == 0); c = c_; G = G_; scratch = scr; flags = fl; target = tgt; }
    int c, G;
    __device__ __forceinline__ bool tile(int t, Unit& u) const { return so.next(t, u); }
    __device__ __forceinline__ bool next(int i, Unit& u) const {
        int t = -1, kt0 = 0, nk = nt, mode = 0, slot = 0;
        if (!paired) { if (PART == 1) { const long L = (long)i * G + c; if (L < so.nwg) t = (int)L; } }
        else if (PART == 1) {
            if (c < rem) { if (i == 0) { t = R * G + c; nk = nt / 2; mode = 1; slot = c; } else if (i <= R) t = (i - 1) * G + c; }
            else if (i < R) t = i * G + c;
        }
        else if (c >= rem && i == 0) { t = R * G + (c - rem); kt0 = nt / 2; nk = nt - nt / 2; mode = 2; slot = c - rem; }
        if (t < 0) return false;
        tile(t, u); u.kt0 = kt0; u.nkt = nk; u.mode = mode; u.slot = slot; return true;
    }
    __device__ __forceinline__ void a_ready(const Unit&) const {}
    __device__ __forceinline__ void done(const Unit&) const {}
    __device__ __forceinline__ void publish(const f32x4 (&acc)[2][2][4][2], const Unit& u, int wid, int lane) const {
        const __amdgpu_buffer_rsrc_t rs = __builtin_amdgcn_make_buffer_rsrc((void*)scratch, 0, 0x7fffffff, 0x00020000);
        const int so_ = __builtin_amdgcn_readfirstlane(u.slot * 262144 + wid * 32768), vo = lane * 16;
#pragma unroll
        for (int ai = 0; ai < 2; ++ai)
#pragma unroll
            for (int bj = 0; bj < 2; ++bj)
#pragma unroll
                for (int m = 0; m < 4; ++m)
#pragma unroll
                    for (int n = 0; n < 2; ++n) { const int r = ((ai * 2 + bj) * 4 + m) * 2 + n;
                        __builtin_amdgcn_raw_buffer_store_b128(__builtin_bit_cast(u32x4, acc[ai][bj][m][n]), rs, vo, so_ + r * 1024, 16); }
        asm volatile("s_waitcnt vmcnt(0)" ::: "memory");
        if (lane == 0) __hip_atomic_fetch_add(flags + 64 * u.slot, 1u, __ATOMIC_RELAXED, __HIP_MEMORY_SCOPE_AGENT);
    }
    __device__ __forceinline__ void consume(f32x4 (&acc)[2][2][4][2], const Unit& u, int wid, int lane) const {
        unsigned spins = 0;
        while ((unsigned)__builtin_amdgcn_readfirstlane((int)__hip_atomic_load(flags + 64 * u.slot, __ATOMIC_RELAXED, __HIP_MEMORY_SCOPE_AGENT)) < target) { __builtin_amdgcn_s_sleep(2); if (++spins > (1u << 22)) break; }
        __builtin_amdgcn_fence(__ATOMIC_ACQUIRE, "agent");
        asm volatile("s_waitcnt vmcnt(0)" ::: "memory");
        const __amdgpu_buffer_rsrc_t rs = __builtin_amdgcn_make_buffer_rsrc((void*)scratch, 0, 0x7fffffff, 0x00020000);
        const int so_ = __builtin_amdgcn_readfirstlane(u.slot * 262144 + wid * 32768), vo = lane * 16;
#pragma unroll
        for (int ai = 0; ai < 2; ++ai)
#pragma unroll
            for (int bj = 0; bj < 2; ++bj)
#pragma unroll
                for (int mh = 0; mh < 2; ++mh) {
                    f32x4 t[4];
#pragma unroll
                    for (int q = 0; q < 4; ++q) { const int m = mh * 2 + (q >> 1), n = q & 1; const int r = ((ai * 2 + bj) * 4 + m) * 2 + n; t[q] = __builtin_bit_cast(f32x4, __builtin_amdgcn_raw_buffer_load_b128(rs, vo, so_ + r * 1024, 16)); }
#pragma unroll
                    for (int q = 0; q < 4; ++q) { const int m = mh * 2 + (q >> 1), n = q & 1; acc[ai][bj][m][n] += t[q]; }
                    asm volatile("" ::: "memory");
                }
    }
};
__device__ __forceinline__ unsigned cvt_pk_bf16(float lo, float hi) { unsigned r; asm volatile("v_cvt_pk_bf16_f32 %0, %1, %2" : "=v"(r) : "v"(lo), "v"(hi)); return r; }
typedef float f32x2 __attribute__((ext_vector_type(2)));
#define EPI_LOOP_AIM _Pragma("unroll") for (int ai = 0; ai < 2; ++ai) _Pragma("unroll") for (int m = 0; m < 4; ++m)
#define EPI_LOOP_BJN _Pragma("unroll") for (int bj = 0; bj < 2; ++bj) _Pragma("unroll") for (int n = 0; n < 2; ++n)
struct EpiF32 {
    static constexpr bool PERM = false, AFTER_DRAIN = false;
    float* C; int ldc;
    __device__ __forceinline__ void operator()(const f32x4 (&acc)[2][2][4][2], const Unit& u, int wr, int wc, int fr, int fq) const {
        const int row0 = u.pm * BM + wr * 64 + fr, col0 = u.pn * BM + wc * 32 + 4 * fq;
        EPI_LOOP_AIM { float* rowp = C + (size_t)(row0 + ai * HALF + m * 16) * ldc + col0;
            EPI_LOOP_BJN *(f32x4*)(rowp + bj * HALF + n * 16) = acc[ai][bj][m][n]; }
    }
};
struct EpiBf16Plain {
    static constexpr bool PERM = true, AFTER_DRAIN = false;
    bf16_t* O; int ldc;
    __device__ __forceinline__ void operator()(const f32x4 (&acc)[2][2][4][2], const Unit& u, int wr, int wc, int fr, int fq) const {
        const int row0 = u.pm * BM + wr * 64 + fr, col0 = u.pn * BM + wc * 32 + 8 * fq;
        EPI_LOOP_AIM { bf16_t* rowp = O + (size_t)(row0 + ai * HALF + m * 16) * ldc + col0;
#pragma unroll
            for (int bj = 0; bj < 2; ++bj) { const f32x4 v0 = acc[ai][bj][m][0], v1 = acc[ai][bj][m][1];
                u32x4 w; w.x = cvt_pk_bf16(v0[0], v0[1]); w.y = cvt_pk_bf16(v0[2], v0[3]); w.z = cvt_pk_bf16(v1[0], v1[1]); w.w = cvt_pk_bf16(v1[2], v1[3]);
                *(u32x4*)(rowp + bj * HALF) = w; } }
    }
};
struct EpiSwiGLU {
    static constexpr bool PERM = true, AFTER_DRAIN = false;
    bf16_t* O; int ldc;
    __device__ __forceinline__ void operator()(const f32x4 (&acc)[2][2][4][2], const Unit& u, int wr, int wc, int fr, int fq) const {
        const int row0 = u.pm * BM + wr * 64 + fr, col0 = u.pn * HALF + wc * 32 + 8 * fq;
        EPI_LOOP_AIM { bf16_t* rowp = O + (size_t)(row0 + ai * HALF + m * 16) * ldc + col0;
            float o[8];
#pragma unroll
            for (int n = 0; n < 2; ++n)
#pragma unroll
                for (int i = 0; i < 4; ++i) { const float g = acc[ai][0][m][n][i], up = acc[ai][1][m][n][i]; o[n * 4 + i] = g * __builtin_amdgcn_rcpf(1.f + __expf(-g)) * up; }
            u32x4 w; w.x = cvt_pk_bf16(o[0], o[1]); w.y = cvt_pk_bf16(o[2], o[3]); w.z = cvt_pk_bf16(o[4], o[5]); w.w = cvt_pk_bf16(o[6], o[7]);
            *(u32x4*)rowp = w; }
    }
};
struct EpiRes {
    static constexpr bool PERM = false, AFTER_DRAIN = false;
    float* X; const float* gate; float coef;
    __device__ __forceinline__ void operator()(const f32x4 (&acc)[2][2][4][2], const Unit& u, int wr, int wc, int fr, int fq) const {
        const int row0 = u.pm * BM + wr * 64 + fr, col0 = u.pn * BM + wc * 32 + 4 * fq;
        const int rt = u.pm * BM; const int j = rt < 4096 ? 0 : 1 + ((rt - 4096) >> 12);
        const float* g = gate + j * 18432 + col0;
        f32x4 gv[2][2];
        EPI_LOOP_BJN gv[bj][n] = *(const f32x4*)(g + bj * HALF + n * 16) * coef;
        EPI_LOOP_AIM { float* rowp = X + (size_t)(row0 + ai * HALF + m * 16) * 2048 + col0;
            EPI_LOOP_BJN { f32x4 x = *(const f32x4*)(rowp + bj * HALF + n * 16); x += gv[bj][n] * acc[ai][bj][m][n]; *(f32x4*)(rowp + bj * HALF + n * 16) = x; }
            asm volatile("" ::: "memory"); }
    }
};
struct EpiZT {
    static constexpr bool PERM = false, AFTER_DRAIN = false;
    float* ZTp; float* ZTs;
    __device__ __forceinline__ void operator()(const f32x4 (&acc)[2][2][4][2], const Unit& u, int wr, int wc, int fr, int fq) const {
        const int ch0 = u.pm * BM + wr * 64 + fr, tok0 = u.pn * BM;
        float* base; int pitch, toff;
        if (tok0 < 4096) { base = ZTp + (size_t)(tok0 >> 8) * 6144 * 256; pitch = 256; toff = 0; }
        else { const int tk = tok0 - 4096; base = ZTs + (size_t)(tk >> 12) * 6144 * 4096; pitch = 4096; toff = tk & 4095; }
        const int c0 = toff + wc * 32 + 4 * fq;
        EPI_LOOP_AIM { float* rowp = base + (size_t)(ch0 + ai * HALF + m * 16) * pitch + c0;
            EPI_LOOP_BJN *(f32x4*)(rowp + bj * HALF + n * 16) = acc[ai][bj][m][n]; }
    }
};
struct EpiVT {
    static constexpr bool PERM = true, AFTER_DRAIN = false;
    bf16_t* VTp; size_t s_off;
    __device__ __forceinline__ void operator()(const f32x4 (&acc)[2][2][4][2], const Unit& u, int wr, int wc, int fr, int fq) const {
        const int ch0 = u.pm * BM + wr * 64 + fr, tok0 = u.pn * BM;
        bf16_t* base; int pitch, toff; bf16_t* VTs = VTp + s_off;
        if (tok0 < 4096) { base = VTp + (size_t)(tok0 >> 8) * 1024 * 256; pitch = 256; toff = 0; }
        else if (tok0 < 12288) { const int tk = tok0 - 4096; base = VTs + (size_t)(tk >> 12) * 1024 * 4352; pitch = 4352; toff = tk & 4095; }
        else { const int tk = tok0 - 12288; base = VTs + (size_t)(tk >> 8) * 1024 * 4352; pitch = 4352; toff = 4096; }
        const int c0 = toff + wc * 32 + 8 * fq;
        EPI_LOOP_AIM { bf16_t* rowp = base + (size_t)(ch0 + ai * HALF + m * 16) * pitch + c0;
#pragma unroll
            for (int bj = 0; bj < 2; ++bj) { const f32x4 v0 = acc[ai][bj][m][0], v1 = acc[ai][bj][m][1];
                u32x4 w; w.x = cvt_pk_bf16(v0[0], v0[1]); w.y = cvt_pk_bf16(v0[2], v0[3]); w.z = cvt_pk_bf16(v1[0], v1[1]); w.w = cvt_pk_bf16(v1[2], v1[3]);
                *(u32x4*)(rowp + bj * HALF) = w; } }
    }
};
struct EpiQ {
    static constexpr bool PERM = true, AFTER_DRAIN = false;
    bf16_t* Q; const float* rope; float qs;
    __device__ __forceinline__ void operator()(const f32x4 (&acc)[2][2][4][2], const Unit& u, int wr, int wc, int fr, int fq) const {
        const int row0 = u.pm * BM + wr * 64 + fr;
        EPI_LOOP_AIM { const int row = row0 + ai * HALF + m * 16; const bool smp = row >= 4096; const int t = (row - 4096) & 4095;
#pragma unroll
            for (int bj = 0; bj < 2; ++bj) { const int c0 = u.pn * BM + bj * HALF + wc * 32 + 8 * fq; const int within = c0 % 192;
                float o[8];
#pragma unroll
                for (int n = 0; n < 2; ++n)
#pragma unroll
                    for (int i = 0; i < 4; ++i) o[n * 4 + i] = acc[ai][bj][m][n][i];
                if (within >= 128 && smp) { const int ri = within - 128;
#pragma unroll
                    for (int q = 0; q < 4; ++q) { const int idx = ri + 2 * q, hf = idx >> 5, j = (idx & 31) >> 1; const int pos = hf ? (t & 63) : (t >> 6);
                        const float2 cs = *(const float2*)(rope + (pos * 16 + j) * 2); const float x1 = o[2 * q], x2 = o[2 * q + 1];
                        o[2 * q] = x1 * cs.x - x2 * cs.y; o[2 * q + 1] = x2 * cs.x + x1 * cs.y; } }
                u32x4 w; w.x = cvt_pk_bf16(o[0] * qs, o[1] * qs); w.y = cvt_pk_bf16(o[2] * qs, o[3] * qs); w.z = cvt_pk_bf16(o[4] * qs, o[5] * qs); w.w = cvt_pk_bf16(o[6] * qs, o[7] * qs);
                *(u32x4*)(Q + (size_t)row * 1536 + c0) = w; } }
    }
};
struct EpiLora {
    static constexpr bool PERM = false, AFTER_DRAIN = false;
    unsigned char* wsb; const float* w0; const float* a0; const float* ka; size_t off_sc, off_kb, off_gb;
    __device__ __forceinline__ void operator()(const f32x4 (&acc)[2][2][4][2], const Unit& u, int wr, int wc, int fr, int fq) const {
        const int row0 = u.pm * BM + wr * 64 + fr; const int seg = u.pn >> 2; const int cb = (u.pn & 3) * BM + wc * 32 + 4 * fq;
        float* SC = (float*)(wsb + off_sc); const float* KB = (const float*)(wsb + off_kb); float* GB = (float*)(wsb + off_gb);
        EPI_LOOP_AIM { const int row = row0 + ai * HALF + m * 16; float* sc = SC + (size_t)row * 9216;
            EPI_LOOP_BJN { const int c = cb + bj * HALF + n * 16; const f32x4 a = acc[ai][bj][m][n];
                if (seg < 2) { const f32x4 wv = *(const f32x4*)(w0 + seg * 1024 + c); f32x4 o;
#pragma unroll
                    for (int i = 0; i < 4; ++i) { const float x = wv[i] + a[i]; const float sp = __logf(1.f + __expf(-x)); o[i] = __expf(-__expf(-sp - 0.5f)); }
                    *(f32x4*)(sc + (3 + seg) * 1024 + c) = o; }
                else if (seg < 4) { const int d = seg - 2; const f32x4 av = *(const f32x4*)(a0 + d * 1024 + c), kav = *(const f32x4*)(ka + c);
                    const f32x4 kk = *(const f32x4*)(sc + 2 * 1024 + c), kr = *(const f32x4*)(KB + (size_t)row * 1024 + c); f32x4 o1, o2;
#pragma unroll
                    for (int i = 0; i < 4; ++i) { const float s = __builtin_amdgcn_rcpf(1.f + __expf(-(av[i] + a[i]))); o1[i] = kk[i] * s; o2[i] = kr[i] * (1.f + (s - 1.f) * kav[i]); }
                    *(f32x4*)(sc + (5 + d) * 1024 + c) = o1; *(f32x4*)(sc + (7 + d) * 1024 + c) = o2; }
                else *(f32x4*)(GB + (size_t)row * 1024 + c) = a; }
            asm volatile("" ::: "memory"); }
    }
};
template <class Epi, class Sched, bool ALIGN_EPI = false, bool SP2 = false>
__device__ __forceinline__ void gemm_phase(PG8_LAS unsigned char* lds, const Gemm g, const Sched& S, const Epi& E, int wave_id) {
    const int tid_l_ = wave_id * 64 + lane_id_v();
    const int tid = tid_l_, wid = __builtin_amdgcn_readfirstlane(tid >> 6), lane = tid & 63, wr = wid >> 2, wc = wid & 3, fr = lane & 15, fq = lane >> 4;
    const int K = g.K, nt = K / BK;
    unsigned voffA[2], voffB[2];
#pragma unroll
    for (int i = 0; i < 2; ++i) { int R, C; stage_rc(tid * 16 + i * 8192, R, C); const int Rb = Epi::PERM ? ((R & ~31) + perm32(R & 31)) : R;
        voffA[i] = (unsigned)(R * K + C) * 2u; voffB[i] = (unsigned)(Rb * K + C) * 2u; }
    const size_t kstep = (size_t)(BK * 2);
    const size_t hstep = (size_t)HALF * K * 2;
    const size_t tstep = 2 * hstep;
    const unsigned ldsw = (unsigned)wid * 1024u;
    const int aoff = lds_byte(wr * 64 + fr, fq * 8), boff = lds_byte(wc * 32 + fr, fq * 8);
#define PG8_SA(b, h) (((b) * 2 + (h)) * HTB)
#define PG8_SB(b, h) ((4 + (b) * 2 + (h)) * HTB)
#define PG8_STAGE(bufoff, gbase, voff) do { _Pragma("unroll") for (int _i = 0; _i < 2; ++_i) \
        __builtin_amdgcn_global_load_lds((const unsigned*)((const char*)(gbase) + (voff)[_i]), (PG8_LAS unsigned*)(lds + (bufoff) + ldsw + _i * 8192), 16, 0, 0); } while (0)
#define PG8_LDA(dst, b, h) do { _Pragma("unroll") for (int m = 0; m < 4; ++m) _Pragma("unroll") for (int k = 0; k < 2; ++k) dst[m][k] = *(const PG8_LAS bf16x8*)(lds + PG8_SA(b, h) + aoff + m * 2048 + k * 1024); } while (0)
#define PG8_LDB(dst, b, h) do { _Pragma("unroll") for (int n = 0; n < 2; ++n) _Pragma("unroll") for (int k = 0; k < 2; ++k) dst[n][k] = *(const PG8_LAS bf16x8*)(lds + PG8_SB(b, h) + boff + n * 2048 + k * 1024); } while (0)
#define PG8_MMA(ai, bj, At, Bt) do { __builtin_amdgcn_s_setprio(1); _Pragma("unroll") for (int m = 0; m < 4; ++m) _Pragma("unroll") for (int n = 0; n < 2; ++n) _Pragma("unroll") for (int k = 0; k < 2; ++k) \
        acc[ai][bj][m][n] = __builtin_amdgcn_mfma_f32_16x16x32_bf16(Bt[n][k], At[m][k], acc[ai][bj][m][n], 0, 0, 0); __builtin_amdgcn_s_setprio(0); } while (0)
#define PG8_WAIT_V(n) asm volatile("s_waitcnt vmcnt(" #n ")" ::: "memory")
#define PG8_WAIT_L(n) asm volatile("s_waitcnt lgkmcnt(" #n ")" ::: "memory")
#define PG8_BAR __builtin_amdgcn_s_barrier()
#define PG8_SCHED __builtin_amdgcn_sched_barrier(0)
    Unit cur, nxt; int ui = 0;
    if (!S.next(0, cur)) return;
    f32x4 acc[2][2][4][2];
#pragma unroll
    for (int a = 0; a < 2; ++a)
#pragma unroll
        for (int b = 0; b < 2; ++b)
#pragma unroll
            for (int m = 0; m < 4; ++m)
#pragma unroll
                for (int n = 0; n < 2; ++n) acc[a][b][m][n] = (f32x4){0.f, 0.f, 0.f, 0.f};
    bf16x8 At[4][2], B0[2][2], B1[2][2];
    const char* cA = (const char*)g.A + (size_t)cur.pm * tstep; const char* cB = (const char*)g.Bt + (size_t)cur.pn * tstep;
    if constexpr (Sched::SPLITK != 0) { cA += (size_t)cur.kt0 * kstep; cB += (size_t)cur.kt0 * kstep; }
    S.a_ready(cur);
    if constexpr (SP2) {
        PG8_STAGE(PG8_SB(0, 0), cB, voffB); PG8_STAGE(PG8_SB(0, 1), cB + hstep, voffB); PG8_STAGE(PG8_SA(0, 0), cA, voffA); PG8_STAGE(PG8_SA(0, 1), cA + hstep, voffA);
        if (wr == 1) PG8_BAR;
        PG8_WAIT_V(2); PG8_BAR;
        PG8_STAGE(PG8_SB(1, 0), cB + kstep, voffB); PG8_STAGE(PG8_SA(1, 0), cA + kstep, voffA); PG8_STAGE(PG8_SB(1, 1), cB + hstep + kstep, voffB);
        PG8_WAIT_V(6); PG8_BAR;
    } else {
        PG8_STAGE(PG8_SB(0, 0), cB, voffB); PG8_STAGE(PG8_SA(0, 0), cA, voffA); PG8_STAGE(PG8_SB(0, 1), cB + hstep, voffB); PG8_STAGE(PG8_SA(0, 1), cA + hstep, voffA);
        if (wr == 1) PG8_BAR;
        PG8_WAIT_V(4); PG8_BAR;
        PG8_STAGE(PG8_SB(1, 0), cB + kstep, voffB); PG8_STAGE(PG8_SA(1, 0), cA + kstep, voffA); PG8_STAGE(PG8_SB(1, 1), cB + hstep + kstep, voffB);
        PG8_WAIT_V(6); PG8_BAR;
    }
    for (;;) {
        const bool has_next = S.next(ui + 1, nxt);
        const char* nA = has_next ? (const char*)g.A + (size_t)nxt.pm * tstep : cA; const char* nB = has_next ? (const char*)g.Bt + (size_t)nxt.pn * tstep : cB;
        if constexpr (Sched::SPLITK != 0) { if (has_next) { nA += (size_t)nxt.kt0 * kstep; nB += (size_t)nxt.kt0 * kstep; } }
        const int cnt = Sched::SPLITK != 0 ? cur.nkt : nt;
        for (int t = 0; t < cnt; t += 2) {
            const bool last = (t == cnt - 2);
            const char* a1 = cA + (size_t)(t + 1) * kstep;
            const char* a2 = last ? nA : cA + (size_t)(t + 2) * kstep; const char* b2 = last ? nB : cB + (size_t)(t + 2) * kstep;
            const char* a3 = a2 + kstep; const char* b3 = b2 + kstep;
            if (last && has_next) S.a_ready(nxt);
            if constexpr (SP2) {
            PG8_LDB(B0, 0, 0); PG8_LDB(B1, 0, 1); PG8_SCHED; PG8_LDA(At, 0, 0); PG8_STAGE(PG8_SA(1, 1), a1 + hstep, voffA);
            PG8_WAIT_V(8); PG8_WAIT_L(0); PG8_BAR; PG8_MMA(0, 0, At, B0); PG8_MMA(0, 1, At, B1); PG8_BAR; PG8_SCHED;
            PG8_LDA(At, 0, 1); PG8_STAGE(PG8_SB(0, 0), b2, voffB); PG8_STAGE(PG8_SB(0, 1), b2 + hstep, voffB); PG8_STAGE(PG8_SA(0, 0), a2, voffA);
            PG8_WAIT_V(8); PG8_WAIT_L(0); PG8_BAR; PG8_MMA(1, 0, At, B0); PG8_MMA(1, 1, At, B1); PG8_BAR; PG8_SCHED;
            PG8_LDB(B0, 1, 0); PG8_LDB(B1, 1, 1); PG8_SCHED; PG8_LDA(At, 1, 0); PG8_STAGE(PG8_SA(0, 1), a2 + hstep, voffA);
            PG8_WAIT_V(8); PG8_WAIT_L(0); PG8_BAR; PG8_MMA(0, 0, At, B0); PG8_MMA(0, 1, At, B1); PG8_BAR; PG8_SCHED;
            PG8_LDA(At, 1, 1); PG8_STAGE(PG8_SB(1, 0), b3, voffB); PG8_STAGE(PG8_SB(1, 1), b3 + hstep, voffB); PG8_STAGE(PG8_SA(1, 0), a3, voffA);
            PG8_WAIT_V(8); PG8_WAIT_L(0); PG8_BAR; PG8_MMA(1, 0, At, B0); PG8_MMA(1, 1, At, B1); PG8_BAR; PG8_SCHED;
            } else {
            PG8_LDB(B0, 0, 0); PG8_SCHED; PG8_LDA(At, 0, 0); PG8_STAGE(PG8_SA(1, 1), a1 + hstep, voffA);
            PG8_WAIT_L(8); PG8_BAR; PG8_WAIT_L(0); PG8_MMA(0, 0, At, B0); PG8_BAR; PG8_SCHED;
            PG8_LDB(B1, 0, 1); PG8_STAGE(PG8_SB(0, 0), b2, voffB);
            PG8_BAR; PG8_WAIT_L(0); PG8_MMA(0, 1, At, B1); PG8_BAR;
            PG8_LDA(At, 0, 1); PG8_STAGE(PG8_SA(0, 0), a2, voffA);
            PG8_BAR; PG8_WAIT_L(0); PG8_MMA(1, 0, At, B0); PG8_BAR; PG8_SCHED;
            PG8_STAGE(PG8_SB(0, 1), b2 + hstep, voffB);
            PG8_WAIT_V(6); PG8_BAR; PG8_MMA(1, 1, At, B1); PG8_BAR;
            PG8_LDB(B0, 1, 0); PG8_SCHED; PG8_LDA(At, 1, 0); PG8_STAGE(PG8_SA(0, 1), a2 + hstep, voffA);
            PG8_WAIT_L(8); PG8_BAR; PG8_WAIT_L(0); PG8_MMA(0, 0, At, B0); PG8_BAR; PG8_SCHED;
            PG8_LDB(B1, 1, 1); PG8_STAGE(PG8_SB(1, 0), b3, voffB);
            PG8_BAR; PG8_WAIT_L(0); PG8_MMA(0, 1, At, B1); PG8_BAR;
            PG8_LDA(At, 1, 1); PG8_STAGE(PG8_SA(1, 0), a3, voffA);
            PG8_BAR; PG8_WAIT_L(0); PG8_MMA(1, 0, At, B0); PG8_BAR; PG8_SCHED;
            PG8_STAGE(PG8_SB(1, 1), b3 + hstep, voffB);
            PG8_WAIT_V(6); PG8_BAR; PG8_MMA(1, 1, At, B1); PG8_BAR;
            }
        }
        if constexpr (ALIGN_EPI) { if (wr == 0) PG8_BAR; }
        if constexpr (Sched::SPLITK == 1) { if (cur.mode == 1) S.publish(acc, cur, wid, lane); else E(acc, cur, wr, wc, fr, fq); S.done(cur); }
        else if constexpr (Sched::SPLITK == 2) { S.consume(acc, cur, wid, lane); E(acc, cur, wr, wc, fr, fq); S.done(cur); }
        else if constexpr (!Epi::AFTER_DRAIN) { E(acc, cur, wr, wc, fr, fq); S.done(cur); }
        if (!has_next) break;
#pragma unroll
        for (int a = 0; a < 2; ++a)
#pragma unroll
            for (int b = 0; b < 2; ++b)
#pragma unroll
                for (int m = 0; m < 4; ++m)
#pragma unroll
                    for (int n = 0; n < 2; ++n) acc[a][b][m][n] = (f32x4){0.f, 0.f, 0.f, 0.f};
        cur = nxt; cA = nA; cB = nB; ++ui;
        if constexpr (ALIGN_EPI) { if (wr == 1) PG8_BAR; }
    }
    PG8_WAIT_V(0);
    if constexpr (!ALIGN_EPI) { if (wr == 0) PG8_BAR; }
    PG8_BAR;
    if constexpr (Epi::AFTER_DRAIN) { E.fused(acc, cur, wr, wc, fr, fq, lds, wid, lane); S.done(cur); }
#undef PG8_SA
#undef PG8_SB
#undef PG8_STAGE
#undef PG8_LDA
#undef PG8_LDB
#undef PG8_MMA
#undef PG8_WAIT_V
#undef PG8_WAIT_L
#undef PG8_BAR
#undef PG8_SCHED
}
}
#define XB_TMO      128
#define XB_XCNT(j)  (256  + 64 * (j))
#define XB_XSUB(j)  (1280 + 64 * (j))
#define XB_XGEN(j)  (2304 + 64 * (j))
#define XB_TOP      3328
#define XB_TOPGEN   3392
#define XCD_BAR_WORDS 3456
#define XB_SPIN_CAP (1u << 18)

__device__ __forceinline__ unsigned xb_ld(unsigned* p)              { return __hip_atomic_load(p, __ATOMIC_RELAXED, __HIP_MEMORY_SCOPE_AGENT); }
__device__ __forceinline__ unsigned xb_add(unsigned* p, unsigned v) { return __hip_atomic_fetch_add(p, v, __ATOMIC_RELAXED, __HIP_MEMORY_SCOPE_AGENT); }
__device__ __forceinline__ unsigned xb_xcc_id() { return (unsigned)__builtin_amdgcn_s_getreg((3 << 11) | 20) & 0xFu; }
#define XB_SPIN(cond, bar) do { unsigned _sp = 0; while (cond) { __builtin_amdgcn_s_sleep(1); \
    if ((++_sp & 255u) == 0u) { if (xb_ld(&(bar)[XB_TMO])) break; if (_sp > XB_SPIN_CAP) { atomicAdd(&(bar)[XB_TMO], 1u); break; } } } } while (0)

struct XcdBarrier {
    unsigned* bar; unsigned x;
    volatile LAS unsigned* st;
};

__device__ __forceinline__ XcdBarrier xcd_barrier_post(unsigned* bar, volatile LAS unsigned* st, int tid_) {
    XcdBarrier b; b.bar = bar; b.x = xb_xcc_id(); b.st = st;
    if (tid_ == 0) (void)xb_add(&bar[XB_XCNT(b.x)], 1u);
    return b;
}
__device__ __forceinline__ void xcd_barrier_complete(unsigned* bar, unsigned x, unsigned& nloc, unsigned& nx) {
    const unsigned G = gridDim.x * gridDim.y * gridDim.z;
    unsigned sum, cnt, mine, sp = 0u;
    for (;;) {
        sum = 0u; cnt = 0u; mine = 0u;
#pragma unroll
        for (unsigned j = 0; j < 16; ++j) { const unsigned c = xb_ld(&bar[XB_XCNT(j)]); sum += c; cnt += (c > 0u) ? 1u : 0u; mine = (j == x) ? c : mine; }
        if (sum == G) break;
        __builtin_amdgcn_s_sleep(1);
        if ((++sp & 255u) == 0u) { if (xb_ld(&bar[XB_TMO])) break; if (sp > XB_SPIN_CAP) { atomicAdd(&bar[XB_TMO], 1u); break; } }
    }
    nloc = mine > 0u ? mine : 1u; nx = cnt > 0u ? cnt : 1u;
}

__device__ __forceinline__ void xcd_barrier(const XcdBarrier& b, int tid_) {
    asm volatile("s_waitcnt vmcnt(0)" ::: "memory");
    __syncthreads();
    if (tid_ == 0) {
        unsigned* bar = b.bar;
        __builtin_amdgcn_s_waitcnt(0);
        unsigned nloc = b.st[0], nx = b.st[1];
        if (nloc == 0u) { xcd_barrier_complete(bar, b.x, nloc, nx); b.st[0] = nloc; b.st[1] = nx; }
        const unsigned old = xb_add(&bar[XB_XSUB(b.x)], 1u);
        const unsigned gen = old / nloc;
        if (old + 1u == (gen + 1u) * nloc) {
            __builtin_amdgcn_fence(__ATOMIC_RELEASE, "agent");
            asm volatile("s_waitcnt vmcnt(0)" ::: "memory");
            const unsigned og = xb_add(&bar[XB_TOP], 1u);
            const unsigned tg = og / nx;
            if (og + 1u == (tg + 1u) * nx) xb_add(&bar[XB_TOPGEN], 1u);
            else XB_SPIN(xb_ld(&bar[XB_TOPGEN]) == tg, bar);
            __builtin_amdgcn_fence(__ATOMIC_ACQUIRE, "agent");
            xb_add(&bar[XB_XGEN(b.x)], 1u);
            asm volatile("s_waitcnt vmcnt(0)" ::: "memory");
        } else {
            XB_SPIN(xb_ld(&bar[XB_XGEN(b.x)]) == gen, bar);
            __builtin_amdgcn_fence(__ATOMIC_ACQUIRE, "agent");
            asm volatile("s_waitcnt vmcnt(0)" ::: "memory");
        }
    }
    __syncthreads();
}

constexpr size_t MiB = 1u << 20;
constexpr size_t WS_CTL = 0, CTL_ZERO_BYTES = 2 * MiB;
constexpr size_t WS_MOD = 2 * MiB;
constexpr size_t WS_PMOD = WS_MOD + 2 * MiB;
constexpr size_t WS_ROPE = WS_PMOD + 8 * MiB;
constexpr size_t WS_W1T = WS_ROPE + 2 * MiB;
constexpr size_t WS_W2T = WS_W1T + 352 * MiB;
constexpr size_t WS_WINE = WS_W2T + 176 * MiB;
constexpr size_t WS_WOUTE = WS_WINE + 34 * MiB;
constexpr size_t WS_WINO = WS_WOUTE + 16 * MiB;
constexpr size_t WS_WOUTO = WS_WINO + 48 * MiB;
constexpr size_t WS_WQ = WS_WOUTO + 16 * MiB;
constexpr size_t WS_WKN = WS_WQ + 4 * MiB;
constexpr size_t WS_WV = WS_WKN + 2 * MiB;
constexpr size_t WS_WLORA = WS_WV + 2 * MiB;
constexpr size_t WS_W3T = WS_WLORA + 8 * MiB;
constexpr size_t WS_H2 = WS_W3T + 8 * MiB;
constexpr size_t WS_X = WS_H2 + 4 * MiB;
constexpr size_t WS_H = WS_X + 96 * MiB;
constexpr size_t WS_ACT = WS_H + 48 * MiB;
constexpr size_t WS_Z = WS_ACT + 132 * MiB;
constexpr size_t WS_SCAN = WS_Z + 288 * MiB;
constexpr size_t SCAN_BYTES = 432 * MiB;
constexpr size_t WS_KBUF = WS_SCAN + 2 * SCAN_BYTES;
constexpr size_t WS_LA = WS_KBUF + 48 * MiB;
constexpr size_t WS_GB = WS_LA + 10 * MiB;
constexpr size_t WS_CQ = WS_GB + 48 * MiB;
constexpr size_t WS_CKV = WS_CQ + 12 * MiB;
constexpr size_t WS_KR = WS_CKV + 8 * MiB;
constexpr size_t WS_Q = WS_KR + 2 * MiB;
constexpr size_t WS_KN = WS_Q + 36 * MiB;
constexpr size_t WS_VT = WS_KN + 26 * MiB;
constexpr size_t WS_YSC = WS_VT + 26 * MiB;
constexpr size_t WS_PQ = WS_ACT;
constexpr size_t WS_SST = WS_ACT + 64 * MiB;
constexpr size_t WS_PST = WS_ACT + 96 * MiB;
constexpr size_t WS_MIX = WS_YSC + 96 * MiB;
constexpr size_t WS_KSS = WS_MIX + 48 * MiB;
constexpr size_t WS_KSP = WS_KSS + 258 * MiB;
constexpr size_t WS_END = WS_KSP + 18 * MiB;
static_assert((size_t)NCH * 64 * 2 * 16384 <= 64 * MiB && (size_t)NCH * 64 * 16384 <= 32 * MiB, "PQ / SST inside the ACT region");
constexpr size_t ZT_S_OFF = (size_t)16 * 6144 * 256 * 4;
constexpr size_t VT_S_OFF = (size_t)16 * 1024 * 256 * 2;

constexpr size_t OUT_YS = (size_t)MP * D, OUT_CKV = (size_t)MT * D, OUT_KR = OUT_CKV + 16 * 2 * 256 * 256, OUT_ST = OUT_KR + 16 * 2 * 256 * 64, OUT_END = OUT_ST + (size_t)16 * 2 * 2 * 16 * 64 * 64;

constexpr int LDS_RING = 131072, LDS_BYTES = 147456, LDS_CTL = LDS_BYTES - 512;

struct KArgs { const float* in[42]; float* out; unsigned char* ws; int ph_lo, ph_hi; };
enum { I_XP = 0, I_XS, I_CCKV, I_CKR, I_ST, I_C, I_CCTX, I_WMOD, I_BMOD, I_NG, I_WFI, I_WFO, I_FNG, I_WINE, I_MUP, I_MUN, I_W0, I_W2, I_A0, I_A2, I_G2, I_KK, I_KA, I_RK, I_GNW, I_GNB,
       I_QN, I_KVN, I_WQB, I_WKVB, I_WOE, I_WINO, I_CW, I_CB, I_FW1, I_FB1, I_FW2, I_FB2, I_FW3, I_FFR, I_HB, I_WOO };

struct Ctx {
    LAS unsigned char* lds; unsigned char* ws; const float* const* in; float* out;
    int tid, lane, wave, G, gw, NGW, vb, bx, zs;
};

DI void tr_item(const float* W, int ldw, int K, bf16* WT, int dstrow0, int srccol0, int k0, LAS float* scr, int lane) {
    float v[32];
#pragma unroll
    for (int i = 0; i < 32; ++i) v[i] = W[(size_t)(k0 + 2 * i + (lane >> 5)) * ldw + srccol0 + (lane & 31)];
#pragma unroll
    for (int i = 0; i < 32; ++i) scr[(2 * i + (lane >> 5)) * 33 + (lane & 31)] = v[i];
    asm volatile("s_waitcnt lgkmcnt(0)" ::: "memory");
    const int c = lane & 7;
#pragma unroll
    for (int j = 0; j < 4; ++j) { const int n = (lane >> 3) + 8 * j; const LAS float* s = scr + (8 * c) * 33 + n;
        v4u o; o.x = pk2(s[0 * 33], s[1 * 33]); o.y = pk2(s[2 * 33], s[3 * 33]); o.z = pk2(s[4 * 33], s[5 * 33]); o.w = pk2(s[6 * 33], s[7 * 33]);
        *(v4u*)(WT + (size_t)(dstrow0 + n) * K + k0 + 8 * c) = o; }
    asm volatile("s_waitcnt lgkmcnt(0)" ::: "memory");
}
template <int MODE> DI void tr_matrix(Ctx& C, const float* W, int ldw, int K, bf16* WT, int ndst, int nsrc, int gw, int NGW) {
    LAS float* scr = (LAS float*)(C.lds + C.wave * 8704);
    const int nkb = K / 64, nnb = ndst / 32, nit = nkb * nnb;
    for (int it = gw; it < nit; it += NGW) {
        const int kb = it / nnb, nb = it % nnb, dr = nb * 32;
        int sc = dr;
        if (MODE == 1) { const int p = dr >> 8, sg = (dr >> 7) & 1, j = dr & 127; sc = sg * 5632 + 128 * p + j; }
        if (MODE == 2 && dr >= nsrc) {
            const int c = C.lane & 7;
#pragma unroll
            for (int j = 0; j < 4; ++j) { const int n = (C.lane >> 3) + 8 * j; *(v4u*)(WT + (size_t)(dr + n) * K + kb * 64 + 8 * c) = (v4u){0u, 0u, 0u, 0u}; }
            continue;
        }
        tr_item(W, ldw, K, WT, dr, sc, kb * 64, scr, C.lane);
    }
}
template <class Fn> DI void cvt_small(Ctx& C, bf16* dst, int N, int K, Fn f) {
    const int total = N * (K / 8);
    for (int idx = C.bx * 512 + C.tid; idx < total; idx += C.G * 512) {
        const int n = idx % N, k8 = idx / N; float v[8];
#pragma unroll
        for (int i = 0; i < 8; ++i) v[i] = f(n, k8 * 8 + i);
        v4u o; o.x = pk2(v[0], v[1]); o.y = pk2(v[2], v[3]); o.z = pk2(v[4], v[5]); o.w = pk2(v[6], v[7]);
        *(v4u*)(dst + (size_t)n * K + k8 * 8) = o;
    }
}

DI void phase_prologue(Ctx& C) {
    const float* const* in = C.in; unsigned char* ws = C.ws;
    tr_matrix<1>(C, in[I_WFI], NFF1, 2048, (bf16*)(ws + WS_W1T), NFF1, NFF1, C.gw, C.NGW);
    tr_matrix<0>(C, in[I_WFO], 2048, DFF, (bf16*)(ws + WS_W2T), 2048, 2048, C.gw, C.NGW);
    for (int i = 0; i < 2; ++i) tr_matrix<2>(C, in[I_WINE] + (size_t)i * 2048 * ZE_N, ZE_N, 2048, (bf16*)(ws + WS_WINE) + (size_t)i * ZE_P * 2048, ZE_P, ZE_N, C.gw, C.NGW);
    for (int i = 0; i < 2; ++i) tr_matrix<0>(C, in[I_WOE] + (size_t)i * 2048 * 2048, 2048, 2048, (bf16*)(ws + WS_WOUTE) + (size_t)i * 2048 * 2048, 2048, 2048, C.gw, C.NGW);
    for (int i = 0; i < 2; ++i) tr_matrix<0>(C, in[I_WINO] + (size_t)i * 2048 * 6144, 6144, 2048, (bf16*)(ws + WS_WINO) + (size_t)i * 6144 * 2048, 6144, 6144, C.gw, C.NGW);
    for (int i = 0; i < 2; ++i) tr_matrix<0>(C, in[I_WOO] + (size_t)i * 2048 * 2048, 2048, 2048, (bf16*)(ws + WS_WOUTO) + (size_t)i * 2048 * 2048, 2048, 2048, C.gw, C.NGW);
    for (int e = 0; e < 2; ++e) {
        const float* wqb = in[I_WQB] + (size_t)e * 512 * 1536;
        cvt_small(C, (bf16*)(ws + WS_WQ) + (size_t)e * 1536 * 512, 1536, 512, [=](int n, int k) { const int hd = n / 192, wi = n % 192; int sc;
            if (wi < 128) sc = wi; else { const int idx = wi - 128, hf = idx >> 5, r = idx & 31; sc = 128 + 32 * hf + 16 * (r & 1) + (r >> 1); }
            return wqb[(size_t)k * 1536 + hd * 192 + sc]; });
        const float* wkv = in[I_WKVB] + (size_t)e * 256 * 2048;
        cvt_small(C, (bf16*)(ws + WS_WKN) + (size_t)e * 1024 * 256, 1024, 256, [=](int n, int k) { return wkv[(size_t)k * 2048 + (n >> 7) * 256 + (n & 127)]; });
        cvt_small(C, (bf16*)(ws + WS_WV) + (size_t)e * 1024 * 256, 1024, 256, [=](int n, int k) { return wkv[(size_t)k * 2048 + (n >> 7) * 256 + 128 + (n & 127)]; });
        const float* w2 = in[I_W2] + (size_t)e * 2 * 64 * 1024; const float* a2 = in[I_A2] + (size_t)e * 2 * 64 * 1024; const float* g2 = in[I_G2] + (size_t)e * 160 * 1024;
        cvt_small(C, (bf16*)(ws + WS_WLORA) + (size_t)e * 5120 * 384, 5120, 384, [=](int n, int k) { const int seg = n >> 10, c = n & 1023; float v = 0.f;
            if (seg < 2) { if (k < 64) v = w2[((size_t)seg * 64 + k) * 1024 + c]; }
            else if (seg < 4) { if (k >= 64 && k < 128) v = a2[((size_t)(seg - 2) * 64 + (k - 64)) * 1024 + c]; }
            else { if (k >= 128 && k < 288) v = g2[(size_t)(k - 128) * 1024 + c]; }
            return v; });
    }
    { const float* w3 = in[I_FW3];
      cvt_small(C, (bf16*)(ws + WS_W3T), 16384, 256, [=](int n, int k) { const int o = n >> 13, col = n & 8191; float v = 0.f; if ((k >> 6) == o) v = w3[((size_t)o * 64 + (k & 63)) * 8192 + col]; return v; }); }
    { LAS float* sl = (LAS float*)(C.lds + 8 * 8704);
      for (int it = C.bx; it < 4 * 8 * 9; it += C.G) {
          const int l = it / 72, kc = (it / 9) % 8, cc = it % 9;
          __syncthreads();
          for (int i = C.tid; i < 768; i += 512) { const int j = i >> 8, k = kc * 256 + (i & 255); const float cv = j == 0 ? in[I_CCTX][k] : in[I_C][(j - 1) * 2048 + k]; sl[i] = silu_f(cv); }
          __syncthreads();
          const int col = cc * 2048 + 4 * C.tid; const float* wp = in[I_WMOD] + ((size_t)l * 2048 + kc * 256) * 18432 + col;
          f32x4v a0 = {0.f, 0.f, 0.f, 0.f}, a1 = a0, a2 = a0;
#pragma unroll 4
          for (int k = 0; k < 256; ++k) { const f32x4v w = *(const f32x4v*)(wp + (size_t)k * 18432); a0 += w * sl[k]; a1 += w * sl[256 + k]; a2 += w * sl[512 + k]; }
          float* pm = (float*)(ws + WS_PMOD) + ((size_t)(kc * 4 + l) * 3) * 18432 + col;
          *(f32x4v*)(pm) = a0; *(f32x4v*)(pm + 18432) = a1; *(f32x4v*)(pm + 2 * 18432) = a2;
      }
      __syncthreads(); }
    { const f32x4v* s0 = (const f32x4v*)in[I_XP]; const f32x4v* s1 = (const f32x4v*)in[I_XS]; f32x4v* x = (f32x4v*)(ws + WS_X);
      const size_t n0 = (size_t)MP * D / 4, n1 = (size_t)MS * D / 4;
      for (size_t i = (size_t)C.bx * 512 + C.tid; i < n0 + n1; i += (size_t)C.G * 512) x[i] = i < n0 ? s0[i] : s1[i - n0]; }
    if (C.bx == 0) for (int i = C.tid; i < 1024; i += 512) { const int pos = i >> 4, j = i & 15; const float inv = 1.0f / powf(10000.0f, (float)(2 * j) / 32.0f); const float a = (float)pos * inv;
        float* r = (float*)(ws + WS_ROPE) + i * 2; r[0] = cosf(a); r[1] = sinf(a); }
    { bf16* H2 = (bf16*)(ws + WS_H2);
      for (int it = C.gw; it < 2 * 4352; it += C.NGW) {
          const int o = it / 4352, rr = it % 4352; const int L = rr < 256 ? 256 : 4096, t = rr < 256 ? rr : rr - 256; const int lane = C.lane;
          float zf = 0.f;
          if (lane == 0) zf = (float)t / (float)(L - 1);
          else if (lane < 33) { const int b = (lane - 1) & 15; const float fr = 1e-4f + (15.0f - 1e-4f) * ((float)b / 15.0f); const float ang = ((float)(2.0 * 3.14159265358979323846 / (double)L) * (float)t) * fr; zf = lane < 17 ? cosf(ang) : -sinf(ang); }
          const float* w1 = in[I_FW1] + (size_t)o * 33 * 64; const float* w2 = in[I_FW2] + (size_t)o * 64 * 64;
          float s = in[I_FB1][o * 64 + lane];
          for (int i = 0; i < 33; ++i) s += shfl_idx(zf, i) * w1[i * 64 + lane];
          const float h1 = sinf(in[I_FFR][(o * 2 + 0) * 64 + lane] * s);
          float s2 = in[I_FB2][o * 64 + lane];
          for (int i = 0; i < 64; ++i) s2 += shfl_idx(h1, i) * w2[i * 64 + lane];
          const float h2 = sinf(in[I_FFR][(o * 2 + 1) * 64 + lane] * s2);
          H2[(size_t)rr * 256 + o * 64 + lane] = (bf16)f2bf(h2);
          if (o == 0) { H2[(size_t)rr * 256 + 128 + lane] = 0; H2[(size_t)rr * 256 + 192 + lane] = 0; }
      } }
}
DI void phase_mod_reduce(Ctx& C) {
    const float* pm = (const float*)(C.ws + WS_PMOD); float* mod = (float*)(C.ws + WS_MOD); const float* bm = C.in[I_BMOD];
    for (int i = C.bx * 512 + C.tid; i < 4 * 3 * 18432; i += C.G * 512) { const int l = i / MODL, n = i % 18432; float s = bm[l * 18432 + n];
#pragma unroll
        for (int kc = 0; kc < 8; ++kc) s += pm[(size_t)kc * 4 * MODL + i];
        mod[i] = s; }
}
DI void phase_norm_mod(Ctx& C, const float* g, const float* modl, int s) {
    const float* X = (const float*)(C.ws + WS_X); bf16* H = (bf16*)(C.ws + WS_H);
    for (int row = C.gw; row < MT; row += C.NGW) {
        const float* sh = modl + row_mod_j(row) * 18432 + (3 * s) * 2048; const float* scl = sh + 2048;
        const f32x4v* xr = (const f32x4v*)(X + (size_t)row * D) + C.lane; f32x4v v[8]; float ss = 0.f;
#pragma unroll
        for (int i = 0; i < 8; ++i) { v[i] = xr[64 * i]; ss += (v[i].x * v[i].x + v[i].y * v[i].y) + (v[i].z * v[i].z + v[i].w * v[i].w); }
        const float rstd = 1.0f / sqrtf(wave_sum(ss) * (1.0f / D) + 1e-6f);
        v2u* o = (v2u*)(H + (size_t)row * D) + C.lane;
#pragma unroll
        for (int i = 0; i < 8; ++i) { const int c = 4 * C.lane + 256 * i; const f32x4v gg = *(const f32x4v*)(g + c), sc = *(const f32x4v*)(scl + c), sf = *(const f32x4v*)(sh + c);
            const f32x4v y = (v[i] * rstd * gg) * (sc + 1.0f) + sf; v2u w; w.x = pk2(y.x, y.y); w.y = pk2(y.z, y.w); o[64 * i] = w; }
    }
}
DI void phase_final_norm(Ctx& C) {
    const float* X = (const float*)(C.ws + WS_X); const float* g = C.in[I_FNG];
    for (int row = C.gw; row < MT; row += C.NGW) {
        const f32x4v* xr = (const f32x4v*)(X + (size_t)row * D) + C.lane; f32x4v v[8]; float ss = 0.f;
#pragma unroll
        for (int i = 0; i < 8; ++i) { v[i] = xr[64 * i]; ss += (v[i].x * v[i].x + v[i].y * v[i].y) + (v[i].z * v[i].z + v[i].w * v[i].w); }
        const float rstd = 1.0f / sqrtf(wave_sum(ss) * (1.0f / D) + 1e-6f);
        f32x4v* o = (f32x4v*)(C.out + (size_t)row * D) + C.lane;
#pragma unroll
        for (int i = 0; i < 8; ++i) { const f32x4v gg = *(const f32x4v*)(g + 4 * C.lane + 256 * i); o[64 * i] = v[i] * rstd * gg; }
    }
}

DI int rope_src(int p) { const int hf = p >> 5, r = p & 31; return 32 * hf + 16 * (r & 1) + (r >> 1); }
DI void phase_even_prep(Ctx& C, int e) {
    const float* const* in = C.in; unsigned char* ws = C.ws; const int lane = C.lane;
    const float* Z = (const float*)(ws + WS_Z); float* SC = (float*)(ws + WS_SCAN + (size_t)e * SCAN_BYTES); float* KB = (float*)(ws + WS_KBUF); bf16* LA = (bf16*)(ws + WS_LA);
    bf16* CQ = (bf16*)(ws + WS_CQ); bf16* CKV = (bf16*)(ws + WS_CKV); bf16* KR = (bf16*)(ws + WS_KR); const float* rope = (const float*)(ws + WS_ROPE);
    const float* mup = in[I_MUP] + e * 3360; const float* mun = in[I_MUN] + e * 3360; const float* kkw = in[I_KK] + e * 1024;
    const float* qn = in[I_QN] + e * 512; const float* kvn = in[I_KVN] + e * 256;
    for (int row = C.gw; row < MKV; row += C.NGW) {
        if (row >= MT) {
            const int rr = row - MT, b = rr >> 8, p = rr & 255;
            const float* cs = in[I_CCKV] + ((size_t)(b * 2 + e) * 256 + p) * 256;
#pragma unroll
            for (int i = 0; i < 4; ++i) CKV[(size_t)row * 256 + 64 * i + lane] = (bf16)f2bf(cs[64 * i + lane]);
            KR[(size_t)row * 64 + lane] = (bf16)f2bf(in[I_CKR][((size_t)(b * 2 + e) * 256 + p) * 64 + rope_src(lane)]);
            continue;
        }
        const bool smp = row >= MP; const int T = smp ? 4096 : 256; const int t = smp ? ((row - MP) & 4095) : (row & 255);
        const float* z = Z + (size_t)row * ZE_P; const bool hp = t > 0, hn = t < T - 1;
        float* sc = SC + (size_t)row * SCAN_P;
#define ZMIX4(c) ({ const f32x4v zc_ = *(const f32x4v*)(z + (c)); const f32x4v zp_ = hp ? *(const f32x4v*)(z + (c) - ZE_P) : (f32x4v){0.f, 0.f, 0.f, 0.f}; const f32x4v zn_ = hn ? *(const f32x4v*)(z + (c) + ZE_P) : (f32x4v){0.f, 0.f, 0.f, 0.f}; \
            zc_ + *(const f32x4v*)(mup + (c)) * (zp_ - zc_) + *(const f32x4v*)(mun + (c)) * (zn_ - zc_); })
#define ZMIX(c) ({ const float zc_ = z[c]; const float zp_ = hp ? z[(c) - ZE_P] : 0.f; const float zn_ = hn ? z[(c) + ZE_P] : 0.f; zc_ + mup[c] * (zp_ - zc_) + mun[c] * (zn_ - zc_); })
#pragma unroll
        for (int i = 0; i < 4; ++i) { const int c = 256 * i + 4 * lane;
            *(f32x4v*)(sc + c) = ZMIX4(c);
            *(f32x4v*)(sc + 1024 + c) = ZMIX4(2048 + c);
            const f32x4v k = ZMIX4(1024 + c); *(f32x4v*)(KB + (size_t)row * 1024 + c) = k;
            const f32x4v kk = k * *(const f32x4v*)(kkw + c); float ss = (kk.x * kk.x + kk.y * kk.y) + (kk.z * kk.z + kk.w * kk.w);
            ss += dpp_f<0xB1>(ss); ss += dpp_f<0x4E>(ss); ss += dpp_f<0x141>(ss); ss += dpp_f<0x140>(ss);
            *(f32x4v*)(sc + 2048 + c) = kk * (1.0f / fmaxf(sqrtf(ss), 1e-12f)); }
        bf16* la = LA + (size_t)row * 384;
        la[lane] = (bf16)f2bf(tanhf(ZMIX(3072 + lane)));
        la[64 + lane] = (bf16)f2bf(ZMIX(3136 + lane));
        la[128 + lane] = (bf16)f2bf(sigmoid_f(ZMIX(3200 + lane)));
        la[192 + lane] = (bf16)f2bf(sigmoid_f(ZMIX(3264 + lane)));
        { float xg = 0.f; if (lane < 32) xg = sigmoid_f(ZMIX(3328 + lane)); la[256 + lane] = (bf16)(lane < 32 ? f2bf(xg) : 0u); la[320 + lane] = 0; }
#undef ZMIX4
#undef ZMIX
        float cq[8], ss = 0.f;
#pragma unroll
        for (int i = 0; i < 8; ++i) { cq[i] = z[3360 + 64 * i + lane]; ss += cq[i] * cq[i]; }
        float rstd = 1.0f / sqrtf(wave_sum(ss) * (1.0f / 512.0f) + 1e-6f);
#pragma unroll
        for (int i = 0; i < 8; ++i) CQ[(size_t)row * 512 + 64 * i + lane] = (bf16)f2bf(cq[i] * rstd * qn[64 * i + lane]);
        float ck[4]; ss = 0.f;
#pragma unroll
        for (int i = 0; i < 4; ++i) { ck[i] = z[3872 + 64 * i + lane]; ss += ck[i] * ck[i]; }
        rstd = 1.0f / sqrtf(wave_sum(ss) * (1.0f / 256.0f) + 1e-6f);
#pragma unroll
        for (int i = 0; i < 4; ++i) { const float y = ck[i] * rstd * kvn[64 * i + lane]; CKV[(size_t)row * 256 + 64 * i + lane] = (bf16)f2bf(y);
            if (!smp) C.out[OUT_CKV + ((size_t)((row >> 8) * 2 + e) * 256 + t) * 256 + 64 * i + lane] = y; }
        const float kr = z[4128 + lane];
        if (!smp) { C.out[OUT_KR + ((size_t)((row >> 8) * 2 + e) * 256 + t) * 64 + lane] = kr; KR[(size_t)row * 64 + lane] = (bf16)f2bf(shfl_idx(kr, rope_src(lane))); }
        else { const int hf = lane >> 5, jj = lane & 15, e2 = (lane >> 4) & 1; const int pos = hf ? (t & 63) : (t >> 6);
            const float xo = shfl_idx(kr, lane ^ 16); const float2 cs = *(const float2*)(rope + (pos * 16 + jj) * 2);
            const float rot = e2 == 0 ? kr * cs.x - xo * cs.y : kr * cs.x + xo * cs.y;
            KR[(size_t)row * 64 + lane] = (bf16)f2bf(shfl_idx(rot, rope_src(lane))); }
    }
}

template <int N> DI float fmac_bc(float acc, float op, float s) { asm("v_fmac_f32_dpp %0, %1, %2 row_newbcast:%3 row_mask:0xf bank_mask:0xf" : "+v"(acc) : "v"(op), "v"(s), "n"(N)); return acc; }
template <int N> DI float mul_bc(float op, float s) { float r; asm("v_mul_f32_dpp %0, %1, %2 row_newbcast:%3 row_mask:0xf bank_mask:0xf" : "=v"(r) : "v"(op), "v"(s), "n"(N)); return r; }
struct ScanOps { f32x4v kk, w, kka, kd, r; float vv; };
typedef __attribute__((__vector_size__(4 * sizeof(int)))) int rsrc_t;
DI f32x4v bl128(__amdgpu_buffer_rsrc_t r, unsigned vo, unsigned so) { return __builtin_bit_cast(f32x4v, __builtin_amdgcn_raw_buffer_load_b128(r, (int)vo, (int)so, 0)); }
DI float bl32(__amdgpu_buffer_rsrc_t r, unsigned vo, unsigned so) { return __builtin_bit_cast(float, __builtin_amdgcn_raw_buffer_load_b32(r, (int)vo, (int)so, 0)); }
template <int MODE> DI ScanOps scan_load(__amdgpu_buffer_rsrc_t rs, unsigned so, unsigned lo, unsigned lv, int d) {
    ScanOps o;
    o.kk = bl128(rs, lo + 2u * 4096u, so); o.w = bl128(rs, lo + (3u + (unsigned)d) * 4096u, so); o.kka = bl128(rs, lo + (5u + (unsigned)d) * 4096u, so);
    if (MODE != 0) { o.kd = bl128(rs, lo + (7u + (unsigned)d) * 4096u, so); o.vv = bl32(rs, lv + 4096u, so); } else { o.kd = (f32x4v){0.f, 0.f, 0.f, 0.f}; o.vv = 0.f; }
    if (MODE == 2) o.r = bl128(rs, lo, so); else o.r = (f32x4v){0.f, 0.f, 0.f, 0.f};
    return o;
}
template <int MODE, int J> DI void scan_col_a(const ScanOps& o, const float (&S)[64], float (&sa)[4]) { sa[J & 3] = fmac_bc<(J >> 2)>(sa[J & 3], o.kk[J & 3], S[J]); }
template <int MODE, int J> DI void scan_col_b(const ScanOps& o, float (&S)[64], float sa, float (&y)[4]) {
    float t = mul_bc<(J >> 2)>(o.w[J & 3], S[J]);
    t = fmac_bc<(J >> 2)>(t, o.kka[J & 3], sa);
    if (MODE != 0) t = fmac_bc<(J >> 2)>(t, o.kd[J & 3], o.vv);
    S[J] = t;
    if (MODE == 2) y[J & 3] = fmac_bc<(J >> 2)>(y[J & 3], o.r[J & 3], t);
}
template <int MODE, int... Js> DI float scan_step(const ScanOps& o, float (&S)[64], std::integer_sequence<int, Js...>) {
    float sa[4] = {0.f, 0.f, 0.f, 0.f}, y[4] = {0.f, 0.f, 0.f, 0.f};
    (scan_col_a<MODE, Js>(o, S, sa), ...);
    const float sat = -((sa[0] + sa[1]) + (sa[2] + sa[3]));
    (scan_col_b<MODE, Js>(o, S, sat, y), ...);
    return (y[0] + y[1]) + (y[2] + y[3]);
}
template <int MODE> DI void scan_wave(const float* SCp, int row0, int rstep, int nsteps, int h, int d, float (&S)[64], float* yout, int lane) {
    const __amdgpu_buffer_rsrc_t rs = __builtin_amdgcn_make_buffer_rsrc((void*)SCp, 0, (int)((size_t)MT * SCAN_P * 4), 0x00020000);
    const __amdgpu_buffer_rsrc_t ry = __builtin_amdgcn_make_buffer_rsrc((void*)yout, 0, (int)((size_t)MT * 1024 * 4), 0x00020000);
    const int so0 = (row0 * SCAN_P + h * 64) * 4, sstep = rstep * SCAN_P * 4, last = nsteps - 1;
    int yo = (row0 * 1024 + h * 64) * 4; const int ystep = rstep * 4096;
    const unsigned lo = 16u * (unsigned)(lane & 15), lv = 4u * (unsigned)lane;
#define SC_LD(s_) scan_load<MODE>(rs, (unsigned)(so0 + ((s_) < last ? (s_) : last) * sstep), lo, lv, d)
#define SC_ST(o_) do { const float y_ = scan_step<MODE>(o_, S, std::make_integer_sequence<int, 64>{}); if (MODE == 2) __builtin_amdgcn_raw_buffer_store_b32(__builtin_bit_cast(unsigned, y_), ry, (int)lv, yo, 0); yo += ystep; } while (0)
    ScanOps o0 = SC_LD(0), o1 = SC_LD(1), o2 = SC_LD(2), o3;
    for (int s = 0; s < nsteps; s += 4) {
        o3 = SC_LD(s + 3); SC_ST(o0);
        o0 = SC_LD(s + 4); SC_ST(o1);
        o1 = SC_LD(s + 5); SC_ST(o2);
        o2 = SC_LD(s + 6); SC_ST(o3);
    }
#undef SC_LD
#undef SC_ST
}
DI void phase_scan1(Ctx& C, int e, int qslot) {
    const float* SCp = (const float*)(C.ws + WS_SCAN + (size_t)e * SCAN_BYTES); float* PQ = (float*)(C.ws + WS_PQ); float* Y = (float*)(C.ws + WS_YSC);
    const int nit = 512 + 64 * (NCH - 1) * 2;
    unsigned* qctr = (unsigned*)(C.ws + WS_CTL) + 8192 + 64 * (e + 2 * qslot);
    for (;;) {
        unsigned itu = 0; if (C.lane == 0) itu = __hip_atomic_fetch_add(qctr, 1u, __ATOMIC_RELAXED, __HIP_MEMORY_SCOPE_AGENT);
        const int it = __builtin_amdgcn_readfirstlane((int)itu); if (it >= nit) break;
        int lane = C.lane; asm volatile("" : "+v"(lane));
        float S[64];
        if (it >= 512) { const int si = it - 512;
            const int kind = si & 1, c = (si >> 1) % (NCH - 1), sidx = (si >> 1) / (NCH - 1);        const int d = sidx & 1, h = (sidx >> 1) & 15, b = sidx >> 5;
            const int t0 = d ? 4095 - c * CHL : c * CHL; const int row0 = MP + b * 4096 + t0;
            float fl = (float)lane; asm volatile("" : "+v"(fl)); const float kf = kind == 0 ? 1.f : 0.f;
#pragma unroll
            for (int j = 0; j < 64; ++j) { S[j] = kf * fmaxf(0.f, 1.f - fabsf(fl - (float)j)); }
            if (kind == 0) scan_wave<0>(SCp, row0, d ? -1 : 1, CHL, h, d, S, nullptr, lane); else scan_wave<1>(SCp, row0, d ? -1 : 1, CHL, h, d, S, nullptr, lane);
            float* dst = PQ + (((size_t)sidx * NCH + c) * 2 + kind) * 4096 + lane * 64;
#pragma unroll
            for (int j = 0; j < 16; ++j) *(f32x4v*)(dst + 4 * j) = (f32x4v){S[4 * j], S[4 * j + 1], S[4 * j + 2], S[4 * j + 3]};
        } else {
            const int pi = it; const int d = pi & 1, h = (pi >> 1) & 15, b = pi >> 5;
#pragma unroll
            for (int j = 0; j < 64; ++j) S[j] = 0.f;
            scan_wave<2>(SCp, b * 256 + (d ? 255 : 0), d ? -1 : 1, 128, h, d, S, Y + (size_t)d * MT * 1024, lane);
            float* dst = (float*)(C.ws + WS_PST) + (size_t)pi * 4096 + lane * 64;
#pragma unroll
            for (int j = 0; j < 16; ++j) *(f32x4v*)(dst + 4 * j) = (f32x4v){S[4 * j], S[4 * j + 1], S[4 * j + 2], S[4 * j + 3]};
        }
    }
}
DI void phase_scan_carry(Ctx& C, int e, int nsw) {
    const float* PQ = (const float*)(C.ws + WS_PQ); float* SST = (float*)(C.ws + WS_SST);
    LAS float* Ss = (LAS float*)C.lds;
    LAS float* Ps = (LAS float*)(C.lds + 64 * 65 * 4 + 64);
    for (int sidx = C.bx; sidx < 64; sidx += C.G) {
        const int d = sidx & 1, h = (sidx >> 1) & 15, b = sidx >> 5; const int row = C.tid & 63, cg = C.wave;
        const float* s0 = C.in[I_ST] + ((((size_t)b * 2 + e) * 2 + d) * 16 + h) * 4096;
        __syncthreads();
        for (int i = C.tid; i < 4096; i += 512) { const float v = s0[i]; Ss[(i >> 6) * 65 + (i & 63)] = v; SST[((size_t)sidx * NCH) * 4096 + i] = v; }
        const float* PQs = PQ + (size_t)sidx * NCH * 2 * 4096;
        f32x4v pp0 = *(const f32x4v*)(PQs + 4 * C.tid), pp1 = *(const f32x4v*)(PQs + 2048 + 4 * C.tid);
        f32x4v qq0 = *(const f32x4v*)(PQs + 4096 + row * 64 + cg * 8), qq1 = *(const f32x4v*)(PQs + 4096 + row * 64 + cg * 8 + 4);
        for (int c = 0; c + 1 < NCH; ++c) {
            __syncthreads();
            *(LAS f32x4v*)(Ps + 4 * C.tid) = pp0; *(LAS f32x4v*)(Ps + 2048 + 4 * C.tid) = pp1;
            float o[8] = {qq0.x, qq0.y, qq0.z, qq0.w, qq1.x, qq1.y, qq1.z, qq1.w};
            if (c + 2 < NCH) { const float* nx = PQs + (size_t)(c + 1) * 2 * 4096;
                pp0 = *(const f32x4v*)(nx + 4 * C.tid); pp1 = *(const f32x4v*)(nx + 2048 + 4 * C.tid);
                qq0 = *(const f32x4v*)(nx + 4096 + row * 64 + cg * 8); qq1 = *(const f32x4v*)(nx + 4096 + row * 64 + cg * 8 + 4); }
            __syncthreads();
            for (int k = 0; k < 64; ++k) { const float sv = Ss[row * 65 + k]; const f32x4v p0 = *(const LAS f32x4v*)(Ps + k * 64 + cg * 8), p1 = *(const LAS f32x4v*)(Ps + k * 64 + cg * 8 + 4);
                o[0] += sv * p0.x; o[1] += sv * p0.y; o[2] += sv * p0.z; o[3] += sv * p0.w; o[4] += sv * p1.x; o[5] += sv * p1.y; o[6] += sv * p1.z; o[7] += sv * p1.w; }
            __syncthreads();
            float* dst = SST + ((size_t)sidx * NCH + c + 1) * 4096 + row * 64 + cg * 8;
#pragma unroll
            for (int i = 0; i < 8; ++i) Ss[row * 65 + cg * 8 + i] = o[i];
            *(f32x4v*)dst = (f32x4v){o[0], o[1], o[2], o[3]}; *(f32x4v*)(dst + 4) = (f32x4v){o[4], o[5], o[6], o[7]};
        }
    }
    {
        const int nb0 = C.G > 64 ? 64 : 0; const float* SCp = (const float*)(C.ws + WS_SCAN + (size_t)e * SCAN_BYTES); float* Y = (float*)(C.ws + WS_YSC);
        if (C.bx >= nb0 && C.wave < nsw) for (int pi = (C.bx - nb0) * nsw + C.wave; pi < 512; pi += (C.G - nb0) * nsw) {
            int lane = C.lane; asm volatile("" : "+v"(lane));
            const int d = pi & 1, h = (pi >> 1) & 15, b = pi >> 5;
            float S[64]; const float* src = (const float*)(C.ws + WS_PST) + (size_t)pi * 4096 + lane * 64;
#pragma unroll
            for (int j = 0; j < 16; ++j) { const f32x4v t = *(const f32x4v*)(src + 4 * j); S[4 * j] = t.x; S[4 * j + 1] = t.y; S[4 * j + 2] = t.z; S[4 * j + 3] = t.w; }
            scan_wave<2>(SCp, b * 256 + (d ? 127 : 128), d ? -1 : 1, 128, h, d, S, Y + (size_t)d * MT * 1024, lane);
            float* dst = C.out + OUT_ST + ((((size_t)b * 2 + e) * 2 + d) * 16 + h) * 4096 + lane * 64;
#pragma unroll
            for (int j = 0; j < 16; ++j) *(f32x4v*)(dst + 4 * j) = (f32x4v){S[4 * j], S[4 * j + 1], S[4 * j + 2], S[4 * j + 3]};
        }
    }
}
DI void phase_scan3(Ctx& C, int e) {
    const float* SCp = (const float*)(C.ws + WS_SCAN + (size_t)e * SCAN_BYTES); const float* SST = (const float*)(C.ws + WS_SST); float* Y = (float*)(C.ws + WS_YSC);
    for (int it = C.gw; it < 64 * NCH; it += C.NGW) {
        int lane = C.lane; asm volatile("" : "+v"(lane));
        const int c = it % NCH, sidx = it / NCH; const int d = sidx & 1, h = (sidx >> 1) & 15, b = sidx >> 5;
        const int t0 = d ? 4095 - c * CHL : c * CHL; const int row0 = MP + b * 4096 + t0;
        float S[64]; const float* src = SST + ((size_t)sidx * NCH + c) * 4096 + lane * 64;
#pragma unroll
        for (int j = 0; j < 16; ++j) { const f32x4v t = *(const f32x4v*)(src + 4 * j); S[4 * j] = t.x; S[4 * j + 1] = t.y; S[4 * j + 2] = t.z; S[4 * j + 3] = t.w; }
        scan_wave<2>(SCp, row0, d ? -1 : 1, CHL, h, d, S, Y + (size_t)d * MT * 1024, lane);
    }
}
DI float row16_sum(float v) { v += dpp_f<0xB1>(v); v += dpp_f<0x4E>(v); v += dpp_f<0x141>(v); v += dpp_f<0x140>(v); return v; }
DI void phase_rwkv_post(Ctx& C, int e) {
    const float* SCp = (const float*)(C.ws + WS_SCAN + (size_t)e * SCAN_BYTES); const float* Y = (const float*)(C.ws + WS_YSC); const float* GB = (const float*)(C.ws + WS_GB); bf16* MIX = (bf16*)(C.ws + WS_MIX);
    const float* rk = C.in[I_RK] + e * 1024; const float* gw = C.in[I_GNW] + e * 1024; const float* gb = C.in[I_GNB] + e * 1024; const int lane = C.lane;
    for (int row = C.gw; row < MT; row += C.NGW) {
        const float* sc = SCp + (size_t)row * SCAN_P;
#pragma unroll
        for (int i = 0; i < 4; ++i) { const int c = 256 * i + 4 * lane;
            const f32x4v y = *(const f32x4v*)(Y + (size_t)row * 1024 + c) + *(const f32x4v*)(Y + ((size_t)MT + row) * 1024 + c);
            const float mu = row16_sum((y.x + y.y) + (y.z + y.w)) * (1.0f / 64.0f); const f32x4v dl = y - mu;
            const float var = row16_sum((dl.x * dl.x + dl.y * dl.y) + (dl.z * dl.z + dl.w * dl.w)) * (1.0f / 64.0f);
            const f32x4v yn = dl * (1.0f / sqrtf(var + 64e-5f));
            const f32x4v rr = *(const f32x4v*)(sc + c), kd = *(const f32x4v*)(sc + 7 * 1024 + c) + *(const f32x4v*)(sc + 8 * 1024 + c), rkv = *(const f32x4v*)(rk + c); const f32x4v pb = rr * kd * rkv;
            const float bs = row16_sum((pb.x + pb.y) + (pb.z + pb.w));
            const f32x4v o = (yn * *(const f32x4v*)(gw + c) + *(const f32x4v*)(gb + c) + *(const f32x4v*)(sc + 1024 + c) * bs) * *(const f32x4v*)(GB + (size_t)row * 1024 + c);
            v2u w; w.x = pk2(o.x, o.y); w.y = pk2(o.z, o.w); *(v2u*)(MIX + (size_t)row * 2048 + c) = w; }
    }
}

constexpr int AT_KP = 200, AT_VP = 72, AT_KB = 64 * AT_KP * 2, AT_VB = 128 * AT_VP * 2, AT_BUF = AT_KB + AT_VB;
DI void attn_unit(Ctx& C, const bf16* Qb, const bf16* KN, const bf16* KRb, const bf16* VTh  , int vpitch, bf16* MIX, int qrow0, int h, int krow0, int nlat, int crow0, int ntile) {
    int tid = C.tid; asm volatile("" : "+v"(tid)); const int lane = tid & 63, r = lane & 31, hh = lane >> 5;
    LAS unsigned char* lds = C.lds;
    s16x8v qf[12];
    { const bf16* qp = Qb + (size_t)(qrow0 + C.wave * 32 + r) * 1536 + h * 192 + 8 * hh;
#pragma unroll
      for (int s = 0; s < 12; ++s) qf[s] = *(const s16x8v*)(qp + 16 * s); }
    f32x16v o[4];
#pragma unroll
    for (int vb = 0; vb < 4; ++vb)
#pragma unroll
        for (int i = 0; i < 16; ++i) o[vb][i] = 0.f;
    float mrun = -INFINITY, lsum = 0.f;
    v4u pre[5];
    auto issue = [&](int j) {
        const int k0 = 64 * j; const int rbase = k0 < nlat ? krow0 + k0 : crow0 + (k0 - nlat);
#pragma unroll
        for (int i = 0; i < 3; ++i) { const int p = tid + 512 * i, key = p / 24, pc = p % 24; const size_t rw = (size_t)(rbase + key);
            pre[i] = pc < 16 ? *(const v4u*)(KN + rw * 1024 + h * 128 + pc * 8) : *(const v4u*)(KRb + rw * 64 + (pc - 16) * 8); }
#pragma unroll
        for (int i = 0; i < 2; ++i) { const int p = tid + 512 * i, dv = p >> 3, pc = p & 7; pre[3 + i] = *(const v4u*)(VTh + (size_t)dv * vpitch + k0 + pc * 8); }
    };
    auto commit = [&](int buf) {
        LAS unsigned char* kb = lds + buf * AT_BUF; LAS unsigned char* vbp = kb + AT_KB;
#pragma unroll
        for (int i = 0; i < 3; ++i) { const int p = tid + 512 * i, key = p / 24, pc = p % 24; *(LAS v4u*)(kb + key * (AT_KP * 2) + pc * 16) = pre[i]; }
#pragma unroll
        for (int i = 0; i < 2; ++i) { const int p = tid + 512 * i, dv = p >> 3, pc = p & 7; *(LAS v4u*)(vbp + dv * (AT_VP * 2) + pc * 16) = pre[3 + i]; }
    };
    __syncthreads();
    issue(0); commit(0); __syncthreads();
    for (int j = 0; j < ntile; ++j) {
        if (j + 1 < ntile) issue(j + 1);
        const LAS unsigned char* kb = lds + (j & 1) * AT_BUF; const LAS unsigned char* vbp = kb + AT_KB;
        f32x16v st[2];
        __builtin_amdgcn_s_setprio(1);
#pragma unroll
        for (int kbk = 0; kbk < 2; ++kbk) {
#pragma unroll
            for (int i = 0; i < 16; ++i) st[kbk][i] = 0.f;
#pragma unroll
            for (int s = 0; s < 12; ++s) { const s16x8v a = *(const LAS s16x8v*)(kb + (32 * kbk + r) * (AT_KP * 2) + (16 * s + 8 * hh) * 2);
                st[kbk] = __builtin_amdgcn_mfma_f32_32x32x16_bf16(a, qf[s], st[kbk], 0, 0, 0); }
        }
        __builtin_amdgcn_s_setprio(0);
        float mx = st[0][0];
#pragma unroll
        for (int i = 1; i < 16; ++i) mx = fmaxf(mx, st[0][i]);
#pragma unroll
        for (int i = 0; i < 16; ++i) mx = fmaxf(mx, st[1][i]);
        mx = fmaxf(mx, shfl_idx(mx, lane ^ 32));
        const float mnew = fmaxf(mrun, mx); const float alpha = __builtin_amdgcn_exp2f(mrun - mnew); mrun = mnew;
        float ps = 0.f;
#pragma unroll
        for (int kbk = 0; kbk < 2; ++kbk)
#pragma unroll
            for (int i = 0; i < 16; ++i) { const float p = __builtin_amdgcn_exp2f(st[kbk][i] - mnew); st[kbk][i] = p; ps += p; }
        lsum = lsum * alpha + ps;
        if (__builtin_amdgcn_ballot_w64(alpha != 1.0f) != 0ull) {
#pragma unroll
            for (int vb = 0; vb < 4; ++vb)
#pragma unroll
                for (int i = 0; i < 16; ++i) o[vb][i] *= alpha; }
        __builtin_amdgcn_s_setprio(1);
#pragma unroll
        for (int kbk = 0; kbk < 2; ++kbk)
#pragma unroll
            for (int s2 = 0; s2 < 2; ++s2) {
                v4u pw; pw.x = pg8::cvt_pk_bf16(st[kbk][8 * s2 + 0], st[kbk][8 * s2 + 1]); pw.y = pg8::cvt_pk_bf16(st[kbk][8 * s2 + 2], st[kbk][8 * s2 + 3]); pw.z = pg8::cvt_pk_bf16(st[kbk][8 * s2 + 4], st[kbk][8 * s2 + 5]); pw.w = pg8::cvt_pk_bf16(st[kbk][8 * s2 + 6], st[kbk][8 * s2 + 7]);
                const s16x8v pf = __builtin_bit_cast(s16x8v, pw);
#pragma unroll
                for (int vb = 0; vb < 4; ++vb) { const LAS unsigned char* vp = vbp + (32 * vb + r) * (AT_VP * 2) + (32 * kbk + 16 * s2 + 4 * hh) * 2;
                    const v2u lo = *(const LAS v2u*)vp, hi = *(const LAS v2u*)(vp + 16); const v4u av = {lo.x, lo.y, hi.x, hi.y};
                    o[vb] = __builtin_amdgcn_mfma_f32_32x32x16_bf16(__builtin_bit_cast(s16x8v, av), pf, o[vb], 0, 0, 0); }
            }
        __builtin_amdgcn_s_setprio(0);
        if (j + 1 < ntile) commit((j + 1) & 1);
        __syncthreads();
    }
    const float inv = 1.0f / (lsum + shfl_idx(lsum, lane ^ 32));
    bf16* op = MIX + (size_t)(qrow0 + C.wave * 32 + r) * 2048 + 1024 + h * 128 + 4 * hh;
#pragma unroll
    for (int vb = 0; vb < 4; ++vb)
#pragma unroll
        for (int g = 0; g < 4; ++g) { v2u w; w.x = pk2(o[vb][4 * g] * inv, o[vb][4 * g + 1] * inv); w.y = pk2(o[vb][4 * g + 2] * inv, o[vb][4 * g + 3] * inv);
            *(v2u*)(op + 32 * vb + 8 * g) = w; }
}
DI void phase_attention(Ctx& C) {
    unsigned char* ws = C.ws; const bf16* Qb = (const bf16*)(ws + WS_Q); const bf16* KN = (const bf16*)(ws + WS_KN); const bf16* KRb = (const bf16*)(ws + WS_KR); bf16* MIX = (bf16*)(ws + WS_MIX);
    const bf16* VTp = (const bf16*)(ws + WS_VT); const bf16* VTs = (const bf16*)(ws + WS_VT + VT_S_OFF);
    for (int u = C.bx; u < 256 + 128; u += C.G) {
        if (u < 256) { const int qb = u & 15, h = (u >> 4) & 7, b = u >> 7;
            attn_unit(C, Qb, KN, KRb, VTs + ((size_t)b * 1024 + h * 128) * 4352, 4352, MIX, MP + b * 4096 + qb * 256, h, MP + b * 4096, 4096, MT + b * 256, 68); }
        else { const int v = u - 256, h = v & 7, b = v >> 3;
            attn_unit(C, Qb, KN, KRb, VTp + ((size_t)b * 1024 + h * 128) * 256, 256, MIX, b * 256, h, b * 256, 256, 0, 4); }
    }
    __syncthreads();
}

DI f32x2v mk2(float a, float b) { return (f32x2v){a, b}; }
DI f32x2v cmul(f32x2v a, f32x2v b) { const f32x2v t = {-b.y, b.x}; return a.x * b + a.y * t; }
DI f32x2v cmulc(f32x2v a, f32x2v b) { const f32x2v t = {b.y, -b.x}; return a.x * b + a.y * t; }
DI f32x2v mul_mi(f32x2v a) { return mk2(a.y, -a.x); }
DI f32x2v mul_pi(f32x2v a) { return mk2(-a.y, a.x); }
DI f32x2v twid(int p, int den) { const float fr = (float)p / (float)den; return mk2(__builtin_amdgcn_cosf(fr), __builtin_amdgcn_sinf(fr)); }
DI int PD(int i) { return i + ((i >> 5) << 1); }
constexpr int FFT_BS = 8192 + 512, FFT_BUF_BYTES = FFT_BS * 8;
DI void bf4_fwd(f32x2v& x0, f32x2v& x1, f32x2v& x2, f32x2v& x3, f32x2v w0, f32x2v wm) {
    const f32x2v a0 = x0 + x2, a2 = cmul(x0 - x2, w0), a1 = x1 + x3, a3 = cmul(x1 - x3, mul_mi(w0));
    x0 = a0 + a1; x1 = cmul(a0 - a1, wm); x2 = a2 + a3; x3 = cmul(a2 - a3, wm);
}
DI void bf4_inv(f32x2v& x0, f32x2v& x1, f32x2v& x2, f32x2v& x3, f32x2v wa, f32x2v w) {
    const f32x2v t1 = cmul(x1, w), t3 = cmul(x3, w);
    const f32x2v a0 = x0 + t1, a1 = x0 - t1, a2 = x2 + t3, a3 = x2 - t3;
    const f32x2v t2 = cmul(a2, wa), t3b = cmul(a3, mul_pi(wa));
    x0 = a0 + t2; x1 = a1 + t3b; x2 = a0 - t2; x3 = a1 - t3b;
}
template <int N, int M, int NI = 1> DI void fft_fwd_pass(LAS f32x2v* buf, int tid) {
    constexpr int S = M / 8;
    const int tr = tid / (N / 16), u = tid % (N / 16), g = u / S, p = u % S; const int base = tr * N + g * 2 * M + p;
    f32x2v e[NI][16];
#pragma unroll
    for (int j = 0; j < NI; ++j)
#pragma unroll
        for (int k = 0; k < 16; ++k) e[j][k] = buf[j * FFT_BS + PD(base + k * S)];
    const f32x2v bc = twid(p, 2 * M); const f32x2v b1 = mk2(bc.x, -bc.y), b2 = cmul(b1, b1), b4 = cmul(b2, b2), b8 = cmul(b4, b4);
    constexpr float C1 = 0.92387953251128674f, S1 = 0.38268343236508977f, R2 = 0.70710678118654752f;
    const f32x2v w1a = cmul(b1, mk2(C1, -S1)), w1b = cmul(b2, mk2(R2, -R2)), w2a = cmul(b1, mk2(R2, -R2)), w2b = mul_mi(b2), w3a = cmul(b1, mk2(S1, -C1)), w3b = cmul(b2, mk2(-R2, -R2));
#pragma unroll
    for (int j = 0; j < NI; ++j) {
        bf4_fwd(e[j][0], e[j][4], e[j][8], e[j][12], b1, b2);
        bf4_fwd(e[j][1], e[j][5], e[j][9], e[j][13], w1a, w1b);
        bf4_fwd(e[j][2], e[j][6], e[j][10], e[j][14], w2a, w2b);
        bf4_fwd(e[j][3], e[j][7], e[j][11], e[j][15], w3a, w3b);
#pragma unroll
        for (int q = 0; q < 4; ++q) bf4_fwd(e[j][4 * q], e[j][4 * q + 1], e[j][4 * q + 2], e[j][4 * q + 3], b4, b8);
#pragma unroll
        for (int k = 0; k < 16; ++k) buf[j * FFT_BS + PD(base + k * S)] = e[j][k];
    }
    __syncthreads();
    if constexpr (M / 16 >= 32) fft_fwd_pass<N, M / 16, NI>(buf, tid);
}
constexpr float c32q(int k) { return k == 0 ? 1.f : k == 1 ? 0.98078528040323043f : k == 2 ? 0.92387953251128674f : k == 3 ? 0.83146961230254524f : k == 4 ? 0.70710678118654752f : k == 5 ? 0.55557023301960218f : k == 6 ? 0.38268343236508977f : k == 7 ? 0.19509032201612825f : 0.f; }
constexpr float c32(int k) { return k <= 8 ? c32q(k) : -c32q(16 - k); }
constexpr float s32(int k) { return k <= 8 ? c32q(8 - k) : c32q(k - 8); }
DI void bf4_fwd_t(f32x2v& x0, f32x2v& x1, f32x2v& x2, f32x2v& x3) {
    const f32x2v a0 = x0 + x2, a2 = x0 - x2, a1 = x1 + x3, a3 = mul_mi(x1 - x3);
    x0 = a0 + a1; x1 = a0 - a1; x2 = a2 + a3; x3 = a2 - a3;
}
DI void bf4_fwd_b1(f32x2v& x0, f32x2v& x1, f32x2v& x2, f32x2v& x3) {
    constexpr float R2 = 0.70710678118654752f;
    const f32x2v a0 = x0 + x2, a2 = cmul(x0 - x2, mk2(R2, -R2)), a1 = x1 + x3, a3 = cmul(x1 - x3, mk2(-R2, -R2));
    x0 = a0 + a1; x1 = mul_mi(a0 - a1); x2 = a2 + a3; x3 = mul_mi(a2 - a3);
}
DI void bf4_inv_t(f32x2v& x0, f32x2v& x1, f32x2v& x2, f32x2v& x3) {
    const f32x2v a0 = x0 + x1, a1 = x0 - x1, a2 = x2 + x3, a3 = x2 - x3; const f32x2v t3b = mul_pi(a3);
    x0 = a0 + a2; x1 = a1 + t3b; x2 = a0 - a2; x3 = a1 - t3b;
}
DI void bf4_inv_b1(f32x2v& x0, f32x2v& x1, f32x2v& x2, f32x2v& x3) {
    constexpr float R2 = 0.70710678118654752f;
    const f32x2v t1 = mul_pi(x1), t3 = mul_pi(x3); const f32x2v a0 = x0 + t1, a1 = x0 - t1, a2 = x2 + t3, a3 = x2 - t3;
    const f32x2v t2 = cmul(a2, mk2(R2, R2)), t3b = cmul(a3, mk2(-R2, R2));
    x0 = a0 + t2; x1 = a1 + t3b; x2 = a0 - t2; x3 = a1 - t3b;
}
template <int NI> DI void fft_r32_fwd(LAS f32x2v* buf, int tid) {
    const int img = tid >> 8, g = tid & 255;
    if (img < NI) {
        LAS f32x4v* p = (LAS f32x4v*)(buf + img * FFT_BS + 34 * g);
        f32x2v r[32];
#pragma unroll
        for (int m = 0; m < 16; ++m) { const f32x4v v = p[m]; r[2 * m] = mk2(v.x, v.y); r[2 * m + 1] = mk2(v.z, v.w); }
        bf4_fwd_t(r[0], r[8], r[16], r[24]);
#pragma unroll
        for (int j = 1; j < 8; ++j) bf4_fwd(r[j], r[j + 8], r[j + 16], r[j + 24], mk2(c32(j), -s32(j)), mk2(c32(2 * j), -s32(2 * j)));
#pragma unroll
        for (int q = 0; q < 4; ++q) { bf4_fwd_t(r[8 * q], r[8 * q + 2], r[8 * q + 4], r[8 * q + 6]); bf4_fwd_b1(r[8 * q + 1], r[8 * q + 3], r[8 * q + 5], r[8 * q + 7]); }
#pragma unroll
        for (int m = 0; m < 16; ++m) { const f32x2v a = r[2 * m] + r[2 * m + 1], b = r[2 * m] - r[2 * m + 1]; p[m] = (f32x4v){a.x, a.y, b.x, b.y}; }
    }
    __syncthreads();
}
template <int NI> DI void fft_r32_inv(LAS f32x2v* buf, int tid) {
    const int img = tid >> 8, g = tid & 255;
    if (img < NI) {
        LAS f32x4v* p = (LAS f32x4v*)(buf + img * FFT_BS + 34 * g);
        f32x2v r[32];
#pragma unroll
        for (int m = 0; m < 16; ++m) { const f32x4v v = p[m]; r[2 * m] = mk2(v.x + v.z, v.y + v.w); r[2 * m + 1] = mk2(v.x - v.z, v.y - v.w); }
#pragma unroll
        for (int q = 0; q < 4; ++q) { bf4_inv_t(r[8 * q], r[8 * q + 2], r[8 * q + 4], r[8 * q + 6]); bf4_inv_b1(r[8 * q + 1], r[8 * q + 3], r[8 * q + 5], r[8 * q + 7]); }
        bf4_inv_t(r[0], r[8], r[16], r[24]);
#pragma unroll
        for (int j = 1; j < 8; ++j) bf4_inv(r[j], r[j + 8], r[j + 16], r[j + 24], mk2(c32(j), s32(j)), mk2(c32(2 * j), s32(2 * j)));
#pragma unroll
        for (int m = 0; m < 16; ++m) p[m] = (f32x4v){r[2 * m].x, r[2 * m].y, r[2 * m + 1].x, r[2 * m + 1].y};
    }
    __syncthreads();
}
template <int N, int NI = 1> DI void fft_fwd(LAS f32x2v* buf, int tid) {
    asm volatile("" : "+v"(tid));
    fft_fwd_pass<N, N / 2, NI>(buf, tid);
    fft_r32_fwd<NI>(buf, tid);
}
template <int N, int M, int NI = 1, bool REC = true> DI void fft_inv_pass(LAS f32x2v* buf, int tid) {
    const int tr = tid / (N / 16), u = tid % (N / 16), g = u / M, p = u % M; const int base = tr * N + g * 16 * M + p;
    f32x2v e[NI][16];
#pragma unroll
    for (int j = 0; j < NI; ++j)
#pragma unroll
        for (int k = 0; k < 16; ++k) e[j][k] = buf[j * FFT_BS + PD(base + k * M)];
    const f32x2v a1 = twid(p, 16 * M), a2 = cmul(a1, a1), a4 = cmul(a2, a2), a8 = cmul(a4, a4);
    constexpr float C1 = 0.92387953251128674f, S1 = 0.38268343236508977f, R2 = 0.70710678118654752f;
    const f32x2v v1a = cmul(a1, mk2(C1, S1)), v1b = cmul(a2, mk2(R2, R2)), v2a = cmul(a1, mk2(R2, R2)), v2b = mul_pi(a2), v3a = cmul(a1, mk2(S1, C1)), v3b = cmul(a2, mk2(-R2, R2));
#pragma unroll
    for (int j = 0; j < NI; ++j) {
#pragma unroll
        for (int q = 0; q < 4; ++q) bf4_inv(e[j][4 * q], e[j][4 * q + 1], e[j][4 * q + 2], e[j][4 * q + 3], a4, a8);
        bf4_inv(e[j][0], e[j][4], e[j][8], e[j][12], a1, a2);
        bf4_inv(e[j][1], e[j][5], e[j][9], e[j][13], v1a, v1b);
        bf4_inv(e[j][2], e[j][6], e[j][10], e[j][14], v2a, v2b);
        bf4_inv(e[j][3], e[j][7], e[j][11], e[j][15], v3a, v3b);
#pragma unroll
        for (int k = 0; k < 16; ++k) buf[j * FFT_BS + PD(base + k * M)] = e[j][k];
    }
    __syncthreads();
    if constexpr (REC && 16 * M < N) fft_inv_pass<N, 16 * M, NI>(buf, tid);
}
template <int N, int NI = 1> DI void fft_inv(LAS f32x2v* buf, int tid) {
    asm volatile("" : "+v"(tid));
    fft_r32_inv<NI>(buf, tid);
    fft_inv_pass<N, 32, NI>(buf, tid);
}
template <int N> DI int ks_perm(int e) { if constexpr (N == 8192) return e < 4096 ? (((e & 63) << 6) | (e >> 6)) : e; else return e; }
template <int N, int NI> DI void fft_pairmul_pre(LAS f32x2v* buf, const f32x4v (&ksr)[8], const f32x4v* KS, int tid) {
    asm volatile("" : "+v"(tid));
    constexpr int LOG = (N == 8192) ? 13 : 9, NB = 8192 / N, NK = N / 2 + 1;
#pragma unroll
    for (int r = 0; r < 9; ++r) {
        const int idx = tid + 512 * r;
        if (r == 8 && idx >= NB * NK) break;
        f32x4v ks; if (r < 8) ks = ksr[r]; else ks = KS[idx];
        const int tr = idx / NK, k = ks_perm<N>(idx % NK);
        const int pk = PD(tr * N + (int)(__brev((unsigned)k) >> (32 - LOG))), pn = PD(tr * N + (int)(__brev((unsigned)((N - k) & (N - 1))) >> (32 - LOG)));
#pragma unroll
        for (int j = 0; j < NI; ++j) {
            const f32x2v zk = buf[j * FFT_BS + pk], zn = buf[j * FFT_BS + pn];
            const f32x2v u1 = mk2(0.5f * (zk.x + zn.x), 0.5f * (zk.y - zn.y)), u2 = mk2(0.5f * (zk.y + zn.y), -0.5f * (zk.x - zn.x));
            const f32x2v y1 = cmul(u1, mk2(ks.x, ks.y)), y2 = cmul(u2, mk2(ks.z, ks.w));
            buf[j * FFT_BS + pk] = mk2(y1.x - y2.y, y1.y + y2.x);
            if (pn != pk) buf[j * FFT_BS + pn] = mk2(y1.x + y2.y, -y1.y + y2.x);
        }
    }
}
template <int N, int NI> DI void fft_fwd_first(LAS f32x2v* buf, int tid, const float (&u0)[NI][8], const float (&u1)[NI][8]) {
    asm volatile("" : "+v"(tid));
    constexpr int M = N / 2, S = M / 8;
    const int tr = tid / (N / 16), p = tid % (N / 16); const int base = tr * N + p;
    const f32x2v bc = twid(p, 2 * M); const f32x2v b1 = mk2(bc.x, -bc.y), b2 = cmul(b1, b1), b4 = cmul(b2, b2), b8 = cmul(b4, b4);
    constexpr float C1 = 0.92387953251128674f, S1 = 0.38268343236508977f, R2 = 0.70710678118654752f;
    const f32x2v w1a = cmul(b1, mk2(C1, -S1)), w1b = cmul(b2, mk2(R2, -R2)), w2a = cmul(b1, mk2(R2, -R2)), w2b = mul_mi(b2), w3a = cmul(b1, mk2(S1, -C1)), w3b = cmul(b2, mk2(-R2, -R2));
    __syncthreads();
#pragma unroll
    for (int j = 0; j < NI; ++j) {
        f32x2v e[16];
#define FFT_HALF_FWD(i, w0, wm) { const f32x2v x0 = mk2(u0[j][i], u1[j][i]), x1 = mk2(u0[j][i + 4], u1[j][i + 4]); const f32x2v a2 = cmul(x0, w0), a3 = cmul(x1, mul_mi(w0)); \
            e[i] = x0 + x1; e[i + 4] = cmul(x0 - x1, wm); e[i + 8] = a2 + a3; e[i + 12] = cmul(a2 - a3, wm); }
        FFT_HALF_FWD(0, b1, b2) FFT_HALF_FWD(1, w1a, w1b) FFT_HALF_FWD(2, w2a, w2b) FFT_HALF_FWD(3, w3a, w3b)
#undef FFT_HALF_FWD
#pragma unroll
        for (int q = 0; q < 4; ++q) bf4_fwd(e[4 * q], e[4 * q + 1], e[4 * q + 2], e[4 * q + 3], b4, b8);
#pragma unroll
        for (int k = 0; k < 16; ++k) buf[j * FFT_BS + PD(base + k * S)] = e[k];
    }
    __syncthreads();
}
template <int N, int NI> DI void fft_inv_last(LAS f32x2v* buf, int tid, f32x2v (&out)[NI][8]) {
    asm volatile("" : "+v"(tid));
    constexpr int M = N / 16;
    const int tr = tid / (N / 16), p = tid % (N / 16); const int base = tr * N + p;
    const f32x2v a1 = twid(p, 16 * M), a2 = cmul(a1, a1), a4 = cmul(a2, a2), a8 = cmul(a4, a4);
    constexpr float C1 = 0.92387953251128674f, S1 = 0.38268343236508977f, R2 = 0.70710678118654752f;
    const f32x2v v1a = cmul(a1, mk2(C1, S1)), v1b = cmul(a2, mk2(R2, R2)), v2a = cmul(a1, mk2(R2, R2)), v2b = mul_pi(a2), v3a = cmul(a1, mk2(S1, C1)), v3b = cmul(a2, mk2(-R2, R2));
#pragma unroll
    for (int j = 0; j < NI; ++j) {
        f32x2v e[16];
#pragma unroll
        for (int k = 0; k < 16; ++k) e[k] = buf[j * FFT_BS + PD(base + k * M)];
#pragma unroll
        for (int q = 0; q < 4; ++q) bf4_inv(e[4 * q], e[4 * q + 1], e[4 * q + 2], e[4 * q + 3], a4, a8);
#define FFT_HALF_INV(i, wa, w) { const f32x2v t1 = cmul(e[i + 4], w), t3 = cmul(e[i + 12], w); const f32x2v a0 = e[i] + t1, a1_ = e[i] - t1, a2_ = e[i + 8] + t3, a3 = e[i + 8] - t3; \
            out[j][i] = a0 + cmul(a2_, wa); out[j][i + 4] = a1_ + cmul(a3, mul_pi(wa)); }
        FFT_HALF_INV(0, a1, a2) FFT_HALF_INV(1, v1a, v1b) FFT_HALF_INV(2, v2a, v2b) FFT_HALF_INV(3, v3a, v3b)
#undef FFT_HALF_INV
    }
}
template <int N, int NI = 1, bool SH = false> DI void fft_pairmul(LAS f32x2v* buf, const f32x4v* const (&KS)[NI]  , int tid) {
    asm volatile("" : "+v"(tid));
    constexpr int LOG = (N == 8192) ? 13 : 9, NB = 8192 / N, NK = N / 2 + 1;
    for (int idx = tid; idx < NB * NK; idx += 512) {
        const int tr = idx / NK, k = ks_perm<N>(idx % NK);
        const int pk = PD(tr * N + (int)(__brev((unsigned)k) >> (32 - LOG))), pn = PD(tr * N + (int)(__brev((unsigned)((N - k) & (N - 1))) >> (32 - LOG)));
        f32x4v ks0 = {0.f, 0.f, 0.f, 0.f}; if (SH) ks0 = KS[0][idx];
#pragma unroll
        for (int j = 0; j < NI; ++j) {
            const f32x2v zk = buf[j * FFT_BS + pk], zn = buf[j * FFT_BS + pn]; const f32x4v ks = SH ? ks0 : KS[j][idx];
            const f32x2v u1 = mk2(0.5f * (zk.x + zn.x), 0.5f * (zk.y - zn.y)), u2 = mk2(0.5f * (zk.y + zn.y), -0.5f * (zk.x - zn.x));
            const f32x2v y1 = cmul(u1, mk2(ks.x, ks.y)), y2 = cmul(u2, mk2(ks.z, ks.w));
            buf[j * FFT_BS + pk] = mk2(y1.x - y2.y, y1.y + y2.x);
            if (pn != pk) buf[j * FFT_BS + pn] = mk2(y1.x + y2.y, -y1.y + y2.x);
        }
    }
}
template <int T> DI void hyena_filter_item(Ctx& C, int o, int n, int pair0) {
    constexpr int N = 2 * T, NB = 4096 / T, LOG = (N == 8192) ? 13 : 9, NK = N / 2 + 1;
    const float* KT = (const float*)(C.ws + WS_SCAN); LAS f32x2v* buf = (LAS f32x2v*)C.lds; LAS float* red = (LAS float*)(C.lds + FFT_BUF_BYTES + 1024);
    int tid = C.tid; asm volatile("" : "+v"(tid)); const int toff = T == 256 ? 0 : 256;
    const float dmin = 4.605170185988092f / 1.5f, dmax = 4.605170185988092f / 0.3f;
    __syncthreads();
    if (tid < 2 * NB) red[tid] = 0.f;
    __syncthreads();
    float k0[16], k1[16];
#pragma unroll
    for (int i = 0; i < 16; ++i) { const int idx = tid + 512 * i, tr = idx / N, pos = idx % N; const int c = 2 * (pair0 + tr);
        float a = 0.f, b = 0.f;
        if (pos != T) { const int side = pos > T ? 1 : 0, tt = pos > T ? N - pos : pos; const float tn = (float)tt / (float)(T - 1);
            const float* kr = KT + ((size_t)o * 8192 + (n * 2 + side) * 2048 + c) * 4352 + toff + tt;
            const float d0 = dmin + (dmax - dmin) * ((float)c / 2047.0f), d1 = dmin + (dmax - dmin) * ((float)(c + 1) / 2047.0f);
            a = kr[0] * expf(-tn * d0); b = kr[4352] * expf(-tn * d1); }
        k0[i] = a; k1[i] = b;
        const float sa = wave_sum(fabsf(a)), sb = wave_sum(fabsf(b));
        if (C.lane == 0) { __hip_atomic_fetch_add(&red[2 * tr], sa, __ATOMIC_RELAXED, __HIP_MEMORY_SCOPE_WORKGROUP); __hip_atomic_fetch_add(&red[2 * tr + 1], sb, __ATOMIC_RELAXED, __HIP_MEMORY_SCOPE_WORKGROUP); } }
    __syncthreads();
    int tl = tid; asm volatile("" : "+v"(tl));
#pragma unroll
    for (int i = 0; i < 16; ++i) { const int idx = tl + 512 * i, tr = idx / N; f32x2v kv = mk2(k0[i] / red[2 * tr], k1[i] / red[2 * tr + 1]);
        if (idx % N == 0) { const float* hb = C.in[I_HB] + (size_t)(o * 2 + n) * 2048 + 2 * (pair0 + tr); kv.x += hb[0]; kv.y += hb[1]; }
        buf[PD(idx)] = kv; }
    __syncthreads();
    fft_fwd<N>(buf, tid);
    f32x4v* KS = (f32x4v*)(C.ws + (T == 256 ? WS_KSP : WS_KSS)) + ((size_t)(o * 2 + n) * 1024 + pair0) * NK;
    const float sc = 1.0f / (float)N;
    for (int idx = tid; idx < NB * NK; idx += 512) { const int tr = idx / NK, k = ks_perm<N>(idx % NK);
        const int pk = tr * N + (int)(__brev((unsigned)k) >> (32 - LOG)), pn = tr * N + (int)(__brev((unsigned)((N - k) & (N - 1))) >> (32 - LOG));
        const f32x2v zk = buf[PD(pk)], zn = buf[PD(pn)];
        KS[idx] = (f32x4v){0.5f * (zk.x + zn.x) * sc, 0.5f * (zk.y - zn.y) * sc, 0.5f * (zk.y + zn.y) * sc, -0.5f * (zk.x - zn.x) * sc}; }
}
DI void phase_hyena_filters(Ctx& C) {
    for (int it = C.vb; it < 4 * 1024 + 4 * 64; it += C.G) {
        if (it < 4096) hyena_filter_item<4096>(C, it >> 11, (it >> 10) & 1, it & 1023);
        else { const int v = it - 4096; hyena_filter_item<256>(C, v >> 7, (v >> 6) & 1, (v & 63) * 16); }
    }
    __syncthreads();
}
template <int T, int NI, int PROBE = 0, bool SH = false> DI void hyena_conv_item(Ctx& C, int o, const int (&seq)[NI], const int (&pair0)[NI]) {
    constexpr int N = 2 * T, NB = 4096 / T, NK = N / 2 + 1;
    LAS f32x2v* buf = (LAS f32x2v*)C.lds; const int tid = C.tid;
    const float* cw = C.in[I_CW] + (size_t)o * 3 * 6144; const float* cb = C.in[I_CB] + (size_t)o * 6144;
    bf16* Y = (bf16*)(C.ws + WS_MIX);
    const float* ZT[NI]; const f32x4v* KS0[NI]; const f32x4v* KS1[NI]; int rowbase[NI];
#pragma unroll
    for (int j = 0; j < NI; ++j) { ZT[j] = (const float*)(C.ws + WS_Z + (T == 256 ? 0 : ZT_S_OFF)) + (size_t)seq[j] * 6144 * T;
        KS0[j] = (const f32x4v*)(C.ws + (T == 256 ? WS_KSP : WS_KSS)) + ((size_t)(o * 2 + 0) * 1024 + pair0[j]) * NK; KS1[j] = KS0[j] + (size_t)1024 * NK;
        rowbase[j] = T == 256 ? seq[j] * 256 : MP + seq[j] * 4096; }
    constexpr int NQ = SH ? 1 : NI;
    float wq[NQ][6][4];
    if constexpr (T == 4096) {
        auto sg = [](float v) { return __builtin_bit_cast(float, __builtin_amdgcn_readfirstlane(__builtin_bit_cast(int, v))); };
#pragma unroll
        for (int j = 0; j < NQ; ++j) {
#pragma unroll
            for (int gq = 0; gq < 6; ++gq) { const int ch = (gq >> 1) * 2048 + 2 * pair0[j] + (gq & 1); wq[j][gq][0] = sg(cw[ch]); wq[j][gq][1] = sg(cw[6144 + ch]); wq[j][gq][2] = sg(cw[2 * 6144 + ch]); wq[j][gq][3] = sg(cb[ch]); }
        }
    }
    auto conv3 = [&](int j, int grp, int jj, int c, int t) { const int ch = grp * 2048 + c + jj; const float* zr = ZT[j] + (size_t)ch * T + t; const float zc = zr[0], zp = t > 0 ? zr[-1] : 0.f, zn = t < T - 1 ? zr[1] : 0.f;
        if constexpr (T == 4096) { const int jq = SH ? 0 : j; return wq[jq][grp * 2 + jj][0] * zp + wq[jq][grp * 2 + jj][1] * zc + wq[jq][grp * 2 + jj][2] * zn + wq[jq][grp * 2 + jj][3]; }
        else return cw[ch] * zp + cw[6144 + ch] * zc + cw[2 * 6144 + ch] * zn + cb[ch]; };
    float u0[NI][8], u1[NI][8]; f32x2v cv[NI][8];
    int tl = tid; asm volatile("" : "+v"(tl));
#pragma unroll
    for (int j = 0; j < NI; ++j)
#pragma unroll
        for (int i = 0; i < 8; ++i) { const int tr = tl / (N / 16), t = tl % (N / 16) + (N / 16) * i, c = 2 * (pair0[j] + tr);
            u0[j][i] = conv3(j, 2, 0, c, t); u1[j][i] = conv3(j, 2, 1, c, t); }
    f32x4v ksr[8];
    if constexpr (SH) {
#pragma unroll
        for (int r = 0; r < 8; ++r) ksr[r] = KS0[0][tl + 512 * r]; }
    fft_fwd_first<N, NI>(buf, tid, u0, u1);
    if constexpr (N == 8192) { int tf = tid; asm volatile("" : "+v"(tf)); fft_fwd_pass<N, 256, NI>(buf, tf); }
    { int tf = tid; asm volatile("" : "+v"(tf)); fft_r32_fwd<NI>(buf, tf); }
    if constexpr (SH) fft_pairmul_pre<N, NI>(buf, ksr, KS0[0], tid); else fft_pairmul<N, NI, SH>(buf, KS0, tid);
    __syncthreads();
    { int tf = tid; asm volatile("" : "+v"(tf)); fft_r32_inv<NI>(buf, tf); }
    if constexpr (N == 8192) { int tf = tid; asm volatile("" : "+v"(tf)); fft_inv_pass<N, 32, NI, false>(buf, tf); }
    fft_inv_last<N, NI>(buf, tid, cv);
    tl = tid; asm volatile("" : "+v"(tl));
#pragma unroll
    for (int j = 0; j < NI; ++j)
#pragma unroll
        for (int i = 0; i < 8; ++i) { const int tr = tl / (N / 16), t = tl % (N / 16) + (N / 16) * i, c = 2 * (pair0[j] + tr);
            u0[j][i] = conv3(j, 0, 0, c, t) * cv[j][i].x; u1[j][i] = conv3(j, 0, 1, c, t) * cv[j][i].y; }
    if constexpr (SH) {
#pragma unroll
        for (int r = 0; r < 8; ++r) ksr[r] = KS1[0][tl + 512 * r]; }
    fft_fwd_first<N, NI>(buf, tid, u0, u1);
    if constexpr (N == 8192) { int tf = tid; asm volatile("" : "+v"(tf)); fft_fwd_pass<N, 256, NI>(buf, tf); }
    { int tf = tid; asm volatile("" : "+v"(tf)); fft_r32_fwd<NI>(buf, tf); }
    if constexpr (SH) fft_pairmul_pre<N, NI>(buf, ksr, KS1[0], tid); else fft_pairmul<N, NI, SH>(buf, KS1, tid);
    __syncthreads();
    { int tf = tid; asm volatile("" : "+v"(tf)); fft_r32_inv<NI>(buf, tf); }
    if constexpr (N == 8192) { int tf = tid; asm volatile("" : "+v"(tf)); fft_inv_pass<N, 32, NI, false>(buf, tf); }
    fft_inv_last<N, NI>(buf, tid, cv);
    tl = tid; asm volatile("" : "+v"(tl));
#pragma unroll
    for (int j = 0; j < NI; ++j)
#pragma unroll
        for (int i = 0; i < 8; ++i) { const int tr = tl / (N / 16), t = tl % (N / 16) + (N / 16) * i, c = 2 * (pair0[j] + tr);
            const float y0 = conv3(j, 1, 0, c, t) * cv[j][i].x, y1 = conv3(j, 1, 1, c, t) * cv[j][i].y;
            *(unsigned*)(Y + (size_t)(rowbase[j] + t) * 2048 + c) = pk2(y0, y1); }
}
template <int PROBE = 0> DI void phase_hyena_conv(Ctx& C, int o) {
    if (C.G == 256) {
        for (int it = C.vb; it < 1024 + 512; it += C.G) {
            if (it < 1024) { const int sq[2] = {0, 1}, pr[2] = {it, it}; hyena_conv_item<4096, 2, PROBE, true>(C, o, sq, pr); }
            else { const int v = it - 1024; const int sq[2] = {2 * (v >> 6), 2 * (v >> 6) + 1}, pr[2] = {(v & 63) * 16, (v & 63) * 16}; hyena_conv_item<256, 2, PROBE, true>(C, o, sq, pr); }
        }
    } else {
        for (int it = C.vb; it < 2048 + 1024; it += C.G) {
            if (it < 2048) { const int sq[1] = {it >> 10}, pr[1] = {it & 1023}; hyena_conv_item<4096, 1, PROBE>(C, o, sq, pr); }
            else { const int v = it - 2048; const int sq[1] = {v >> 6}, pr[1] = {(v & 63) * 16}; hyena_conv_item<256, 1, PROBE>(C, o, sq, pr); }
        }
    }
    __syncthreads();
}

#ifndef ONE_LAUNCH
#define ONE_LAUNCH 1
#endif
#ifndef SKIP_FFN
#define SKIP_FFN 0
#endif
#ifndef SKIP_EVEN
#define SKIP_EVEN 0
#endif
#ifndef SKIP_ODD
#define SKIP_ODD 0
#endif
#ifndef DUP_FFN
#define DUP_FFN 0
#endif
#ifndef DUP_EVEN
#define DUP_EVEN 0
#endif
#ifndef DUP_ODD
#define DUP_ODD 0
#endif
#ifndef DUP_PRO
#define DUP_PRO 0
#endif
#ifndef DUP_E
#define DUP_E 0
#endif
#ifndef DUP_O
#define DUP_O 0
#endif
constexpr int NPH_MAX = 96;
template <int V> struct IntC { static constexpr int value = V; };
DI void launder(Ctx& C, const KArgs& a) { const int t = lane_id_v(); C.lane = t; C.tid = C.wave * 64 + t;
    int z = 0; asm volatile("" : "+v"(z)); const int zs = __builtin_amdgcn_readfirstlane(z);
    C.ws = a.ws + zs; C.in = a.in + zs; C.out = a.out + zs;
    C.zs = zs; C.G = (int)gridDim.x + zs; C.bx = (int)blockIdx.x + zs; C.gw = C.bx * 8 + C.wave; C.NGW = C.G * 8; C.vb = (C.G % 8 == 0) ? (C.bx % 8) * (C.G / 8) + C.bx / 8 : C.bx; }
__global__ void __launch_bounds__(512, 2) mega_fwd(KArgs args) {
    extern __shared__ __attribute__((aligned(16))) unsigned char lds_raw[];
    Ctx C;
    C.lds = (LAS unsigned char*)lds_raw; C.ws = args.ws; C.in = args.in; C.out = args.out;
    C.wave = __builtin_amdgcn_readfirstlane((int)threadIdx.x >> 6); C.lane = lane_id_v(); C.tid = C.wave * 64 + C.lane;
    C.zs = 0; C.G = 0; C.bx = 0; C.gw = 0; C.NGW = 0; C.vb = 0;
    for (int u = C.tid; u < (LDS_BYTES - LDS_CTL) / 4; u += 512) ((LAS unsigned*)(C.lds + LDS_CTL))[u] = 0u;
    __syncthreads();
    (void)xcd_barrier_post((unsigned*)(args.ws + WS_CTL) + 4096, (volatile LAS unsigned*)(C.lds + LDS_CTL + 64), C.tid);
#if ONE_LAUNCH
    constexpr int lo = 0, hi = 1 << 20; int ph = 0;
#else
    const int lo = args.ph_lo, hi = args.ph_hi; int ph = 0;
#endif
#define PH_IF if (ph >= lo && ph < hi) if (launder(C, args), true)
#define PH_NEXT do { const bool both_ = (ph >= lo) && (ph + 1 < hi); ++ph; if (both_) { launder(C, args); XcdBarrier b_; b_.bar = (unsigned*)(C.ws + WS_CTL) + 4096; b_.x = xb_xcc_id() + (unsigned)C.zs; b_.st = (volatile LAS unsigned*)(C.lds + LDS_CTL + 64); xcd_barrier(b_, C.tid); } } while (0)
#define ring C.lds
#define MOD ((const float*)(C.ws + WS_MOD))
#define X ((float*)(C.ws + WS_X))

#if DUP_PRO == 1
    PH_IF { phase_prologue(C); } PH_NEXT;
#endif
    PH_IF {
#ifndef NO_PROLOGUE
 phase_prologue(C);
#endif
 } PH_NEXT;
    PH_IF { phase_mod_reduce(C);
        pg8::Gemm g{(const bf16*)(C.ws + WS_W3T), (const bf16*)(C.ws + WS_H2), 16384, 4352, 256}; pg8::StaticOrder S; S.init(16384, 4352, C.G, C.bx);
        pg8::EpiF32 E{(float*)(C.ws + WS_SCAN), 4352};
        pg8::gemm_phase<pg8::EpiF32, pg8::StaticOrder, true, true>(ring, g, S, E, C.wave); } PH_NEXT;
#if DUP_PRO == 2
    PH_IF { phase_hyena_filters(C); } PH_NEXT;
#endif
    PH_IF {
#ifndef NO_HYENA
 phase_hyena_filters(C);
#endif
 } PH_NEXT;

#define FFN_BLOCK(l, fi, s, cf) do { \
    if (!SKIP_FFN) { \
    PH_IF { phase_norm_mod(C, C.in[I_NG] + ((l) * 3 + (s)) * 2048, MOD + (size_t)(l) * MODL, (s)); } PH_NEXT; \
    PH_IF { pg8::Gemm g{(const bf16*)(C.ws + WS_H), (const bf16*)(C.ws + WS_W1T) + (size_t)((l) * 2 + (fi)) * NFF1 * 2048, MT, NFF1, 2048}; pg8::StaticOrder S; S.init(MT, NFF1, C.G, C.bx); \
        pg8::EpiSwiGLU E{(bf16*)(C.ws + WS_ACT), DFF}; pg8::gemm_phase<pg8::EpiSwiGLU, pg8::StaticOrder, false, true>(ring, g, S, E, C.wave); \
        { const int nf_ = (l) * 2 + (fi) + 1, idle0_ = (MT / 256) * (NFF1 / 256) % C.G; if ((cf) != 0.0f && nf_ < 8 && C.bx >= idle0_) { launder(C, args); \
            tr_matrix<0>(C, C.in[I_WFO] + (size_t)nf_ * DFF * 2048, 2048, DFF, (bf16*)(C.ws + WS_W2T) + (size_t)nf_ * 2048 * DFF, 2048, 2048, (C.bx - idle0_) * 8 + C.wave, (C.G - idle0_) * 8); } } } PH_NEXT; \
    PH_IF { pg8::Gemm g{(const bf16*)(C.ws + WS_ACT), (const bf16*)(C.ws + WS_W2T) + (size_t)((l) * 2 + (fi)) * 2048 * DFF, MT, 2048, DFF}; \
        pg8::EpiRes E{X, MOD + (size_t)(l) * MODL + (3 * (s) + 2) * 2048, (cf)}; \
        { pg8::PairOrder<1> S; S.init(MT, 2048, DFF, C.G, C.bx, (float*)(C.ws + WS_Z), (unsigned*)(C.ws + WS_CTL) + 16384, (DUP_FFN ? 8u * (unsigned)(2 * ((l) * 2 + (fi)) + ((cf) != 0.0f ? 2 : 1)) : 8u * (unsigned)((l) * 2 + (fi) + 1))); \
          pg8::gemm_phase<pg8::EpiRes, pg8::PairOrder<1>, false, true>(ring, g, S, E, C.wave); } \
        { launder(C, args); pg8::PairOrder<2> S; S.init(MT, 2048, DFF, C.G, C.bx, (float*)(C.ws + WS_Z), (unsigned*)(C.ws + WS_CTL) + 16384, (DUP_FFN ? 8u * (unsigned)(2 * ((l) * 2 + (fi)) + ((cf) != 0.0f ? 2 : 1)) : 8u * (unsigned)((l) * 2 + (fi) + 1))); \
          pg8::Gemm g2{(const bf16*)(C.ws + WS_ACT), (const bf16*)(C.ws + WS_W2T) + (size_t)((l) * 2 + (fi)) * 2048 * DFF, MT, 2048, DFF}; pg8::EpiRes E2{X, MOD + (size_t)(l) * MODL + (3 * (s) + 2) * 2048, (cf)}; \
          pg8::gemm_phase<pg8::EpiRes, pg8::PairOrder<2>, true, true>(ring, g2, S, E2, C.wave); } \
        { const int nf_ = (l) * 2 + (fi) + 1; if ((cf) != 0.0f && nf_ < 8 && !(C.G >= 235 && !SKIP_EVEN && ((l) & 1) == 0 && (fi) == 0) && !(C.G == 256 && !SKIP_EVEN && ((l) & 1) == 0 && (fi) == 1)) { launder(C, args); \
            tr_matrix<1>(C, C.in[I_WFI] + (size_t)nf_ * 2048 * NFF1, NFF1, 2048, (bf16*)(C.ws + WS_W1T) + (size_t)nf_ * NFF1 * 2048, NFF1, NFF1, C.gw, C.NGW); } } } PH_NEXT; \
    } } while (0)

    auto layer_pair = [&](auto PC) __attribute__((always_inline)) {
        constexpr int p = decltype(PC)::value; constexpr int le = 2 * p, lod = 2 * p + 1;
#if DUP_FFN
        FFN_BLOCK(le, 0, 0, 0.0f);
#endif
        FFN_BLOCK(le, 0, 0, 0.5f);
        auto even_mix = [&](float cf, int qslot) __attribute__((always_inline)) {
            const int e = p;
            PH_IF { phase_norm_mod(C, C.in[I_NG] + (le * 3 + 1) * 2048, MOD + (size_t)le * MODL, 1); } PH_NEXT;
            PH_IF { pg8::Gemm g{(const bf16*)(C.ws + WS_H), (const bf16*)(C.ws + WS_WINE) + (size_t)e * ZE_P * 2048, MT, ZE_P, 2048}; pg8::StaticOrder S; S.init(MT, ZE_P, C.G, C.bx);
                pg8::EpiF32 E{(float*)(C.ws + WS_Z), ZE_P}; pg8::gemm_phase<pg8::EpiF32, pg8::StaticOrder, true, true>(ring, g, S, E, C.wave);
                { const int nf_ = le * 2 + 2, idle0_ = (MT / 256) * (ZE_P / 256) % C.G;
                  if (cf != 0.0f && C.G == 256 && C.bx >= idle0_) { launder(C, args);
                    tr_matrix<1>(C, C.in[I_WFI] + (size_t)nf_ * 2048 * NFF1, NFF1, 2048, (bf16*)(C.ws + WS_W1T) + (size_t)nf_ * NFF1 * 2048, NFF1, NFF1, (C.bx - idle0_) * 8 + C.wave, (C.G - idle0_) * 8); } } } PH_NEXT;
#if DUP_E == 5
            PH_IF { phase_even_prep(C, e); } PH_NEXT;
#endif
            PH_IF { phase_even_prep(C, e); } PH_NEXT;
#if DUP_E == 7
            PH_IF {
                { pg8::Gemm g{(const bf16*)(C.ws + WS_LA), (const bf16*)(C.ws + WS_WLORA) + (size_t)e * 5120 * 384, MT, 5120, 384}; pg8::StaticOrder S; S.init(MT, 5120, C.G, C.bx);
                  pg8::EpiLora E{C.ws, C.in[I_W0] + e * 2048, C.in[I_A0] + e * 2048, C.in[I_KA] + e * 1024, WS_SCAN + (size_t)e * SCAN_BYTES, WS_KBUF, WS_GB};
                  pg8::gemm_phase<pg8::EpiLora, pg8::StaticOrder, true, true>(ring, g, S, E, C.wave); }
                launder(C, args);
                { pg8::Gemm g{(const bf16*)(C.ws + WS_CQ), (const bf16*)(C.ws + WS_WQ) + (size_t)e * 1536 * 512, MT, 1536, 512}; pg8::StaticOrder S; S.init(MT, 1536, C.G, C.bx);
                  pg8::EpiQ E{(bf16*)(C.ws + WS_Q), (const float*)(C.ws + WS_ROPE), 0.07216878364870322f * 1.4426950408889634f};
                  pg8::gemm_phase<pg8::EpiQ, pg8::StaticOrder, true, true>(ring, g, S, E, C.wave); }
                launder(C, args);
                { pg8::Gemm g{(const bf16*)(C.ws + WS_CKV), (const bf16*)(C.ws + WS_WKN) + (size_t)e * 1024 * 256, MKV, 1024, 256}; pg8::StaticOrder S; S.init(MKV, 1024, C.G, C.bx);
                  pg8::EpiBf16Plain E{(bf16*)(C.ws + WS_KN), 1024};
                  pg8::gemm_phase<pg8::EpiBf16Plain, pg8::StaticOrder, false, false>(ring, g, S, E, C.wave); }
                launder(C, args);
                { pg8::Gemm g{(const bf16*)(C.ws + WS_WV) + (size_t)e * 1024 * 256, (const bf16*)(C.ws + WS_CKV), 1024, MKV, 256}; pg8::StaticOrder S; S.init(1024, MKV, C.G, C.bx);
                  pg8::EpiVT E{(bf16*)(C.ws + WS_VT), VT_S_OFF / 2};
                  pg8::gemm_phase<pg8::EpiVT, pg8::StaticOrder, false, false>(ring, g, S, E, C.wave); }
            } PH_NEXT;
#endif
            PH_IF {
                { pg8::Gemm g{(const bf16*)(C.ws + WS_LA), (const bf16*)(C.ws + WS_WLORA) + (size_t)e * 5120 * 384, MT, 5120, 384}; pg8::StaticOrder S; S.init(MT, 5120, C.G, C.bx);
                  pg8::EpiLora E{C.ws, C.in[I_W0] + e * 2048, C.in[I_A0] + e * 2048, C.in[I_KA] + e * 1024, WS_SCAN + (size_t)e * SCAN_BYTES, WS_KBUF, WS_GB};
                  pg8::gemm_phase<pg8::EpiLora, pg8::StaticOrder, true, true>(ring, g, S, E, C.wave); }
                launder(C, args);
                { pg8::Gemm g{(const bf16*)(C.ws + WS_CQ), (const bf16*)(C.ws + WS_WQ) + (size_t)e * 1536 * 512, MT, 1536, 512}; pg8::StaticOrder S; S.init(MT, 1536, C.G, (C.bx + 64) % C.G);
                  pg8::EpiQ E{(bf16*)(C.ws + WS_Q), (const float*)(C.ws + WS_ROPE), 0.07216878364870322f * 1.4426950408889634f};
                  pg8::gemm_phase<pg8::EpiQ, pg8::StaticOrder, true, true>(ring, g, S, E, C.wave); }
                launder(C, args);
                { pg8::Gemm g{(const bf16*)(C.ws + WS_CKV), (const bf16*)(C.ws + WS_WKN) + (size_t)e * 1024 * 256, MKV, 1024, 256}; pg8::StaticOrder S; S.init(MKV, 1024, C.G, (C.bx + 32) % C.G);
                  pg8::EpiBf16Plain E{(bf16*)(C.ws + WS_KN), 1024};
                  pg8::gemm_phase<pg8::EpiBf16Plain, pg8::StaticOrder, false, false>(ring, g, S, E, C.wave); }
                launder(C, args);
                { pg8::Gemm g{(const bf16*)(C.ws + WS_WV) + (size_t)e * 1024 * 256, (const bf16*)(C.ws + WS_CKV), 1024, MKV, 256}; pg8::StaticOrder S; S.init(1024, MKV, C.G, (C.bx + 88) % C.G);
                  pg8::EpiVT E{(bf16*)(C.ws + WS_VT), VT_S_OFF / 2};
                  pg8::gemm_phase<pg8::EpiVT, pg8::StaticOrder, false, false>(ring, g, S, E, C.wave); }
            } PH_NEXT;
#if DUP_E == 1
            PH_IF { phase_scan1(C, e, 2); } PH_NEXT;
#endif
            PH_IF {
#ifndef NO_SCAN
 phase_scan1(C, e, qslot);
#endif
 } PH_NEXT;
#if DUP_E == 2
            PH_IF { phase_scan_carry(C, e, 8); __syncthreads(); } PH_NEXT;
#endif
            PH_IF { const bool host_ = cf != 0.0f && C.G >= 235; phase_scan_carry(C, e, host_ ? 3 : 8);
                if (host_ && C.bx >= 64 && C.wave >= 3) { launder(C, args); const int nf_ = le * 2 + 1;
                    tr_matrix<1>(C, C.in[I_WFI] + (size_t)nf_ * 2048 * NFF1, NFF1, 2048, (bf16*)(C.ws + WS_W1T) + (size_t)nf_ * NFF1 * 2048, NFF1, NFF1, (C.bx - 64) * 5 + C.wave - 3, (C.G - 64) * 5); }
                __syncthreads(); } PH_NEXT;
#if DUP_E == 3
            PH_IF { phase_scan3(C, e); } PH_NEXT;
#endif
#if DUP_E == 4
            PH_IF { phase_attention(C); } PH_NEXT;
#endif
            PH_IF {
#ifndef NO_SCAN
 phase_scan3(C, e);
#endif
#ifndef NO_ATTN
 phase_attention(C);
#endif
 } PH_NEXT;
#if DUP_E == 6
            PH_IF { phase_rwkv_post(C, e); } PH_NEXT;
#endif
            PH_IF { phase_rwkv_post(C, e); } PH_NEXT;
            PH_IF { pg8::Gemm g{(const bf16*)(C.ws + WS_MIX), (const bf16*)(C.ws + WS_WOUTE) + (size_t)e * 2048 * 2048, MT, 2048, 2048}; pg8::StaticOrder S; S.init(MT, 2048, C.G, C.bx);
                pg8::EpiRes E{X, MOD + (size_t)le * MODL + (3 * 1 + 2) * 2048, cf}; pg8::gemm_phase<pg8::EpiRes, pg8::StaticOrder, false, true>(ring, g, S, E, C.wave); } PH_NEXT;
        };
#if DUP_EVEN
        even_mix(0.0f, 1);
#endif
        if (!SKIP_EVEN) even_mix(1.0f, 0);
#if DUP_FFN
        FFN_BLOCK(le, 1, 2, 0.0f);
#endif
        FFN_BLOCK(le, 1, 2, 0.5f);
#if DUP_FFN
        FFN_BLOCK(lod, 0, 0, 0.0f);
#endif
        FFN_BLOCK(lod, 0, 0, 0.5f);
        auto odd_mix = [&](float cf) __attribute__((always_inline)) {
            const int o = p;
            PH_IF { phase_norm_mod(C, C.in[I_NG] + (lod * 3 + 1) * 2048, MOD + (size_t)lod * MODL, 1); } PH_NEXT;
            PH_IF { pg8::Gemm g{(const bf16*)(C.ws + WS_WINO) + (size_t)o * 6144 * 2048, (const bf16*)(C.ws + WS_H), 6144, MT, 2048}; pg8::StaticOrder S; S.init(6144, MT, C.G, C.bx);
                pg8::EpiZT E{(float*)(C.ws + WS_Z), (float*)(C.ws + WS_Z + ZT_S_OFF)}; pg8::gemm_phase<pg8::EpiZT, pg8::StaticOrder, false, true>(ring, g, S, E, C.wave); } PH_NEXT;
#if DUP_O == 1
            PH_IF { phase_hyena_conv(C, o); } PH_NEXT;
#endif
#if DUP_O == 2
            PH_IF { phase_hyena_conv<1>(C, o); } PH_NEXT;
#endif
            PH_IF {
#ifndef NO_HYENA
 phase_hyena_conv(C, o);
#endif
 } PH_NEXT;
            PH_IF { pg8::Gemm g{(const bf16*)(C.ws + WS_MIX), (const bf16*)(C.ws + WS_WOUTO) + (size_t)o * 2048 * 2048, MT, 2048, 2048}; pg8::StaticOrder S; S.init(MT, 2048, C.G, C.bx);
                pg8::EpiRes E{X, MOD + (size_t)lod * MODL + (3 * 1 + 2) * 2048, cf}; pg8::gemm_phase<pg8::EpiRes, pg8::StaticOrder, false, true>(ring, g, S, E, C.wave); } PH_NEXT;
        };
#if DUP_ODD
        odd_mix(0.0f);
#endif
        if (!SKIP_ODD) odd_mix(1.0f);
#if DUP_FFN
        FFN_BLOCK(lod, 1, 2, 0.0f);
#endif
        FFN_BLOCK(lod, 1, 2, 0.5f);
    };
    layer_pair(IntC<0>{}); layer_pair(IntC<1>{});
    PH_IF { phase_final_norm(C); } PH_NEXT;
#undef MOD
#undef X
#undef ring
}

extern "C" void kernel_launch(void* const* d_in, const int* in_sizes, int n_in, void* d_out, int out_size, void* d_ws, size_t ws_size, hipStream_t stream) {
    static int grid = 0;
    if (grid == 0) {
        if (n_in != 42 || (size_t)out_size != OUT_END || ws_size < WS_END) { fprintf(stderr, "kernel_launch: unexpected sizes n_in %d out %d ws %zu (need %zu)\n", n_in, out_size, ws_size, (size_t)WS_END); grid = -1; return; }
        int dev = 0, cus = 0, per_cu = 0;
        if (hipGetDevice(&dev) != hipSuccess || hipDeviceGetAttribute(&cus, hipDeviceAttributeMultiprocessorCount, dev) != hipSuccess) { grid = -1; return; }
        if (hipFuncSetAttribute((const void*)mega_fwd, hipFuncAttributeMaxDynamicSharedMemorySize, LDS_BYTES) != hipSuccess) { fprintf(stderr, "kernel_launch: hipFuncSetAttribute failed\n"); grid = -1; return; }
        if (hipOccupancyMaxActiveBlocksPerMultiprocessor(&per_cu, (const void*)mega_fwd, 512, LDS_BYTES) != hipSuccess || per_cu < 1) fprintf(stderr, "kernel_launch: occupancy query says %d\n", per_cu);
        (void)hipGetLastError();
        grid = cus;
    }
    if (grid < 0) return;
    (void)hipMemsetAsync((char*)d_ws + WS_CTL, 0, CTL_ZERO_BYTES, stream);
    KArgs a{};
    for (int i = 0; i < 42; ++i) a.in[i] = (const float*)d_in[i];
    a.out = (float*)d_out; a.ws = (unsigned char*)d_ws;
#if ONE_LAUNCH
    a.ph_lo = 0; a.ph_hi = 1 << 20;
    hipLaunchKernelGGL(mega_fwd, dim3(grid), dim3(512), LDS_BYTES, stream, a);
#else
    for (int i = 0; i < NPH_MAX; ++i) { a.ph_lo = i; a.ph_hi = i + 1; hipLaunchKernelGGL(mega_fwd, dim3(grid), dim3(512), LDS_BYTES, stream, a); }
#endif
}
```

```cpp
#include <hip/hip_runtime.h>
#include <cstdio>
#include <cstdint>
#include <utility>
#define DI __device__ __forceinline__
#define GAS __attribute__((address_space(1)))
#define LAS __attribute__((address_space(3)))
#define CAS __attribute__((address_space(4)))
typedef unsigned short bf16;
typedef unsigned v4u __attribute__((ext_vector_type(4)));
typedef unsigned v2u __attribute__((ext_vector_type(2)));
typedef float f32x4v __attribute__((ext_vector_type(4)));
typedef float f32x2v __attribute__((ext_vector_type(2)));
typedef float f32x16v __attribute__((ext_vector_type(16)));
typedef short s16x8v __attribute__((ext_vector_type(8)));
typedef short s16x4v __attribute__((ext_vector_type(4)));

constexpr int D = 2048, MP = 4096, MS = 8192, MT = 12288, MKV = 12800;
constexpr int DFF = 5632, NFF1 = 11264;
constexpr int ZE_N = 4192, ZE_P = 4352;
constexpr int SCAN_P = 9 * 1024;
constexpr int NCH = 32, CHL = 4096 / NCH;
constexpr int MODL = 3 * 18432;

DI int lane_id_v() { int l; asm volatile("v_mbcnt_lo_u32_b32 %0, -1, 0\n\tv_mbcnt_hi_u32_b32 %0, -1, %0" : "=v"(l)); return l; }
DI unsigned f2bf(float f) { unsigned u = __builtin_bit_cast(unsigned, f); return (u + 0x7fffu + ((u >> 16) & 1u)) >> 16; }
DI unsigned pk2(float lo, float hi) { unsigned r; asm("v_cvt_pk_bf16_f32 %0, %1, %2" : "=v"(r) : "v"(lo), "v"(hi)); return r; }
DI float bf2f(unsigned short b) { return __builtin_bit_cast(float, ((unsigned)b) << 16); }
template <int CTRL> DI float dpp_f(float v) { return __builtin_bit_cast(float, __builtin_amdgcn_update_dpp(0, __builtin_bit_cast(int, v), CTRL, 0xf, 0xf, true)); }
DI float shfl_idx(float v, int src) { return __builtin_bit_cast(float, __builtin_amdgcn_ds_bpermute(src << 2, __builtin_bit_cast(int, v))); }
DI float wave_sum(float v) {
    v += dpp_f<0xB1>(v); v += dpp_f<0x4E>(v); v += dpp_f<0x141>(v); v += dpp_f<0x140>(v);
    v += __builtin_bit_cast(float, __builtin_amdgcn_ds_swizzle(__builtin_bit_cast(int, v), 0x401F));
    return __builtin_bit_cast(float, __builtin_amdgcn_readlane(__builtin_bit_cast(int, v), 0)) + __builtin_bit_cast(float, __builtin_amdgcn_readlane(__builtin_bit_cast(int, v), 32));
}
DI float sigmoid_f(float x) { return __builtin_amdgcn_rcpf(1.f + __expf(-x)); }
DI float silu_f(float x) { return x * sigmoid_f(x); }
DI int scan_perm(int j) { return 4 * (j & 15) + (j >> 4); }
DI int row_mod_j(int row) { return row < MP ? 0 : 1 + ((row - MP) >> 12); }
namespace pg8 {
#define PG8_LAS __attribute__((address_space(3)))
typedef unsigned short bf16_t;
typedef short bf16x8 __attribute__((ext_vector_type(8)));
typedef float f32x4 __attribute__((ext_vector_type(4)));
typedef unsigned u32x4 __attribute__((ext_vector_type(4)));
constexpr int BM = 256, BK = 64, HALF = 128, HTB = HALF * BK * 2  , STAGE_BYTES = 8 * HTB, NXCD = 8, WGM = 8;

__host__ __device__ __forceinline__ int lds_byte(int r, int c) { const int st = (r >> 4) * 2 + (c >> 5), rr = r & 15, cc = c & 31, ob = rr * 64 + cc * 2; return st * 1024 + (ob ^ (((ob >> 9) & 1) << 5)); }
__host__ __device__ __forceinline__ void stage_rc(int b, int& R, int& C) { const int st = b / 1024, sb = b % 1024, swz = sb ^ (((sb >> 9) & 1) << 5); R = (st >> 1) * 16 + swz / 64; C = (st & 1) * 32 + (swz % 64) / 2; }
__host__ __device__ __forceinline__ int perm32(int rho) { const int n = rho >> 4, i = rho & 15; return 8 * (i >> 2) + 4 * n + (i & 3); }

struct Unit { int pm, pn; int kt0, nkt, mode, slot; };
struct Gemm { const bf16_t* A; const bf16_t* Bt; int M, N, K; };
struct StaticOrder {
    static constexpr int SPLITK = 0;
    int nM, nN, nwg, G, c;
    __host__ __device__ __forceinline__ void init(int M, int N, int G_, int c_) { nM = M / BM; nN = N / BM; nwg = nM * nN; G = G_; c = c_; }
    __host__ __device__ __forceinline__ bool next(int i, Unit& u) const {
        const long L = (long)i * G + c; if (L >= nwg) return false;
        int wgid = (int)L; { const int q = nwg / NXCD, r = nwg % NXCD, xcd = wgid % NXCD, off = wgid / NXCD; wgid = (xcd < r ? xcd * (q + 1) : r * (q + 1) + (xcd - r) * q) + off; }
        const int nig = WGM * nN, gid = wgid / nig, fm = gid * WGM, gsz = (nM - fm) < WGM ? (nM - fm) : WGM;
        u.pm = fm + ((wgid % nig) % gsz); u.pn = (wgid % nig) / gsz; u.kt0 = 0; u.nkt = 0; u.mode = 0; u.slot = 0; return true;
    }
    __device__ __forceinline__ void a_ready(const Unit&) const {}
    __device__ __forceinline__ void done(const Unit&) const {}
    __device__ __forceinline__ void publish(const f32x4 (&)[2][2][4][2], const Unit&, int, int) const {}
    __device__ __forceinline__ void consume(f32x4 (&)[2][2][4][2], const Unit&, int, int) const {}
};

template <int PART> struct PairOrder {
    static constexpr int SPLITK = PART;
    StaticOrder so; int R, rem, nt; bool paired;
    float* scratch; unsigned* flags; unsigned target;
    __device__ __forceinline__ void init(int M, int N, int K, int G_, int c_, float* scr, unsigned* fl, unsigned tgt) { so.init(M, N, G_, 0); so.c = 0; so.G = 1; R = so.nwg / G_; rem = so.nwg % G_; nt = K / BK;
        paired = (2 * rem == G_) && ((nt / 2) % 2 == 0); c = c_; G = G_; scratch = scr; flags = fl; target = tgt; }
    int c, G;
    __device__ __forceinline__ bool tile(int t, Unit& u) const { return so.next(t, u); }
    __device__ __forceinline__ bool next(int i, Unit& u) const {
        int t = -1, kt0 = 0, nk = nt, mode = 0, slot = 0;
        if (!paired) { if (PART == 1) { const long L = (long)i * G + c; if (L < so.nwg) t = (int)L; } }
        else if (PART == 1) {
            if (c < rem) { if (i == 0) { t = R * G + c; nk = nt / 2; mode = 1; slot = c; } else if (i <= R) t = (i - 1) * G + c; }
            else if (i < R) t = i * G + c;
        }
        else if (c >= rem && i == 0) { t = R * G + (c - rem); kt0 = nt / 2; nk = nt - nt / 2; mode = 2; slot = c - rem; }
        if (t < 0) return false;
        tile(t, u); u.kt0 = kt0; u.nkt = nk; u.mode = mode; u.slot = slot; return true;
    }
    __device__ __forceinline__ void a_ready(const Unit&) const {}
    __device__ __forceinline__ void done(const Unit&) const {}
    __device__ __forceinline__ void publish(const f32x4 (&acc)[2][2][4][2], const Unit& u, int wid, int lane) const {
        const __amdgpu_buffer_rsrc_t rs = __builtin_amdgcn_make_buffer_rsrc((void*)scratch, 0, 0x7fffffff, 0x00020000);
        const int so_ = __builtin_amdgcn_readfirstlane(u.slot * 262144 + wid * 32768), vo = lane * 16;
#pragma unroll
        for (int ai = 0; ai < 2; ++ai)
#pragma unroll
            for (int bj = 0; bj < 2; ++bj)
#pragma unroll
                for (int m = 0; m < 4; ++m)
#pragma unroll
                    for (int n = 0; n < 2; ++n) { const int r = ((ai * 2 + bj) * 4 + m) * 2 + n;
                        __builtin_amdgcn_raw_buffer_store_b128(__builtin_bit_cast(u32x4, acc[ai][bj][m][n]), rs, vo, so_ + r * 1024, 16); }
        asm volatile("s_waitcnt vmcnt(0)" ::: "memory");
        if (lane == 0) __hip_atomic_fetch_add(flags + 64 * u.slot, 1u, __ATOMIC_RELAXED, __HIP_MEMORY_SCOPE_AGENT);
    }
    __device__ __forceinline__ void consume(f32x4 (&acc)[2][2][4][2], const Unit& u, int wid, int lane) const {
        unsigned spins = 0;
        while ((unsigned)__builtin_amdgcn_readfirstlane((int)__hip_atomic_load(flags + 64 * u.slot, __ATOMIC_RELAXED, __HIP_MEMORY_SCOPE_AGENT)) < target) { __builtin_amdgcn_s_sleep(2); if (++spins > (1u << 22)) break; }
        __builtin_amdgcn_fence(__ATOMIC_ACQUIRE, "agent");
        asm volatile("s_waitcnt vmcnt(0)" ::: "memory");
        const __amdgpu_buffer_rsrc_t rs = __builtin_amdgcn_make_buffer_rsrc((void*)scratch, 0, 0x7fffffff, 0x00020000);
        const int so_ = __builtin_amdgcn_readfirstlane(u.slot * 262144 + wid * 32768), vo = lane * 16;
#pragma unroll
        for (int ai = 0; ai < 2; ++ai)
#pragma unroll
            for (int bj = 0; bj < 2; ++bj)
#pragma unroll
                for (int mh = 0; mh < 2; ++mh) {
                    f32x4 t[4];
#pragma unroll
                    for (int q = 0; q < 4; ++q) { const int m = mh * 2 + (q >> 1), n = q & 1; const int r = ((ai * 2 + bj) * 4 + m) * 2 + n; t[q] = __builtin_bit_cast(f32x4, __builtin_amdgcn_raw_buffer_load_b128(rs, vo, so_ + r * 1024, 16)); }
#pragma unroll
                    for (int q = 0; q < 4; ++q) { const int m = mh * 2 + (q >> 1), n = q & 1; acc[ai][bj][m][n] += t[q]; }
                    asm volatile("" ::: "memory");
                }
    }
};
__device__ __forceinline__ unsigned cvt_pk_bf16(float lo, float hi) { unsigned r; asm volatile("v_cvt_pk_bf16_f32 %0, %1, %2" : "=v"(r) : "v"(lo), "v"(hi)); return r; }
typedef float f32x2 __attribute__((ext_vector_type(2)));
#define EPI_LOOP_AIM _Pragma("unroll") for (int ai = 0; ai < 2; ++ai) _Pragma("unroll") for (int m = 0; m < 4; ++m)
#define EPI_LOOP_BJN _Pragma("unroll") for (int bj = 0; bj < 2; ++bj) _Pragma("unroll") for (int n = 0; n < 2; ++n)
struct EpiF32 {
    static constexpr bool PERM = false, AFTER_DRAIN = false;
    float* C; int ldc;
    __device__ __forceinline__ void operator()(const f32x4 (&acc)[2][2][4][2], const Unit& u, int wr, int wc, int fr, int fq) const {
        const int row0 = u.pm * BM + wr * 64 + fr, col0 = u.pn * BM + wc * 32 + 4 * fq;
        EPI_LOOP_AIM { float* rowp = C + (size_t)(row0 + ai * HALF + m * 16) * ldc + col0;
            EPI_LOOP_BJN *(f32x4*)(rowp + bj * HALF + n * 16) = acc[ai][bj][m][n]; }
    }
};
struct EpiBf16Plain {
    static constexpr bool PERM = true, AFTER_DRAIN = false;
    bf16_t* O; int ldc;
    __device__ __forceinline__ void operator()(const f32x4 (&acc)[2][2][4][2], const Unit& u, int wr, int wc, int fr, int fq) const {
        const int row0 = u.pm * BM + wr * 64 + fr, col0 = u.pn * BM + wc * 32 + 8 * fq;
        EPI_LOOP_AIM { bf16_t* rowp = O + (size_t)(row0 + ai * HALF + m * 16) * ldc + col0;
#pragma unroll
            for (int bj = 0; bj < 2; ++bj) { const f32x4 v0 = acc[ai][bj][m][0], v1 = acc[ai][bj][m][1];
                u32x4 w; w.x = cvt_pk_bf16(v0[0], v0[1]); w.y = cvt_pk_bf16(v0[2], v0[3]); w.z = cvt_pk_bf16(v1[0], v1[1]); w.w = cvt_pk_bf16(v1[2], v1[3]);
                *(u32x4*)(rowp + bj * HALF) = w; } }
    }
};
struct EpiSwiGLU {
    static constexpr bool PERM = true, AFTER_DRAIN = false;
    bf16_t* O; int ldc;
    __device__ __forceinline__ void operator()(const f32x4 (&acc)[2][2][4][2], const Unit& u, int wr, int wc, int fr, int fq) const {
        const int row0 = u.pm * BM + wr * 64 + fr, col0 = u.pn * HALF + wc * 32 + 8 * fq;
        EPI_LOOP_AIM { bf16_t* rowp = O + (size_t)(row0 + ai * HALF + m * 16) * ldc + col0;
            float o[8];
#pragma unroll
            for (int n = 0; n < 2; ++n)
#pragma unroll
                for (int i = 0; i < 4; ++i) { const float g = acc[ai][0][m][n][i], up = acc[ai][1][m][n][i]; o[n * 4 + i] = g * __builtin_amdgcn_rcpf(1.f + __expf(-g)) * up; }
            u32x4 w; w.x = cvt_pk_bf16(o[0], o[1]); w.y = cvt_pk_bf16(o[2], o[3]); w.z = cvt_pk_bf16(o[4], o[5]); w.w = cvt_pk_bf16(o[6], o[7]);
            *(u32x4*)rowp = w; }
    }
};
struct EpiRes {
    static constexpr bool PERM = false, AFTER_DRAIN = false;
    float* X; const float* gate; float coef;
    __device__ __forceinline__ void operator()(const f32x4 (&acc)[2][2][4][2], const Unit& u, int wr, int wc, int fr, int fq) const {
        const int row0 = u.pm * BM + wr * 64 + fr, col0 = u.pn * BM + wc * 32 + 4 * fq;
        const int rt = u.pm * BM; const int j = rt < 4096 ? 0 : 1 + ((rt - 4096) >> 12);
        const float* g = gate + j * 18432 + col0;
        f32x4 gv[2][2];
        EPI_LOOP_BJN gv[bj][n] = *(const f32x4*)(g + bj * HALF + n * 16) * coef;
        EPI_LOOP_AIM { float* rowp = X + (size_t)(row0 + ai * HALF + m * 16) * 2048 + col0;
            EPI_LOOP_BJN { f32x4 x = *(const f32x4*)(rowp + bj * HALF + n * 16); x += gv[bj][n] * acc[ai][bj][m][n]; *(f32x4*)(rowp + bj * HALF + n * 16) = x; }
            asm volatile("" ::: "memory"); }
    }
};
struct EpiZT {
    static constexpr bool PERM = false, AFTER_DRAIN = false;
    float* ZTp; float* ZTs;
    __device__ __forceinline__ void operator()(const f32x4 (&acc)[2][2][4][2], const Unit& u, int wr, int wc, int fr, int fq) const {
        const int ch0 = u.pm * BM + wr * 64 + fr, tok0 = u.pn * BM;
        float* base; int pitch, toff;
        if (tok0 < 4096) { base = ZTp + (size_t)(tok0 >> 8) * 6144 * 256; pitch = 256; toff = 0; }
        else { const int tk = tok0 - 4096; base = ZTs + (size_t)(tk >> 12) * 6144 * 4096; pitch = 4096; toff = tk & 4095; }
        const int c0 = toff + wc * 32 + 4 * fq;
        EPI_LOOP_AIM { float* rowp = base + (size_t)(ch0 + ai * HALF + m * 16) * pitch + c0;
            EPI_LOOP_BJN *(f32x4*)(rowp + bj * HALF + n * 16) = acc[ai][bj][m][n]; }
    }
};
struct EpiVT {
    static constexpr bool PERM = true, AFTER_DRAIN = false;
    bf16_t* VTp; size_t s_off;
    __device__ __forceinline__ void operator()(const f32x4 (&acc)[2][2][4][2], const Unit& u, int wr, int wc, int fr, int fq) const {
        const int ch0 = u.pm * BM + wr * 64 + fr, tok0 = u.pn * BM;
        bf16_t* base; int pitch, toff; bf16_t* VTs = VTp + s_off;
        if (tok0 < 4096) { base = VTp + (size_t)(tok0 >> 8) * 1024 * 256; pitch = 256; toff = 0; }
        else if (tok0 < 12288) { const int tk = tok0 - 4096; base = VTs + (size_t)(tk >> 12) * 1024 * 4352; pitch = 4352; toff = tk & 4095; }
        else { const int tk = tok0 - 12288; base = VTs + (size_t)(tk >> 8) * 1024 * 4352; pitch = 4352; toff = 4096; }
        const int c0 = toff + wc * 32 + 8 * fq;
        EPI_LOOP_AIM { bf16_t* rowp = base + (size_t)(ch0 + ai * HALF + m * 16) * pitch + c0;
#pragma unroll
            for (int bj = 0; bj < 2; ++bj) { const f32x4 v0 = acc[ai][bj][m][0], v1 = acc[ai][bj][m][1];
                u32x4 w; w.x = cvt_pk_bf16(v0[0], v0[1]); w.y = cvt_pk_bf16(v0[2], v0[3]); w.z = cvt_pk_bf16(v1[0], v1[1]); w.w = cvt_pk_bf16(v1[2], v1[3]);
                *(u32x4*)(rowp + bj * HALF) = w; } }
    }
};
struct EpiQ {
    static constexpr bool PERM = true, AFTER_DRAIN = false;
    bf16_t* Q; const float* rope; float qs;
    __device__ __forceinline__ void operator()(const f32x4 (&acc)[2][2][4][2], const Unit& u, int wr, int wc, int fr, int fq) const {
        const int row0 = u.pm * BM + wr * 64 + fr;
        EPI_LOOP_AIM { const int row = row0 + ai * HALF + m * 16; const bool smp = row >= 4096; const int t = (row - 4096) & 4095;
#pragma unroll
            for (int bj = 0; bj < 2; ++bj) { const int c0 = u.pn * BM + bj * HALF + wc * 32 + 8 * fq; const int within = c0 % 192;
                float o[8];
#pragma unroll
                for (int n = 0; n < 2; ++n)
#pragma unroll
                    for (int i = 0; i < 4; ++i) o[n * 4 + i] = acc[ai][bj][m][n][i];
                if (within >= 128 && smp) { const int ri = within - 128;
#pragma unroll
                    for (int q = 0; q < 4; ++q) { const int idx = ri + 2 * q, hf = idx >> 5, j = (idx & 31) >> 1; const int pos = hf ? (t & 63) : (t >> 6);
                        const float2 cs = *(const float2*)(rope + (pos * 16 + j) * 2); const float x1 = o[2 * q], x2 = o[2 * q + 1];
                        o[2 * q] = x1 * cs.x - x2 * cs.y; o[2 * q + 1] = x2 * cs.x + x1 * cs.y; } }
                u32x4 w; w.x = cvt_pk_bf16(o[0] * qs, o[1] * qs); w.y = cvt_pk_bf16(o[2] * qs, o[3] * qs); w.z = cvt_pk_bf16(o[4] * qs, o[5] * qs); w.w = cvt_pk_bf16(o[6] * qs, o[7] * qs);
                *(u32x4*)(Q + (size_t)row * 1536 + c0) = w; } }
    }
};
struct EpiLora {
    static constexpr bool PERM = false, AFTER_DRAIN = false;
    unsigned char* wsb; const float* w0; const float* a0; const float* ka; size_t off_sc, off_kb, off_gb;
    __device__ __forceinline__ void operator()(const f32x4 (&acc)[2][2][4][2], const Unit& u, int wr, int wc, int fr, int fq) const {
        const int row0 = u.pm * BM + wr * 64 + fr; const int seg = u.pn >> 2; const int cb = (u.pn & 3) * BM + wc * 32 + 4 * fq;
        float* SC = (float*)(wsb + off_sc); const float* KB = (const float*)(wsb + off_kb); float* GB = (float*)(wsb + off_gb);
        EPI_LOOP_AIM { const int row = row0 + ai * HALF + m * 16; float* sc = SC + (size_t)row * 9216;
            EPI_LOOP_BJN { const int c = cb + bj * HALF + n * 16; const f32x4 a = acc[ai][bj][m][n];
                if (seg < 2) { const f32x4 wv = *(const f32x4*)(w0 + seg * 1024 + c); f32x4 o;
#pragma unroll
                    for (int i = 0; i < 4; ++i) { const float x = wv[i] + a[i]; const float sp = __logf(1.f + __expf(-x)); o[i] = __expf(-__expf(-sp - 0.5f)); }
                    *(f32x4*)(sc + (3 + seg) * 1024 + c) = o; }
                else if (seg < 4) { const int d = seg - 2; const f32x4 av = *(const f32x4*)(a0 + d * 1024 + c), kav = *(const f32x4*)(ka + c);
                    const f32x4 kk = *(const f32x4*)(sc + 2 * 1024 + c), kr = *(const f32x4*)(KB + (size_t)row * 1024 + c); f32x4 o1, o2;
#pragma unroll
                    for (int i = 0; i < 4; ++i) { const float s = __builtin_amdgcn_rcpf(1.f + __expf(-(av[i] + a[i]))); o1[i] = kk[i] * s; o2[i] = kr[i] * (1.f + (s - 1.f) * kav[i]); }
                    *(f32x4*)(sc + (5 + d) * 1024 + c) = o1; *(f32x4*)(sc + (7 + d) * 1024 + c) = o2; }
                else *(f32x4*)(GB + (size_t)row * 1024 + c) = a; }
            asm volatile("" ::: "memory"); }
    }
};
template <class Epi, class Sched, bool ALIGN_EPI = false, bool SP2 = false>
__device__ __forceinline__ void gemm_phase(PG8_LAS unsigned char* lds, const Gemm g, const Sched& S, const Epi& E, int wave_id) {
    const int tid_l_ = wave_id * 64 + lane_id_v();
    const int tid = tid_l_, wid = __builtin_amdgcn_readfirstlane(tid >> 6), lane = tid & 63, wr = wid >> 2, wc = wid & 3, fr = lane & 15, fq = lane >> 4;
    const int K = g.K, nt = K / BK;
    unsigned voffA[2], voffB[2];
#pragma unroll
    for (int i = 0; i < 2; ++i) { int R, C; stage_rc(tid * 16 + i * 8192, R, C); const int Rb = Epi::PERM ? ((R & ~31) + perm32(R & 31)) : R;
        voffA[i] = (unsigned)(R * K + C) * 2u; voffB[i] = (unsigned)(Rb * K + C) * 2u; }
    const size_t kstep = (size_t)(BK * 2);
    const size_t hstep = (size_t)HALF * K * 2;
    const size_t tstep = 2 * hstep;
    const unsigned ldsw = (unsigned)wid * 1024u;
    const int aoff = lds_byte(wr * 64 + fr, fq * 8), boff = lds_byte(wc * 32 + fr, fq * 8);
#define PG8_SA(b, h) (((b) * 2 + (h)) * HTB)
#define PG8_SB(b, h) ((4 + (b) * 2 + (h)) * HTB)
#define PG8_STAGE(bufoff, gbase, voff) do { _Pragma("unroll") for (int _i = 0; _i < 2; ++_i) \
        __builtin_amdgcn_global_load_lds((const unsigned*)((const char*)(gbase) + (voff)[_i]), (PG8_LAS unsigned*)(lds + (bufoff) + ldsw + _i * 8192), 16, 0, 0); } while (0)
#define PG8_LDA(dst, b, h) do { _Pragma("unroll") for (int m = 0; m < 4; ++m) _Pragma("unroll") for (int k = 0; k < 2; ++k) dst[m][k] = *(const PG8_LAS bf16x8*)(lds + PG8_SA(b, h) + aoff + m * 2048 + k * 1024); } while (0)
#define PG8_LDB(dst, b, h) do { _Pragma("unroll") for (int n = 0; n < 2; ++n) _Pragma("unroll") for (int k = 0; k < 2; ++k) dst[n][k] = *(const PG8_LAS bf16x8*)(lds + PG8_SB(b, h) + boff + n * 2048 + k * 1024); } while (0)
#define PG8_MMA(ai, bj, At, Bt) do { __builtin_amdgcn_s_setprio(1); _Pragma("unroll") for (int m = 0; m < 4; ++m) _Pragma("unroll") for (int n = 0; n < 2; ++n) _Pragma("unroll") for (int k = 0; k < 2; ++k) \
        acc[ai][bj][m][n] = __builtin_amdgcn_mfma_f32_16x16x32_bf16(Bt[n][k], At[m][k], acc[ai][bj][m][n], 0, 0, 0); __builtin_amdgcn_s_setprio(0); } while (0)
#define PG8_WAIT_V(n) asm volatile("s_waitcnt vmcnt(" #n ")" ::: "memory")
#define PG8_WAIT_L(n) asm volatile("s_waitcnt lgkmcnt(" #n ")" ::: "memory")
#define PG8_BAR __builtin_amdgcn_s_barrier()
#define PG8_SCHED __builtin_amdgcn_sched_barrier(0)
    Unit cur, nxt; int ui = 0;
    if (!S.next(0, cur)) return;
    f32x4 acc[2][2][4][2];
#pragma unroll
    for (int a = 0; a < 2; ++a)
#pragma unroll
        for (int b = 0; b < 2; ++b)
#pragma unroll
            for (int m = 0; m < 4; ++m)
#pragma unroll
                for (int n = 0; n < 2; ++n) acc[a][b][m][n] = (f32x4){0.f, 0.f, 0.f, 0.f};
    bf16x8 At[4][2], B0[2][2], B1[2][2];
    const char* cA = (const char*)g.A + (size_t)cur.pm * tstep; const char* cB = (const char*)g.Bt + (size_t)cur.pn * tstep;
    if constexpr (Sched::SPLITK != 0) { cA += (size_t)cur.kt0 * kstep; cB += (size_t)cur.kt0 * kstep; }
    S.a_ready(cur);
    if constexpr (SP2) {
        PG8_STAGE(PG8_SB(0, 0), cB, voffB); PG8_STAGE(PG8_SB(0, 1), cB + hstep, voffB); PG8_STAGE(PG8_SA(0, 0), cA, voffA); PG8_STAGE(PG8_SA(0, 1), cA + hstep, voffA);
        if (wr == 1) PG8_BAR;
        PG8_WAIT_V(2); PG8_BAR;
        PG8_STAGE(PG8_SB(1, 0), cB + kstep, voffB); PG8_STAGE(PG8_SA(1, 0), cA + kstep, voffA); PG8_STAGE(PG8_SB(1, 1), cB + hstep + kstep, voffB);
        PG8_WAIT_V(6); PG8_BAR;
    } else {
        PG8_STAGE(PG8_SB(0, 0), cB, voffB); PG8_STAGE(PG8_SA(0, 0), cA, voffA); PG8_STAGE(PG8_SB(0, 1), cB + hstep, voffB); PG8_STAGE(PG8_SA(0, 1), cA + hstep, voffA);
        if (wr == 1) PG8_BAR;
        PG8_WAIT_V(4); PG8_BAR;
        PG8_STAGE(PG8_SB(1, 0), cB + kstep, voffB); PG8_STAGE(PG8_SA(1, 0), cA + kstep, voffA); PG8_STAGE(PG8_SB(1, 1), cB + hstep + kstep, voffB);
        PG8_WAIT_V(6); PG8_BAR;
    }
    for (;;) {
        const bool has_next = S.next(ui + 1, nxt);
        const char* nA = has_next ? (const char*)g.A + (size_t)nxt.pm * tstep : cA; const char* nB = has_next ? (const char*)g.Bt + (size_t)nxt.pn * tstep : cB;
        if constexpr (Sched::SPLITK != 0) { if (has_next) { nA += (size_t)nxt.kt0 * kstep; nB += (size_t)nxt.kt0 * kstep; } }
        const int cnt = Sched::SPLITK != 0 ? cur.nkt : nt;
        for (int t = 0; t < cnt; t += 2) {
            const bool last = (t == cnt - 2);
            const char* a1 = cA + (size_t)(t + 1) * kstep;
            const char* a2 = last ? nA : cA + (size_t)(t + 2) * kstep; const char* b2 = last ? nB : cB + (size_t)(t + 2) * kstep;
            const char* a3 = a2 + kstep; const char* b3 = b2 + kstep;
            if (last && has_next) S.a_ready(nxt);
            if constexpr (SP2) {
            PG8_LDB(B0, 0, 0); PG8_LDB(B1, 0, 1); PG8_SCHED; PG8_LDA(At, 0, 0); PG8_STAGE(PG8_SA(1, 1), a1 + hstep, voffA);
            PG8_WAIT_V(8); PG8_WAIT_L(0); PG8_BAR; PG8_MMA(0, 0, At, B0); PG8_MMA(0, 1, At, B1); PG8_BAR; PG8_SCHED;
            PG8_LDA(At, 0, 1); PG8_STAGE(PG8_SB(0, 0), b2, voffB); PG8_STAGE(PG8_SB(0, 1), b2 + hstep, voffB); PG8_STAGE(PG8_SA(0, 0), a2, voffA);
            PG8_WAIT_V(8); PG8_WAIT_L(0); PG8_BAR; PG8_MMA(1, 0, At, B0); PG8_MMA(1, 1, At, B1); PG8_BAR; PG8_SCHED;
            PG8_LDB(B0, 1, 0); PG8_LDB(B1, 1, 1); PG8_SCHED; PG8_LDA(At, 1, 0); PG8_STAGE(PG8_SA(0, 1), a2 + hstep, voffA);
            PG8_WAIT_V(8); PG8_WAIT_L(0); PG8_BAR; PG8_MMA(0, 0, At, B0); PG8_MMA(0, 1, At, B1); PG8_BAR; PG8_SCHED;
            PG8_LDA(At, 1, 1); PG8_STAGE(PG8_SB(1, 0), b3, voffB); PG8_STAGE(PG8_SB(1, 1), b3 + hstep, voffB); PG8_STAGE(PG8_SA(1, 0), a3, voffA);
            PG8_WAIT_V(8); PG8_WAIT_L(0); PG8_BAR; PG8_MMA(1, 0, At, B0); PG8_MMA(1, 1, At, B1); PG8_BAR; PG8_SCHED;
            } else {
            PG8_LDB(B0, 0, 0); PG8_SCHED; PG8_LDA(At, 0, 0); PG8_STAGE(PG8_SA(1, 1), a1 + hstep, voffA);
            PG8_WAIT_L(8); PG8_BAR; PG8_WAIT_L(0); PG8_MMA(0, 0, At, B0); PG8_BAR; PG8_SCHED;
            PG8_LDB(B1, 0, 1); PG8_STAGE(PG8_SB(0, 0), b2, voffB);
            PG8_BAR; PG8_WAIT_L(0); PG8_MMA(0, 1, At, B1); PG8_BAR;
            PG8_LDA(At, 0, 1); PG8_STAGE(PG8_SA(0, 0), a2, voffA);
            PG8_BAR; PG8_WAIT_L(0); PG8_MMA(1, 0, At, B0); PG8_BAR; PG8_SCHED;
            PG8_STAGE(PG8_SB(0, 1), b2 + hstep, voffB);
            PG8_WAIT_V(6); PG8_BAR; PG8_MMA(1, 1, At, B1); PG8_BAR;
            PG8_LDB(B0, 1, 0); PG8_SCHED; PG8_LDA(At, 1, 0); PG8_STAGE(PG8_SA(0, 1), a2 + hstep, voffA);
            PG8_WAIT_L(8); PG8_BAR; PG8_WAIT_L(0); PG8_MMA(0, 0, At, B0); PG8_BAR; PG8_SCHED;
            PG8_LDB(B1, 1, 1); PG8_STAGE(PG8_SB(1, 0), b3, voffB);
            PG8_BAR; PG8_WAIT_L(0); PG8_MMA(0, 1, At, B1); PG8_BAR;
            PG8_LDA(At, 1, 1); PG8_STAGE(PG8_SA(1, 0), a3, voffA);
            PG8_BAR; PG8_WAIT_L(0); PG8_MMA(1, 0, At, B0); PG8_BAR; PG8_SCHED;
            PG8_STAGE(PG8_SB(1, 1), b3 + hstep, voffB);
            PG8_WAIT_V(6); PG8_BAR; PG8_MMA(1, 1, At, B1); PG8_BAR;
            }
        }
        if constexpr (ALIGN_EPI) { if (wr == 0) PG8_BAR; }
        if constexpr (Sched::SPLITK == 1) { if (cur.mode == 1) S.publish(acc, cur, wid, lane); else E(acc, cur, wr, wc, fr, fq); S.done(cur); }
        else if constexpr (Sched::SPLITK == 2) { S.consume(acc, cur, wid, lane); E(acc, cur, wr, wc, fr, fq); S.done(cur); }
        else if constexpr (!Epi::AFTER_DRAIN) { E(acc, cur, wr, wc, fr, fq); S.done(cur); }
        if (!has_next) break;
#pragma unroll
        for (int a = 0; a < 2; ++a)
#pragma unroll
            for (int b = 0; b < 2; ++b)
#pragma unroll
                for (int m = 0; m < 4; ++m)
#pragma unroll
                    for (int n = 0; n < 2; ++n) acc[a][b][m][n] = (f32x4){0.f, 0.f, 0.f, 0.f};
        cur = nxt; cA = nA; cB = nB; ++ui;
        if constexpr (ALIGN_EPI) { if (wr == 1) PG8_BAR; }
    }
    PG8_WAIT_V(0);
    if constexpr (!ALIGN_EPI) { if (wr == 0) PG8_BAR; }
    PG8_BAR;
    if constexpr (Epi::AFTER_DRAIN) { E.fused(acc, cur, wr, wc, fr, fq, lds, wid, lane); S.done(cur); }
#undef PG8_SA
#undef PG8_SB
#undef PG8_STAGE
#undef PG8_LDA
#undef PG8_LDB
#undef PG8_MMA
#undef PG8_WAIT_V
#undef PG8_WAIT_L
#undef PG8_BAR
#undef PG8_SCHED
}
}
#define XB_TMO      128
#define XB_XCNT(j)  (256  + 64 * (j))
#define XB_XSUB(j)  (1280 + 64 * (j))
#define XB_XGEN(j)  (2304 + 64 * (j))
#define XB_TOP      3328
#define XB_TOPGEN   3392
#define XCD_BAR_WORDS 3456
#define XB_SPIN_CAP (1u << 18)

__device__ __forceinline__ unsigned xb_ld(unsigned* p)              { return __hip_atomic_load(p, __ATOMIC_RELAXED, __HIP_MEMORY_SCOPE_AGENT); }
__device__ __forceinline__ unsigned xb_add(unsigned* p, unsigned v) { return __hip_atomic_fetch_add(p, v, __ATOMIC_RELAXED, __HIP_MEMORY_SCOPE_AGENT); }
__device__ __forceinline__ unsigned xb_xcc_id() { return (unsigned)__builtin_amdgcn_s_getreg((3 << 11) | 20) & 0xFu; }
#define XB_SPIN(cond, bar) do { unsigned _sp = 0; while (cond) { __builtin_amdgcn_s_sleep(1); \
    if ((++_sp & 255u) == 0u) { if (xb_ld(&(bar)[XB_TMO])) break; if (_sp > XB_SPIN_CAP) { atomicAdd(&(bar)[XB_TMO], 1u); break; } } } } while (0)

struct XcdBarrier {
    unsigned* bar; unsigned x;
    volatile LAS unsigned* st;
};

__device__ __forceinline__ XcdBarrier xcd_barrier_post(unsigned* bar, volatile LAS unsigned* st, int tid_) {
    XcdBarrier b; b.bar = bar; b.x = xb_xcc_id(); b.st = st;
    if (tid_ == 0) (void)xb_add(&bar[XB_XCNT(b.x)], 1u);
    return b;
}
__device__ __forceinline__ void xcd_barrier_complete(unsigned* bar, unsigned x, unsigned& nloc, unsigned& nx) {
    const unsigned G = gridDim.x * gridDim.y * gridDim.z;
    unsigned sum, cnt, mine, sp = 0u;
    for (;;) {
        sum = 0u; cnt = 0u; mine = 0u;
#pragma unroll
        for (unsigned j = 0; j < 16; ++j) { const unsigned c = xb_ld(&bar[XB_XCNT(j)]); sum += c; cnt += (c > 0u) ? 1u : 0u; mine = (j == x) ? c : mine; }
        if (sum == G) break;
        __builtin_amdgcn_s_sleep(1);
        if ((++sp & 255u) == 0u) { if (xb_ld(&bar[XB_TMO])) break; if (sp > XB_SPIN_CAP) { atomicAdd(&bar[XB_TMO], 1u); break; } }
    }
    nloc = mine > 0u ? mine : 1u; nx = cnt > 0u ? cnt : 1u;
}

__device__ __forceinline__ void xcd_barrier(const XcdBarrier& b, int tid_) {
    asm volatile("s_waitcnt vmcnt(0)" ::: "memory");
    __syncthreads();
    if (tid_ == 0) {
        unsigned* bar = b.bar;
        __builtin_amdgcn_s_waitcnt(0);
        unsigned nloc = b.st[0], nx = b.st[1];
        if (nloc == 0u) { xcd_barrier_complete(bar, b.x, nloc, nx); b.st[0] = nloc; b.st[1] = nx; }
        const unsigned old = xb_add(&bar[XB_XSUB(b.x)], 1u);
        const unsigned gen = old / nloc;
        if (old + 1u == (gen + 1u) * nloc) {
            __builtin_amdgcn_fence(__ATOMIC_RELEASE, "agent");
            asm volatile("s_waitcnt vmcnt(0)" ::: "memory");
            const unsigned og = xb_add(&bar[XB_TOP], 1u);
            const unsigned tg = og / nx;
            if (og + 1u == (tg + 1u) * nx) xb_add(&bar[XB_TOPGEN], 1u);
            else XB_SPIN(xb_ld(&bar[XB_TOPGEN]) == tg, bar);
            __builtin_amdgcn_fence(__ATOMIC_ACQUIRE, "agent");
            xb_add(&bar[XB_XGEN(b.x)], 1u);
            asm volatile("s_waitcnt vmcnt(0)" ::: "memory");
        } else {
            XB_SPIN(xb_ld(&bar[XB_XGEN(b.x)]) == gen, bar);
            __builtin_amdgcn_fence(__ATOMIC_ACQUIRE, "agent");
            asm volatile("s_waitcnt vmcnt(0)" ::: "memory");
        }
    }
    __syncthreads();
}

constexpr size_t MiB = 1u << 20;
constexpr size_t WS_CTL = 0, CTL_ZERO_BYTES = 2 * MiB;
constexpr size_t WS_MOD = 2 * MiB;
constexpr size_t WS_PMOD = WS_MOD + 2 * MiB;
constexpr size_t WS_ROPE = WS_PMOD + 8 * MiB;
constexpr size_t WS_W1T = WS_ROPE + 2 * MiB;
constexpr size_t WS_W2T = WS_W1T + 352 * MiB;
constexpr size_t WS_WINE = WS_W2T + 176 * MiB;
constexpr size_t WS_WOUTE = WS_WINE + 34 * MiB;
constexpr size_t WS_WINO = WS_WOUTE + 16 * MiB;
constexpr size_t WS_WOUTO = WS_WINO + 48 * MiB;
constexpr size_t WS_WQ = WS_WOUTO + 16 * MiB;
constexpr size_t WS_WKN = WS_WQ + 4 * MiB;
constexpr size_t WS_WV = WS_WKN + 2 * MiB;
constexpr size_t WS_WLORA = WS_WV + 2 * MiB;
constexpr size_t WS_W3T = WS_WLORA + 8 * MiB;
constexpr size_t WS_H2 = WS_W3T + 8 * MiB;
constexpr size_t WS_X = WS_H2 + 4 * MiB;
constexpr size_t WS_H = WS_X + 96 * MiB;
constexpr size_t WS_ACT = WS_H + 48 * MiB;
constexpr size_t WS_Z = WS_ACT + 132 * MiB;
constexpr size_t WS_SCAN = WS_Z + 288 * MiB;
constexpr size_t SCAN_BYTES = 432 * MiB;
constexpr size_t WS_KBUF = WS_SCAN + 2 * SCAN_BYTES;
constexpr size_t WS_LA = WS_KBUF + 48 * MiB;
constexpr size_t WS_GB = WS_LA + 10 * MiB;
constexpr size_t WS_CQ = WS_GB + 48 * MiB;
constexpr size_t WS_CKV = WS_CQ + 12 * MiB;
constexpr size_t WS_KR = WS_CKV + 8 * MiB;
constexpr size_t WS_Q = WS_KR + 2 * MiB;
constexpr size_t WS_KN = WS_Q + 36 * MiB;
constexpr size_t WS_VT = WS_KN + 26 * MiB;
constexpr size_t WS_YSC = WS_VT + 26 * MiB;
constexpr size_t WS_PQ = WS_ACT;
constexpr size_t WS_SST = WS_ACT + 64 * MiB;
constexpr size_t WS_PST = WS_ACT + 96 * MiB;
constexpr size_t WS_MIX = WS_YSC + 96 * MiB;
constexpr size_t WS_KSS = WS_MIX + 48 * MiB;
constexpr size_t WS_KSP = WS_KSS + 258 * MiB;
constexpr size_t WS_END = WS_KSP + 18 * MiB;
static_assert((size_t)NCH * 64 * 2 * 16384 <= 64 * MiB && (size_t)NCH * 64 * 16384 <= 32 * MiB, "PQ / SST inside the ACT region");
constexpr size_t ZT_S_OFF = (size_t)16 * 6144 * 256 * 4;
constexpr size_t VT_S_OFF = (size_t)16 * 1024 * 256 * 2;

constexpr size_t OUT_YS = (size_t)MP * D, OUT_CKV = (size_t)MT * D, OUT_KR = OUT_CKV + 16 * 2 * 256 * 256, OUT_ST = OUT_KR + 16 * 2 * 256 * 64, OUT_END = OUT_ST + (size_t)16 * 2 * 2 * 16 * 64 * 64;

constexpr int LDS_RING = 131072, LDS_BYTES = 147456, LDS_CTL = LDS_BYTES - 512;

struct KArgs { const float* in[42]; float* out; unsigned char* ws; int ph_lo, ph_hi; };
enum { I_XP = 0, I_XS, I_CCKV, I_CKR, I_ST, I_C, I_CCTX, I_WMOD, I_BMOD, I_NG, I_WFI, I_WFO, I_FNG, I_WINE, I_MUP, I_MUN, I_W0, I_W2, I_A0, I_A2, I_G2, I_KK, I_KA, I_RK, I_GNW, I_GNB,
       I_QN, I_KVN, I_WQB, I_WKVB, I_WOE, I_WINO, I_CW, I_CB, I_FW1, I_FB1, I_FW2, I_FB2, I_FW3, I_FFR, I_HB, I_WOO };

struct Ctx {
    LAS unsigned char* lds; unsigned char* ws; const float* const* in; float* out;
    int tid, lane, wave, G, gw, NGW, vb, bx, zs;
};

DI void tr_item(const float* W, int ldw, int K, bf16* WT, int dstrow0, int srccol0, int k0, LAS float* scr, int lane) {
    float v[32];
#pragma unroll
    for (int i = 0; i < 32; ++i) v[i] = W[(size_t)(k0 + 2 * i + (lane >> 5)) * ldw + srccol0 + (lane & 31)];
#pragma unroll
    for (int i = 0; i < 32; ++i) scr[(2 * i + (lane >> 5)) * 33 + (lane & 31)] = v[i];
    asm volatile("s_waitcnt lgkmcnt(0)" ::: "memory");
    const int c = lane & 7;
#pragma unroll
    for (int j = 0; j < 4; ++j) { const int n = (lane >> 3) + 8 * j; const LAS float* s = scr + (8 * c) * 33 + n;
        v4u o; o.x = pk2(s[0 * 33], s[1 * 33]); o.y = pk2(s[2 * 33], s[3 * 33]); o.z = pk2(s[4 * 33], s[5 * 33]); o.w = pk2(s[6 * 33], s[7 * 33]);
        *(v4u*)(WT + (size_t)(dstrow0 + n) * K + k0 + 8 * c) = o; }
    asm volatile("s_waitcnt lgkmcnt(0)" ::: "memory");
}
template <int MODE> DI void tr_matrix(Ctx& C, const float* W, int ldw, int K, bf16* WT, int ndst, int nsrc, int gw, int NGW) {
    LAS float* scr = (LAS float*)(C.lds + C.wave * 8704);
    const int nkb = K / 64, nnb = ndst / 32, nit = nkb * nnb;
    for (int it = gw; it < nit; it += NGW) {
        const int kb = it / nnb, nb = it % nnb, dr = nb * 32;
        int sc = dr;
        if (MODE == 1) { const int p = dr >> 8, sg = (dr >> 7) & 1, j = dr & 127; sc = sg * 5632 + 128 * p + j; }
        if (MODE == 2 && dr >= nsrc) {
            const int c = C.lane & 7;
#pragma unroll
            for (int j = 0; j < 4; ++j) { const int n = (C.lane >> 3) + 8 * j; *(v4u*)(WT + (size_t)(dr + n) * K + kb * 64 + 8 * c) = (v4u){0u, 0u, 0u, 0u}; }
            continue;
        }
        tr_item(W, ldw, K, WT, dr, sc, kb * 64, scr, C.lane);
    }
}
template <class Fn> DI void cvt_small(Ctx& C, bf16* dst, int N, int K, Fn f) {
    const int total = N * (K / 8);
    for (int idx = C.bx * 512 + C.tid; idx < total; idx += C.G * 512) {
        const int n = idx % N, k8 = idx / N; float v[8];
#pragma unroll
        for (int i = 0; i < 8; ++i) v[i] = f(n, k8 * 8 + i);
        v4u o; o.x = pk2(v[0], v[1]); o.y = pk2(v[2], v[3]); o.z = pk2(v[4], v[5]); o.w = pk2(v[6], v[7]);
        *(v4u*)(dst + (size_t)n * K + k8 * 8) = o;
    }
}

DI void phase_prologue(Ctx& C) {
    const float* const* in = C.in; unsigned char* ws = C.ws;
    tr_matrix<1>(C, in[I_WFI], NFF1, 2048, (bf16*)(ws + WS_W1T), NFF1, NFF1, C.gw, C.NGW);
    tr_matrix<0>(C, in[I_WFO], 2048, DFF, (bf16*)(ws + WS_W2T), 2048, 2048, C.gw, C.NGW);
    for (int i = 0; i < 2; ++i) tr_matrix<2>(C, in[I_WINE] + (size_t)i * 2048 * ZE_N, ZE_N, 2048, (bf16*)(ws + WS_WINE) + (size_t)i * ZE_P * 2048, ZE_P, ZE_N, C.gw, C.NGW);
    for (int i = 0; i < 2; ++i) tr_matrix<0>(C, in[I_WOE] + (size_t)i * 2048 * 2048, 2048, 2048, (bf16*)(ws + WS_WOUTE) + (size_t)i * 2048 * 2048, 2048, 2048, C.gw, C.NGW);
    for (int i = 0; i < 2; ++i) tr_matrix<0>(C, in[I_WINO] + (size_t)i * 2048 * 6144, 6144, 2048, (bf16*)(ws + WS_WINO) + (size_t)i * 6144 * 2048, 6144, 6144, C.gw, C.NGW);
    for (int i = 0; i < 2; ++i) tr_matrix<0>(C, in[I_WOO] + (size_t)i * 2048 * 2048, 2048, 2048, (bf16*)(ws + WS_WOUTO) + (size_t)i * 2048 * 2048, 2048, 2048, C.gw, C.NGW);
    for (int e = 0; e < 2; ++e) {
        const float* wqb = in[I_WQB] + (size_t)e * 512 * 1536;
        cvt_small(C, (bf16*)(ws + WS_WQ) + (size_t)e * 1536 * 512, 1536, 512, [=](int n, int k) { const int hd = n / 192, wi = n % 192; int sc;
            if (wi < 128) sc = wi; else { const int idx = wi - 128, hf = idx >> 5, r = idx & 31; sc = 128 + 32 * hf + 16 * (r & 1) + (r >> 1); }
            return wqb[(size_t)k * 1536 + hd * 192 + sc]; });
        const float* wkv = in[I_WKVB] + (size_t)e * 256 * 2048;
        cvt_small(C, (bf16*)(ws + WS_WKN) + (size_t)e * 1024 * 256, 1024, 256, [=](int n, int k) { return wkv[(size_t)k * 2048 + (n >> 7) * 256 + (n & 127)]; });
        cvt_small(C, (bf16*)(ws + WS_WV) + (size_t)e * 1024 * 256, 1024, 256, [=](int n, int k) { return wkv[(size_t)k * 2048 + (n >> 7) * 256 + 128 + (n & 127)]; });
        const float* w2 = in[I_W2] + (size_t)e * 2 * 64 * 1024; const float* a2 = in[I_A2] + (size_t)e * 2 * 64 * 1024; const float* g2 = in[I_G2] + (size_t)e * 160 * 1024;
        cvt_small(C, (bf16*)(ws + WS_WLORA) + (size_t)e * 5120 * 384, 5120, 384, [=](int n, int k) { const int seg = n >> 10, c = n & 1023; float v = 0.f;
            if (seg < 2) { if (k < 64) v = w2[((size_t)seg * 64 + k) * 1024 + c]; }
            else if (seg < 4) { if (k >= 64 && k < 128) v = a2[((size_t)(seg - 2) * 64 + (k - 64)) * 1024 + c]; }
            else { if (k >= 128 && k < 288) v = g2[(size_t)(k - 128) * 1024 + c]; }
            return v; });
    }
    { const float* w3 = in[I_FW3];
      cvt_small(C, (bf16*)(ws + WS_W3T), 16384, 256, [=](int n, int k) { const int o = n >> 13, col = n & 8191; float v = 0.f; if ((k >> 6) == o) v = w3[((size_t)o * 64 + (k & 63)) * 8192 + col]; return v; }); }
    { LAS float* sl = (LAS float*)(C.lds + 8 * 8704);
      for (int it = C.bx; it < 4 * 8 * 9; it += C.G) {
          const int l = it / 72, kc = (it / 9) % 8, cc = it % 9;
          __syncthreads();
          for (int i = C.tid; i < 768; i += 512) { const int j = i >> 8, k = kc * 256 + (i & 255); const float cv = j == 0 ? in[I_CCTX][k] : in[I_C][(j - 1) * 2048 + k]; sl[i] = silu_f(cv); }
          __syncthreads();
          const int col = cc * 2048 + 4 * C.tid; const float* wp = in[I_WMOD] + ((size_t)l * 2048 + kc * 256) * 18432 + col;
          f32x4v a0 = {0.f, 0.f, 0.f, 0.f}, a1 = a0, a2 = a0;
#pragma unroll 4
          for (int k = 0; k < 256; ++k) { const f32x4v w = *(const f32x4v*)(wp + (size_t)k * 18432); a0 += w * sl[k]; a1 += w * sl[256 + k]; a2 += w * sl[512 + k]; }
          float* pm = (float*)(ws + WS_PMOD) + ((size_t)(kc * 4 + l) * 3) * 18432 + col;
          *(f32x4v*)(pm) = a0; *(f32x4v*)(pm + 18432) = a1; *(f32x4v*)(pm + 2 * 18432) = a2;
      }
      __syncthreads(); }
    { const f32x4v* s0 = (const f32x4v*)in[I_XP]; const f32x4v* s1 = (const f32x4v*)in[I_XS]; f32x4v* x = (f32x4v*)(ws + WS_X);
      const size_t n0 = (size_t)MP * D / 4, n1 = (size_t)MS * D / 4;
      for (size_t i = (size_t)C.bx * 512 + C.tid; i < n0 + n1; i += (size_t)C.G * 512) x[i] = i < n0 ? s0[i] : s1[i - n0]; }
    if (C.bx == 0) for (int i = C.tid; i < 1024; i += 512) { const int pos = i >> 4, j = i & 15; const float inv = 1.0f / powf(10000.0f, (float)(2 * j) / 32.0f); const float a = (float)pos * inv;
        float* r = (float*)(ws + WS_ROPE) + i * 2; r[0] = cosf(a); r[1] = sinf(a); }
    { bf16* H2 = (bf16*)(ws + WS_H2);
      for (int it = C.gw; it < 2 * 4352; it += C.NGW) {
          const int o = it / 4352, rr = it % 4352; const int L = rr < 256 ? 256 : 4096, t = rr < 256 ? rr : rr - 256; const int lane = C.lane;
          float zf = 0.f;
          if (lane == 0) zf = (float)t / (float)(L - 1);
          else if (lane < 33) { const int b = (lane - 1) & 15; const float fr = 1e-4f + (15.0f - 1e-4f) * ((float)b / 15.0f); const float ang = ((float)(2.0 * 3.14159265358979323846 / (double)L) * (float)t) * fr; zf = lane < 17 ? cosf(ang) : -sinf(ang); }
          const float* w1 = in[I_FW1] + (size_t)o * 33 * 64; const float* w2 = in[I_FW2] + (size_t)o * 64 * 64;
          float s = in[I_FB1][o * 64 + lane];
          for (int i = 0; i < 33; ++i) s += shfl_idx(zf, i) * w1[i * 64 + lane];
          const float h1 = sinf(in[I_FFR][(o * 2 + 0) * 64 + lane] * s);
          float s2 = in[I_FB2][o * 64 + lane];
          for (int i = 0; i < 64; ++i) s2 += shfl_idx(h1, i) * w2[i * 64 + lane];
          const float h2 = sinf(in[I_FFR][(o * 2 + 1) * 64 + lane] * s2);
          H2[(size_t)rr * 256 + o * 64 + lane] = (bf16)f2bf(h2);
          if (o == 0) { H2[(size_t)rr * 256 + 128 + lane] = 0; H2[(size_t)rr * 256 + 192 + lane] = 0; }
      } }
}
DI void phase_mod_reduce(Ctx& C) {
    const float* pm = (const float*)(C.ws + WS_PMOD); float* mod = (float*)(C.ws + WS_MOD); const float* bm = C.in[I_BMOD];
    for (int i = C.bx * 512 + C.tid; i < 4 * 3 * 18432; i += C.G * 512) { const int l = i / MODL, n = i % 18432; float s = bm[l * 18432 + n];
#pragma unroll
        for (int kc = 0; kc < 8; ++kc) s += pm[(size_t)kc * 4 * MODL + i];
        mod[i] = s; }
}
DI void phase_norm_mod(Ctx& C, const float* g, const float* modl, int s) {
    const float* X = (const float*)(C.ws + WS_X); bf16* H = (bf16*)(C.ws + WS_H);
    for (int row = C.gw; row < MT; row += C.NGW) {
        const float* sh = modl + row_mod_j(row) * 18432 + (3 * s) * 2048; const float* scl = sh + 2048;
        const f32x4v* xr = (const f32x4v*)(X + (size_t)row * D) + C.lane; f32x4v v[8]; float ss = 0.f;
#pragma unroll
        for (int i = 0; i < 8; ++i) { v[i] = xr[64 * i]; ss += (v[i].x * v[i].x + v[i].y * v[i].y) + (v[i].z * v[i].z + v[i].w * v[i].w); }
        const float rstd = 1.0f / sqrtf(wave_sum(ss) * (1.0f / D) + 1e-6f);
        v2u* o = (v2u*)(H + (size_t)row * D) + C.lane;
#pragma unroll
        for (int i = 0; i < 8; ++i) { const int c = 4 * C.lane + 256 * i; const f32x4v gg = *(const f32x4v*)(g + c), sc = *(const f32x4v*)(scl + c), sf = *(const f32x4v*)(sh + c);
            const f32x4v y = (v[i] * rstd * gg) * (sc + 1.0f) + sf; v2u w; w.x = pk2(y.x, y.y); w.y = pk2(y.z, y.w); o[64 * i] = w; }
    }
}
DI void phase_final_norm(Ctx& C) {
    const float* X = (const float*)(C.ws + WS_X); const float* g = C.in[I_FNG];
    for (int row = C.gw; row < MT; row += C.NGW) {
        const f32x4v* xr = (const f32x4v*)(X + (size_t)row * D) + C.lane; f32x4v v[8]; float ss = 0.f;
#pragma unroll
        for (int i = 0; i < 8; ++i) { v[i] = xr[64 * i]; ss += (v[i].x * v[i].x + v[i].y * v[i].y) + (v[i].z * v[i].z + v[i].w * v[i].w); }
        const float rstd = 1.0f / sqrtf(wave_sum(ss) * (1.0f / D) + 1e-6f);
        f32x4v* o = (f32x4v*)(C.out + (size_t)row * D) + C.lane;
#pragma unroll
        for (int i = 0; i < 8; ++i) { const f32x4v gg = *(const f32x4v*)(g + 4 * C.lane + 256 * i); o[64 * i] = v[i] * rstd * gg; }
    }
}

DI int rope_src(int p) { const int hf = p >> 5, r = p & 31; return 32 * hf + 16 * (r & 1) + (r >> 1); }
DI void phase_even_prep(Ctx& C, int e) {
    const float* const* in = C.in; unsigned char* ws = C.ws; const int lane = C.lane;
    const float* Z = (const float*)(ws + WS_Z); float* SC = (float*)(ws + WS_SCAN + (size_t)e * SCAN_BYTES); float* KB = (float*)(ws + WS_KBUF); bf16* LA = (bf16*)(ws + WS_LA);
    bf16* CQ = (bf16*)(ws + WS_CQ); bf16* CKV = (bf16*)(ws + WS_CKV); bf16* KR = (bf16*)(ws + WS_KR); const float* rope = (const float*)(ws + WS_ROPE);
    const float* mup = in[I_MUP] + e * 3360; const float* mun = in[I_MUN] + e * 3360; const float* kkw = in[I_KK] + e * 1024;
    const float* qn = in[I_QN] + e * 512; const float* kvn = in[I_KVN] + e * 256;
    for (int row = C.gw; row < MKV; row += C.NGW) {
        if (row >= MT) {
            const int rr = row - MT, b = rr >> 8, p = rr & 255;
            const float* cs = in[I_CCKV] + ((size_t)(b * 2 + e) * 256 + p) * 256;
#pragma unroll
            for (int i = 0; i < 4; ++i) CKV[(size_t)row * 256 + 64 * i + lane] = (bf16)f2bf(cs[64 * i + lane]);
            KR[(size_t)row * 64 + lane] = (bf16)f2bf(in[I_CKR][((size_t)(b * 2 + e) * 256 + p) * 64 + rope_src(lane)]);
            continue;
        }
        const bool smp = row >= MP; const int T = smp ? 4096 : 256; const int t = smp ? ((row - MP) & 4095) : (row & 255);
        const float* z = Z + (size_t)row * ZE_P; const bool hp = t > 0, hn = t < T - 1;
        float* sc = SC + (size_t)row * SCAN_P;
#define ZMIX4(c) ({ const f32x4v zc_ = *(const f32x4v*)(z + (c)); const f32x4v zp_ = hp ? *(const f32x4v*)(z + (c) - ZE_P) : (f32x4v){0.f, 0.f, 0.f, 0.f}; const f32x4v zn_ = hn ? *(const f32x4v*)(z + (c) + ZE_P) : (f32x4v){0.f, 0.f, 0.f, 0.f}; \
            zc_ + *(const f32x4v*)(mup + (c)) * (zp_ - zc_) + *(const f32x4v*)(mun + (c)) * (zn_ - zc_); })
#define ZMIX(c) ({ const float zc_ = z[c]; const float zp_ = hp ? z[(c) - ZE_P] : 0.f; const float zn_ = hn ? z[(c) + ZE_P] : 0.f; zc_ + mup[c] * (zp_ - zc_) + mun[c] * (zn_ - zc_); })
#pragma unroll
        for (int i = 0; i < 4; ++i) { const int c = 256 * i + 4 * lane;
            *(f32x4v*)(sc + c) = ZMIX4(c);
            *(f32x4v*)(sc + 1024 + c) = ZMIX4(2048 + c);
            const f32x4v k = ZMIX4(1024 + c); *(f32x4v*)(KB + (size_t)row * 1024 + c) = k;
            const f32x4v kk = k * *(const f32x4v*)(kkw + c); float ss = (kk.x * kk.x + kk.y * kk.y) + (kk.z * kk.z + kk.w * kk.w);
            ss += dpp_f<0xB1>(ss); ss += dpp_f<0x4E>(ss); ss += dpp_f<0x141>(ss); ss += dpp_f<0x140>(ss);
            *(f32x4v*)(sc + 2048 + c) = kk * (1.0f / fmaxf(sqrtf(ss), 1e-12f)); }
        bf16* la = LA + (size_t)row * 384;
        la[lane] = (bf16)f2bf(tanhf(ZMIX(3072 + lane)));
        la[64 + lane] = (bf16)f2bf(ZMIX(3136 + lane));
        la[128 + lane] = (bf16)f2bf(sigmoid_f(ZMIX(3200 + lane)));
        la[192 + lane] = (bf16)f2bf(sigmoid_f(ZMIX(3264 + lane)));
        { float xg = 0.f; if (lane < 32) xg = sigmoid_f(ZMIX(3328 + lane)); la[256 + lane] = (bf16)(lane < 32 ? f2bf(xg) : 0u); la[320 + lane] = 0; }
#undef ZMIX4
#undef ZMIX
        float cq[8], ss = 0.f;
#pragma unroll
        for (int i = 0; i < 8; ++i) { cq[i] = z[3360 + 64 * i + lane]; ss += cq[i] * cq[i]; }
        float rstd = 1.0f / sqrtf(wave_sum(ss) * (1.0f / 512.0f) + 1e-6f);
#pragma unroll
        for (int i = 0; i < 8; ++i) CQ[(size_t)row * 512 + 64 * i + lane] = (bf16)f2bf(cq[i] * rstd * qn[64 * i + lane]);
        float ck[4]; ss = 0.f;
#pragma unroll
        for (int i = 0; i < 4; ++i) { ck[i] = z[3872 + 64 * i + lane]; ss += ck[i] * ck[i]; }
        rstd = 1.0f / sqrtf(wave_sum(ss) * (1.0f / 256.0f) + 1e-6f);
#pragma unroll
        for (int i = 0; i < 4; ++i) { const float y = ck[i] * rstd * kvn[64 * i + lane]; CKV[(size_t)row * 256 + 64 * i + lane] = (bf16)f2bf(y);
            if (!smp) C.out[OUT_CKV + ((size_t)((row >> 8) * 2 + e) * 256 + t) * 256 + 64 * i + lane] = y; }
        const float kr = z[4128 + lane];
        if (!smp) { C.out[OUT_KR + ((size_t)((row >> 8) * 2 + e) * 256 + t) * 64 + lane] = kr; KR[(size_t)row * 64 + lane] = (bf16)f2bf(shfl_idx(kr, rope_src(lane))); }
        else { const int hf = lane >> 5, jj = lane & 15, e2 = (lane >> 4) & 1; const int pos = hf ? (t & 63) : (t >> 6);
            const float xo = shfl_idx(kr, lane ^ 16); const float2 cs = *(const float2*)(rope + (pos * 16 + jj) * 2);
            const float rot = e2 == 0 ? kr * cs.x - xo * cs.y : kr * cs.x + xo * cs.y;
            KR[(size_t)row * 64 + lane] = (bf16)f2bf(shfl_idx(rot, rope_src(lane))); }
    }
}

template <int N> DI float fmac_bc(float acc, float op, float s) { asm("v_fmac_f32_dpp %0, %1, %2 row_newbcast:%3 row_mask:0xf bank_mask:0xf" : "+v"(acc) : "v"(op), "v"(s), "n"(N)); return acc; }
template <int N> DI float mul_bc(float op, float s) { float r; asm("v_mul_f32_dpp %0, %1, %2 row_newbcast:%3 row_mask:0xf bank_mask:0xf" : "=v"(r) : "v"(op), "v"(s), "n"(N)); return r; }
struct ScanOps { f32x4v kk, w, kka, kd, r; float vv; };
typedef __attribute__((__vector_size__(4 * sizeof(int)))) int rsrc_t;
DI f32x4v bl128(__amdgpu_buffer_rsrc_t r, unsigned vo, unsigned so) { return __builtin_bit_cast(f32x4v, __builtin_amdgcn_raw_buffer_load_b128(r, (int)vo, (int)so, 0)); }
DI float bl32(__amdgpu_buffer_rsrc_t r, unsigned vo, unsigned so) { return __builtin_bit_cast(float, __builtin_amdgcn_raw_buffer_load_b32(r, (int)vo, (int)so, 0)); }
template <int MODE> DI ScanOps scan_load(__amdgpu_buffer_rsrc_t rs, unsigned so, unsigned lo, unsigned lv, int d) {
    ScanOps o;
    o.kk = bl128(rs, lo + 2u * 4096u, so); o.w = bl128(rs, lo + (3u + (unsigned)d) * 4096u, so); o.kka = bl128(rs, lo + (5u + (unsigned)d) * 4096u, so);
    if (MODE != 0) { o.kd = bl128(rs, lo + (7u + (unsigned)d) * 4096u, so); o.vv = bl32(rs, lv + 4096u, so); } else { o.kd = (f32x4v){0.f, 0.f, 0.f, 0.f}; o.vv = 0.f; }
    if (MODE == 2) o.r = bl128(rs, lo, so); else o.r = (f32x4v){0.f, 0.f, 0.f, 0.f};
    return o;
}
template <int MODE, int J> DI void scan_col_a(const ScanOps& o, const float (&S)[64], float (&sa)[4]) { sa[J & 3] = fmac_bc<(J >> 2)>(sa[J & 3], o.kk[J & 3], S[J]); }
template <int MODE, int J> DI void scan_col_b(const ScanOps& o, float (&S)[64], float sa, float (&y)[4]) {
    float t = mul_bc<(J >> 2)>(o.w[J & 3], S[J]);
    t = fmac_bc<(J >> 2)>(t, o.kka[J & 3], sa);
    if (MODE != 0) t = fmac_bc<(J >> 2)>(t, o.kd[J & 3], o.vv);
    S[J] = t;
    if (MODE == 2) y[J & 3] = fmac_bc<(J >> 2)>(y[J & 3], o.r[J & 3], t);
}
template <int MODE, int... Js> DI float scan_step(const ScanOps& o, float (&S)[64], std::integer_sequence<int, Js...>) {
    float sa[4] = {0.f, 0.f, 0.f, 0.f}, y[4] = {0.f, 0.f, 0.f, 0.f};
    (scan_col_a<MODE, Js>(o, S, sa), ...);
    const float sat = -((sa[0] + sa[1]) + (sa[2] + sa[3]));
    (scan_col_b<MODE, Js>(o, S, sat, y), ...);
    return (y[0] + y[1]) + (y[2] + y[3]);
}
template <int MODE> DI void scan_wave(const float* SCp, int row0, int rstep, int nsteps, int h, int d, float (&S)[64], float* yout, int lane) {
    const __amdgpu_buffer_rsrc_t rs = __builtin_amdgcn_make_buffer_rsrc((void*)SCp, 0, (int)((size_t)MT * SCAN_P * 4), 0x00020000);
    const __amdgpu_buffer_rsrc_t ry = __builtin_amdgcn_make_buffer_rsrc((void*)yout, 0, (int)((size_t)MT * 1024 * 4), 0x00020000);
    const int so0 = (row0 * SCAN_P + h * 64) * 4, sstep = rstep * SCAN_P * 4, last = nsteps - 1;
    int yo = (row0 * 1024 + h * 64) * 4; const int ystep = rstep * 4096;
    const unsigned lo = 16u * (unsigned)(lane & 15), lv = 4u * (unsigned)lane;
#define SC_LD(s_) scan_load<MODE>(rs, (unsigned)(so0 + ((s_) < last ? (s_) : last) * sstep), lo, lv, d)
#define SC_ST(o_) do { const float y_ = scan_step<MODE>(o_, S, std::make_integer_sequence<int, 64>{}); if (MODE == 2) __builtin_amdgcn_raw_buffer_store_b32(__builtin_bit_cast(unsigned, y_), ry, (int)lv, yo, 0); yo += ystep; } while (0)
    ScanOps o0 = SC_LD(0), o1 = SC_LD(1), o2 = SC_LD(2), o3;
    for (int s = 0; s < nsteps; s += 4) {
        o3 = SC_LD(s + 3); SC_ST(o0);
        o0 = SC_LD(s + 4); SC_ST(o1);
        o1 = SC_LD(s + 5); SC_ST(o2);
        o2 = SC_LD(s + 6); SC_ST(o3);
    }
#undef SC_LD
#undef SC_ST
}
DI void phase_scan1(Ctx& C, int e, int qslot) {
    const float* SCp = (const float*)(C.ws + WS_SCAN + (size_t)e * SCAN_BYTES); float* PQ = (float*)(C.ws + WS_PQ); float* Y = (float*)(C.ws + WS_YSC);
    const int nit = 512 + 64 * (NCH - 1) * 2;
    unsigned* qctr = (unsigned*)(C.ws + WS_CTL) + 8192 + 64 * (e + 2 * qslot);
    for (;;) {
        unsigned itu = 0; if (C.lane == 0) itu = __hip_atomic_fetch_add(qctr, 1u, __ATOMIC_RELAXED, __HIP_MEMORY_SCOPE_AGENT);
        const int it = __builtin_amdgcn_readfirstlane((int)itu); if (it >= nit) break;
        int lane = C.lane; asm volatile("" : "+v"(lane));
        float S[64];
        if (it >= 512) { const int si = it - 512;
            const int kind = si & 1, c = (si >> 1) % (NCH - 1), sidx = (si >> 1) / (NCH - 1);        const int d = sidx & 1, h = (sidx >> 1) & 15, b = sidx >> 5;
            const int t0 = d ? 4095 - c * CHL : c * CHL; const int row0 = MP + b * 4096 + t0;
            float fl = (float)lane; asm volatile("" : "+v"(fl)); const float kf = kind == 0 ? 1.f : 0.f;
#pragma unroll
            for (int j = 0; j < 64; ++j) { S[j] = kf * fmaxf(0.f, 1.f - fabsf(fl - (float)j)); }
            if (kind == 0) scan_wave<0>(SCp, row0, d ? -1 : 1, CHL, h, d, S, nullptr, lane); else scan_wave<1>(SCp, row0, d ? -1 : 1, CHL, h, d, S, nullptr, lane);
            float* dst = PQ + (((size_t)sidx * NCH + c) * 2 + kind) * 4096 + lane * 64;
#pragma unroll
            for (int j = 0; j < 16; ++j) *(f32x4v*)(dst + 4 * j) = (f32x4v){S[4 * j], S[4 * j + 1], S[4 * j + 2], S[4 * j + 3]};
        } else {
            const int pi = it; const int d = pi & 1, h = (pi >> 1) & 15, b = pi >> 5;
#pragma unroll
            for (int j = 0; j < 64; ++j) S[j] = 0.f;
            scan_wave<2>(SCp, b * 256 + (d ? 255 : 0), d ? -1 : 1, 128, h, d, S, Y + (size_t)d * MT * 1024, lane);
            float* dst = (float*)(C.ws + WS_PST) + (size_t)pi * 4096 + lane * 64;
#pragma unroll
            for (int j = 0; j < 16; ++j) *(f32x4v*)(dst + 4 * j) = (f32x4v){S[4 * j], S[4 * j + 1], S[4 * j + 2], S[4 * j + 3]};
        }
    }
}
DI void phase_scan_carry(Ctx& C, int e, int nsw) {
    const float* PQ = (const float*)(C.ws + WS_PQ); float* SST = (float*)(C.ws + WS_SST);
    LAS float* Ss = (LAS float*)C.lds;
    LAS float* Ps = (LAS float*)(C.lds + 64 * 65 * 4 + 64);
    for (int sidx = C.bx; sidx < 64; sidx += C.G) {
        const int d = sidx & 1, h = (sidx >> 1) & 15, b = sidx >> 5; const int row = C.tid & 63, cg = C.wave;
        const float* s0 = C.in[I_ST] + ((((size_t)b * 2 + e) * 2 + d) * 16 + h) * 4096;
        __syncthreads();
        for (int i = C.tid; i < 4096; i += 512) { const float v = s0[i]; Ss[(i >> 6) * 65 + (i & 63)] = v; SST[((size_t)sidx * NCH) * 4096 + i] = v; }
        const float* PQs = PQ + (size_t)sidx * NCH * 2 * 4096;
        f32x4v pp0 = *(const f32x4v*)(PQs + 4 * C.tid), pp1 = *(const f32x4v*)(PQs + 2048 + 4 * C.tid);
        f32x4v qq0 = *(const f32x4v*)(PQs + 4096 + row * 64 + cg * 8), qq1 = *(const f32x4v*)(PQs + 4096 + row * 64 + cg * 8 + 4);
        for (int c = 0; c + 1 < NCH; ++c) {
            __syncthreads();
            *(LAS f32x4v*)(Ps + 4 * C.tid) = pp0; *(LAS f32x4v*)(Ps + 2048 + 4 * C.tid) = pp1;
            float o[8] = {qq0.x, qq0.y, qq0.z, qq0.w, qq1.x, qq1.y, qq1.z, qq1.w};
            if (c + 2 < NCH) { const float* nx = PQs + (size_t)(c + 1) * 2 * 4096;
                pp0 = *(const f32x4v*)(nx + 4 * C.tid); pp1 = *(const f32x4v*)(nx + 2048 + 4 * C.tid);
                qq0 = *(const f32x4v*)(nx + 4096 + row * 64 + cg * 8); qq1 = *(const f32x4v*)(nx + 4096 + row * 64 + cg * 8 + 4); }
            __syncthreads();
            for (int k = 0; k < 64; ++k) { const float sv = Ss[row * 65 + k]; const f32x4v p0 = *(const LAS f32x4v*)(Ps + k * 64 + cg * 8), p1 = *(const LAS f32x4v*)(Ps + k * 64 + cg * 8 + 4);
                o[0] += sv * p0.x; o[1] += sv * p0.y; o[2] += sv * p0.z; o[3] += sv * p0.w; o[4] += sv * p1.x; o[5] += sv * p1.y; o[6] += sv * p1.z; o[7] += sv * p1.w; }
            __syncthreads();
            float* dst = SST + ((size_t)sidx * NCH + c + 1) * 4096 + row * 64 + cg * 8;
#pragma unroll
            for (int i = 0; i < 8; ++i) Ss[row * 65 + cg * 8 + i] = o[i];
            *(f32x4v*)dst = (f32x4v){o[0], o[1], o[2], o[3]}; *(f32x4v*)(dst + 4) = (f32x4v){o[4], o[5], o[6], o[7]};
        }
    }
    {
        const int nb0 = C.G > 64 ? 64 : 0; const float* SCp = (const float*)(C.ws + WS_SCAN + (size_t)e * SCAN_BYTES); float* Y = (float*)(C.ws + WS_YSC);
        if (C.bx >= nb0 && C.wave < nsw) for (int pi = (C.bx - nb0) * nsw + C.wave; pi < 512; pi += (C.G - nb0) * nsw) {
            int lane = C.lane; asm volatile("" : "+v"(lane));
            const int d = pi & 1, h = (pi >> 1) & 15, b = pi >> 5;
            float S[64]; const float* src = (const float*)(C.ws + WS_PST) + (size_t)pi * 4096 + lane * 64;
#pragma unroll
            for (int j = 0; j < 16; ++j) { const f32x4v t = *(const f32x4v*)(src + 4 * j); S[4 * j] = t.x; S[4 * j + 1] = t.y; S[4 * j + 2] = t.z; S[4 * j + 3] = t.w; }
            scan_wave<2>(SCp, b * 256 + (d ? 127 : 128), d ? -1 : 1, 128, h, d, S, Y + (size_t)d * MT * 1024, lane);
            float* dst = C.out + OUT_ST + ((((size_t)b * 2 + e) * 2 + d) * 16 + h) * 4096 + lane * 64;
#pragma unroll
            for (int j = 0; j < 16; ++j) *(f32x4v*)(dst + 4 * j) = (f32x4v){S[4 * j], S[4 * j + 1], S[4 * j + 2], S[4 * j + 3]};
        }
    }
}
DI void phase_scan3(Ctx& C, int e) {
    const float* SCp = (const float*)(C.ws + WS_SCAN + (size_t)e * SCAN_BYTES); const float* SST = (const float*)(C.ws + WS_SST); float* Y = (float*)(C.ws + WS_YSC);
    for (int it = C.gw; it < 64 * NCH; it += C.NGW) {
        int lane = C.lane; asm volatile("" : "+v"(lane));
        const int c = it % NCH, sidx = it / NCH; const int d = sidx & 1, h = (sidx >> 1) & 15, b = sidx >> 5;
        const int t0 = d ? 4095 - c * CHL : c * CHL; const int row0 = MP + b * 4096 + t0;
        float S[64]; const float* src = SST + ((size_t)sidx * NCH + c) * 4096 + lane * 64;
#pragma unroll
        for (int j = 0; j < 16; ++j) { const f32x4v t = *(const f32x4v*)(src + 4 * j); S[4 * j] = t.x; S[4 * j + 1] = t.y; S[4 * j + 2] = t.z; S[4 * j + 3] = t.w; }
        scan_wave<2>(SCp, row0, d ? -1 : 1, CHL, h, d, S, Y + (size_t)d * MT * 1024, lane);
    }
}
DI float row16_sum(float v) { v += dpp_f<0xB1>(v); v += dpp_f<0x4E>(v); v += dpp_f<0x141>(v); v += dpp_f<0x140>(v); return v; }
DI void phase_rwkv_post(Ctx& C, int e) {
    const float* SCp = (const float*)(C.ws + WS_SCAN + (size_t)e * SCAN_BYTES); const float* Y = (const float*)(C.ws + WS_YSC); const float* GB = (const float*)(C.ws + WS_GB); bf16* MIX = (bf16*)(C.ws + WS_MIX);
    const float* rk = C.in[I_RK] + e * 1024; const float* gw = C.in[I_GNW] + e * 1024; const float* gb = C.in[I_GNB] + e * 1024; const int lane = C.lane;
    for (int row = C.gw; row < MT; row += C.NGW) {
        const float* sc = SCp + (size_t)row * SCAN_P;
#pragma unroll
        for (int i = 0; i < 4; ++i) { const int c = 256 * i + 4 * lane;
            const f32x4v y = *(const f32x4v*)(Y + (size_t)row * 1024 + c) + *(const f32x4v*)(Y + ((size_t)MT + row) * 1024 + c);
            const float mu = row16_sum((y.x + y.y) + (y.z + y.w)) * (1.0f / 64.0f); const f32x4v dl = y - mu;
            const float var = row16_sum((dl.x * dl.x + dl.y * dl.y) + (dl.z * dl.z + dl.w * dl.w)) * (1.0f / 64.0f);
            const f32x4v yn = dl * (1.0f / sqrtf(var + 64e-5f));
            const f32x4v rr = *(const f32x4v*)(sc + c), kd = *(const f32x4v*)(sc + 7 * 1024 + c) + *(const f32x4v*)(sc + 8 * 1024 + c), rkv = *(const f32x4v*)(rk + c); const f32x4v pb = rr * kd * rkv;
            const float bs = row16_sum((pb.x + pb.y) + (pb.z + pb.w));
            const f32x4v o = (yn * *(const f32x4v*)(gw + c) + *(const f32x4v*)(gb + c) + *(const f32x4v*)(sc + 1024 + c) * bs) * *(const f32x4v*)(GB + (size_t)row * 1024 + c);
            v2u w; w.x = pk2(o.x, o.y); w.y = pk2(o.z, o.w); *(v2u*)(MIX + (size_t)row * 2048 + c) = w; }
    }
}

constexpr int AT_KP = 200, AT_VP = 72, AT_KB = 64 * AT_KP * 2, AT_VB = 128 * AT_VP * 2, AT_BUF = AT_KB + AT_VB;
DI void attn_unit(Ctx& C, const bf16* Qb, const bf16* KN, const bf16* KRb, const bf16* VTh  , int vpitch, bf16* MIX, int qrow0, int h, int krow0, int nlat, int crow0, int ntile) {
    int tid = C.tid; asm volatile("" : "+v"(tid)); const int lane = tid & 63, r = lane & 31, hh = lane >> 5;
    LAS unsigned char* lds = C.lds;
    s16x8v qf[12];
    { const bf16* qp = Qb + (size_t)(qrow0 + C.wave * 32 + r) * 1536 + h * 192 + 8 * hh;
#pragma unroll
      for (int s = 0; s < 12; ++s) qf[s] = *(const s16x8v*)(qp + 16 * s); }
    f32x16v o[4];
#pragma unroll
    for (int vb = 0; vb < 4; ++vb)
#pragma unroll
        for (int i = 0; i < 16; ++i) o[vb][i] = 0.f;
    float mrun = -INFINITY, lsum = 0.f;
    v4u pre[5];
    auto issue = [&](int j) {
        const int k0 = 64 * j; const int rbase = k0 < nlat ? krow0 + k0 : crow0 + (k0 - nlat);
#pragma unroll
        for (int i = 0; i < 3; ++i) { const int p = tid + 512 * i, key = p / 24, pc = p % 24; const size_t rw = (size_t)(rbase + key);
            pre[i] = pc < 16 ? *(const v4u*)(KN + rw * 1024 + h * 128 + pc * 8) : *(const v4u*)(KRb + rw * 64 + (pc - 16) * 8); }
#pragma unroll
        for (int i = 0; i < 2; ++i) { const int p = tid + 512 * i, dv = p >> 3, pc = p & 7; pre[3 + i] = *(const v4u*)(VTh + (size_t)dv * vpitch + k0 + pc * 8); }
    };
    auto commit = [&](int buf) {
        LAS unsigned char* kb = lds + buf * AT_BUF; LAS unsigned char* vbp = kb + AT_KB;
#pragma unroll
        for (int i = 0; i < 3; ++i) { const int p = tid + 512 * i, key = p / 24, pc = p % 24; *(LAS v4u*)(kb + key * (AT_KP * 2) + pc * 16) = pre[i]; }
#pragma unroll
        for (int i = 0; i < 2; ++i) { const int p = tid + 512 * i, dv = p >> 3, pc = p & 7; *(LAS v4u*)(vbp + dv * (AT_VP * 2) + pc * 16) = pre[3 + i]; }
    };
    __syncthreads();
    issue(0); commit(0); __syncthreads();
    for (int j = 0; j < ntile; ++j) {
        if (j + 1 < ntile) issue(j + 1);
        const LAS unsigned char* kb = lds + (j & 1) * AT_BUF; const LAS unsigned char* vbp = kb + AT_KB;
        f32x16v st[2];
        __builtin_amdgcn_s_setprio(1);
#pragma unroll
        for (int kbk = 0; kbk < 2; ++kbk) {
#pragma unroll
            for (int i = 0; i < 16; ++i) st[kbk][i] = 0.f;
#pragma unroll
            for (int s = 0; s < 12; ++s) { const s16x8v a = *(const LAS s16x8v*)(kb + (32 * kbk + r) * (AT_KP * 2) + (16 * s + 8 * hh) * 2);
                st[kbk] = __builtin_amdgcn_mfma_f32_32x32x16_bf16(a, qf[s], st[kbk], 0, 0, 0); }
        }
        __builtin_amdgcn_s_setprio(0);
        float mx = st[0][0];
#pragma unroll
        for (int i = 1; i < 16; ++i) mx = fmaxf(mx, st[0][i]);
#pragma unroll
        for (int i = 0; i < 16; ++i) mx = fmaxf(mx, st[1][i]);
        mx = fmaxf(mx, shfl_idx(mx, lane ^ 32));
        const float mnew = fmaxf(mrun, mx); const float alpha = __builtin_amdgcn_exp2f(mrun - mnew); mrun = mnew;
        float ps = 0.f;
#pragma unroll
        for (int kbk = 0; kbk < 2; ++kbk)
#pragma unroll
            for (int i = 0; i < 16; ++i) { const float p = __builtin_amdgcn_exp2f(st[kbk][i] - mnew); st[kbk][i] = p; ps += p; }
        lsum = lsum * alpha + ps;
        if (__builtin_amdgcn_ballot_w64(alpha != 1.0f) != 0ull) {
#pragma unroll
            for (int vb = 0; vb < 4; ++vb)
#pragma unroll
                for (int i = 0; i < 16; ++i) o[vb][i] *= alpha; }
        __builtin_amdgcn_s_setprio(1);
#pragma unroll
        for (int kbk = 0; kbk < 2; ++kbk)
#pragma unroll
            for (int s2 = 0; s2 < 2; ++s2) {
                v4u pw; pw.x = pg8::cvt_pk_bf16(st[kbk][8 * s2 + 0], st[kbk][8 * s2 + 1]); pw.y = pg8::cvt_pk_bf16(st[kbk][8 * s2 + 2], st[kbk][8 * s2 + 3]); pw.z = pg8::cvt_pk_bf16(st[kbk][8 * s2 + 4], st[kbk][8 * s2 + 5]); pw.w = pg8::cvt_pk_bf16(st[kbk][8 * s2 + 6], st[kbk][8 * s2 + 7]);
                const s16x8v pf = __builtin_bit_cast(s16x8v, pw);
#pragma unroll
                for (int vb = 0; vb < 4; ++vb) { const LAS unsigned char* vp = vbp + (32 * vb + r) * (AT_VP * 2) + (32 * kbk + 16 * s2 + 4 * hh) * 2;
                    const v2u lo = *(const LAS v2u*)vp, hi = *(const LAS v2u*)(vp + 16); const v4u av = {lo.x, lo.y, hi.x, hi.y};
                    o[vb] = __builtin_amdgcn_mfma_f32_32x32x16_bf16(__builtin_bit_cast(s16x8v, av), pf, o[vb], 0, 0, 0); }
            }
        __builtin_amdgcn_s_setprio(0);
        if (j + 1 < ntile) commit((j + 1) & 1);
        __syncthreads();
    }
    const float inv = 1.0f / (lsum + shfl_idx(lsum, lane ^ 32));
    bf16* op = MIX + (size_t)(qrow0 + C.wave * 32 + r) * 2048 + 1024 + h * 128 + 4 * hh;
#pragma unroll
    for (int vb = 0; vb < 4; ++vb)
#pragma unroll
        for (int g = 0; g < 4; ++g) { v2u w; w.x = pk2(o[vb][4 * g] * inv, o[vb][4 * g + 1] * inv); w.y = pk2(o[vb][4 * g + 2] * inv, o[vb][4 * g + 3] * inv);
            *(v2u*)(op + 32 * vb + 8 * g) = w; }
}
DI void phase_attention(Ctx& C) {
    unsigned char* ws = C.ws; const bf16* Qb = (const bf16*)(ws + WS_Q); const bf16* KN = (const bf16*)(ws + WS_KN); const bf16* KRb = (const bf16*)(ws + WS_KR); bf16* MIX = (bf16*)(ws + WS_MIX);
    const bf16* VTp = (const bf16*)(ws + WS_VT); const bf16* VTs = (const bf16*)(ws + WS_VT + VT_S_OFF);
    for (int u = C.bx; u < 256 + 128; u += C.G) {
        if (u < 256) { const int qb = u & 15, h = (u >> 4) & 7, b = u >> 7;
            attn_unit(C, Qb, KN, KRb, VTs + ((size_t)b * 1024 + h * 128) * 4352, 4352, MIX, MP + b * 4096 + qb * 256, h, MP + b * 4096, 4096, MT + b * 256, 68); }
        else { const int v = u - 256, h = v & 7, b = v >> 3;
            attn_unit(C, Qb, KN, KRb, VTp + ((size_t)b * 1024 + h * 128) * 256, 256, MIX, b * 256, h, b * 256, 256, 0, 4); }
    }
    __syncthreads();
}

DI f32x2v mk2(float a, float b) { return (f32x2v){a, b}; }
DI f32x2v cmul(f32x2v a, f32x2v b) { const f32x2v t = {-b.y, b.x}; return a.x * b + a.y * t; }
DI f32x2v cmulc(f32x2v a, f32x2v b) { const f32x2v t = {b.y, -b.x}; return a.x * b + a.y * t; }
DI f32x2v mul_mi(f32x2v a) { return mk2(a.y, -a.x); }
DI f32x2v mul_pi(f32x2v a) { return mk2(-a.y, a.x); }
DI f32x2v twid(int p, int den) { const float fr = (float)p / (float)den; return mk2(__builtin_amdgcn_cosf(fr), __builtin_amdgcn_sinf(fr)); }
DI int PD(int i) { return i + ((i >> 5) << 1); }
constexpr int FFT_BS = 8192 + 512, FFT_BUF_BYTES = FFT_BS * 8;
DI void bf4_fwd(f32x2v& x0, f32x2v& x1, f32x2v& x2, f32x2v& x3, f32x2v w0, f32x2v wm) {
    const f32x2v a0 = x0 + x2, a2 = cmul(x0 - x2, w0), a1 = x1 + x3, a3 = cmul(x1 - x3, mul_mi(w0));
    x0 = a0 + a1; x1 = cmul(a0 - a1, wm); x2 = a2 + a3; x3 = cmul(a2 - a3, wm);
}
DI void bf4_inv(f32x2v& x0, f32x2v& x1, f32x2v& x2, f32x2v& x3, f32x2v wa, f32x2v w) {
    const f32x2v t1 = cmul(x1, w), t3 = cmul(x3, w);
    const f32x2v a0 = x0 + t1, a1 = x0 - t1, a2 = x2 + t3, a3 = x2 - t3;
    const f32x2v t2 = cmul(a2, wa), t3b = cmul(a3, mul_pi(wa));
    x0 = a0 + t2; x1 = a1 + t3b; x2 = a0 - t2; x3 = a1 - t3b;
}
template <int N, int M, int NI = 1> DI void fft_fwd_pass(LAS f32x2v* buf, int tid) {
    constexpr int S = M / 8;
    const int tr = tid / (N / 16), u = tid % (N / 16), g = u / S, p = u % S; const int base = tr * N + g * 2 * M + p;
    f32x2v e[NI][16];
#pragma unroll
    for (int j = 0; j < NI; ++j)
#pragma unroll
        for (int k = 0; k < 16; ++k) e[j][k] = buf[j * FFT_BS + PD(base + k * S)];
    const f32x2v bc = twid(p, 2 * M); const f32x2v b1 = mk2(bc.x, -bc.y), b2 = cmul(b1, b1), b4 = cmul(b2, b2), b8 = cmul(b4, b4);
    constexpr float C1 = 0.92387953251128674f, S1 = 0.38268343236508977f, R2 = 0.70710678118654752f;
    const f32x2v w1a = cmul(b1, mk2(C1, -S1)), w1b = cmul(b2, mk2(R2, -R2)), w2a = cmul(b1, mk2(R2, -R2)), w2b = mul_mi(b2), w3a = cmul(b1, mk2(S1, -C1)), w3b = cmul(b2, mk2(-R2, -R2));
#pragma unroll
    for (int j = 0; j < NI; ++j) {
        bf4_fwd(e[j][0], e[j][4], e[j][8], e[j][12], b1, b2);
        bf4_fwd(e[j][1], e[j][5], e[j][9], e[j][13], w1a, w1b);
        bf4_fwd(e[j][2], e[j][6], e[j][10], e[j][14], w2a, w2b);
        bf4_fwd(e[j][3], e[j][7], e[j][11], e[j][15], w3a, w3b);
#pragma unroll
        for (int q = 0; q < 4; ++q) bf4_fwd(e[j][4 * q], e[j][4 * q + 1], e[j][4 * q + 2], e[j][4 * q + 3], b4, b8);
#pragma unroll
        for (int k = 0; k < 16; ++k) buf[j * FFT_BS + PD(base + k * S)] = e[j][k];
    }
    __syncthreads();
    if constexpr (M / 16 >= 32) fft_fwd_pass<N, M / 16, NI>(buf, tid);
}
constexpr float c32q(int k) { return k == 0 ? 1.f : k == 1 ? 0.98078528040323043f : k == 2 ? 0.92387953251128674f : k == 3 ? 0.83146961230254524f : k == 4 ? 0.70710678118654752f : k == 5 ? 0.55557023301960218f : k == 6 ? 0.38268343236508977f : k == 7 ? 0.19509032201612825f : 0.f; }
constexpr float c32(int k) { return k <= 8 ? c32q(k) : -c32q(16 - k); }
constexpr float s32(int k) { return k <= 8 ? c32q(8 - k) : c32q(k - 8); }
DI void bf4_fwd_t(f32x2v& x0, f32x2v& x1, f32x2v& x2, f32x2v& x3) {
    const f32x2v a0 = x0 + x2, a2 = x0 - x2, a1 = x1 + x3, a3 = mul_mi(x1 - x3);
    x0 = a0 + a1; x1 = a0 - a1; x2 = a2 + a3; x3 = a2 - a3;
}
DI void bf4_fwd_b1(f32x2v& x0, f32x2v& x1, f32x2v& x2, f32x2v& x3) {
    constexpr float R2 = 0.70710678118654752f;
    const f32x2v a0 = x0 + x2, a2 = cmul(x0 - x2, mk2(R2, -R2)), a1 = x1 + x3, a3 = cmul(x1 - x3, mk2(-R2, -R2));
    x0 = a0 + a1; x1 = mul_mi(a0 - a1); x2 = a2 + a3; x3 = mul_mi(a2 - a3);
}
DI void bf4_inv_t(f32x2v& x0, f32x2v& x1, f32x2v& x2, f32x2v& x3) {
    const f32x2v a0 = x0 + x1, a1 = x0 - x1, a2 = x2 + x3, a3 = x2 - x3; const f32x2v t3b = mul_pi(a3);
    x0 = a0 + a2; x1 = a1 + t3b; x2 = a0 - a2; x3 = a1 - t3b;
}
DI void bf4_inv_b1(f32x2v& x0, f32x2v& x1, f32x2v& x2, f32x2v& x3) {
    constexpr float R2 = 0.70710678118654752f;
    const f32x2v t1 = mul_pi(x1), t3 = mul_pi(x3); const f32x2v a0 = x0 + t1, a1 = x0 - t1, a2 = x2 + t3, a3 = x2 - t3;
    const f32x2v t2 = cmul(a2, mk2(R2, R2)), t3b = cmul(a3, mk2(-R2, R2));
    x0 = a0 + t2; x1 = a1 + t3b; x2 = a0 - t2; x3 = a1 - t3b;
}
template <int NI> DI void fft_r32_fwd(LAS f32x2v* buf, int tid) {
    const int img = tid >> 8, g = tid & 255;
    if (img < NI) {
        LAS f32x4v* p = (LAS f32x4v*)(buf + img * FFT_BS + 34 * g);
        f32x2v r[32];
#pragma unroll
        for (int m = 0; m < 16; ++m) { const f32x4v v = p[m]; r[2 * m] = mk2(v.x, v.y); r[2 * m + 1] = mk2(v.z, v.w); }
        bf4_fwd_t(r[0], r[8], r[16], r[24]);
#pragma unroll
        for (int j = 1; j < 8; ++j) bf4_fwd(r[j], r[j + 8], r[j + 16], r[j + 24], mk2(c32(j), -s32(j)), mk2(c32(2 * j), -s32(2 * j)));
#pragma unroll
        for (int q = 0; q < 4; ++q) { bf4_fwd_t(r[8 * q], r[8 * q + 2], r[8 * q + 4], r[8 * q + 6]); bf4_fwd_b1(r[8 * q + 1], r[8 * q + 3], r[8 * q + 5], r[8 * q + 7]); }
#pragma unroll
        for (int m = 0; m < 16; ++m) { const f32x2v a = r[2 * m] + r[2 * m + 1], b = r[2 * m] - r[2 * m + 1]; p[m] = (f32x4v){a.x, a.y, b.x, b.y}; }
    }
    __syncthreads();
}
template <int NI> DI void fft_r32_inv(LAS f32x2v* buf, int tid) {
    const int img = tid >> 8, g = tid & 255;
    if (img < NI) {
        LAS f32x4v* p = (LAS f32x4v*)(buf + img * FFT_BS + 34 * g);
        f32x2v r[32];
#pragma unroll
        for (int m = 0; m < 16; ++m) { const f32x4v v = p[m]; r[2 * m] = mk2(v.x + v.z, v.y + v.w); r[2 * m + 1] = mk2(v.x - v.z, v.y - v.w); }
#pragma unroll
        for (int q = 0; q < 4; ++q) { bf4_inv_t(r[8 * q], r[8 * q + 2], r[8 * q + 4], r[8 * q + 6]); bf4_inv_b1(r[8 * q + 1], r[8 * q + 3], r[8 * q + 5], r[8 * q + 7]); }
        bf4_inv_t(r[0], r[8], r[16], r[24]);
#pragma unroll
        for (int j = 1; j < 8; ++j) bf4_inv(r[j], r[j + 8], r[j + 16], r[j + 24], mk2(c32(j), s32(j)), mk2(c32(2 * j), s32(2 * j)));
#pragma unroll
        for (int m = 0; m < 16; ++m) p[m] = (f32x4v){r[2 * m].x, r[2 * m].y, r[2 * m + 1].x, r[2 * m + 1].y};
    }
    __syncthreads();
}
template <int N, int NI = 1> DI void fft_fwd(LAS f32x2v* buf, int tid) {
    asm volatile("" : "+v"(tid));
    fft_fwd_pass<N, N / 2, NI>(buf, tid);
    fft_r32_fwd<NI>(buf, tid);
}
template <int N, int M, int NI = 1, bool REC = true> DI void fft_inv_pass(LAS f32x2v* buf, int tid) {
    const int tr = tid / (N / 16), u = tid % (N / 16), g = u / M, p = u % M; const int base = tr * N + g * 16 * M + p;
    f32x2v e[NI][16];
#pragma unroll
    for (int j = 0; j < NI; ++j)
#pragma unroll
        for (int k = 0; k < 16; ++k) e[j][k] = buf[j * FFT_BS + PD(base + k * M)];
    const f32x2v a1 = twid(p, 16 * M), a2 = cmul(a1, a1), a4 = cmul(a2, a2), a8 = cmul(a4, a4);
    constexpr float C1 = 0.92387953251128674f, S1 = 0.38268343236508977f, R2 = 0.70710678118654752f;
    const f32x2v v1a = cmul(a1, mk2(C1, S1)), v1b = cmul(a2, mk2(R2, R2)), v2a = cmul(a1, mk2(R2, R2)), v2b = mul_pi(a2), v3a = cmul(a1, mk2(S1, C1)), v3b = cmul(a2, mk2(-R2, R2));
#pragma unroll
    for (int j = 0; j < NI; ++j) {
#pragma unroll
        for (int q = 0; q < 4; ++q) bf4_inv(e[j][4 * q], e[j][4 * q + 1], e[j][4 * q + 2], e[j][4 * q + 3], a4, a8);
        bf4_inv(e[j][0], e[j][4], e[j][8], e[j][12], a1, a2);
        bf4_inv(e[j][1], e[j][5], e[j][9], e[j][13], v1a, v1b);
        bf4_inv(e[j][2], e[j][6], e[j][10], e[j][14], v2a, v2b);
        bf4_inv(e[j][3], e[j][7], e[j][11], e[j][15], v3a, v3b);
#pragma unroll
        for (int k = 0; k < 16; ++k) buf[j * FFT_BS + PD(base + k * M)] = e[j][k];
    }
    __syncthreads();
    if constexpr (REC && 16 * M < N) fft_inv_pass<N, 16 * M, NI>(buf, tid);
}
template <int N, int NI = 1> DI void fft_inv(LAS f32x2v* buf, int tid) {
    asm volatile("" : "+v"(tid));
    fft_r32_inv<NI>(buf, tid);
    fft_inv_pass<N, 32, NI>(buf, tid);
}
template <int N> DI int ks_perm(int e) { if constexpr (N == 8192) return e < 4096 ? (((e & 63) << 6) | (e >> 6)) : e; else return e; }
template <int N, int NI> DI void fft_pairmul_pre(LAS f32x2v* buf, const f32x4v (&ksr)[8], const f32x4v* KS, int tid) {
    asm volatile("" : "+v"(tid));
    constexpr int LOG = (N == 8192) ? 13 : 9, NB = 8192 / N, NK = N / 2 + 1;
#pragma unroll
    for (int r = 0; r < 9; ++r) {
        const int idx = tid + 512 * r;
        if (r == 8 && idx >= NB * NK) break;
        f32x4v ks; if (r < 8) ks = ksr[r]; else ks = KS[idx];
        const int tr = idx / NK, k = ks_perm<N>(idx % NK);
        const int pk = PD(tr * N + (int)(__brev((unsigned)k) >> (32 - LOG))), pn = PD(tr * N + (int)(__brev((unsigned)((N - k) & (N - 1))) >> (32 - LOG)));
#pragma unroll
        for (int j = 0; j < NI; ++j) {
            const f32x2v zk = buf[j * FFT_BS + pk], zn = buf[j * FFT_BS + pn];
            const f32x2v u1 = mk2(0.5f * (zk.x + zn.x), 0.5f * (zk.y - zn.y)), u2 = mk2(0.5f * (zk.y + zn.y), -0.5f * (zk.x - zn.x));
            const f32x2v y1 = cmul(u1, mk2(ks.x, ks.y)), y2 = cmul(u2, mk2(ks.z, ks.w));
            buf[j * FFT_BS + pk] = mk2(y1.x - y2.y, y1.y + y2.x);
            if (pn != pk) buf[j * FFT_BS + pn] = mk2(y1.x + y2.y, -y1.y + y2.x);
        }
    }
}
template <int N, int NI> DI void fft_fwd_first(LAS f32x2v* buf, int tid, const float (&u0)[NI][8], const float (&u1)[NI][8]) {
    asm volatile("" : "+v"(tid));
    constexpr int M = N / 2, S = M / 8;
    const int tr = tid / (N / 16), p = tid % (N / 16); const int base = tr * N + p;
    const f32x2v bc = twid(p, 2 * M); const f32x2v b1 = mk2(bc.x, -bc.y), b2 = cmul(b1, b1), b4 = cmul(b2, b2), b8 = cmul(b4, b4);
    constexpr float C1 = 0.92387953251128674f, S1 = 0.38268343236508977f, R2 = 0.70710678118654752f;
    const f32x2v w1a = cmul(b1, mk2(C1, -S1)), w1b = cmul(b2, mk2(R2, -R2)), w2a = cmul(b1, mk2(R2, -R2)), w2b = mul_mi(b2), w3a = cmul(b1, mk2(S1, -C1)), w3b = cmul(b2, mk2(-R2, -R2));
    __syncthreads();
#pragma unroll
    for (int j = 0; j < NI; ++j) {
        f32x2v e[16];
#define FFT_HALF_FWD(i, w0, wm) { const f32x2v x0 = mk2(u0[j][i], u1[j][i]), x1 = mk2(u0[j][i + 4], u1[j][i + 4]); const f32x2v a2 = cmul(x0, w0), a3 = cmul(x1, mul_mi(w0)); \
            e[i] = x0 + x1; e[i + 4] = cmul(x0 - x1, wm); e[i + 8] = a2 + a3; e[i + 12] = cmul(a2 - a3, wm); }
        FFT_HALF_FWD(0, b1, b2) FFT_HALF_FWD(1, w1a, w1b) FFT_HALF_FWD(2, w2a, w2b) FFT_HALF_FWD(3, w3a, w3b)
#undef FFT_HALF_FWD
#pragma unroll
        for (int q = 0; q < 4; ++q) bf4_fwd(e[4 * q], e[4 * q + 1], e[4 * q + 2], e[4 * q + 3], b4, b8);
#pragma unroll
        for (int k = 0; k < 16; ++k) buf[j * FFT_BS + PD(base + k * S)] = e[k];
    }
    __syncthreads();
}
template <int N, int NI> DI void fft_inv_last(LAS f32x2v* buf, int tid, f32x2v (&out)[NI][8]) {
    asm volatile("" : "+v"(tid));
    constexpr int M = N / 16;
    const int tr = tid / (N / 16), p = tid % (N / 16); const int base = tr * N + p;
    const f32x2v a1 = twid(p, 16 * M), a2 = cmul(a1, a1), a4 = cmul(a2, a2), a8 = cmul(a4, a4);
    constexpr float C1 = 0.92387953251128674f, S1 = 0.38268343236508977f, R2 = 0.70710678118654752f;
    const f32x2v v1a = cmul(a1, mk2(C1, S1)), v1b = cmul(a2, mk2(R2, R2)), v2a = cmul(a1, mk2(R2, R2)), v2b = mul_pi(a2), v3a = cmul(a1, mk2(S1, C1)), v3b = cmul(a2, mk2(-R2, R2));
#pragma unroll
    for (int j = 0; j < NI; ++j) {
        f32x2v e[16];
#pragma unroll
        for (int k = 0; k < 16; ++k) e[k] = buf[j * FFT_BS + PD(base + k * M)];
#pragma unroll
        for (int q = 0; q < 4; ++q) bf4_inv(e[4 * q], e[4 * q + 1], e[4 * q + 2], e[4 * q + 3], a4, a8);
#define FFT_HALF_INV(i, wa, w) { const f32x2v t1 = cmul(e[i + 4], w), t3 = cmul(e[i + 12], w); const f32x2v a0 = e[i] + t1, a1_ = e[i] - t1, a2_ = e[i + 8] + t3, a3 = e[i + 8] - t3; \
            out[j][i] = a0 + cmul(a2_, wa); out[j][i + 4] = a1_ + cmul(a3, mul_pi(wa)); }
        FFT_HALF_INV(0, a1, a2) FFT_HALF_INV(1, v1a, v1b) FFT_HALF_INV(2, v2a, v2b) FFT_HALF_INV(3, v3a, v3b)
#undef FFT_HALF_INV
    }
}
template <int N, int NI = 1, bool SH = false> DI void fft_pairmul(LAS f32x2v* buf, const f32x4v* const (&KS)[NI]  , int tid) {
    asm volatile("" : "+v"(tid));
    constexpr int LOG = (N == 8192) ? 13 : 9, NB = 8192 / N, NK = N / 2 + 1;
    for (int idx = tid; idx < NB * NK; idx += 512) {
        const int tr = idx / NK, k = ks_perm<N>(idx % NK);
        const int pk = PD(tr * N + (int)(__brev((unsigned)k) >> (32 - LOG))), pn = PD(tr * N + (int)(__brev((unsigned)((N - k) & (N - 1))) >> (32 - LOG)));
        f32x4v ks0 = {0.f, 0.f, 0.f, 0.f}; if (SH) ks0 = KS[0][idx];
#pragma unroll
        for (int j = 0; j < NI; ++j) {
            const f32x2v zk = buf[j * FFT_BS + pk], zn = buf[j * FFT_BS + pn]; const f32x4v ks = SH ? ks0 : KS[j][idx];
            const f32x2v u1 = mk2(0.5f * (zk.x + zn.x), 0.5f * (zk.y - zn.y)), u2 = mk2(0.5f * (zk.y + zn.y), -0.5f * (zk.x - zn.x));
            const f32x2v y1 = cmul(u1, mk2(ks.x, ks.y)), y2 = cmul(u2, mk2(ks.z, ks.w));
            buf[j * FFT_BS + pk] = mk2(y1.x - y2.y, y1.y + y2.x);
            if (pn != pk) buf[j * FFT_BS + pn] = mk2(y1.x + y2.y, -y1.y + y2.x);
        }
    }
}
template <int T> DI void hyena_filter_item(Ctx& C, int o, int n, int pair0) {
    constexpr int N = 2 * T, NB = 4096 / T, LOG = (N == 8192) ? 13 : 9, NK = N / 2 + 1;
    const float* KT = (const float*)(C.ws + WS_SCAN); LAS f32x2v* buf = (LAS f32x2v*)C.lds; LAS float* red = (LAS float*)(C.lds + FFT_BUF_BYTES + 1024);
    int tid = C.tid; asm volatile("" : "+v"(tid)); const int toff = T == 256 ? 0 : 256;
    const float dmin = 4.605170185988092f / 1.5f, dmax = 4.605170185988092f / 0.3f;
    __syncthreads();
    if (tid < 2 * NB) red[tid] = 0.f;
    __syncthreads();
    float k0[16], k1[16];
#pragma unroll
    for (int i = 0; i < 16; ++i) { const int idx = tid + 512 * i, tr = idx / N, pos = idx % N; const int c = 2 * (pair0 + tr);
        float a = 0.f, b = 0.f;
        if (pos != T) { const int side = pos > T ? 1 : 0, tt = pos > T ? N - pos : pos; const float tn = (float)tt / (float)(T - 1);
            const float* kr = KT + ((size_t)o * 8192 + (n * 2 + side) * 2048 + c) * 4352 + toff + tt;
            const float d0 = dmin + (dmax - dmin) * ((float)c / 2047.0f), d1 = dmin + (dmax - dmin) * ((float)(c + 1) / 2047.0f);
            a = kr[0] * expf(-tn * d0); b = kr[4352] * expf(-tn * d1); }
        k0[i] = a; k1[i] = b;
        const float sa = wave_sum(fabsf(a)), sb = wave_sum(fabsf(b));
        if (C.lane == 0) { __hip_atomic_fetch_add(&red[2 * tr], sa, __ATOMIC_RELAXED, __HIP_MEMORY_SCOPE_WORKGROUP); __hip_atomic_fetch_add(&red[2 * tr + 1], sb, __ATOMIC_RELAXED, __HIP_MEMORY_SCOPE_WORKGROUP); } }
    __syncthreads();
    int tl = tid; asm volatile("" : "+v"(tl));
#pragma unroll
    for (int i = 0; i < 16; ++i) { const int idx = tl + 512 * i, tr = idx / N; f32x2v kv = mk2(k0[i] / red[2 * tr], k1[i] / red[2 * tr + 1]);
        if (idx % N == 0) { const float* hb = C.in[I_HB] + (size_t)(o * 2 + n) * 2048 + 2 * (pair0 + tr); kv.x += hb[0]; kv.y += hb[1]; }
        buf[PD(idx)] = kv; }
    __syncthreads();
    fft_fwd<N>(buf, tid);
    f32x4v* KS = (f32x4v*)(C.ws + (T == 256 ? WS_KSP : WS_KSS)) + ((size_t)(o * 2 + n) * 1024 + pair0) * NK;
    const float sc = 1.0f / (float)N;
    for (int idx = tid; idx < NB * NK; idx += 512) { const int tr = idx / NK, k = ks_perm<N>(idx % NK);
        const int pk = tr * N + (int)(__brev((unsigned)k) >> (32 - LOG)), pn = tr * N + (int)(__brev((unsigned)((N - k) & (N - 1))) >> (32 - LOG));
        const f32x2v zk = buf[PD(pk)], zn = buf[PD(pn)];
        KS[idx] = (f32x4v){0.5f * (zk.x + zn.x) * sc, 0.5f * (zk.y - zn.y) * sc, 0.5f * (zk.y + zn.y) * sc, -0.5f * (zk.x - zn.x) * sc}; }
}
DI void phase_hyena_filters(Ctx& C) {
    for (int it = C.vb; it < 4 * 1024 + 4 * 64; it += C.G) {
        if (it < 4096) hyena_filter_item<4096>(C, it >> 11, (it >> 10) & 1, it & 1023);
        else { const int v = it - 4096; hyena_filter_item<256>(C, v >> 7, (v >> 6) & 1, (v & 63) * 16); }
    }
    __syncthreads();
}
template <int T, int NI, int PROBE = 0, bool SH = false> DI void hyena_conv_item(Ctx& C, int o, const int (&seq)[NI], const int (&pair0)[NI]) {
    constexpr int N = 2 * T, NB = 4096 / T, NK = N / 2 + 1;
    LAS f32x2v* buf = (LAS f32x2v*)C.lds; const int tid = C.tid;
    const float* cw = C.in[I_CW] + (size_t)o * 3 * 6144; const float* cb = C.in[I_CB] + (size_t)o * 6144;
    bf16* Y = (bf16*)(C.ws + WS_MIX);
    const float* ZT[NI]; const f32x4v* KS0[NI]; const f32x4v* KS1[NI]; int rowbase[NI];
#pragma unroll
    for (int j = 0; j < NI; ++j) { ZT[j] = (const float*)(C.ws + WS_Z + (T == 256 ? 0 : ZT_S_OFF)) + (size_t)seq[j] * 6144 * T;
        KS0[j] = (const f32x4v*)(C.ws + (T == 256 ? WS_KSP : WS_KSS)) + ((size_t)(o * 2 + 0) * 1024 + pair0[j]) * NK; KS1[j] = KS0[j] + (size_t)1024 * NK;
        rowbase[j] = T == 256 ? seq[j] * 256 : MP + seq[j] * 4096; }
    constexpr int NQ = SH ? 1 : NI;
    float wq[NQ][6][4];
    if constexpr (T == 4096) {
        auto sg = [](float v) { return __builtin_bit_cast(float, __builtin_amdgcn_readfirstlane(__builtin_bit_cast(int, v))); };
#pragma unroll
        for (int j = 0; j < NQ; ++j) {
#pragma unroll
            for (int gq = 0; gq < 6; ++gq) { const int ch = (gq >> 1) * 2048 + 2 * pair0[j] + (gq & 1); wq[j][gq][0] = sg(cw[ch]); wq[j][gq][1] = sg(cw[6144 + ch]); wq[j][gq][2] = sg(cw[2 * 6144 + ch]); wq[j][gq][3] = sg(cb[ch]); }
        }
    }
    auto ld3 = [&](int j, int grp, int jj, int c, int t, float (&z)[3]) __attribute__((always_inline)) { const int ch = grp * 2048 + c + jj; const float* zr = ZT[j] + (size_t)ch * T + t; z[0] = zr[-1]; z[1] = zr[0]; z[2] = zr[1]; };
    auto ap3 = [&](int j, int grp, int jj, int c, int t, const float (&z)[3]) __attribute__((always_inline)) { const int ch = grp * 2048 + c + jj; const float zp = t > 0 ? z[0] : 0.f, zn = t < T - 1 ? z[2] : 0.f;
        if constexpr (T == 4096) { const int jq = SH ? 0 : j; return wq[jq][grp * 2 + jj][0] * zp + wq[jq][grp * 2 + jj][1] * z[1] + wq[jq][grp * 2 + jj][2] * zn + wq[jq][grp * 2 + jj][3]; }
        else return cw[ch] * zp + cw[6144 + ch] * z[1] + cw[2 * 6144 + ch] * zn + cb[ch]; };
    float gz[NI][8][2][3]; constexpr int NPRE = (T == 4096) ? NI : 1;
    float u0[NI][8], u1[NI][8]; f32x2v cv[NI][8];
    int tl = tid; asm volatile("" : "+v"(tl));
#pragma unroll
    for (int j = 0; j < NI; ++j)
#pragma unroll
        for (int i = 0; i < 8; ++i) { const int tr = tl / (N / 16), t = tl % (N / 16) + (N / 16) * i, c = 2 * (pair0[j] + tr);
            float z0[3], z1[3]; ld3(j, 2, 0, c, t, z0); ld3(j, 2, 1, c, t, z1); u0[j][i] = ap3(j, 2, 0, c, t, z0); u1[j][i] = ap3(j, 2, 1, c, t, z1); }
    f32x4v ksr[8];
    if constexpr (SH) {
#pragma unroll
        for (int r = 0; r < 8; ++r) ksr[r] = KS0[0][tl + 512 * r]; }
    fft_fwd_first<N, NI>(buf, tid, u0, u1);
    if constexpr (N == 8192) { int tf = tid; asm volatile("" : "+v"(tf)); fft_fwd_pass<N, 256, NI>(buf, tf); }
    { int tf = tid; asm volatile("" : "+v"(tf)); fft_r32_fwd<NI>(buf, tf); }
    if constexpr (SH) fft_pairmul_pre<N, NI>(buf, ksr, KS0[0], tid); else fft_pairmul<N, NI, SH>(buf, KS0, tid);
    __syncthreads();
    { int tf = tid; asm volatile("" : "+v"(tf)); fft_r32_inv<NI>(buf, tf); }
    if constexpr (N == 8192) { int tf = tid; asm volatile("" : "+v"(tf)); fft_inv_pass<N, 32, NI, false>(buf, tf); }
    tl = tid; asm volatile("" : "+v"(tl));
#pragma unroll
    for (int j = 0; j < NPRE; ++j)
#pragma unroll
        for (int i = 0; i < 8; ++i) { const int tr = tl / (N / 16), t = tl % (N / 16) + (N / 16) * i, c = 2 * (pair0[j] + tr); ld3(j, 0, 0, c, t, gz[j][i][0]); ld3(j, 0, 1, c, t, gz[j][i][1]); }
    fft_inv_last<N, NI>(buf, tid, cv);
#pragma unroll
    for (int j = NPRE; j < NI; ++j)
#pragma unroll
        for (int i = 0; i < 8; ++i) { const int tr = tl / (N / 16), t = tl % (N / 16) + (N / 16) * i, c = 2 * (pair0[j] + tr); ld3(j, 0, 0, c, t, gz[j][i][0]); ld3(j, 0, 1, c, t, gz[j][i][1]); }
#pragma unroll
    for (int j = 0; j < NI; ++j)
#pragma unroll
        for (int i = 0; i < 8; ++i) { const int tr = tl / (N / 16), t = tl % (N / 16) + (N / 16) * i, c = 2 * (pair0[j] + tr);
            u0[j][i] = ap3(j, 0, 0, c, t, gz[j][i][0]) * cv[j][i].x; u1[j][i] = ap3(j, 0, 1, c, t, gz[j][i][1]) * cv[j][i].y; }
    if constexpr (SH) {
#pragma unroll
        for (int r = 0; r < 8; ++r) ksr[r] = KS1[0][tl + 512 * r]; }
    fft_fwd_first<N, NI>(buf, tid, u0, u1);
    if constexpr (N == 8192) { int tf = tid; asm volatile("" : "+v"(tf)); fft_fwd_pass<N, 256, NI>(buf, tf); }
    { int tf = tid; asm volatile("" : "+v"(tf)); fft_r32_fwd<NI>(buf, tf); }
    if constexpr (SH) fft_pairmul_pre<N, NI>(buf, ksr, KS1[0], tid); else fft_pairmul<N, NI, SH>(buf, KS1, tid);
    __syncthreads();
    { int tf = tid; asm volatile("" : "+v"(tf)); fft_r32_inv<NI>(buf, tf); }
    if constexpr (N == 8192) { int tf = tid; asm volatile("" : "+v"(tf)); fft_inv_pass<N, 32, NI, false>(buf, tf); }
    tl = tid; asm volatile("" : "+v"(tl));
#pragma unroll
    for (int j = 0; j < NPRE; ++j)
#pragma unroll
        for (int i = 0; i < 8; ++i) { const int tr = tl / (N / 16), t = tl % (N / 16) + (N / 16) * i, c = 2 * (pair0[j] + tr); ld3(j, 1, 0, c, t, gz[j][i][0]); ld3(j, 1, 1, c, t, gz[j][i][1]); }
    fft_inv_last<N, NI>(buf, tid, cv);
#pragma unroll
    for (int j = NPRE; j < NI; ++j)
#pragma unroll
        for (int i = 0; i < 8; ++i) { const int tr = tl / (N / 16), t = tl % (N / 16) + (N / 16) * i, c = 2 * (pair0[j] + tr); ld3(j, 1, 0, c, t, gz[j][i][0]); ld3(j, 1, 1, c, t, gz[j][i][1]); }
#pragma unroll
    for (int j = 0; j < NI; ++j)
#pragma unroll
        for (int i = 0; i < 8; ++i) { const int tr = tl / (N / 16), t = tl % (N / 16) + (N / 16) * i, c = 2 * (pair0[j] + tr);
            const float y0 = ap3(j, 1, 0, c, t, gz[j][i][0]) * cv[j][i].x, y1 = ap3(j, 1, 1, c, t, gz[j][i][1]) * cv[j][i].y;
            *(unsigned*)(Y + (size_t)(rowbase[j] + t) * 2048 + c) = pk2(y0, y1); }
}
template <int PROBE = 0> DI void phase_hyena_conv(Ctx& C, int o) {
    if (C.G == 256) {
        for (int it = C.vb; it < 1024 + 512; it += C.G) {
            if (it < 1024) { const int sq[2] = {0, 1}, pr[2] = {it, it}; hyena_conv_item<4096, 2, PROBE, true>(C, o, sq, pr); }
            else { const int v = it - 1024; const int sq[2] = {2 * (v >> 6), 2 * (v >> 6) + 1}, pr[2] = {(v & 63) * 16, (v & 63) * 16}; hyena_conv_item<256, 2, PROBE, true>(C, o, sq, pr); }
        }
    } else {
        for (int it = C.vb; it < 2048 + 1024; it += C.G) {
            if (it < 2048) { const int sq[1] = {it >> 10}, pr[1] = {it & 1023}; hyena_conv_item<4096, 1, PROBE>(C, o, sq, pr); }
            else { const int v = it - 2048; const int sq[1] = {v >> 6}, pr[1] = {(v & 63) * 16}; hyena_conv_item<256, 1, PROBE>(C, o, sq, pr); }
        }
    }
    __syncthreads();
}

#ifndef ONE_LAUNCH
#define ONE_LAUNCH 1
#endif
#ifndef SKIP_FFN
#define SKIP_FFN 0
#endif
#ifndef SKIP_EVEN
#define SKIP_EVEN 0
#endif
#ifndef SKIP_ODD
#define SKIP_ODD 0
#endif
#ifndef DUP_FFN
#define DUP_FFN 0
#endif
#ifndef DUP_EVEN
#define DUP_EVEN 0
#endif
#ifndef DUP_ODD
#define DUP_ODD 0
#endif
#ifndef DUP_PRO
#define DUP_PRO 0
#endif
#ifndef DUP_E
#define DUP_E 0
#endif
#ifndef DUP_O
#define DUP_O 0
#endif
constexpr int NPH_MAX = 96;
template <int V> struct IntC { static constexpr int value = V; };
DI void launder(Ctx& C, const KArgs& a) { const int t = lane_id_v(); C.lane = t; C.tid = C.wave * 64 + t;
    int z = 0; asm volatile("" : "+v"(z)); const int zs = __builtin_amdgcn_readfirstlane(z);
    C.ws = a.ws + zs; C.in = a.in + zs; C.out = a.out + zs;
    C.zs = zs; C.G = (int)gridDim.x + zs; C.bx = (int)blockIdx.x + zs; C.gw = C.bx * 8 + C.wave; C.NGW = C.G * 8; C.vb = (C.G % 8 == 0) ? (C.bx % 8) * (C.G / 8) + C.bx / 8 : C.bx; }
__global__ void __launch_bounds__(512, 2) mega_fwd(KArgs args) {
    extern __shared__ __attribute__((aligned(16))) unsigned char lds_raw[];
    Ctx C;
    C.lds = (LAS unsigned char*)lds_raw; C.ws = args.ws; C.in = args.in; C.out = args.out;
    C.wave = __builtin_amdgcn_readfirstlane((int)threadIdx.x >> 6); C.lane = lane_id_v(); C.tid = C.wave * 64 + C.lane;
    C.zs = 0; C.G = 0; C.bx = 0; C.gw = 0; C.NGW = 0; C.vb = 0;
    for (int u = C.tid; u < (LDS_BYTES - LDS_CTL) / 4; u += 512) ((LAS unsigned*)(C.lds + LDS_CTL))[u] = 0u;
    __syncthreads();
    (void)xcd_barrier_post((unsigned*)(args.ws + WS_CTL) + 4096, (volatile LAS unsigned*)(C.lds + LDS_CTL + 64), C.tid);
#if ONE_LAUNCH
    constexpr int lo = 0, hi = 1 << 20; int ph = 0;
#else
    const int lo = args.ph_lo, hi = args.ph_hi; int ph = 0;
#endif
#define PH_IF if (ph >= lo && ph < hi) if (launder(C, args), true)
#define PH_NEXT do { const bool both_ = (ph >= lo) && (ph + 1 < hi); ++ph; if (both_) { launder(C, args); XcdBarrier b_; b_.bar = (unsigned*)(C.ws + WS_CTL) + 4096; b_.x = xb_xcc_id() + (unsigned)C.zs; b_.st = (volatile LAS unsigned*)(C.lds + LDS_CTL + 64); xcd_barrier(b_, C.tid); } } while (0)
#define ring C.lds
#define MOD ((const float*)(C.ws + WS_MOD))
#define X ((float*)(C.ws + WS_X))

#if DUP_PRO == 1
    PH_IF { phase_prologue(C); } PH_NEXT;
#endif
    PH_IF {
#ifndef NO_PROLOGUE
 phase_prologue(C);
#endif
 } PH_NEXT;
    PH_IF { phase_mod_reduce(C);
        pg8::Gemm g{(const bf16*)(C.ws + WS_W3T), (const bf16*)(C.ws + WS_H2), 16384, 4352, 256}; pg8::StaticOrder S; S.init(16384, 4352, C.G, C.bx);
        pg8::EpiF32 E{(float*)(C.ws + WS_SCAN), 4352};
        pg8::gemm_phase<pg8::EpiF32, pg8::StaticOrder, true, true>(ring, g, S, E, C.wave); } PH_NEXT;
#if DUP_PRO == 2
    PH_IF { phase_hyena_filters(C); } PH_NEXT;
#endif
    PH_IF {
#ifndef NO_HYENA
 phase_hyena_filters(C);
#endif
 } PH_NEXT;

#define FFN_BLOCK(l, fi, s, cf) do { \
    if (!SKIP_FFN) { \
    PH_IF { phase_norm_mod(C, C.in[I_NG] + ((l) * 3 + (s)) * 2048, MOD + (size_t)(l) * MODL, (s)); } PH_NEXT; \
    PH_IF { pg8::Gemm g{(const bf16*)(C.ws + WS_H), (const bf16*)(C.ws + WS_W1T) + (size_t)((l) * 2 + (fi)) * NFF1 * 2048, MT, NFF1, 2048}; pg8::StaticOrder S; S.init(MT, NFF1, C.G, C.bx); \
        pg8::EpiSwiGLU E{(bf16*)(C.ws + WS_ACT), DFF}; pg8::gemm_phase<pg8::EpiSwiGLU, pg8::StaticOrder, false, true>(ring, g, S, E, C.wave); \
        { const int nf_ = (l) * 2 + (fi) + 1, idle0_ = (MT / 256) * (NFF1 / 256) % C.G; if ((cf) != 0.0f && nf_ < 8 && C.bx >= idle0_) { launder(C, args); \
            tr_matrix<0>(C, C.in[I_WFO] + (size_t)nf_ * DFF * 2048, 2048, DFF, (bf16*)(C.ws + WS_W2T) + (size_t)nf_ * 2048 * DFF, 2048, 2048, (C.bx - idle0_) * 8 + C.wave, (C.G - idle0_) * 8); } } } PH_NEXT; \
    PH_IF { pg8::Gemm g{(const bf16*)(C.ws + WS_ACT), (const bf16*)(C.ws + WS_W2T) + (size_t)((l) * 2 + (fi)) * 2048 * DFF, MT, 2048, DFF}; \
        pg8::EpiRes E{X, MOD + (size_t)(l) * MODL + (3 * (s) + 2) * 2048, (cf)}; \
        { pg8::PairOrder<1> S; S.init(MT, 2048, DFF, C.G, C.bx, (float*)(C.ws + WS_Z), (unsigned*)(C.ws + WS_CTL) + 16384, (DUP_FFN ? 8u * (unsigned)(2 * ((l) * 2 + (fi)) + ((cf) != 0.0f ? 2 : 1)) : 8u * (unsigned)((l) * 2 + (fi) + 1))); \
          pg8::gemm_phase<pg8::EpiRes, pg8::PairOrder<1>, false, true>(ring, g, S, E, C.wave); } \
        { launder(C, args); pg8::PairOrder<2> S; S.init(MT, 2048, DFF, C.G, C.bx, (float*)(C.ws + WS_Z), (unsigned*)(C.ws + WS_CTL) + 16384, (DUP_FFN ? 8u * (unsigned)(2 * ((l) * 2 + (fi)) + ((cf) != 0.0f ? 2 : 1)) : 8u * (unsigned)((l) * 2 + (fi) + 1))); \
          pg8::Gemm g2{(const bf16*)(C.ws + WS_ACT), (const bf16*)(C.ws + WS_W2T) + (size_t)((l) * 2 + (fi)) * 2048 * DFF, MT, 2048, DFF}; pg8::EpiRes E2{X, MOD + (size_t)(l) * MODL + (3 * (s) + 2) * 2048, (cf)}; \
          pg8::gemm_phase<pg8::EpiRes, pg8::PairOrder<2>, true, true>(ring, g2, S, E2, C.wave); } \
        { const int nf_ = (l) * 2 + (fi) + 1; if ((cf) != 0.0f && nf_ < 8 && !(C.G >= 235 && !SKIP_EVEN && ((l) & 1) == 0 && (fi) == 0) && !(C.G == 256 && !SKIP_EVEN && ((l) & 1) == 0 && (fi) == 1)) { launder(C, args); \
            tr_matrix<1>(C, C.in[I_WFI] + (size_t)nf_ * 2048 * NFF1, NFF1, 2048, (bf16*)(C.ws + WS_W1T) + (size_t)nf_ * NFF1 * 2048, NFF1, NFF1, C.gw, C.NGW); } } } PH_NEXT; \
    } } while (0)

    auto layer_pair = [&](auto PC) __attribute__((always_inline)) {
        constexpr int p = decltype(PC)::value; constexpr int le = 2 * p, lod = 2 * p + 1;
#if DUP_FFN
        FFN_BLOCK(le, 0, 0, 0.0f);
#endif
        FFN_BLOCK(le, 0, 0, 0.5f);
        auto even_mix = [&](float cf, int qslot) __attribute__((always_inline)) {
            const int e = p;
            PH_IF { phase_norm_mod(C, C.in[I_NG] + (le * 3 + 1) * 2048, MOD + (size_t)le * MODL, 1); } PH_NEXT;
            PH_IF { pg8::Gemm g{(const bf16*)(C.ws + WS_H), (const bf16*)(C.ws + WS_WINE) + (size_t)e * ZE_P * 2048, MT, ZE_P, 2048}; pg8::StaticOrder S; S.init(MT, ZE_P, C.G, C.bx);
                pg8::EpiF32 E{(float*)(C.ws + WS_Z), ZE_P}; pg8::gemm_phase<pg8::EpiF32, pg8::StaticOrder, true, true>(ring, g, S, E, C.wave);
                { const int nf_ = le * 2 + 2, idle0_ = (MT / 256) * (ZE_P / 256) % C.G;
                  if (cf != 0.0f && C.G == 256 && C.bx >= idle0_) { launder(C, args);
                    tr_matrix<1>(C, C.in[I_WFI] + (size_t)nf_ * 2048 * NFF1, NFF1, 2048, (bf16*)(C.ws + WS_W1T) + (size_t)nf_ * NFF1 * 2048, NFF1, NFF1, (C.bx - idle0_) * 8 + C.wave, (C.G - idle0_) * 8); } } } PH_NEXT;
#if DUP_E == 5
            PH_IF { phase_even_prep(C, e); } PH_NEXT;
#endif
            PH_IF { phase_even_prep(C, e); } PH_NEXT;
#if DUP_E == 7
            PH_IF {
                { pg8::Gemm g{(const bf16*)(C.ws + WS_LA), (const bf16*)(C.ws + WS_WLORA) + (size_t)e * 5120 * 384, MT, 5120, 384}; pg8::StaticOrder S; S.init(MT, 5120, C.G, C.bx);
                  pg8::EpiLora E{C.ws, C.in[I_W0] + e * 2048, C.in[I_A0] + e * 2048, C.in[I_KA] + e * 1024, WS_SCAN + (size_t)e * SCAN_BYTES, WS_KBUF, WS_GB};
                  pg8::gemm_phase<pg8::EpiLora, pg8::StaticOrder, true, true>(ring, g, S, E, C.wave); }
                launder(C, args);
                { pg8::Gemm g{(const bf16*)(C.ws + WS_CQ), (const bf16*)(C.ws + WS_WQ) + (size_t)e * 1536 * 512, MT, 1536, 512}; pg8::StaticOrder S; S.init(MT, 1536, C.G, C.bx);
                  pg8::EpiQ E{(bf16*)(C.ws + WS_Q), (const float*)(C.ws + WS_ROPE), 0.07216878364870322f * 1.4426950408889634f};
                  pg8::gemm_phase<pg8::EpiQ, pg8::StaticOrder, true, true>(ring, g, S, E, C.wave); }
                launder(C, args);
                { pg8::Gemm g{(const bf16*)(C.ws + WS_CKV), (const bf16*)(C.ws + WS_WKN) + (size_t)e * 1024 * 256, MKV, 1024, 256}; pg8::StaticOrder S; S.init(MKV, 1024, C.G, C.bx);
                  pg8::EpiBf16Plain E{(bf16*)(C.ws + WS_KN), 1024};
                  pg8::gemm_phase<pg8::EpiBf16Plain, pg8::StaticOrder, false, false>(ring, g, S, E, C.wave); }
                launder(C, args);
                { pg8::Gemm g{(const bf16*)(C.ws + WS_WV) + (size_t)e * 1024 * 256, (const bf16*)(C.ws + WS_CKV), 1024, MKV, 256}; pg8::StaticOrder S; S.init(1024, MKV, C.G, C.bx);
                  pg8::EpiVT E{(bf16*)(C.ws + WS_VT), VT_S_OFF / 2};
                  pg8::gemm_phase<pg8::EpiVT, pg8::StaticOrder, false, false>(ring, g, S, E, C.wave); }
            } PH_NEXT;
#endif
            PH_IF {
                { pg8::Gemm g{(const bf16*)(C.ws + WS_LA), (const bf16*)(C.ws + WS_WLORA) + (size_t)e * 5120 * 384, MT, 5120, 384}; pg8::StaticOrder S; S.init(MT, 5120, C.G, C.bx);
                  pg8::EpiLora E{C.ws, C.in[I_W0] + e * 2048, C.in[I_A0] + e * 2048, C.in[I_KA] + e * 1024, WS_SCAN + (size_t)e * SCAN_BYTES, WS_KBUF, WS_GB};
                  pg8::gemm_phase<pg8::EpiLora, pg8::StaticOrder, true, true>(ring, g, S, E, C.wave); }
                launder(C, args);
                { pg8::Gemm g{(const bf16*)(C.ws + WS_CQ), (const bf16*)(C.ws + WS_WQ) + (size_t)e * 1536 * 512, MT, 1536, 512}; pg8::StaticOrder S; S.init(MT, 1536, C.G, (C.bx + 64) % C.G);
                  pg8::EpiQ E{(bf16*)(C.ws + WS_Q), (const float*)(C.ws + WS_ROPE), 0.07216878364870322f * 1.4426950408889634f};
                  pg8::gemm_phase<pg8::EpiQ, pg8::StaticOrder, true, true>(ring, g, S, E, C.wave); }
                launder(C, args);
                { pg8::Gemm g{(const bf16*)(C.ws + WS_CKV), (const bf16*)(C.ws + WS_WKN) + (size_t)e * 1024 * 256, MKV, 1024, 256}; pg8::StaticOrder S; S.init(MKV, 1024, C.G, (C.bx + 32) % C.G);
                  pg8::EpiBf16Plain E{(bf16*)(C.ws + WS_KN), 1024};
                  pg8::gemm_phase<pg8::EpiBf16Plain, pg8::StaticOrder, false, false>(ring, g, S, E, C.wave); }
                launder(C, args);
                { pg8::Gemm g{(const bf16*)(C.ws + WS_WV) + (size_t)e * 1024 * 256, (const bf16*)(C.ws + WS_CKV), 1024, MKV, 256}; pg8::StaticOrder S; S.init(1024, MKV, C.G, (C.bx + 88) % C.G);
                  pg8::EpiVT E{(bf16*)(C.ws + WS_VT), VT_S_OFF / 2};
                  pg8::gemm_phase<pg8::EpiVT, pg8::StaticOrder, false, false>(ring, g, S, E, C.wave); }
            } PH_NEXT;
#if DUP_E == 1
            PH_IF { phase_scan1(C, e, 2); } PH_NEXT;
#endif
            PH_IF {
#ifndef NO_SCAN
 phase_scan1(C, e, qslot);
#endif
 } PH_NEXT;
#if DUP_E == 2
            PH_IF { phase_scan_carry(C, e, 8); __syncthreads(); } PH_NEXT;
#endif
            PH_IF { const bool host_ = cf != 0.0f && C.G >= 235; phase_scan_carry(C, e, host_ ? 3 : 8);
                if (host_ && C.bx >= 64 && C.wave >= 3) { launder(C, args); const int nf_ = le * 2 + 1;
                    tr_matrix<1>(C, C.in[I_WFI] + (size_t)nf_ * 2048 * NFF1, NFF1, 2048, (bf16*)(C.ws + WS_W1T) + (size_t)nf_ * NFF1 * 2048, NFF1, NFF1, (C.bx - 64) * 5 + C.wave - 3, (C.G - 64) * 5); }
                __syncthreads(); } PH_NEXT;
#if DUP_E == 3
            PH_IF { phase_scan3(C, e); } PH_NEXT;
#endif
#if DUP_E == 4
            PH_IF { phase_attention(C); } PH_NEXT;
#endif
            PH_IF {
#ifndef NO_SCAN
 phase_scan3(C, e);
#endif
#ifndef NO_ATTN
 phase_attention(C);
#endif
 } PH_NEXT;
#if DUP_E == 6
            PH_IF { phase_rwkv_post(C, e); } PH_NEXT;
#endif
            PH_IF { phase_rwkv_post(C, e); } PH_NEXT;
            PH_IF { pg8::Gemm g{(const bf16*)(C.ws + WS_MIX), (const bf16*)(C.ws + WS_WOUTE) + (size_t)e * 2048 * 2048, MT, 2048, 2048}; pg8::StaticOrder S; S.init(MT, 2048, C.G, C.bx);
                pg8::EpiRes E{X, MOD + (size_t)le * MODL + (3 * 1 + 2) * 2048, cf}; pg8::gemm_phase<pg8::EpiRes, pg8::StaticOrder, false, true>(ring, g, S, E, C.wave); } PH_NEXT;
        };
#if DUP_EVEN
        even_mix(0.0f, 1);
#endif
        if (!SKIP_EVEN) even_mix(1.0f, 0);
#if DUP_FFN
        FFN_BLOCK(le, 1, 2, 0.0f);
#endif
        FFN_BLOCK(le, 1, 2, 0.5f);
#if DUP_FFN
        FFN_BLOCK(lod, 0, 0, 0.0f);
#endif
        FFN_BLOCK(lod, 0, 0, 0.5f);
        auto odd_mix = [&](float cf) __attribute__((always_inline)) {
            const int o = p;
            PH_IF { phase_norm_mod(C, C.in[I_NG] + (lod * 3 + 1) * 2048, MOD + (size_t)lod * MODL, 1); } PH_NEXT;
            PH_IF { pg8::Gemm g{(const bf16*)(C.ws + WS_WINO) + (size_t)o * 6144 * 2048, (const bf16*)(C.ws + WS_H), 6144, MT, 2048}; pg8::StaticOrder S; S.init(6144, MT, C.G, C.bx);
                pg8::EpiZT E{(float*)(C.ws + WS_Z), (float*)(C.ws + WS_Z + ZT_S_OFF)}; pg8::gemm_phase<pg8::EpiZT, pg8::StaticOrder, false, true>(ring, g, S, E, C.wave); } PH_NEXT;
#if DUP_O == 1
            PH_IF { phase_hyena_conv(C, o); } PH_NEXT;
#endif
#if DUP_O == 2
            PH_IF { phase_hyena_conv<1>(C, o); } PH_NEXT;
#endif
            PH_IF {
#ifndef NO_HYENA
 phase_hyena_conv(C, o);
#endif
 } PH_NEXT;
            PH_IF { pg8::Gemm g{(const bf16*)(C.ws + WS_MIX), (const bf16*)(C.ws + WS_WOUTO) + (size_t)o * 2048 * 2048, MT, 2048, 2048}; pg8::StaticOrder S; S.init(MT, 2048, C.G, C.bx);
                pg8::EpiRes E{X, MOD + (size_t)lod * MODL + (3 * 1 + 2) * 2048, cf}; pg8::gemm_phase<pg8::EpiRes, pg8::StaticOrder, false, true>(ring, g, S, E, C.wave); } PH_NEXT;
        };
#if DUP_ODD
        odd_mix(0.0f);
#endif
        if (!SKIP_ODD) odd_mix(1.0f);
#if DUP_FFN
        FFN_BLOCK(lod, 1, 2, 0.0f);
#endif
        FFN_BLOCK(lod, 1, 2, 0.5f);
    };
    layer_pair(IntC<0>{}); layer_pair(IntC<1>{});
    PH_IF { phase_final_norm(C); } PH_NEXT;
#undef MOD
#undef X
#undef ring
}

extern "C" void kernel_launch(void* const* d_in, const int* in_sizes, int n_in, void* d_out, int out_size, void* d_ws, size_t ws_size, hipStream_t stream) {
    static int grid = 0;
    if (grid == 0) {
        if (n_in != 42 || (size_t)out_size != OUT_END || ws_size < WS_END) { fprintf(stderr, "kernel_launch: unexpected sizes n_in %d out %d ws %zu (need %zu)\n", n_in, out_size, ws_size, (size_t)WS_END); grid = -1; return; }
        int dev = 0, cus = 0, per_cu = 0;
        if (hipGetDevice(&dev) != hipSuccess || hipDeviceGetAttribute(&cus, hipDeviceAttributeMultiprocessorCount, dev) != hipSuccess) { grid = -1; return; }
        if (hipFuncSetAttribute((const void*)mega_fwd, hipFuncAttributeMaxDynamicSharedMemorySize, LDS_BYTES) != hipSuccess) { fprintf(stderr, "kernel_launch: hipFuncSetAttribute failed\n"); grid = -1; return; }
        if (hipOccupancyMaxActiveBlocksPerMultiprocessor(&per_cu, (const void*)mega_fwd, 512, LDS_BYTES) != hipSuccess || per_cu < 1) fprintf(stderr, "kernel_launch: occupancy query says %d\n", per_cu);
        (void)hipGetLastError();
        grid = cus;
    }
    if (grid < 0) return;
    (void)hipMemsetAsync((char*)d_ws + WS_CTL, 0, CTL_ZERO_BYTES, stream);
    KArgs a{};
    for (int i = 0; i < 42; ++i) a.in[i] = (const float*)d_in[i];
    a.out = (float*)d_out; a.ws = (unsigned char*)d_ws;
#if ONE_LAUNCH
    a.ph_lo = 0; a.ph_hi = 1 << 20;
    hipLaunchKernelGGL(mega_fwd, dim3(grid), dim3(512), LDS_BYTES, stream, a);
#else
    for (int i = 0; i < NPH_MAX; ++i) { a.ph_lo = i; a.ph_hi = i + 1; hipLaunchKernelGGL(mega_fwd, dim3(grid), dim3(512), LDS_BYTES, stream, a); }
#endif
}
```

```cpp
#include <hip/hip_runtime.h>
#include <cstdio>
#include <cstdint>
#include <utility>
#define DI __device__ __forceinline__
#define GAS __attribute__((address_space(1)))
#define LAS __attribute__((address_space(3)))
#define CAS __attribute__((address_space(4)))
typedef unsigned short bf16;
typedef unsigned v4u __attribute__((ext_vector_type(4)));
typedef unsigned v2u __attribute__((ext_vector_type(2)));
typedef float f32x4v __attribute__((ext_vector_type(4)));
typedef float f32x2v __attribute__((ext_vector_type(2)));
typedef float f32x16v __attribute__((ext_vector_type(16)));
typedef short s16x8v __attribute__((ext_vector_type(8)));
typedef short s16x4v __attribute__((ext_vector_type(4)));

constexpr int D = 2048, MP = 4096, MS = 8192, MT = 12288, MKV = 12800;
constexpr int DFF = 5632, NFF1 = 11264;
constexpr int ZE_N = 4192, ZE_P = 4352;
constexpr int SCAN_P = 9 * 1024;
constexpr int NCH = 32, CHL = 4096 / NCH;
constexpr int MODL = 3 * 18432;

DI int lane_id_v() { int l; asm volatile("v_mbcnt_lo_u32_b32 %0, -1, 0\n\tv_mbcnt_hi_u32_b32 %0, -1, %0" : "=v"(l)); return l; }
DI unsigned f2bf(float f) { unsigned u = __builtin_bit_cast(unsigned, f); return (u + 0x7fffu + ((u >> 16) & 1u)) >> 16; }
DI unsigned pk2(float lo, float hi) { unsigned r; asm("v_cvt_pk_bf16_f32 %0, %1, %2" : "=v"(r) : "v"(lo), "v"(hi)); return r; }
DI float bf2f(unsigned short b) { return __builtin_bit_cast(float, ((unsigned)b) << 16); }
template <int CTRL> DI float dpp_f(float v) { return __builtin_bit_cast(float, __builtin_amdgcn_update_dpp(0, __builtin_bit_cast(int, v), CTRL, 0xf, 0xf, true)); }
DI float shfl_idx(float v, int src) { return __builtin_bit_cast(float, __builtin_amdgcn_ds_bpermute(src << 2, __builtin_bit_cast(int, v))); }
DI float wave_sum(float v) {
    v += dpp_f<0xB1>(v); v += dpp_f<0x4E>(v); v += dpp_f<0x141>(v); v += dpp_f<0x140>(v);
    v += __builtin_bit_cast(float, __builtin_amdgcn_ds_swizzle(__builtin_bit_cast(int, v), 0x401F));
    return __builtin_bit_cast(float, __builtin_amdgcn_readlane(__builtin_bit_cast(int, v), 0)) + __builtin_bit_cast(float, __builtin_amdgcn_readlane(__builtin_bit_cast(int, v), 32));
}
DI float sigmoid_f(float x) { return __builtin_amdgcn_rcpf(1.f + __expf(-x)); }
DI float silu_f(float x) { return x * sigmoid_f(x); }
DI int scan_perm(int j) { return 4 * (j & 15) + (j >> 4); }
DI int row_mod_j(int row) { return row < MP ? 0 : 1 + ((row - MP) >> 12); }
namespace pg8 {
#define PG8_LAS __attribute__((address_space(3)))
typedef unsigned short bf16_t;
typedef short bf16x8 __attribute__((ext_vector_type(8)));
typedef float f32x4 __attribute__((ext_vector_type(4)));
typedef unsigned u32x4 __attribute__((ext_vector_type(4)));
constexpr int BM = 256, BK = 64, HALF = 128, HTB = HALF * BK * 2  , STAGE_BYTES = 8 * HTB, NXCD = 8, WGM = 8;

__host__ __device__ __forceinline__ int lds_byte(int r, int c) { const int st = (r >> 4) * 2 + (c >> 5), rr = r & 15, cc = c & 31, ob = rr * 64 + cc * 2; return st * 1024 + (ob ^ (((ob >> 9) & 1) << 5)); }
__host__ __device__ __forceinline__ void stage_rc(int b, int& R, int& C) { const int st = b / 1024, sb = b % 1024, swz = sb ^ (((sb >> 9) & 1) << 5); R = (st >> 1) * 16 + swz / 64; C = (st & 1) * 32 + (swz % 64) / 2; }
__host__ __device__ __forceinline__ int perm32(int rho) { const int n = rho >> 4, i = rho & 15; return 8 * (i >> 2) + 4 * n + (i & 3); }

struct Unit { int pm, pn; int kt0, nkt, mode, slot; };
struct Gemm { const bf16_t* A; const bf16_t* Bt; int M, N, K; };
struct StaticOrder {
    static constexpr int SPLITK = 0;
    int nM, nN, nwg, G, c;
    __host__ __device__ __forceinline__ void init(int M, int N, int G_, int c_) { nM = M / BM; nN = N / BM; nwg = nM * nN; G = G_; c = c_; }
    __host__ __device__ __forceinline__ bool next(int i, Unit& u) const {
        const long L = (long)i * G + c; if (L >= nwg) return false;
        int wgid = (int)L; { const int q = nwg / NXCD, r = nwg % NXCD, xcd = wgid % NXCD, off = wgid / NXCD; wgid = (xcd < r ? xcd * (q + 1) : r * (q + 1) + (xcd - r) * q) + off; }
        const int nig = WGM * nN, gid = wgid / nig, fm = gid * WGM, gsz = (nM - fm) < WGM ? (nM - fm) : WGM;
        u.pm = fm + ((wgid % nig) % gsz); u.pn = (wgid % nig) / gsz; u.kt0 = 0; u.nkt = 0; u.mode = 0; u.slot = 0; return true;
    }
    __device__ __forceinline__ void a_ready(const Unit&) const {}
    __device__ __forceinline__ void done(const Unit&) const {}
    __device__ __forceinline__ void publish(const f32x4 (&)[2][2][4][2], const Unit&, int, int) const {}
    __device__ __forceinline__ void consume(f32x4 (&)[2][2][4][2], const Unit&, int, int) const {}
};

template <int PART> struct PairOrder {
    static constexpr int SPLITK = PART;
    StaticOrder so; int R, rem, nt; bool paired;
    float* scratch; unsigned* flags; unsigned target;
    __device__ __forceinline__ void init(int M, int N, int K, int G_, int c_, float* scr, unsigned* fl, unsigned tgt) { so.init(M, N, G_, 0); so.c = 0; so.G = 1; R = so.nwg / G_; rem = so.nwg % G_; nt = K / BK;
        paired = (2 * rem == G_) && ((nt / 2) % 2 == 0); c = c_; G = G_; scratch = scr; flags = fl; target = tgt; }
    int c, G;
    __device__ __forceinline__ bool tile(int t, Unit& u) const { return so.next(t, u); }
    __device__ __forceinline__ bool next(int i, Unit& u) const {
        int t = -1, kt0 = 0, nk = nt, mode = 0, slot = 0;
        if (!paired) { if (PART == 1) { const long L = (long)i * G + c; if (L < so.nwg) t = (int)L; } }
        else if (PART == 1) {
            if (c < rem) { if (i == 0) { t = R * G + c; nk = nt / 2; mode = 1; slot = c; } else if (i <= R) t = (i - 1) * G + c; }
            else if (i < R) t = i * G + c;
        }
        else if (c >= rem && i == 0) { t = R * G + (c - rem); kt0 = nt / 2; nk = nt - nt / 2; mode = 2; slot = c - rem; }
        if (t < 0) return false;
        tile(t, u); u.kt0 = kt0; u.nkt = nk; u.mode = mode; u.slot = slot; return true;
    }
    __device__ __forceinline__ void a_ready(const Unit&) const {}
    __device__ __forceinline__ void done(const Unit&) const {}
    __device__ __forceinline__ void publish(const f32x4 (&acc)[2][2][4][2], const Unit& u, int wid, int lane) const {
        const __amdgpu_buffer_rsrc_t rs = __builtin_amdgcn_make_buffer_rsrc((void*)scratch, 0, 0x7fffffff, 0x00020000);
        const int so_ = __builtin_amdgcn_readfirstlane(u.slot * 262144 + wid * 32768), vo = lane * 16;
#pragma unroll
        for (int ai = 0; ai < 2; ++ai)
#pragma unroll
            for (int bj = 0; bj < 2; ++bj)
#pragma unroll
                for (int m = 0; m < 4; ++m)
#pragma unroll
                    for (int n = 0; n < 2; ++n) { const int r = ((ai * 2 + bj) * 4 + m) * 2 + n;
                        __builtin_amdgcn_raw_buffer_store_b128(__builtin_bit_cast(u32x4, acc[ai][bj][m][n]), rs, vo, so_ + r * 1024, 16); }
        asm volatile("s_waitcnt vmcnt(0)" ::: "memory");
        if (lane == 0) __hip_atomic_fetch_add(flags + 64 * u.slot, 1u, __ATOMIC_RELAXED, __HIP_MEMORY_SCOPE_AGENT);
    }
    __device__ __forceinline__ void consume(f32x4 (&acc)[2][2][4][2], const Unit& u, int wid, int lane) const {
        unsigned spins = 0;
        while ((unsigned)__builtin_amdgcn_readfirstlane((int)__hip_atomic_load(flags + 64 * u.slot, __ATOMIC_RELAXED, __HIP_MEMORY_SCOPE_AGENT)) < target) { __builtin_amdgcn_s_sleep(2); if (++spins > (1u << 22)) break; }
        __builtin_amdgcn_fence(__ATOMIC_ACQUIRE, "agent");
        asm volatile("s_waitcnt vmcnt(0)" ::: "memory");
        const __amdgpu_buffer_rsrc_t rs = __builtin_amdgcn_make_buffer_rsrc((void*)scratch, 0, 0x7fffffff, 0x00020000);
        const int so_ = __builtin_amdgcn_readfirstlane(u.slot * 262144 + wid * 32768), vo = lane * 16;
#pragma unroll
        for (int ai = 0; ai < 2; ++ai)
#pragma unroll
            for (int bj = 0; bj < 2; ++bj)
#pragma unroll
                for (int mh = 0; mh < 2; ++mh) {
                    f32x4 t[4];
#pragma unroll
                    for (int q = 0; q < 4; ++q) { const int m = mh * 2 + (q >> 1), n = q & 1; const int r = ((ai * 2 + bj) * 4 + m) * 2 + n; t[q] = __builtin_bit_cast(f32x4, __builtin_amdgcn_raw_buffer_load_b128(rs, vo, so_ + r * 1024, 16)); }
#pragma unroll
                    for (int q = 0; q < 4; ++q) { const int m = mh * 2 + (q >> 1), n = q & 1; acc[ai][bj][m][n] += t[q]; }
                    asm volatile("" ::: "memory");
                }
    }
};
__device__ __forceinline__ unsigned cvt_pk_bf16(float lo, float hi) { unsigned r; asm volatile("v_cvt_pk_bf16_f32 %0, %1, %2" : "=v"(r) : "v"(lo), "v"(hi)); return r; }
typedef float f32x2 __attribute__((ext_vector_type(2)));
#define EPI_LOOP_AIM _Pragma("unroll") for (int ai = 0; ai < 2; ++ai) _Pragma("unroll") for (int m = 0; m < 4; ++m)
#define EPI_LOOP_BJN _Pragma("unroll") for (int bj = 0; bj < 2; ++bj) _Pragma("unroll") for (int n = 0; n < 2; ++n)
struct EpiF32 {
    static constexpr bool PERM = false, AFTER_DRAIN = false;
    float* C; int ldc;
    __device__ __forceinline__ void operator()(const f32x4 (&acc)[2][2][4][2], const Unit& u, int wr, int wc, int fr, int fq) const {
        const int row0 = u.pm * BM + wr * 64 + fr, col0 = u.pn * BM + wc * 32 + 4 * fq;
        EPI_LOOP_AIM { float* rowp = C + (size_t)(row0 + ai * HALF + m * 16) * ldc + col0;
            EPI_LOOP_BJN *(f32x4*)(rowp + bj * HALF + n * 16) = acc[ai][bj][m][n]; }
    }
};
struct EpiBf16Plain {
    static constexpr bool PERM = true, AFTER_DRAIN = false;
    bf16_t* O; int ldc;
    __device__ __forceinline__ void operator()(const f32x4 (&acc)[2][2][4][2], const Unit& u, int wr, int wc, int fr, int fq) const {
        const int row0 = u.pm * BM + wr * 64 + fr, col0 = u.pn * BM + wc * 32 + 8 * fq;
        EPI_LOOP_AIM { bf16_t* rowp = O + (size_t)(row0 + ai * HALF + m * 16) * ldc + col0;
#pragma unroll
            for (int bj = 0; bj < 2; ++bj) { const f32x4 v0 = acc[ai][bj][m][0], v1 = acc[ai][bj][m][1];
                u32x4 w; w.x = cvt_pk_bf16(v0[0], v0[1]); w.y = cvt_pk_bf16(v0[2], v0[3]); w.z = cvt_pk_bf16(v1[0], v1[1]); w.w = cvt_pk_bf16(v1[2], v1[3]);
                *(u32x4*)(rowp + bj * HALF) = w; } }
    }
};
struct EpiSwiGLU {
    static constexpr bool PERM = true, AFTER_DRAIN = false;
    bf16_t* O; int ldc;
    __device__ __forceinline__ void operator()(const f32x4 (&acc)[2][2][4][2], const Unit& u, int wr, int wc, int fr, int fq) const {
        const int row0 = u.pm * BM + wr * 64 + fr, col0 = u.pn * HALF + wc * 32 + 8 * fq;
        EPI_LOOP_AIM { bf16_t* rowp = O + (size_t)(row0 + ai * HALF + m * 16) * ldc + col0;
            float o[8];
#pragma unroll
            for (int n = 0; n < 2; ++n)
#pragma unroll
                for (int i = 0; i < 4; ++i) { const float g = acc[ai][0][m][n][i], up = acc[ai][1][m][n][i]; o[n * 4 + i] = g * __builtin_amdgcn_rcpf(1.f + __expf(-g)) * up; }
            u32x4 w; w.x = cvt_pk_bf16(o[0], o[1]); w.y = cvt_pk_bf16(o[2], o[3]); w.z = cvt_pk_bf16(o[4], o[5]); w.w = cvt_pk_bf16(o[6], o[7]);
            *(u32x4*)rowp = w; }
    }
};
struct EpiRes {
    static constexpr bool PERM = false, AFTER_DRAIN = false;
    float* X; const float* gate; float coef;
    __device__ __forceinline__ void operator()(const f32x4 (&acc)[2][2][4][2], const Unit& u, int wr, int wc, int fr, int fq) const {
        const int row0 = u.pm * BM + wr * 64 + fr, col0 = u.pn * BM + wc * 32 + 4 * fq;
        const int rt = u.pm * BM; const int j = rt < 4096 ? 0 : 1 + ((rt - 4096) >> 12);
        const float* g = gate + j * 18432 + col0;
        f32x4 gv[2][2];
        EPI_LOOP_BJN gv[bj][n] = *(const f32x4*)(g + bj * HALF + n * 16) * coef;
        EPI_LOOP_AIM { float* rowp = X + (size_t)(row0 + ai * HALF + m * 16) * 2048 + col0;
            EPI_LOOP_BJN { f32x4 x = *(const f32x4*)(rowp + bj * HALF + n * 16); x += gv[bj][n] * acc[ai][bj][m][n]; *(f32x4*)(rowp + bj * HALF + n * 16) = x; }
            asm volatile("" ::: "memory"); }
    }
};
struct EpiZT {
    static constexpr bool PERM = false, AFTER_DRAIN = false;
    float* ZTp; float* ZTs;
    __device__ __forceinline__ void operator()(const f32x4 (&acc)[2][2][4][2], const Unit& u, int wr, int wc, int fr, int fq) const {
        const int ch0 = u.pm * BM + wr * 64 + fr, tok0 = u.pn * BM;
        float* base; int pitch, toff;
        if (tok0 < 4096) { base = ZTp + (size_t)(tok0 >> 8) * 6144 * 256; pitch = 256; toff = 0; }
        else { const int tk = tok0 - 4096; base = ZTs + (size_t)(tk >> 12) * 6144 * 4096; pitch = 4096; toff = tk & 4095; }
        const int c0 = toff + wc * 32 + 4 * fq;
        EPI_LOOP_AIM { float* rowp = base + (size_t)(ch0 + ai * HALF + m * 16) * pitch + c0;
            EPI_LOOP_BJN *(f32x4*)(rowp + bj * HALF + n * 16) = acc[ai][bj][m][n]; }
    }
};
struct EpiVT {
    static constexpr bool PERM = true, AFTER_DRAIN = false;
    bf16_t* VTp; size_t s_off;
    __device__ __forceinline__ void operator()(const f32x4 (&acc)[2][2][4][2], const Unit& u, int wr, int wc, int fr, int fq) const {
        const int ch0 = u.pm * BM + wr * 64 + fr, tok0 = u.pn * BM;
        bf16_t* base; int pitch, toff; bf16_t* VTs = VTp + s_off;
        if (tok0 < 4096) { base = VTp + (size_t)(tok0 >> 8) * 1024 * 256; pitch = 256; toff = 0; }
        else if (tok0 < 12288) { const int tk = tok0 - 4096; base = VTs + (size_t)(tk >> 12) * 1024 * 4352; pitch = 4352; toff = tk & 4095; }
        else { const int tk = tok0 - 12288; base = VTs + (size_t)(tk >> 8) * 1024 * 4352; pitch = 4352; toff = 4096; }
        const int c0 = toff + wc * 32 + 8 * fq;
        EPI_LOOP_AIM { bf16_t* rowp = base + (size_t)(ch0 + ai * HALF + m * 16) * pitch + c0;
#pragma unroll
            for (int bj = 0; bj < 2; ++bj) { const f32x4 v0 = acc[ai][bj][m][0], v1 = acc[ai][bj][m][1];
                u32x4 w; w.x = cvt_pk_bf16(v0[0], v0[1]); w.y = cvt_pk_bf16(v0[2], v0[3]); w.z = cvt_pk_bf16(v1[0], v1[1]); w.w = cvt_pk_bf16(v1[2], v1[3]);
                *(u32x4*)(rowp + bj * HALF) = w; } }
    }
};
struct EpiQ {
    static constexpr bool PERM = true, AFTER_DRAIN = false;
    bf16_t* Q; const float* rope; float qs;
    __device__ __forceinline__ void operator()(const f32x4 (&acc)[2][2][4][2], const Unit& u, int wr, int wc, int fr, int fq) const {
        const int row0 = u.pm * BM + wr * 64 + fr;
        EPI_LOOP_AIM { const int row = row0 + ai * HALF + m * 16; const bool smp = row >= 4096; const int t = (row - 4096) & 4095;
#pragma unroll
            for (int bj = 0; bj < 2; ++bj) { const int c0 = u.pn * BM + bj * HALF + wc * 32 + 8 * fq; const int within = c0 % 192;
                float o[8];
#pragma unroll
                for (int n = 0; n < 2; ++n)
#pragma unroll
                    for (int i = 0; i < 4; ++i) o[n * 4 + i] = acc[ai][bj][m][n][i];
                if (within >= 128 && smp) { const int ri = within - 128;
#pragma unroll
                    for (int q = 0; q < 4; ++q) { const int idx = ri + 2 * q, hf = idx >> 5, j = (idx & 31) >> 1; const int pos = hf ? (t & 63) : (t >> 6);
                        const float2 cs = *(const float2*)(rope + (pos * 16 + j) * 2); const float x1 = o[2 * q], x2 = o[2 * q + 1];
                        o[2 * q] = x1 * cs.x - x2 * cs.y; o[2 * q + 1] = x2 * cs.x + x1 * cs.y; } }
                u32x4 w; w.x = cvt_pk_bf16(o[0] * qs, o[1] * qs); w.y = cvt_pk_bf16(o[2] * qs, o[3] * qs); w.z = cvt_pk_bf16(o[4] * qs, o[5] * qs); w.w = cvt_pk_bf16(o[6] * qs, o[7] * qs);
                *(u32x4*)(Q + (size_t)row * 1536 + c0) = w; } }
    }
};
struct EpiLora {
    static constexpr bool PERM = false, AFTER_DRAIN = false;
    unsigned char* wsb; const float* w0; const float* a0; const float* ka; size_t off_sc, off_kb, off_gb;
    __device__ __forceinline__ void operator()(const f32x4 (&acc)[2][2][4][2], const Unit& u, int wr, int wc, int fr, int fq) const {
        const int row0 = u.pm * BM + wr * 64 + fr; const int seg = u.pn >> 2; const int cb = (u.pn & 3) * BM + wc * 32 + 4 * fq;
        float* SC = (float*)(wsb + off_sc); const float* KB = (const float*)(wsb + off_kb); float* GB = (float*)(wsb + off_gb);
        EPI_LOOP_AIM { const int row = row0 + ai * HALF + m * 16; float* sc = SC + (size_t)row * 9216;
            EPI_LOOP_BJN { const int c = cb + bj * HALF + n * 16; const f32x4 a = acc[ai][bj][m][n];
                if (seg < 2) { const f32x4 wv = *(const f32x4*)(w0 + seg * 1024 + c); f32x4 o;
#pragma unroll
                    for (int i = 0; i < 4; ++i) { const float x = wv[i] + a[i]; const float sp = __logf(1.f + __expf(-x)); o[i] = __expf(-__expf(-sp - 0.5f)); }
                    *(f32x4*)(sc + (3 + seg) * 1024 + c) = o; }
                else if (seg < 4) { const int d = seg - 2; const f32x4 av = *(const f32x4*)(a0 + d * 1024 + c), kav = *(const f32x4*)(ka + c);
                    const f32x4 kk = *(const f32x4*)(sc + 2 * 1024 + c), kr = *(const f32x4*)(KB + (size_t)row * 1024 + c); f32x4 o1, o2;
#pragma unroll
                    for (int i = 0; i < 4; ++i) { const float s = __builtin_amdgcn_rcpf(1.f + __expf(-(av[i] + a[i]))); o1[i] = kk[i] * s; o2[i] = kr[i] * (1.f + (s - 1.f) * kav[i]); }
                    *(f32x4*)(sc + (5 + d) * 1024 + c) = o1; *(f32x4*)(sc + (7 + d) * 1024 + c) = o2; }
                else *(f32x4*)(GB + (size_t)row * 1024 + c) = a; }
            asm volatile("" ::: "memory"); }
    }
};
template <class Epi, class Sched, bool ALIGN_EPI = false, bool SP2 = false>
__device__ __forceinline__ void gemm_phase(PG8_LAS unsigned char* lds, const Gemm g, const Sched& S, const Epi& E, int wave_id) {
    const int tid_l_ = wave_id * 64 + lane_id_v();
    const int tid = tid_l_, wid = __builtin_amdgcn_readfirstlane(tid >> 6), lane = tid & 63, wr = wid >> 2, wc = wid & 3, fr = lane & 15, fq = lane >> 4;
    const int K = g.K, nt = K / BK;
    unsigned voffA[2], voffB[2];
#pragma unroll
    for (int i = 0; i < 2; ++i) { int R, C; stage_rc(tid * 16 + i * 8192, R, C); const int Rb = Epi::PERM ? ((R & ~31) + perm32(R & 31)) : R;
        voffA[i] = (unsigned)(R * K + C) * 2u; voffB[i] = (unsigned)(Rb * K + C) * 2u; }
    const size_t kstep = (size_t)(BK * 2);
    const size_t hstep = (size_t)HALF * K * 2;
    const size_t tstep = 2 * hstep;
    const unsigned ldsw = (unsigned)wid * 1024u;
    const int aoff = lds_byte(wr * 64 + fr, fq * 8), boff = lds_byte(wc * 32 + fr, fq * 8);
#define PG8_SA(b, h) (((b) * 2 + (h)) * HTB)
#define PG8_SB(b, h) ((4 + (b) * 2 + (h)) * HTB)
#define PG8_STAGE(bufoff, gbase, voff) do { _Pragma("unroll") for (int _i = 0; _i < 2; ++_i) \
        __builtin_amdgcn_global_load_lds((const unsigned*)((const char*)(gbase) + (voff)[_i]), (PG8_LAS unsigned*)(lds + (bufoff) + ldsw + _i * 8192), 16, 0, 0); } while (0)
#define PG8_LDA(dst, b, h) do { _Pragma("unroll") for (int m = 0; m < 4; ++m) _Pragma("unroll") for (int k = 0; k < 2; ++k) dst[m][k] = *(const PG8_LAS bf16x8*)(lds + PG8_SA(b, h) + aoff + m * 2048 + k * 1024); } while (0)
#define PG8_LDB(dst, b, h) do { _Pragma("unroll") for (int n = 0; n < 2; ++n) _Pragma("unroll") for (int k = 0; k < 2; ++k) dst[n][k] = *(const PG8_LAS bf16x8*)(lds + PG8_SB(b, h) + boff + n * 2048 + k * 1024); } while (0)
#define PG8_MMA(ai, bj, At, Bt) do { __builtin_amdgcn_s_setprio(1); _Pragma("unroll") for (int m = 0; m < 4; ++m) _Pragma("unroll") for (int n = 0; n < 2; ++n) _Pragma("unroll") for (int k = 0; k < 2; ++k) \
        acc[ai][bj][m][n] = __builtin_amdgcn_mfma_f32_16x16x32_bf16(Bt[n][k], At[m][k], acc[ai][bj][m][n], 0, 0, 0); __builtin_amdgcn_s_setprio(0); } while (0)
#define PG8_WAIT_V(n) asm volatile("s_waitcnt vmcnt(" #n ")" ::: "memory")
#define PG8_WAIT_L(n) asm volatile("s_waitcnt lgkmcnt(" #n ")" ::: "memory")
#define PG8_BAR __builtin_amdgcn_s_barrier()
#define PG8_SCHED __builtin_amdgcn_sched_barrier(0)
    Unit cur, nxt; int ui = 0;
    if (!S.next(0, cur)) return;
    f32x4 acc[2][2][4][2];
#pragma unroll
    for (int a = 0; a < 2; ++a)
#pragma unroll
        for (int b = 0; b < 2; ++b)
#pragma unroll
            for (int m = 0; m < 4; ++m)
#pragma unroll
                for (int n = 0; n < 2; ++n) acc[a][b][m][n] = (f32x4){0.f, 0.f, 0.f, 0.f};
    bf16x8 At[4][2], B0[2][2], B1[2][2];
    const char* cA = (const char*)g.A + (size_t)cur.pm * tstep; const char* cB = (const char*)g.Bt + (size_t)cur.pn * tstep;
    if constexpr (Sched::SPLITK != 0) { cA += (size_t)cur.kt0 * kstep; cB += (size_t)cur.kt0 * kstep; }
    S.a_ready(cur);
    if constexpr (SP2) {
        PG8_STAGE(PG8_SB(0, 0), cB, voffB); PG8_STAGE(PG8_SB(0, 1), cB + hstep, voffB); PG8_STAGE(PG8_SA(0, 0), cA, voffA); PG8_STAGE(PG8_SA(0, 1), cA + hstep, voffA);
        if (wr == 1) PG8_BAR;
        PG8_WAIT_V(2); PG8_BAR;
        PG8_STAGE(PG8_SB(1, 0), cB + kstep, voffB); PG8_STAGE(PG8_SA(1, 0), cA + kstep, voffA); PG8_STAGE(PG8_SB(1, 1), cB + hstep + kstep, voffB);
        PG8_WAIT_V(6); PG8_BAR;
    } else {
        PG8_STAGE(PG8_SB(0, 0), cB, voffB); PG8_STAGE(PG8_SA(0, 0), cA, voffA); PG8_STAGE(PG8_SB(0, 1), cB + hstep, voffB); PG8_STAGE(PG8_SA(0, 1), cA + hstep, voffA);
        if (wr == 1) PG8_BAR;
        PG8_WAIT_V(4); PG8_BAR;
        PG8_STAGE(PG8_SB(1, 0), cB + kstep, voffB); PG8_STAGE(PG8_SA(1, 0), cA + kstep, voffA); PG8_STAGE(PG8_SB(1, 1), cB + hstep + kstep, voffB);
        PG8_WAIT_V(6); PG8_BAR;
    }
    for (;;) {
        const bool has_next = S.next(ui + 1, nxt);
        const char* nA = has_next ? (const char*)g.A + (size_t)nxt.pm * tstep : cA; const char* nB = has_next ? (const char*)g.Bt + (size_t)nxt.pn * tstep : cB;
        if constexpr (Sched::SPLITK != 0) { if (has_next) { nA += (size_t)nxt.kt0 * kstep; nB += (size_t)nxt.kt0 * kstep; } }
        const int cnt = Sched::SPLITK != 0 ? cur.nkt : nt;
        for (int t = 0; t < cnt; t += 2) {
            const bool last = (t == cnt - 2);
            const char* a1 = cA + (size_t)(t + 1) * kstep;
            const char* a2 = last ? nA : cA + (size_t)(t + 2) * kstep; const char* b2 = last ? nB : cB + (size_t)(t + 2) * kstep;
            const char* a3 = a2 + kstep; const char* b3 = b2 + kstep;
            if (last && has_next) S.a_ready(nxt);
            if constexpr (SP2) {
            PG8_LDB(B0, 0, 0); PG8_LDB(B1, 0, 1); PG8_SCHED; PG8_LDA(At, 0, 0); PG8_STAGE(PG8_SA(1, 1), a1 + hstep, voffA);
            PG8_WAIT_V(8); PG8_WAIT_L(0); PG8_BAR; PG8_MMA(0, 0, At, B0); PG8_MMA(0, 1, At, B1); PG8_BAR; PG8_SCHED;
            PG8_LDA(At, 0, 1); PG8_STAGE(PG8_SB(0, 0), b2, voffB); PG8_STAGE(PG8_SB(0, 1), b2 + hstep, voffB); PG8_STAGE(PG8_SA(0, 0), a2, voffA);
            PG8_WAIT_V(8); PG8_WAIT_L(0); PG8_BAR; PG8_MMA(1, 0, At, B0); PG8_MMA(1, 1, At, B1); PG8_BAR; PG8_SCHED;
            PG8_LDB(B0, 1, 0); PG8_LDB(B1, 1, 1); PG8_SCHED; PG8_LDA(At, 1, 0); PG8_STAGE(PG8_SA(0, 1), a2 + hstep, voffA);
            PG8_WAIT_V(8); PG8_WAIT_L(0); PG8_BAR; PG8_MMA(0, 0, At, B0); PG8_MMA(0, 1, At, B1); PG8_BAR; PG8_SCHED;
            PG8_LDA(At, 1, 1); PG8_STAGE(PG8_SB(1, 0), b3, voffB); PG8_STAGE(PG8_SB(1, 1), b3 + hstep, voffB); PG8_STAGE(PG8_SA(1, 0), a3, voffA);
            PG8_WAIT_V(8); PG8_WAIT_L(0); PG8_BAR; PG8_MMA(1, 0, At, B0); PG8_MMA(1, 1, At, B1); PG8_BAR; PG8_SCHED;
            } else {
            PG8_LDB(B0, 0, 0); PG8_SCHED; PG8_LDA(At, 0, 0); PG8_STAGE(PG8_SA(1, 1), a1 + hstep, voffA);
            PG8_WAIT_L(8); PG8_BAR; PG8_WAIT_L(0); PG8_MMA(0, 0, At, B0); PG8_BAR; PG8_SCHED;
            PG8_LDB(B1, 0, 1); PG8_STAGE(PG8_SB(0, 0), b2, voffB);
            PG8_BAR; PG8_WAIT_L(0); PG8_MMA(0, 1, At, B1); PG8_BAR;
            PG8_LDA(At, 0, 1); PG8_STAGE(PG8_SA(0, 0), a2, voffA);
            PG8_BAR; PG8_WAIT_L(0); PG8_MMA(1, 0, At, B0); PG8_BAR; PG8_SCHED;
            PG8_STAGE(PG8_SB(0, 1), b2 + hstep, voffB);
            PG8_WAIT_V(6); PG8_BAR; PG8_MMA(1, 1, At, B1); PG8_BAR;
            PG8_LDB(B0, 1, 0); PG8_SCHED; PG8_LDA(At, 1, 0); PG8_STAGE(PG8_SA(0, 1), a2 + hstep, voffA);
            PG8_WAIT_L(8); PG8_BAR; PG8_WAIT_L(0); PG8_MMA(0, 0, At, B0); PG8_BAR; PG8_SCHED;
            PG8_LDB(B1, 1, 1); PG8_STAGE(PG8_SB(1, 0), b3, voffB);
            PG8_BAR; PG8_WAIT_L(0); PG8_MMA(0, 1, At, B1); PG8_BAR;
            PG8_LDA(At, 1, 1); PG8_STAGE(PG8_SA(1, 0), a3, voffA);
            PG8_BAR; PG8_WAIT_L(0); PG8_MMA(1, 0, At, B0); PG8_BAR; PG8_SCHED;
            PG8_STAGE(PG8_SB(1, 1), b3 + hstep, voffB);
            PG8_WAIT_V(6); PG8_BAR; PG8_MMA(1, 1, At, B1); PG8_BAR;
            }
        }
        if constexpr (ALIGN_EPI) { if (wr == 0) PG8_BAR; }
        if constexpr (Sched::SPLITK == 1) { if (cur.mode == 1) S.publish(acc, cur, wid, lane); else E(acc, cur, wr, wc, fr, fq); S.done(cur); }
        else if constexpr (Sched::SPLITK == 2) { S.consume(acc, cur, wid, lane); E(acc, cur, wr, wc, fr, fq); S.done(cur); }
        else if constexpr (!Epi::AFTER_DRAIN) { E(acc, cur, wr, wc, fr, fq); S.done(cur); }
        if (!has_next) break;
#pragma unroll
        for (int a = 0; a < 2; ++a)
#pragma unroll
            for (int b = 0; b < 2; ++b)
#pragma unroll
                for (int m = 0; m < 4; ++m)
#pragma unroll
                    for (int n = 0; n < 2; ++n) acc[a][b][m][n] = (f32x4){0.f, 0.f, 0.f, 0.f};
        cur = nxt; cA = nA; cB = nB; ++ui;
        if constexpr (ALIGN_EPI) { if (wr == 1) PG8_BAR; }
    }
    PG8_WAIT_V(0);
    if constexpr (!ALIGN_EPI) { if (wr == 0) PG8_BAR; }
    PG8_BAR;
    if constexpr (Epi::AFTER_DRAIN) { E.fused(acc, cur, wr, wc, fr, fq, lds, wid, lane); S.done(cur); }
#undef PG8_SA
#undef PG8_SB
#undef PG8_STAGE
#undef PG8_LDA
#undef PG8_LDB
#undef PG8_MMA
#undef PG8_WAIT_V
#undef PG8_WAIT_L
#undef PG8_BAR
#undef PG8_SCHED
}
}
#define XB_TMO      128
#define XB_XCNT(j)  (256  + 64 * (j))
#define XB_XSUB(j)  (1280 + 64 * (j))
#define XB_XGEN(j)  (2304 + 64 * (j))
#define XB_TOP      3328
#define XB_TOPGEN   3392
#define XCD_BAR_WORDS 3456
#define XB_SPIN_CAP (1u << 18)

__device__ __forceinline__ unsigned xb_ld(unsigned* p)              { return __hip_atomic_load(p, __ATOMIC_RELAXED, __HIP_MEMORY_SCOPE_AGENT); }
__device__ __forceinline__ unsigned xb_add(unsigned* p, unsigned v) { return __hip_atomic_fetch_add(p, v, __ATOMIC_RELAXED, __HIP_MEMORY_SCOPE_AGENT); }
__device__ __forceinline__ unsigned xb_xcc_id() { return (unsigned)__builtin_amdgcn_s_getreg((3 << 11) | 20) & 0xFu; }
#define XB_SPIN(cond, bar) do { unsigned _sp = 0; while (cond) { __builtin_amdgcn_s_sleep(1); \
    if ((++_sp & 255u) == 0u) { if (xb_ld(&(bar)[XB_TMO])) break; if (_sp > XB_SPIN_CAP) { atomicAdd(&(bar)[XB_TMO], 1u); break; } } } } while (0)

struct XcdBarrier {
    unsigned* bar; unsigned x;
    volatile LAS unsigned* st;
};

__device__ __forceinline__ XcdBarrier xcd_barrier_post(unsigned* bar, volatile LAS unsigned* st, int tid_) {
    XcdBarrier b; b.bar = bar; b.x = xb_xcc_id(); b.st = st;
    if (tid_ == 0) (void)xb_add(&bar[XB_XCNT(b.x)], 1u);
    return b;
}
__device__ __forceinline__ void xcd_barrier_complete(unsigned* bar, unsigned x, unsigned& nloc, unsigned& nx) {
    const unsigned G = gridDim.x * gridDim.y * gridDim.z;
    unsigned sum, cnt, mine, sp = 0u;
    for (;;) {
        sum = 0u; cnt = 0u; mine = 0u;
#pragma unroll
        for (unsigned j = 0; j < 16; ++j) { const unsigned c = xb_ld(&bar[XB_XCNT(j)]); sum += c; cnt += (c > 0u) ? 1u : 0u; mine = (j == x) ? c : mine; }
        if (sum == G) break;
        __builtin_amdgcn_s_sleep(1);
        if ((++sp & 255u) == 0u) { if (xb_ld(&bar[XB_TMO])) break; if (sp > XB_SPIN_CAP) { atomicAdd(&bar[XB_TMO], 1u); break; } }
    }
    nloc = mine > 0u ? mine : 1u; nx = cnt > 0u ? cnt : 1u;
}

__device__ __forceinline__ void xcd_barrier(const XcdBarrier& b, int tid_) {
    asm volatile("s_waitcnt vmcnt(0)" ::: "memory");
    __syncthreads();
    if (tid_ == 0) {
        unsigned* bar = b.bar;
        __builtin_amdgcn_s_waitcnt(0);
        unsigned nloc = b.st[0], nx = b.st[1];
        if (nloc == 0u) { xcd_barrier_complete(bar, b.x, nloc, nx); b.st[0] = nloc; b.st[1] = nx; }
        const unsigned old = xb_add(&bar[XB_XSUB(b.x)], 1u);
        const unsigned gen = old / nloc;
        if (old + 1u == (gen + 1u) * nloc) {
            __builtin_amdgcn_fence(__ATOMIC_RELEASE, "agent");
            asm volatile("s_waitcnt vmcnt(0)" ::: "memory");
            const unsigned og = xb_add(&bar[XB_TOP], 1u);
            const unsigned tg = og / nx;
            if (og + 1u == (tg + 1u) * nx) xb_add(&bar[XB_TOPGEN], 1u);
            else XB_SPIN(xb_ld(&bar[XB_TOPGEN]) == tg, bar);
            __builtin_amdgcn_fence(__ATOMIC_ACQUIRE, "agent");
            xb_add(&bar[XB_XGEN(b.x)], 1u);
            asm volatile("s_waitcnt vmcnt(0)" ::: "memory");
        } else {
            XB_SPIN(xb_ld(&bar[XB_XGEN(b.x)]) == gen, bar);
            __builtin_amdgcn_fence(__ATOMIC_ACQUIRE, "agent");
            asm volatile("s_waitcnt vmcnt(0)" ::: "memory");
        }
    }
    __syncthreads();
}

constexpr size_t MiB = 1u << 20;
constexpr size_t WS_CTL = 0, CTL_ZERO_BYTES = 2 * MiB;
constexpr size_t WS_MOD = 2 * MiB;
constexpr size_t WS_PMOD = WS_MOD + 2 * MiB;
constexpr size_t WS_ROPE = WS_PMOD + 8 * MiB;
constexpr size_t WS_W1T = WS_ROPE + 2 * MiB;
constexpr size_t WS_W2T = WS_W1T + 352 * MiB;
constexpr size_t WS_WINE = WS_W2T + 176 * MiB;
constexpr size_t WS_WOUTE = WS_WINE + 34 * MiB;
constexpr size_t WS_WINO = WS_WOUTE + 16 * MiB;
constexpr size_t WS_WOUTO = WS_WINO + 48 * MiB;
constexpr size_t WS_WQ = WS_WOUTO + 16 * MiB;
constexpr size_t WS_WKN = WS_WQ + 4 * MiB;
constexpr size_t WS_WV = WS_WKN + 2 * MiB;
constexpr size_t WS_WLORA = WS_WV + 2 * MiB;
constexpr size_t WS_W3T = WS_WLORA + 8 * MiB;
constexpr size_t WS_H2 = WS_W3T + 8 * MiB;
constexpr size_t WS_X = WS_H2 + 4 * MiB;
constexpr size_t WS_H = WS_X + 96 * MiB;
constexpr size_t WS_ACT = WS_H + 48 * MiB;
constexpr size_t WS_Z = WS_ACT + 132 * MiB;
constexpr size_t WS_SCAN = WS_Z + 288 * MiB;
constexpr size_t SCAN_BYTES = 432 * MiB;
constexpr size_t WS_KBUF = WS_SCAN + 2 * SCAN_BYTES;
constexpr size_t WS_LA = WS_KBUF + 48 * MiB;
constexpr size_t WS_GB = WS_LA + 10 * MiB;
constexpr size_t WS_CQ = WS_GB + 48 * MiB;
constexpr size_t WS_CKV = WS_CQ + 12 * MiB;
constexpr size_t WS_KR = WS_CKV + 8 * MiB;
constexpr size_t WS_Q = WS_KR + 2 * MiB;
constexpr size_t WS_KN = WS_Q + 36 * MiB;
constexpr size_t WS_VT = WS_KN + 26 * MiB;
constexpr size_t WS_YSC = WS_VT + 26 * MiB;
constexpr size_t WS_PQ = WS_ACT;
constexpr size_t WS_SST = WS_ACT + 64 * MiB;
constexpr size_t WS_PST = WS_ACT + 96 * MiB;
constexpr size_t WS_MIX = WS_YSC + 96 * MiB;
constexpr size_t WS_KSS = WS_MIX + 48 * MiB;
constexpr size_t WS_KSP = WS_KSS + 258 * MiB;
constexpr size_t WS_END = WS_KSP + 18 * MiB;
static_assert((size_t)NCH * 64 * 2 * 16384 <= 64 * MiB && (size_t)NCH * 64 * 16384 <= 32 * MiB, "PQ / SST inside the ACT region");
constexpr size_t ZT_S_OFF = (size_t)16 * 6144 * 256 * 4;
constexpr size_t VT_S_OFF = (size_t)16 * 1024 * 256 * 2;

constexpr size_t OUT_YS = (size_t)MP * D, OUT_CKV = (size_t)MT * D, OUT_KR = OUT_CKV + 16 * 2 * 256 * 256, OUT_ST = OUT_KR + 16 * 2 * 256 * 64, OUT_END = OUT_ST + (size_t)16 * 2 * 2 * 16 * 64 * 64;

constexpr int LDS_RING = 131072, LDS_BYTES = 147456, LDS_CTL = LDS_BYTES - 512;

struct KArgs { const float* in[42]; float* out; unsigned char* ws; int ph_lo, ph_hi; };
enum { I_XP = 0, I_XS, I_CCKV, I_CKR, I_ST, I_C, I_CCTX, I_WMOD, I_BMOD, I_NG, I_WFI, I_WFO, I_FNG, I_WINE, I_MUP, I_MUN, I_W0, I_W2, I_A0, I_A2, I_G2, I_KK, I_KA, I_RK, I_GNW, I_GNB,
       I_QN, I_KVN, I_WQB, I_WKVB, I_WOE, I_WINO, I_CW, I_CB, I_FW1, I_FB1, I_FW2, I_FB2, I_FW3, I_FFR, I_HB, I_WOO };

struct Ctx {
    LAS unsigned char* lds; unsigned char* ws; const float* const* in; float* out;
    int tid, lane, wave, G, gw, NGW, vb, bx, zs;
};

DI void tr_item(const float* W, int ldw, int K, bf16* WT, int dstrow0, int srccol0, int k0, LAS float* scr, int lane) {
    float v[32];
#pragma unroll
    for (int i = 0; i < 32; ++i) v[i] = W[(size_t)(k0 + 2 * i + (lane >> 5)) * ldw + srccol0 + (lane & 31)];
#pragma unroll
    for (int i = 0; i < 32; ++i) scr[(2 * i + (lane >> 5)) * 33 + (lane & 31)] = v[i];
    asm volatile("s_waitcnt lgkmcnt(0)" ::: "memory");
    const int c = lane & 7;
#pragma unroll
    for (int j = 0; j < 4; ++j) { const int n = (lane >> 3) + 8 * j; const LAS float* s = scr + (8 * c) * 33 + n;
        v4u o; o.x = pk2(s[0 * 33], s[1 * 33]); o.y = pk2(s[2 * 33], s[3 * 33]); o.z = pk2(s[4 * 33], s[5 * 33]); o.w = pk2(s[6 * 33], s[7 * 33]);
        *(v4u*)(WT + (size_t)(dstrow0 + n) * K + k0 + 8 * c) = o; }
    asm volatile("s_waitcnt lgkmcnt(0)" ::: "memory");
}
template <int MODE> DI void tr_matrix(Ctx& C, const float* W, int ldw, int K, bf16* WT, int ndst, int nsrc, int gw, int NGW) {
    LAS float* scr = (LAS float*)(C.lds + C.wave * 8704);
    const int nkb = K / 64, nnb = ndst / 32, nit = nkb * nnb;
    for (int it = gw; it < nit; it += NGW) {
        const int kb = it / nnb, nb = it % nnb, dr = nb * 32;
        int sc = dr;
        if (MODE == 1) { const int p = dr >> 8, sg = (dr >> 7) & 1, j = dr & 127; sc = sg * 5632 + 128 * p + j; }
        if (MODE == 2 && dr >= nsrc) {
            const int c = C.lane & 7;
#pragma unroll
            for (int j = 0; j < 4; ++j) { const int n = (C.lane >> 3) + 8 * j; *(v4u*)(WT + (size_t)(dr + n) * K + kb * 64 + 8 * c) = (v4u){0u, 0u, 0u, 0u}; }
            continue;
        }
        tr_item(W, ldw, K, WT, dr, sc, kb * 64, scr, C.lane);
    }
}
template <class Fn> DI void cvt_small(Ctx& C, bf16* dst, int N, int K, Fn f) {
    const int total = N * (K / 8);
    for (int idx = C.bx * 512 + C.tid; idx < total; idx += C.G * 512) {
        const int n = idx % N, k8 = idx / N; float v[8];
#pragma unroll
        for (int i = 0; i < 8; ++i) v[i] = f(n, k8 * 8 + i);
        v4u o; o.x = pk2(v[0], v[1]); o.y = pk2(v[2], v[3]); o.z = pk2(v[4], v[5]); o.w = pk2(v[6], v[7]);
        *(v4u*)(dst + (size_t)n * K + k8 * 8) = o;
    }
}

DI void phase_prologue(Ctx& C) {
    const float* const* in = C.in; unsigned char* ws = C.ws;
    tr_matrix<1>(C, in[I_WFI], NFF1, 2048, (bf16*)(ws + WS_W1T), NFF1, NFF1, C.gw, C.NGW);
    tr_matrix<0>(C, in[I_WFO], 2048, DFF, (bf16*)(ws + WS_W2T), 2048, 2048, C.gw, C.NGW);
    for (int i = 0; i < 2; ++i) tr_matrix<2>(C, in[I_WINE] + (size_t)i * 2048 * ZE_N, ZE_N, 2048, (bf16*)(ws + WS_WINE) + (size_t)i * ZE_P * 2048, ZE_P, ZE_N, C.gw, C.NGW);
    for (int i = 0; i < 2; ++i) tr_matrix<0>(C, in[I_WOE] + (size_t)i * 2048 * 2048, 2048, 2048, (bf16*)(ws + WS_WOUTE) + (size_t)i * 2048 * 2048, 2048, 2048, C.gw, C.NGW);
    for (int i = 0; i < 2; ++i) tr_matrix<0>(C, in[I_WINO] + (size_t)i * 2048 * 6144, 6144, 2048, (bf16*)(ws + WS_WINO) + (size_t)i * 6144 * 2048, 6144, 6144, C.gw, C.NGW);
    for (int i = 0; i < 2; ++i) tr_matrix<0>(C, in[I_WOO] + (size_t)i * 2048 * 2048, 2048, 2048, (bf16*)(ws + WS_WOUTO) + (size_t)i * 2048 * 2048, 2048, 2048, C.gw, C.NGW);
    for (int e = 0; e < 2; ++e) {
        const float* wqb = in[I_WQB] + (size_t)e * 512 * 1536;
        cvt_small(C, (bf16*)(ws + WS_WQ) + (size_t)e * 1536 * 512, 1536, 512, [=](int n, int k) { const int hd = n / 192, wi = n % 192; int sc;
            if (wi < 128) sc = wi; else { const int idx = wi - 128, hf = idx >> 5, r = idx & 31; sc = 128 + 32 * hf + 16 * (r & 1) + (r >> 1); }
            return wqb[(size_t)k * 1536 + hd * 192 + sc]; });
        const float* wkv = in[I_WKVB] + (size_t)e * 256 * 2048;
        cvt_small(C, (bf16*)(ws + WS_WKN) + (size_t)e * 1024 * 256, 1024, 256, [=](int n, int k) { return wkv[(size_t)k * 2048 + (n >> 7) * 256 + (n & 127)]; });
        cvt_small(C, (bf16*)(ws + WS_WV) + (size_t)e * 1024 * 256, 1024, 256, [=](int n, int k) { return wkv[(size_t)k * 2048 + (n >> 7) * 256 + 128 + (n & 127)]; });
        const float* w2 = in[I_W2] + (size_t)e * 2 * 64 * 1024; const float* a2 = in[I_A2] + (size_t)e * 2 * 64 * 1024; const float* g2 = in[I_G2] + (size_t)e * 160 * 1024;
        cvt_small(C, (bf16*)(ws + WS_WLORA) + (size_t)e * 5120 * 384, 5120, 384, [=](int n, int k) { const int seg = n >> 10, c = n & 1023; float v = 0.f;
            if (seg < 2) { if (k < 64) v = w2[((size_t)seg * 64 + k) * 1024 + c]; }
            else if (seg < 4) { if (k >= 64 && k < 128) v = a2[((size_t)(seg - 2) * 64 + (k - 64)) * 1024 + c]; }
            else { if (k >= 128 && k < 288) v = g2[(size_t)(k - 128) * 1024 + c]; }
            return v; });
    }
    { const float* w3 = in[I_FW3];
      cvt_small(C, (bf16*)(ws + WS_W3T), 16384, 256, [=](int n, int k) { const int o = n >> 13, col = n & 8191; float v = 0.f; if ((k >> 6) == o) v = w3[((size_t)o * 64 + (k & 63)) * 8192 + col]; return v; }); }
    { LAS float* sl = (LAS float*)(C.lds + 8 * 8704);
      for (int it = C.bx; it < 4 * 8 * 9; it += C.G) {
          const int l = it / 72, kc = (it / 9) % 8, cc = it % 9;
          __syncthreads();
          for (int i = C.tid; i < 768; i += 512) { const int j = i >> 8, k = kc * 256 + (i & 255); const float cv = j == 0 ? in[I_CCTX][k] : in[I_C][(j - 1) * 2048 + k]; sl[i] = silu_f(cv); }
          __syncthreads();
          const int col = cc * 2048 + 4 * C.tid; const float* wp = in[I_WMOD] + ((size_t)l * 2048 + kc * 256) * 18432 + col;
          f32x4v a0 = {0.f, 0.f, 0.f, 0.f}, a1 = a0, a2 = a0;
#pragma unroll 4
          for (int k = 0; k < 256; ++k) { const f32x4v w = *(const f32x4v*)(wp + (size_t)k * 18432); a0 += w * sl[k]; a1 += w * sl[256 + k]; a2 += w * sl[512 + k]; }
          float* pm = (float*)(ws + WS_PMOD) + ((size_t)(kc * 4 + l) * 3) * 18432 + col;
          *(f32x4v*)(pm) = a0; *(f32x4v*)(pm + 18432) = a1; *(f32x4v*)(pm + 2 * 18432) = a2;
      }
      __syncthreads(); }
    { const f32x4v* s0 = (const f32x4v*)in[I_XP]; const f32x4v* s1 = (const f32x4v*)in[I_XS]; f32x4v* x = (f32x4v*)(ws + WS_X);
      const size_t n0 = (size_t)MP * D / 4, n1 = (size_t)MS * D / 4;
      for (size_t i = (size_t)C.bx * 512 + C.tid; i < n0 + n1; i += (size_t)C.G * 512) x[i] = i < n0 ? s0[i] : s1[i - n0]; }
    if (C.bx == 0) for (int i = C.tid; i < 1024; i += 512) { const int pos = i >> 4, j = i & 15; const float inv = 1.0f / powf(10000.0f, (float)(2 * j) / 32.0f); const float a = (float)pos * inv;
        float* r = (float*)(ws + WS_ROPE) + i * 2; r[0] = cosf(a); r[1] = sinf(a); }
    { bf16* H2 = (bf16*)(ws + WS_H2);
      for (int it = C.gw; it < 2 * 4352; it += C.NGW) {
          const int o = it / 4352, rr = it % 4352; const int L = rr < 256 ? 256 : 4096, t = rr < 256 ? rr : rr - 256; const int lane = C.lane;
          float zf = 0.f;
          if (lane == 0) zf = (float)t / (float)(L - 1);
          else if (lane < 33) { const int b = (lane - 1) & 15; const float fr = 1e-4f + (15.0f - 1e-4f) * ((float)b / 15.0f); const float ang = ((float)(2.0 * 3.14159265358979323846 / (double)L) * (float)t) * fr; zf = lane < 17 ? cosf(ang) : -sinf(ang); }
          const float* w1 = in[I_FW1] + (size_t)o * 33 * 64; const float* w2 = in[I_FW2] + (size_t)o * 64 * 64;
          float s = in[I_FB1][o * 64 + lane];
          for (int i = 0; i < 33; ++i) s += shfl_idx(zf, i) * w1[i * 64 + lane];
          const float h1 = sinf(in[I_FFR][(o * 2 + 0) * 64 + lane] * s);
          float s2 = in[I_FB2][o * 64 + lane];
          for (int i = 0; i < 64; ++i) s2 += shfl_idx(h1, i) * w2[i * 64 + lane];
          const float h2 = sinf(in[I_FFR][(o * 2 + 1) * 64 + lane] * s2);
          H2[(size_t)rr * 256 + o * 64 + lane] = (bf16)f2bf(h2);
          if (o == 0) { H2[(size_t)rr * 256 + 128 + lane] = 0; H2[(size_t)rr * 256 + 192 + lane] = 0; }
      } }
}
DI void phase_mod_reduce(Ctx& C) {
    const float* pm = (const float*)(C.ws + WS_PMOD); float* mod = (float*)(C.ws + WS_MOD); const float* bm = C.in[I_BMOD];
    for (int i = C.bx * 512 + C.tid; i < 4 * 3 * 18432; i += C.G * 512) { const int l = i / MODL, n = i % 18432; float s = bm[l * 18432 + n];
#pragma unroll
        for (int kc = 0; kc < 8; ++kc) s += pm[(size_t)kc * 4 * MODL + i];
        mod[i] = s; }
}
DI void phase_norm_mod(Ctx& C, const float* g, const float* modl, int s) {
    const float* X = (const float*)(C.ws + WS_X); bf16* H = (bf16*)(C.ws + WS_H);
    for (int row = C.gw; row < MT; row += C.NGW) {
        const float* sh = modl + row_mod_j(row) * 18432 + (3 * s) * 2048; const float* scl = sh + 2048;
        const f32x4v* xr = (const f32x4v*)(X + (size_t)row * D) + C.lane; f32x4v v[8]; float ss = 0.f;
#pragma unroll
        for (int i = 0; i < 8; ++i) { v[i] = xr[64 * i]; ss += (v[i].x * v[i].x + v[i].y * v[i].y) + (v[i].z * v[i].z + v[i].w * v[i].w); }
        const float rstd = 1.0f / sqrtf(wave_sum(ss) * (1.0f / D) + 1e-6f);
        v2u* o = (v2u*)(H + (size_t)row * D) + C.lane;
#pragma unroll
        for (int i = 0; i < 8; ++i) { const int c = 4 * C.lane + 256 * i; const f32x4v gg = *(const f32x4v*)(g + c), sc = *(const f32x4v*)(scl + c), sf = *(const f32x4v*)(sh + c);
            const f32x4v y = (v[i] * rstd * gg) * (sc + 1.0f) + sf; v2u w; w.x = pk2(y.x, y.y); w.y = pk2(y.z, y.w); o[64 * i] = w; }
    }
}
DI void phase_final_norm(Ctx& C) {
    const float* X = (const float*)(C.ws + WS_X); const float* g = C.in[I_FNG];
    for (int row = C.gw; row < MT; row += C.NGW) {
        const f32x4v* xr = (const f32x4v*)(X + (size_t)row * D) + C.lane; f32x4v v[8]; float ss = 0.f;
#pragma unroll
        for (int i = 0; i < 8; ++i) { v[i] = xr[64 * i]; ss += (v[i].x * v[i].x + v[i].y * v[i].y) + (v[i].z * v[i].z + v[i].w * v[i].w); }
        const float rstd = 1.0f / sqrtf(wave_sum(ss) * (1.0f / D) + 1e-6f);
        f32x4v* o = (f32x4v*)(C.out + (size_t)row * D) + C.lane;
#pragma unroll
        for (int i = 0; i < 8; ++i) { const f32x4v gg = *(const f32x4v*)(g + 4 * C.lane + 256 * i); o[64 * i] = v[i] * rstd * gg; }
    }
}

DI int rope_src(int p) { const int hf = p >> 5, r = p & 31; return 32 * hf + 16 * (r & 1) + (r >> 1); }
DI void phase_even_prep(Ctx& C, int e) {
    const float* const* in = C.in; unsigned char* ws = C.ws; const int lane = C.lane;
    const float* Z = (const float*)(ws + WS_Z); float* SC = (float*)(ws + WS_SCAN + (size_t)e * SCAN_BYTES); float* KB = (float*)(ws + WS_KBUF); bf16* LA = (bf16*)(ws + WS_LA);
    bf16* CQ = (bf16*)(ws + WS_CQ); bf16* CKV = (bf16*)(ws + WS_CKV); bf16* KR = (bf16*)(ws + WS_KR); const float* rope = (const float*)(ws + WS_ROPE);
    const float* mup = in[I_MUP] + e * 3360; const float* mun = in[I_MUN] + e * 3360; const float* kkw = in[I_KK] + e * 1024;
    const float* qn = in[I_QN] + e * 512; const float* kvn = in[I_KVN] + e * 256;
    for (int row = C.gw; row < MKV; row += C.NGW) {
        if (row >= MT) {
            const int rr = row - MT, b = rr >> 8, p = rr & 255;
            const float* cs = in[I_CCKV] + ((size_t)(b * 2 + e) * 256 + p) * 256;
#pragma unroll
            for (int i = 0; i < 4; ++i) CKV[(size_t)row * 256 + 64 * i + lane] = (bf16)f2bf(cs[64 * i + lane]);
            KR[(size_t)row * 64 + lane] = (bf16)f2bf(in[I_CKR][((size_t)(b * 2 + e) * 256 + p) * 64 + rope_src(lane)]);
            continue;
        }
        const bool smp = row >= MP; const int T = smp ? 4096 : 256; const int t = smp ? ((row - MP) & 4095) : (row & 255);
        const float* z = Z + (size_t)row * ZE_P; const bool hp = t > 0, hn = t < T - 1;
        float* sc = SC + (size_t)row * SCAN_P;
#define ZMIX4(c) ({ const f32x4v zc_ = *(const f32x4v*)(z + (c)); const f32x4v zp_ = hp ? *(const f32x4v*)(z + (c) - ZE_P) : (f32x4v){0.f, 0.f, 0.f, 0.f}; const f32x4v zn_ = hn ? *(const f32x4v*)(z + (c) + ZE_P) : (f32x4v){0.f, 0.f, 0.f, 0.f}; \
            zc_ + *(const f32x4v*)(mup + (c)) * (zp_ - zc_) + *(const f32x4v*)(mun + (c)) * (zn_ - zc_); })
#define ZMIX(c) ({ const float zc_ = z[c]; const float zp_ = hp ? z[(c) - ZE_P] : 0.f; const float zn_ = hn ? z[(c) + ZE_P] : 0.f; zc_ + mup[c] * (zp_ - zc_) + mun[c] * (zn_ - zc_); })
#pragma unroll
        for (int i = 0; i < 4; ++i) { const int c = 256 * i + 4 * lane;
            *(f32x4v*)(sc + c) = ZMIX4(c);
            *(f32x4v*)(sc + 1024 + c) = ZMIX4(2048 + c);
            const f32x4v k = ZMIX4(1024 + c); *(f32x4v*)(KB + (size_t)row * 1024 + c) = k;
            const f32x4v kk = k * *(const f32x4v*)(kkw + c); float ss = (kk.x * kk.x + kk.y * kk.y) + (kk.z * kk.z + kk.w * kk.w);
            ss += dpp_f<0xB1>(ss); ss += dpp_f<0x4E>(ss); ss += dpp_f<0x141>(ss); ss += dpp_f<0x140>(ss);
            *(f32x4v*)(sc + 2048 + c) = kk * (1.0f / fmaxf(sqrtf(ss), 1e-12f)); }
        bf16* la = LA + (size_t)row * 384;
        la[lane] = (bf16)f2bf(tanhf(ZMIX(3072 + lane)));
        la[64 + lane] = (bf16)f2bf(ZMIX(3136 + lane));
        la[128 + lane] = (bf16)f2bf(sigmoid_f(ZMIX(3200 + lane)));
        la[192 + lane] = (bf16)f2bf(sigmoid_f(ZMIX(3264 + lane)));
        { float xg = 0.f; if (lane < 32) xg = sigmoid_f(ZMIX(3328 + lane)); la[256 + lane] = (bf16)(lane < 32 ? f2bf(xg) : 0u); la[320 + lane] = 0; }
#undef ZMIX4
#undef ZMIX
        float cq[8], ss = 0.f;
#pragma unroll
        for (int i = 0; i < 8; ++i) { cq[i] = z[3360 + 64 * i + lane]; ss += cq[i] * cq[i]; }
        float rstd = 1.0f / sqrtf(wave_sum(ss) * (1.0f / 512.0f) + 1e-6f);
#pragma unroll
        for (int i = 0; i < 8; ++i) CQ[(size_t)row * 512 + 64 * i + lane] = (bf16)f2bf(cq[i] * rstd * qn[64 * i + lane]);
        float ck[4]; ss = 0.f;
#pragma unroll
        for (int i = 0; i < 4; ++i) { ck[i] = z[3872 + 64 * i + lane]; ss += ck[i] * ck[i]; }
        rstd = 1.0f / sqrtf(wave_sum(ss) * (1.0f / 256.0f) + 1e-6f);
#pragma unroll
        for (int i = 0; i < 4; ++i) { const float y = ck[i] * rstd * kvn[64 * i + lane]; CKV[(size_t)row * 256 + 64 * i + lane] = (bf16)f2bf(y);
            if (!smp) C.out[OUT_CKV + ((size_t)((row >> 8) * 2 + e) * 256 + t) * 256 + 64 * i + lane] = y; }
        const float kr = z[4128 + lane];
        if (!smp) { C.out[OUT_KR + ((size_t)((row >> 8) * 2 + e) * 256 + t) * 64 + lane] = kr; KR[(size_t)row * 64 + lane] = (bf16)f2bf(shfl_idx(kr, rope_src(lane))); }
        else { const int hf = lane >> 5, jj = lane & 15, e2 = (lane >> 4) & 1; const int pos = hf ? (t & 63) : (t >> 6);
            const float xo = shfl_idx(kr, lane ^ 16); const float2 cs = *(const float2*)(rope + (pos * 16 + jj) * 2);
            const float rot = e2 == 0 ? kr * cs.x - xo * cs.y : kr * cs.x + xo * cs.y;
            KR[(size_t)row * 64 + lane] = (bf16)f2bf(shfl_idx(rot, rope_src(lane))); }
    }
}

template <int N> DI float fmac_bc(float acc, float op, float s) { asm("v_fmac_f32_dpp %0, %1, %2 row_newbcast:%3 row_mask:0xf bank_mask:0xf" : "+v"(acc) : "v"(op), "v"(s), "n"(N)); return acc; }
template <int N> DI float mul_bc(float op, float s) { float r; asm("v_mul_f32_dpp %0, %1, %2 row_newbcast:%3 row_mask:0xf bank_mask:0xf" : "=v"(r) : "v"(op), "v"(s), "n"(N)); return r; }
struct ScanOps { f32x4v kk, w, kka, kd, r; float vv; };
typedef __attribute__((__vector_size__(4 * sizeof(int)))) int rsrc_t;
DI f32x4v bl128(__amdgpu_buffer_rsrc_t r, unsigned vo, unsigned so) { return __builtin_bit_cast(f32x4v, __builtin_amdgcn_raw_buffer_load_b128(r, (int)vo, (int)so, 0)); }
DI float bl32(__amdgpu_buffer_rsrc_t r, unsigned vo, unsigned so) { return __builtin_bit_cast(float, __builtin_amdgcn_raw_buffer_load_b32(r, (int)vo, (int)so, 0)); }
template <int MODE> DI ScanOps scan_load(__amdgpu_buffer_rsrc_t rs, unsigned so, unsigned lo, unsigned lv, int d) {
    ScanOps o;
    o.kk = bl128(rs, lo + 2u * 4096u, so); o.w = bl128(rs, lo + (3u + (unsigned)d) * 4096u, so); o.kka = bl128(rs, lo + (5u + (unsigned)d) * 4096u, so);
    if (MODE != 0) { o.kd = bl128(rs, lo + (7u + (unsigned)d) * 4096u, so); o.vv = bl32(rs, lv + 4096u, so); } else { o.kd = (f32x4v){0.f, 0.f, 0.f, 0.f}; o.vv = 0.f; }
    if (MODE == 2) o.r = bl128(rs, lo, so); else o.r = (f32x4v){0.f, 0.f, 0.f, 0.f};
    return o;
}
template <int MODE, int J> DI void scan_col_a(const ScanOps& o, const float (&S)[64], float (&sa)[4]) { sa[J & 3] = fmac_bc<(J >> 2)>(sa[J & 3], o.kk[J & 3], S[J]); }
template <int MODE, int J> DI void scan_col_b(const ScanOps& o, float (&S)[64], float sa, float (&y)[4]) {
    float t = mul_bc<(J >> 2)>(o.w[J & 3], S[J]);
    t = fmac_bc<(J >> 2)>(t, o.kka[J & 3], sa);
    if (MODE != 0) t = fmac_bc<(J >> 2)>(t, o.kd[J & 3], o.vv);
    S[J] = t;
    if (MODE == 2) y[J & 3] = fmac_bc<(J >> 2)>(y[J & 3], o.r[J & 3], t);
}
template <int MODE, int... Js> DI float scan_step(const ScanOps& o, float (&S)[64], std::integer_sequence<int, Js...>) {
    float sa[4] = {0.f, 0.f, 0.f, 0.f}, y[4] = {0.f, 0.f, 0.f, 0.f};
    (scan_col_a<MODE, Js>(o, S, sa), ...);
    const float sat = -((sa[0] + sa[1]) + (sa[2] + sa[3]));
    (scan_col_b<MODE, Js>(o, S, sat, y), ...);
    return (y[0] + y[1]) + (y[2] + y[3]);
}
template <int MODE> DI void scan_wave(const float* SCp, int row0, int rstep, int nsteps, int h, int d, float (&S)[64], float* yout, int lane) {
    const __amdgpu_buffer_rsrc_t rs = __builtin_amdgcn_make_buffer_rsrc((void*)SCp, 0, (int)((size_t)MT * SCAN_P * 4), 0x00020000);
    const __amdgpu_buffer_rsrc_t ry = __builtin_amdgcn_make_buffer_rsrc((void*)yout, 0, (int)((size_t)MT * 1024 * 4), 0x00020000);
    const int so0 = (row0 * SCAN_P + h * 64) * 4, sstep = rstep * SCAN_P * 4, last = nsteps - 1;
    int yo = (row0 * 1024 + h * 64) * 4; const int ystep = rstep * 4096;
    const unsigned lo = 16u * (unsigned)(lane & 15), lv = 4u * (unsigned)lane;
#define SC_LD(s_) scan_load<MODE>(rs, (unsigned)(so0 + ((s_) < last ? (s_) : last) * sstep), lo, lv, d)
#define SC_ST(o_) do { const float y_ = scan_step<MODE>(o_, S, std::make_integer_sequence<int, 64>{}); if (MODE == 2) __builtin_amdgcn_raw_buffer_store_b32(__builtin_bit_cast(unsigned, y_), ry, (int)lv, yo, 0); yo += ystep; } while (0)
    ScanOps o0 = SC_LD(0), o1 = SC_LD(1), o2 = SC_LD(2), o3;
    for (int s = 0; s < nsteps; s += 4) {
        o3 = SC_LD(s + 3); SC_ST(o0);
        o0 = SC_LD(s + 4); SC_ST(o1);
        o1 = SC_LD(s + 5); SC_ST(o2);
        o2 = SC_LD(s + 6); SC_ST(o3);
    }
#undef SC_LD
#undef SC_ST
}
DI void phase_scan1(Ctx& C, int e, int qslot) {
    const float* SCp = (const float*)(C.ws + WS_SCAN + (size_t)e * SCAN_BYTES); float* PQ = (float*)(C.ws + WS_PQ); float* Y = (float*)(C.ws + WS_YSC);
    const int nit = 512 + 64 * (NCH - 1) * 2;
    unsigned* qctr = (unsigned*)(C.ws + WS_CTL) + 8192 + 64 * (e + 2 * qslot);
    for (;;) {
        unsigned itu = 0; if (C.lane == 0) itu = __hip_atomic_fetch_add(qctr, 1u, __ATOMIC_RELAXED, __HIP_MEMORY_SCOPE_AGENT);
        const int it = __builtin_amdgcn_readfirstlane((int)itu); if (it >= nit) break;
        int lane = C.lane; asm volatile("" : "+v"(lane));
        float S[64];
        if (it >= 512) { const int si = it - 512;
            const int kind = si & 1, c = (si >> 1) % (NCH - 1), sidx = (si >> 1) / (NCH - 1);        const int d = sidx & 1, h = (sidx >> 1) & 15, b = sidx >> 5;
            const int t0 = d ? 4095 - c * CHL : c * CHL; const int row0 = MP + b * 4096 + t0;
            float fl = (float)lane; asm volatile("" : "+v"(fl)); const float kf = kind == 0 ? 1.f : 0.f;
#pragma unroll
            for (int j = 0; j < 64; ++j) { S[j] = kf * fmaxf(0.f, 1.f - fabsf(fl - (float)j)); }
            if (kind == 0) scan_wave<0>(SCp, row0, d ? -1 : 1, CHL, h, d, S, nullptr, lane); else scan_wave<1>(SCp, row0, d ? -1 : 1, CHL, h, d, S, nullptr, lane);
            float* dst = PQ + (((size_t)sidx * NCH + c) * 2 + kind) * 4096 + lane * 64;
#pragma unroll
            for (int j = 0; j < 16; ++j) *(f32x4v*)(dst + 4 * j) = (f32x4v){S[4 * j], S[4 * j + 1], S[4 * j + 2], S[4 * j + 3]};
        } else {
            const int pi = it; const int d = pi & 1, h = (pi >> 1) & 15, b = pi >> 5;
#pragma unroll
            for (int j = 0; j < 64; ++j) S[j] = 0.f;
            scan_wave<2>(SCp, b * 256 + (d ? 255 : 0), d ? -1 : 1, 128, h, d, S, Y + (size_t)d * MT * 1024, lane);
            float* dst = (float*)(C.ws + WS_PST) + (size_t)pi * 4096 + lane * 64;
#pragma unroll
            for (int j = 0; j < 16; ++j) *(f32x4v*)(dst + 4 * j) = (f32x4v){S[4 * j], S[4 * j + 1], S[4 * j + 2], S[4 * j + 3]};
        }
    }
}
DI void phase_scan_carry(Ctx& C, int e, int nsw) {
    const float* PQ = (const float*)(C.ws + WS_PQ); float* SST = (float*)(C.ws + WS_SST);
    LAS float* Ss = (LAS float*)C.lds;
    LAS float* Ps = (LAS float*)(C.lds + 64 * 65 * 4 + 64);
    for (int sidx = C.bx; sidx < 64; sidx += C.G) {
        const int d = sidx & 1, h = (sidx >> 1) & 15, b = sidx >> 5; const int row = C.tid & 63, cg = C.wave;
        const float* s0 = C.in[I_ST] + ((((size_t)b * 2 + e) * 2 + d) * 16 + h) * 4096;
        __syncthreads();
        for (int i = C.tid; i < 4096; i += 512) { const float v = s0[i]; Ss[(i >> 6) * 65 + (i & 63)] = v; SST[((size_t)sidx * NCH) * 4096 + i] = v; }
        const float* PQs = PQ + (size_t)sidx * NCH * 2 * 4096;
        f32x4v pp0 = *(const f32x4v*)(PQs + 4 * C.tid), pp1 = *(const f32x4v*)(PQs + 2048 + 4 * C.tid);
        f32x4v qq0 = *(const f32x4v*)(PQs + 4096 + row * 64 + cg * 8), qq1 = *(const f32x4v*)(PQs + 4096 + row * 64 + cg * 8 + 4);
        for (int c = 0; c + 1 < NCH; ++c) {
            __syncthreads();
            *(LAS f32x4v*)(Ps + 4 * C.tid) = pp0; *(LAS f32x4v*)(Ps + 2048 + 4 * C.tid) = pp1;
            float o[8] = {qq0.x, qq0.y, qq0.z, qq0.w, qq1.x, qq1.y, qq1.z, qq1.w};
            if (c + 2 < NCH) { const float* nx = PQs + (size_t)(c + 1) * 2 * 4096;
                pp0 = *(const f32x4v*)(nx + 4 * C.tid); pp1 = *(const f32x4v*)(nx + 2048 + 4 * C.tid);
                qq0 = *(const f32x4v*)(nx + 4096 + row * 64 + cg * 8); qq1 = *(const f32x4v*)(nx + 4096 + row * 64 + cg * 8 + 4); }
            __syncthreads();
            for (int k = 0; k < 64; ++k) { const float sv = Ss[row * 65 + k]; const f32x4v p0 = *(const LAS f32x4v*)(Ps + k * 64 + cg * 8), p1 = *(const LAS f32x4v*)(Ps + k * 64 + cg * 8 + 4);
                o[0] += sv * p0.x; o[1] += sv * p0.y; o[2] += sv * p0.z; o[3] += sv * p0.w; o[4] += sv * p1.x; o[5] += sv * p1.y; o[6] += sv * p1.z; o[7] += sv * p1.w; }
            __syncthreads();
            float* dst = SST + ((size_t)sidx * NCH + c + 1) * 4096 + row * 64 + cg * 8;
#pragma unroll
            for (int i = 0; i < 8; ++i) Ss[row * 65 + cg * 8 + i] = o[i];
            *(f32x4v*)dst = (f32x4v){o[0], o[1], o[2], o[3]}; *(f32x4v*)(dst + 4) = (f32x4v){o[4], o[5], o[6], o[7]};
        }
    }
    {
        const int nb0 = C.G > 64 ? 64 : 0; const float* SCp = (const float*)(C.ws + WS_SCAN + (size_t)e * SCAN_BYTES); float* Y = (float*)(C.ws + WS_YSC);
        if (C.bx >= nb0 && C.wave < nsw) for (int pi = (C.bx - nb0) * nsw + C.wave; pi < 512; pi += (C.G - nb0) * nsw) {
            int lane = C.lane; asm volatile("" : "+v"(lane));
            const int d = pi & 1, h = (pi >> 1) & 15, b = pi >> 5;
            float S[64]; const float* src = (const float*)(C.ws + WS_PST) + (size_t)pi * 4096 + lane * 64;
#pragma unroll
            for (int j = 0; j < 16; ++j) { const f32x4v t = *(const f32x4v*)(src + 4 * j); S[4 * j] = t.x; S[4 * j + 1] = t.y; S[4 * j + 2] = t.z; S[4 * j + 3] = t.w; }
            scan_wave<2>(SCp, b * 256 + (d ? 127 : 128), d ? -1 : 1, 128, h, d, S, Y + (size_t)d * MT * 1024, lane);
            float* dst = C.out + OUT_ST + ((((size_t)b * 2 + e) * 2 + d) * 16 + h) * 4096 + lane * 64;
#pragma unroll
            for (int j = 0; j < 16; ++j) *(f32x4v*)(dst + 4 * j) = (f32x4v){S[4 * j], S[4 * j + 1], S[4 * j + 2], S[4 * j + 3]};
        }
    }
}
DI void phase_scan3(Ctx& C, int e) {
    const float* SCp = (const float*)(C.ws + WS_SCAN + (size_t)e * SCAN_BYTES); const float* SST = (const float*)(C.ws + WS_SST); float* Y = (float*)(C.ws + WS_YSC);
    for (int it = C.gw; it < 64 * NCH; it += C.NGW) {
        int lane = C.lane; asm volatile("" : "+v"(lane));
        const int c = it % NCH, sidx = it / NCH; const int d = sidx & 1, h = (sidx >> 1) & 15, b = sidx >> 5;
        const int t0 = d ? 4095 - c * CHL : c * CHL; const int row0 = MP + b * 4096 + t0;
        float S[64]; const float* src = SST + ((size_t)sidx * NCH + c) * 4096 + lane * 64;
#pragma unroll
        for (int j = 0; j < 16; ++j) { const f32x4v t = *(const f32x4v*)(src + 4 * j); S[4 * j] = t.x; S[4 * j + 1] = t.y; S[4 * j + 2] = t.z; S[4 * j + 3] = t.w; }
        scan_wave<2>(SCp, row0, d ? -1 : 1, CHL, h, d, S, Y + (size_t)d * MT * 1024, lane);
    }
}
DI float row16_sum(float v) { v += dpp_f<0xB1>(v); v += dpp_f<0x4E>(v); v += dpp_f<0x141>(v); v += dpp_f<0x140>(v); return v; }
DI void phase_rwkv_post(Ctx& C, int e) {
    const float* SCp = (const float*)(C.ws + WS_SCAN + (size_t)e * SCAN_BYTES); const float* Y = (const float*)(C.ws + WS_YSC); const float* GB = (const float*)(C.ws + WS_GB); bf16* MIX = (bf16*)(C.ws + WS_MIX);
    const float* rk = C.in[I_RK] + e * 1024; const float* gw = C.in[I_GNW] + e * 1024; const float* gb = C.in[I_GNB] + e * 1024; const int lane = C.lane;
    for (int row = C.gw; row < MT; row += C.NGW) {
        const float* sc = SCp + (size_t)row * SCAN_P;
#pragma unroll
        for (int i = 0; i < 4; ++i) { const int c = 256 * i + 4 * lane;
            const f32x4v y = *(const f32x4v*)(Y + (size_t)row * 1024 + c) + *(const f32x4v*)(Y + ((size_t)MT + row) * 1024 + c);
            const float mu = row16_sum((y.x + y.y) + (y.z + y.w)) * (1.0f / 64.0f); const f32x4v dl = y - mu;
            const float var = row16_sum((dl.x * dl.x + dl.y * dl.y) + (dl.z * dl.z + dl.w * dl.w)) * (1.0f / 64.0f);
            const f32x4v yn = dl * (1.0f / sqrtf(var + 64e-5f));
            const f32x4v rr = *(const f32x4v*)(sc + c), kd = *(const f32x4v*)(sc + 7 * 1024 + c) + *(const f32x4v*)(sc + 8 * 1024 + c), rkv = *(const f32x4v*)(rk + c); const f32x4v pb = rr * kd * rkv;
            const float bs = row16_sum((pb.x + pb.y) + (pb.z + pb.w));
            const f32x4v o = (yn * *(const f32x4v*)(gw + c) + *(const f32x4v*)(gb + c) + *(const f32x4v*)(sc + 1024 + c) * bs) * *(const f32x4v*)(GB + (size_t)row * 1024 + c);
            v2u w; w.x = pk2(o.x, o.y); w.y = pk2(o.z, o.w); *(v2u*)(MIX + (size_t)row * 2048 + c) = w; }
    }
}

constexpr int AT_KP = 200, AT_VP = 72, AT_KB = 64 * AT_KP * 2, AT_VB = 128 * AT_VP * 2, AT_BUF = AT_KB + AT_VB;
DI void attn_unit(Ctx& C, const bf16* Qb, const bf16* KN, const bf16* KRb, const bf16* VTh  , int vpitch, bf16* MIX, int qrow0, int h, int krow0, int nlat, int crow0, int ntile) {
    int tid = C.tid; asm volatile("" : "+v"(tid)); const int lane = tid & 63, r = lane & 31, hh = lane >> 5;
    LAS unsigned char* lds = C.lds;
    s16x8v qf[12];
    { const bf16* qp = Qb + (size_t)(qrow0 + C.wave * 32 + r) * 1536 + h * 192 + 8 * hh;
#pragma unroll
      for (int s = 0; s < 12; ++s) qf[s] = *(const s16x8v*)(qp + 16 * s); }
    f32x16v o[4];
#pragma unroll
    for (int vb = 0; vb < 4; ++vb)
#pragma unroll
        for (int i = 0; i < 16; ++i) o[vb][i] = 0.f;
    float mrun = -INFINITY, lsum = 0.f;
    v4u pre[5];
    auto issue = [&](int j) {
        const int k0 = 64 * j; const int rbase = k0 < nlat ? krow0 + k0 : crow0 + (k0 - nlat);
#pragma unroll
        for (int i = 0; i < 3; ++i) { const int p = tid + 512 * i, key = p / 24, pc = p % 24; const size_t rw = (size_t)(rbase + key);
            pre[i] = pc < 16 ? *(const v4u*)(KN + rw * 1024 + h * 128 + pc * 8) : *(const v4u*)(KRb + rw * 64 + (pc - 16) * 8); }
#pragma unroll
        for (int i = 0; i < 2; ++i) { const int p = tid + 512 * i, dv = p >> 3, pc = p & 7; pre[3 + i] = *(const v4u*)(VTh + (size_t)dv * vpitch + k0 + pc * 8); }
    };
    auto commit = [&](int buf) {
        LAS unsigned char* kb = lds + buf * AT_BUF; LAS unsigned char* vbp = kb + AT_KB;
#pragma unroll
        for (int i = 0; i < 3; ++i) { const int p = tid + 512 * i, key = p / 24, pc = p % 24; *(LAS v4u*)(kb + key * (AT_KP * 2) + pc * 16) = pre[i]; }
#pragma unroll
        for (int i = 0; i < 2; ++i) { const int p = tid + 512 * i, dv = p >> 3, pc = p & 7; *(LAS v4u*)(vbp + dv * (AT_VP * 2) + pc * 16) = pre[3 + i]; }
    };
    __syncthreads();
    issue(0); commit(0); __syncthreads();
    for (int j = 0; j < ntile; ++j) {
        if (j + 1 < ntile) issue(j + 1);
        const LAS unsigned char* kb = lds + (j & 1) * AT_BUF; const LAS unsigned char* vbp = kb + AT_KB;
        f32x16v st[2];
        __builtin_amdgcn_s_setprio(1);
#pragma unroll
        for (int kbk = 0; kbk < 2; ++kbk) {
#pragma unroll
            for (int i = 0; i < 16; ++i) st[kbk][i] = 0.f;
#pragma unroll
            for (int s = 0; s < 12; ++s) { const s16x8v a = *(const LAS s16x8v*)(kb + (32 * kbk + r) * (AT_KP * 2) + (16 * s + 8 * hh) * 2);
                st[kbk] = __builtin_amdgcn_mfma_f32_32x32x16_bf16(a, qf[s], st[kbk], 0, 0, 0); }
        }
        __builtin_amdgcn_s_setprio(0);
        float mx = st[0][0];
#pragma unroll
        for (int i = 1; i < 16; ++i) mx = fmaxf(mx, st[0][i]);
#pragma unroll
        for (int i = 0; i < 16; ++i) mx = fmaxf(mx, st[1][i]);
        mx = fmaxf(mx, shfl_idx(mx, lane ^ 32));
        const float mnew = fmaxf(mrun, mx); const float alpha = __builtin_amdgcn_exp2f(mrun - mnew); mrun = mnew;
        float ps = 0.f;
#pragma unroll
        for (int kbk = 0; kbk < 2; ++kbk)
#pragma unroll
            for (int i = 0; i < 16; ++i) { const float p = __builtin_amdgcn_exp2f(st[kbk][i] - mnew); st[kbk][i] = p; ps += p; }
        lsum = lsum * alpha + ps;
        if (__builtin_amdgcn_ballot_w64(alpha != 1.0f) != 0ull) {
#pragma unroll
            for (int vb = 0; vb < 4; ++vb)
#pragma unroll
                for (int i = 0; i < 16; ++i) o[vb][i] *= alpha; }
        __builtin_amdgcn_s_setprio(1);
#pragma unroll
        for (int kbk = 0; kbk < 2; ++kbk)
#pragma unroll
            for (int s2 = 0; s2 < 2; ++s2) {
                v4u pw; pw.x = pg8::cvt_pk_bf16(st[kbk][8 * s2 + 0], st[kbk][8 * s2 + 1]); pw.y = pg8::cvt_pk_bf16(st[kbk][8 * s2 + 2], st[kbk][8 * s2 + 3]); pw.z = pg8::cvt_pk_bf16(st[kbk][8 * s2 + 4], st[kbk][8 * s2 + 5]); pw.w = pg8::cvt_pk_bf16(st[kbk][8 * s2 + 6], st[kbk][8 * s2 + 7]);
                const s16x8v pf = __builtin_bit_cast(s16x8v, pw);
#pragma unroll
                for (int vb = 0; vb < 4; ++vb) { const LAS unsigned char* vp = vbp + (32 * vb + r) * (AT_VP * 2) + (32 * kbk + 16 * s2 + 4 * hh) * 2;
                    const v2u lo = *(const LAS v2u*)vp, hi = *(const LAS v2u*)(vp + 16); const v4u av = {lo.x, lo.y, hi.x, hi.y};
                    o[vb] = __builtin_amdgcn_mfma_f32_32x32x16_bf16(__builtin_bit_cast(s16x8v, av), pf, o[vb], 0, 0, 0); }
            }
        __builtin_amdgcn_s_setprio(0);
        if (j + 1 < ntile) commit((j + 1) & 1);
        __syncthreads();
    }
    const float inv = 1.0f / (lsum + shfl_idx(lsum, lane ^ 32));
    bf16* op = MIX + (size_t)(qrow0 + C.wave * 32 + r) * 2048 + 1024 + h * 128 + 4 * hh;
#pragma unroll
    for (int vb = 0; vb < 4; ++vb)
#pragma unroll
        for (int g = 0; g < 4; ++g) { v2u w; w.x = pk2(o[vb][4 * g] * inv, o[vb][4 * g + 1] * inv); w.y = pk2(o[vb][4 * g + 2] * inv, o[vb][4 * g + 3] * inv);
            *(v2u*)(op + 32 * vb + 8 * g) = w; }
}
DI void phase_attention(Ctx& C) {
    unsigned char* ws = C.ws; const bf16* Qb = (const bf16*)(ws + WS_Q); const bf16* KN = (const bf16*)(ws + WS_KN); const bf16* KRb = (const bf16*)(ws + WS_KR); bf16* MIX = (bf16*)(ws + WS_MIX);
    const bf16* VTp = (const bf16*)(ws + WS_VT); const bf16* VTs = (const bf16*)(ws + WS_VT + VT_S_OFF);
    for (int u = C.bx; u < 256 + 128; u += C.G) {
        if (u < 256) { const int qb = u & 15, h = (u >> 4) & 7, b = u >> 7;
            attn_unit(C, Qb, KN, KRb, VTs + ((size_t)b * 1024 + h * 128) * 4352, 4352, MIX, MP + b * 4096 + qb * 256, h, MP + b * 4096, 4096, MT + b * 256, 68); }
        else { const int v = u - 256, h = v & 7, b = v >> 3;
            attn_unit(C, Qb, KN, KRb, VTp + ((size_t)b * 1024 + h * 128) * 256, 256, MIX, b * 256, h, b * 256, 256, 0, 4); }
    }
    __syncthreads();
}

DI f32x2v mk2(float a, float b) { return (f32x2v){a, b}; }
DI f32x2v cmul(f32x2v a, f32x2v b) { const f32x2v t = {-b.y, b.x}; return a.x * b + a.y * t; }
DI f32x2v cmulc(f32x2v a, f32x2v b) { const f32x2v t = {b.y, -b.x}; return a.x * b + a.y * t; }
DI f32x2v mul_mi(f32x2v a) { return mk2(a.y, -a.x); }
DI f32x2v mul_pi(f32x2v a) { return mk2(-a.y, a.x); }
DI f32x2v twid(int p, int den) { const float fr = (float)p / (float)den; return mk2(__builtin_amdgcn_cosf(fr), __builtin_amdgcn_sinf(fr)); }
DI int PD(int i) { return i + ((i >> 5) << 1); }
constexpr int FFT_BS = 8192 + 512, FFT_BUF_BYTES = FFT_BS * 8;
DI void bf4_fwd(f32x2v& x0, f32x2v& x1, f32x2v& x2, f32x2v& x3, f32x2v w0, f32x2v wm) {
    const f32x2v a0 = x0 + x2, a2 = cmul(x0 - x2, w0), a1 = x1 + x3, a3 = cmul(x1 - x3, mul_mi(w0));
    x0 = a0 + a1; x1 = cmul(a0 - a1, wm); x2 = a2 + a3; x3 = cmul(a2 - a3, wm);
}
DI void bf4_inv(f32x2v& x0, f32x2v& x1, f32x2v& x2, f32x2v& x3, f32x2v wa, f32x2v w) {
    const f32x2v t1 = cmul(x1, w), t3 = cmul(x3, w);
    const f32x2v a0 = x0 + t1, a1 = x0 - t1, a2 = x2 + t3, a3 = x2 - t3;
    const f32x2v t2 = cmul(a2, wa), t3b = cmul(a3, mul_pi(wa));
    x0 = a0 + t2; x1 = a1 + t3b; x2 = a0 - t2; x3 = a1 - t3b;
}
template <int N, int M, int NI = 1> DI void fft_fwd_pass(LAS f32x2v* buf, int tid) {
    constexpr int S = M / 8;
    const int tr = tid / (N / 16), u = tid % (N / 16), g = u / S, p = u % S; const int base = tr * N + g * 2 * M + p;
    f32x2v e[NI][16];
#pragma unroll
    for (int j = 0; j < NI; ++j)
#pragma unroll
        for (int k = 0; k < 16; ++k) e[j][k] = buf[j * FFT_BS + PD(base + k * S)];
    const f32x2v bc = twid(p, 2 * M); const f32x2v b1 = mk2(bc.x, -bc.y), b2 = cmul(b1, b1), b4 = cmul(b2, b2), b8 = cmul(b4, b4);
    constexpr float C1 = 0.92387953251128674f, S1 = 0.38268343236508977f, R2 = 0.70710678118654752f;
    const f32x2v w1a = cmul(b1, mk2(C1, -S1)), w1b = cmul(b2, mk2(R2, -R2)), w2a = cmul(b1, mk2(R2, -R2)), w2b = mul_mi(b2), w3a = cmul(b1, mk2(S1, -C1)), w3b = cmul(b2, mk2(-R2, -R2));
#pragma unroll
    for (int j = 0; j < NI; ++j) {
        bf4_fwd(e[j][0], e[j][4], e[j][8], e[j][12], b1, b2);
        bf4_fwd(e[j][1], e[j][5], e[j][9], e[j][13], w1a, w1b);
        bf4_fwd(e[j][2], e[j][6], e[j][10], e[j][14], w2a, w2b);
        bf4_fwd(e[j][3], e[j][7], e[j][11], e[j][15], w3a, w3b);
#pragma unroll
        for (int q = 0; q < 4; ++q) bf4_fwd(e[j][4 * q], e[j][4 * q + 1], e[j][4 * q + 2], e[j][4 * q + 3], b4, b8);
#pragma unroll
        for (int k = 0; k < 16; ++k) buf[j * FFT_BS + PD(base + k * S)] = e[j][k];
    }
    __syncthreads();
    if constexpr (M / 16 >= 32) fft_fwd_pass<N, M / 16, NI>(buf, tid);
}
constexpr float c32q(int k) { return k == 0 ? 1.f : k == 1 ? 0.98078528040323043f : k == 2 ? 0.92387953251128674f : k == 3 ? 0.83146961230254524f : k == 4 ? 0.70710678118654752f : k == 5 ? 0.55557023301960218f : k == 6 ? 0.38268343236508977f : k == 7 ? 0.19509032201612825f : 0.f; }
constexpr float c32(int k) { return k <= 8 ? c32q(k) : -c32q(16 - k); }
constexpr float s32(int k) { return k <= 8 ? c32q(8 - k) : c32q(k - 8); }
DI void bf4_fwd_t(f32x2v& x0, f32x2v& x1, f32x2v& x2, f32x2v& x3) {
    const f32x2v a0 = x0 + x2, a2 = x0 - x2, a1 = x1 + x3, a3 = mul_mi(x1 - x3);
    x0 = a0 + a1; x1 = a0 - a1; x2 = a2 + a3; x3 = a2 - a3;
}
DI void bf4_fwd_b1(f32x2v& x0, f32x2v& x1, f32x2v& x2, f32x2v& x3) {
    constexpr float R2 = 0.70710678118654752f;
    const f32x2v a0 = x0 + x2, a2 = cmul(x0 - x2, mk2(R2, -R2)), a1 = x1 + x3, a3 = cmul(x1 - x3, mk2(-R2, -R2));
    x0 = a0 + a1; x1 = mul_mi(a0 - a1); x2 = a2 + a3; x3 = mul_mi(a2 - a3);
}
DI void bf4_inv_t(f32x2v& x0, f32x2v& x1, f32x2v& x2, f32x2v& x3) {
    const f32x2v a0 = x0 + x1, a1 = x0 - x1, a2 = x2 + x3, a3 = x2 - x3; const f32x2v t3b = mul_pi(a3);
    x0 = a0 + a2; x1 = a1 + t3b; x2 = a0 - a2; x3 = a1 - t3b;
}
DI void bf4_inv_b1(f32x2v& x0, f32x2v& x1, f32x2v& x2, f32x2v& x3) {
    constexpr float R2 = 0.70710678118654752f;
    const f32x2v t1 = mul_pi(x1), t3 = mul_pi(x3); const f32x2v a0 = x0 + t1, a1 = x0 - t1, a2 = x2 + t3, a3 = x2 - t3;
    const f32x2v t2 = cmul(a2, mk2(R2, R2)), t3b = cmul(a3, mk2(-R2, R2));
    x0 = a0 + t2; x1 = a1 + t3b; x2 = a0 - t2; x3 = a1 - t3b;
}
template <int NI> DI void fft_r32_fwd(LAS f32x2v* buf, int tid) {
    const int img = tid >> 8, g = tid & 255;
    if (img < NI) {
        LAS f32x4v* p = (LAS f32x4v*)(buf + img * FFT_BS + 34 * g);
        f32x2v r[32];
#pragma unroll
        for (int m = 0; m < 16; ++m) { const f32x4v v = p[m]; r[2 * m] = mk2(v.x, v.y); r[2 * m + 1] = mk2(v.z, v.w); }
        bf4_fwd_t(r[0], r[8], r[16], r[24]);
#pragma unroll
        for (int j = 1; j < 8; ++j) bf4_fwd(r[j], r[j + 8], r[j + 16], r[j + 24], mk2(c32(j), -s32(j)), mk2(c32(2 * j), -s32(2 * j)));
#pragma unroll
        for (int q = 0; q < 4; ++q) { bf4_fwd_t(r[8 * q], r[8 * q + 2], r[8 * q + 4], r[8 * q + 6]); bf4_fwd_b1(r[8 * q + 1], r[8 * q + 3], r[8 * q + 5], r[8 * q + 7]); }
#pragma unroll
        for (int m = 0; m < 16; ++m) { const f32x2v a = r[2 * m] + r[2 * m + 1], b = r[2 * m] - r[2 * m + 1]; p[m] = (f32x4v){a.x, a.y, b.x, b.y}; }
    }
    __syncthreads();
}
template <int NI> DI void fft_r32_inv(LAS f32x2v* buf, int tid) {
    const int img = tid >> 8, g = tid & 255;
    if (img < NI) {
        LAS f32x4v* p = (LAS f32x4v*)(buf + img * FFT_BS + 34 * g);
        f32x2v r[32];
#pragma unroll
        for (int m = 0; m < 16; ++m) { const f32x4v v = p[m]; r[2 * m] = mk2(v.x + v.z, v.y + v.w); r[2 * m + 1] = mk2(v.x - v.z, v.y - v.w); }
#pragma unroll
        for (int q = 0; q < 4; ++q) { bf4_inv_t(r[8 * q], r[8 * q + 2], r[8 * q + 4], r[8 * q + 6]); bf4_inv_b1(r[8 * q + 1], r[8 * q + 3], r[8 * q + 5], r[8 * q + 7]); }
        bf4_inv_t(r[0], r[8], r[16], r[24]);
#pragma unroll
        for (int j = 1; j < 8; ++j) bf4_inv(r[j], r[j + 8], r[j + 16], r[j + 24], mk2(c32(j), s32(j)), mk2(c32(2 * j), s32(2 * j)));
#pragma unroll
        for (int m = 0; m < 16; ++m) p[m] = (f32x4v){r[2 * m].x, r[2 * m].y, r[2 * m + 1].x, r[2 * m + 1].y};
    }
    __syncthreads();
}
template <int N, int NI = 1> DI void fft_fwd(LAS f32x2v* buf, int tid) {
    asm volatile("" : "+v"(tid));
    fft_fwd_pass<N, N / 2, NI>(buf, tid);
    fft_r32_fwd<NI>(buf, tid);
}
template <int N, int M, int NI = 1, bool REC = true> DI void fft_inv_pass(LAS f32x2v* buf, int tid) {
    const int tr = tid / (N / 16), u = tid % (N / 16), g = u / M, p = u % M; const int base = tr * N + g * 16 * M + p;
    f32x2v e[NI][16];
#pragma unroll
    for (int j = 0; j < NI; ++j)
#pragma unroll
        for (int k = 0; k < 16; ++k) e[j][k] = buf[j * FFT_BS + PD(base + k * M)];
    const f32x2v a1 = twid(p, 16 * M), a2 = cmul(a1, a1), a4 = cmul(a2, a2), a8 = cmul(a4, a4);
    constexpr float C1 = 0.92387953251128674f, S1 = 0.38268343236508977f, R2 = 0.70710678118654752f;
    const f32x2v v1a = cmul(a1, mk2(C1, S1)), v1b = cmul(a2, mk2(R2, R2)), v2a = cmul(a1, mk2(R2, R2)), v2b = mul_pi(a2), v3a = cmul(a1, mk2(S1, C1)), v3b = cmul(a2, mk2(-R2, R2));
#pragma unroll
    for (int j = 0; j < NI; ++j) {
#pragma unroll
        for (int q = 0; q < 4; ++q) bf4_inv(e[j][4 * q], e[j][4 * q + 1], e[j][4 * q + 2], e[j][4 * q + 3], a4, a8);
        bf4_inv(e[j][0], e[j][4], e[j][8], e[j][12], a1, a2);
        bf4_inv(e[j][1], e[j][5], e[j][9], e[j][13], v1a, v1b);
        bf4_inv(e[j][2], e[j][6], e[j][10], e[j][14], v2a, v2b);
        bf4_inv(e[j][3], e[j][7], e[j][11], e[j][15], v3a, v3b);
#pragma unroll
        for (int k = 0; k < 16; ++k) buf[j * FFT_BS + PD(base + k * M)] = e[j][k];
    }
    __syncthreads();
    if constexpr (REC && 16 * M < N) fft_inv_pass<N, 16 * M, NI>(buf, tid);
}
template <int N, int NI = 1> DI void fft_inv(LAS f32x2v* buf, int tid) {
    asm volatile("" : "+v"(tid));
    fft_r32_inv<NI>(buf, tid);
    fft_inv_pass<N, 32, NI>(buf, tid);
}
template <int N> DI int ks_perm(int e) { if constexpr (N == 8192) return e < 4096 ? (((e & 63) << 6) | (e >> 6)) : e; else return e; }
template <int N, int NI> DI void fft_pairmul_pre(LAS f32x2v* buf, const f32x4v (&ksr)[8], const f32x4v* KS, int tid) {
    asm volatile("" : "+v"(tid));
    constexpr int LOG = (N == 8192) ? 13 : 9, NB = 8192 / N, NK = N / 2 + 1;
#pragma unroll
    for (int r = 0; r < 9; ++r) {
        const int idx = tid + 512 * r;
        if (r == 8 && idx >= NB * NK) break;
        f32x4v ks; if (r < 8) ks = ksr[r]; else ks = KS[idx];
        const int tr = idx / NK, k = ks_perm<N>(idx % NK);
        const int pk = PD(tr * N + (int)(__brev((unsigned)k) >> (32 - LOG))), pn = PD(tr * N + (int)(__brev((unsigned)((N - k) & (N - 1))) >> (32 - LOG)));
#pragma unroll
        for (int j = 0; j < NI; ++j) {
            const f32x2v zk = buf[j * FFT_BS + pk], zn = buf[j * FFT_BS + pn];
            const f32x2v u1 = mk2(0.5f * (zk.x + zn.x), 0.5f * (zk.y - zn.y)), u2 = mk2(0.5f * (zk.y + zn.y), -0.5f * (zk.x - zn.x));
            const f32x2v y1 = cmul(u1, mk2(ks.x, ks.y)), y2 = cmul(u2, mk2(ks.z, ks.w));
            buf[j * FFT_BS + pk] = mk2(y1.x - y2.y, y1.y + y2.x);
            if (pn != pk) buf[j * FFT_BS + pn] = mk2(y1.x + y2.y, -y1.y + y2.x);
        }
    }
}
template <int N, int NI> DI void fft_fwd_first(LAS f32x2v* buf, int tid, const float (&u0)[NI][8], const float (&u1)[NI][8]) {
    asm volatile("" : "+v"(tid));
    constexpr int M = N / 2, S = M / 8;
    const int tr = tid / (N / 16), p = tid % (N / 16); const int base = tr * N + p;
    const f32x2v bc = twid(p, 2 * M); const f32x2v b1 = mk2(bc.x, -bc.y), b2 = cmul(b1, b1), b4 = cmul(b2, b2), b8 = cmul(b4, b4);
    constexpr float C1 = 0.92387953251128674f, S1 = 0.38268343236508977f, R2 = 0.70710678118654752f;
    const f32x2v w1a = cmul(b1, mk2(C1, -S1)), w1b = cmul(b2, mk2(R2, -R2)), w2a = cmul(b1, mk2(R2, -R2)), w2b = mul_mi(b2), w3a = cmul(b1, mk2(S1, -C1)), w3b = cmul(b2, mk2(-R2, -R2));
    __syncthreads();
#pragma unroll
    for (int j = 0; j < NI; ++j) {
        f32x2v e[16];
#define FFT_HALF_FWD(i, w0, wm) { const f32x2v x0 = mk2(u0[j][i], u1[j][i]), x1 = mk2(u0[j][i + 4], u1[j][i + 4]); const f32x2v a2 = cmul(x0, w0), a3 = cmul(x1, mul_mi(w0)); \
            e[i] = x0 + x1; e[i + 4] = cmul(x0 - x1, wm); e[i + 8] = a2 + a3; e[i + 12] = cmul(a2 - a3, wm); }
        FFT_HALF_FWD(0, b1, b2) FFT_HALF_FWD(1, w1a, w1b) FFT_HALF_FWD(2, w2a, w2b) FFT_HALF_FWD(3, w3a, w3b)
#undef FFT_HALF_FWD
#pragma unroll
        for (int q = 0; q < 4; ++q) bf4_fwd(e[4 * q], e[4 * q + 1], e[4 * q + 2], e[4 * q + 3], b4, b8);
#pragma unroll
        for (int k = 0; k < 16; ++k) buf[j * FFT_BS + PD(base + k * S)] = e[k];
    }
    __syncthreads();
}
template <int N, int NI> DI void fft_inv_last(LAS f32x2v* buf, int tid, f32x2v (&out)[NI][8]) {
    asm volatile("" : "+v"(tid));
    constexpr int M = N / 16;
    const int tr = tid / (N / 16), p = tid % (N / 16); const int base = tr * N + p;
    const f32x2v a1 = twid(p, 16 * M), a2 = cmul(a1, a1), a4 = cmul(a2, a2), a8 = cmul(a4, a4);
    constexpr float C1 = 0.92387953251128674f, S1 = 0.38268343236508977f, R2 = 0.70710678118654752f;
    const f32x2v v1a = cmul(a1, mk2(C1, S1)), v1b = cmul(a2, mk2(R2, R2)), v2a = cmul(a1, mk2(R2, R2)), v2b = mul_pi(a2), v3a = cmul(a1, mk2(S1, C1)), v3b = cmul(a2, mk2(-R2, R2));
#pragma unroll
    for (int j = 0; j < NI; ++j) {
        f32x2v e[16];
#pragma unroll
        for (int k = 0; k < 16; ++k) e[k] = buf[j * FFT_BS + PD(base + k * M)];
#pragma unroll
        for (int q = 0; q < 4; ++q) bf4_inv(e[4 * q], e[4 * q + 1], e[4 * q + 2], e[4 * q + 3], a4, a8);
#define FFT_HALF_INV(i, wa, w) { const f32x2v t1 = cmul(e[i + 4], w), t3 = cmul(e[i + 12], w); const f32x2v a0 = e[i] + t1, a1_ = e[i] - t1, a2_ = e[i + 8] + t3, a3 = e[i + 8] - t3; \
            out[j][i] = a0 + cmul(a2_, wa); out[j][i + 4] = a1_ + cmul(a3, mul_pi(wa)); }
        FFT_HALF_INV(0, a1, a2) FFT_HALF_INV(1, v1a, v1b) FFT_HALF_INV(2, v2a, v2b) FFT_HALF_INV(3, v3a, v3b)
#undef FFT_HALF_INV
    }
}
template <int N, int NI = 1, bool SH = false> DI void fft_pairmul(LAS f32x2v* buf, const f32x4v* const (&KS)[NI]  , int tid) {
    asm volatile("" : "+v"(tid));
    constexpr int LOG = (N == 8192) ? 13 : 9, NB = 8192 / N, NK = N / 2 + 1;
    for (int idx = tid; idx < NB * NK; idx += 512) {
        const int tr = idx / NK, k = ks_perm<N>(idx % NK);
        const int pk = PD(tr * N + (int)(__brev((unsigned)k) >> (32 - LOG))), pn = PD(tr * N + (int)(__brev((unsigned)((N - k) & (N - 1))) >> (32 - LOG)));
        f32x4v ks0 = {0.f, 0.f, 0.f, 0.f}; if (SH) ks0 = KS[0][idx];
#pragma unroll
        for (int j = 0; j < NI; ++j) {
            const f32x2v zk = buf[j * FFT_BS + pk], zn = buf[j * FFT_BS + pn]; const f32x4v ks = SH ? ks0 : KS[j][idx];
            const f32x2v u1 = mk2(0.5f * (zk.x + zn.x), 0.5f * (zk.y - zn.y)), u2 = mk2(0.5f * (zk.y + zn.y), -0.5f * (zk.x - zn.x));
            const f32x2v y1 = cmul(u1, mk2(ks.x, ks.y)), y2 = cmul(u2, mk2(ks.z, ks.w));
            buf[j * FFT_BS + pk] = mk2(y1.x - y2.y, y1.y + y2.x);
            if (pn != pk) buf[j * FFT_BS + pn] = mk2(y1.x + y2.y, -y1.y + y2.x);
        }
    }
}
template <int T> DI void hyena_filter_item(Ctx& C, int o, int n, int pair0) {
    constexpr int N = 2 * T, NB = 4096 / T, LOG = (N == 8192) ? 13 : 9, NK = N / 2 + 1;
    const bf16* KT = (const bf16*)(C.ws + WS_SCAN); LAS f32x2v* buf = (LAS f32x2v*)C.lds; LAS float* red = (LAS float*)(C.lds + FFT_BUF_BYTES + 1024);
    int tid = C.tid; asm volatile("" : "+v"(tid)); const int toff = T == 256 ? 0 : 256;
    const float dmin = 4.605170185988092f / 1.5f, dmax = 4.605170185988092f / 0.3f;
    __syncthreads();
    if (tid < 2 * NB) red[tid] = 0.f;
    __syncthreads();
    float k0[16], k1[16];
#pragma unroll
    for (int i = 0; i < 16; ++i) { const int idx = tid + 512 * i, tr = idx / N, pos = idx % N; const int c = 2 * (pair0 + tr);
        float a = 0.f, b = 0.f;
        if (pos != T) { const int side = pos > T ? 1 : 0, tt = pos > T ? N - pos : pos; const float tn = (float)tt / (float)(T - 1);
            const bf16* kr = KT + ((size_t)o * 8192 + (n * 2 + side) * 2048 + c) * 4352 + toff + tt;
            const float d0 = dmin + (dmax - dmin) * ((float)c / 2047.0f), d1 = dmin + (dmax - dmin) * ((float)(c + 1) / 2047.0f);
            a = bf2f(kr[0]) * expf(-tn * d0); b = bf2f(kr[4352]) * expf(-tn * d1); }
        k0[i] = a; k1[i] = b;
        const float sa = wave_sum(fabsf(a)), sb = wave_sum(fabsf(b));
        if (C.lane == 0) { __hip_atomic_fetch_add(&red[2 * tr], sa, __ATOMIC_RELAXED, __HIP_MEMORY_SCOPE_WORKGROUP); __hip_atomic_fetch_add(&red[2 * tr + 1], sb, __ATOMIC_RELAXED, __HIP_MEMORY_SCOPE_WORKGROUP); } }
    __syncthreads();
    int tl = tid; asm volatile("" : "+v"(tl));
#pragma unroll
    for (int i = 0; i < 16; ++i) { const int idx = tl + 512 * i, tr = idx / N; f32x2v kv = mk2(k0[i] / red[2 * tr], k1[i] / red[2 * tr + 1]);
        if (idx % N == 0) { const float* hb = C.in[I_HB] + (size_t)(o * 2 + n) * 2048 + 2 * (pair0 + tr); kv.x += hb[0]; kv.y += hb[1]; }
        buf[PD(idx)] = kv; }
    __syncthreads();
    fft_fwd<N>(buf, tid);
    f32x4v* KS = (f32x4v*)(C.ws + (T == 256 ? WS_KSP : WS_KSS)) + ((size_t)(o * 2 + n) * 1024 + pair0) * NK;
    const float sc = 1.0f / (float)N;
    for (int idx = tid; idx < NB * NK; idx += 512) { const int tr = idx / NK, k = ks_perm<N>(idx % NK);
        const int pk = tr * N + (int)(__brev((unsigned)k) >> (32 - LOG)), pn = tr * N + (int)(__brev((unsigned)((N - k) & (N - 1))) >> (32 - LOG));
        const f32x2v zk = buf[PD(pk)], zn = buf[PD(pn)];
        KS[idx] = (f32x4v){0.5f * (zk.x + zn.x) * sc, 0.5f * (zk.y - zn.y) * sc, 0.5f * (zk.y + zn.y) * sc, -0.5f * (zk.x - zn.x) * sc}; }
}
DI void phase_hyena_filters(Ctx& C) {
    for (int it = C.vb; it < 4 * 1024 + 4 * 64; it += C.G) {
        if (it < 4096) hyena_filter_item<4096>(C, it >> 11, (it >> 10) & 1, it & 1023);
        else { const int v = it - 4096; hyena_filter_item<256>(C, v >> 7, (v >> 6) & 1, (v & 63) * 16); }
    }
    __syncthreads();
}
template <int T, int NI, int PROBE = 0, bool SH = false> DI void hyena_conv_item(Ctx& C, int o, const int (&seq)[NI], const int (&pair0)[NI]) {
    constexpr int N = 2 * T, NB = 4096 / T, NK = N / 2 + 1;
    LAS f32x2v* buf = (LAS f32x2v*)C.lds; const int tid = C.tid;
    const float* cw = C.in[I_CW] + (size_t)o * 3 * 6144; const float* cb = C.in[I_CB] + (size_t)o * 6144;
    bf16* Y = (bf16*)(C.ws + WS_MIX);
    const float* ZT[NI]; const f32x4v* KS0[NI]; const f32x4v* KS1[NI]; int rowbase[NI];
#pragma unroll
    for (int j = 0; j < NI; ++j) { ZT[j] = (const float*)(C.ws + WS_Z + (T == 256 ? 0 : ZT_S_OFF)) + (size_t)seq[j] * 6144 * T;
        KS0[j] = (const f32x4v*)(C.ws + (T == 256 ? WS_KSP : WS_KSS)) + ((size_t)(o * 2 + 0) * 1024 + pair0[j]) * NK; KS1[j] = KS0[j] + (size_t)1024 * NK;
        rowbase[j] = T == 256 ? seq[j] * 256 : MP + seq[j] * 4096; }
    constexpr int NQ = SH ? 1 : NI;
    float wq[NQ][6][4];
    if constexpr (T == 4096) {
        auto sg = [](float v) { return __builtin_bit_cast(float, __builtin_amdgcn_readfirstlane(__builtin_bit_cast(int, v))); };
#pragma unroll
        for (int j = 0; j < NQ; ++j) {
#pragma unroll
            for (int gq = 0; gq < 6; ++gq) { const int ch = (gq >> 1) * 2048 + 2 * pair0[j] + (gq & 1); wq[j][gq][0] = sg(cw[ch]); wq[j][gq][1] = sg(cw[6144 + ch]); wq[j][gq][2] = sg(cw[2 * 6144 + ch]); wq[j][gq][3] = sg(cb[ch]); }
        }
    }
    auto ld3 = [&](int j, int grp, int jj, int c, int t, float (&z)[3]) __attribute__((always_inline)) { const int ch = grp * 2048 + c + jj; const float* zr = ZT[j] + (size_t)ch * T + t; z[0] = zr[-1]; z[1] = zr[0]; z[2] = zr[1]; };
    auto ap3 = [&](int j, int grp, int jj, int c, int t, const float (&z)[3]) __attribute__((always_inline)) { const int ch = grp * 2048 + c + jj; const float zp = t > 0 ? z[0] : 0.f, zn = t < T - 1 ? z[2] : 0.f;
        if constexpr (T == 4096) { const int jq = SH ? 0 : j; return wq[jq][grp * 2 + jj][0] * zp + wq[jq][grp * 2 + jj][1] * z[1] + wq[jq][grp * 2 + jj][2] * zn + wq[jq][grp * 2 + jj][3]; }
        else return cw[ch] * zp + cw[6144 + ch] * z[1] + cw[2 * 6144 + ch] * zn + cb[ch]; };
    float gz[NI][8][2][3]; constexpr int NPRE = (T == 4096) ? NI : 1;
    float u0[NI][8], u1[NI][8]; f32x2v cv[NI][8];
    int tl = tid; asm volatile("" : "+v"(tl));
#pragma unroll
    for (int j = 0; j < NI; ++j)
#pragma unroll
        for (int i = 0; i < 8; ++i) { const int tr = tl / (N / 16), t = tl % (N / 16) + (N / 16) * i, c = 2 * (pair0[j] + tr);
            float z0[3], z1[3]; ld3(j, 2, 0, c, t, z0); ld3(j, 2, 1, c, t, z1); u0[j][i] = ap3(j, 2, 0, c, t, z0); u1[j][i] = ap3(j, 2, 1, c, t, z1); }
    f32x4v ksr[8];
    if constexpr (SH) {
#pragma unroll
        for (int r = 0; r < 8; ++r) ksr[r] = KS0[0][tl + 512 * r]; }
    fft_fwd_first<N, NI>(buf, tid, u0, u1);
    if constexpr (N == 8192) { int tf = tid; asm volatile("" : "+v"(tf)); fft_fwd_pass<N, 256, NI>(buf, tf); }
    { int tf = tid; asm volatile("" : "+v"(tf)); fft_r32_fwd<NI>(buf, tf); }
    if constexpr (SH) fft_pairmul_pre<N, NI>(buf, ksr, KS0[0], tid); else fft_pairmul<N, NI, SH>(buf, KS0, tid);
    __syncthreads();
    { int tf = tid; asm volatile("" : "+v"(tf)); fft_r32_inv<NI>(buf, tf); }
    if constexpr (N == 8192) { int tf = tid; asm volatile("" : "+v"(tf)); fft_inv_pass<N, 32, NI, false>(buf, tf); }
    tl = tid; asm volatile("" : "+v"(tl));
#pragma unroll
    for (int j = 0; j < NPRE; ++j)
#pragma unroll
        for (int i = 0; i < 8; ++i) { const int tr = tl / (N / 16), t = tl % (N / 16) + (N / 16) * i, c = 2 * (pair0[j] + tr); ld3(j, 0, 0, c, t, gz[j][i][0]); ld3(j, 0, 1, c, t, gz[j][i][1]); }
    fft_inv_last<N, NI>(buf, tid, cv);
#pragma unroll
    for (int j = NPRE; j < NI; ++j)
#pragma unroll
        for (int i = 0; i < 8; ++i) { const int tr = tl / (N / 16), t = tl % (N / 16) + (N / 16) * i, c = 2 * (pair0[j] + tr); ld3(j, 0, 0, c, t, gz[j][i][0]); ld3(j, 0, 1, c, t, gz[j][i][1]); }
#pragma unroll
    for (int j = 0; j < NI; ++j)
#pragma unroll
        for (int i = 0; i < 8; ++i) { const int tr = tl / (N / 16), t = tl % (N / 16) + (N / 16) * i, c = 2 * (pair0[j] + tr);
            u0[j][i] = ap3(j, 0, 0, c, t, gz[j][i][0]) * cv[j][i].x; u1[j][i] = ap3(j, 0, 1, c, t, gz[j][i][1]) * cv[j][i].y; }
    if constexpr (SH) {
#pragma unroll
        for (int r = 0; r < 8; ++r) ksr[r] = KS1[0][tl + 512 * r]; }
    fft_fwd_first<N, NI>(buf, tid, u0, u1);
    if constexpr (N == 8192) { int tf = tid; asm volatile("" : "+v"(tf)); fft_fwd_pass<N, 256, NI>(buf, tf); }
    { int tf = tid; asm volatile("" : "+v"(tf)); fft_r32_fwd<NI>(buf, tf); }
    if constexpr (SH) fft_pairmul_pre<N, NI>(buf, ksr, KS1[0], tid); else fft_pairmul<N, NI, SH>(buf, KS1, tid);
    __syncthreads();
    { int tf = tid; asm volatile("" : "+v"(tf)); fft_r32_inv<NI>(buf, tf); }
    if constexpr (N == 8192) { int tf = tid; asm volatile("" : "+v"(tf)); fft_inv_pass<N, 32, NI, false>(buf, tf); }
    tl = tid; asm volatile("" : "+v"(tl));
#pragma unroll
    for (int j = 0; j < NPRE; ++j)
#pragma unroll
        for (int i = 0; i < 8; ++i) { const int tr = tl / (N / 16), t = tl % (N / 16) + (N / 16) * i, c = 2 * (pair0[j] + tr); ld3(j, 1, 0, c, t, gz[j][i][0]); ld3(j, 1, 1, c, t, gz[j][i][1]); }
    fft_inv_last<N, NI>(buf, tid, cv);
#pragma unroll
    for (int j = NPRE; j < NI; ++j)
#pragma unroll
        for (int i = 0; i < 8; ++i) { const int tr = tl / (N / 16), t = tl % (N / 16) + (N / 16) * i, c = 2 * (pair0[j] + tr); ld3(j, 1, 0, c, t, gz[j][i][0]); ld3(j, 1, 1, c, t, gz[j][i][1]); }
#pragma unroll
    for (int j = 0; j < NI; ++j)
#pragma unroll
        for (int i = 0; i < 8; ++i) { const int tr = tl / (N / 16), t = tl % (N / 16) + (N / 16) * i, c = 2 * (pair0[j] + tr);
            const float y0 = ap3(j, 1, 0, c, t, gz[j][i][0]) * cv[j][i].x, y1 = ap3(j, 1, 1, c, t, gz[j][i][1]) * cv[j][i].y;
            *(unsigned*)(Y + (size_t)(rowbase[j] + t) * 2048 + c) = pk2(y0, y1); }
}
template <int PROBE = 0> DI void phase_hyena_conv(Ctx& C, int o) {
    if (C.G == 256) {
        for (int it = C.vb; it < 1024 + 512; it += C.G) {
            if (it < 1024) { const int sq[2] = {0, 1}, pr[2] = {it, it}; hyena_conv_item<4096, 2, PROBE, true>(C, o, sq, pr); }
            else { const int v = it - 1024; const int sq[2] = {2 * (v >> 6), 2 * (v >> 6) + 1}, pr[2] = {(v & 63) * 16, (v & 63) * 16}; hyena_conv_item<256, 2, PROBE, true>(C, o, sq, pr); }
        }
    } else {
        for (int it = C.vb; it < 2048 + 1024; it += C.G) {
            if (it < 2048) { const int sq[1] = {it >> 10}, pr[1] = {it & 1023}; hyena_conv_item<4096, 1, PROBE>(C, o, sq, pr); }
            else { const int v = it - 2048; const int sq[1] = {v >> 6}, pr[1] = {(v & 63) * 16}; hyena_conv_item<256, 1, PROBE>(C, o, sq, pr); }
        }
    }
    __syncthreads();
}

#ifndef ONE_LAUNCH
#define ONE_LAUNCH 1
#endif
#ifndef SKIP_FFN
#define SKIP_FFN 0
#endif
#ifndef SKIP_EVEN
#define SKIP_EVEN 0
#endif
#ifndef SKIP_ODD
#define SKIP_ODD 0
#endif
#ifndef DUP_FFN
#define DUP_FFN 0
#endif
#ifndef DUP_EVEN
#define DUP_EVEN 0
#endif
#ifndef DUP_ODD
#define DUP_ODD 0
#endif
#ifndef DUP_PRO
#define DUP_PRO 0
#endif
#ifndef DUP_E
#define DUP_E 0
#endif
#ifndef DUP_O
#define DUP_O 0
#endif
constexpr int NPH_MAX = 96;
template <int V> struct IntC { static constexpr int value = V; };
DI void launder(Ctx& C, const KArgs& a) { const int t = lane_id_v(); C.lane = t; C.tid = C.wave * 64 + t;
    int z = 0; asm volatile("" : "+v"(z)); const int zs = __builtin_amdgcn_readfirstlane(z);
    C.ws = a.ws + zs; C.in = a.in + zs; C.out = a.out + zs;
    C.zs = zs; C.G = (int)gridDim.x + zs; C.bx = (int)blockIdx.x + zs; C.gw = C.bx * 8 + C.wave; C.NGW = C.G * 8; C.vb = (C.G % 8 == 0) ? (C.bx % 8) * (C.G / 8) + C.bx / 8 : C.bx; }
__global__ void __launch_bounds__(512, 2) mega_fwd(KArgs args) {
    extern __shared__ __attribute__((aligned(16))) unsigned char lds_raw[];
    Ctx C;
    C.lds = (LAS unsigned char*)lds_raw; C.ws = args.ws; C.in = args.in; C.out = args.out;
    C.wave = __builtin_amdgcn_readfirstlane((int)threadIdx.x >> 6); C.lane = lane_id_v(); C.tid = C.wave * 64 + C.lane;
    C.zs = 0; C.G = 0; C.bx = 0; C.gw = 0; C.NGW = 0; C.vb = 0;
    for (int u = C.tid; u < (LDS_BYTES - LDS_CTL) / 4; u += 512) ((LAS unsigned*)(C.lds + LDS_CTL))[u] = 0u;
    __syncthreads();
    (void)xcd_barrier_post((unsigned*)(args.ws + WS_CTL) + 4096, (volatile LAS unsigned*)(C.lds + LDS_CTL + 64), C.tid);
#if ONE_LAUNCH
    constexpr int lo = 0, hi = 1 << 20; int ph = 0;
#else
    const int lo = args.ph_lo, hi = args.ph_hi; int ph = 0;
#endif
#define PH_IF if (ph >= lo && ph < hi) if (launder(C, args), true)
#define PH_NEXT do { const bool both_ = (ph >= lo) && (ph + 1 < hi); ++ph; if (both_) { launder(C, args); XcdBarrier b_; b_.bar = (unsigned*)(C.ws + WS_CTL) + 4096; b_.x = xb_xcc_id() + (unsigned)C.zs; b_.st = (volatile LAS unsigned*)(C.lds + LDS_CTL + 64); xcd_barrier(b_, C.tid); } } while (0)
#define ring C.lds
#define MOD ((const float*)(C.ws + WS_MOD))
#define X ((float*)(C.ws + WS_X))

#if DUP_PRO == 1
    PH_IF { phase_prologue(C); } PH_NEXT;
#endif
    PH_IF {
#ifndef NO_PROLOGUE
 phase_prologue(C);
#endif
 } PH_NEXT;
    PH_IF { phase_mod_reduce(C);
        pg8::Gemm g{(const bf16*)(C.ws + WS_W3T), (const bf16*)(C.ws + WS_H2), 16384, 4352, 256}; pg8::StaticOrder S; S.init(16384, 4352, C.G, C.bx);
        pg8::EpiBf16Plain E{(bf16*)(C.ws + WS_SCAN), 4352};
        pg8::gemm_phase<pg8::EpiBf16Plain, pg8::StaticOrder, false, false>(ring, g, S, E, C.wave); } PH_NEXT;
#if DUP_PRO == 2
    PH_IF { phase_hyena_filters(C); } PH_NEXT;
#endif
    PH_IF {
#ifndef NO_HYENA
 phase_hyena_filters(C);
#endif
 } PH_NEXT;

#define FFN_BLOCK(l, fi, s, cf) do { \
    if (!SKIP_FFN) { \
    PH_IF { phase_norm_mod(C, C.in[I_NG] + ((l) * 3 + (s)) * 2048, MOD + (size_t)(l) * MODL, (s)); } PH_NEXT; \
    PH_IF { pg8::Gemm g{(const bf16*)(C.ws + WS_H), (const bf16*)(C.ws + WS_W1T) + (size_t)((l) * 2 + (fi)) * NFF1 * 2048, MT, NFF1, 2048}; pg8::StaticOrder S; S.init(MT, NFF1, C.G, C.bx); \
        pg8::EpiSwiGLU E{(bf16*)(C.ws + WS_ACT), DFF}; pg8::gemm_phase<pg8::EpiSwiGLU, pg8::StaticOrder, false, true>(ring, g, S, E, C.wave); \
        { const int nf_ = (l) * 2 + (fi) + 1, idle0_ = (MT / 256) * (NFF1 / 256) % C.G; if ((cf) != 0.0f && nf_ < 8 && C.bx >= idle0_) { launder(C, args); \
            tr_matrix<0>(C, C.in[I_WFO] + (size_t)nf_ * DFF * 2048, 2048, DFF, (bf16*)(C.ws + WS_W2T) + (size_t)nf_ * 2048 * DFF, 2048, 2048, (C.bx - idle0_) * 8 + C.wave, (C.G - idle0_) * 8); } } } PH_NEXT; \
    PH_IF { pg8::Gemm g{(const bf16*)(C.ws + WS_ACT), (const bf16*)(C.ws + WS_W2T) + (size_t)((l) * 2 + (fi)) * 2048 * DFF, MT, 2048, DFF}; \
        pg8::EpiRes E{X, MOD + (size_t)(l) * MODL + (3 * (s) + 2) * 2048, (cf)}; \
        { pg8::PairOrder<1> S; S.init(MT, 2048, DFF, C.G, C.bx, (float*)(C.ws + WS_Z), (unsigned*)(C.ws + WS_CTL) + 16384, (DUP_FFN ? 8u * (unsigned)(2 * ((l) * 2 + (fi)) + ((cf) != 0.0f ? 2 : 1)) : 8u * (unsigned)((l) * 2 + (fi) + 1))); \
          pg8::gemm_phase<pg8::EpiRes, pg8::PairOrder<1>, false, true>(ring, g, S, E, C.wave); } \
        { launder(C, args); pg8::PairOrder<2> S; S.init(MT, 2048, DFF, C.G, C.bx, (float*)(C.ws + WS_Z), (unsigned*)(C.ws + WS_CTL) + 16384, (DUP_FFN ? 8u * (unsigned)(2 * ((l) * 2 + (fi)) + ((cf) != 0.0f ? 2 : 1)) : 8u * (unsigned)((l) * 2 + (fi) + 1))); \
          pg8::Gemm g2{(const bf16*)(C.ws + WS_ACT), (const bf16*)(C.ws + WS_W2T) + (size_t)((l) * 2 + (fi)) * 2048 * DFF, MT, 2048, DFF}; pg8::EpiRes E2{X, MOD + (size_t)(l) * MODL + (3 * (s) + 2) * 2048, (cf)}; \
          pg8::gemm_phase<pg8::EpiRes, pg8::PairOrder<2>, true, true>(ring, g2, S, E2, C.wave); } \
        { const int nf_ = (l) * 2 + (fi) + 1; if ((cf) != 0.0f && nf_ < 8 && !(C.G >= 235 && !SKIP_EVEN && ((l) & 1) == 0 && (fi) == 0) && !(C.G == 256 && !SKIP_EVEN && ((l) & 1) == 0 && (fi) == 1)) { launder(C, args); \
            tr_matrix<1>(C, C.in[I_WFI] + (size_t)nf_ * 2048 * NFF1, NFF1, 2048, (bf16*)(C.ws + WS_W1T) + (size_t)nf_ * NFF1 * 2048, NFF1, NFF1, C.gw, C.NGW); } } } PH_NEXT; \
    } } while (0)

    auto layer_pair = [&](auto PC) __attribute__((always_inline)) {
        constexpr int p = decltype(PC)::value; constexpr int le = 2 * p, lod = 2 * p + 1;
#if DUP_FFN
        FFN_BLOCK(le, 0, 0, 0.0f);
#endif
        FFN_BLOCK(le, 0, 0, 0.5f);
        auto even_mix = [&](float cf, int qslot) __attribute__((always_inline)) {
            const int e = p;
            PH_IF { phase_norm_mod(C, C.in[I_NG] + (le * 3 + 1) * 2048, MOD + (size_t)le * MODL, 1); } PH_NEXT;
            PH_IF { pg8::Gemm g{(const bf16*)(C.ws + WS_H), (const bf16*)(C.ws + WS_WINE) + (size_t)e * ZE_P * 2048, MT, ZE_P, 2048}; pg8::StaticOrder S; S.init(MT, ZE_P, C.G, C.bx);
                pg8::EpiF32 E{(float*)(C.ws + WS_Z), ZE_P}; pg8::gemm_phase<pg8::EpiF32, pg8::StaticOrder, true, true>(ring, g, S, E, C.wave);
                { const int nf_ = le * 2 + 2, idle0_ = (MT / 256) * (ZE_P / 256) % C.G;
                  if (cf != 0.0f && C.G == 256 && C.bx >= idle0_) { launder(C, args);
                    tr_matrix<1>(C, C.in[I_WFI] + (size_t)nf_ * 2048 * NFF1, NFF1, 2048, (bf16*)(C.ws + WS_W1T) + (size_t)nf_ * NFF1 * 2048, NFF1, NFF1, (C.bx - idle0_) * 8 + C.wave, (C.G - idle0_) * 8); } } } PH_NEXT;
#if DUP_E == 5
            PH_IF { phase_even_prep(C, e); } PH_NEXT;
#endif
            PH_IF { phase_even_prep(C, e); } PH_NEXT;
#if DUP_E == 7
            PH_IF {
                { pg8::Gemm g{(const bf16*)(C.ws + WS_LA), (const bf16*)(C.ws + WS_WLORA) + (size_t)e * 5120 * 384, MT, 5120, 384}; pg8::StaticOrder S; S.init(MT, 5120, C.G, C.bx);
                  pg8::EpiLora E{C.ws, C.in[I_W0] + e * 2048, C.in[I_A0] + e * 2048, C.in[I_KA] + e * 1024, WS_SCAN + (size_t)e * SCAN_BYTES, WS_KBUF, WS_GB};
                  pg8::gemm_phase<pg8::EpiLora, pg8::StaticOrder, true, true>(ring, g, S, E, C.wave); }
                launder(C, args);
                { pg8::Gemm g{(const bf16*)(C.ws + WS_CQ), (const bf16*)(C.ws + WS_WQ) + (size_t)e * 1536 * 512, MT, 1536, 512}; pg8::StaticOrder S; S.init(MT, 1536, C.G, C.bx);
                  pg8::EpiQ E{(bf16*)(C.ws + WS_Q), (const float*)(C.ws + WS_ROPE), 0.07216878364870322f * 1.4426950408889634f};
                  pg8::gemm_phase<pg8::EpiQ, pg8::StaticOrder, true, true>(ring, g, S, E, C.wave); }
                launder(C, args);
                { pg8::Gemm g{(const bf16*)(C.ws + WS_CKV), (const bf16*)(C.ws + WS_WKN) + (size_t)e * 1024 * 256, MKV, 1024, 256}; pg8::StaticOrder S; S.init(MKV, 1024, C.G, C.bx);
                  pg8::EpiBf16Plain E{(bf16*)(C.ws + WS_KN), 1024};
                  pg8::gemm_phase<pg8::EpiBf16Plain, pg8::StaticOrder, false, false>(ring, g, S, E, C.wave); }
                launder(C, args);
                { pg8::Gemm g{(const bf16*)(C.ws + WS_WV) + (size_t)e * 1024 * 256, (const bf16*)(C.ws + WS_CKV), 1024, MKV, 256}; pg8::StaticOrder S; S.init(1024, MKV, C.G, C.bx);
                  pg8::EpiVT E{(bf16*)(C.ws + WS_VT), VT_S_OFF / 2};
                  pg8::gemm_phase<pg8::EpiVT, pg8::StaticOrder, false, false>(ring, g, S, E, C.wave); }
            } PH_NEXT;
#endif
            PH_IF {
                { pg8::Gemm g{(const bf16*)(C.ws + WS_LA), (const bf16*)(C.ws + WS_WLORA) + (size_t)e * 5120 * 384, MT, 5120, 384}; pg8::StaticOrder S; S.init(MT, 5120, C.G, C.bx);
                  pg8::EpiLora E{C.ws, C.in[I_W0] + e * 2048, C.in[I_A0] + e * 2048, C.in[I_KA] + e * 1024, WS_SCAN + (size_t)e * SCAN_BYTES, WS_KBUF, WS_GB};
                  pg8::gemm_phase<pg8::EpiLora, pg8::StaticOrder, true, true>(ring, g, S, E, C.wave); }
                launder(C, args);
                { pg8::Gemm g{(const bf16*)(C.ws + WS_CQ), (const bf16*)(C.ws + WS_WQ) + (size_t)e * 1536 * 512, MT, 1536, 512}; pg8::StaticOrder S; S.init(MT, 1536, C.G, (C.bx + 64) % C.G);
                  pg8::EpiQ E{(bf16*)(C.ws + WS_Q), (const float*)(C.ws + WS_ROPE), 0.07216878364870322f * 1.4426950408889634f};
                  pg8::gemm_phase<pg8::EpiQ, pg8::StaticOrder, true, true>(ring, g, S, E, C.wave); }
                launder(C, args);
                { pg8::Gemm g{(const bf16*)(C.ws + WS_CKV), (const bf16*)(C.ws + WS_WKN) + (size_t)e * 1024 * 256, MKV, 1024, 256}; pg8::StaticOrder S; S.init(MKV, 1024, C.G, (C.bx + 32) % C.G);
                  pg8::EpiBf16Plain E{(bf16*)(C.ws + WS_KN), 1024};
                  pg8::gemm_phase<pg8::EpiBf16Plain, pg8::StaticOrder, false, false>(ring, g, S, E, C.wave); }
                launder(C, args);
                { pg8::Gemm g{(const bf16*)(C.ws + WS_WV) + (size_t)e * 1024 * 256, (const bf16*)(C.ws + WS_CKV), 1024, MKV, 256}; pg8::StaticOrder S; S.init(1024, MKV, C.G, (C.bx + 88) % C.G);
                  pg8::EpiVT E{(bf16*)(C.ws + WS_VT), VT_S_OFF / 2};
                  pg8::gemm_phase<pg8::EpiVT, pg8::StaticOrder, false, false>(ring, g, S, E, C.wave); }
            } PH_NEXT;
#if DUP_E == 1
            PH_IF { phase_scan1(C, e, 2); } PH_NEXT;
#endif
            PH_IF {
#ifndef NO_SCAN
 phase_scan1(C, e, qslot);
#endif
 } PH_NEXT;
#if DUP_E == 2
            PH_IF { phase_scan_carry(C, e, 8); __syncthreads(); } PH_NEXT;
#endif
            PH_IF { const bool host_ = cf != 0.0f && C.G >= 235; phase_scan_carry(C, e, host_ ? 3 : 8);
                if (host_ && C.bx >= 64 && C.wave >= 3) { launder(C, args); const int nf_ = le * 2 + 1;
                    tr_matrix<1>(C, C.in[I_WFI] + (size_t)nf_ * 2048 * NFF1, NFF1, 2048, (bf16*)(C.ws + WS_W1T) + (size_t)nf_ * NFF1 * 2048, NFF1, NFF1, (C.bx - 64) * 5 + C.wave - 3, (C.G - 64) * 5); }
                __syncthreads(); } PH_NEXT;
#if DUP_E == 3
            PH_IF { phase_scan3(C, e); } PH_NEXT;
#endif
#if DUP_E == 4
            PH_IF { phase_attention(C); } PH_NEXT;
#endif
            PH_IF {
#ifndef NO_SCAN
 phase_scan3(C, e);
#endif
#ifndef NO_ATTN
 phase_attention(C);
#endif
 } PH_NEXT;
#if DUP_E == 6
            PH_IF { phase_rwkv_post(C, e); } PH_NEXT;
#endif
            PH_IF { phase_rwkv_post(C, e); } PH_NEXT;
            PH_IF { pg8::Gemm g{(const bf16*)(C.ws + WS_MIX), (const bf16*)(C.ws + WS_WOUTE) + (size_t)e * 2048 * 2048, MT, 2048, 2048}; pg8::StaticOrder S; S.init(MT, 2048, C.G, C.bx);
                pg8::EpiRes E{X, MOD + (size_t)le * MODL + (3 * 1 + 2) * 2048, cf}; pg8::gemm_phase<pg8::EpiRes, pg8::StaticOrder, false, true>(ring, g, S, E, C.wave); } PH_NEXT;
        };
#if DUP_EVEN
        even_mix(0.0f, 1);
#endif
        if (!SKIP_EVEN) even_mix(1.0f, 0);
#if DUP_FFN
        FFN_BLOCK(le, 1, 2, 0.0f);
#endif
        FFN_BLOCK(le, 1, 2, 0.5f);
#if DUP_FFN
        FFN_BLOCK(lod, 0, 0, 0.0f);
#endif
        FFN_BLOCK(lod, 0, 0, 0.5f);
        auto odd_mix = [&](float cf) __attribute__((always_inline)) {
            const int o = p;
            PH_IF { phase_norm_mod(C, C.in[I_NG] + (lod * 3 + 1) * 2048, MOD + (size_t)lod * MODL, 1); } PH_NEXT;
            PH_IF { pg8::Gemm g{(const bf16*)(C.ws + WS_WINO) + (size_t)o * 6144 * 2048, (const bf16*)(C.ws + WS_H), 6144, MT, 2048}; pg8::StaticOrder S; S.init(6144, MT, C.G, C.bx);
                pg8::EpiZT E{(float*)(C.ws + WS_Z), (float*)(C.ws + WS_Z + ZT_S_OFF)}; pg8::gemm_phase<pg8::EpiZT, pg8::StaticOrder, false, true>(ring, g, S, E, C.wave); } PH_NEXT;
#if DUP_O == 1
            PH_IF { phase_hyena_conv(C, o); } PH_NEXT;
#endif
#if DUP_O == 2
            PH_IF { phase_hyena_conv<1>(C, o); } PH_NEXT;
#endif
            PH_IF {
#ifndef NO_HYENA
 phase_hyena_conv(C, o);
#endif
 } PH_NEXT;
            PH_IF { pg8::Gemm g{(const bf16*)(C.ws + WS_MIX), (const bf16*)(C.ws + WS_WOUTO) + (size_t)o * 2048 * 2048, MT, 2048, 2048}; pg8::StaticOrder S; S.init(MT, 2048, C.G, C.bx);
                pg8::EpiRes E{X, MOD + (size_t)lod * MODL + (3 * 1 + 2) * 2048, cf}; pg8::gemm_phase<pg8::EpiRes, pg8::StaticOrder, false, true>(ring, g, S, E, C.wave); } PH_NEXT;
        };
#if DUP_ODD
        odd_mix(0.0f);
#endif
        if (!SKIP_ODD) odd_mix(1.0f);
#if DUP_FFN
        FFN_BLOCK(lod, 1, 2, 0.0f);
#endif
        FFN_BLOCK(lod, 1, 2, 0.5f);
    };
    layer_pair(IntC<0>{}); layer_pair(IntC<1>{});
    PH_IF { phase_final_norm(C); } PH_NEXT;
#undef MOD
#undef X
#undef ring
}

extern "C" void kernel_launch(void* const* d_in, const int* in_sizes, int n_in, void* d_out, int out_size, void* d_ws, size_t ws_size, hipStream_t stream) {
    static int grid = 0;
    if (grid == 0) {
        if (n_in != 42 || (size_t)out_size != OUT_END || ws_size < WS_END) { fprintf(stderr, "kernel_launch: unexpected sizes n_in %d out %d ws %zu (need %zu)\n", n_in, out_size, ws_size, (size_t)WS_END); grid = -1; return; }
        int dev = 0, cus = 0, per_cu = 0;
        if (hipGetDevice(&dev) != hipSuccess || hipDeviceGetAttribute(&cus, hipDeviceAttributeMultiprocessorCount, dev) != hipSuccess) { grid = -1; return; }
        if (hipFuncSetAttribute((const void*)mega_fwd, hipFuncAttributeMaxDynamicSharedMemorySize, LDS_BYTES) != hipSuccess) { fprintf(stderr, "kernel_launch: hipFuncSetAttribute failed\n"); grid = -1; return; }
        if (hipOccupancyMaxActiveBlocksPerMultiprocessor(&per_cu, (const void*)mega_fwd, 512, LDS_BYTES) != hipSuccess || per_cu < 1) fprintf(stderr, "kernel_launch: occupancy query says %d\n", per_cu);
        (void)hipGetLastError();
        grid = cus;
    }
    if (grid < 0) return;
    (void)hipMemsetAsync((char*)d_ws + WS_CTL, 0, CTL_ZERO_BYTES, stream);
    KArgs a{};
    for (int i = 0; i < 42; ++i) a.in[i] = (const float*)d_in[i];
    a.out = (float*)d_out; a.ws = (unsigned char*)d_ws;
#if ONE_LAUNCH
    a.ph_lo = 0; a.ph_hi = 1 << 20;
    hipLaunchKernelGGL(mega_fwd, dim3(grid), dim3(512), LDS_BYTES, stream, a);
#else
    for (int i = 0; i < NPH_MAX; ++i) { a.ph_lo = i; a.ph_hi = i + 1; hipLaunchKernelGGL(mega_fwd, dim3(grid), dim3(512), LDS_BYTES, stream, a); }
#endif
}
```

```cpp
#include <hip/hip_runtime.h>
#include <cstdio>
#include <cstdint>
#include <utility>
#define DI __device__ __forceinline__
#define GAS __attribute__((address_space(1)))
#define LAS __attribute__((address_space(3)))
#define CAS __attribute__((address_space(4)))
typedef unsigned short bf16;
typedef unsigned v4u __attribute__((ext_vector_type(4)));
typedef unsigned v2u __attribute__((ext_vector_type(2)));
typedef float f32x4v __attribute__((ext_vector_type(4)));
typedef float f32x2v __attribute__((ext_vector_type(2)));
typedef float f32x16v __attribute__((ext_vector_type(16)));
typedef short s16x8v __attribute__((ext_vector_type(8)));
typedef short s16x4v __attribute__((ext_vector_type(4)));

constexpr int D = 2048, MP = 4096, MS = 8192, MT = 12288, MKV = 12800;
constexpr int DFF = 5632, NFF1 = 11264;
constexpr int ZE_N = 4192, ZE_P = 4352;
constexpr int SCAN_P = 9 * 1024;
constexpr int NCH = 32, CHL = 4096 / NCH;
constexpr int MODL = 3 * 18432;

DI int lane_id_v() { int l; asm volatile("v_mbcnt_lo_u32_b32 %0, -1, 0\n\tv_mbcnt_hi_u32_b32 %0, -1, %0" : "=v"(l)); return l; }
DI unsigned f2bf(float f) { unsigned u = __builtin_bit_cast(unsigned, f); return (u + 0x7fffu + ((u >> 16) & 1u)) >> 16; }
DI unsigned pk2(float lo, float hi) { unsigned r; asm("v_cvt_pk_bf16_f32 %0, %1, %2" : "=v"(r) : "v"(lo), "v"(hi)); return r; }
DI float bf2f(unsigned short b) { return __builtin_bit_cast(float, ((unsigned)b) << 16); }
template <int CTRL> DI float dpp_f(float v) { return __builtin_bit_cast(float, __builtin_amdgcn_update_dpp(0, __builtin_bit_cast(int, v), CTRL, 0xf, 0xf, true)); }
DI float shfl_idx(float v, int src) { return __builtin_bit_cast(float, __builtin_amdgcn_ds_bpermute(src << 2, __builtin_bit_cast(int, v))); }
DI float wave_sum(float v) {
    v += dpp_f<0xB1>(v); v += dpp_f<0x4E>(v); v += dpp_f<0x141>(v); v += dpp_f<0x140>(v);
    v += __builtin_bit_cast(float, __builtin_amdgcn_ds_swizzle(__builtin_bit_cast(int, v), 0x401F));
    return __builtin_bit_cast(float, __builtin_amdgcn_readlane(__builtin_bit_cast(int, v), 0)) + __builtin_bit_cast(float, __builtin_amdgcn_readlane(__builtin_bit_cast(int, v), 32));
}
DI float sigmoid_f(float x) { return __builtin_amdgcn_rcpf(1.f + __expf(-x)); }
DI float silu_f(float x) { return x * sigmoid_f(x); }
DI int scan_perm(int j) { return 4 * (j & 15) + (j >> 4); }
DI int row_mod_j(int row) { return row < MP ? 0 : 1 + ((row - MP) >> 12); }
namespace pg8 {
#define PG8_LAS __attribute__((address_space(3)))
typedef unsigned short bf16_t;
typedef short bf16x8 __attribute__((ext_vector_type(8)));
typedef float f32x4 __attribute__((ext_vector_type(4)));
typedef unsigned u32x4 __attribute__((ext_vector_type(4)));
constexpr int BM = 256, BK = 64, HALF = 128, HTB = HALF * BK * 2  , STAGE_BYTES = 8 * HTB, NXCD = 8, WGM = 8;

__host__ __device__ __forceinline__ int lds_byte(int r, int c) { const int st = (r >> 4) * 2 + (c >> 5), rr = r & 15, cc = c & 31, ob = rr * 64 + cc * 2; return st * 1024 + (ob ^ (((ob >> 9) & 1) << 5)); }
__host__ __device__ __forceinline__ void stage_rc(int b, int& R, int& C) { const int st = b / 1024, sb = b % 1024, swz = sb ^ (((sb >> 9) & 1) << 5); R = (st >> 1) * 16 + swz / 64; C = (st & 1) * 32 + (swz % 64) / 2; }
__host__ __device__ __forceinline__ int perm32(int rho) { const int n = rho >> 4, i = rho & 15; return 8 * (i >> 2) + 4 * n + (i & 3); }

struct Unit { int pm, pn; int kt0, nkt, mode, slot; };
struct Gemm { const bf16_t* A; const bf16_t* Bt; int M, N, K; };
struct StaticOrder {
    static constexpr int SPLITK = 0;
    int nM, nN, nwg, G, c;
    __host__ __device__ __forceinline__ void init(int M, int N, int G_, int c_) { nM = M / BM; nN = N / BM; nwg = nM * nN; G = G_; c = c_; }
    __host__ __device__ __forceinline__ bool next(int i, Unit& u) const {
        const long L = (long)i * G + c; if (L >= nwg) return false;
        int wgid = (int)L; { const int q = nwg / NXCD, r = nwg % NXCD, xcd = wgid % NXCD, off = wgid / NXCD; wgid = (xcd < r ? xcd * (q + 1) : r * (q + 1) + (xcd - r) * q) + off; }
        const int nig = WGM * nN, gid = wgid / nig, fm = gid * WGM, gsz = (nM - fm) < WGM ? (nM - fm) : WGM;
        u.pm = fm + ((wgid % nig) % gsz); u.pn = (wgid % nig) / gsz; u.kt0 = 0; u.nkt = 0; u.mode = 0; u.slot = 0; return true;
    }
    __device__ __forceinline__ void a_ready(const Unit&) const {}
    __device__ __forceinline__ void done(const Unit&) const {}
    __device__ __forceinline__ void publish(const f32x4 (&)[2][2][4][2], const Unit&, int, int) const {}
    __device__ __forceinline__ void consume(f32x4 (&)[2][2][4][2], const Unit&, int, int) const {}
};

template <int PART> struct PairOrder {
    static constexpr int SPLITK = PART;
    StaticOrder so; int R, rem, nt; bool paired;
    float* scratch; unsigned* flags; unsigned target;
    __device__ __forceinline__ void init(int M, int N, int K, int G_, int c_, float* scr, unsigned* fl, unsigned tgt) { so.init(M, N, G_, 0); so.c = 0; so.G = 1; R = so.nwg / G_; rem = so.nwg % G_; nt = K / BK;
        paired = (2 * rem == G_) && ((nt / 2) % 2 == 0); c = c_; G = G_; scratch = scr; flags = fl; target = tgt; }
    int c, G;
    __device__ __forceinline__ bool tile(int t, Unit& u) const { return so.next(t, u); }
    __device__ __forceinline__ bool next(int i, Unit& u) const {
        int t = -1, kt0 = 0, nk = nt, mode = 0, slot = 0;
        if (!paired) { if (PART == 1) { const long L = (long)i * G + c; if (L < so.nwg) t = (int)L; } }
        else if (PART == 1) {
            if (c < rem) { if (i == 0) { t = R * G + c; nk = nt / 2; mode = 1; slot = c; } else if (i <= R) t = (i - 1) * G + c; }
            else if (i < R) t = i * G + c;
        }
        else if (c >= rem && i == 0) { t = R * G + (c - rem); kt0 = nt / 2; nk = nt - nt / 2; mode = 2; slot = c - rem; }
        if (t < 0) return false;
        tile(t, u); u.kt0 = kt0; u.nkt = nk; u.mode = mode; u.slot = slot; return true;
    }
    __device__ __forceinline__ void a_ready(const Unit&) const {}
    __device__ __forceinline__ void done(const Unit&) const {}
    __device__ __forceinline__ void publish(const f32x4 (&acc)[2][2][4][2], const Unit& u, int wid, int lane) const {
        const __amdgpu_buffer_rsrc_t rs = __builtin_amdgcn_make_buffer_rsrc((void*)scratch, 0, 0x7fffffff, 0x00020000);
        const int so_ = __builtin_amdgcn_readfirstlane(u.slot * 262144 + wid * 32768), vo = lane * 16;
#pragma unroll
        for (int ai = 0; ai < 2; ++ai)
#pragma unroll
            for (int bj = 0; bj < 2; ++bj)
#pragma unroll
                for (int m = 0; m < 4; ++m)
#pragma unroll
                    for (int n = 0; n < 2; ++n) { const int r = ((ai * 2 + bj) * 4 + m) * 2 + n;
                        __builtin_amdgcn_raw_buffer_store_b128(__builtin_bit_cast(u32x4, acc[ai][bj][m][n]), rs, vo, so_ + r * 1024, 16); }
        asm volatile("s_waitcnt vmcnt(0)" ::: "memory");
        if (lane == 0) __hip_atomic_fetch_add(flags + 64 * u.slot, 1u, __ATOMIC_RELAXED, __HIP_MEMORY_SCOPE_AGENT);
    }
    __device__ __forceinline__ void consume(f32x4 (&acc)[2][2][4][2], const Unit& u, int wid, int lane) const {
        unsigned spins = 0;
        while ((unsigned)__builtin_amdgcn_readfirstlane((int)__hip_atomic_load(flags + 64 * u.slot, __ATOMIC_RELAXED, __HIP_MEMORY_SCOPE_AGENT)) < target) { __builtin_amdgcn_s_sleep(2); if (++spins > (1u << 22)) break; }
        __builtin_amdgcn_fence(__ATOMIC_ACQUIRE, "agent");
        asm volatile("s_waitcnt vmcnt(0)" ::: "memory");
        const __amdgpu_buffer_rsrc_t rs = __builtin_amdgcn_make_buffer_rsrc((void*)scratch, 0, 0x7fffffff, 0x00020000);
        const int so_ = __builtin_amdgcn_readfirstlane(u.slot * 262144 + wid * 32768), vo = lane * 16;
#pragma unroll
        for (int ai = 0; ai < 2; ++ai)
#pragma unroll
            for (int bj = 0; bj < 2; ++bj)
#pragma unroll
                for (int mh = 0; mh < 2; ++mh) {
                    f32x4 t[4];
#pragma unroll
                    for (int q = 0; q < 4; ++q) { const int m = mh * 2 + (q >> 1), n = q & 1; const int r = ((ai * 2 + bj) * 4 + m) * 2 + n; t[q] = __builtin_bit_cast(f32x4, __builtin_amdgcn_raw_buffer_load_b128(rs, vo, so_ + r * 1024, 16)); }
#pragma unroll
                    for (int q = 0; q < 4; ++q) { const int m = mh * 2 + (q >> 1), n = q & 1; acc[ai][bj][m][n] += t[q]; }
                    asm volatile("" ::: "memory");
                }
    }
};
__device__ __forceinline__ unsigned cvt_pk_bf16(float lo, float hi) { unsigned r; asm volatile("v_cvt_pk_bf16_f32 %0, %1, %2" : "=v"(r) : "v"(lo), "v"(hi)); return r; }
typedef float f32x2 __attribute__((ext_vector_type(2)));
#define EPI_LOOP_AIM _Pragma("unroll") for (int ai = 0; ai < 2; ++ai) _Pragma("unroll") for (int m = 0; m < 4; ++m)
#define EPI_LOOP_BJN _Pragma("unroll") for (int bj = 0; bj < 2; ++bj) _Pragma("unroll") for (int n = 0; n < 2; ++n)
struct EpiF32 {
    static constexpr bool PERM = false, AFTER_DRAIN = false;
    float* C; int ldc;
    __device__ __forceinline__ void operator()(const f32x4 (&acc)[2][2][4][2], const Unit& u, int wr, int wc, int fr, int fq) const {
        const int row0 = u.pm * BM + wr * 64 + fr, col0 = u.pn * BM + wc * 32 + 4 * fq;
        EPI_LOOP_AIM { float* rowp = C + (size_t)(row0 + ai * HALF + m * 16) * ldc + col0;
            EPI_LOOP_BJN *(f32x4*)(rowp + bj * HALF + n * 16) = acc[ai][bj][m][n]; }
    }
};
struct EpiBf16Plain {
    static constexpr bool PERM = true, AFTER_DRAIN = false;
    bf16_t* O; int ldc;
    __device__ __forceinline__ void operator()(const f32x4 (&acc)[2][2][4][2], const Unit& u, int wr, int wc, int fr, int fq) const {
        const int row0 = u.pm * BM + wr * 64 + fr, col0 = u.pn * BM + wc * 32 + 8 * fq;
        EPI_LOOP_AIM { bf16_t* rowp = O + (size_t)(row0 + ai * HALF + m * 16) * ldc + col0;
#pragma unroll
            for (int bj = 0; bj < 2; ++bj) { const f32x4 v0 = acc[ai][bj][m][0], v1 = acc[ai][bj][m][1];
                u32x4 w; w.x = cvt_pk_bf16(v0[0], v0[1]); w.y = cvt_pk_bf16(v0[2], v0[3]); w.z = cvt_pk_bf16(v1[0], v1[1]); w.w = cvt_pk_bf16(v1[2], v1[3]);
                *(u32x4*)(rowp + bj * HALF) = w; } }
    }
};
struct EpiSwiGLU {
    static constexpr bool PERM = true, AFTER_DRAIN = false;
    bf16_t* O; int ldc;
    __device__ __forceinline__ void operator()(const f32x4 (&acc)[2][2][4][2], const Unit& u, int wr, int wc, int fr, int fq) const {
        const int row0 = u.pm * BM + wr * 64 + fr, col0 = u.pn * HALF + wc * 32 + 8 * fq;
        EPI_LOOP_AIM { bf16_t* rowp = O + (size_t)(row0 + ai * HALF + m * 16) * ldc + col0;
            float o[8];
#pragma unroll
            for (int n = 0; n < 2; ++n)
#pragma unroll
                for (int i = 0; i < 4; ++i) { const float g = acc[ai][0][m][n][i], up = acc[ai][1][m][n][i]; o[n * 4 + i] = g * __builtin_amdgcn_rcpf(1.f + __expf(-g)) * up; }
            u32x4 w; w.x = cvt_pk_bf16(o[0], o[1]); w.y = cvt_pk_bf16(o[2], o[3]); w.z = cvt_pk_bf16(o[4], o[5]); w.w = cvt_pk_bf16(o[6], o[7]);
            *(u32x4*)rowp = w; }
    }
};
struct EpiRes {
    static constexpr bool PERM = false, AFTER_DRAIN = false;
    float* X; const float* gate; float coef;
    __device__ __forceinline__ void operator()(const f32x4 (&acc)[2][2][4][2], const Unit& u, int wr, int wc, int fr, int fq) const {
        const int row0 = u.pm * BM + wr * 64 + fr, col0 = u.pn * BM + wc * 32 + 4 * fq;
        const int rt = u.pm * BM; const int j = rt < 4096 ? 0 : 1 + ((rt - 4096) >> 12);
        const float* g = gate + j * 18432 + col0;
        f32x4 gv[2][2];
        EPI_LOOP_BJN gv[bj][n] = *(const f32x4*)(g + bj * HALF + n * 16) * coef;
        EPI_LOOP_AIM { float* rowp = X + (size_t)(row0 + ai * HALF + m * 16) * 2048 + col0;
            EPI_LOOP_BJN { f32x4 x = *(const f32x4*)(rowp + bj * HALF + n * 16); x += gv[bj][n] * acc[ai][bj][m][n]; *(f32x4*)(rowp + bj * HALF + n * 16) = x; }
            asm volatile("" ::: "memory"); }
    }
};
struct EpiZT {
    static constexpr bool PERM = false, AFTER_DRAIN = false;
    float* ZTp; float* ZTs;
    __device__ __forceinline__ void operator()(const f32x4 (&acc)[2][2][4][2], const Unit& u, int wr, int wc, int fr, int fq) const {
        const int ch0 = u.pm * BM + wr * 64 + fr, tok0 = u.pn * BM;
        float* base; int pitch, toff;
        if (tok0 < 4096) { base = ZTp + (size_t)(tok0 >> 8) * 6144 * 256; pitch = 256; toff = 0; }
        else { const int tk = tok0 - 4096; base = ZTs + (size_t)(tk >> 12) * 6144 * 4096; pitch = 4096; toff = tk & 4095; }
        const int c0 = toff + wc * 32 + 4 * fq;
        EPI_LOOP_AIM { float* rowp = base + (size_t)(ch0 + ai * HALF + m * 16) * pitch + c0;
            EPI_LOOP_BJN *(f32x4*)(rowp + bj * HALF + n * 16) = acc[ai][bj][m][n]; }
    }
};
struct EpiVT {
    static constexpr bool PERM = true, AFTER_DRAIN = false;
    bf16_t* VTp; size_t s_off;
    __device__ __forceinline__ void operator()(const f32x4 (&acc)[2][2][4][2], const Unit& u, int wr, int wc, int fr, int fq) const {
        const int ch0 = u.pm * BM + wr * 64 + fr, tok0 = u.pn * BM;
        bf16_t* base; int pitch, toff; bf16_t* VTs = VTp + s_off;
        if (tok0 < 4096) { base = VTp + (size_t)(tok0 >> 8) * 1024 * 256; pitch = 256; toff = 0; }
        else if (tok0 < 12288) { const int tk = tok0 - 4096; base = VTs + (size_t)(tk >> 12) * 1024 * 4352; pitch = 4352; toff = tk & 4095; }
        else { const int tk = tok0 - 12288; base = VTs + (size_t)(tk >> 8) * 1024 * 4352; pitch = 4352; toff = 4096; }
        const int c0 = toff + wc * 32 + 8 * fq;
        EPI_LOOP_AIM { bf16_t* rowp = base + (size_t)(ch0 + ai * HALF + m * 16) * pitch + c0;
#pragma unroll
            for (int bj = 0; bj < 2; ++bj) { const f32x4 v0 = acc[ai][bj][m][0], v1 = acc[ai][bj][m][1];
                u32x4 w; w.x = cvt_pk_bf16(v0[0], v0[1]); w.y = cvt_pk_bf16(v0[2], v0[3]); w.z = cvt_pk_bf16(v1[0], v1[1]); w.w = cvt_pk_bf16(v1[2], v1[3]);
                *(u32x4*)(rowp + bj * HALF) = w; } }
    }
};
struct EpiQ {
    static constexpr bool PERM = true, AFTER_DRAIN = false;
    bf16_t* Q; const float* rope; float qs;
    __device__ __forceinline__ void operator()(const f32x4 (&acc)[2][2][4][2], const Unit& u, int wr, int wc, int fr, int fq) const {
        const int row0 = u.pm * BM + wr * 64 + fr;
        EPI_LOOP_AIM { const int row = row0 + ai * HALF + m * 16; const bool smp = row >= 4096; const int t = (row - 4096) & 4095;
#pragma unroll
            for (int bj = 0; bj < 2; ++bj) { const int c0 = u.pn * BM + bj * HALF + wc * 32 + 8 * fq; const int within = c0 % 192;
                float o[8];
#pragma unroll
                for (int n = 0; n < 2; ++n)
#pragma unroll
                    for (int i = 0; i < 4; ++i) o[n * 4 + i] = acc[ai][bj][m][n][i];
                if (within >= 128 && smp) { const int ri = within - 128;
#pragma unroll
                    for (int q = 0; q < 4; ++q) { const int idx = ri + 2 * q, hf = idx >> 5, j = (idx & 31) >> 1; const int pos = hf ? (t & 63) : (t >> 6);
                        const float2 cs = *(const float2*)(rope + (pos * 16 + j) * 2); const float x1 = o[2 * q], x2 = o[2 * q + 1];
                        o[2 * q] = x1 * cs.x - x2 * cs.y; o[2 * q + 1] = x2 * cs.x + x1 * cs.y; } }
                u32x4 w; w.x = cvt_pk_bf16(o[0] * qs, o[1] * qs); w.y = cvt_pk_bf16(o[2] * qs, o[3] * qs); w.z = cvt_pk_bf16(o[4] * qs, o[5] * qs); w.w = cvt_pk_bf16(o[6] * qs, o[7] * qs);
                *(u32x4*)(Q + (size_t)row * 1536 + c0) = w; } }
    }
};
struct EpiLora {
    static constexpr bool PERM = false, AFTER_DRAIN = false;
    unsigned char* wsb; const float* w0; const float* a0; const float* ka; size_t off_sc, off_kb, off_gb;
    __device__ __forceinline__ void operator()(const f32x4 (&acc)[2][2][4][2], const Unit& u, int wr, int wc, int fr, int fq) const {
        const int row0 = u.pm * BM + wr * 64 + fr; const int seg = u.pn >> 2; const int cb = (u.pn & 3) * BM + wc * 32 + 4 * fq;
        float* SC = (float*)(wsb + off_sc); const float* KB = (const float*)(wsb + off_kb); float* GB = (float*)(wsb + off_gb);
        EPI_LOOP_AIM { const int row = row0 + ai * HALF + m * 16; float* sc = SC + (size_t)row * 9216;
            EPI_LOOP_BJN { const int c = cb + bj * HALF + n * 16; const f32x4 a = acc[ai][bj][m][n];
                if (seg < 2) { const f32x4 wv = *(const f32x4*)(w0 + seg * 1024 + c); f32x4 o;
#pragma unroll
                    for (int i = 0; i < 4; ++i) { const float x = wv[i] + a[i]; const float sp = __logf(1.f + __expf(-x)); o[i] = __expf(-__expf(-sp - 0.5f)); }
                    *(f32x4*)(sc + (3 + seg) * 1024 + c) = o; }
                else if (seg < 4) { const int d = seg - 2; const f32x4 av = *(const f32x4*)(a0 + d * 1024 + c), kav = *(const f32x4*)(ka + c);
                    const f32x4 kk = *(const f32x4*)(sc + 2 * 1024 + c), kr = *(const f32x4*)(KB + (size_t)row * 1024 + c); f32x4 o1, o2;
#pragma unroll
                    for (int i = 0; i < 4; ++i) { const float s = __builtin_amdgcn_rcpf(1.f + __expf(-(av[i] + a[i]))); o1[i] = kk[i] * s; o2[i] = kr[i] * (1.f + (s - 1.f) * kav[i]); }
                    *(f32x4*)(sc + (5 + d) * 1024 + c) = o1; *(f32x4*)(sc + (7 + d) * 1024 + c) = o2; }
                else *(f32x4*)(GB + (size_t)row * 1024 + c) = a; }
            asm volatile("" ::: "memory"); }
    }
};
template <class Epi, class Sched, bool ALIGN_EPI = false, bool SP2 = false>
__device__ __forceinline__ void gemm_phase(PG8_LAS unsigned char* lds, const Gemm g, const Sched& S, const Epi& E, int wave_id) {
    const int tid_l_ = wave_id * 64 + lane_id_v();
    const int tid = tid_l_, wid = __builtin_amdgcn_readfirstlane(tid >> 6), lane = tid & 63, wr = wid >> 2, wc = wid & 3, fr = lane & 15, fq = lane >> 4;
    const int K = g.K, nt = K / BK;
    unsigned voffA[2], voffB[2];
#pragma unroll
    for (int i = 0; i < 2; ++i) { int R, C; stage_rc(tid * 16 + i * 8192, R, C); const int Rb = Epi::PERM ? ((R & ~31) + perm32(R & 31)) : R;
        voffA[i] = (unsigned)(R * K + C) * 2u; voffB[i] = (unsigned)(Rb * K + C) * 2u; }
    const size_t kstep = (size_t)(BK * 2);
    const size_t hstep = (size_t)HALF * K * 2;
    const size_t tstep = 2 * hstep;
    const unsigned ldsw = (unsigned)wid * 1024u;
    const int aoff = lds_byte(wr * 64 + fr, fq * 8), boff = lds_byte(wc * 32 + fr, fq * 8);
#define PG8_SA(b, h) (((b) * 2 + (h)) * HTB)
#define PG8_SB(b, h) ((4 + (b) * 2 + (h)) * HTB)
#define PG8_STAGE(bufoff, gbase, voff) do { _Pragma("unroll") for (int _i = 0; _i < 2; ++_i) \
        __builtin_amdgcn_global_load_lds((const unsigned*)((const char*)(gbase) + (voff)[_i]), (PG8_LAS unsigned*)(lds + (bufoff) + ldsw + _i * 8192), 16, 0, 0); } while (0)
#define PG8_LDA(dst, b, h) do { _Pragma("unroll") for (int m = 0; m < 4; ++m) _Pragma("unroll") for (int k = 0; k < 2; ++k) dst[m][k] = *(const PG8_LAS bf16x8*)(lds + PG8_SA(b, h) + aoff + m * 2048 + k * 1024); } while (0)
#define PG8_LDB(dst, b, h) do { _Pragma("unroll") for (int n = 0; n < 2; ++n) _Pragma("unroll") for (int k = 0; k < 2; ++k) dst[n][k] = *(const PG8_LAS bf16x8*)(lds + PG8_SB(b, h) + boff + n * 2048 + k * 1024); } while (0)
#define PG8_MMA(ai, bj, At, Bt) do { __builtin_amdgcn_s_setprio(1); _Pragma("unroll") for (int m = 0; m < 4; ++m) _Pragma("unroll") for (int n = 0; n < 2; ++n) _Pragma("unroll") for (int k = 0; k < 2; ++k) \
        acc[ai][bj][m][n] = __builtin_amdgcn_mfma_f32_16x16x32_bf16(Bt[n][k], At[m][k], acc[ai][bj][m][n], 0, 0, 0); __builtin_amdgcn_s_setprio(0); } while (0)
#define PG8_WAIT_V(n) asm volatile("s_waitcnt vmcnt(" #n ")" ::: "memory")
#define PG8_WAIT_L(n) asm volatile("s_waitcnt lgkmcnt(" #n ")" ::: "memory")
#define PG8_BAR __builtin_amdgcn_s_barrier()
#define PG8_SCHED __builtin_amdgcn_sched_barrier(0)
    Unit cur, nxt; int ui = 0;
    if (!S.next(0, cur)) return;
    f32x4 acc[2][2][4][2];
#pragma unroll
    for (int a = 0; a < 2; ++a)
#pragma unroll
        for (int b = 0; b < 2; ++b)
#pragma unroll
            for (int m = 0; m < 4; ++m)
#pragma unroll
                for (int n = 0; n < 2; ++n) acc[a][b][m][n] = (f32x4){0.f, 0.f, 0.f, 0.f};
    bf16x8 At[4][2], B0[2][2], B1[2][2];
    const char* cA = (const char*)g.A + (size_t)cur.pm * tstep; const char* cB = (const char*)g.Bt + (size_t)cur.pn * tstep;
    if constexpr (Sched::SPLITK != 0) { cA += (size_t)cur.kt0 * kstep; cB += (size_t)cur.kt0 * kstep; }
    S.a_ready(cur);
    if constexpr (SP2) {
        PG8_STAGE(PG8_SB(0, 0), cB, voffB); PG8_STAGE(PG8_SB(0, 1), cB + hstep, voffB); PG8_STAGE(PG8_SA(0, 0), cA, voffA); PG8_STAGE(PG8_SA(0, 1), cA + hstep, voffA);
        if (wr == 1) PG8_BAR;
        PG8_WAIT_V(2); PG8_BAR;
        PG8_STAGE(PG8_SB(1, 0), cB + kstep, voffB); PG8_STAGE(PG8_SA(1, 0), cA + kstep, voffA); PG8_STAGE(PG8_SB(1, 1), cB + hstep + kstep, voffB);
        PG8_WAIT_V(6); PG8_BAR;
    } else {
        PG8_STAGE(PG8_SB(0, 0), cB, voffB); PG8_STAGE(PG8_SA(0, 0), cA, voffA); PG8_STAGE(PG8_SB(0, 1), cB + hstep, voffB); PG8_STAGE(PG8_SA(0, 1), cA + hstep, voffA);
        if (wr == 1) PG8_BAR;
        PG8_WAIT_V(4); PG8_BAR;
        PG8_STAGE(PG8_SB(1, 0), cB + kstep, voffB); PG8_STAGE(PG8_SA(1, 0), cA + kstep, voffA); PG8_STAGE(PG8_SB(1, 1), cB + hstep + kstep, voffB);
        PG8_WAIT_V(6); PG8_BAR;
    }
    for (;;) {
        const bool has_next = S.next(ui + 1, nxt);
        const char* nA = has_next ? (const char*)g.A + (size_t)nxt.pm * tstep : cA; const char* nB = has_next ? (const char*)g.Bt + (size_t)nxt.pn * tstep : cB;
        if constexpr (Sched::SPLITK != 0) { if (has_next) { nA += (size_t)nxt.kt0 * kstep; nB += (size_t)nxt.kt0 * kstep; } }
        const int cnt = Sched::SPLITK != 0 ? cur.nkt : nt;
        for (int t = 0; t < cnt; t += 2) {
            const bool last = (t == cnt - 2);
            const char* a1 = cA + (size_t)(t + 1) * kstep;
            const char* a2 = last ? nA : cA + (size_t)(t + 2) * kstep; const char* b2 = last ? nB : cB + (size_t)(t + 2) * kstep;
            const char* a3 = a2 + kstep; const char* b3 = b2 + kstep;
            if (last && has_next) S.a_ready(nxt);
            if constexpr (SP2) {
            PG8_LDB(B0, 0, 0); PG8_LDB(B1, 0, 1); PG8_SCHED; PG8_LDA(At, 0, 0); PG8_STAGE(PG8_SA(1, 1), a1 + hstep, voffA);
            PG8_WAIT_V(8); PG8_WAIT_L(0); PG8_BAR; PG8_MMA(0, 0, At, B0); PG8_MMA(0, 1, At, B1); PG8_BAR; PG8_SCHED;
            PG8_LDA(At, 0, 1); PG8_STAGE(PG8_SB(0, 0), b2, voffB); PG8_STAGE(PG8_SB(0, 1), b2 + hstep, voffB); PG8_STAGE(PG8_SA(0, 0), a2, voffA);
            PG8_WAIT_V(8); PG8_WAIT_L(0); PG8_BAR; PG8_MMA(1, 0, At, B0); PG8_MMA(1, 1, At, B1); PG8_BAR; PG8_SCHED;
            PG8_LDB(B0, 1, 0); PG8_LDB(B1, 1, 1); PG8_SCHED; PG8_LDA(At, 1, 0); PG8_STAGE(PG8_SA(0, 1), a2 + hstep, voffA);
            PG8_WAIT_V(8); PG8_WAIT_L(0); PG8_BAR; PG8_MMA(0, 0, At, B0); PG8_MMA(0, 1, At, B1); PG8_BAR; PG8_SCHED;
            PG8_LDA(At, 1, 1); PG8_STAGE(PG8_SB(1, 0), b3, voffB); PG8_STAGE(PG8_SB(1, 1), b3 + hstep, voffB); PG8_STAGE(PG8_SA(1, 0), a3, voffA);
            PG8_WAIT_V(8); PG8_WAIT_L(0); PG8_BAR; PG8_MMA(1, 0, At, B0); PG8_MMA(1, 1, At, B1); PG8_BAR; PG8_SCHED;
            } else {
            PG8_LDB(B0, 0, 0); PG8_SCHED; PG8_LDA(At, 0, 0); PG8_STAGE(PG8_SA(1, 1), a1 + hstep, voffA);
            PG8_WAIT_L(8); PG8_BAR; PG8_WAIT_L(0); PG8_MMA(0, 0, At, B0); PG8_BAR; PG8_SCHED;
            PG8_LDB(B1, 0, 1); PG8_STAGE(PG8_SB(0, 0), b2, voffB);
            PG8_BAR; PG8_WAIT_L(0); PG8_MMA(0, 1, At, B1); PG8_BAR;
            PG8_LDA(At, 0, 1); PG8_STAGE(PG8_SA(0, 0), a2, voffA);
            PG8_BAR; PG8_WAIT_L(0); PG8_MMA(1, 0, At, B0); PG8_BAR; PG8_SCHED;
            PG8_STAGE(PG8_SB(0, 1), b2 + hstep, voffB);
            PG8_WAIT_V(6); PG8_BAR; PG8_MMA(1, 1, At, B1); PG8_BAR;
            PG8_LDB(B0, 1, 0); PG8_SCHED; PG8_LDA(At, 1, 0); PG8_STAGE(PG8_SA(0, 1), a2 + hstep, voffA);
            PG8_WAIT_L(8); PG8_BAR; PG8_WAIT_L(0); PG8_MMA(0, 0, At, B0); PG8_BAR; PG8_SCHED;
            PG8_LDB(B1, 1, 1); PG8_STAGE(PG8_SB(1, 0), b3, voffB);
            PG8_BAR; PG8_WAIT_L(0); PG8_MMA(0, 1, At, B1); PG8_BAR;
            PG8_LDA(At, 1, 1); PG8_STAGE(PG8_SA(1, 0), a3, voffA);
            PG8_BAR; PG8_WAIT_L(0); PG8_MMA(1, 0, At, B0); PG8_BAR; PG8_SCHED;
            PG8_STAGE(PG8_SB(1, 1), b3 + hstep, voffB);
            PG8_WAIT_V(6); PG8_BAR; PG8_MMA(1, 1, At, B1); PG8_BAR;
            }
        }
        if constexpr (ALIGN_EPI) { if (wr == 0) PG8_BAR; }
        if constexpr (Sched::SPLITK == 1) { if (cur.mode == 1) S.publish(acc, cur, wid, lane); else E(acc, cur, wr, wc, fr, fq); S.done(cur); }
        else if constexpr (Sched::SPLITK == 2) { S.consume(acc, cur, wid, lane); E(acc, cur, wr, wc, fr, fq); S.done(cur); }
        else if constexpr (!Epi::AFTER_DRAIN) { E(acc, cur, wr, wc, fr, fq); S.done(cur); }
        if (!has_next) break;
#pragma unroll
        for (int a = 0; a < 2; ++a)
#pragma unroll
            for (int b = 0; b < 2; ++b)
#pragma unroll
                for (int m = 0; m < 4; ++m)
#pragma unroll
                    for (int n = 0; n < 2; ++n) acc[a][b][m][n] = (f32x4){0.f, 0.f, 0.f, 0.f};
        cur = nxt; cA = nA; cB = nB; ++ui;
        if constexpr (ALIGN_EPI) { if (wr == 1) PG8_BAR; }
    }
    PG8_WAIT_V(0);
    if constexpr (!ALIGN_EPI) { if (wr == 0) PG8_BAR; }
    PG8_BAR;
    if constexpr (Epi::AFTER_DRAIN) { E.fused(acc, cur, wr, wc, fr, fq, lds, wid, lane); S.done(cur); }
#undef PG8_SA
#undef PG8_SB
#undef PG8_STAGE
#undef PG8_LDA
#undef PG8_LDB
#undef PG8_MMA
#undef PG8_WAIT_V
#undef PG8_WAIT_L
#undef PG8_BAR
#undef PG8_SCHED
}
}
#define XB_TMO      128
#define XB_XCNT(j)  (256  + 64 * (j))
#define XB_XSUB(j)  (1280 + 64 * (j))
#define XB_XGEN(j)  (2304 + 64 * (j))
#define XB_TOP      3328
#define XB_TOPGEN   3392
#define XCD_BAR_WORDS 3456
#define XB_SPIN_CAP (1u << 18)

__device__ __forceinline__ unsigned xb_ld(unsigned* p)              { return __hip_atomic_load(p, __ATOMIC_RELAXED, __HIP_MEMORY_SCOPE_AGENT); }
__device__ __forceinline__ unsigned xb_add(unsigned* p, unsigned v) { return __hip_atomic_fetch_add(p, v, __ATOMIC_RELAXED, __HIP_MEMORY_SCOPE_AGENT); }
__device__ __forceinline__ unsigned xb_xcc_id() { return (unsigned)__builtin_amdgcn_s_getreg((3 << 11) | 20) & 0xFu; }
#define XB_SPIN(cond, bar) do { unsigned _sp = 0; while (cond) { __builtin_amdgcn_s_sleep(1); \
    if ((++_sp & 255u) == 0u) { if (xb_ld(&(bar)[XB_TMO])) break; if (_sp > XB_SPIN_CAP) { atomicAdd(&(bar)[XB_TMO], 1u); break; } } } } while (0)

struct XcdBarrier {
    unsigned* bar; unsigned x;
    volatile LAS unsigned* st;
};

__device__ __forceinline__ XcdBarrier xcd_barrier_post(unsigned* bar, volatile LAS unsigned* st, int tid_) {
    XcdBarrier b; b.bar = bar; b.x = xb_xcc_id(); b.st = st;
    if (tid_ == 0) (void)xb_add(&bar[XB_XCNT(b.x)], 1u);
    return b;
}
__device__ __forceinline__ void xcd_barrier_complete(unsigned* bar, unsigned x, unsigned& nloc, unsigned& nx) {
    const unsigned G = gridDim.x * gridDim.y * gridDim.z;
    unsigned sum, cnt, mine, sp = 0u;
    for (;;) {
        sum = 0u; cnt = 0u; mine = 0u;
#pragma unroll
        for (unsigned j = 0; j < 16; ++j) { const unsigned c = xb_ld(&bar[XB_XCNT(j)]); sum += c; cnt += (c > 0u) ? 1u : 0u; mine = (j == x) ? c : mine; }
        if (sum == G) break;
        __builtin_amdgcn_s_sleep(1);
        if ((++sp & 255u) == 0u) { if (xb_ld(&bar[XB_TMO])) break; if (sp > XB_SPIN_CAP) { atomicAdd(&bar[XB_TMO], 1u); break; } }
    }
    nloc = mine > 0u ? mine : 1u; nx = cnt > 0u ? cnt : 1u;
}

__device__ __forceinline__ void xcd_barrier(const XcdBarrier& b, int tid_) {
    asm volatile("s_waitcnt vmcnt(0)" ::: "memory");
    __syncthreads();
    if (tid_ == 0) {
        unsigned* bar = b.bar;
        __builtin_amdgcn_s_waitcnt(0);
        unsigned nloc = b.st[0], nx = b.st[1];
        if (nloc == 0u) { xcd_barrier_complete(bar, b.x, nloc, nx); b.st[0] = nloc; b.st[1] = nx; }
        const unsigned old = xb_add(&bar[XB_XSUB(b.x)], 1u);
        const unsigned gen = old / nloc;
        if (old + 1u == (gen + 1u) * nloc) {
            __builtin_amdgcn_fence(__ATOMIC_RELEASE, "agent");
            asm volatile("s_waitcnt vmcnt(0)" ::: "memory");
            const unsigned og = xb_add(&bar[XB_TOP], 1u);
            const unsigned tg = og / nx;
            if (og + 1u == (tg + 1u) * nx) xb_add(&bar[XB_TOPGEN], 1u);
            else XB_SPIN(xb_ld(&bar[XB_TOPGEN]) == tg, bar);
            __builtin_amdgcn_fence(__ATOMIC_ACQUIRE, "agent");
            xb_add(&bar[XB_XGEN(b.x)], 1u);
            asm volatile("s_waitcnt vmcnt(0)" ::: "memory");
        } else {
            XB_SPIN(xb_ld(&bar[XB_XGEN(b.x)]) == gen, bar);
            __builtin_amdgcn_fence(__ATOMIC_ACQUIRE, "agent");
            asm volatile("s_waitcnt vmcnt(0)" ::: "memory");
        }
    }
    __syncthreads();
}

constexpr size_t MiB = 1u << 20;
constexpr size_t WS_CTL = 0, CTL_ZERO_BYTES = 2 * MiB;
constexpr size_t WS_MOD = 2 * MiB;
constexpr size_t WS_PMOD = WS_MOD + 2 * MiB;
constexpr size_t WS_ROPE = WS_PMOD + 8 * MiB;
constexpr size_t WS_W1T = WS_ROPE + 2 * MiB;
constexpr size_t WS_W2T = WS_W1T + 352 * MiB;
constexpr size_t WS_WINE = WS_W2T + 176 * MiB;
constexpr size_t WS_WOUTE = WS_WINE + 34 * MiB;
constexpr size_t WS_WINO = WS_WOUTE + 16 * MiB;
constexpr size_t WS_WOUTO = WS_WINO + 48 * MiB;
constexpr size_t WS_WQ = WS_WOUTO + 16 * MiB;
constexpr size_t WS_WKN = WS_WQ + 4 * MiB;
constexpr size_t WS_WV = WS_WKN + 2 * MiB;
constexpr size_t WS_WLORA = WS_WV + 2 * MiB;
constexpr size_t WS_W3T = WS_WLORA + 8 * MiB;
constexpr size_t WS_H2 = WS_W3T + 8 * MiB;
constexpr size_t WS_X = WS_H2 + 4 * MiB;
constexpr size_t WS_H = WS_X + 96 * MiB;
constexpr size_t WS_ACT = WS_H + 48 * MiB;
constexpr size_t WS_Z = WS_ACT + 132 * MiB;
constexpr size_t WS_SCAN = WS_Z + 288 * MiB;
constexpr size_t SCAN_BYTES = 432 * MiB;
constexpr size_t WS_KBUF = WS_SCAN + 2 * SCAN_BYTES;
constexpr size_t WS_LA = WS_KBUF + 48 * MiB;
constexpr size_t WS_GB = WS_LA + 10 * MiB;
constexpr size_t WS_CQ = WS_GB + 48 * MiB;
constexpr size_t WS_CKV = WS_CQ + 12 * MiB;
constexpr size_t WS_KR = WS_CKV + 8 * MiB;
constexpr size_t WS_Q = WS_KR + 2 * MiB;
constexpr size_t WS_KN = WS_Q + 36 * MiB;
constexpr size_t WS_VT = WS_KN + 26 * MiB;
constexpr size_t WS_YSC = WS_VT + 26 * MiB;
constexpr size_t WS_PQ = WS_ACT;
constexpr size_t WS_SST = WS_ACT + 64 * MiB;
constexpr size_t WS_PST = WS_ACT + 96 * MiB;
constexpr size_t WS_MIX = WS_YSC + 96 * MiB;
constexpr size_t WS_KSS = WS_MIX + 48 * MiB;
constexpr size_t WS_KSP = WS_KSS + 258 * MiB;
constexpr size_t WS_END = WS_KSP + 18 * MiB;
static_assert((size_t)NCH * 64 * 2 * 16384 <= 64 * MiB && (size_t)NCH * 64 * 16384 <= 32 * MiB, "PQ / SST inside the ACT region");
constexpr size_t ZT_S_OFF = (size_t)16 * 6144 * 256 * 4;
constexpr size_t VT_S_OFF = (size_t)16 * 1024 * 256 * 2;

constexpr size_t OUT_YS = (size_t)MP * D, OUT_CKV = (size_t)MT * D, OUT_KR = OUT_CKV + 16 * 2 * 256 * 256, OUT_ST = OUT_KR + 16 * 2 * 256 * 64, OUT_END = OUT_ST + (size_t)16 * 2 * 2 * 16 * 64 * 64;

constexpr int LDS_RING = 131072, LDS_BYTES = 147456, LDS_CTL = LDS_BYTES - 512;

struct KArgs { const float* in[42]; float* out; unsigned char* ws; int ph_lo, ph_hi; };
enum { I_XP = 0, I_XS, I_CCKV, I_CKR, I_ST, I_C, I_CCTX, I_WMOD, I_BMOD, I_NG, I_WFI, I_WFO, I_FNG, I_WINE, I_MUP, I_MUN, I_W0, I_W2, I_A0, I_A2, I_G2, I_KK, I_KA, I_RK, I_GNW, I_GNB,
       I_QN, I_KVN, I_WQB, I_WKVB, I_WOE, I_WINO, I_CW, I_CB, I_FW1, I_FB1, I_FW2, I_FB2, I_FW3, I_FFR, I_HB, I_WOO };

struct Ctx {
    LAS unsigned char* lds; unsigned char* ws; const float* const* in; float* out;
    int tid, lane, wave, G, gw, NGW, vb, bx, zs;
};

DI void tr_item(const float* W, int ldw, int K, bf16* WT, int dstrow0, int srccol0, int k0, LAS float* scr, int lane) {
    float v[32];
#pragma unroll
    for (int i = 0; i < 32; ++i) v[i] = W[(size_t)(k0 + 2 * i + (lane >> 5)) * ldw + srccol0 + (lane & 31)];
#pragma unroll
    for (int i = 0; i < 32; ++i) scr[(2 * i + (lane >> 5)) * 33 + (lane & 31)] = v[i];
    asm volatile("s_waitcnt lgkmcnt(0)" ::: "memory");
    const int c = lane & 7;
#pragma unroll
    for (int j = 0; j < 4; ++j) { const int n = (lane >> 3) + 8 * j; const LAS float* s = scr + (8 * c) * 33 + n;
        v4u o; o.x = pk2(s[0 * 33], s[1 * 33]); o.y = pk2(s[2 * 33], s[3 * 33]); o.z = pk2(s[4 * 33], s[5 * 33]); o.w = pk2(s[6 * 33], s[7 * 33]);
        *(v4u*)(WT + (size_t)(dstrow0 + n) * K + k0 + 8 * c) = o; }
    asm volatile("s_waitcnt lgkmcnt(0)" ::: "memory");
}
template <int MODE> DI void tr_matrix(Ctx& C, const float* W, int ldw, int K, bf16* WT, int ndst, int nsrc, int gw, int NGW) {
    LAS float* scr = (LAS float*)(C.lds + C.wave * 8704);
    const int nkb = K / 64, nnb = ndst / 32, nit = nkb * nnb;
    for (int it = gw; it < nit; it += NGW) {
        const int kb = it / nnb, nb = it % nnb, dr = nb * 32;
        int sc = dr;
        if (MODE == 1) { const int p = dr >> 8, sg = (dr >> 7) & 1, j = dr & 127; sc = sg * 5632 + 128 * p + j; }
        if (MODE == 2 && dr >= nsrc) {
            const int c = C.lane & 7;
#pragma unroll
            for (int j = 0; j < 4; ++j) { const int n = (C.lane >> 3) + 8 * j; *(v4u*)(WT + (size_t)(dr + n) * K + kb * 64 + 8 * c) = (v4u){0u, 0u, 0u, 0u}; }
            continue;
        }
        tr_item(W, ldw, K, WT, dr, sc, kb * 64, scr, C.lane);
    }
}
template <class Fn> DI void cvt_small(Ctx& C, bf16* dst, int N, int K, Fn f) {
    const int total = N * (K / 8);
    for (int idx = C.bx * 512 + C.tid; idx < total; idx += C.G * 512) {
        const int n = idx % N, k8 = idx / N; float v[8];
#pragma unroll
        for (int i = 0; i < 8; ++i) v[i] = f(n, k8 * 8 + i);
        v4u o; o.x = pk2(v[0], v[1]); o.y = pk2(v[2], v[3]); o.z = pk2(v[4], v[5]); o.w = pk2(v[6], v[7]);
        *(v4u*)(dst + (size_t)n * K + k8 * 8) = o;
    }
}

DI void phase_prologue(Ctx& C) {
    const float* const* in = C.in; unsigned char* ws = C.ws;
    tr_matrix<1>(C, in[I_WFI], NFF1, 2048, (bf16*)(ws + WS_W1T), NFF1, NFF1, C.gw, C.NGW);
    tr_matrix<0>(C, in[I_WFO], 2048, DFF, (bf16*)(ws + WS_W2T), 2048, 2048, C.gw, C.NGW);
    for (int i = 0; i < 2; ++i) tr_matrix<2>(C, in[I_WINE] + (size_t)i * 2048 * ZE_N, ZE_N, 2048, (bf16*)(ws + WS_WINE) + (size_t)i * ZE_P * 2048, ZE_P, ZE_N, C.gw, C.NGW);
    for (int i = 0; i < 2; ++i) tr_matrix<0>(C, in[I_WOE] + (size_t)i * 2048 * 2048, 2048, 2048, (bf16*)(ws + WS_WOUTE) + (size_t)i * 2048 * 2048, 2048, 2048, C.gw, C.NGW);
    for (int i = 0; i < 2; ++i) tr_matrix<0>(C, in[I_WINO] + (size_t)i * 2048 * 6144, 6144, 2048, (bf16*)(ws + WS_WINO) + (size_t)i * 6144 * 2048, 6144, 6144, C.gw, C.NGW);
    for (int i = 0; i < 2; ++i) tr_matrix<0>(C, in[I_WOO] + (size_t)i * 2048 * 2048, 2048, 2048, (bf16*)(ws + WS_WOUTO) + (size_t)i * 2048 * 2048, 2048, 2048, C.gw, C.NGW);
    for (int e = 0; e < 2; ++e) {
        const float* wqb = in[I_WQB] + (size_t)e * 512 * 1536;
        cvt_small(C, (bf16*)(ws + WS_WQ) + (size_t)e * 1536 * 512, 1536, 512, [=](int n, int k) { const int hd = n / 192, wi = n % 192; int sc;
            if (wi < 128) sc = wi; else { const int idx = wi - 128, hf = idx >> 5, r = idx & 31; sc = 128 + 32 * hf + 16 * (r & 1) + (r >> 1); }
            return wqb[(size_t)k * 1536 + hd * 192 + sc]; });
        const float* wkv = in[I_WKVB] + (size_t)e * 256 * 2048;
        cvt_small(C, (bf16*)(ws + WS_WKN) + (size_t)e * 1024 * 256, 1024, 256, [=](int n, int k) { return wkv[(size_t)k * 2048 + (n >> 7) * 256 + (n & 127)]; });
        cvt_small(C, (bf16*)(ws + WS_WV) + (size_t)e * 1024 * 256, 1024, 256, [=](int n, int k) { return wkv[(size_t)k * 2048 + (n >> 7) * 256 + 128 + (n & 127)]; });
        const float* w2 = in[I_W2] + (size_t)e * 2 * 64 * 1024; const float* a2 = in[I_A2] + (size_t)e * 2 * 64 * 1024; const float* g2 = in[I_G2] + (size_t)e * 160 * 1024;
        cvt_small(C, (bf16*)(ws + WS_WLORA) + (size_t)e * 5120 * 384, 5120, 384, [=](int n, int k) { const int seg = n >> 10, c = n & 1023; float v = 0.f;
            if (seg < 2) { if (k < 64) v = w2[((size_t)seg * 64 + k) * 1024 + c]; }
            else if (seg < 4) { if (k >= 64 && k < 128) v = a2[((size_t)(seg - 2) * 64 + (k - 64)) * 1024 + c]; }
            else { if (k >= 128 && k < 288) v = g2[(size_t)(k - 128) * 1024 + c]; }
            return v; });
    }
    { const float* w3 = in[I_FW3];
      cvt_small(C, (bf16*)(ws + WS_W3T), 16384, 256, [=](int n, int k) { const int o = n >> 13, col = n & 8191; float v = 0.f; if ((k >> 6) == o) v = w3[((size_t)o * 64 + (k & 63)) * 8192 + col]; return v; }); }
    { LAS float* sl = (LAS float*)(C.lds + 8 * 8704);
      for (int it = C.bx; it < 4 * 8 * 9; it += C.G) {
          const int l = it / 72, kc = (it / 9) % 8, cc = it % 9;
          __syncthreads();
          for (int i = C.tid; i < 768; i += 512) { const int j = i >> 8, k = kc * 256 + (i & 255); const float cv = j == 0 ? in[I_CCTX][k] : in[I_C][(j - 1) * 2048 + k]; sl[i] = silu_f(cv); }
          __syncthreads();
          const int col = cc * 2048 + 4 * C.tid; const float* wp = in[I_WMOD] + ((size_t)l * 2048 + kc * 256) * 18432 + col;
          f32x4v a0 = {0.f, 0.f, 0.f, 0.f}, a1 = a0, a2 = a0;
#pragma unroll 4
          for (int k = 0; k < 256; ++k) { const f32x4v w = *(const f32x4v*)(wp + (size_t)k * 18432); a0 += w * sl[k]; a1 += w * sl[256 + k]; a2 += w * sl[512 + k]; }
          float* pm = (float*)(ws + WS_PMOD) + ((size_t)(kc * 4 + l) * 3) * 18432 + col;
          *(f32x4v*)(pm) = a0; *(f32x4v*)(pm + 18432) = a1; *(f32x4v*)(pm + 2 * 18432) = a2;
      }
      __syncthreads(); }
    { const f32x4v* s0 = (const f32x4v*)in[I_XP]; const f32x4v* s1 = (const f32x4v*)in[I_XS]; f32x4v* x = (f32x4v*)(ws + WS_X);
      const size_t n0 = (size_t)MP * D / 4, n1 = (size_t)MS * D / 4;
      for (size_t i = (size_t)C.bx * 512 + C.tid; i < n0 + n1; i += (size_t)C.G * 512) x[i] = i < n0 ? s0[i] : s1[i - n0]; }
    if (C.bx == 0) for (int i = C.tid; i < 1024; i += 512) { const int pos = i >> 4, j = i & 15; const float inv = 1.0f / powf(10000.0f, (float)(2 * j) / 32.0f); const float a = (float)pos * inv;
        float* r = (float*)(ws + WS_ROPE) + i * 2; r[0] = cosf(a); r[1] = sinf(a); }
    { bf16* H2 = (bf16*)(ws + WS_H2);
      for (int it = C.gw; it < 2 * 4352; it += C.NGW) {
          const int o = it / 4352, rr = it % 4352; const int L = rr < 256 ? 256 : 4096, t = rr < 256 ? rr : rr - 256; const int lane = C.lane;
          float zf = 0.f;
          if (lane == 0) zf = (float)t / (float)(L - 1);
          else if (lane < 33) { const int b = (lane - 1) & 15; const float fr = 1e-4f + (15.0f - 1e-4f) * ((float)b / 15.0f); const float ang = ((float)(2.0 * 3.14159265358979323846 / (double)L) * (float)t) * fr; zf = lane < 17 ? cosf(ang) : -sinf(ang); }
          const float* w1 = in[I_FW1] + (size_t)o * 33 * 64; const float* w2 = in[I_FW2] + (size_t)o * 64 * 64;
          float s = in[I_FB1][o * 64 + lane];
          for (int i = 0; i < 33; ++i) s += shfl_idx(zf, i) * w1[i * 64 + lane];
          const float h1 = sinf(in[I_FFR][(o * 2 + 0) * 64 + lane] * s);
          float s2 = in[I_FB2][o * 64 + lane];
          for (int i = 0; i < 64; ++i) s2 += shfl_idx(h1, i) * w2[i * 64 + lane];
          const float h2 = sinf(in[I_FFR][(o * 2 + 1) * 64 + lane] * s2);
          H2[(size_t)rr * 256 + o * 64 + lane] = (bf16)f2bf(h2);
          if (o == 0) { H2[(size_t)rr * 256 + 128 + lane] = 0; H2[(size_t)rr * 256 + 192 + lane] = 0; }
      } }
}
DI void phase_mod_reduce(Ctx& C) {
    const float* pm = (const float*)(C.ws + WS_PMOD); float* mod = (float*)(C.ws + WS_MOD); const float* bm = C.in[I_BMOD];
    for (int i = C.bx * 512 + C.tid; i < 4 * 3 * 18432; i += C.G * 512) { const int l = i / MODL, n = i % 18432; float s = bm[l * 18432 + n];
#pragma unroll
        for (int kc = 0; kc < 8; ++kc) s += pm[(size_t)kc * 4 * MODL + i];
        mod[i] = s; }
}
DI void phase_norm_mod(Ctx& C, const float* g, const float* modl, int s) {
    const float* X = (const float*)(C.ws + WS_X); bf16* H = (bf16*)(C.ws + WS_H);
    for (int row = C.gw; row < MT; row += C.NGW) {
        const float* sh = modl + row_mod_j(row) * 18432 + (3 * s) * 2048; const float* scl = sh + 2048;
        const f32x4v* xr = (const f32x4v*)(X + (size_t)row * D) + C.lane; f32x4v v[8]; float ss = 0.f;
#pragma unroll
        for (int i = 0; i < 8; ++i) { v[i] = xr[64 * i]; ss += (v[i].x * v[i].x + v[i].y * v[i].y) + (v[i].z * v[i].z + v[i].w * v[i].w); }
        const float rstd = 1.0f / sqrtf(wave_sum(ss) * (1.0f / D) + 1e-6f);
        v2u* o = (v2u*)(H + (size_t)row * D) + C.lane;
#pragma unroll
        for (int i = 0; i < 8; ++i) { const int c = 4 * C.lane + 256 * i; const f32x4v gg = *(const f32x4v*)(g + c), sc = *(const f32x4v*)(scl + c), sf = *(const f32x4v*)(sh + c);
            const f32x4v y = (v[i] * rstd * gg) * (sc + 1.0f) + sf; v2u w; w.x = pk2(y.x, y.y); w.y = pk2(y.z, y.w); o[64 * i] = w; }
    }
}
DI void phase_final_norm(Ctx& C) {
    const float* X = (const float*)(C.ws + WS_X); const float* g = C.in[I_FNG];
    for (int row = C.gw; row < MT; row += C.NGW) {
        const f32x4v* xr = (const f32x4v*)(X + (size_t)row * D) + C.lane; f32x4v v[8]; float ss = 0.f;
#pragma unroll
        for (int i = 0; i < 8; ++i) { v[i] = xr[64 * i]; ss += (v[i].x * v[i].x + v[i].y * v[i].y) + (v[i].z * v[i].z + v[i].w * v[i].w); }
        const float rstd = 1.0f / sqrtf(wave_sum(ss) * (1.0f / D) + 1e-6f);
        f32x4v* o = (f32x4v*)(C.out + (size_t)row * D) + C.lane;
#pragma unroll
        for (int i = 0; i < 8; ++i) { const f32x4v gg = *(const f32x4v*)(g + 4 * C.lane + 256 * i); o[64 * i] = v[i] * rstd * gg; }
    }
}

DI int rope_src(int p) { const int hf = p >> 5, r = p & 31; return 32 * hf + 16 * (r & 1) + (r >> 1); }
DI void phase_even_prep(Ctx& C, int e) {
    const float* const* in = C.in; unsigned char* ws = C.ws; const int lane = C.lane;
    const float* Z = (const float*)(ws + WS_Z); float* SC = (float*)(ws + WS_SCAN + (size_t)e * SCAN_BYTES); float* KB = (float*)(ws + WS_KBUF); bf16* LA = (bf16*)(ws + WS_LA);
    bf16* CQ = (bf16*)(ws + WS_CQ); bf16* CKV = (bf16*)(ws + WS_CKV); bf16* KR = (bf16*)(ws + WS_KR); const float* rope = (const float*)(ws + WS_ROPE);
    const float* mup = in[I_MUP] + e * 3360; const float* mun = in[I_MUN] + e * 3360; const float* kkw = in[I_KK] + e * 1024;
    const float* qn = in[I_QN] + e * 512; const float* kvn = in[I_KVN] + e * 256;
    for (int row = C.gw; row < MKV; row += C.NGW) {
        if (row >= MT) {
            const int rr = row - MT, b = rr >> 8, p = rr & 255;
            const float* cs = in[I_CCKV] + ((size_t)(b * 2 + e) * 256 + p) * 256;
#pragma unroll
            for (int i = 0; i < 4; ++i) CKV[(size_t)row * 256 + 64 * i + lane] = (bf16)f2bf(cs[64 * i + lane]);
            KR[(size_t)row * 64 + lane] = (bf16)f2bf(in[I_CKR][((size_t)(b * 2 + e) * 256 + p) * 64 + rope_src(lane)]);
            continue;
        }
        const bool smp = row >= MP; const int T = smp ? 4096 : 256; const int t = smp ? ((row - MP) & 4095) : (row & 255);
        const float* z = Z + (size_t)row * ZE_P; const bool hp = t > 0, hn = t < T - 1;
        float* sc = SC + (size_t)row * SCAN_P;
#define ZMIX4(c) ({ const f32x4v zc_ = *(const f32x4v*)(z + (c)); const f32x4v zp_ = hp ? *(const f32x4v*)(z + (c) - ZE_P) : (f32x4v){0.f, 0.f, 0.f, 0.f}; const f32x4v zn_ = hn ? *(const f32x4v*)(z + (c) + ZE_P) : (f32x4v){0.f, 0.f, 0.f, 0.f}; \
            zc_ + *(const f32x4v*)(mup + (c)) * (zp_ - zc_) + *(const f32x4v*)(mun + (c)) * (zn_ - zc_); })
#define ZMIX(c) ({ const float zc_ = z[c]; const float zp_ = hp ? z[(c) - ZE_P] : 0.f; const float zn_ = hn ? z[(c) + ZE_P] : 0.f; zc_ + mup[c] * (zp_ - zc_) + mun[c] * (zn_ - zc_); })
#pragma unroll
        for (int i = 0; i < 4; ++i) { const int c = 256 * i + 4 * lane;
            *(f32x4v*)(sc + c) = ZMIX4(c);
            *(f32x4v*)(sc + 1024 + c) = ZMIX4(2048 + c);
            const f32x4v k = ZMIX4(1024 + c); *(f32x4v*)(KB + (size_t)row * 1024 + c) = k;
            const f32x4v kk = k * *(const f32x4v*)(kkw + c); float ss = (kk.x * kk.x + kk.y * kk.y) + (kk.z * kk.z + kk.w * kk.w);
            ss += dpp_f<0xB1>(ss); ss += dpp_f<0x4E>(ss); ss += dpp_f<0x141>(ss); ss += dpp_f<0x140>(ss);
            *(f32x4v*)(sc + 2048 + c) = kk * (1.0f / fmaxf(sqrtf(ss), 1e-12f)); }
        bf16* la = LA + (size_t)row * 384;
        la[lane] = (bf16)f2bf(tanhf(ZMIX(3072 + lane)));
        la[64 + lane] = (bf16)f2bf(ZMIX(3136 + lane));
        la[128 + lane] = (bf16)f2bf(sigmoid_f(ZMIX(3200 + lane)));
        la[192 + lane] = (bf16)f2bf(sigmoid_f(ZMIX(3264 + lane)));
        { float xg = 0.f; if (lane < 32) xg = sigmoid_f(ZMIX(3328 + lane)); la[256 + lane] = (bf16)(lane < 32 ? f2bf(xg) : 0u); la[320 + lane] = 0; }
#undef ZMIX4
#undef ZMIX
        float cq[8], ss = 0.f;
#pragma unroll
        for (int i = 0; i < 8; ++i) { cq[i] = z[3360 + 64 * i + lane]; ss += cq[i] * cq[i]; }
        float rstd = 1.0f / sqrtf(wave_sum(ss) * (1.0f / 512.0f) + 1e-6f);
#pragma unroll
        for (int i = 0; i < 8; ++i) CQ[(size_t)row * 512 + 64 * i + lane] = (bf16)f2bf(cq[i] * rstd * qn[64 * i + lane]);
        float ck[4]; ss = 0.f;
#pragma unroll
        for (int i = 0; i < 4; ++i) { ck[i] = z[3872 + 64 * i + lane]; ss += ck[i] * ck[i]; }
        rstd = 1.0f / sqrtf(wave_sum(ss) * (1.0f / 256.0f) + 1e-6f);
#pragma unroll
        for (int i = 0; i < 4; ++i) { const float y = ck[i] * rstd * kvn[64 * i + lane]; CKV[(size_t)row * 256 + 64 * i + lane] = (bf16)f2bf(y);
            if (!smp) C.out[OUT_CKV + ((size_t)((row >> 8) * 2 + e) * 256 + t) * 256 + 64 * i + lane] = y; }
        const float kr = z[4128 + lane];
        if (!smp) { C.out[OUT_KR + ((size_t)((row >> 8) * 2 + e) * 256 + t) * 64 + lane] = kr; KR[(size_t)row * 64 + lane] = (bf16)f2bf(shfl_idx(kr, rope_src(lane))); }
        else { const int hf = lane >> 5, jj = lane & 15, e2 = (lane >> 4) & 1; const int pos = hf ? (t & 63) : (t >> 6);
            const float xo = shfl_idx(kr, lane ^ 16); const float2 cs = *(const float2*)(rope + (pos * 16 + jj) * 2);
            const float rot = e2 == 0 ? kr * cs.x - xo * cs.y : kr * cs.x + xo * cs.y;
            KR[(size_t)row * 64 + lane] = (bf16)f2bf(shfl_idx(rot, rope_src(lane))); }
    }
}

template <int N> DI float fmac_bc(float acc, float op, float s) { asm("v_fmac_f32_dpp %0, %1, %2 row_newbcast:%3 row_mask:0xf bank_mask:0xf" : "+v"(acc) : "v"(op), "v"(s), "n"(N)); return acc; }
template <int N> DI float mul_bc(float op, float s) { float r; asm("v_mul_f32_dpp %0, %1, %2 row_newbcast:%3 row_mask:0xf bank_mask:0xf" : "=v"(r) : "v"(op), "v"(s), "n"(N)); return r; }
struct ScanOps { f32x4v kk, w, kka, kd, r; float vv; };
typedef __attribute__((__vector_size__(4 * sizeof(int)))) int rsrc_t;
DI f32x4v bl128(__amdgpu_buffer_rsrc_t r, unsigned vo, unsigned so) { return __builtin_bit_cast(f32x4v, __builtin_amdgcn_raw_buffer_load_b128(r, (int)vo, (int)so, 0)); }
DI float bl32(__amdgpu_buffer_rsrc_t r, unsigned vo, unsigned so) { return __builtin_bit_cast(float, __builtin_amdgcn_raw_buffer_load_b32(r, (int)vo, (int)so, 0)); }
template <int MODE> DI ScanOps scan_load(__amdgpu_buffer_rsrc_t rs, unsigned so, unsigned lo, unsigned lv, int d) {
    ScanOps o;
    o.kk = bl128(rs, lo + 2u * 4096u, so); o.w = bl128(rs, lo + (3u + (unsigned)d) * 4096u, so); o.kka = bl128(rs, lo + (5u + (unsigned)d) * 4096u, so);
    if (MODE != 0) { o.kd = bl128(rs, lo + (7u + (unsigned)d) * 4096u, so); o.vv = bl32(rs, lv + 4096u, so); } else { o.kd = (f32x4v){0.f, 0.f, 0.f, 0.f}; o.vv = 0.f; }
    if (MODE == 2) o.r = bl128(rs, lo, so); else o.r = (f32x4v){0.f, 0.f, 0.f, 0.f};
    return o;
}
template <int MODE, int J> DI void scan_col_a(const ScanOps& o, const float (&S)[64], float (&sa)[4]) { sa[J & 3] = fmac_bc<(J >> 2)>(sa[J & 3], o.kk[J & 3], S[J]); }
template <int MODE, int J> DI void scan_col_b(const ScanOps& o, float (&S)[64], float sa, float (&y)[4]) {
    float t = mul_bc<(J >> 2)>(o.w[J & 3], S[J]);
    t = fmac_bc<(J >> 2)>(t, o.kka[J & 3], sa);
    if (MODE != 0) t = fmac_bc<(J >> 2)>(t, o.kd[J & 3], o.vv);
    S[J] = t;
    if (MODE == 2) y[J & 3] = fmac_bc<(J >> 2)>(y[J & 3], o.r[J & 3], t);
}
template <int MODE, int... Js> DI float scan_step(const ScanOps& o, float (&S)[64], std::integer_sequence<int, Js...>) {
    float sa[4] = {0.f, 0.f, 0.f, 0.f}, y[4] = {0.f, 0.f, 0.f, 0.f};
    (scan_col_a<MODE, Js>(o, S, sa), ...);
    const float sat = -((sa[0] + sa[1]) + (sa[2] + sa[3]));
    (scan_col_b<MODE, Js>(o, S, sat, y), ...);
    return (y[0] + y[1]) + (y[2] + y[3]);
}
template <int MODE> DI void scan_wave(const float* SCp, int row0, int rstep, int nsteps, int h, int d, float (&S)[64], float* yout, int lane) {
    const __amdgpu_buffer_rsrc_t rs = __builtin_amdgcn_make_buffer_rsrc((void*)SCp, 0, (int)((size_t)MT * SCAN_P * 4), 0x00020000);
    const __amdgpu_buffer_rsrc_t ry = __builtin_amdgcn_make_buffer_rsrc((void*)yout, 0, (int)((size_t)MT * 1024 * 4), 0x00020000);
    const int so0 = (row0 * SCAN_P + h * 64) * 4, sstep = rstep * SCAN_P * 4, last = nsteps - 1;
    int yo = (row0 * 1024 + h * 64) * 4; const int ystep = rstep * 4096;
    const unsigned lo = 16u * (unsigned)(lane & 15), lv = 4u * (unsigned)lane;
#define SC_LD(s_) scan_load<MODE>(rs, (unsigned)(so0 + ((s_) < last ? (s_) : last) * sstep), lo, lv, d)
#define SC_ST(o_) do { const float y_ = scan_step<MODE>(o_, S, std::make_integer_sequence<int, 64>{}); if (MODE == 2) __builtin_amdgcn_raw_buffer_store_b32(__builtin_bit_cast(unsigned, y_), ry, (int)lv, yo, 0); yo += ystep; } while (0)
    ScanOps o0 = SC_LD(0), o1 = SC_LD(1), o2 = SC_LD(2), o3;
    for (int s = 0; s < nsteps; s += 4) {
        o3 = SC_LD(s + 3); SC_ST(o0);
        o0 = SC_LD(s + 4); SC_ST(o1);
        o1 = SC_LD(s + 5); SC_ST(o2);
        o2 = SC_LD(s + 6); SC_ST(o3);
    }
#undef SC_LD
#undef SC_ST
}
DI void phase_scan1(Ctx& C, int e, int qslot) {
    const float* SCp = (const float*)(C.ws + WS_SCAN + (size_t)e * SCAN_BYTES); float* PQ = (float*)(C.ws + WS_PQ); float* Y = (float*)(C.ws + WS_YSC);
    const int nit = 512 + 64 * (NCH - 1) * 2;
    unsigned* qctr = (unsigned*)(C.ws + WS_CTL) + 8192 + 64 * (e + 2 * qslot);
    for (;;) {
        unsigned itu = 0; if (C.lane == 0) itu = __hip_atomic_fetch_add(qctr, 1u, __ATOMIC_RELAXED, __HIP_MEMORY_SCOPE_AGENT);
        const int it = __builtin_amdgcn_readfirstlane((int)itu); if (it >= nit) break;
        int lane = C.lane; asm volatile("" : "+v"(lane));
        float S[64];
        if (it >= 512) { const int si = it - 512;
            const int kind = si & 1, c = (si >> 1) % (NCH - 1), sidx = (si >> 1) / (NCH - 1);        const int d = sidx & 1, h = (sidx >> 1) & 15, b = sidx >> 5;
            const int t0 = d ? 4095 - c * CHL : c * CHL; const int row0 = MP + b * 4096 + t0;
            float fl = (float)lane; asm volatile("" : "+v"(fl)); const float kf = kind == 0 ? 1.f : 0.f;
#pragma unroll
            for (int j = 0; j < 64; ++j) { S[j] = kf * fmaxf(0.f, 1.f - fabsf(fl - (float)j)); }
            if (kind == 0) scan_wave<0>(SCp, row0, d ? -1 : 1, CHL, h, d, S, nullptr, lane); else scan_wave<1>(SCp, row0, d ? -1 : 1, CHL, h, d, S, nullptr, lane);
            float* dst = PQ + (((size_t)sidx * NCH + c) * 2 + kind) * 4096 + lane * 64;
#pragma unroll
            for (int j = 0; j < 16; ++j) *(f32x4v*)(dst + 4 * j) = (f32x4v){S[4 * j], S[4 * j + 1], S[4 * j + 2], S[4 * j + 3]};
        } else {
            const int pi = it; const int d = pi & 1, h = (pi >> 1) & 15, b = pi >> 5;
#pragma unroll
            for (int j = 0; j < 64; ++j) S[j] = 0.f;
            scan_wave<2>(SCp, b * 256 + (d ? 255 : 0), d ? -1 : 1, 128, h, d, S, Y + (size_t)d * MT * 1024, lane);
            float* dst = (float*)(C.ws + WS_PST) + (size_t)pi * 4096 + lane * 64;
#pragma unroll
            for (int j = 0; j < 16; ++j) *(f32x4v*)(dst + 4 * j) = (f32x4v){S[4 * j], S[4 * j + 1], S[4 * j + 2], S[4 * j + 3]};
        }
    }
}
DI void phase_scan_carry(Ctx& C, int e, int nsw) {
    const float* PQ = (const float*)(C.ws + WS_PQ); float* SST = (float*)(C.ws + WS_SST);
    LAS float* Ss = (LAS float*)C.lds;
    LAS float* Ps = (LAS float*)(C.lds + 64 * 65 * 4 + 64);
    for (int sidx = C.bx; sidx < 64; sidx += C.G) {
        const int d = sidx & 1, h = (sidx >> 1) & 15, b = sidx >> 5; const int row = C.tid & 63, cg = C.wave;
        const float* s0 = C.in[I_ST] + ((((size_t)b * 2 + e) * 2 + d) * 16 + h) * 4096;
        __syncthreads();
        for (int i = C.tid; i < 4096; i += 512) { const float v = s0[i]; Ss[(i >> 6) * 65 + (i & 63)] = v; SST[((size_t)sidx * NCH) * 4096 + i] = v; }
        const float* PQs = PQ + (size_t)sidx * NCH * 2 * 4096;
        f32x4v pp0 = *(const f32x4v*)(PQs + 4 * C.tid), pp1 = *(const f32x4v*)(PQs + 2048 + 4 * C.tid);
        f32x4v qq0 = *(const f32x4v*)(PQs + 4096 + row * 64 + cg * 8), qq1 = *(const f32x4v*)(PQs + 4096 + row * 64 + cg * 8 + 4);
        for (int c = 0; c + 1 < NCH; ++c) {
            __syncthreads();
            *(LAS f32x4v*)(Ps + 4 * C.tid) = pp0; *(LAS f32x4v*)(Ps + 2048 + 4 * C.tid) = pp1;
            float o[8] = {qq0.x, qq0.y, qq0.z, qq0.w, qq1.x, qq1.y, qq1.z, qq1.w};
            if (c + 2 < NCH) { const float* nx = PQs + (size_t)(c + 1) * 2 * 4096;
                pp0 = *(const f32x4v*)(nx + 4 * C.tid); pp1 = *(const f32x4v*)(nx + 2048 + 4 * C.tid);
                qq0 = *(const f32x4v*)(nx + 4096 + row * 64 + cg * 8); qq1 = *(const f32x4v*)(nx + 4096 + row * 64 + cg * 8 + 4); }
            __syncthreads();
            for (int k = 0; k < 64; ++k) { const float sv = Ss[row * 65 + k]; const f32x4v p0 = *(const LAS f32x4v*)(Ps + k * 64 + cg * 8), p1 = *(const LAS f32x4v*)(Ps + k * 64 + cg * 8 + 4);
                o[0] += sv * p0.x; o[1] += sv * p0.y; o[2] += sv * p0.z; o[3] += sv * p0.w; o[4] += sv * p1.x; o[5] += sv * p1.y; o[6] += sv * p1.z; o[7] += sv * p1.w; }
            __syncthreads();
            float* dst = SST + ((size_t)sidx * NCH + c + 1) * 4096 + row * 64 + cg * 8;
#pragma unroll
            for (int i = 0; i < 8; ++i) Ss[row * 65 + cg * 8 + i] = o[i];
            *(f32x4v*)dst = (f32x4v){o[0], o[1], o[2], o[3]}; *(f32x4v*)(dst + 4) = (f32x4v){o[4], o[5], o[6], o[7]};
        }
    }
    {
        const int nb0 = C.G > 64 ? 64 : 0; const float* SCp = (const float*)(C.ws + WS_SCAN + (size_t)e * SCAN_BYTES); float* Y = (float*)(C.ws + WS_YSC);
        if (C.bx >= nb0 && C.wave < nsw) for (int pi = (C.bx - nb0) * nsw + C.wave; pi < 512; pi += (C.G - nb0) * nsw) {
            int lane = C.lane; asm volatile("" : "+v"(lane));
            const int d = pi & 1, h = (pi >> 1) & 15, b = pi >> 5;
            float S[64]; const float* src = (const float*)(C.ws + WS_PST) + (size_t)pi * 4096 + lane * 64;
#pragma unroll
            for (int j = 0; j < 16; ++j) { const f32x4v t = *(const f32x4v*)(src + 4 * j); S[4 * j] = t.x; S[4 * j + 1] = t.y; S[4 * j + 2] = t.z; S[4 * j + 3] = t.w; }
            scan_wave<2>(SCp, b * 256 + (d ? 127 : 128), d ? -1 : 1, 128, h, d, S, Y + (size_t)d * MT * 1024, lane);
            float* dst = C.out + OUT_ST + ((((size_t)b * 2 + e) * 2 + d) * 16 + h) * 4096 + lane * 64;
#pragma unroll
            for (int j = 0; j < 16; ++j) *(f32x4v*)(dst + 4 * j) = (f32x4v){S[4 * j], S[4 * j + 1], S[4 * j + 2], S[4 * j + 3]};
        }
    }
}
DI void phase_scan3(Ctx& C, int e) {
    const float* SCp = (const float*)(C.ws + WS_SCAN + (size_t)e * SCAN_BYTES); const float* SST = (const float*)(C.ws + WS_SST); float* Y = (float*)(C.ws + WS_YSC);
    for (int it = C.gw; it < 64 * NCH; it += C.NGW) {
        int lane = C.lane; asm volatile("" : "+v"(lane));
        const int c = it % NCH, sidx = it / NCH; const int d = sidx & 1, h = (sidx >> 1) & 15, b = sidx >> 5;
        const int t0 = d ? 4095 - c * CHL : c * CHL; const int row0 = MP + b * 4096 + t0;
        float S[64]; const float* src = SST + ((size_t)sidx * NCH + c) * 4096 + lane * 64;
#pragma unroll
        for (int j = 0; j < 16; ++j) { const f32x4v t = *(const f32x4v*)(src + 4 * j); S[4 * j] = t.x; S[4 * j + 1] = t.y; S[4 * j + 2] = t.z; S[4 * j + 3] = t.w; }
        scan_wave<2>(SCp, row0, d ? -1 : 1, CHL, h, d, S, Y + (size_t)d * MT * 1024, lane);
    }
}
DI float row16_sum(float v) { v += dpp_f<0xB1>(v); v += dpp_f<0x4E>(v); v += dpp_f<0x141>(v); v += dpp_f<0x140>(v); return v; }
DI void phase_rwkv_post(Ctx& C, int e) {
    const float* SCp = (const float*)(C.ws + WS_SCAN + (size_t)e * SCAN_BYTES); const float* Y = (const float*)(C.ws + WS_YSC); const float* GB = (const float*)(C.ws + WS_GB); bf16* MIX = (bf16*)(C.ws + WS_MIX);
    const float* rk = C.in[I_RK] + e * 1024; const float* gw = C.in[I_GNW] + e * 1024; const float* gb = C.in[I_GNB] + e * 1024; const int lane = C.lane;
    for (int row = C.gw; row < MT; row += C.NGW) {
        const float* sc = SCp + (size_t)row * SCAN_P;
#pragma unroll
        for (int i = 0; i < 4; ++i) { const int c = 256 * i + 4 * lane;
            const f32x4v y = *(const f32x4v*)(Y + (size_t)row * 1024 + c) + *(const f32x4v*)(Y + ((size_t)MT + row) * 1024 + c);
            const float mu = row16_sum((y.x + y.y) + (y.z + y.w)) * (1.0f / 64.0f); const f32x4v dl = y - mu;
            const float var = row16_sum((dl.x * dl.x + dl.y * dl.y) + (dl.z * dl.z + dl.w * dl.w)) * (1.0f / 64.0f);
            const f32x4v yn = dl * (1.0f / sqrtf(var + 64e-5f));
            const f32x4v rr = *(const f32x4v*)(sc + c), kd = *(const f32x4v*)(sc + 7 * 1024 + c) + *(const f32x4v*)(sc + 8 * 1024 + c), rkv = *(const f32x4v*)(rk + c); const f32x4v pb = rr * kd * rkv;
            const float bs = row16_sum((pb.x + pb.y) + (pb.z + pb.w));
            const f32x4v o = (yn * *(const f32x4v*)(gw + c) + *(const f32x4v*)(gb + c) + *(const f32x4v*)(sc + 1024 + c) * bs) * *(const f32x4v*)(GB + (size_t)row * 1024 + c);
            v2u w; w.x = pk2(o.x, o.y); w.y = pk2(o.z, o.w); *(v2u*)(MIX + (size_t)row * 2048 + c) = w; }
    }
}

constexpr int AT_KP = 200, AT_VP = 72, AT_KB = 64 * AT_KP * 2, AT_VB = 128 * AT_VP * 2, AT_BUF = AT_KB + AT_VB;
DI void attn_unit(Ctx& C, const bf16* Qb, const bf16* KN, const bf16* KRb, const bf16* VTh  , int vpitch, bf16* MIX, int qrow0, int h, int krow0, int nlat, int crow0, int ntile) {
    int tid = C.tid; asm volatile("" : "+v"(tid)); const int lane = tid & 63, r = lane & 31, hh = lane >> 5;
    LAS unsigned char* lds = C.lds;
    s16x8v qf[12];
    { const bf16* qp = Qb + (size_t)(qrow0 + C.wave * 32 + r) * 1536 + h * 192 + 8 * hh;
#pragma unroll
      for (int s = 0; s < 12; ++s) qf[s] = *(const s16x8v*)(qp + 16 * s); }
    f32x16v o[4];
#pragma unroll
    for (int vb = 0; vb < 4; ++vb)
#pragma unroll
        for (int i = 0; i < 16; ++i) o[vb][i] = 0.f;
    float mrun = -INFINITY, lsum = 0.f;
    v4u pre[5];
    auto issue = [&](int j) {
        const int k0 = 64 * j; const int rbase = k0 < nlat ? krow0 + k0 : crow0 + (k0 - nlat);
#pragma unroll
        for (int i = 0; i < 3; ++i) { const int p = tid + 512 * i, key = p / 24, pc = p % 24; const size_t rw = (size_t)(rbase + key);
            pre[i] = pc < 16 ? *(const v4u*)(KN + rw * 1024 + h * 128 + pc * 8) : *(const v4u*)(KRb + rw * 64 + (pc - 16) * 8); }
#pragma unroll
        for (int i = 0; i < 2; ++i) { const int p = tid + 512 * i, dv = p >> 3, pc = p & 7; pre[3 + i] = *(const v4u*)(VTh + (size_t)dv * vpitch + k0 + pc * 8); }
    };
    auto commit = [&](int buf) {
        LAS unsigned char* kb = lds + buf * AT_BUF; LAS unsigned char* vbp = kb + AT_KB;
#pragma unroll
        for (int i = 0; i < 3; ++i) { const int p = tid + 512 * i, key = p / 24, pc = p % 24; *(LAS v4u*)(kb + key * (AT_KP * 2) + pc * 16) = pre[i]; }
#pragma unroll
        for (int i = 0; i < 2; ++i) { const int p = tid + 512 * i, dv = p >> 3, pc = p & 7; *(LAS v4u*)(vbp + dv * (AT_VP * 2) + pc * 16) = pre[3 + i]; }
    };
    __syncthreads();
    issue(0); commit(0); __syncthreads();
    for (int j = 0; j < ntile; ++j) {
        if (j + 1 < ntile) issue(j + 1);
        const LAS unsigned char* kb = lds + (j & 1) * AT_BUF; const LAS unsigned char* vbp = kb + AT_KB;
        f32x16v st[2];
        __builtin_amdgcn_s_setprio(1);
#pragma unroll
        for (int kbk = 0; kbk < 2; ++kbk) {
#pragma unroll
            for (int i = 0; i < 16; ++i) st[kbk][i] = 0.f;
#pragma unroll
            for (int s = 0; s < 12; ++s) { const s16x8v a = *(const LAS s16x8v*)(kb + (32 * kbk + r) * (AT_KP * 2) + (16 * s + 8 * hh) * 2);
                st[kbk] = __builtin_amdgcn_mfma_f32_32x32x16_bf16(a, qf[s], st[kbk], 0, 0, 0); }
        }
        __builtin_amdgcn_s_setprio(0);
        float mx = st[0][0];
#pragma unroll
        for (int i = 1; i < 16; ++i) mx = fmaxf(mx, st[0][i]);
#pragma unroll
        for (int i = 0; i < 16; ++i) mx = fmaxf(mx, st[1][i]);
        mx = fmaxf(mx, shfl_idx(mx, lane ^ 32));
        const float mnew = fmaxf(mrun, mx); const float alpha = __builtin_amdgcn_exp2f(mrun - mnew); mrun = mnew;
        float ps = 0.f;
#pragma unroll
        for (int kbk = 0; kbk < 2; ++kbk)
#pragma unroll
            for (int i = 0; i < 16; ++i) { const float p = __builtin_amdgcn_exp2f(st[kbk][i] - mnew); st[kbk][i] = p; ps += p; }
        lsum = lsum * alpha + ps;
        if (__builtin_amdgcn_ballot_w64(alpha != 1.0f) != 0ull) {
#pragma unroll
            for (int vb = 0; vb < 4; ++vb)
#pragma unroll
                for (int i = 0; i < 16; ++i) o[vb][i] *= alpha; }
        __builtin_amdgcn_s_setprio(1);
#pragma unroll
        for (int kbk = 0; kbk < 2; ++kbk)
#pragma unroll
            for (int s2 = 0; s2 < 2; ++s2) {
                v4u pw; pw.x = pg8::cvt_pk_bf16(st[kbk][8 * s2 + 0], st[kbk][8 * s2 + 1]); pw.y = pg8::cvt_pk_bf16(st[kbk][8 * s2 + 2], st[kbk][8 * s2 + 3]); pw.z = pg8::cvt_pk_bf16(st[kbk][8 * s2 + 4], st[kbk][8 * s2 + 5]); pw.w = pg8::cvt_pk_bf16(st[kbk][8 * s2 + 6], st[kbk][8 * s2 + 7]);
                const s16x8v pf = __builtin_bit_cast(s16x8v, pw);
#pragma unroll
                for (int vb = 0; vb < 4; ++vb) { const LAS unsigned char* vp = vbp + (32 * vb + r) * (AT_VP * 2) + (32 * kbk + 16 * s2 + 4 * hh) * 2;
                    const v2u lo = *(const LAS v2u*)vp, hi = *(const LAS v2u*)(vp + 16); const v4u av = {lo.x, lo.y, hi.x, hi.y};
                    o[vb] = __builtin_amdgcn_mfma_f32_32x32x16_bf16(__builtin_bit_cast(s16x8v, av), pf, o[vb], 0, 0, 0); }
            }
        __builtin_amdgcn_s_setprio(0);
        if (j + 1 < ntile) commit((j + 1) & 1);
        __syncthreads();
    }
    const float inv = 1.0f / (lsum + shfl_idx(lsum, lane ^ 32));
    bf16* op = MIX + (size_t)(qrow0 + C.wave * 32 + r) * 2048 + 1024 + h * 128 + 4 * hh;
#pragma unroll
    for (int vb = 0; vb < 4; ++vb)
#pragma unroll
        for (int g = 0; g < 4; ++g) { v2u w; w.x = pk2(o[vb][4 * g] * inv, o[vb][4 * g + 1] * inv); w.y = pk2(o[vb][4 * g + 2] * inv, o[vb][4 * g + 3] * inv);
            *(v2u*)(op + 32 * vb + 8 * g) = w; }
}
DI void phase_attention(Ctx& C) {
    unsigned char* ws = C.ws; const bf16* Qb = (const bf16*)(ws + WS_Q); const bf16* KN = (const bf16*)(ws + WS_KN); const bf16* KRb = (const bf16*)(ws + WS_KR); bf16* MIX = (bf16*)(ws + WS_MIX);
    const bf16* VTp = (const bf16*)(ws + WS_VT); const bf16* VTs = (const bf16*)(ws + WS_VT + VT_S_OFF);
    for (int u = C.bx; u < 256 + 128; u += C.G) {
        if (u < 256) { const int qb = u & 15, h = (u >> 4) & 7, b = u >> 7;
            attn_unit(C, Qb, KN, KRb, VTs + ((size_t)b * 1024 + h * 128) * 4352, 4352, MIX, MP + b * 4096 + qb * 256, h, MP + b * 4096, 4096, MT + b * 256, 68); }
        else { const int v = u - 256, h = v & 7, b = v >> 3;
            attn_unit(C, Qb, KN, KRb, VTp + ((size_t)b * 1024 + h * 128) * 256, 256, MIX, b * 256, h, b * 256, 256, 0, 4); }
    }
    __syncthreads();
}

DI f32x2v mk2(float a, float b) { return (f32x2v){a, b}; }
DI f32x2v cmul(f32x2v a, f32x2v b) { const f32x2v t = {-b.y, b.x}; return a.x * b + a.y * t; }
DI f32x2v cmulc(f32x2v a, f32x2v b) { const f32x2v t = {b.y, -b.x}; return a.x * b + a.y * t; }
DI f32x2v mul_mi(f32x2v a) { return mk2(a.y, -a.x); }
DI f32x2v mul_pi(f32x2v a) { return mk2(-a.y, a.x); }
DI f32x2v twid(int p, int den) { const float fr = (float)p / (float)den; return mk2(__builtin_amdgcn_cosf(fr), __builtin_amdgcn_sinf(fr)); }
DI int PD(int i) { return i + ((i >> 5) << 1); }
constexpr int FFT_BS = 8192 + 512, FFT_BUF_BYTES = FFT_BS * 8;
DI void bf4_fwd(f32x2v& x0, f32x2v& x1, f32x2v& x2, f32x2v& x3, f32x2v w0, f32x2v wm) {
    const f32x2v a0 = x0 + x2, a2 = cmul(x0 - x2, w0), a1 = x1 + x3, a3 = cmul(x1 - x3, mul_mi(w0));
    x0 = a0 + a1; x1 = cmul(a0 - a1, wm); x2 = a2 + a3; x3 = cmul(a2 - a3, wm);
}
DI void bf4_inv(f32x2v& x0, f32x2v& x1, f32x2v& x2, f32x2v& x3, f32x2v wa, f32x2v w) {
    const f32x2v t1 = cmul(x1, w), t3 = cmul(x3, w);
    const f32x2v a0 = x0 + t1, a1 = x0 - t1, a2 = x2 + t3, a3 = x2 - t3;
    const f32x2v t2 = cmul(a2, wa), t3b = cmul(a3, mul_pi(wa));
    x0 = a0 + t2; x1 = a1 + t3b; x2 = a0 - t2; x3 = a1 - t3b;
}
template <int N, int M, int NI = 1> DI void fft_fwd_pass(LAS f32x2v* buf, int tid) {
    constexpr int S = M / 8;
    const int tr = tid / (N / 16), u = tid % (N / 16), g = u / S, p = u % S; const int base = tr * N + g * 2 * M + p;
    f32x2v e[NI][16];
#pragma unroll
    for (int j = 0; j < NI; ++j)
#pragma unroll
        for (int k = 0; k < 16; ++k) e[j][k] = buf[j * FFT_BS + PD(base + k * S)];
    const f32x2v bc = twid(p, 2 * M); const f32x2v b1 = mk2(bc.x, -bc.y), b2 = cmul(b1, b1), b4 = cmul(b2, b2), b8 = cmul(b4, b4);
    constexpr float C1 = 0.92387953251128674f, S1 = 0.38268343236508977f, R2 = 0.70710678118654752f;
    const f32x2v w1a = cmul(b1, mk2(C1, -S1)), w1b = cmul(b2, mk2(R2, -R2)), w2a = cmul(b1, mk2(R2, -R2)), w2b = mul_mi(b2), w3a = cmul(b1, mk2(S1, -C1)), w3b = cmul(b2, mk2(-R2, -R2));
#pragma unroll
    for (int j = 0; j < NI; ++j) {
        bf4_fwd(e[j][0], e[j][4], e[j][8], e[j][12], b1, b2);
        bf4_fwd(e[j][1], e[j][5], e[j][9], e[j][13], w1a, w1b);
        bf4_fwd(e[j][2], e[j][6], e[j][10], e[j][14], w2a, w2b);
        bf4_fwd(e[j][3], e[j][7], e[j][11], e[j][15], w3a, w3b);
#pragma unroll
        for (int q = 0; q < 4; ++q) bf4_fwd(e[j][4 * q], e[j][4 * q + 1], e[j][4 * q + 2], e[j][4 * q + 3], b4, b8);
#pragma unroll
        for (int k = 0; k < 16; ++k) buf[j * FFT_BS + PD(base + k * S)] = e[j][k];
    }
    __syncthreads();
    if constexpr (M / 16 >= 32) fft_fwd_pass<N, M / 16, NI>(buf, tid);
}
constexpr float c32q(int k) { return k == 0 ? 1.f : k == 1 ? 0.98078528040323043f : k == 2 ? 0.92387953251128674f : k == 3 ? 0.83146961230254524f : k == 4 ? 0.70710678118654752f : k == 5 ? 0.55557023301960218f : k == 6 ? 0.38268343236508977f : k == 7 ? 0.19509032201612825f : 0.f; }
constexpr float c32(int k) { return k <= 8 ? c32q(k) : -c32q(16 - k); }
constexpr float s32(int k) { return k <= 8 ? c32q(8 - k) : c32q(k - 8); }
DI void bf4_fwd_t(f32x2v& x0, f32x2v& x1, f32x2v& x2, f32x2v& x3) {
    const f32x2v a0 = x0 + x2, a2 = x0 - x2, a1 = x1 + x3, a3 = mul_mi(x1 - x3);
    x0 = a0 + a1; x1 = a0 - a1; x2 = a2 + a3; x3 = a2 - a3;
}
DI void bf4_fwd_b1(f32x2v& x0, f32x2v& x1, f32x2v& x2, f32x2v& x3) {
    constexpr float R2 = 0.70710678118654752f;
    const f32x2v a0 = x0 + x2, a2 = cmul(x0 - x2, mk2(R2, -R2)), a1 = x1 + x3, a3 = cmul(x1 - x3, mk2(-R2, -R2));
    x0 = a0 + a1; x1 = mul_mi(a0 - a1); x2 = a2 + a3; x3 = mul_mi(a2 - a3);
}
DI void bf4_inv_t(f32x2v& x0, f32x2v& x1, f32x2v& x2, f32x2v& x3) {
    const f32x2v a0 = x0 + x1, a1 = x0 - x1, a2 = x2 + x3, a3 = x2 - x3; const f32x2v t3b = mul_pi(a3);
    x0 = a0 + a2; x1 = a1 + t3b; x2 = a0 - a2; x3 = a1 - t3b;
}
DI void bf4_inv_b1(f32x2v& x0, f32x2v& x1, f32x2v& x2, f32x2v& x3) {
    constexpr float R2 = 0.70710678118654752f;
    const f32x2v t1 = mul_pi(x1), t3 = mul_pi(x3); const f32x2v a0 = x0 + t1, a1 = x0 - t1, a2 = x2 + t3, a3 = x2 - t3;
    const f32x2v t2 = cmul(a2, mk2(R2, R2)), t3b = cmul(a3, mk2(-R2, R2));
    x0 = a0 + t2; x1 = a1 + t3b; x2 = a0 - t2; x3 = a1 - t3b;
}
template <int NI> DI void fft_r32_fwd(LAS f32x2v* buf, int tid) {
    const int img = tid >> 8, g = tid & 255;
    if (img < NI) {
        LAS f32x4v* p = (LAS f32x4v*)(buf + img * FFT_BS + 34 * g);
        f32x2v r[32];
#pragma unroll
        for (int m = 0; m < 16; ++m) { const f32x4v v = p[m]; r[2 * m] = mk2(v.x, v.y); r[2 * m + 1] = mk2(v.z, v.w); }
        bf4_fwd_t(r[0], r[8], r[16], r[24]);
#pragma unroll
        for (int j = 1; j < 8; ++j) bf4_fwd(r[j], r[j + 8], r[j + 16], r[j + 24], mk2(c32(j), -s32(j)), mk2(c32(2 * j), -s32(2 * j)));
#pragma unroll
        for (int q = 0; q < 4; ++q) { bf4_fwd_t(r[8 * q], r[8 * q + 2], r[8 * q + 4], r[8 * q + 6]); bf4_fwd_b1(r[8 * q + 1], r[8 * q + 3], r[8 * q + 5], r[8 * q + 7]); }
#pragma unroll
        for (int m = 0; m < 16; ++m) { const f32x2v a = r[2 * m] + r[2 * m + 1], b = r[2 * m] - r[2 * m + 1]; p[m] = (f32x4v){a.x, a.y, b.x, b.y}; }
    }
    __syncthreads();
}
template <int NI> DI void fft_r32_inv(LAS f32x2v* buf, int tid) {
    const int img = tid >> 8, g = tid & 255;
    if (img < NI) {
        LAS f32x4v* p = (LAS f32x4v*)(buf + img * FFT_BS + 34 * g);
        f32x2v r[32];
#pragma unroll
        for (int m = 0; m < 16; ++m) { const f32x4v v = p[m]; r[2 * m] = mk2(v.x + v.z, v.y + v.w); r[2 * m + 1] = mk2(v.x - v.z, v.y - v.w); }
#pragma unroll
        for (int q = 0; q < 4; ++q) { bf4_inv_t(r[8 * q], r[8 * q + 2], r[8 * q + 4], r[8 * q + 6]); bf4_inv_b1(r[8 * q + 1], r[8 * q + 3], r[8 * q + 5], r[8 * q + 7]); }
        bf4_inv_t(r[0], r[8], r[16], r[24]);
#pragma unroll
        for (int j = 1; j < 8; ++j) bf4_inv(r[j], r[j + 8], r[j + 16], r[j + 24], mk2(c32(j), s32(j)), mk2(c32(2 * j), s32(2 * j)));
#pragma unroll
        for (int m = 0; m < 16; ++m) p[m] = (f32x4v){r[2 * m].x, r[2 * m].y, r[2 * m + 1].x, r[2 * m + 1].y};
    }
    __syncthreads();
}
template <int N, int NI = 1> DI void fft_fwd(LAS f32x2v* buf, int tid) {
    asm volatile("" : "+v"(tid));
    fft_fwd_pass<N, N / 2, NI>(buf, tid);
    fft_r32_fwd<NI>(buf, tid);
}
template <int N, int M, int NI = 1, bool REC = true> DI void fft_inv_pass(LAS f32x2v* buf, int tid) {
    const int tr = tid / (N / 16), u = tid % (N / 16), g = u / M, p = u % M; const int base = tr * N + g * 16 * M + p;
    f32x2v e[NI][16];
#pragma unroll
    for (int j = 0; j < NI; ++j)
#pragma unroll
        for (int k = 0; k < 16; ++k) e[j][k] = buf[j * FFT_BS + PD(base + k * M)];
    const f32x2v a1 = twid(p, 16 * M), a2 = cmul(a1, a1), a4 = cmul(a2, a2), a8 = cmul(a4, a4);
    constexpr float C1 = 0.92387953251128674f, S1 = 0.38268343236508977f, R2 = 0.70710678118654752f;
    const f32x2v v1a = cmul(a1, mk2(C1, S1)), v1b = cmul(a2, mk2(R2, R2)), v2a = cmul(a1, mk2(R2, R2)), v2b = mul_pi(a2), v3a = cmul(a1, mk2(S1, C1)), v3b = cmul(a2, mk2(-R2, R2));
#pragma unroll
    for (int j = 0; j < NI; ++j) {
#pragma unroll
        for (int q = 0; q < 4; ++q) bf4_inv(e[j][4 * q], e[j][4 * q + 1], e[j][4 * q + 2], e[j][4 * q + 3], a4, a8);
        bf4_inv(e[j][0], e[j][4], e[j][8], e[j][12], a1, a2);
        bf4_inv(e[j][1], e[j][5], e[j][9], e[j][13], v1a, v1b);
        bf4_inv(e[j][2], e[j][6], e[j][10], e[j][14], v2a, v2b);
        bf4_inv(e[j][3], e[j][7], e[j][11], e[j][15], v3a, v3b);
#pragma unroll
        for (int k = 0; k < 16; ++k) buf[j * FFT_BS + PD(base + k * M)] = e[j][k];
    }
    __syncthreads();
    if constexpr (REC && 16 * M < N) fft_inv_pass<N, 16 * M, NI>(buf, tid);
}
template <int N, int NI = 1> DI void fft_inv(LAS f32x2v* buf, int tid) {
    asm volatile("" : "+v"(tid));
    fft_r32_inv<NI>(buf, tid);
    fft_inv_pass<N, 32, NI>(buf, tid);
}
DI v2u ks_pack(float a, float b, float cc, float d) { v2u w; w.x = __builtin_bit_cast(unsigned, __builtin_amdgcn_cvt_pkrtz(a, b)); w.y = __builtin_bit_cast(unsigned, __builtin_amdgcn_cvt_pkrtz(cc, d)); return w; }
DI float h2f(unsigned short h) { return (float)__builtin_bit_cast(_Float16, h); }
DI f32x4v ks_unpack(v2u w) { return (f32x4v){h2f((unsigned short)(w.x & 0xffffu)), h2f((unsigned short)(w.x >> 16)), h2f((unsigned short)(w.y & 0xffffu)), h2f((unsigned short)(w.y >> 16))}; }
template <int N> DI int ks_perm(int e) { if constexpr (N == 8192) return e < 4096 ? (((e & 63) << 6) | (e >> 6)) : e; else return e; }
template <int N, int NI> DI void fft_pairmul_pre(LAS f32x2v* buf, const v2u (&ksr)[8], const v2u* KS, int tid) {
    asm volatile("" : "+v"(tid));
    constexpr int LOG = (N == 8192) ? 13 : 9, NB = 8192 / N, NK = N / 2 + 1;
#pragma unroll
    for (int r = 0; r < 9; ++r) {
        const int idx = tid + 512 * r;
        if (r == 8 && idx >= NB * NK) break;
        v2u kw; if (r < 8) kw = ksr[r]; else kw = KS[idx]; const f32x4v ks = ks_unpack(kw);
        const int tr = idx / NK, k = ks_perm<N>(idx % NK);
        const int pk = PD(tr * N + (int)(__brev((unsigned)k) >> (32 - LOG))), pn = PD(tr * N + (int)(__brev((unsigned)((N - k) & (N - 1))) >> (32 - LOG)));
#pragma unroll
        for (int j = 0; j < NI; ++j) {
            const f32x2v zk = buf[j * FFT_BS + pk], zn = buf[j * FFT_BS + pn];
            constexpr float hn_ = 0.5f / (float)N; const f32x2v u1 = mk2(hn_ * (zk.x + zn.x), hn_ * (zk.y - zn.y)), u2 = mk2(hn_ * (zk.y + zn.y), -hn_ * (zk.x - zn.x));
            const f32x2v y1 = cmul(u1, mk2(ks.x, ks.y)), y2 = cmul(u2, mk2(ks.z, ks.w));
            buf[j * FFT_BS + pk] = mk2(y1.x - y2.y, y1.y + y2.x);
            if (pn != pk) buf[j * FFT_BS + pn] = mk2(y1.x + y2.y, -y1.y + y2.x);
        }
    }
}
template <int N, int NI> DI void fft_fwd_first(LAS f32x2v* buf, int tid, const float (&u0)[NI][8], const float (&u1)[NI][8]) {
    asm volatile("" : "+v"(tid));
    constexpr int M = N / 2, S = M / 8;
    const int tr = tid / (N / 16), p = tid % (N / 16); const int base = tr * N + p;
    const f32x2v bc = twid(p, 2 * M); const f32x2v b1 = mk2(bc.x, -bc.y), b2 = cmul(b1, b1), b4 = cmul(b2, b2), b8 = cmul(b4, b4);
    constexpr float C1 = 0.92387953251128674f, S1 = 0.38268343236508977f, R2 = 0.70710678118654752f;
    const f32x2v w1a = cmul(b1, mk2(C1, -S1)), w1b = cmul(b2, mk2(R2, -R2)), w2a = cmul(b1, mk2(R2, -R2)), w2b = mul_mi(b2), w3a = cmul(b1, mk2(S1, -C1)), w3b = cmul(b2, mk2(-R2, -R2));
    __syncthreads();
#pragma unroll
    for (int j = 0; j < NI; ++j) {
        f32x2v e[16];
#define FFT_HALF_FWD(i, w0, wm) { const f32x2v x0 = mk2(u0[j][i], u1[j][i]), x1 = mk2(u0[j][i + 4], u1[j][i + 4]); const f32x2v a2 = cmul(x0, w0), a3 = cmul(x1, mul_mi(w0)); \
            e[i] = x0 + x1; e[i + 4] = cmul(x0 - x1, wm); e[i + 8] = a2 + a3; e[i + 12] = cmul(a2 - a3, wm); }
        FFT_HALF_FWD(0, b1, b2) FFT_HALF_FWD(1, w1a, w1b) FFT_HALF_FWD(2, w2a, w2b) FFT_HALF_FWD(3, w3a, w3b)
#undef FFT_HALF_FWD
#pragma unroll
        for (int q = 0; q < 4; ++q) bf4_fwd(e[4 * q], e[4 * q + 1], e[4 * q + 2], e[4 * q + 3], b4, b8);
#pragma unroll
        for (int k = 0; k < 16; ++k) buf[j * FFT_BS + PD(base + k * S)] = e[k];
    }
    __syncthreads();
}
template <int N, int NI> DI void fft_inv_last(LAS f32x2v* buf, int tid, f32x2v (&out)[NI][8]) {
    asm volatile("" : "+v"(tid));
    constexpr int M = N / 16;
    const int tr = tid / (N / 16), p = tid % (N / 16); const int base = tr * N + p;
    const f32x2v a1 = twid(p, 16 * M), a2 = cmul(a1, a1), a4 = cmul(a2, a2), a8 = cmul(a4, a4);
    constexpr float C1 = 0.92387953251128674f, S1 = 0.38268343236508977f, R2 = 0.70710678118654752f;
    const f32x2v v1a = cmul(a1, mk2(C1, S1)), v1b = cmul(a2, mk2(R2, R2)), v2a = cmul(a1, mk2(R2, R2)), v2b = mul_pi(a2), v3a = cmul(a1, mk2(S1, C1)), v3b = cmul(a2, mk2(-R2, R2));
#pragma unroll
    for (int j = 0; j < NI; ++j) {
        f32x2v e[16];
#pragma unroll
        for (int k = 0; k < 16; ++k) e[k] = buf[j * FFT_BS + PD(base + k * M)];
#pragma unroll
        for (int q = 0; q < 4; ++q) bf4_inv(e[4 * q], e[4 * q + 1], e[4 * q + 2], e[4 * q + 3], a4, a8);
#define FFT_HALF_INV(i, wa, w) { const f32x2v t1 = cmul(e[i + 4], w), t3 = cmul(e[i + 12], w); const f32x2v a0 = e[i] + t1, a1_ = e[i] - t1, a2_ = e[i + 8] + t3, a3 = e[i + 8] - t3; \
            out[j][i] = a0 + cmul(a2_, wa); out[j][i + 4] = a1_ + cmul(a3, mul_pi(wa)); }
        FFT_HALF_INV(0, a1, a2) FFT_HALF_INV(1, v1a, v1b) FFT_HALF_INV(2, v2a, v2b) FFT_HALF_INV(3, v3a, v3b)
#undef FFT_HALF_INV
    }
}
template <int N, int NI = 1, bool SH = false> DI void fft_pairmul(LAS f32x2v* buf, const v2u* const (&KS)[NI]  , int tid) {
    asm volatile("" : "+v"(tid));
    constexpr int LOG = (N == 8192) ? 13 : 9, NB = 8192 / N, NK = N / 2 + 1;
    for (int idx = tid; idx < NB * NK; idx += 512) {
        const int tr = idx / NK, k = ks_perm<N>(idx % NK);
        const int pk = PD(tr * N + (int)(__brev((unsigned)k) >> (32 - LOG))), pn = PD(tr * N + (int)(__brev((unsigned)((N - k) & (N - 1))) >> (32 - LOG)));
        f32x4v ks0 = {0.f, 0.f, 0.f, 0.f}; if (SH) ks0 = ks_unpack(KS[0][idx]);
#pragma unroll
        for (int j = 0; j < NI; ++j) {
            const f32x2v zk = buf[j * FFT_BS + pk], zn = buf[j * FFT_BS + pn]; const f32x4v ks = SH ? ks0 : ks_unpack(KS[j][idx]);
            constexpr float hn_ = 0.5f / (float)N; const f32x2v u1 = mk2(hn_ * (zk.x + zn.x), hn_ * (zk.y - zn.y)), u2 = mk2(hn_ * (zk.y + zn.y), -hn_ * (zk.x - zn.x));
            const f32x2v y1 = cmul(u1, mk2(ks.x, ks.y)), y2 = cmul(u2, mk2(ks.z, ks.w));
            buf[j * FFT_BS + pk] = mk2(y1.x - y2.y, y1.y + y2.x);
            if (pn != pk) buf[j * FFT_BS + pn] = mk2(y1.x + y2.y, -y1.y + y2.x);
        }
    }
}
template <int T> DI void hyena_filter_item(Ctx& C, int o, int n, int pair0) {
    constexpr int N = 2 * T, NB = 4096 / T, LOG = (N == 8192) ? 13 : 9, NK = N / 2 + 1;
    const bf16* KT = (const bf16*)(C.ws + WS_SCAN); LAS f32x2v* buf = (LAS f32x2v*)C.lds; LAS float* red = (LAS float*)(C.lds + FFT_BUF_BYTES + 1024);
    int tid = C.tid; asm volatile("" : "+v"(tid)); const int toff = T == 256 ? 0 : 256;
    const float dmin = 4.605170185988092f / 1.5f, dmax = 4.605170185988092f / 0.3f;
    __syncthreads();
    if (tid < 2 * NB) red[tid] = 0.f;
    __syncthreads();
    float k0[16], k1[16];
#pragma unroll
    for (int i = 0; i < 16; ++i) { const int idx = tid + 512 * i, tr = idx / N, pos = idx % N; const int c = 2 * (pair0 + tr);
        float a = 0.f, b = 0.f;
        if (pos != T) { const int side = pos > T ? 1 : 0, tt = pos > T ? N - pos : pos; const float tn = (float)tt / (float)(T - 1);
            const bf16* kr = KT + ((size_t)o * 8192 + (n * 2 + side) * 2048 + c) * 4352 + toff + tt;
            const float d0 = dmin + (dmax - dmin) * ((float)c / 2047.0f), d1 = dmin + (dmax - dmin) * ((float)(c + 1) / 2047.0f);
            a = bf2f(kr[0]) * expf(-tn * d0); b = bf2f(kr[4352]) * expf(-tn * d1); }
        k0[i] = a; k1[i] = b;
        const float sa = wave_sum(fabsf(a)), sb = wave_sum(fabsf(b));
        if (C.lane == 0) { __hip_atomic_fetch_add(&red[2 * tr], sa, __ATOMIC_RELAXED, __HIP_MEMORY_SCOPE_WORKGROUP); __hip_atomic_fetch_add(&red[2 * tr + 1], sb, __ATOMIC_RELAXED, __HIP_MEMORY_SCOPE_WORKGROUP); } }
    __syncthreads();
    int tl = tid; asm volatile("" : "+v"(tl));
#pragma unroll
    for (int i = 0; i < 16; ++i) { const int idx = tl + 512 * i, tr = idx / N; f32x2v kv = mk2(k0[i] / red[2 * tr], k1[i] / red[2 * tr + 1]);
        if (idx % N == 0) { const float* hb = C.in[I_HB] + (size_t)(o * 2 + n) * 2048 + 2 * (pair0 + tr); kv.x += hb[0]; kv.y += hb[1]; }
        buf[PD(idx)] = kv; }
    __syncthreads();
    fft_fwd<N>(buf, tid);
    v2u* KS = (v2u*)(C.ws + (T == 256 ? WS_KSP : WS_KSS)) + ((size_t)(o * 2 + n) * 1024 + pair0) * NK;
    for (int idx = tid; idx < NB * NK; idx += 512) { const int tr = idx / NK, k = ks_perm<N>(idx % NK);
        const int pk = tr * N + (int)(__brev((unsigned)k) >> (32 - LOG)), pn = tr * N + (int)(__brev((unsigned)((N - k) & (N - 1))) >> (32 - LOG));
        const f32x2v zk = buf[PD(pk)], zn = buf[PD(pn)];
        KS[idx] = ks_pack(0.5f * (zk.x + zn.x), 0.5f * (zk.y - zn.y), 0.5f * (zk.y + zn.y), -0.5f * (zk.x - zn.x)); }
}
DI void phase_hyena_filters(Ctx& C) {
    for (int it = C.vb; it < 4 * 1024 + 4 * 64; it += C.G) {
        if (it < 4096) hyena_filter_item<4096>(C, it >> 11, (it >> 10) & 1, it & 1023);
        else { const int v = it - 4096; hyena_filter_item<256>(C, v >> 7, (v >> 6) & 1, (v & 63) * 16); }
    }
    __syncthreads();
}
template <int T, int NI, int PROBE = 0, bool SH = false> DI void hyena_conv_item(Ctx& C, int o, const int (&seq)[NI], const int (&pair0)[NI]) {
    constexpr int N = 2 * T, NB = 4096 / T, NK = N / 2 + 1;
    LAS f32x2v* buf = (LAS f32x2v*)C.lds; const int tid = C.tid;
    const float* cw = C.in[I_CW] + (size_t)o * 3 * 6144; const float* cb = C.in[I_CB] + (size_t)o * 6144;
    bf16* Y = (bf16*)(C.ws + WS_MIX);
    const float* ZT[NI]; const v2u* KS0[NI]; const v2u* KS1[NI]; int rowbase[NI];
#pragma unroll
    for (int j = 0; j < NI; ++j) { ZT[j] = (const float*)(C.ws + WS_Z + (T == 256 ? 0 : ZT_S_OFF)) + (size_t)seq[j] * 6144 * T;
        KS0[j] = (const v2u*)(C.ws + (T == 256 ? WS_KSP : WS_KSS)) + ((size_t)(o * 2 + 0) * 1024 + pair0[j]) * NK; KS1[j] = KS0[j] + (size_t)1024 * NK;
        rowbase[j] = T == 256 ? seq[j] * 256 : MP + seq[j] * 4096; }
    constexpr int NQ = SH ? 1 : NI;
    float wq[NQ][6][4];
    if constexpr (T == 4096) {
        auto sg = [](float v) { return __builtin_bit_cast(float, __builtin_amdgcn_readfirstlane(__builtin_bit_cast(int, v))); };
#pragma unroll
        for (int j = 0; j < NQ; ++j) {
#pragma unroll
            for (int gq = 0; gq < 6; ++gq) { const int ch = (gq >> 1) * 2048 + 2 * pair0[j] + (gq & 1); wq[j][gq][0] = sg(cw[ch]); wq[j][gq][1] = sg(cw[6144 + ch]); wq[j][gq][2] = sg(cw[2 * 6144 + ch]); wq[j][gq][3] = sg(cb[ch]); }
        }
    }
    auto ld3 = [&](int j, int grp, int jj, int c, int t, float (&z)[3]) __attribute__((always_inline)) { const int ch = grp * 2048 + c + jj; const float* zr = ZT[j] + (size_t)ch * T + t; z[0] = zr[-1]; z[1] = zr[0]; z[2] = zr[1]; };
    auto ap3 = [&](int j, int grp, int jj, int c, int t, const float (&z)[3]) __attribute__((always_inline)) { const int ch = grp * 2048 + c + jj; const float zp = t > 0 ? z[0] : 0.f, zn = t < T - 1 ? z[2] : 0.f;
        if constexpr (T == 4096) { const int jq = SH ? 0 : j; return wq[jq][grp * 2 + jj][0] * zp + wq[jq][grp * 2 + jj][1] * z[1] + wq[jq][grp * 2 + jj][2] * zn + wq[jq][grp * 2 + jj][3]; }
        else return cw[ch] * zp + cw[6144 + ch] * z[1] + cw[2 * 6144 + ch] * zn + cb[ch]; };
    float gz[NI][8][2][3]; constexpr int NPRE = (T == 4096) ? NI : 1;
    float u0[NI][8], u1[NI][8]; f32x2v cv[NI][8];
    int tl = tid; asm volatile("" : "+v"(tl));
#pragma unroll
    for (int j = 0; j < NI; ++j)
#pragma unroll
        for (int i = 0; i < 8; ++i) { const int tr = tl / (N / 16), t = tl % (N / 16) + (N / 16) * i, c = 2 * (pair0[j] + tr);
            float z0[3], z1[3]; ld3(j, 2, 0, c, t, z0); ld3(j, 2, 1, c, t, z1); u0[j][i] = ap3(j, 2, 0, c, t, z0); u1[j][i] = ap3(j, 2, 1, c, t, z1); }
    v2u ksr[8];
    if constexpr (SH) {
#pragma unroll
        for (int r = 0; r < 8; ++r) ksr[r] = KS0[0][tl + 512 * r]; }
    fft_fwd_first<N, NI>(buf, tid, u0, u1);
    if constexpr (N == 8192) { int tf = tid; asm volatile("" : "+v"(tf)); fft_fwd_pass<N, 256, NI>(buf, tf); }
    { int tf = tid; asm volatile("" : "+v"(tf)); fft_r32_fwd<NI>(buf, tf); }
    if constexpr (SH) fft_pairmul_pre<N, NI>(buf, ksr, KS0[0], tid); else fft_pairmul<N, NI, SH>(buf, KS0, tid);
    __syncthreads();
    { int tf = tid; asm volatile("" : "+v"(tf)); fft_r32_inv<NI>(buf, tf); }
    if constexpr (N == 8192) { int tf = tid; asm volatile("" : "+v"(tf)); fft_inv_pass<N, 32, NI, false>(buf, tf); }
    tl = tid; asm volatile("" : "+v"(tl));
#pragma unroll
    for (int j = 0; j < NPRE; ++j)
#pragma unroll
        for (int i = 0; i < 8; ++i) { const int tr = tl / (N / 16), t = tl % (N / 16) + (N / 16) * i, c = 2 * (pair0[j] + tr); ld3(j, 0, 0, c, t, gz[j][i][0]); ld3(j, 0, 1, c, t, gz[j][i][1]); }
    fft_inv_last<N, NI>(buf, tid, cv);
#pragma unroll
    for (int j = NPRE; j < NI; ++j)
#pragma unroll
        for (int i = 0; i < 8; ++i) { const int tr = tl / (N / 16), t = tl % (N / 16) + (N / 16) * i, c = 2 * (pair0[j] + tr); ld3(j, 0, 0, c, t, gz[j][i][0]); ld3(j, 0, 1, c, t, gz[j][i][1]); }
#pragma unroll
    for (int j = 0; j < NI; ++j)
#pragma unroll
        for (int i = 0; i < 8; ++i) { const int tr = tl / (N / 16), t = tl % (N / 16) + (N / 16) * i, c = 2 * (pair0[j] + tr);
            u0[j][i] = ap3(j, 0, 0, c, t, gz[j][i][0]) * cv[j][i].x; u1[j][i] = ap3(j, 0, 1, c, t, gz[j][i][1]) * cv[j][i].y; }
    if constexpr (SH) {
#pragma unroll
        for (int r = 0; r < 8; ++r) ksr[r] = KS1[0][tl + 512 * r]; }
    fft_fwd_first<N, NI>(buf, tid, u0, u1);
    if constexpr (N == 8192) { int tf = tid; asm volatile("" : "+v"(tf)); fft_fwd_pass<N, 256, NI>(buf, tf); }
    { int tf = tid; asm volatile("" : "+v"(tf)); fft_r32_fwd<NI>(buf, tf); }
    if constexpr (SH) fft_pairmul_pre<N, NI>(buf, ksr, KS1[0], tid); else fft_pairmul<N, NI, SH>(buf, KS1, tid);
    __syncthreads();
    { int tf = tid; asm volatile("" : "+v"(tf)); fft_r32_inv<NI>(buf, tf); }
    if constexpr (N == 8192) { int tf = tid; asm volatile("" : "+v"(tf)); fft_inv_pass<N, 32, NI, false>(buf, tf); }
    tl = tid; asm volatile("" : "+v"(tl));
#pragma unroll
    for (int j = 0; j < NPRE; ++j)
#pragma unroll
        for (int i = 0; i < 8; ++i) { const int tr = tl / (N / 16), t = tl % (N / 16) + (N / 16) * i, c = 2 * (pair0[j] + tr); ld3(j, 1, 0, c, t, gz[j][i][0]); ld3(j, 1, 1, c, t, gz[j][i][1]); }
    fft_inv_last<N, NI>(buf, tid, cv);
#pragma unroll
    for (int j = NPRE; j < NI; ++j)
#pragma unroll
        for (int i = 0; i < 8; ++i) { const int tr = tl / (N / 16), t = tl % (N / 16) + (N / 16) * i, c = 2 * (pair0[j] + tr); ld3(j, 1, 0, c, t, gz[j][i][0]); ld3(j, 1, 1, c, t, gz[j][i][1]); }
#pragma unroll
    for (int j = 0; j < NI; ++j)
#pragma unroll
        for (int i = 0; i < 8; ++i) { const int tr = tl / (N / 16), t = tl % (N / 16) + (N / 16) * i, c = 2 * (pair0[j] + tr);
            const float y0 = ap3(j, 1, 0, c, t, gz[j][i][0]) * cv[j][i].x, y1 = ap3(j, 1, 1, c, t, gz[j][i][1]) * cv[j][i].y;
            *(unsigned*)(Y + (size_t)(rowbase[j] + t) * 2048 + c) = pk2(y0, y1); }
}
template <int PROBE = 0> DI void phase_hyena_conv(Ctx& C, int o) {
    if (C.G == 256) {
        for (int it = C.vb; it < 1024 + 512; it += C.G) {
            if (it < 1024) { const int sq[2] = {0, 1}, pr[2] = {it, it}; hyena_conv_item<4096, 2, PROBE, true>(C, o, sq, pr); }
            else { const int v = it - 1024; const int sq[2] = {2 * (v >> 6), 2 * (v >> 6) + 1}, pr[2] = {(v & 63) * 16, (v & 63) * 16}; hyena_conv_item<256, 2, PROBE, true>(C, o, sq, pr); }
        }
    } else {
        for (int it = C.vb; it < 2048 + 1024; it += C.G) {
            if (it < 2048) { const int sq[1] = {it >> 10}, pr[1] = {it & 1023}; hyena_conv_item<4096, 1, PROBE>(C, o, sq, pr); }
            else { const int v = it - 2048; const int sq[1] = {v >> 6}, pr[1] = {(v & 63) * 16}; hyena_conv_item<256, 1, PROBE>(C, o, sq, pr); }
        }
    }
    __syncthreads();
}

#ifndef ONE_LAUNCH
#define ONE_LAUNCH 1
#endif
#ifndef SKIP_FFN
#define SKIP_FFN 0
#endif
#ifndef SKIP_EVEN
#define SKIP_EVEN 0
#endif
#ifndef SKIP_ODD
#define SKIP_ODD 0
#endif
#ifndef DUP_FFN
#define DUP_FFN 0
#endif
#ifndef DUP_EVEN
#define DUP_EVEN 0
#endif
#ifndef DUP_ODD
#define DUP_ODD 0
#endif
#ifndef DUP_PRO
#define DUP_PRO 0
#endif
#ifndef DUP_E
#define DUP_E 0
#endif
#ifndef DUP_O
#define DUP_O 0
#endif
constexpr int NPH_MAX = 96;
template <int V> struct IntC { static constexpr int value = V; };
DI void launder(Ctx& C, const KArgs& a) { const int t = lane_id_v(); C.lane = t; C.tid = C.wave * 64 + t;
    int z = 0; asm volatile("" : "+v"(z)); const int zs = __builtin_amdgcn_readfirstlane(z);
    C.ws = a.ws + zs; C.in = a.in + zs; C.out = a.out + zs;
    C.zs = zs; C.G = (int)gridDim.x + zs; C.bx = (int)blockIdx.x + zs; C.gw = C.bx * 8 + C.wave; C.NGW = C.G * 8; C.vb = (C.G % 8 == 0) ? (C.bx % 8) * (C.G / 8) + C.bx / 8 : C.bx; }
__global__ void __launch_bounds__(512, 2) mega_fwd(KArgs args) {
    extern __shared__ __attribute__((aligned(16))) unsigned char lds_raw[];
    Ctx C;
    C.lds = (LAS unsigned char*)lds_raw; C.ws = args.ws; C.in = args.in; C.out = args.out;
    C.wave = __builtin_amdgcn_readfirstlane((int)threadIdx.x >> 6); C.lane = lane_id_v(); C.tid = C.wave * 64 + C.lane;
    C.zs = 0; C.G = 0; C.bx = 0; C.gw = 0; C.NGW = 0; C.vb = 0;
    for (int u = C.tid; u < (LDS_BYTES - LDS_CTL) / 4; u += 512) ((LAS unsigned*)(C.lds + LDS_CTL))[u] = 0u;
    __syncthreads();
    (void)xcd_barrier_post((unsigned*)(args.ws + WS_CTL) + 4096, (volatile LAS unsigned*)(C.lds + LDS_CTL + 64), C.tid);
#if ONE_LAUNCH
    constexpr int lo = 0, hi = 1 << 20; int ph = 0;
#else
    const int lo = args.ph_lo, hi = args.ph_hi; int ph = 0;
#endif
#define PH_IF if (ph >= lo && ph < hi) if (launder(C, args), true)
#define PH_NEXT do { const bool both_ = (ph >= lo) && (ph + 1 < hi); ++ph; if (both_) { launder(C, args); XcdBarrier b_; b_.bar = (unsigned*)(C.ws + WS_CTL) + 4096; b_.x = xb_xcc_id() + (unsigned)C.zs; b_.st = (volatile LAS unsigned*)(C.lds + LDS_CTL + 64); xcd_barrier(b_, C.tid); } } while (0)
#define ring C.lds
#define MOD ((const float*)(C.ws + WS_MOD))
#define X ((float*)(C.ws + WS_X))

#if DUP_PRO == 1
    PH_IF { phase_prologue(C); } PH_NEXT;
#endif
    PH_IF {
#ifndef NO_PROLOGUE
 phase_prologue(C);
#endif
 } PH_NEXT;
    PH_IF { phase_mod_reduce(C);
        pg8::Gemm g{(const bf16*)(C.ws + WS_W3T), (const bf16*)(C.ws + WS_H2), 16384, 4352, 256}; pg8::StaticOrder S; S.init(16384, 4352, C.G, C.bx);
        pg8::EpiBf16Plain E{(bf16*)(C.ws + WS_SCAN), 4352};
        pg8::gemm_phase<pg8::EpiBf16Plain, pg8::StaticOrder, false, false>(ring, g, S, E, C.wave); } PH_NEXT;
#if DUP_PRO == 2
    PH_IF { phase_hyena_filters(C); } PH_NEXT;
#endif
    PH_IF {
#ifndef NO_HYENA
 phase_hyena_filters(C);
#endif
 } PH_NEXT;

#define FFN_BLOCK(l, fi, s, cf) do { \
    if (!SKIP_FFN) { \
    PH_IF { phase_norm_mod(C, C.in[I_NG] + ((l) * 3 + (s)) * 2048, MOD + (size_t)(l) * MODL, (s)); } PH_NEXT; \
    PH_IF { pg8::Gemm g{(const bf16*)(C.ws + WS_H), (const bf16*)(C.ws + WS_W1T) + (size_t)((l) * 2 + (fi)) * NFF1 * 2048, MT, NFF1, 2048}; pg8::StaticOrder S; S.init(MT, NFF1, C.G, C.bx); \
        pg8::EpiSwiGLU E{(bf16*)(C.ws + WS_ACT), DFF}; pg8::gemm_phase<pg8::EpiSwiGLU, pg8::StaticOrder, false, true>(ring, g, S, E, C.wave); \
        { const int nf_ = (l) * 2 + (fi) + 1, idle0_ = (MT / 256) * (NFF1 / 256) % C.G; if ((cf) != 0.0f && nf_ < 8 && C.bx >= idle0_) { launder(C, args); \
            tr_matrix<0>(C, C.in[I_WFO] + (size_t)nf_ * DFF * 2048, 2048, DFF, (bf16*)(C.ws + WS_W2T) + (size_t)nf_ * 2048 * DFF, 2048, 2048, (C.bx - idle0_) * 8 + C.wave, (C.G - idle0_) * 8); } } } PH_NEXT; \
    PH_IF { pg8::Gemm g{(const bf16*)(C.ws + WS_ACT), (const bf16*)(C.ws + WS_W2T) + (size_t)((l) * 2 + (fi)) * 2048 * DFF, MT, 2048, DFF}; \
        pg8::EpiRes E{X, MOD + (size_t)(l) * MODL + (3 * (s) + 2) * 2048, (cf)}; \
        { pg8::PairOrder<1> S; S.init(MT, 2048, DFF, C.G, C.bx, (float*)(C.ws + WS_Z), (unsigned*)(C.ws + WS_CTL) + 16384, (DUP_FFN ? 8u * (unsigned)(2 * ((l) * 2 + (fi)) + ((cf) != 0.0f ? 2 : 1)) : 8u * (unsigned)((l) * 2 + (fi) + 1))); \
          pg8::gemm_phase<pg8::EpiRes, pg8::PairOrder<1>, false, true>(ring, g, S, E, C.wave); } \
        { launder(C, args); pg8::PairOrder<2> S; S.init(MT, 2048, DFF, C.G, C.bx, (float*)(C.ws + WS_Z), (unsigned*)(C.ws + WS_CTL) + 16384, (DUP_FFN ? 8u * (unsigned)(2 * ((l) * 2 + (fi)) + ((cf) != 0.0f ? 2 : 1)) : 8u * (unsigned)((l) * 2 + (fi) + 1))); \
          pg8::Gemm g2{(const bf16*)(C.ws + WS_ACT), (const bf16*)(C.ws + WS_W2T) + (size_t)((l) * 2 + (fi)) * 2048 * DFF, MT, 2048, DFF}; pg8::EpiRes E2{X, MOD + (size_t)(l) * MODL + (3 * (s) + 2) * 2048, (cf)}; \
          pg8::gemm_phase<pg8::EpiRes, pg8::PairOrder<2>, true, true>(ring, g2, S, E2, C.wave); } \
        { const int nf_ = (l) * 2 + (fi) + 1; if ((cf) != 0.0f && nf_ < 8 && !(C.G >= 235 && !SKIP_EVEN && ((l) & 1) == 0 && (fi) == 0) && !(C.G == 256 && !SKIP_EVEN && ((l) & 1) == 0 && (fi) == 1)) { launder(C, args); \
            tr_matrix<1>(C, C.in[I_WFI] + (size_t)nf_ * 2048 * NFF1, NFF1, 2048, (bf16*)(C.ws + WS_W1T) + (size_t)nf_ * NFF1 * 2048, NFF1, NFF1, C.gw, C.NGW); } } } PH_NEXT; \
    } } while (0)

    auto layer_pair = [&](auto PC) __attribute__((always_inline)) {
        constexpr int p = decltype(PC)::value; constexpr int le = 2 * p, lod = 2 * p + 1;
#if DUP_FFN
        FFN_BLOCK(le, 0, 0, 0.0f);
#endif
        FFN_BLOCK(le, 0, 0, 0.5f);
        auto even_mix = [&](float cf, int qslot) __attribute__((always_inline)) {
            const int e = p;
            PH_IF { phase_norm_mod(C, C.in[I_NG] + (le * 3 + 1) * 2048, MOD + (size_t)le * MODL, 1); } PH_NEXT;
            PH_IF { pg8::Gemm g{(const bf16*)(C.ws + WS_H), (const bf16*)(C.ws + WS_WINE) + (size_t)e * ZE_P * 2048, MT, ZE_P, 2048}; pg8::StaticOrder S; S.init(MT, ZE_P, C.G, C.bx);
                pg8::EpiF32 E{(float*)(C.ws + WS_Z), ZE_P}; pg8::gemm_phase<pg8::EpiF32, pg8::StaticOrder, true, true>(ring, g, S, E, C.wave);
                { const int nf_ = le * 2 + 2, idle0_ = (MT / 256) * (ZE_P / 256) % C.G;
                  if (cf != 0.0f && C.G == 256 && C.bx >= idle0_) { launder(C, args);
                    tr_matrix<1>(C, C.in[I_WFI] + (size_t)nf_ * 2048 * NFF1, NFF1, 2048, (bf16*)(C.ws + WS_W1T) + (size_t)nf_ * NFF1 * 2048, NFF1, NFF1, (C.bx - idle0_) * 8 + C.wave, (C.G - idle0_) * 8); } } } PH_NEXT;
#if DUP_E == 5
            PH_IF { phase_even_prep(C, e); } PH_NEXT;
#endif
            PH_IF { phase_even_prep(C, e); } PH_NEXT;
#if DUP_E == 7
            PH_IF {
                { pg8::Gemm g{(const bf16*)(C.ws + WS_LA), (const bf16*)(C.ws + WS_WLORA) + (size_t)e * 5120 * 384, MT, 5120, 384}; pg8::StaticOrder S; S.init(MT, 5120, C.G, C.bx);
                  pg8::EpiLora E{C.ws, C.in[I_W0] + e * 2048, C.in[I_A0] + e * 2048, C.in[I_KA] + e * 1024, WS_SCAN + (size_t)e * SCAN_BYTES, WS_KBUF, WS_GB};
                  pg8::gemm_phase<pg8::EpiLora, pg8::StaticOrder, true, true>(ring, g, S, E, C.wave); }
                launder(C, args);
                { pg8::Gemm g{(const bf16*)(C.ws + WS_CQ), (const bf16*)(C.ws + WS_WQ) + (size_t)e * 1536 * 512, MT, 1536, 512}; pg8::StaticOrder S; S.init(MT, 1536, C.G, C.bx);
                  pg8::EpiQ E{(bf16*)(C.ws + WS_Q), (const float*)(C.ws + WS_ROPE), 0.07216878364870322f * 1.4426950408889634f};
                  pg8::gemm_phase<pg8::EpiQ, pg8::StaticOrder, true, true>(ring, g, S, E, C.wave); }
                launder(C, args);
                { pg8::Gemm g{(const bf16*)(C.ws + WS_CKV), (const bf16*)(C.ws + WS_WKN) + (size_t)e * 1024 * 256, MKV, 1024, 256}; pg8::StaticOrder S; S.init(MKV, 1024, C.G, C.bx);
                  pg8::EpiBf16Plain E{(bf16*)(C.ws + WS_KN), 1024};
                  pg8::gemm_phase<pg8::EpiBf16Plain, pg8::StaticOrder, false, false>(ring, g, S, E, C.wave); }
                launder(C, args);
                { pg8::Gemm g{(const bf16*)(C.ws + WS_WV) + (size_t)e * 1024 * 256, (const bf16*)(C.ws + WS_CKV), 1024, MKV, 256}; pg8::StaticOrder S; S.init(1024, MKV, C.G, C.bx);
                  pg8::EpiVT E{(bf16*)(C.ws + WS_VT), VT_S_OFF / 2};
                  pg8::gemm_phase<pg8::EpiVT, pg8::StaticOrder, false, false>(ring, g, S, E, C.wave); }
            } PH_NEXT;
#endif
            PH_IF {
                { pg8::Gemm g{(const bf16*)(C.ws + WS_LA), (const bf16*)(C.ws + WS_WLORA) + (size_t)e * 5120 * 384, MT, 5120, 384}; pg8::StaticOrder S; S.init(MT, 5120, C.G, C.bx);
                  pg8::EpiLora E{C.ws, C.in[I_W0] + e * 2048, C.in[I_A0] + e * 2048, C.in[I_KA] + e * 1024, WS_SCAN + (size_t)e * SCAN_BYTES, WS_KBUF, WS_GB};
                  pg8::gemm_phase<pg8::EpiLora, pg8::StaticOrder, true, true>(ring, g, S, E, C.wave); }
                launder(C, args);
                { pg8::Gemm g{(const bf16*)(C.ws + WS_CQ), (const bf16*)(C.ws + WS_WQ) + (size_t)e * 1536 * 512, MT, 1536, 512}; pg8::StaticOrder S; S.init(MT, 1536, C.G, (C.bx + 64) % C.G);
                  pg8::EpiQ E{(bf16*)(C.ws + WS_Q), (const float*)(C.ws + WS_ROPE), 0.07216878364870322f * 1.4426950408889634f};
                  pg8::gemm_phase<pg8::EpiQ, pg8::StaticOrder, true, true>(ring, g, S, E, C.wave); }
                launder(C, args);
                { pg8::Gemm g{(const bf16*)(C.ws + WS_CKV), (const bf16*)(C.ws + WS_WKN) + (size_t)e * 1024 * 256, MKV, 1024, 256}; pg8::StaticOrder S; S.init(MKV, 1024, C.G, (C.bx + 32) % C.G);
                  pg8::EpiBf16Plain E{(bf16*)(C.ws + WS_KN), 1024};
                  pg8::gemm_phase<pg8::EpiBf16Plain, pg8::StaticOrder, false, false>(ring, g, S, E, C.wave); }
                launder(C, args);
                { pg8::Gemm g{(const bf16*)(C.ws + WS_WV) + (size_t)e * 1024 * 256, (const bf16*)(C.ws + WS_CKV), 1024, MKV, 256}; pg8::StaticOrder S; S.init(1024, MKV, C.G, (C.bx + 88) % C.G);
                  pg8::EpiVT E{(bf16*)(C.ws + WS_VT), VT_S_OFF / 2};
                  pg8::gemm_phase<pg8::EpiVT, pg8::StaticOrder, false, false>(ring, g, S, E, C.wave); }
            } PH_NEXT;
#if DUP_E == 1
            PH_IF { phase_scan1(C, e, 2); } PH_NEXT;
#endif
            PH_IF {
#ifndef NO_SCAN
 phase_scan1(C, e, qslot);
#endif
 } PH_NEXT;
#if DUP_E == 2
            PH_IF { phase_scan_carry(C, e, 8); __syncthreads(); } PH_NEXT;
#endif
            PH_IF { const bool host_ = cf != 0.0f && C.G >= 235; phase_scan_carry(C, e, host_ ? 3 : 8);
                if (host_ && C.bx >= 64 && C.wave >= 3) { launder(C, args); const int nf_ = le * 2 + 1;
                    tr_matrix<1>(C, C.in[I_WFI] + (size_t)nf_ * 2048 * NFF1, NFF1, 2048, (bf16*)(C.ws + WS_W1T) + (size_t)nf_ * NFF1 * 2048, NFF1, NFF1, (C.bx - 64) * 5 + C.wave - 3, (C.G - 64) * 5); }
                __syncthreads(); } PH_NEXT;
#if DUP_E == 3
            PH_IF { phase_scan3(C, e); } PH_NEXT;
#endif
#if DUP_E == 4
            PH_IF { phase_attention(C); } PH_NEXT;
#endif
            PH_IF {
#ifndef NO_SCAN
 phase_scan3(C, e);
#endif
#ifndef NO_ATTN
 phase_attention(C);
#endif
 } PH_NEXT;
#if DUP_E == 6
            PH_IF { phase_rwkv_post(C, e); } PH_NEXT;
#endif
            PH_IF { phase_rwkv_post(C, e); } PH_NEXT;
            PH_IF { pg8::Gemm g{(const bf16*)(C.ws + WS_MIX), (const bf16*)(C.ws + WS_WOUTE) + (size_t)e * 2048 * 2048, MT, 2048, 2048}; pg8::StaticOrder S; S.init(MT, 2048, C.G, C.bx);
                pg8::EpiRes E{X, MOD + (size_t)le * MODL + (3 * 1 + 2) * 2048, cf}; pg8::gemm_phase<pg8::EpiRes, pg8::StaticOrder, false, true>(ring, g, S, E, C.wave); } PH_NEXT;
        };
#if DUP_EVEN
        even_mix(0.0f, 1);
#endif
        if (!SKIP_EVEN) even_mix(1.0f, 0);
#if DUP_FFN
        FFN_BLOCK(le, 1, 2, 0.0f);
#endif
        FFN_BLOCK(le, 1, 2, 0.5f);
#if DUP_FFN
        FFN_BLOCK(lod, 0, 0, 0.0f);
#endif
        FFN_BLOCK(lod, 0, 0, 0.5f);
        auto odd_mix = [&](float cf) __attribute__((always_inline)) {
            const int o = p;
            PH_IF { phase_norm_mod(C, C.in[I_NG] + (lod * 3 + 1) * 2048, MOD + (size_t)lod * MODL, 1); } PH_NEXT;
            PH_IF { pg8::Gemm g{(const bf16*)(C.ws + WS_WINO) + (size_t)o * 6144 * 2048, (const bf16*)(C.ws + WS_H), 6144, MT, 2048}; pg8::StaticOrder S; S.init(6144, MT, C.G, C.bx);
                pg8::EpiZT E{(float*)(C.ws + WS_Z), (float*)(C.ws + WS_Z + ZT_S_OFF)}; pg8::gemm_phase<pg8::EpiZT, pg8::StaticOrder, false, true>(ring, g, S, E, C.wave); } PH_NEXT;
#if DUP_O == 1
            PH_IF { phase_hyena_conv(C, o); } PH_NEXT;
#endif
#if DUP_O == 2
            PH_IF { phase_hyena_conv<1>(C, o); } PH_NEXT;
#endif
            PH_IF {
#ifndef NO_HYENA
 phase_hyena_conv(C, o);
#endif
 } PH_NEXT;
            PH_IF { pg8::Gemm g{(const bf16*)(C.ws + WS_MIX), (const bf16*)(C.ws + WS_WOUTO) + (size_t)o * 2048 * 2048, MT, 2048, 2048}; pg8::StaticOrder S; S.init(MT, 2048, C.G, C.bx);
                pg8::EpiRes E{X, MOD + (size_t)lod * MODL + (3 * 1 + 2) * 2048, cf}; pg8::gemm_phase<pg8::EpiRes, pg8::StaticOrder, false, true>(ring, g, S, E, C.wave); } PH_NEXT;
        };
#if DUP_ODD
        odd_mix(0.0f);
#endif
        if (!SKIP_ODD) odd_mix(1.0f);
#if DUP_FFN
        FFN_BLOCK(lod, 1, 2, 0.0f);
#endif
        FFN_BLOCK(lod, 1, 2, 0.5f);
    };
    layer_pair(IntC<0>{}); layer_pair(IntC<1>{});
    PH_IF { phase_final_norm(C); } PH_NEXT;
#undef MOD
#undef X
#undef ring
}

extern "C" void kernel_launch(void* const* d_in, const int* in_sizes, int n_in, void* d_out, int out_size, void* d_ws, size_t ws_size, hipStream_t stream) {
    static int grid = 0;
    if (grid == 0) {
        if (n_in != 42 || (size_t)out_size != OUT_END || ws_size < WS_END) { fprintf(stderr, "kernel_launch: unexpected sizes n_in %d out %d ws %zu (need %zu)\n", n_in, out_size, ws_size, (size_t)WS_END); grid = -1; return; }
        int dev = 0, cus = 0, per_cu = 0;
        if (hipGetDevice(&dev) != hipSuccess || hipDeviceGetAttribute(&cus, hipDeviceAttributeMultiprocessorCount, dev) != hipSuccess) { grid = -1; return; }
        if (hipFuncSetAttribute((const void*)mega_fwd, hipFuncAttributeMaxDynamicSharedMemorySize, LDS_BYTES) != hipSuccess) { fprintf(stderr, "kernel_launch: hipFuncSetAttribute failed\n"); grid = -1; return; }
        if (hipOccupancyMaxActiveBlocksPerMultiprocessor(&per_cu, (const void*)mega_fwd, 512, LDS_BYTES) != hipSuccess || per_cu < 1) fprintf(stderr, "kernel_launch: occupancy query says %d\n", per_cu);
        (void)hipGetLastError();
        grid = cus;
    }
    if (grid < 0) return;
    (void)hipMemsetAsync((char*)d_ws + WS_CTL, 0, CTL_ZERO_BYTES, stream);
    KArgs a{};
    for (int i = 0; i < 42; ++i) a.in[i] = (const float*)d_in[i];
    a.out = (float*)d_out; a.ws = (unsigned char*)d_ws;
#if ONE_LAUNCH
    a.ph_lo = 0; a.ph_hi = 1 << 20;
    hipLaunchKernelGGL(mega_fwd, dim3(grid), dim3(512), LDS_BYTES, stream, a);
#else
    for (int i = 0; i < NPH_MAX; ++i) { a.ph_lo = i; a.ph_hi = i + 1; hipLaunchKernelGGL(mega_fwd, dim3(grid), dim3(512), LDS_BYTES, stream, a); }
#endif
}
```

```cpp
#include <hip/hip_runtime.h>
#include <cstdio>
#include <cstdint>
#include <utility>
#define DI __device__ __forceinline__
#define GAS __attribute__((address_space(1)))
#define LAS __attribute__((address_space(3)))
#define CAS __attribute__((address_space(4)))
typedef unsigned short bf16;
typedef unsigned v4u __attribute__((ext_vector_type(4)));
typedef unsigned v2u __attribute__((ext_vector_type(2)));
typedef float f32x4v __attribute__((ext_vector_type(4)));
typedef float f32x2v __attribute__((ext_vector_type(2)));
typedef float f32x16v __attribute__((ext_vector_type(16)));
typedef short s16x8v __attribute__((ext_vector_type(8)));
typedef short s16x4v __attribute__((ext_vector_type(4)));

constexpr int D = 2048, MP = 4096, MS = 8192, MT = 12288, MKV = 12800;
constexpr int DFF = 5632, NFF1 = 11264;
constexpr int ZE_N = 4192, ZE_P = 4352;
constexpr int SCAN_P = 9 * 1024;
constexpr int NCH = 32, CHL = 4096 / NCH;
constexpr int MODL = 3 * 18432;

DI int lane_id_v() { int l; asm volatile("v_mbcnt_lo_u32_b32 %0, -1, 0\n\tv_mbcnt_hi_u32_b32 %0, -1, %0" : "=v"(l)); return l; }
DI unsigned f2bf(float f) { unsigned u = __builtin_bit_cast(unsigned, f); return (u + 0x7fffu + ((u >> 16) & 1u)) >> 16; }
DI unsigned pk2(float lo, float hi) { unsigned r; asm("v_cvt_pk_bf16_f32 %0, %1, %2" : "=v"(r) : "v"(lo), "v"(hi)); return r; }
DI float bf2f(unsigned short b) { return __builtin_bit_cast(float, ((unsigned)b) << 16); }
DI float h2f(unsigned short h) { return (float)__builtin_bit_cast(_Float16, h); }
DI unsigned pkh(float a, float b) { return (unsigned)__builtin_bit_cast(unsigned short, (_Float16)a) | ((unsigned)__builtin_bit_cast(unsigned short, (_Float16)b) << 16); }
DI f32x4v h4_unpack(v2u w) { return (f32x4v){h2f((unsigned short)(w.x & 0xffffu)), h2f((unsigned short)(w.x >> 16)), h2f((unsigned short)(w.y & 0xffffu)), h2f((unsigned short)(w.y >> 16))}; }
DI v2u h4_pack(f32x4v v) { v2u w; w.x = pkh(v.x, v.y); w.y = pkh(v.z, v.w); return w; }
template <int CTRL> DI float dpp_f(float v) { return __builtin_bit_cast(float, __builtin_amdgcn_update_dpp(0, __builtin_bit_cast(int, v), CTRL, 0xf, 0xf, true)); }
DI float shfl_idx(float v, int src) { return __builtin_bit_cast(float, __builtin_amdgcn_ds_bpermute(src << 2, __builtin_bit_cast(int, v))); }
DI float wave_sum(float v) {
    v += dpp_f<0xB1>(v); v += dpp_f<0x4E>(v); v += dpp_f<0x141>(v); v += dpp_f<0x140>(v);
    v += __builtin_bit_cast(float, __builtin_amdgcn_ds_swizzle(__builtin_bit_cast(int, v), 0x401F));
    return __builtin_bit_cast(float, __builtin_amdgcn_readlane(__builtin_bit_cast(int, v), 0)) + __builtin_bit_cast(float, __builtin_amdgcn_readlane(__builtin_bit_cast(int, v), 32));
}
DI float sigmoid_f(float x) { return __builtin_amdgcn_rcpf(1.f + __expf(-x)); }
DI float silu_f(float x) { return x * sigmoid_f(x); }
DI int scan_perm(int j) { return 4 * (j & 15) + (j >> 4); }
DI int row_mod_j(int row) { return row < MP ? 0 : 1 + ((row - MP) >> 12); }
namespace pg8 {
#define PG8_LAS __attribute__((address_space(3)))
typedef unsigned short bf16_t;
typedef short bf16x8 __attribute__((ext_vector_type(8)));
typedef float f32x4 __attribute__((ext_vector_type(4)));
typedef unsigned u32x4 __attribute__((ext_vector_type(4)));
constexpr int BM = 256, BK = 64, HALF = 128, HTB = HALF * BK * 2  , STAGE_BYTES = 8 * HTB, NXCD = 8, WGM = 8;

__host__ __device__ __forceinline__ int lds_byte(int r, int c) { const int st = (r >> 4) * 2 + (c >> 5), rr = r & 15, cc = c & 31, ob = rr * 64 + cc * 2; return st * 1024 + (ob ^ (((ob >> 9) & 1) << 5)); }
__host__ __device__ __forceinline__ void stage_rc(int b, int& R, int& C) { const int st = b / 1024, sb = b % 1024, swz = sb ^ (((sb >> 9) & 1) << 5); R = (st >> 1) * 16 + swz / 64; C = (st & 1) * 32 + (swz % 64) / 2; }
__host__ __device__ __forceinline__ int perm32(int rho) { const int n = rho >> 4, i = rho & 15; return 8 * (i >> 2) + 4 * n + (i & 3); }

struct Unit { int pm, pn; int kt0, nkt, mode, slot; };
struct Gemm { const bf16_t* A; const bf16_t* Bt; int M, N, K; };
struct StaticOrder {
    static constexpr int SPLITK = 0;
    int nM, nN, nwg, G, c;
    __host__ __device__ __forceinline__ void init(int M, int N, int G_, int c_) { nM = M / BM; nN = N / BM; nwg = nM * nN; G = G_; c = c_; }
    __host__ __device__ __forceinline__ bool next(int i, Unit& u) const {
        const long L = (long)i * G + c; if (L >= nwg) return false;
        int wgid = (int)L; { const int q = nwg / NXCD, r = nwg % NXCD, xcd = wgid % NXCD, off = wgid / NXCD; wgid = (xcd < r ? xcd * (q + 1) : r * (q + 1) + (xcd - r) * q) + off; }
        const int nig = WGM * nN, gid = wgid / nig, fm = gid * WGM, gsz = (nM - fm) < WGM ? (nM - fm) : WGM;
        u.pm = fm + ((wgid % nig) % gsz); u.pn = (wgid % nig) / gsz; u.kt0 = 0; u.nkt = 0; u.mode = 0; u.slot = 0; return true;
    }
    __device__ __forceinline__ void a_ready(const Unit&) const {}
    __device__ __forceinline__ void done(const Unit&) const {}
    __device__ __forceinline__ void publish(const f32x4 (&)[2][2][4][2], const Unit&, int, int) const {}
    __device__ __forceinline__ void consume(f32x4 (&)[2][2][4][2], const Unit&, int, int) const {}
};

template <int PART> struct PairOrder {
    static constexpr int SPLITK = PART;
    StaticOrder so; int R, rem, nt; bool paired;
    float* scratch; unsigned* flags; unsigned target;
    __device__ __forceinline__ void init(int M, int N, int K, int G_, int c_, float* scr, unsigned* fl, unsigned tgt) { so.init(M, N, G_, 0); so.c = 0; so.G = 1; R = so.nwg / G_; rem = so.nwg % G_; nt = K / BK;
        paired = (2 * rem == G_) && ((nt / 2) % 2 == 0); c = c_; G = G_; scratch = scr; flags = fl; target = tgt; }
    int c, G;
    __device__ __forceinline__ bool tile(int t, Unit& u) const { return so.next(t, u); }
    __device__ __forceinline__ bool next(int i, Unit& u) const {
        int t = -1, kt0 = 0, nk = nt, mode = 0, slot = 0;
        if (!paired) { if (PART == 1) { const long L = (long)i * G + c; if (L < so.nwg) t = (int)L; } }
        else if (PART == 1) {
            if (c < rem) { if (i == 0) { t = R * G + c; nk = nt / 2; mode = 1; slot = c; } else if (i <= R) t = (i - 1) * G + c; }
            else if (i < R) t = i * G + c;
        }
        else if (c >= rem && i == 0) { t = R * G + (c - rem); kt0 = nt / 2; nk = nt - nt / 2; mode = 2; slot = c - rem; }
        if (t < 0) return false;
        tile(t, u); u.kt0 = kt0; u.nkt = nk; u.mode = mode; u.slot = slot; return true;
    }
    __device__ __forceinline__ void a_ready(const Unit&) const {}
    __device__ __forceinline__ void done(const Unit&) const {}
    __device__ __forceinline__ void publish(const f32x4 (&acc)[2][2][4][2], const Unit& u, int wid, int lane) const {
        const __amdgpu_buffer_rsrc_t rs = __builtin_amdgcn_make_buffer_rsrc((void*)scratch, 0, 0x7fffffff, 0x00020000);
        const int so_ = __builtin_amdgcn_readfirstlane(u.slot * 262144 + wid * 32768), vo = lane * 16;
#pragma unroll
        for (int ai = 0; ai < 2; ++ai)
#pragma unroll
            for (int bj = 0; bj < 2; ++bj)
#pragma unroll
                for (int m = 0; m < 4; ++m)
#pragma unroll
                    for (int n = 0; n < 2; ++n) { const int r = ((ai * 2 + bj) * 4 + m) * 2 + n;
                        __builtin_amdgcn_raw_buffer_store_b128(__builtin_bit_cast(u32x4, acc[ai][bj][m][n]), rs, vo, so_ + r * 1024, 16); }
        asm volatile("s_waitcnt vmcnt(0)" ::: "memory");
        if (lane == 0) __hip_atomic_fetch_add(flags + 64 * u.slot, 1u, __ATOMIC_RELAXED, __HIP_MEMORY_SCOPE_AGENT);
    }
    __device__ __forceinline__ void consume(f32x4 (&acc)[2][2][4][2], const Unit& u, int wid, int lane) const {
        unsigned spins = 0;
        while ((unsigned)__builtin_amdgcn_readfirstlane((int)__hip_atomic_load(flags + 64 * u.slot, __ATOMIC_RELAXED, __HIP_MEMORY_SCOPE_AGENT)) < target) { __builtin_amdgcn_s_sleep(2); if (++spins > (1u << 22)) break; }
        __builtin_amdgcn_fence(__ATOMIC_ACQUIRE, "agent");
        asm volatile("s_waitcnt vmcnt(0)" ::: "memory");
        const __amdgpu_buffer_rsrc_t rs = __builtin_amdgcn_make_buffer_rsrc((void*)scratch, 0, 0x7fffffff, 0x00020000);
        const int so_ = __builtin_amdgcn_readfirstlane(u.slot * 262144 + wid * 32768), vo = lane * 16;
#pragma unroll
        for (int ai = 0; ai < 2; ++ai)
#pragma unroll
            for (int bj = 0; bj < 2; ++bj)
#pragma unroll
                for (int mh = 0; mh < 2; ++mh) {
                    f32x4 t[4];
#pragma unroll
                    for (int q = 0; q < 4; ++q) { const int m = mh * 2 + (q >> 1), n = q & 1; const int r = ((ai * 2 + bj) * 4 + m) * 2 + n; t[q] = __builtin_bit_cast(f32x4, __builtin_amdgcn_raw_buffer_load_b128(rs, vo, so_ + r * 1024, 16)); }
#pragma unroll
                    for (int q = 0; q < 4; ++q) { const int m = mh * 2 + (q >> 1), n = q & 1; acc[ai][bj][m][n] += t[q]; }
                    asm volatile("" ::: "memory");
                }
    }
};
__device__ __forceinline__ unsigned cvt_pk_bf16(float lo, float hi) { unsigned r; asm volatile("v_cvt_pk_bf16_f32 %0, %1, %2" : "=v"(r) : "v"(lo), "v"(hi)); return r; }
typedef float f32x2 __attribute__((ext_vector_type(2)));
#define EPI_LOOP_AIM _Pragma("unroll") for (int ai = 0; ai < 2; ++ai) _Pragma("unroll") for (int m = 0; m < 4; ++m)
#define EPI_LOOP_BJN _Pragma("unroll") for (int bj = 0; bj < 2; ++bj) _Pragma("unroll") for (int n = 0; n < 2; ++n)
struct EpiF32 {
    static constexpr bool PERM = false, AFTER_DRAIN = false;
    float* C; int ldc;
    __device__ __forceinline__ void operator()(const f32x4 (&acc)[2][2][4][2], const Unit& u, int wr, int wc, int fr, int fq) const {
        const int row0 = u.pm * BM + wr * 64 + fr, col0 = u.pn * BM + wc * 32 + 4 * fq;
        EPI_LOOP_AIM { float* rowp = C + (size_t)(row0 + ai * HALF + m * 16) * ldc + col0;
            EPI_LOOP_BJN *(f32x4*)(rowp + bj * HALF + n * 16) = acc[ai][bj][m][n]; }
    }
};
struct EpiBf16Plain {
    static constexpr bool PERM = true, AFTER_DRAIN = false;
    bf16_t* O; int ldc;
    __device__ __forceinline__ void operator()(const f32x4 (&acc)[2][2][4][2], const Unit& u, int wr, int wc, int fr, int fq) const {
        const int row0 = u.pm * BM + wr * 64 + fr, col0 = u.pn * BM + wc * 32 + 8 * fq;
        EPI_LOOP_AIM { bf16_t* rowp = O + (size_t)(row0 + ai * HALF + m * 16) * ldc + col0;
#pragma unroll
            for (int bj = 0; bj < 2; ++bj) { const f32x4 v0 = acc[ai][bj][m][0], v1 = acc[ai][bj][m][1];
                u32x4 w; w.x = cvt_pk_bf16(v0[0], v0[1]); w.y = cvt_pk_bf16(v0[2], v0[3]); w.z = cvt_pk_bf16(v1[0], v1[1]); w.w = cvt_pk_bf16(v1[2], v1[3]);
                *(u32x4*)(rowp + bj * HALF) = w; } }
    }
};
struct EpiSwiGLU {
    static constexpr bool PERM = true, AFTER_DRAIN = false;
    bf16_t* O; int ldc;
    __device__ __forceinline__ void operator()(const f32x4 (&acc)[2][2][4][2], const Unit& u, int wr, int wc, int fr, int fq) const {
        const int row0 = u.pm * BM + wr * 64 + fr, col0 = u.pn * HALF + wc * 32 + 8 * fq;
        EPI_LOOP_AIM { bf16_t* rowp = O + (size_t)(row0 + ai * HALF + m * 16) * ldc + col0;
            float o[8];
#pragma unroll
            for (int n = 0; n < 2; ++n)
#pragma unroll
                for (int i = 0; i < 4; ++i) { const float g = acc[ai][0][m][n][i], up = acc[ai][1][m][n][i]; o[n * 4 + i] = g * __builtin_amdgcn_rcpf(1.f + __expf(-g)) * up; }
            u32x4 w; w.x = cvt_pk_bf16(o[0], o[1]); w.y = cvt_pk_bf16(o[2], o[3]); w.z = cvt_pk_bf16(o[4], o[5]); w.w = cvt_pk_bf16(o[6], o[7]);
            *(u32x4*)rowp = w; }
    }
};
struct EpiRes {
    static constexpr bool PERM = false, AFTER_DRAIN = false;
    unsigned short* X; const float* gate; float coef;
    __device__ __forceinline__ void operator()(const f32x4 (&acc)[2][2][4][2], const Unit& u, int wr, int wc, int fr, int fq) const {
        const int row0 = u.pm * BM + wr * 64 + fr, col0 = u.pn * BM + wc * 32 + 4 * fq;
        const int rt = u.pm * BM; const int j = rt < 4096 ? 0 : 1 + ((rt - 4096) >> 12);
        const float* g = gate + j * 18432 + col0;
        f32x4 gv[2][2];
        EPI_LOOP_BJN gv[bj][n] = *(const f32x4*)(g + bj * HALF + n * 16) * coef;
        EPI_LOOP_AIM { unsigned short* rowp = X + (size_t)(row0 + ai * HALF + m * 16) * 2048 + col0;
            EPI_LOOP_BJN { const v2u w = *(const v2u*)(rowp + bj * HALF + n * 16); const f32x4v xo = h4_unpack(w); const f32x4 d = gv[bj][n] * acc[ai][bj][m][n];
                *(v2u*)(rowp + bj * HALF + n * 16) = h4_pack((f32x4v){xo.x + d[0], xo.y + d[1], xo.z + d[2], xo.w + d[3]}); }
            asm volatile("" ::: "memory"); }
    }
};
struct EpiZT {
    static constexpr bool PERM = false, AFTER_DRAIN = false;
    float* ZTp; float* ZTs;
    __device__ __forceinline__ void operator()(const f32x4 (&acc)[2][2][4][2], const Unit& u, int wr, int wc, int fr, int fq) const {
        const int ch0 = u.pm * BM + wr * 64 + fr, tok0 = u.pn * BM;
        float* base; int pitch, toff;
        if (tok0 < 4096) { base = ZTp + (size_t)(tok0 >> 8) * 6144 * 256; pitch = 256; toff = 0; }
        else { const int tk = tok0 - 4096; base = ZTs + (size_t)(tk >> 12) * 6144 * 4096; pitch = 4096; toff = tk & 4095; }
        const int c0 = toff + wc * 32 + 4 * fq;
        EPI_LOOP_AIM { float* rowp = base + (size_t)(ch0 + ai * HALF + m * 16) * pitch + c0;
            EPI_LOOP_BJN *(f32x4*)(rowp + bj * HALF + n * 16) = acc[ai][bj][m][n]; }
    }
};
struct EpiVT {
    static constexpr bool PERM = true, AFTER_DRAIN = false;
    bf16_t* VTp; size_t s_off;
    __device__ __forceinline__ void operator()(const f32x4 (&acc)[2][2][4][2], const Unit& u, int wr, int wc, int fr, int fq) const {
        const int ch0 = u.pm * BM + wr * 64 + fr, tok0 = u.pn * BM;
        bf16_t* base; int pitch, toff; bf16_t* VTs = VTp + s_off;
        if (tok0 < 4096) { base = VTp + (size_t)(tok0 >> 8) * 1024 * 256; pitch = 256; toff = 0; }
        else if (tok0 < 12288) { const int tk = tok0 - 4096; base = VTs + (size_t)(tk >> 12) * 1024 * 4352; pitch = 4352; toff = tk & 4095; }
        else { const int tk = tok0 - 12288; base = VTs + (size_t)(tk >> 8) * 1024 * 4352; pitch = 4352; toff = 4096; }
        const int c0 = toff + wc * 32 + 8 * fq;
        EPI_LOOP_AIM { bf16_t* rowp = base + (size_t)(ch0 + ai * HALF + m * 16) * pitch + c0;
#pragma unroll
            for (int bj = 0; bj < 2; ++bj) { const f32x4 v0 = acc[ai][bj][m][0], v1 = acc[ai][bj][m][1];
                u32x4 w; w.x = cvt_pk_bf16(v0[0], v0[1]); w.y = cvt_pk_bf16(v0[2], v0[3]); w.z = cvt_pk_bf16(v1[0], v1[1]); w.w = cvt_pk_bf16(v1[2], v1[3]);
                *(u32x4*)(rowp + bj * HALF) = w; } }
    }
};
struct EpiQ {
    static constexpr bool PERM = true, AFTER_DRAIN = false;
    bf16_t* Q; const float* rope; float qs;
    __device__ __forceinline__ void operator()(const f32x4 (&acc)[2][2][4][2], const Unit& u, int wr, int wc, int fr, int fq) const {
        const int row0 = u.pm * BM + wr * 64 + fr;
        EPI_LOOP_AIM { const int row = row0 + ai * HALF + m * 16; const bool smp = row >= 4096; const int t = (row - 4096) & 4095;
#pragma unroll
            for (int bj = 0; bj < 2; ++bj) { const int c0 = u.pn * BM + bj * HALF + wc * 32 + 8 * fq; const int within = c0 % 192;
                float o[8];
#pragma unroll
                for (int n = 0; n < 2; ++n)
#pragma unroll
                    for (int i = 0; i < 4; ++i) o[n * 4 + i] = acc[ai][bj][m][n][i];
                if (within >= 128 && smp) { const int ri = within - 128;
#pragma unroll
                    for (int q = 0; q < 4; ++q) { const int idx = ri + 2 * q, hf = idx >> 5, j = (idx & 31) >> 1; const int pos = hf ? (t & 63) : (t >> 6);
                        const float2 cs = *(const float2*)(rope + (pos * 16 + j) * 2); const float x1 = o[2 * q], x2 = o[2 * q + 1];
                        o[2 * q] = x1 * cs.x - x2 * cs.y; o[2 * q + 1] = x2 * cs.x + x1 * cs.y; } }
                u32x4 w; w.x = cvt_pk_bf16(o[0] * qs, o[1] * qs); w.y = cvt_pk_bf16(o[2] * qs, o[3] * qs); w.z = cvt_pk_bf16(o[4] * qs, o[5] * qs); w.w = cvt_pk_bf16(o[6] * qs, o[7] * qs);
                *(u32x4*)(Q + (size_t)row * 1536 + c0) = w; } }
    }
};
struct EpiLora {
    static constexpr bool PERM = false, AFTER_DRAIN = false;
    unsigned char* wsb; const float* w0; const float* a0; const float* ka; size_t off_sc, off_kb, off_gb;
    __device__ __forceinline__ void operator()(const f32x4 (&acc)[2][2][4][2], const Unit& u, int wr, int wc, int fr, int fq) const {
        const int row0 = u.pm * BM + wr * 64 + fr; const int seg = u.pn >> 2; const int cb = (u.pn & 3) * BM + wc * 32 + 4 * fq;
        float* SC = (float*)(wsb + off_sc); const float* KB = (const float*)(wsb + off_kb); float* GB = (float*)(wsb + off_gb);
        EPI_LOOP_AIM { const int row = row0 + ai * HALF + m * 16; float* sc = SC + (size_t)row * 9216;
            EPI_LOOP_BJN { const int c = cb + bj * HALF + n * 16; const f32x4 a = acc[ai][bj][m][n];
                if (seg < 2) { const f32x4 wv = *(const f32x4*)(w0 + seg * 1024 + c); f32x4 o;
#pragma unroll
                    for (int i = 0; i < 4; ++i) { const float x = wv[i] + a[i]; const float sp = __logf(1.f + __expf(-x)); o[i] = __expf(-__expf(-sp - 0.5f)); }
                    *(f32x4*)(sc + (3 + seg) * 1024 + c) = o; }
                else if (seg < 4) { const int d = seg - 2; const f32x4 av = *(const f32x4*)(a0 + d * 1024 + c), kav = *(const f32x4*)(ka + c);
                    const f32x4 kk = *(const f32x4*)(sc + 2 * 1024 + c), kr = *(const f32x4*)(KB + (size_t)row * 1024 + c); f32x4 o1, o2;
#pragma unroll
                    for (int i = 0; i < 4; ++i) { const float s = __builtin_amdgcn_rcpf(1.f + __expf(-(av[i] + a[i]))); o1[i] = kk[i] * s; o2[i] = kr[i] * (1.f + (s - 1.f) * kav[i]); }
                    *(f32x4*)(sc + (5 + d) * 1024 + c) = o1; *(f32x4*)(sc + (7 + d) * 1024 + c) = o2; }
                else *(f32x4*)(GB + (size_t)row * 1024 + c) = a; }
            asm volatile("" ::: "memory"); }
    }
};
template <class Epi, class Sched, bool ALIGN_EPI = false, bool SP2 = false>
__device__ __forceinline__ void gemm_phase(PG8_LAS unsigned char* lds, const Gemm g, const Sched& S, const Epi& E, int wave_id) {
    const int tid_l_ = wave_id * 64 + lane_id_v();
    const int tid = tid_l_, wid = __builtin_amdgcn_readfirstlane(tid >> 6), lane = tid & 63, wr = wid >> 2, wc = wid & 3, fr = lane & 15, fq = lane >> 4;
    const int K = g.K, nt = K / BK;
    unsigned voffA[2], voffB[2];
#pragma unroll
    for (int i = 0; i < 2; ++i) { int R, C; stage_rc(tid * 16 + i * 8192, R, C); const int Rb = Epi::PERM ? ((R & ~31) + perm32(R & 31)) : R;
        voffA[i] = (unsigned)(R * K + C) * 2u; voffB[i] = (unsigned)(Rb * K + C) * 2u; }
    const size_t kstep = (size_t)(BK * 2);
    const size_t hstep = (size_t)HALF * K * 2;
    const size_t tstep = 2 * hstep;
    const unsigned ldsw = (unsigned)wid * 1024u;
    const int aoff = lds_byte(wr * 64 + fr, fq * 8), boff = lds_byte(wc * 32 + fr, fq * 8);
#define PG8_SA(b, h) (((b) * 2 + (h)) * HTB)
#define PG8_SB(b, h) ((4 + (b) * 2 + (h)) * HTB)
#define PG8_STAGE(bufoff, gbase, voff) do { _Pragma("unroll") for (int _i = 0; _i < 2; ++_i) \
        __builtin_amdgcn_global_load_lds((const unsigned*)((const char*)(gbase) + (voff)[_i]), (PG8_LAS unsigned*)(lds + (bufoff) + ldsw + _i * 8192), 16, 0, 0); } while (0)
#define PG8_LDA(dst, b, h) do { _Pragma("unroll") for (int m = 0; m < 4; ++m) _Pragma("unroll") for (int k = 0; k < 2; ++k) dst[m][k] = *(const PG8_LAS bf16x8*)(lds + PG8_SA(b, h) + aoff + m * 2048 + k * 1024); } while (0)
#define PG8_LDB(dst, b, h) do { _Pragma("unroll") for (int n = 0; n < 2; ++n) _Pragma("unroll") for (int k = 0; k < 2; ++k) dst[n][k] = *(const PG8_LAS bf16x8*)(lds + PG8_SB(b, h) + boff + n * 2048 + k * 1024); } while (0)
#define PG8_MMA(ai, bj, At, Bt) do { __builtin_amdgcn_s_setprio(1); _Pragma("unroll") for (int m = 0; m < 4; ++m) _Pragma("unroll") for (int n = 0; n < 2; ++n) _Pragma("unroll") for (int k = 0; k < 2; ++k) \
        acc[ai][bj][m][n] = __builtin_amdgcn_mfma_f32_16x16x32_bf16(Bt[n][k], At[m][k], acc[ai][bj][m][n], 0, 0, 0); __builtin_amdgcn_s_setprio(0); } while (0)
#define PG8_WAIT_V(n) asm volatile("s_waitcnt vmcnt(" #n ")" ::: "memory")
#define PG8_WAIT_L(n) asm volatile("s_waitcnt lgkmcnt(" #n ")" ::: "memory")
#define PG8_BAR __builtin_amdgcn_s_barrier()
#define PG8_SCHED __builtin_amdgcn_sched_barrier(0)
    Unit cur, nxt; int ui = 0;
    if (!S.next(0, cur)) return;
    f32x4 acc[2][2][4][2];
#pragma unroll
    for (int a = 0; a < 2; ++a)
#pragma unroll
        for (int b = 0; b < 2; ++b)
#pragma unroll
            for (int m = 0; m < 4; ++m)
#pragma unroll
                for (int n = 0; n < 2; ++n) acc[a][b][m][n] = (f32x4){0.f, 0.f, 0.f, 0.f};
    bf16x8 At[4][2], B0[2][2], B1[2][2];
    const char* cA = (const char*)g.A + (size_t)cur.pm * tstep; const char* cB = (const char*)g.Bt + (size_t)cur.pn * tstep;
    if constexpr (Sched::SPLITK != 0) { cA += (size_t)cur.kt0 * kstep; cB += (size_t)cur.kt0 * kstep; }
    S.a_ready(cur);
    if constexpr (SP2) {
        PG8_STAGE(PG8_SB(0, 0), cB, voffB); PG8_STAGE(PG8_SB(0, 1), cB + hstep, voffB); PG8_STAGE(PG8_SA(0, 0), cA, voffA); PG8_STAGE(PG8_SA(0, 1), cA + hstep, voffA);
        if (wr == 1) PG8_BAR;
        PG8_WAIT_V(2); PG8_BAR;
        PG8_STAGE(PG8_SB(1, 0), cB + kstep, voffB); PG8_STAGE(PG8_SA(1, 0), cA + kstep, voffA); PG8_STAGE(PG8_SB(1, 1), cB + hstep + kstep, voffB);
        PG8_WAIT_V(6); PG8_BAR;
    } else {
        PG8_STAGE(PG8_SB(0, 0), cB, voffB); PG8_STAGE(PG8_SA(0, 0), cA, voffA); PG8_STAGE(PG8_SB(0, 1), cB + hstep, voffB); PG8_STAGE(PG8_SA(0, 1), cA + hstep, voffA);
        if (wr == 1) PG8_BAR;
        PG8_WAIT_V(4); PG8_BAR;
        PG8_STAGE(PG8_SB(1, 0), cB + kstep, voffB); PG8_STAGE(PG8_SA(1, 0), cA + kstep, voffA); PG8_STAGE(PG8_SB(1, 1), cB + hstep + kstep, voffB);
        PG8_WAIT_V(6); PG8_BAR;
    }
    for (;;) {
        const bool has_next = S.next(ui + 1, nxt);
        const char* nA = has_next ? (const char*)g.A + (size_t)nxt.pm * tstep : cA; const char* nB = has_next ? (const char*)g.Bt + (size_t)nxt.pn * tstep : cB;
        if constexpr (Sched::SPLITK != 0) { if (has_next) { nA += (size_t)nxt.kt0 * kstep; nB += (size_t)nxt.kt0 * kstep; } }
        const int cnt = Sched::SPLITK != 0 ? cur.nkt : nt;
        for (int t = 0; t < cnt; t += 2) {
            const bool last = (t == cnt - 2);
            const char* a1 = cA + (size_t)(t + 1) * kstep;
            const char* a2 = last ? nA : cA + (size_t)(t + 2) * kstep; const char* b2 = last ? nB : cB + (size_t)(t + 2) * kstep;
            const char* a3 = a2 + kstep; const char* b3 = b2 + kstep;
            if (last && has_next) S.a_ready(nxt);
            if constexpr (SP2) {
            PG8_LDB(B0, 0, 0); PG8_LDB(B1, 0, 1); PG8_SCHED; PG8_LDA(At, 0, 0); PG8_STAGE(PG8_SA(1, 1), a1 + hstep, voffA);
            PG8_WAIT_V(8); PG8_WAIT_L(0); PG8_BAR; PG8_MMA(0, 0, At, B0); PG8_MMA(0, 1, At, B1); PG8_BAR; PG8_SCHED;
            PG8_LDA(At, 0, 1); PG8_STAGE(PG8_SB(0, 0), b2, voffB); PG8_STAGE(PG8_SB(0, 1), b2 + hstep, voffB); PG8_STAGE(PG8_SA(0, 0), a2, voffA);
            PG8_WAIT_V(8); PG8_WAIT_L(0); PG8_BAR; PG8_MMA(1, 0, At, B0); PG8_MMA(1, 1, At, B1); PG8_BAR; PG8_SCHED;
            PG8_LDB(B0, 1, 0); PG8_LDB(B1, 1, 1); PG8_SCHED; PG8_LDA(At, 1, 0); PG8_STAGE(PG8_SA(0, 1), a2 + hstep, voffA);
            PG8_WAIT_V(8); PG8_WAIT_L(0); PG8_BAR; PG8_MMA(0, 0, At, B0); PG8_MMA(0, 1, At, B1); PG8_BAR; PG8_SCHED;
            PG8_LDA(At, 1, 1); PG8_STAGE(PG8_SB(1, 0), b3, voffB); PG8_STAGE(PG8_SB(1, 1), b3 + hstep, voffB); PG8_STAGE(PG8_SA(1, 0), a3, voffA);
            PG8_WAIT_V(8); PG8_WAIT_L(0); PG8_BAR; PG8_MMA(1, 0, At, B0); PG8_MMA(1, 1, At, B1); PG8_BAR; PG8_SCHED;
            } else {
            PG8_LDB(B0, 0, 0); PG8_SCHED; PG8_LDA(At, 0, 0); PG8_STAGE(PG8_SA(1, 1), a1 + hstep, voffA);
            PG8_WAIT_L(8); PG8_BAR; PG8_WAIT_L(0); PG8_MMA(0, 0, At, B0); PG8_BAR; PG8_SCHED;
            PG8_LDB(B1, 0, 1); PG8_STAGE(PG8_SB(0, 0), b2, voffB);
            PG8_BAR; PG8_WAIT_L(0); PG8_MMA(0, 1, At, B1); PG8_BAR;
            PG8_LDA(At, 0, 1); PG8_STAGE(PG8_SA(0, 0), a2, voffA);
            PG8_BAR; PG8_WAIT_L(0); PG8_MMA(1, 0, At, B0); PG8_BAR; PG8_SCHED;
            PG8_STAGE(PG8_SB(0, 1), b2 + hstep, voffB);
            PG8_WAIT_V(6); PG8_BAR; PG8_MMA(1, 1, At, B1); PG8_BAR;
            PG8_LDB(B0, 1, 0); PG8_SCHED; PG8_LDA(At, 1, 0); PG8_STAGE(PG8_SA(0, 1), a2 + hstep, voffA);
            PG8_WAIT_L(8); PG8_BAR; PG8_WAIT_L(0); PG8_MMA(0, 0, At, B0); PG8_BAR; PG8_SCHED;
            PG8_LDB(B1, 1, 1); PG8_STAGE(PG8_SB(1, 0), b3, voffB);
            PG8_BAR; PG8_WAIT_L(0); PG8_MMA(0, 1, At, B1); PG8_BAR;
            PG8_LDA(At, 1, 1); PG8_STAGE(PG8_SA(1, 0), a3, voffA);
            PG8_BAR; PG8_WAIT_L(0); PG8_MMA(1, 0, At, B0); PG8_BAR; PG8_SCHED;
            PG8_STAGE(PG8_SB(1, 1), b3 + hstep, voffB);
            PG8_WAIT_V(6); PG8_BAR; PG8_MMA(1, 1, At, B1); PG8_BAR;
            }
        }
        if constexpr (ALIGN_EPI) { if (wr == 0) PG8_BAR; }
        if constexpr (Sched::SPLITK == 1) { if (cur.mode == 1) S.publish(acc, cur, wid, lane); else E(acc, cur, wr, wc, fr, fq); S.done(cur); }
        else if constexpr (Sched::SPLITK == 2) { S.consume(acc, cur, wid, lane); E(acc, cur, wr, wc, fr, fq); S.done(cur); }
        else if constexpr (!Epi::AFTER_DRAIN) { E(acc, cur, wr, wc, fr, fq); S.done(cur); }
        if (!has_next) break;
#pragma unroll
        for (int a = 0; a < 2; ++a)
#pragma unroll
            for (int b = 0; b < 2; ++b)
#pragma unroll
                for (int m = 0; m < 4; ++m)
#pragma unroll
                    for (int n = 0; n < 2; ++n) acc[a][b][m][n] = (f32x4){0.f, 0.f, 0.f, 0.f};
        cur = nxt; cA = nA; cB = nB; ++ui;
        if constexpr (ALIGN_EPI) { if (wr == 1) PG8_BAR; }
    }
    PG8_WAIT_V(0);
    if constexpr (!ALIGN_EPI) { if (wr == 0) PG8_BAR; }
    PG8_BAR;
    if constexpr (Epi::AFTER_DRAIN) { E.fused(acc, cur, wr, wc, fr, fq, lds, wid, lane); S.done(cur); }
#undef PG8_SA
#undef PG8_SB
#undef PG8_STAGE
#undef PG8_LDA
#undef PG8_LDB
#undef PG8_MMA
#undef PG8_WAIT_V
#undef PG8_WAIT_L
#undef PG8_BAR
#undef PG8_SCHED
}
}
#define XB_TMO      128
#define XB_XCNT(j)  (256  + 64 * (j))
#define XB_XSUB(j)  (1280 + 64 * (j))
#define XB_XGEN(j)  (2304 + 64 * (j))
#define XB_TOP      3328
#define XB_TOPGEN   3392
#define XCD_BAR_WORDS 3456
#define XB_SPIN_CAP (1u << 18)

__device__ __forceinline__ unsigned xb_ld(unsigned* p)              { return __hip_atomic_load(p, __ATOMIC_RELAXED, __HIP_MEMORY_SCOPE_AGENT); }
__device__ __forceinline__ unsigned xb_add(unsigned* p, unsigned v) { return __hip_atomic_fetch_add(p, v, __ATOMIC_RELAXED, __HIP_MEMORY_SCOPE_AGENT); }
__device__ __forceinline__ unsigned xb_xcc_id() { return (unsigned)__builtin_amdgcn_s_getreg((3 << 11) | 20) & 0xFu; }
#define XB_SPIN(cond, bar) do { unsigned _sp = 0; while (cond) { __builtin_amdgcn_s_sleep(1); \
    if ((++_sp & 255u) == 0u) { if (xb_ld(&(bar)[XB_TMO])) break; if (_sp > XB_SPIN_CAP) { atomicAdd(&(bar)[XB_TMO], 1u); break; } } } } while (0)

struct XcdBarrier {
    unsigned* bar; unsigned x;
    volatile LAS unsigned* st;
};

__device__ __forceinline__ XcdBarrier xcd_barrier_post(unsigned* bar, volatile LAS unsigned* st, int tid_) {
    XcdBarrier b; b.bar = bar; b.x = xb_xcc_id(); b.st = st;
    if (tid_ == 0) (void)xb_add(&bar[XB_XCNT(b.x)], 1u);
    return b;
}
__device__ __forceinline__ void xcd_barrier_complete(unsigned* bar, unsigned x, unsigned& nloc, unsigned& nx) {
    const unsigned G = gridDim.x * gridDim.y * gridDim.z;
    unsigned sum, cnt, mine, sp = 0u;
    for (;;) {
        sum = 0u; cnt = 0u; mine = 0u;
#pragma unroll
        for (unsigned j = 0; j < 16; ++j) { const unsigned c = xb_ld(&bar[XB_XCNT(j)]); sum += c; cnt += (c > 0u) ? 1u : 0u; mine = (j == x) ? c : mine; }
        if (sum == G) break;
        __builtin_amdgcn_s_sleep(1);
        if ((++sp & 255u) == 0u) { if (xb_ld(&bar[XB_TMO])) break; if (sp > XB_SPIN_CAP) { atomicAdd(&bar[XB_TMO], 1u); break; } }
    }
    nloc = mine > 0u ? mine : 1u; nx = cnt > 0u ? cnt : 1u;
}

__device__ __forceinline__ void xcd_barrier(const XcdBarrier& b, int tid_) {
    asm volatile("s_waitcnt vmcnt(0)" ::: "memory");
    __syncthreads();
    if (tid_ == 0) {
        unsigned* bar = b.bar;
        __builtin_amdgcn_s_waitcnt(0);
        unsigned nloc = b.st[0], nx = b.st[1];
        if (nloc == 0u) { xcd_barrier_complete(bar, b.x, nloc, nx); b.st[0] = nloc; b.st[1] = nx; }
        const unsigned old = xb_add(&bar[XB_XSUB(b.x)], 1u);
        const unsigned gen = old / nloc;
        if (old + 1u == (gen + 1u) * nloc) {
            __builtin_amdgcn_fence(__ATOMIC_RELEASE, "agent");
            asm volatile("s_waitcnt vmcnt(0)" ::: "memory");
            const unsigned og = xb_add(&bar[XB_TOP], 1u);
            const unsigned tg = og / nx;
            if (og + 1u == (tg + 1u) * nx) xb_add(&bar[XB_TOPGEN], 1u);
            else XB_SPIN(xb_ld(&bar[XB_TOPGEN]) == tg, bar);
            __builtin_amdgcn_fence(__ATOMIC_ACQUIRE, "agent");
            xb_add(&bar[XB_XGEN(b.x)], 1u);
            asm volatile("s_waitcnt vmcnt(0)" ::: "memory");
        } else {
            XB_SPIN(xb_ld(&bar[XB_XGEN(b.x)]) == gen, bar);
            __builtin_amdgcn_fence(__ATOMIC_ACQUIRE, "agent");
            asm volatile("s_waitcnt vmcnt(0)" ::: "memory");
        }
    }
    __syncthreads();
}

constexpr size_t MiB = 1u << 20;
constexpr size_t WS_CTL = 0, CTL_ZERO_BYTES = 2 * MiB;
constexpr size_t WS_MOD = 2 * MiB;
constexpr size_t WS_PMOD = WS_MOD + 2 * MiB;
constexpr size_t WS_ROPE = WS_PMOD + 8 * MiB;
constexpr size_t WS_W1T = WS_ROPE + 2 * MiB;
constexpr size_t WS_W2T = WS_W1T + 352 * MiB;
constexpr size_t WS_WINE = WS_W2T + 176 * MiB;
constexpr size_t WS_WOUTE = WS_WINE + 34 * MiB;
constexpr size_t WS_WINO = WS_WOUTE + 16 * MiB;
constexpr size_t WS_WOUTO = WS_WINO + 48 * MiB;
constexpr size_t WS_WQ = WS_WOUTO + 16 * MiB;
constexpr size_t WS_WKN = WS_WQ + 4 * MiB;
constexpr size_t WS_WV = WS_WKN + 2 * MiB;
constexpr size_t WS_WLORA = WS_WV + 2 * MiB;
constexpr size_t WS_W3T = WS_WLORA + 8 * MiB;
constexpr size_t WS_H2 = WS_W3T + 8 * MiB;
constexpr size_t WS_X = WS_H2 + 4 * MiB;
constexpr size_t WS_H = WS_X + 96 * MiB;
constexpr size_t WS_ACT = WS_H + 48 * MiB;
constexpr size_t WS_Z = WS_ACT + 132 * MiB;
constexpr size_t WS_SCAN = WS_Z + 288 * MiB;
constexpr size_t SCAN_BYTES = 432 * MiB;
constexpr size_t WS_KBUF = WS_SCAN + 2 * SCAN_BYTES;
constexpr size_t WS_LA = WS_KBUF + 48 * MiB;
constexpr size_t WS_GB = WS_LA + 10 * MiB;
constexpr size_t WS_CQ = WS_GB + 48 * MiB;
constexpr size_t WS_CKV = WS_CQ + 12 * MiB;
constexpr size_t WS_KR = WS_CKV + 8 * MiB;
constexpr size_t WS_Q = WS_KR + 2 * MiB;
constexpr size_t WS_KN = WS_Q + 36 * MiB;
constexpr size_t WS_VT = WS_KN + 26 * MiB;
constexpr size_t WS_YSC = WS_VT + 26 * MiB;
constexpr size_t WS_PQ = WS_ACT;
constexpr size_t WS_SST = WS_ACT + 64 * MiB;
constexpr size_t WS_PST = WS_ACT + 96 * MiB;
constexpr size_t WS_MIX = WS_YSC + 96 * MiB;
constexpr size_t WS_KSS = WS_MIX + 48 * MiB;
constexpr size_t WS_KSP = WS_KSS + 258 * MiB;
constexpr size_t WS_END = WS_KSP + 18 * MiB;
static_assert((size_t)NCH * 64 * 2 * 16384 <= 64 * MiB && (size_t)NCH * 64 * 16384 <= 32 * MiB, "PQ / SST inside the ACT region");
constexpr size_t ZT_S_OFF = (size_t)16 * 6144 * 256 * 4;
constexpr size_t VT_S_OFF = (size_t)16 * 1024 * 256 * 2;

constexpr size_t OUT_YS = (size_t)MP * D, OUT_CKV = (size_t)MT * D, OUT_KR = OUT_CKV + 16 * 2 * 256 * 256, OUT_ST = OUT_KR + 16 * 2 * 256 * 64, OUT_END = OUT_ST + (size_t)16 * 2 * 2 * 16 * 64 * 64;

constexpr int LDS_RING = 131072, LDS_BYTES = 147456, LDS_CTL = LDS_BYTES - 512;

struct KArgs { const float* in[42]; float* out; unsigned char* ws; int ph_lo, ph_hi; };
enum { I_XP = 0, I_XS, I_CCKV, I_CKR, I_ST, I_C, I_CCTX, I_WMOD, I_BMOD, I_NG, I_WFI, I_WFO, I_FNG, I_WINE, I_MUP, I_MUN, I_W0, I_W2, I_A0, I_A2, I_G2, I_KK, I_KA, I_RK, I_GNW, I_GNB,
       I_QN, I_KVN, I_WQB, I_WKVB, I_WOE, I_WINO, I_CW, I_CB, I_FW1, I_FB1, I_FW2, I_FB2, I_FW3, I_FFR, I_HB, I_WOO };

struct Ctx {
    LAS unsigned char* lds; unsigned char* ws; const float* const* in; float* out;
    int tid, lane, wave, G, gw, NGW, vb, bx, zs;
};

DI void tr_item(const float* W, int ldw, int K, bf16* WT, int dstrow0, int srccol0, int k0, LAS float* scr, int lane) {
    float v[32];
#pragma unroll
    for (int i = 0; i < 32; ++i) v[i] = W[(size_t)(k0 + 2 * i + (lane >> 5)) * ldw + srccol0 + (lane & 31)];
#pragma unroll
    for (int i = 0; i < 32; ++i) scr[(2 * i + (lane >> 5)) * 33 + (lane & 31)] = v[i];
    asm volatile("s_waitcnt lgkmcnt(0)" ::: "memory");
    const int c = lane & 7;
#pragma unroll
    for (int j = 0; j < 4; ++j) { const int n = (lane >> 3) + 8 * j; const LAS float* s = scr + (8 * c) * 33 + n;
        v4u o; o.x = pk2(s[0 * 33], s[1 * 33]); o.y = pk2(s[2 * 33], s[3 * 33]); o.z = pk2(s[4 * 33], s[5 * 33]); o.w = pk2(s[6 * 33], s[7 * 33]);
        *(v4u*)(WT + (size_t)(dstrow0 + n) * K + k0 + 8 * c) = o; }
    asm volatile("s_waitcnt lgkmcnt(0)" ::: "memory");
}
template <int MODE> DI void tr_matrix(Ctx& C, const float* W, int ldw, int K, bf16* WT, int ndst, int nsrc, int gw, int NGW) {
    LAS float* scr = (LAS float*)(C.lds + C.wave * 8704);
    const int nkb = K / 64, nnb = ndst / 32, nit = nkb * nnb;
    for (int it = gw; it < nit; it += NGW) {
        const int kb = it / nnb, nb = it % nnb, dr = nb * 32;
        int sc = dr;
        if (MODE == 1) { const int p = dr >> 8, sg = (dr >> 7) & 1, j = dr & 127; sc = sg * 5632 + 128 * p + j; }
        if (MODE == 2 && dr >= nsrc) {
            const int c = C.lane & 7;
#pragma unroll
            for (int j = 0; j < 4; ++j) { const int n = (C.lane >> 3) + 8 * j; *(v4u*)(WT + (size_t)(dr + n) * K + kb * 64 + 8 * c) = (v4u){0u, 0u, 0u, 0u}; }
            continue;
        }
        tr_item(W, ldw, K, WT, dr, sc, kb * 64, scr, C.lane);
    }
}
template <class Fn> DI void cvt_small(Ctx& C, bf16* dst, int N, int K, Fn f) {
    const int total = N * (K / 8);
    for (int idx = C.bx * 512 + C.tid; idx < total; idx += C.G * 512) {
        const int n = idx % N, k8 = idx / N; float v[8];
#pragma unroll
        for (int i = 0; i < 8; ++i) v[i] = f(n, k8 * 8 + i);
        v4u o; o.x = pk2(v[0], v[1]); o.y = pk2(v[2], v[3]); o.z = pk2(v[4], v[5]); o.w = pk2(v[6], v[7]);
        *(v4u*)(dst + (size_t)n * K + k8 * 8) = o;
    }
}

DI void phase_prologue(Ctx& C) {
    const float* const* in = C.in; unsigned char* ws = C.ws;
    tr_matrix<1>(C, in[I_WFI], NFF1, 2048, (bf16*)(ws + WS_W1T), NFF1, NFF1, C.gw, C.NGW);
    tr_matrix<0>(C, in[I_WFO], 2048, DFF, (bf16*)(ws + WS_W2T), 2048, 2048, C.gw, C.NGW);
    for (int i = 0; i < 2; ++i) tr_matrix<2>(C, in[I_WINE] + (size_t)i * 2048 * ZE_N, ZE_N, 2048, (bf16*)(ws + WS_WINE) + (size_t)i * ZE_P * 2048, ZE_P, ZE_N, C.gw, C.NGW);
    for (int i = 0; i < 2; ++i) tr_matrix<0>(C, in[I_WOE] + (size_t)i * 2048 * 2048, 2048, 2048, (bf16*)(ws + WS_WOUTE) + (size_t)i * 2048 * 2048, 2048, 2048, C.gw, C.NGW);
    for (int i = 0; i < 2; ++i) tr_matrix<0>(C, in[I_WINO] + (size_t)i * 2048 * 6144, 6144, 2048, (bf16*)(ws + WS_WINO) + (size_t)i * 6144 * 2048, 6144, 6144, C.gw, C.NGW);
    for (int i = 0; i < 2; ++i) tr_matrix<0>(C, in[I_WOO] + (size_t)i * 2048 * 2048, 2048, 2048, (bf16*)(ws + WS_WOUTO) + (size_t)i * 2048 * 2048, 2048, 2048, C.gw, C.NGW);
    for (int e = 0; e < 2; ++e) {
        const float* wqb = in[I_WQB] + (size_t)e * 512 * 1536;
        cvt_small(C, (bf16*)(ws + WS_WQ) + (size_t)e * 1536 * 512, 1536, 512, [=](int n, int k) { const int hd = n / 192, wi = n % 192; int sc;
            if (wi < 128) sc = wi; else { const int idx = wi - 128, hf = idx >> 5, r = idx & 31; sc = 128 + 32 * hf + 16 * (r & 1) + (r >> 1); }
            return wqb[(size_t)k * 1536 + hd * 192 + sc]; });
        const float* wkv = in[I_WKVB] + (size_t)e * 256 * 2048;
        cvt_small(C, (bf16*)(ws + WS_WKN) + (size_t)e * 1024 * 256, 1024, 256, [=](int n, int k) { return wkv[(size_t)k * 2048 + (n >> 7) * 256 + (n & 127)]; });
        cvt_small(C, (bf16*)(ws + WS_WV) + (size_t)e * 1024 * 256, 1024, 256, [=](int n, int k) { return wkv[(size_t)k * 2048 + (n >> 7) * 256 + 128 + (n & 127)]; });
        const float* w2 = in[I_W2] + (size_t)e * 2 * 64 * 1024; const float* a2 = in[I_A2] + (size_t)e * 2 * 64 * 1024; const float* g2 = in[I_G2] + (size_t)e * 160 * 1024;
        cvt_small(C, (bf16*)(ws + WS_WLORA) + (size_t)e * 5120 * 384, 5120, 384, [=](int n, int k) { const int seg = n >> 10, c = n & 1023; float v = 0.f;
            if (seg < 2) { if (k < 64) v = w2[((size_t)seg * 64 + k) * 1024 + c]; }
            else if (seg < 4) { if (k >= 64 && k < 128) v = a2[((size_t)(seg - 2) * 64 + (k - 64)) * 1024 + c]; }
            else { if (k >= 128 && k < 288) v = g2[(size_t)(k - 128) * 1024 + c]; }
            return v; });
    }
    { const float* w3 = in[I_FW3];
      cvt_small(C, (bf16*)(ws + WS_W3T), 16384, 256, [=](int n, int k) { const int o = n >> 13, col = n & 8191; float v = 0.f; if ((k >> 6) == o) v = w3[((size_t)o * 64 + (k & 63)) * 8192 + col]; return v; }); }
    { LAS float* sl = (LAS float*)(C.lds + 8 * 8704);
      for (int it = C.bx; it < 4 * 8 * 9; it += C.G) {
          const int l = it / 72, kc = (it / 9) % 8, cc = it % 9;
          __syncthreads();
          for (int i = C.tid; i < 768; i += 512) { const int j = i >> 8, k = kc * 256 + (i & 255); const float cv = j == 0 ? in[I_CCTX][k] : in[I_C][(j - 1) * 2048 + k]; sl[i] = silu_f(cv); }
          __syncthreads();
          const int col = cc * 2048 + 4 * C.tid; const float* wp = in[I_WMOD] + ((size_t)l * 2048 + kc * 256) * 18432 + col;
          f32x4v a0 = {0.f, 0.f, 0.f, 0.f}, a1 = a0, a2 = a0;
#pragma unroll 4
          for (int k = 0; k < 256; ++k) { const f32x4v w = *(const f32x4v*)(wp + (size_t)k * 18432); a0 += w * sl[k]; a1 += w * sl[256 + k]; a2 += w * sl[512 + k]; }
          float* pm = (float*)(ws + WS_PMOD) + ((size_t)(kc * 4 + l) * 3) * 18432 + col;
          *(f32x4v*)(pm) = a0; *(f32x4v*)(pm + 18432) = a1; *(f32x4v*)(pm + 2 * 18432) = a2;
      }
      __syncthreads(); }
    { const f32x4v* s0 = (const f32x4v*)in[I_XP]; const f32x4v* s1 = (const f32x4v*)in[I_XS]; v2u* x = (v2u*)(ws + WS_X);
      const size_t n0 = (size_t)MP * D / 4, n1 = (size_t)MS * D / 4;
      for (size_t i = (size_t)C.bx * 512 + C.tid; i < n0 + n1; i += (size_t)C.G * 512) x[i] = h4_pack(i < n0 ? s0[i] : s1[i - n0]); }
    if (C.bx == 0) for (int i = C.tid; i < 1024; i += 512) { const int pos = i >> 4, j = i & 15; const float inv = 1.0f / powf(10000.0f, (float)(2 * j) / 32.0f); const float a = (float)pos * inv;
        float* r = (float*)(ws + WS_ROPE) + i * 2; r[0] = cosf(a); r[1] = sinf(a); }
    { bf16* H2 = (bf16*)(ws + WS_H2);
      for (int it = C.gw; it < 2 * 4352; it += C.NGW) {
          const int o = it / 4352, rr = it % 4352; const int L = rr < 256 ? 256 : 4096, t = rr < 256 ? rr : rr - 256; const int lane = C.lane;
          float zf = 0.f;
          if (lane == 0) zf = (float)t / (float)(L - 1);
          else if (lane < 33) { const int b = (lane - 1) & 15; const float fr = 1e-4f + (15.0f - 1e-4f) * ((float)b / 15.0f); const float ang = ((float)(2.0 * 3.14159265358979323846 / (double)L) * (float)t) * fr; zf = lane < 17 ? cosf(ang) : -sinf(ang); }
          const float* w1 = in[I_FW1] + (size_t)o * 33 * 64; const float* w2 = in[I_FW2] + (size_t)o * 64 * 64;
          float s = in[I_FB1][o * 64 + lane];
          for (int i = 0; i < 33; ++i) s += shfl_idx(zf, i) * w1[i * 64 + lane];
          const float h1 = sinf(in[I_FFR][(o * 2 + 0) * 64 + lane] * s);
          float s2 = in[I_FB2][o * 64 + lane];
          for (int i = 0; i < 64; ++i) s2 += shfl_idx(h1, i) * w2[i * 64 + lane];
          const float h2 = sinf(in[I_FFR][(o * 2 + 1) * 64 + lane] * s2);
          H2[(size_t)rr * 256 + o * 64 + lane] = (bf16)f2bf(h2);
          if (o == 0) { H2[(size_t)rr * 256 + 128 + lane] = 0; H2[(size_t)rr * 256 + 192 + lane] = 0; }
      } }
}
DI void phase_mod_reduce(Ctx& C) {
    const float* pm = (const float*)(C.ws + WS_PMOD); float* mod = (float*)(C.ws + WS_MOD); const float* bm = C.in[I_BMOD];
    for (int i = C.bx * 512 + C.tid; i < 4 * 3 * 18432; i += C.G * 512) { const int l = i / MODL, n = i % 18432; float s = bm[l * 18432 + n];
#pragma unroll
        for (int kc = 0; kc < 8; ++kc) s += pm[(size_t)kc * 4 * MODL + i];
        mod[i] = s; }
}
DI void phase_norm_mod(Ctx& C, const float* g, const float* modl, int s) {
    const unsigned short* X = (const unsigned short*)(C.ws + WS_X); bf16* H = (bf16*)(C.ws + WS_H);
    for (int row = C.gw; row < MT; row += C.NGW) {
        const float* sh = modl + row_mod_j(row) * 18432 + (3 * s) * 2048; const float* scl = sh + 2048;
        const v2u* xr = (const v2u*)(X + (size_t)row * D) + C.lane; f32x4v v[8]; float ss = 0.f;
#pragma unroll
        for (int i = 0; i < 8; ++i) { v[i] = h4_unpack(xr[64 * i]); ss += (v[i].x * v[i].x + v[i].y * v[i].y) + (v[i].z * v[i].z + v[i].w * v[i].w); }
        const float rstd = 1.0f / sqrtf(wave_sum(ss) * (1.0f / D) + 1e-6f);
        v2u* o = (v2u*)(H + (size_t)row * D) + C.lane;
#pragma unroll
        for (int i = 0; i < 8; ++i) { const int c = 4 * C.lane + 256 * i; const f32x4v gg = *(const f32x4v*)(g + c), sc = *(const f32x4v*)(scl + c), sf = *(const f32x4v*)(sh + c);
            const f32x4v y = (v[i] * rstd * gg) * (sc + 1.0f) + sf; v2u w; w.x = pk2(y.x, y.y); w.y = pk2(y.z, y.w); o[64 * i] = w; }
    }
}
DI void phase_final_norm(Ctx& C) {
    const unsigned short* X = (const unsigned short*)(C.ws + WS_X); const float* g = C.in[I_FNG];
    for (int row = C.gw; row < MT; row += C.NGW) {
        const v2u* xr = (const v2u*)(X + (size_t)row * D) + C.lane; f32x4v v[8]; float ss = 0.f;
#pragma unroll
        for (int i = 0; i < 8; ++i) { v[i] = h4_unpack(xr[64 * i]); ss += (v[i].x * v[i].x + v[i].y * v[i].y) + (v[i].z * v[i].z + v[i].w * v[i].w); }
        const float rstd = 1.0f / sqrtf(wave_sum(ss) * (1.0f / D) + 1e-6f);
        f32x4v* o = (f32x4v*)(C.out + (size_t)row * D) + C.lane;
#pragma unroll
        for (int i = 0; i < 8; ++i) { const f32x4v gg = *(const f32x4v*)(g + 4 * C.lane + 256 * i); o[64 * i] = v[i] * rstd * gg; }
    }
}

DI int rope_src(int p) { const int hf = p >> 5, r = p & 31; return 32 * hf + 16 * (r & 1) + (r >> 1); }
DI void phase_even_prep(Ctx& C, int e) {
    const float* const* in = C.in; unsigned char* ws = C.ws; const int lane = C.lane;
    const float* Z = (const float*)(ws + WS_Z); float* SC = (float*)(ws + WS_SCAN + (size_t)e * SCAN_BYTES); float* KB = (float*)(ws + WS_KBUF); bf16* LA = (bf16*)(ws + WS_LA);
    bf16* CQ = (bf16*)(ws + WS_CQ); bf16* CKV = (bf16*)(ws + WS_CKV); bf16* KR = (bf16*)(ws + WS_KR); const float* rope = (const float*)(ws + WS_ROPE);
    const float* mup = in[I_MUP] + e * 3360; const float* mun = in[I_MUN] + e * 3360; const float* kkw = in[I_KK] + e * 1024;
    const float* qn = in[I_QN] + e * 512; const float* kvn = in[I_KVN] + e * 256;
    for (int row = C.gw; row < MKV; row += C.NGW) {
        if (row >= MT) {
            const int rr = row - MT, b = rr >> 8, p = rr & 255;
            const float* cs = in[I_CCKV] + ((size_t)(b * 2 + e) * 256 + p) * 256;
#pragma unroll
            for (int i = 0; i < 4; ++i) CKV[(size_t)row * 256 + 64 * i + lane] = (bf16)f2bf(cs[64 * i + lane]);
            KR[(size_t)row * 64 + lane] = (bf16)f2bf(in[I_CKR][((size_t)(b * 2 + e) * 256 + p) * 64 + rope_src(lane)]);
            continue;
        }
        const bool smp = row >= MP; const int T = smp ? 4096 : 256; const int t = smp ? ((row - MP) & 4095) : (row & 255);
        const float* z = Z + (size_t)row * ZE_P; const bool hp = t > 0, hn = t < T - 1;
        float* sc = SC + (size_t)row * SCAN_P;
#define ZMIX4(c) ({ const f32x4v zc_ = *(const f32x4v*)(z + (c)); const f32x4v zp_ = hp ? *(const f32x4v*)(z + (c) - ZE_P) : (f32x4v){0.f, 0.f, 0.f, 0.f}; const f32x4v zn_ = hn ? *(const f32x4v*)(z + (c) + ZE_P) : (f32x4v){0.f, 0.f, 0.f, 0.f}; \
            zc_ + *(const f32x4v*)(mup + (c)) * (zp_ - zc_) + *(const f32x4v*)(mun + (c)) * (zn_ - zc_); })
#define ZMIX(c) ({ const float zc_ = z[c]; const float zp_ = hp ? z[(c) - ZE_P] : 0.f; const float zn_ = hn ? z[(c) + ZE_P] : 0.f; zc_ + mup[c] * (zp_ - zc_) + mun[c] * (zn_ - zc_); })
#pragma unroll
        for (int i = 0; i < 4; ++i) { const int c = 256 * i + 4 * lane;
            *(f32x4v*)(sc + c) = ZMIX4(c);
            *(f32x4v*)(sc + 1024 + c) = ZMIX4(2048 + c);
            const f32x4v k = ZMIX4(1024 + c); *(f32x4v*)(KB + (size_t)row * 1024 + c) = k;
            const f32x4v kk = k * *(const f32x4v*)(kkw + c); float ss = (kk.x * kk.x + kk.y * kk.y) + (kk.z * kk.z + kk.w * kk.w);
            ss += dpp_f<0xB1>(ss); ss += dpp_f<0x4E>(ss); ss += dpp_f<0x141>(ss); ss += dpp_f<0x140>(ss);
            *(f32x4v*)(sc + 2048 + c) = kk * (1.0f / fmaxf(sqrtf(ss), 1e-12f)); }
        bf16* la = LA + (size_t)row * 384;
        la[lane] = (bf16)f2bf(tanhf(ZMIX(3072 + lane)));
        la[64 + lane] = (bf16)f2bf(ZMIX(3136 + lane));
        la[128 + lane] = (bf16)f2bf(sigmoid_f(ZMIX(3200 + lane)));
        la[192 + lane] = (bf16)f2bf(sigmoid_f(ZMIX(3264 + lane)));
        { float xg = 0.f; if (lane < 32) xg = sigmoid_f(ZMIX(3328 + lane)); la[256 + lane] = (bf16)(lane < 32 ? f2bf(xg) : 0u); la[320 + lane] = 0; }
#undef ZMIX4
#undef ZMIX
        float cq[8], ss = 0.f;
#pragma unroll
        for (int i = 0; i < 8; ++i) { cq[i] = z[3360 + 64 * i + lane]; ss += cq[i] * cq[i]; }
        float rstd = 1.0f / sqrtf(wave_sum(ss) * (1.0f / 512.0f) + 1e-6f);
#pragma unroll
        for (int i = 0; i < 8; ++i) CQ[(size_t)row * 512 + 64 * i + lane] = (bf16)f2bf(cq[i] * rstd * qn[64 * i + lane]);
        float ck[4]; ss = 0.f;
#pragma unroll
        for (int i = 0; i < 4; ++i) { ck[i] = z[3872 + 64 * i + lane]; ss += ck[i] * ck[i]; }
        rstd = 1.0f / sqrtf(wave_sum(ss) * (1.0f / 256.0f) + 1e-6f);
#pragma unroll
        for (int i = 0; i < 4; ++i) { const float y = ck[i] * rstd * kvn[64 * i + lane]; CKV[(size_t)row * 256 + 64 * i + lane] = (bf16)f2bf(y);
            if (!smp) C.out[OUT_CKV + ((size_t)((row >> 8) * 2 + e) * 256 + t) * 256 + 64 * i + lane] = y; }
        const float kr = z[4128 + lane];
        if (!smp) { C.out[OUT_KR + ((size_t)((row >> 8) * 2 + e) * 256 + t) * 64 + lane] = kr; KR[(size_t)row * 64 + lane] = (bf16)f2bf(shfl_idx(kr, rope_src(lane))); }
        else { const int hf = lane >> 5, jj = lane & 15, e2 = (lane >> 4) & 1; const int pos = hf ? (t & 63) : (t >> 6);
            const float xo = shfl_idx(kr, lane ^ 16); const float2 cs = *(const float2*)(rope + (pos * 16 + jj) * 2);
            const float rot = e2 == 0 ? kr * cs.x - xo * cs.y : kr * cs.x + xo * cs.y;
            KR[(size_t)row * 64 + lane] = (bf16)f2bf(shfl_idx(rot, rope_src(lane))); }
    }
}

template <int N> DI float fmac_bc(float acc, float op, float s) { asm("v_fmac_f32_dpp %0, %1, %2 row_newbcast:%3 row_mask:0xf bank_mask:0xf" : "+v"(acc) : "v"(op), "v"(s), "n"(N)); return acc; }
template <int N> DI float mul_bc(float op, float s) { float r; asm("v_mul_f32_dpp %0, %1, %2 row_newbcast:%3 row_mask:0xf bank_mask:0xf" : "=v"(r) : "v"(op), "v"(s), "n"(N)); return r; }
struct ScanOps { f32x4v kk, w, kka, kd, r; float vv; };
typedef __attribute__((__vector_size__(4 * sizeof(int)))) int rsrc_t;
DI f32x4v bl128(__amdgpu_buffer_rsrc_t r, unsigned vo, unsigned so) { return __builtin_bit_cast(f32x4v, __builtin_amdgcn_raw_buffer_load_b128(r, (int)vo, (int)so, 0)); }
DI float bl32(__amdgpu_buffer_rsrc_t r, unsigned vo, unsigned so) { return __builtin_bit_cast(float, __builtin_amdgcn_raw_buffer_load_b32(r, (int)vo, (int)so, 0)); }
template <int MODE> DI ScanOps scan_load(__amdgpu_buffer_rsrc_t rs, unsigned so, unsigned lo, unsigned lv, int d) {
    ScanOps o;
    o.kk = bl128(rs, lo + 2u * 4096u, so); o.w = bl128(rs, lo + (3u + (unsigned)d) * 4096u, so); o.kka = bl128(rs, lo + (5u + (unsigned)d) * 4096u, so);
    if (MODE != 0) { o.kd = bl128(rs, lo + (7u + (unsigned)d) * 4096u, so); o.vv = bl32(rs, lv + 4096u, so); } else { o.kd = (f32x4v){0.f, 0.f, 0.f, 0.f}; o.vv = 0.f; }
    if (MODE == 2) o.r = bl128(rs, lo, so); else o.r = (f32x4v){0.f, 0.f, 0.f, 0.f};
    return o;
}
template <int MODE, int J> DI void scan_col_a(const ScanOps& o, const float (&S)[64], float (&sa)[4]) { sa[J & 3] = fmac_bc<(J >> 2)>(sa[J & 3], o.kk[J & 3], S[J]); }
template <int MODE, int J> DI void scan_col_b(const ScanOps& o, float (&S)[64], float sa, float (&y)[4]) {
    float t = mul_bc<(J >> 2)>(o.w[J & 3], S[J]);
    t = fmac_bc<(J >> 2)>(t, o.kka[J & 3], sa);
    if (MODE != 0) t = fmac_bc<(J >> 2)>(t, o.kd[J & 3], o.vv);
    S[J] = t;
    if (MODE == 2) y[J & 3] = fmac_bc<(J >> 2)>(y[J & 3], o.r[J & 3], t);
}
template <int MODE, int... Js> DI float scan_step(const ScanOps& o, float (&S)[64], std::integer_sequence<int, Js...>) {
    float sa[4] = {0.f, 0.f, 0.f, 0.f}, y[4] = {0.f, 0.f, 0.f, 0.f};
    (scan_col_a<MODE, Js>(o, S, sa), ...);
    const float sat = -((sa[0] + sa[1]) + (sa[2] + sa[3]));
    (scan_col_b<MODE, Js>(o, S, sat, y), ...);
    return (y[0] + y[1]) + (y[2] + y[3]);
}
template <int MODE> DI void scan_wave(const float* SCp, int row0, int rstep, int nsteps, int h, int d, float (&S)[64], float* yout, int lane) {
    const __amdgpu_buffer_rsrc_t rs = __builtin_amdgcn_make_buffer_rsrc((void*)SCp, 0, (int)((size_t)MT * SCAN_P * 4), 0x00020000);
    const __amdgpu_buffer_rsrc_t ry = __builtin_amdgcn_make_buffer_rsrc((void*)yout, 0, (int)((size_t)MT * 1024 * 4), 0x00020000);
    const int so0 = (row0 * SCAN_P + h * 64) * 4, sstep = rstep * SCAN_P * 4, last = nsteps - 1;
    int yo = (row0 * 1024 + h * 64) * 4; const int ystep = rstep * 4096;
    const unsigned lo = 16u * (unsigned)(lane & 15), lv = 4u * (unsigned)lane;
#define SC_LD(s_) scan_load<MODE>(rs, (unsigned)(so0 + ((s_) < last ? (s_) : last) * sstep), lo, lv, d)
#define SC_ST(o_) do { const float y_ = scan_step<MODE>(o_, S, std::make_integer_sequence<int, 64>{}); if (MODE == 2) __builtin_amdgcn_raw_buffer_store_b32(__builtin_bit_cast(unsigned, y_), ry, (int)lv, yo, 0); yo += ystep; } while (0)
    ScanOps o0 = SC_LD(0), o1 = SC_LD(1), o2 = SC_LD(2), o3;
    for (int s = 0; s < nsteps; s += 4) {
        o3 = SC_LD(s + 3); SC_ST(o0);
        o0 = SC_LD(s + 4); SC_ST(o1);
        o1 = SC_LD(s + 5); SC_ST(o2);
        o2 = SC_LD(s + 6); SC_ST(o3);
    }
#undef SC_LD
#undef SC_ST
}
DI void phase_scan1(Ctx& C, int e, int qslot) {
    const float* SCp = (const float*)(C.ws + WS_SCAN + (size_t)e * SCAN_BYTES); float* PQ = (float*)(C.ws + WS_PQ); float* Y = (float*)(C.ws + WS_YSC);
    const int nit = 512 + 64 * (NCH - 1) * 2;
    unsigned* qctr = (unsigned*)(C.ws + WS_CTL) + 8192 + 64 * (e + 2 * qslot);
    for (;;) {
        unsigned itu = 0; if (C.lane == 0) itu = __hip_atomic_fetch_add(qctr, 1u, __ATOMIC_RELAXED, __HIP_MEMORY_SCOPE_AGENT);
        const int it = __builtin_amdgcn_readfirstlane((int)itu); if (it >= nit) break;
        int lane = C.lane; asm volatile("" : "+v"(lane));
        float S[64];
        if (it >= 512) { const int si = it - 512;
            const int kind = si & 1, c = (si >> 1) % (NCH - 1), sidx = (si >> 1) / (NCH - 1);        const int d = sidx & 1, h = (sidx >> 1) & 15, b = sidx >> 5;
            const int t0 = d ? 4095 - c * CHL : c * CHL; const int row0 = MP + b * 4096 + t0;
            float fl = (float)lane; asm volatile("" : "+v"(fl)); const float kf = kind == 0 ? 1.f : 0.f;
#pragma unroll
            for (int j = 0; j < 64; ++j) { S[j] = kf * fmaxf(0.f, 1.f - fabsf(fl - (float)j)); }
            if (kind == 0) scan_wave<0>(SCp, row0, d ? -1 : 1, CHL, h, d, S, nullptr, lane); else scan_wave<1>(SCp, row0, d ? -1 : 1, CHL, h, d, S, nullptr, lane);
            float* dst = PQ + (((size_t)sidx * NCH + c) * 2 + kind) * 4096 + lane * 64;
#pragma unroll
            for (int j = 0; j < 16; ++j) *(f32x4v*)(dst + 4 * j) = (f32x4v){S[4 * j], S[4 * j + 1], S[4 * j + 2], S[4 * j + 3]};
        } else {
            const int pi = it; const int d = pi & 1, h = (pi >> 1) & 15, b = pi >> 5;
#pragma unroll
            for (int j = 0; j < 64; ++j) S[j] = 0.f;
            scan_wave<2>(SCp, b * 256 + (d ? 255 : 0), d ? -1 : 1, 128, h, d, S, Y + (size_t)d * MT * 1024, lane);
            float* dst = (float*)(C.ws + WS_PST) + (size_t)pi * 4096 + lane * 64;
#pragma unroll
            for (int j = 0; j < 16; ++j) *(f32x4v*)(dst + 4 * j) = (f32x4v){S[4 * j], S[4 * j + 1], S[4 * j + 2], S[4 * j + 3]};
        }
    }
}
DI void phase_scan_carry(Ctx& C, int e, int nsw) {
    const float* PQ = (const float*)(C.ws + WS_PQ); float* SST = (float*)(C.ws + WS_SST);
    LAS float* Ss = (LAS float*)C.lds;
    LAS float* Ps = (LAS float*)(C.lds + 64 * 65 * 4 + 64);
    for (int sidx = C.bx; sidx < 64; sidx += C.G) {
        const int d = sidx & 1, h = (sidx >> 1) & 15, b = sidx >> 5; const int row = C.tid & 63, cg = C.wave;
        const float* s0 = C.in[I_ST] + ((((size_t)b * 2 + e) * 2 + d) * 16 + h) * 4096;
        __syncthreads();
        for (int i = C.tid; i < 4096; i += 512) { const float v = s0[i]; Ss[(i >> 6) * 65 + (i & 63)] = v; SST[((size_t)sidx * NCH) * 4096 + i] = v; }
        const float* PQs = PQ + (size_t)sidx * NCH * 2 * 4096;
        f32x4v pp0 = *(const f32x4v*)(PQs + 4 * C.tid), pp1 = *(const f32x4v*)(PQs + 2048 + 4 * C.tid);
        f32x4v qq0 = *(const f32x4v*)(PQs + 4096 + row * 64 + cg * 8), qq1 = *(const f32x4v*)(PQs + 4096 + row * 64 + cg * 8 + 4);
        for (int c = 0; c + 1 < NCH; ++c) {
            __syncthreads();
            *(LAS f32x4v*)(Ps + 4 * C.tid) = pp0; *(LAS f32x4v*)(Ps + 2048 + 4 * C.tid) = pp1;
            float o[8] = {qq0.x, qq0.y, qq0.z, qq0.w, qq1.x, qq1.y, qq1.z, qq1.w};
            if (c + 2 < NCH) { const float* nx = PQs + (size_t)(c + 1) * 2 * 4096;
                pp0 = *(const f32x4v*)(nx + 4 * C.tid); pp1 = *(const f32x4v*)(nx + 2048 + 4 * C.tid);
                qq0 = *(const f32x4v*)(nx + 4096 + row * 64 + cg * 8); qq1 = *(const f32x4v*)(nx + 4096 + row * 64 + cg * 8 + 4); }
            __syncthreads();
            for (int k = 0; k < 64; ++k) { const float sv = Ss[row * 65 + k]; const f32x4v p0 = *(const LAS f32x4v*)(Ps + k * 64 + cg * 8), p1 = *(const LAS f32x4v*)(Ps + k * 64 + cg * 8 + 4);
                o[0] += sv * p0.x; o[1] += sv * p0.y; o[2] += sv * p0.z; o[3] += sv * p0.w; o[4] += sv * p1.x; o[5] += sv * p1.y; o[6] += sv * p1.z; o[7] += sv * p1.w; }
            __syncthreads();
            float* dst = SST + ((size_t)sidx * NCH + c + 1) * 4096 + row * 64 + cg * 8;
#pragma unroll
            for (int i = 0; i < 8; ++i) Ss[row * 65 + cg * 8 + i] = o[i];
            *(f32x4v*)dst = (f32x4v){o[0], o[1], o[2], o[3]}; *(f32x4v*)(dst + 4) = (f32x4v){o[4], o[5], o[6], o[7]};
        }
    }
    {
        const int nb0 = C.G > 64 ? 64 : 0; const float* SCp = (const float*)(C.ws + WS_SCAN + (size_t)e * SCAN_BYTES); float* Y = (float*)(C.ws + WS_YSC);
        if (C.bx >= nb0 && C.wave < nsw) for (int pi = (C.bx - nb0) * nsw + C.wave; pi < 512; pi += (C.G - nb0) * nsw) {
            int lane = C.lane; asm volatile("" : "+v"(lane));
            const int d = pi & 1, h = (pi >> 1) & 15, b = pi >> 5;
            float S[64]; const float* src = (const float*)(C.ws + WS_PST) + (size_t)pi * 4096 + lane * 64;
#pragma unroll
            for (int j = 0; j < 16; ++j) { const f32x4v t = *(const f32x4v*)(src + 4 * j); S[4 * j] = t.x; S[4 * j + 1] = t.y; S[4 * j + 2] = t.z; S[4 * j + 3] = t.w; }
            scan_wave<2>(SCp, b * 256 + (d ? 127 : 128), d ? -1 : 1, 128, h, d, S, Y + (size_t)d * MT * 1024, lane);
            float* dst = C.out + OUT_ST + ((((size_t)b * 2 + e) * 2 + d) * 16 + h) * 4096 + lane * 64;
#pragma unroll
            for (int j = 0; j < 16; ++j) *(f32x4v*)(dst + 4 * j) = (f32x4v){S[4 * j], S[4 * j + 1], S[4 * j + 2], S[4 * j + 3]};
        }
    }
}
DI void phase_scan3(Ctx& C, int e) {
    const float* SCp = (const float*)(C.ws + WS_SCAN + (size_t)e * SCAN_BYTES); const float* SST = (const float*)(C.ws + WS_SST); float* Y = (float*)(C.ws + WS_YSC);
    for (int it = C.gw; it < 64 * NCH; it += C.NGW) {
        int lane = C.lane; asm volatile("" : "+v"(lane));
        const int c = it % NCH, sidx = it / NCH; const int d = sidx & 1, h = (sidx >> 1) & 15, b = sidx >> 5;
        const int t0 = d ? 4095 - c * CHL : c * CHL; const int row0 = MP + b * 4096 + t0;
        float S[64]; const float* src = SST + ((size_t)sidx * NCH + c) * 4096 + lane * 64;
#pragma unroll
        for (int j = 0; j < 16; ++j) { const f32x4v t = *(const f32x4v*)(src + 4 * j); S[4 * j] = t.x; S[4 * j + 1] = t.y; S[4 * j + 2] = t.z; S[4 * j + 3] = t.w; }
        scan_wave<2>(SCp, row0, d ? -1 : 1, CHL, h, d, S, Y + (size_t)d * MT * 1024, lane);
    }
}
DI float row16_sum(float v) { v += dpp_f<0xB1>(v); v += dpp_f<0x4E>(v); v += dpp_f<0x141>(v); v += dpp_f<0x140>(v); return v; }
DI void phase_rwkv_post(Ctx& C, int e) {
    const float* SCp = (const float*)(C.ws + WS_SCAN + (size_t)e * SCAN_BYTES); const float* Y = (const float*)(C.ws + WS_YSC); const float* GB = (const float*)(C.ws + WS_GB); bf16* MIX = (bf16*)(C.ws + WS_MIX);
    const float* rk = C.in[I_RK] + e * 1024; const float* gw = C.in[I_GNW] + e * 1024; const float* gb = C.in[I_GNB] + e * 1024; const int lane = C.lane;
    for (int row = C.gw; row < MT; row += C.NGW) {
        const float* sc = SCp + (size_t)row * SCAN_P;
#pragma unroll
        for (int i = 0; i < 4; ++i) { const int c = 256 * i + 4 * lane;
            const f32x4v y = *(const f32x4v*)(Y + (size_t)row * 1024 + c) + *(const f32x4v*)(Y + ((size_t)MT + row) * 1024 + c);
            const float mu = row16_sum((y.x + y.y) + (y.z + y.w)) * (1.0f / 64.0f); const f32x4v dl = y - mu;
            const float var = row16_sum((dl.x * dl.x + dl.y * dl.y) + (dl.z * dl.z + dl.w * dl.w)) * (1.0f / 64.0f);
            const f32x4v yn = dl * (1.0f / sqrtf(var + 64e-5f));
            const f32x4v rr = *(const f32x4v*)(sc + c), kd = *(const f32x4v*)(sc + 7 * 1024 + c) + *(const f32x4v*)(sc + 8 * 1024 + c), rkv = *(const f32x4v*)(rk + c); const f32x4v pb = rr * kd * rkv;
            const float bs = row16_sum((pb.x + pb.y) + (pb.z + pb.w));
            const f32x4v o = (yn * *(const f32x4v*)(gw + c) + *(const f32x4v*)(gb + c) + *(const f32x4v*)(sc + 1024 + c) * bs) * *(const f32x4v*)(GB + (size_t)row * 1024 + c);
            v2u w; w.x = pk2(o.x, o.y); w.y = pk2(o.z, o.w); *(v2u*)(MIX + (size_t)row * 2048 + c) = w; }
    }
}

constexpr int AT_KP = 200, AT_VP = 72, AT_KB = 64 * AT_KP * 2, AT_VB = 128 * AT_VP * 2, AT_BUF = AT_KB + AT_VB;
DI void attn_unit(Ctx& C, const bf16* Qb, const bf16* KN, const bf16* KRb, const bf16* VTh  , int vpitch, bf16* MIX, int qrow0, int h, int krow0, int nlat, int crow0, int ntile) {
    int tid = C.tid; asm volatile("" : "+v"(tid)); const int lane = tid & 63, r = lane & 31, hh = lane >> 5;
    LAS unsigned char* lds = C.lds;
    s16x8v qf[12];
    { const bf16* qp = Qb + (size_t)(qrow0 + C.wave * 32 + r) * 1536 + h * 192 + 8 * hh;
#pragma unroll
      for (int s = 0; s < 12; ++s) qf[s] = *(const s16x8v*)(qp + 16 * s); }
    f32x16v o[4];
#pragma unroll
    for (int vb = 0; vb < 4; ++vb)
#pragma unroll
        for (int i = 0; i < 16; ++i) o[vb][i] = 0.f;
    float mrun = -INFINITY, lsum = 0.f;
    v4u pre[5];
    auto issue = [&](int j) {
        const int k0 = 64 * j; const int rbase = k0 < nlat ? krow0 + k0 : crow0 + (k0 - nlat);
#pragma unroll
        for (int i = 0; i < 3; ++i) { const int p = tid + 512 * i, key = p / 24, pc = p % 24; const size_t rw = (size_t)(rbase + key);
            pre[i] = pc < 16 ? *(const v4u*)(KN + rw * 1024 + h * 128 + pc * 8) : *(const v4u*)(KRb + rw * 64 + (pc - 16) * 8); }
#pragma unroll
        for (int i = 0; i < 2; ++i) { const int p = tid + 512 * i, dv = p >> 3, pc = p & 7; pre[3 + i] = *(const v4u*)(VTh + (size_t)dv * vpitch + k0 + pc * 8); }
    };
    auto commit = [&](int buf) {
        LAS unsigned char* kb = lds + buf * AT_BUF; LAS unsigned char* vbp = kb + AT_KB;
#pragma unroll
        for (int i = 0; i < 3; ++i) { const int p = tid + 512 * i, key = p / 24, pc = p % 24; *(LAS v4u*)(kb + key * (AT_KP * 2) + pc * 16) = pre[i]; }
#pragma unroll
        for (int i = 0; i < 2; ++i) { const int p = tid + 512 * i, dv = p >> 3, pc = p & 7; *(LAS v4u*)(vbp + dv * (AT_VP * 2) + pc * 16) = pre[3 + i]; }
    };
    __syncthreads();
    issue(0); commit(0); __syncthreads();
    for (int j = 0; j < ntile; ++j) {
        if (j + 1 < ntile) issue(j + 1);
        const LAS unsigned char* kb = lds + (j & 1) * AT_BUF; const LAS unsigned char* vbp = kb + AT_KB;
        f32x16v st[2];
        __builtin_amdgcn_s_setprio(1);
#pragma unroll
        for (int kbk = 0; kbk < 2; ++kbk) {
#pragma unroll
            for (int i = 0; i < 16; ++i) st[kbk][i] = 0.f;
#pragma unroll
            for (int s = 0; s < 12; ++s) { const s16x8v a = *(const LAS s16x8v*)(kb + (32 * kbk + r) * (AT_KP * 2) + (16 * s + 8 * hh) * 2);
                st[kbk] = __builtin_amdgcn_mfma_f32_32x32x16_bf16(a, qf[s], st[kbk], 0, 0, 0); }
        }
        __builtin_amdgcn_s_setprio(0);
        float mx = st[0][0];
#pragma unroll
        for (int i = 1; i < 16; ++i) mx = fmaxf(mx, st[0][i]);
#pragma unroll
        for (int i = 0; i < 16; ++i) mx = fmaxf(mx, st[1][i]);
        mx = fmaxf(mx, shfl_idx(mx, lane ^ 32));
        const float mnew = fmaxf(mrun, mx); const float alpha = __builtin_amdgcn_exp2f(mrun - mnew); mrun = mnew;
        float ps = 0.f;
#pragma unroll
        for (int kbk = 0; kbk < 2; ++kbk)
#pragma unroll
            for (int i = 0; i < 16; ++i) { const float p = __builtin_amdgcn_exp2f(st[kbk][i] - mnew); st[kbk][i] = p; ps += p; }
        lsum = lsum * alpha + ps;
        if (__builtin_amdgcn_ballot_w64(alpha != 1.0f) != 0ull) {
#pragma unroll
            for (int vb = 0; vb < 4; ++vb)
#pragma unroll
                for (int i = 0; i < 16; ++i) o[vb][i] *= alpha; }
        __builtin_amdgcn_s_setprio(1);
#pragma unroll
        for (int kbk = 0; kbk < 2; ++kbk)
#pragma unroll
            for (int s2 = 0; s2 < 2; ++s2) {
                v4u pw; pw.x = pg8::cvt_pk_bf16(st[kbk][8 * s2 + 0], st[kbk][8 * s2 + 1]); pw.y = pg8::cvt_pk_bf16(st[kbk][8 * s2 + 2], st[kbk][8 * s2 + 3]); pw.z = pg8::cvt_pk_bf16(st[kbk][8 * s2 + 4], st[kbk][8 * s2 + 5]); pw.w = pg8::cvt_pk_bf16(st[kbk][8 * s2 + 6], st[kbk][8 * s2 + 7]);
                const s16x8v pf = __builtin_bit_cast(s16x8v, pw);
#pragma unroll
                for (int vb = 0; vb < 4; ++vb) { const LAS unsigned char* vp = vbp + (32 * vb + r) * (AT_VP * 2) + (32 * kbk + 16 * s2 + 4 * hh) * 2;
                    const v2u lo = *(const LAS v2u*)vp, hi = *(const LAS v2u*)(vp + 16); const v4u av = {lo.x, lo.y, hi.x, hi.y};
                    o[vb] = __builtin_amdgcn_mfma_f32_32x32x16_bf16(__builtin_bit_cast(s16x8v, av), pf, o[vb], 0, 0, 0); }
            }
        __builtin_amdgcn_s_setprio(0);
        if (j + 1 < ntile) commit((j + 1) & 1);
        __syncthreads();
    }
    const float inv = 1.0f / (lsum + shfl_idx(lsum, lane ^ 32));
    bf16* op = MIX + (size_t)(qrow0 + C.wave * 32 + r) * 2048 + 1024 + h * 128 + 4 * hh;
#pragma unroll
    for (int vb = 0; vb < 4; ++vb)
#pragma unroll
        for (int g = 0; g < 4; ++g) { v2u w; w.x = pk2(o[vb][4 * g] * inv, o[vb][4 * g + 1] * inv); w.y = pk2(o[vb][4 * g + 2] * inv, o[vb][4 * g + 3] * inv);
            *(v2u*)(op + 32 * vb + 8 * g) = w; }
}
DI void phase_attention(Ctx& C) {
    unsigned char* ws = C.ws; const bf16* Qb = (const bf16*)(ws + WS_Q); const bf16* KN = (const bf16*)(ws + WS_KN); const bf16* KRb = (const bf16*)(ws + WS_KR); bf16* MIX = (bf16*)(ws + WS_MIX);
    const bf16* VTp = (const bf16*)(ws + WS_VT); const bf16* VTs = (const bf16*)(ws + WS_VT + VT_S_OFF);
    for (int u = C.bx; u < 256 + 128; u += C.G) {
        if (u < 256) { const int qb = u & 15, h = (u >> 4) & 7, b = u >> 7;
            attn_unit(C, Qb, KN, KRb, VTs + ((size_t)b * 1024 + h * 128) * 4352, 4352, MIX, MP + b * 4096 + qb * 256, h, MP + b * 4096, 4096, MT + b * 256, 68); }
        else { const int v = u - 256, h = v & 7, b = v >> 3;
            attn_unit(C, Qb, KN, KRb, VTp + ((size_t)b * 1024 + h * 128) * 256, 256, MIX, b * 256, h, b * 256, 256, 0, 4); }
    }
    __syncthreads();
}

DI f32x2v mk2(float a, float b) { return (f32x2v){a, b}; }
DI f32x2v cmul(f32x2v a, f32x2v b) { const f32x2v t = {-b.y, b.x}; return a.x * b + a.y * t; }
DI f32x2v cmulc(f32x2v a, f32x2v b) { const f32x2v t = {b.y, -b.x}; return a.x * b + a.y * t; }
DI f32x2v mul_mi(f32x2v a) { return mk2(a.y, -a.x); }
DI f32x2v mul_pi(f32x2v a) { return mk2(-a.y, a.x); }
DI f32x2v twid(int p, int den) { const float fr = (float)p / (float)den; return mk2(__builtin_amdgcn_cosf(fr), __builtin_amdgcn_sinf(fr)); }
DI int PD(int i) { return i + ((i >> 5) << 1); }
constexpr int FFT_BS = 8192 + 512, FFT_BUF_BYTES = FFT_BS * 8;
DI void bf4_fwd(f32x2v& x0, f32x2v& x1, f32x2v& x2, f32x2v& x3, f32x2v w0, f32x2v wm) {
    const f32x2v a0 = x0 + x2, a2 = cmul(x0 - x2, w0), a1 = x1 + x3, a3 = cmul(x1 - x3, mul_mi(w0));
    x0 = a0 + a1; x1 = cmul(a0 - a1, wm); x2 = a2 + a3; x3 = cmul(a2 - a3, wm);
}
DI void bf4_inv(f32x2v& x0, f32x2v& x1, f32x2v& x2, f32x2v& x3, f32x2v wa, f32x2v w) {
    const f32x2v t1 = cmul(x1, w), t3 = cmul(x3, w);
    const f32x2v a0 = x0 + t1, a1 = x0 - t1, a2 = x2 + t3, a3 = x2 - t3;
    const f32x2v t2 = cmul(a2, wa), t3b = cmul(a3, mul_pi(wa));
    x0 = a0 + t2; x1 = a1 + t3b; x2 = a0 - t2; x3 = a1 - t3b;
}
template <int N, int M, int NI = 1> DI void fft_fwd_pass(LAS f32x2v* buf, int tid) {
    constexpr int S = M / 8;
    const int tr = tid / (N / 16), u = tid % (N / 16), g = u / S, p = u % S; const int base = tr * N + g * 2 * M + p;
    f32x2v e[NI][16];
#pragma unroll
    for (int j = 0; j < NI; ++j)
#pragma unroll
        for (int k = 0; k < 16; ++k) e[j][k] = buf[j * FFT_BS + PD(base + k * S)];
    const f32x2v bc = twid(p, 2 * M); const f32x2v b1 = mk2(bc.x, -bc.y), b2 = cmul(b1, b1), b4 = cmul(b2, b2), b8 = cmul(b4, b4);
    constexpr float C1 = 0.92387953251128674f, S1 = 0.38268343236508977f, R2 = 0.70710678118654752f;
    const f32x2v w1a = cmul(b1, mk2(C1, -S1)), w1b = cmul(b2, mk2(R2, -R2)), w2a = cmul(b1, mk2(R2, -R2)), w2b = mul_mi(b2), w3a = cmul(b1, mk2(S1, -C1)), w3b = cmul(b2, mk2(-R2, -R2));
#pragma unroll
    for (int j = 0; j < NI; ++j) {
        bf4_fwd(e[j][0], e[j][4], e[j][8], e[j][12], b1, b2);
        bf4_fwd(e[j][1], e[j][5], e[j][9], e[j][13], w1a, w1b);
        bf4_fwd(e[j][2], e[j][6], e[j][10], e[j][14], w2a, w2b);
        bf4_fwd(e[j][3], e[j][7], e[j][11], e[j][15], w3a, w3b);
#pragma unroll
        for (int q = 0; q < 4; ++q) bf4_fwd(e[j][4 * q], e[j][4 * q + 1], e[j][4 * q + 2], e[j][4 * q + 3], b4, b8);
#pragma unroll
        for (int k = 0; k < 16; ++k) buf[j * FFT_BS + PD(base + k * S)] = e[j][k];
    }
    __syncthreads();
    if constexpr (M / 16 >= 32) fft_fwd_pass<N, M / 16, NI>(buf, tid);
}
constexpr float c32q(int k) { return k == 0 ? 1.f : k == 1 ? 0.98078528040323043f : k == 2 ? 0.92387953251128674f : k == 3 ? 0.83146961230254524f : k == 4 ? 0.70710678118654752f : k == 5 ? 0.55557023301960218f : k == 6 ? 0.38268343236508977f : k == 7 ? 0.19509032201612825f : 0.f; }
constexpr float c32(int k) { return k <= 8 ? c32q(k) : -c32q(16 - k); }
constexpr float s32(int k) { return k <= 8 ? c32q(8 - k) : c32q(k - 8); }
DI void bf4_fwd_t(f32x2v& x0, f32x2v& x1, f32x2v& x2, f32x2v& x3) {
    const f32x2v a0 = x0 + x2, a2 = x0 - x2, a1 = x1 + x3, a3 = mul_mi(x1 - x3);
    x0 = a0 + a1; x1 = a0 - a1; x2 = a2 + a3; x3 = a2 - a3;
}
DI void bf4_fwd_b1(f32x2v& x0, f32x2v& x1, f32x2v& x2, f32x2v& x3) {
    constexpr float R2 = 0.70710678118654752f;
    const f32x2v a0 = x0 + x2, a2 = cmul(x0 - x2, mk2(R2, -R2)), a1 = x1 + x3, a3 = cmul(x1 - x3, mk2(-R2, -R2));
    x0 = a0 + a1; x1 = mul_mi(a0 - a1); x2 = a2 + a3; x3 = mul_mi(a2 - a3);
}
DI void bf4_inv_t(f32x2v& x0, f32x2v& x1, f32x2v& x2, f32x2v& x3) {
    const f32x2v a0 = x0 + x1, a1 = x0 - x1, a2 = x2 + x3, a3 = x2 - x3; const f32x2v t3b = mul_pi(a3);
    x0 = a0 + a2; x1 = a1 + t3b; x2 = a0 - a2; x3 = a1 - t3b;
}
DI void bf4_inv_b1(f32x2v& x0, f32x2v& x1, f32x2v& x2, f32x2v& x3) {
    constexpr float R2 = 0.70710678118654752f;
    const f32x2v t1 = mul_pi(x1), t3 = mul_pi(x3); const f32x2v a0 = x0 + t1, a1 = x0 - t1, a2 = x2 + t3, a3 = x2 - t3;
    const f32x2v t2 = cmul(a2, mk2(R2, R2)), t3b = cmul(a3, mk2(-R2, R2));
    x0 = a0 + t2; x1 = a1 + t3b; x2 = a0 - t2; x3 = a1 - t3b;
}
template <int NI> DI void fft_r32_fwd(LAS f32x2v* buf, int tid) {
    const int img = tid >> 8, g = tid & 255;
    if (img < NI) {
        LAS f32x4v* p = (LAS f32x4v*)(buf + img * FFT_BS + 34 * g);
        f32x2v r[32];
#pragma unroll
        for (int m = 0; m < 16; ++m) { const f32x4v v = p[m]; r[2 * m] = mk2(v.x, v.y); r[2 * m + 1] = mk2(v.z, v.w); }
        bf4_fwd_t(r[0], r[8], r[16], r[24]);
#pragma unroll
        for (int j = 1; j < 8; ++j) bf4_fwd(r[j], r[j + 8], r[j + 16], r[j + 24], mk2(c32(j), -s32(j)), mk2(c32(2 * j), -s32(2 * j)));
#pragma unroll
        for (int q = 0; q < 4; ++q) { bf4_fwd_t(r[8 * q], r[8 * q + 2], r[8 * q + 4], r[8 * q + 6]); bf4_fwd_b1(r[8 * q + 1], r[8 * q + 3], r[8 * q + 5], r[8 * q + 7]); }
#pragma unroll
        for (int m = 0; m < 16; ++m) { const f32x2v a = r[2 * m] + r[2 * m + 1], b = r[2 * m] - r[2 * m + 1]; p[m] = (f32x4v){a.x, a.y, b.x, b.y}; }
    }
    __syncthreads();
}
template <int NI> DI void fft_r32_inv(LAS f32x2v* buf, int tid) {
    const int img = tid >> 8, g = tid & 255;
    if (img < NI) {
        LAS f32x4v* p = (LAS f32x4v*)(buf + img * FFT_BS + 34 * g);
        f32x2v r[32];
#pragma unroll
        for (int m = 0; m < 16; ++m) { const f32x4v v = p[m]; r[2 * m] = mk2(v.x + v.z, v.y + v.w); r[2 * m + 1] = mk2(v.x - v.z, v.y - v.w); }
#pragma unroll
        for (int q = 0; q < 4; ++q) { bf4_inv_t(r[8 * q], r[8 * q + 2], r[8 * q + 4], r[8 * q + 6]); bf4_inv_b1(r[8 * q + 1], r[8 * q + 3], r[8 * q + 5], r[8 * q + 7]); }
        bf4_inv_t(r[0], r[8], r[16], r[24]);
#pragma unroll
        for (int j = 1; j < 8; ++j) bf4_inv(r[j], r[j + 8], r[j + 16], r[j + 24], mk2(c32(j), s32(j)), mk2(c32(2 * j), s32(2 * j)));
#pragma unroll
        for (int m = 0; m < 16; ++m) p[m] = (f32x4v){r[2 * m].x, r[2 * m].y, r[2 * m + 1].x, r[2 * m + 1].y};
    }
    __syncthreads();
}
template <int N, int NI = 1> DI void fft_fwd(LAS f32x2v* buf, int tid) {
    asm volatile("" : "+v"(tid));
    fft_fwd_pass<N, N / 2, NI>(buf, tid);
    fft_r32_fwd<NI>(buf, tid);
}
template <int N, int M, int NI = 1, bool REC = true> DI void fft_inv_pass(LAS f32x2v* buf, int tid) {
    const int tr = tid / (N / 16), u = tid % (N / 16), g = u / M, p = u % M; const int base = tr * N + g * 16 * M + p;
    f32x2v e[NI][16];
#pragma unroll
    for (int j = 0; j < NI; ++j)
#pragma unroll
        for (int k = 0; k < 16; ++k) e[j][k] = buf[j * FFT_BS + PD(base + k * M)];
    const f32x2v a1 = twid(p, 16 * M), a2 = cmul(a1, a1), a4 = cmul(a2, a2), a8 = cmul(a4, a4);
    constexpr float C1 = 0.92387953251128674f, S1 = 0.38268343236508977f, R2 = 0.70710678118654752f;
    const f32x2v v1a = cmul(a1, mk2(C1, S1)), v1b = cmul(a2, mk2(R2, R2)), v2a = cmul(a1, mk2(R2, R2)), v2b = mul_pi(a2), v3a = cmul(a1, mk2(S1, C1)), v3b = cmul(a2, mk2(-R2, R2));
#pragma unroll
    for (int j = 0; j < NI; ++j) {
#pragma unroll
        for (int q = 0; q < 4; ++q) bf4_inv(e[j][4 * q], e[j][4 * q + 1], e[j][4 * q + 2], e[j][4 * q + 3], a4, a8);
        bf4_inv(e[j][0], e[j][4], e[j][8], e[j][12], a1, a2);
        bf4_inv(e[j][1], e[j][5], e[j][9], e[j][13], v1a, v1b);
        bf4_inv(e[j][2], e[j][6], e[j][10], e[j][14], v2a, v2b);
        bf4_inv(e[j][3], e[j][7], e[j][11], e[j][15], v3a, v3b);
#pragma unroll
        for (int k = 0; k < 16; ++k) buf[j * FFT_BS + PD(base + k * M)] = e[j][k];
    }
    __syncthreads();
    if constexpr (REC && 16 * M < N) fft_inv_pass<N, 16 * M, NI>(buf, tid);
}
template <int N, int NI = 1> DI void fft_inv(LAS f32x2v* buf, int tid) {
    asm volatile("" : "+v"(tid));
    fft_r32_inv<NI>(buf, tid);
    fft_inv_pass<N, 32, NI>(buf, tid);
}
DI v2u ks_pack(float a, float b, float cc, float d) { v2u w; w.x = __builtin_bit_cast(unsigned, __builtin_amdgcn_cvt_pkrtz(a, b)); w.y = __builtin_bit_cast(unsigned, __builtin_amdgcn_cvt_pkrtz(cc, d)); return w; }
DI f32x4v ks_unpack(v2u w) { return (f32x4v){h2f((unsigned short)(w.x & 0xffffu)), h2f((unsigned short)(w.x >> 16)), h2f((unsigned short)(w.y & 0xffffu)), h2f((unsigned short)(w.y >> 16))}; }
template <int N> DI int ks_perm(int e) { if constexpr (N == 8192) return e < 4096 ? (((e & 63) << 6) | (e >> 6)) : e; else return e; }
template <int N, int NI> DI void fft_pairmul_pre(LAS f32x2v* buf, const v2u (&ksr)[8], const v2u* KS, int tid) {
    asm volatile("" : "+v"(tid));
    constexpr int LOG = (N == 8192) ? 13 : 9, NB = 8192 / N, NK = N / 2 + 1;
#pragma unroll
    for (int r = 0; r < 9; ++r) {
        const int idx = tid + 512 * r;
        if (r == 8 && idx >= NB * NK) break;
        v2u kw; if (r < 8) kw = ksr[r]; else kw = KS[idx]; const f32x4v ks = ks_unpack(kw);
        const int tr = idx / NK, k = ks_perm<N>(idx % NK);
        const int pk = PD(tr * N + (int)(__brev((unsigned)k) >> (32 - LOG))), pn = PD(tr * N + (int)(__brev((unsigned)((N - k) & (N - 1))) >> (32 - LOG)));
#pragma unroll
        for (int j = 0; j < NI; ++j) {
            const f32x2v zk = buf[j * FFT_BS + pk], zn = buf[j * FFT_BS + pn];
            constexpr float hn_ = 0.5f / (float)N; const f32x2v u1 = mk2(hn_ * (zk.x + zn.x), hn_ * (zk.y - zn.y)), u2 = mk2(hn_ * (zk.y + zn.y), -hn_ * (zk.x - zn.x));
            const f32x2v y1 = cmul(u1, mk2(ks.x, ks.y)), y2 = cmul(u2, mk2(ks.z, ks.w));
            buf[j * FFT_BS + pk] = mk2(y1.x - y2.y, y1.y + y2.x);
            if (pn != pk) buf[j * FFT_BS + pn] = mk2(y1.x + y2.y, -y1.y + y2.x);
        }
    }
}
template <int N, int NI> DI void fft_fwd_first(LAS f32x2v* buf, int tid, const float (&u0)[NI][8], const float (&u1)[NI][8]) {
    asm volatile("" : "+v"(tid));
    constexpr int M = N / 2, S = M / 8;
    const int tr = tid / (N / 16), p = tid % (N / 16); const int base = tr * N + p;
    const f32x2v bc = twid(p, 2 * M); const f32x2v b1 = mk2(bc.x, -bc.y), b2 = cmul(b1, b1), b4 = cmul(b2, b2), b8 = cmul(b4, b4);
    constexpr float C1 = 0.92387953251128674f, S1 = 0.38268343236508977f, R2 = 0.70710678118654752f;
    const f32x2v w1a = cmul(b1, mk2(C1, -S1)), w1b = cmul(b2, mk2(R2, -R2)), w2a = cmul(b1, mk2(R2, -R2)), w2b = mul_mi(b2), w3a = cmul(b1, mk2(S1, -C1)), w3b = cmul(b2, mk2(-R2, -R2));
    __syncthreads();
#pragma unroll
    for (int j = 0; j < NI; ++j) {
        f32x2v e[16];
#define FFT_HALF_FWD(i, w0, wm) { const f32x2v x0 = mk2(u0[j][i], u1[j][i]), x1 = mk2(u0[j][i + 4], u1[j][i + 4]); const f32x2v a2 = cmul(x0, w0), a3 = cmul(x1, mul_mi(w0)); \
            e[i] = x0 + x1; e[i + 4] = cmul(x0 - x1, wm); e[i + 8] = a2 + a3; e[i + 12] = cmul(a2 - a3, wm); }
        FFT_HALF_FWD(0, b1, b2) FFT_HALF_FWD(1, w1a, w1b) FFT_HALF_FWD(2, w2a, w2b) FFT_HALF_FWD(3, w3a, w3b)
#undef FFT_HALF_FWD
#pragma unroll
        for (int q = 0; q < 4; ++q) bf4_fwd(e[4 * q], e[4 * q + 1], e[4 * q + 2], e[4 * q + 3], b4, b8);
#pragma unroll
        for (int k = 0; k < 16; ++k) buf[j * FFT_BS + PD(base + k * S)] = e[k];
    }
    __syncthreads();
}
template <int N, int NI> DI void fft_inv_last(LAS f32x2v* buf, int tid, f32x2v (&out)[NI][8]) {
    asm volatile("" : "+v"(tid));
    constexpr int M = N / 16;
    const int tr = tid / (N / 16), p = tid % (N / 16); const int base = tr * N + p;
    const f32x2v a1 = twid(p, 16 * M), a2 = cmul(a1, a1), a4 = cmul(a2, a2), a8 = cmul(a4, a4);
    constexpr float C1 = 0.92387953251128674f, S1 = 0.38268343236508977f, R2 = 0.70710678118654752f;
    const f32x2v v1a = cmul(a1, mk2(C1, S1)), v1b = cmul(a2, mk2(R2, R2)), v2a = cmul(a1, mk2(R2, R2)), v2b = mul_pi(a2), v3a = cmul(a1, mk2(S1, C1)), v3b = cmul(a2, mk2(-R2, R2));
#pragma unroll
    for (int j = 0; j < NI; ++j) {
        f32x2v e[16];
#pragma unroll
        for (int k = 0; k < 16; ++k) e[k] = buf[j * FFT_BS + PD(base + k * M)];
#pragma unroll
        for (int q = 0; q < 4; ++q) bf4_inv(e[4 * q], e[4 * q + 1], e[4 * q + 2], e[4 * q + 3], a4, a8);
#define FFT_HALF_INV(i, wa, w) { const f32x2v t1 = cmul(e[i + 4], w), t3 = cmul(e[i + 12], w); const f32x2v a0 = e[i] + t1, a1_ = e[i] - t1, a2_ = e[i + 8] + t3, a3 = e[i + 8] - t3; \
            out[j][i] = a0 + cmul(a2_, wa); out[j][i + 4] = a1_ + cmul(a3, mul_pi(wa)); }
        FFT_HALF_INV(0, a1, a2) FFT_HALF_INV(1, v1a, v1b) FFT_HALF_INV(2, v2a, v2b) FFT_HALF_INV(3, v3a, v3b)
#undef FFT_HALF_INV
    }
}
template <int N, int NI = 1, bool SH = false> DI void fft_pairmul(LAS f32x2v* buf, const v2u* const (&KS)[NI]  , int tid) {
    asm volatile("" : "+v"(tid));
    constexpr int LOG = (N == 8192) ? 13 : 9, NB = 8192 / N, NK = N / 2 + 1;
    for (int idx = tid; idx < NB * NK; idx += 512) {
        const int tr = idx / NK, k = ks_perm<N>(idx % NK);
        const int pk = PD(tr * N + (int)(__brev((unsigned)k) >> (32 - LOG))), pn = PD(tr * N + (int)(__brev((unsigned)((N - k) & (N - 1))) >> (32 - LOG)));
        f32x4v ks0 = {0.f, 0.f, 0.f, 0.f}; if (SH) ks0 = ks_unpack(KS[0][idx]);
#pragma unroll
        for (int j = 0; j < NI; ++j) {
            const f32x2v zk = buf[j * FFT_BS + pk], zn = buf[j * FFT_BS + pn]; const f32x4v ks = SH ? ks0 : ks_unpack(KS[j][idx]);
            constexpr float hn_ = 0.5f / (float)N; const f32x2v u1 = mk2(hn_ * (zk.x + zn.x), hn_ * (zk.y - zn.y)), u2 = mk2(hn_ * (zk.y + zn.y), -hn_ * (zk.x - zn.x));
            const f32x2v y1 = cmul(u1, mk2(ks.x, ks.y)), y2 = cmul(u2, mk2(ks.z, ks.w));
            buf[j * FFT_BS + pk] = mk2(y1.x - y2.y, y1.y + y2.x);
            if (pn != pk) buf[j * FFT_BS + pn] = mk2(y1.x + y2.y, -y1.y + y2.x);
        }
    }
}
template <int T> DI void hyena_filter_item(Ctx& C, int o, int n, int pair0) {
    constexpr int N = 2 * T, NB = 4096 / T, LOG = (N == 8192) ? 13 : 9, NK = N / 2 + 1;
    const bf16* KT = (const bf16*)(C.ws + WS_SCAN); LAS f32x2v* buf = (LAS f32x2v*)C.lds; LAS float* red = (LAS float*)(C.lds + FFT_BUF_BYTES + 1024);
    int tid = C.tid; asm volatile("" : "+v"(tid)); const int toff = T == 256 ? 0 : 256;
    const float dmin = 4.605170185988092f / 1.5f, dmax = 4.605170185988092f / 0.3f;
    __syncthreads();
    if (tid < 2 * NB) red[tid] = 0.f;
    __syncthreads();
    float k0[16], k1[16];
#pragma unroll
    for (int i = 0; i < 16; ++i) { const int idx = tid + 512 * i, tr = idx / N, pos = idx % N; const int c = 2 * (pair0 + tr);
        float a = 0.f, b = 0.f;
        if (pos != T) { const int side = pos > T ? 1 : 0, tt = pos > T ? N - pos : pos; const float tn = (float)tt / (float)(T - 1);
            const bf16* kr = KT + ((size_t)o * 8192 + (n * 2 + side) * 2048 + c) * 4352 + toff + tt;
            const float d0 = dmin + (dmax - dmin) * ((float)c / 2047.0f), d1 = dmin + (dmax - dmin) * ((float)(c + 1) / 2047.0f);
            a = bf2f(kr[0]) * expf(-tn * d0); b = bf2f(kr[4352]) * expf(-tn * d1); }
        k0[i] = a; k1[i] = b;
        const float sa = wave_sum(fabsf(a)), sb = wave_sum(fabsf(b));
        if (C.lane == 0) { __hip_atomic_fetch_add(&red[2 * tr], sa, __ATOMIC_RELAXED, __HIP_MEMORY_SCOPE_WORKGROUP); __hip_atomic_fetch_add(&red[2 * tr + 1], sb, __ATOMIC_RELAXED, __HIP_MEMORY_SCOPE_WORKGROUP); } }
    __syncthreads();
    int tl = tid; asm volatile("" : "+v"(tl));
#pragma unroll
    for (int i = 0; i < 16; ++i) { const int idx = tl + 512 * i, tr = idx / N; f32x2v kv = mk2(k0[i] / red[2 * tr], k1[i] / red[2 * tr + 1]);
        if (idx % N == 0) { const float* hb = C.in[I_HB] + (size_t)(o * 2 + n) * 2048 + 2 * (pair0 + tr); kv.x += hb[0]; kv.y += hb[1]; }
        buf[PD(idx)] = kv; }
    __syncthreads();
    fft_fwd<N>(buf, tid);
    v2u* KS = (v2u*)(C.ws + (T == 256 ? WS_KSP : WS_KSS)) + ((size_t)(o * 2 + n) * 1024 + pair0) * NK;
    for (int idx = tid; idx < NB * NK; idx += 512) { const int tr = idx / NK, k = ks_perm<N>(idx % NK);
        const int pk = tr * N + (int)(__brev((unsigned)k) >> (32 - LOG)), pn = tr * N + (int)(__brev((unsigned)((N - k) & (N - 1))) >> (32 - LOG));
        const f32x2v zk = buf[PD(pk)], zn = buf[PD(pn)];
        KS[idx] = ks_pack(0.5f * (zk.x + zn.x), 0.5f * (zk.y - zn.y), 0.5f * (zk.y + zn.y), -0.5f * (zk.x - zn.x)); }
}
DI void phase_hyena_filters(Ctx& C) {
    for (int it = C.vb; it < 4 * 1024 + 4 * 64; it += C.G) {
        if (it < 4096) hyena_filter_item<4096>(C, it >> 11, (it >> 10) & 1, it & 1023);
        else { const int v = it - 4096; hyena_filter_item<256>(C, v >> 7, (v >> 6) & 1, (v & 63) * 16); }
    }
    __syncthreads();
}
template <int T, int NI, int PROBE = 0, bool SH = false> DI void hyena_conv_item(Ctx& C, int o, const int (&seq)[NI], const int (&pair0)[NI]) {
    constexpr int N = 2 * T, NB = 4096 / T, NK = N / 2 + 1;
    LAS f32x2v* buf = (LAS f32x2v*)C.lds; const int tid = C.tid;
    const float* cw = C.in[I_CW] + (size_t)o * 3 * 6144; const float* cb = C.in[I_CB] + (size_t)o * 6144;
    bf16* Y = (bf16*)(C.ws + WS_MIX);
    const float* ZT[NI]; const v2u* KS0[NI]; const v2u* KS1[NI]; int rowbase[NI];
#pragma unroll
    for (int j = 0; j < NI; ++j) { ZT[j] = (const float*)(C.ws + WS_Z + (T == 256 ? 0 : ZT_S_OFF)) + (size_t)seq[j] * 6144 * T;
        KS0[j] = (const v2u*)(C.ws + (T == 256 ? WS_KSP : WS_KSS)) + ((size_t)(o * 2 + 0) * 1024 + pair0[j]) * NK; KS1[j] = KS0[j] + (size_t)1024 * NK;
        rowbase[j] = T == 256 ? seq[j] * 256 : MP + seq[j] * 4096; }
    constexpr int NQ = SH ? 1 : NI;
    float wq[NQ][6][4];
    if constexpr (T == 4096) {
        auto sg = [](float v) { return __builtin_bit_cast(float, __builtin_amdgcn_readfirstlane(__builtin_bit_cast(int, v))); };
#pragma unroll
        for (int j = 0; j < NQ; ++j) {
#pragma unroll
            for (int gq = 0; gq < 6; ++gq) { const int ch = (gq >> 1) * 2048 + 2 * pair0[j] + (gq & 1); wq[j][gq][0] = sg(cw[ch]); wq[j][gq][1] = sg(cw[6144 + ch]); wq[j][gq][2] = sg(cw[2 * 6144 + ch]); wq[j][gq][3] = sg(cb[ch]); }
        }
    }
    auto ld3 = [&](int j, int grp, int jj, int c, int t, float (&z)[3]) __attribute__((always_inline)) { const int ch = grp * 2048 + c + jj; const float* zr = ZT[j] + (size_t)ch * T + t; z[0] = zr[-1]; z[1] = zr[0]; z[2] = zr[1]; };
    auto ap3 = [&](int j, int grp, int jj, int c, int t, const float (&z)[3]) __attribute__((always_inline)) { const int ch = grp * 2048 + c + jj; const float zp = t > 0 ? z[0] : 0.f, zn = t < T - 1 ? z[2] : 0.f;
        if constexpr (T == 4096) { const int jq = SH ? 0 : j; return wq[jq][grp * 2 + jj][0] * zp + wq[jq][grp * 2 + jj][1] * z[1] + wq[jq][grp * 2 + jj][2] * zn + wq[jq][grp * 2 + jj][3]; }
        else return cw[ch] * zp + cw[6144 + ch] * z[1] + cw[2 * 6144 + ch] * zn + cb[ch]; };
    float gz[NI][8][2][3]; constexpr int NPRE = (T == 4096) ? NI : 1;
    float u0[NI][8], u1[NI][8]; f32x2v cv[NI][8];
    int tl = tid; asm volatile("" : "+v"(tl));
#pragma unroll
    for (int j = 0; j < NI; ++j)
#pragma unroll
        for (int i = 0; i < 8; ++i) { const int tr = tl / (N / 16), t = tl % (N / 16) + (N / 16) * i, c = 2 * (pair0[j] + tr);
            float z0[3], z1[3]; ld3(j, 2, 0, c, t, z0); ld3(j, 2, 1, c, t, z1); u0[j][i] = ap3(j, 2, 0, c, t, z0); u1[j][i] = ap3(j, 2, 1, c, t, z1); }
    v2u ksr[8];
    if constexpr (SH) {
#pragma unroll
        for (int r = 0; r < 8; ++r) ksr[r] = KS0[0][tl + 512 * r]; }
    fft_fwd_first<N, NI>(buf, tid, u0, u1);
    if constexpr (N == 8192) { int tf = tid; asm volatile("" : "+v"(tf)); fft_fwd_pass<N, 256, NI>(buf, tf); }
    { int tf = tid; asm volatile("" : "+v"(tf)); fft_r32_fwd<NI>(buf, tf); }
    if constexpr (SH) fft_pairmul_pre<N, NI>(buf, ksr, KS0[0], tid); else fft_pairmul<N, NI, SH>(buf, KS0, tid);
    __syncthreads();
    { int tf = tid; asm volatile("" : "+v"(tf)); fft_r32_inv<NI>(buf, tf); }
    if constexpr (N == 8192) { int tf = tid; asm volatile("" : "+v"(tf)); fft_inv_pass<N, 32, NI, false>(buf, tf); }
    tl = tid; asm volatile("" : "+v"(tl));
#pragma unroll
    for (int j = 0; j < NPRE; ++j)
#pragma unroll
        for (int i = 0; i < 8; ++i) { const int tr = tl / (N / 16), t = tl % (N / 16) + (N / 16) * i, c = 2 * (pair0[j] + tr); ld3(j, 0, 0, c, t, gz[j][i][0]); ld3(j, 0, 1, c, t, gz[j][i][1]); }
    fft_inv_last<N, NI>(buf, tid, cv);
#pragma unroll
    for (int j = NPRE; j < NI; ++j)
#pragma unroll
        for (int i = 0; i < 8; ++i) { const int tr = tl / (N / 16), t = tl % (N / 16) + (N / 16) * i, c = 2 * (pair0[j] + tr); ld3(j, 0, 0, c, t, gz[j][i][0]); ld3(j, 0, 1, c, t, gz[j][i][1]); }
#pragma unroll
    for (int j = 0; j < NI; ++j)
#pragma unroll
        for (int i = 0; i < 8; ++i) { const int tr = tl / (N / 16), t = tl % (N / 16) + (N / 16) * i, c = 2 * (pair0[j] + tr);
            u0[j][i] = ap3(j, 0, 0, c, t, gz[j][i][0]) * cv[j][i].x; u1[j][i] = ap3(j, 0, 1, c, t, gz[j][i][1]) * cv[j][i].y; }
    if constexpr (SH) {
#pragma unroll
        for (int r = 0; r < 8; ++r) ksr[r] = KS1[0][tl + 512 * r]; }
    fft_fwd_first<N, NI>(buf, tid, u0, u1);
    if constexpr (N == 8192) { int tf = tid; asm volatile("" : "+v"(tf)); fft_fwd_pass<N, 256, NI>(buf, tf); }
    { int tf = tid; asm volatile("" : "+v"(tf)); fft_r32_fwd<NI>(buf, tf); }
    if constexpr (SH) fft_pairmul_pre<N, NI>(buf, ksr, KS1[0], tid); else fft_pairmul<N, NI, SH>(buf, KS1, tid);
    __syncthreads();
    { int tf = tid; asm volatile("" : "+v"(tf)); fft_r32_inv<NI>(buf, tf); }
    if constexpr (N == 8192) { int tf = tid; asm volatile("" : "+v"(tf)); fft_inv_pass<N, 32, NI, false>(buf, tf); }
    tl = tid; asm volatile("" : "+v"(tl));
#pragma unroll
    for (int j = 0; j < NPRE; ++j)
#pragma unroll
        for (int i = 0; i < 8; ++i) { const int tr = tl / (N / 16), t = tl % (N / 16) + (N / 16) * i, c = 2 * (pair0[j] + tr); ld3(j, 1, 0, c, t, gz[j][i][0]); ld3(j, 1, 1, c, t, gz[j][i][1]); }
    fft_inv_last<N, NI>(buf, tid, cv);
#pragma unroll
    for (int j = NPRE; j < NI; ++j)
#pragma unroll
        for (int i = 0; i < 8; ++i) { const int tr = tl / (N / 16), t = tl % (N / 16) + (N / 16) * i, c = 2 * (pair0[j] + tr); ld3(j, 1, 0, c, t, gz[j][i][0]); ld3(j, 1, 1, c, t, gz[j][i][1]); }
#pragma unroll
    for (int j = 0; j < NI; ++j)
#pragma unroll
        for (int i = 0; i < 8; ++i) { const int tr = tl / (N / 16), t = tl % (N / 16) + (N / 16) * i, c = 2 * (pair0[j] + tr);
            const float y0 = ap3(j, 1, 0, c, t, gz[j][i][0]) * cv[j][i].x, y1 = ap3(j, 1, 1, c, t, gz[j][i][1]) * cv[j][i].y;
            *(unsigned*)(Y + (size_t)(rowbase[j] + t) * 2048 + c) = pk2(y0, y1); }
}
template <int PROBE = 0> DI void phase_hyena_conv(Ctx& C, int o) {
    if (C.G == 256) {
        for (int it = C.vb; it < 1024 + 512; it += C.G) {
            if (it < 1024) { const int sq[2] = {0, 1}, pr[2] = {it, it}; hyena_conv_item<4096, 2, PROBE, true>(C, o, sq, pr); }
            else { const int v = it - 1024; const int sq[2] = {2 * (v >> 6), 2 * (v >> 6) + 1}, pr[2] = {(v & 63) * 16, (v & 63) * 16}; hyena_conv_item<256, 2, PROBE, true>(C, o, sq, pr); }
        }
    } else {
        for (int it = C.vb; it < 2048 + 1024; it += C.G) {
            if (it < 2048) { const int sq[1] = {it >> 10}, pr[1] = {it & 1023}; hyena_conv_item<4096, 1, PROBE>(C, o, sq, pr); }
            else { const int v = it - 2048; const int sq[1] = {v >> 6}, pr[1] = {(v & 63) * 16}; hyena_conv_item<256, 1, PROBE>(C, o, sq, pr); }
        }
    }
    __syncthreads();
}

#ifndef ONE_LAUNCH
#define ONE_LAUNCH 1
#endif
#ifndef SKIP_FFN
#define SKIP_FFN 0
#endif
#ifndef SKIP_EVEN
#define SKIP_EVEN 0
#endif
#ifndef SKIP_ODD
#define SKIP_ODD 0
#endif
#ifndef DUP_FFN
#define DUP_FFN 0
#endif
#ifndef DUP_EVEN
#define DUP_EVEN 0
#endif
#ifndef DUP_ODD
#define DUP_ODD 0
#endif
#ifndef DUP_PRO
#define DUP_PRO 0
#endif
#ifndef DUP_E
#define DUP_E 0
#endif
#ifndef DUP_O
#define DUP_O 0
#endif
constexpr int NPH_MAX = 96;
template <int V> struct IntC { static constexpr int value = V; };
DI void launder(Ctx& C, const KArgs& a) { const int t = lane_id_v(); C.lane = t; C.tid = C.wave * 64 + t;
    int z = 0; asm volatile("" : "+v"(z)); const int zs = __builtin_amdgcn_readfirstlane(z);
    C.ws = a.ws + zs; C.in = a.in + zs; C.out = a.out + zs;
    C.zs = zs; C.G = (int)gridDim.x + zs; C.bx = (int)blockIdx.x + zs; C.gw = C.bx * 8 + C.wave; C.NGW = C.G * 8; C.vb = (C.G % 8 == 0) ? (C.bx % 8) * (C.G / 8) + C.bx / 8 : C.bx; }
__global__ void __launch_bounds__(512, 2) mega_fwd(KArgs args) {
    extern __shared__ __attribute__((aligned(16))) unsigned char lds_raw[];
    Ctx C;
    C.lds = (LAS unsigned char*)lds_raw; C.ws = args.ws; C.in = args.in; C.out = args.out;
    C.wave = __builtin_amdgcn_readfirstlane((int)threadIdx.x >> 6); C.lane = lane_id_v(); C.tid = C.wave * 64 + C.lane;
    C.zs = 0; C.G = 0; C.bx = 0; C.gw = 0; C.NGW = 0; C.vb = 0;
    for (int u = C.tid; u < (LDS_BYTES - LDS_CTL) / 4; u += 512) ((LAS unsigned*)(C.lds + LDS_CTL))[u] = 0u;
    __syncthreads();
    (void)xcd_barrier_post((unsigned*)(args.ws + WS_CTL) + 4096, (volatile LAS unsigned*)(C.lds + LDS_CTL + 64), C.tid);
#if ONE_LAUNCH
    constexpr int lo = 0, hi = 1 << 20; int ph = 0;
#else
    const int lo = args.ph_lo, hi = args.ph_hi; int ph = 0;
#endif
#define PH_IF if (ph >= lo && ph < hi) if (launder(C, args), true)
#define PH_NEXT do { const bool both_ = (ph >= lo) && (ph + 1 < hi); ++ph; if (both_) { launder(C, args); XcdBarrier b_; b_.bar = (unsigned*)(C.ws + WS_CTL) + 4096; b_.x = xb_xcc_id() + (unsigned)C.zs; b_.st = (volatile LAS unsigned*)(C.lds + LDS_CTL + 64); xcd_barrier(b_, C.tid); } } while (0)
#define ring C.lds
#define MOD ((const float*)(C.ws + WS_MOD))
#define X ((unsigned short*)(C.ws + WS_X))

#if DUP_PRO == 1
    PH_IF { phase_prologue(C); } PH_NEXT;
#endif
    PH_IF {
#ifndef NO_PROLOGUE
 phase_prologue(C);
#endif
 } PH_NEXT;
    PH_IF { phase_mod_reduce(C);
        pg8::Gemm g{(const bf16*)(C.ws + WS_W3T), (const bf16*)(C.ws + WS_H2), 16384, 4352, 256}; pg8::StaticOrder S; S.init(16384, 4352, C.G, C.bx);
        pg8::EpiBf16Plain E{(bf16*)(C.ws + WS_SCAN), 4352};
        pg8::gemm_phase<pg8::EpiBf16Plain, pg8::StaticOrder, false, false>(ring, g, S, E, C.wave); } PH_NEXT;
#if DUP_PRO == 2
    PH_IF { phase_hyena_filters(C); } PH_NEXT;
#endif
    PH_IF {
#ifndef NO_HYENA
 phase_hyena_filters(C);
#endif
 } PH_NEXT;

#define FFN_BLOCK(l, fi, s, cf) do { \
    if (!SKIP_FFN) { \
    PH_IF { phase_norm_mod(C, C.in[I_NG] + ((l) * 3 + (s)) * 2048, MOD + (size_t)(l) * MODL, (s)); } PH_NEXT; \
    PH_IF { pg8::Gemm g{(const bf16*)(C.ws + WS_H), (const bf16*)(C.ws + WS_W1T) + (size_t)((l) * 2 + (fi)) * NFF1 * 2048, MT, NFF1, 2048}; pg8::StaticOrder S; S.init(MT, NFF1, C.G, C.bx); \
        pg8::EpiSwiGLU E{(bf16*)(C.ws + WS_ACT), DFF}; pg8::gemm_phase<pg8::EpiSwiGLU, pg8::StaticOrder, false, true>(ring, g, S, E, C.wave); \
        { const int nf_ = (l) * 2 + (fi) + 1, idle0_ = (MT / 256) * (NFF1 / 256) % C.G; if ((cf) != 0.0f && nf_ < 8 && C.bx >= idle0_) { launder(C, args); \
            tr_matrix<0>(C, C.in[I_WFO] + (size_t)nf_ * DFF * 2048, 2048, DFF, (bf16*)(C.ws + WS_W2T) + (size_t)nf_ * 2048 * DFF, 2048, 2048, (C.bx - idle0_) * 8 + C.wave, (C.G - idle0_) * 8); } } } PH_NEXT; \
    PH_IF { pg8::Gemm g{(const bf16*)(C.ws + WS_ACT), (const bf16*)(C.ws + WS_W2T) + (size_t)((l) * 2 + (fi)) * 2048 * DFF, MT, 2048, DFF}; \
        pg8::EpiRes E{X, MOD + (size_t)(l) * MODL + (3 * (s) + 2) * 2048, (cf)}; \
        { pg8::PairOrder<1> S; S.init(MT, 2048, DFF, C.G, C.bx, (float*)(C.ws + WS_Z), (unsigned*)(C.ws + WS_CTL) + 16384, (DUP_FFN ? 8u * (unsigned)(2 * ((l) * 2 + (fi)) + ((cf) != 0.0f ? 2 : 1)) : 8u * (unsigned)((l) * 2 + (fi) + 1))); \
          pg8::gemm_phase<pg8::EpiRes, pg8::PairOrder<1>, false, true>(ring, g, S, E, C.wave); } \
        { launder(C, args); pg8::PairOrder<2> S; S.init(MT, 2048, DFF, C.G, C.bx, (float*)(C.ws + WS_Z), (unsigned*)(C.ws + WS_CTL) + 16384, (DUP_FFN ? 8u * (unsigned)(2 * ((l) * 2 + (fi)) + ((cf) != 0.0f ? 2 : 1)) : 8u * (unsigned)((l) * 2 + (fi) + 1))); \
          pg8::Gemm g2{(const bf16*)(C.ws + WS_ACT), (const bf16*)(C.ws + WS_W2T) + (size_t)((l) * 2 + (fi)) * 2048 * DFF, MT, 2048, DFF}; pg8::EpiRes E2{X, MOD + (size_t)(l) * MODL + (3 * (s) + 2) * 2048, (cf)}; \
          pg8::gemm_phase<pg8::EpiRes, pg8::PairOrder<2>, true, true>(ring, g2, S, E2, C.wave); } \
        { const int nf_ = (l) * 2 + (fi) + 1; if ((cf) != 0.0f && nf_ < 8 && !(C.G >= 235 && !SKIP_EVEN && ((l) & 1) == 0 && (fi) == 0) && !(C.G == 256 && !SKIP_EVEN && ((l) & 1) == 0 && (fi) == 1)) { launder(C, args); \
            tr_matrix<1>(C, C.in[I_WFI] + (size_t)nf_ * 2048 * NFF1, NFF1, 2048, (bf16*)(C.ws + WS_W1T) + (size_t)nf_ * NFF1 * 2048, NFF1, NFF1, C.gw, C.NGW); } } } PH_NEXT; \
    } } while (0)

    auto layer_pair = [&](auto PC) __attribute__((always_inline)) {
        constexpr int p = decltype(PC)::value; constexpr int le = 2 * p, lod = 2 * p + 1;
#if DUP_FFN
        FFN_BLOCK(le, 0, 0, 0.0f);
#endif
        FFN_BLOCK(le, 0, 0, 0.5f);
        auto even_mix = [&](float cf, int qslot) __attribute__((always_inline)) {
            const int e = p;
            PH_IF { phase_norm_mod(C, C.in[I_NG] + (le * 3 + 1) * 2048, MOD + (size_t)le * MODL, 1); } PH_NEXT;
            PH_IF { pg8::Gemm g{(const bf16*)(C.ws + WS_H), (const bf16*)(C.ws + WS_WINE) + (size_t)e * ZE_P * 2048, MT, ZE_P, 2048}; pg8::StaticOrder S; S.init(MT, ZE_P, C.G, C.bx);
                pg8::EpiF32 E{(float*)(C.ws + WS_Z), ZE_P}; pg8::gemm_phase<pg8::EpiF32, pg8::StaticOrder, true, true>(ring, g, S, E, C.wave);
                { const int nf_ = le * 2 + 2, idle0_ = (MT / 256) * (ZE_P / 256) % C.G;
                  if (cf != 0.0f && C.G == 256 && C.bx >= idle0_) { launder(C, args);
                    tr_matrix<1>(C, C.in[I_WFI] + (size_t)nf_ * 2048 * NFF1, NFF1, 2048, (bf16*)(C.ws + WS_W1T) + (size_t)nf_ * NFF1 * 2048, NFF1, NFF1, (C.bx - idle0_) * 8 + C.wave, (C.G - idle0_) * 8); } } } PH_NEXT;
#if DUP_E == 5
            PH_IF { phase_even_prep(C, e); } PH_NEXT;
#endif
            PH_IF { phase_even_prep(C, e); } PH_NEXT;
#if DUP_E == 7
            PH_IF {
                { pg8::Gemm g{(const bf16*)(C.ws + WS_LA), (const bf16*)(C.ws + WS_WLORA) + (size_t)e * 5120 * 384, MT, 5120, 384}; pg8::StaticOrder S; S.init(MT, 5120, C.G, C.bx);
                  pg8::EpiLora E{C.ws, C.in[I_W0] + e * 2048, C.in[I_A0] + e * 2048, C.in[I_KA] + e * 1024, WS_SCAN + (size_t)e * SCAN_BYTES, WS_KBUF, WS_GB};
                  pg8::gemm_phase<pg8::EpiLora, pg8::StaticOrder, true, true>(ring, g, S, E, C.wave); }
                launder(C, args);
                { pg8::Gemm g{(const bf16*)(C.ws + WS_CQ), (const bf16*)(C.ws + WS_WQ) + (size_t)e * 1536 * 512, MT, 1536, 512}; pg8::StaticOrder S; S.init(MT, 1536, C.G, C.bx);
                  pg8::EpiQ E{(bf16*)(C.ws + WS_Q), (const float*)(C.ws + WS_ROPE), 0.07216878364870322f * 1.4426950408889634f};
                  pg8::gemm_phase<pg8::EpiQ, pg8::StaticOrder, true, true>(ring, g, S, E, C.wave); }
                launder(C, args);
                { pg8::Gemm g{(const bf16*)(C.ws + WS_CKV), (const bf16*)(C.ws + WS_WKN) + (size_t)e * 1024 * 256, MKV, 1024, 256}; pg8::StaticOrder S; S.init(MKV, 1024, C.G, C.bx);
                  pg8::EpiBf16Plain E{(bf16*)(C.ws + WS_KN), 1024};
                  pg8::gemm_phase<pg8::EpiBf16Plain, pg8::StaticOrder, false, false>(ring, g, S, E, C.wave); }
                launder(C, args);
                { pg8::Gemm g{(const bf16*)(C.ws + WS_WV) + (size_t)e * 1024 * 256, (const bf16*)(C.ws + WS_CKV), 1024, MKV, 256}; pg8::StaticOrder S; S.init(1024, MKV, C.G, C.bx);
                  pg8::EpiVT E{(bf16*)(C.ws + WS_VT), VT_S_OFF / 2};
                  pg8::gemm_phase<pg8::EpiVT, pg8::StaticOrder, false, false>(ring, g, S, E, C.wave); }
            } PH_NEXT;
#endif
            PH_IF {
                { pg8::Gemm g{(const bf16*)(C.ws + WS_LA), (const bf16*)(C.ws + WS_WLORA) + (size_t)e * 5120 * 384, MT, 5120, 384}; pg8::StaticOrder S; S.init(MT, 5120, C.G, C.bx);
                  pg8::EpiLora E{C.ws, C.in[I_W0] + e * 2048, C.in[I_A0] + e * 2048, C.in[I_KA] + e * 1024, WS_SCAN + (size_t)e * SCAN_BYTES, WS_KBUF, WS_GB};
                  pg8::gemm_phase<pg8::EpiLora, pg8::StaticOrder, true, true>(ring, g, S, E, C.wave); }
                launder(C, args);
                { pg8::Gemm g{(const bf16*)(C.ws + WS_CQ), (const bf16*)(C.ws + WS_WQ) + (size_t)e * 1536 * 512, MT, 1536, 512}; pg8::StaticOrder S; S.init(MT, 1536, C.G, (C.bx + 64) % C.G);
                  pg8::EpiQ E{(bf16*)(C.ws + WS_Q), (const float*)(C.ws + WS_ROPE), 0.07216878364870322f * 1.4426950408889634f};
                  pg8::gemm_phase<pg8::EpiQ, pg8::StaticOrder, true, true>(ring, g, S, E, C.wave); }
                launder(C, args);
                { pg8::Gemm g{(const bf16*)(C.ws + WS_CKV), (const bf16*)(C.ws + WS_WKN) + (size_t)e * 1024 * 256, MKV, 1024, 256}; pg8::StaticOrder S; S.init(MKV, 1024, C.G, (C.bx + 32) % C.G);
                  pg8::EpiBf16Plain E{(bf16*)(C.ws + WS_KN), 1024};
                  pg8::gemm_phase<pg8::EpiBf16Plain, pg8::StaticOrder, false, false>(ring, g, S, E, C.wave); }
                launder(C, args);
                { pg8::Gemm g{(const bf16*)(C.ws + WS_WV) + (size_t)e * 1024 * 256, (const bf16*)(C.ws + WS_CKV), 1024, MKV, 256}; pg8::StaticOrder S; S.init(1024, MKV, C.G, (C.bx + 88) % C.G);
                  pg8::EpiVT E{(bf16*)(C.ws + WS_VT), VT_S_OFF / 2};
                  pg8::gemm_phase<pg8::EpiVT, pg8::StaticOrder, false, false>(ring, g, S, E, C.wave); }
            } PH_NEXT;
#if DUP_E == 1
            PH_IF { phase_scan1(C, e, 2); } PH_NEXT;
#endif
            PH_IF {
#ifndef NO_SCAN
 phase_scan1(C, e, qslot);
#endif
 } PH_NEXT;
#if DUP_E == 2
            PH_IF { phase_scan_carry(C, e, 8); __syncthreads(); } PH_NEXT;
#endif
            PH_IF { const bool host_ = cf != 0.0f && C.G >= 235; phase_scan_carry(C, e, host_ ? 3 : 8);
                if (host_ && C.bx >= 64 && C.wave >= 3) { launder(C, args); const int nf_ = le * 2 + 1;
                    tr_matrix<1>(C, C.in[I_WFI] + (size_t)nf_ * 2048 * NFF1, NFF1, 2048, (bf16*)(C.ws + WS_W1T) + (size_t)nf_ * NFF1 * 2048, NFF1, NFF1, (C.bx - 64) * 5 + C.wave - 3, (C.G - 64) * 5); }
                __syncthreads(); } PH_NEXT;
#if DUP_E == 3
            PH_IF { phase_scan3(C, e); } PH_NEXT;
#endif
#if DUP_E == 4
            PH_IF { phase_attention(C); } PH_NEXT;
#endif
            PH_IF {
#ifndef NO_SCAN
 phase_scan3(C, e);
#endif
#ifndef NO_ATTN
 phase_attention(C);
#endif
 } PH_NEXT;
#if DUP_E == 6
            PH_IF { phase_rwkv_post(C, e); } PH_NEXT;
#endif
            PH_IF { phase_rwkv_post(C, e); } PH_NEXT;
            PH_IF { pg8::Gemm g{(const bf16*)(C.ws + WS_MIX), (const bf16*)(C.ws + WS_WOUTE) + (size_t)e * 2048 * 2048, MT, 2048, 2048}; pg8::StaticOrder S; S.init(MT, 2048, C.G, C.bx);
                pg8::EpiRes E{X, MOD + (size_t)le * MODL + (3 * 1 + 2) * 2048, cf}; pg8::gemm_phase<pg8::EpiRes, pg8::StaticOrder, false, true>(ring, g, S, E, C.wave); } PH_NEXT;
        };
#if DUP_EVEN
        even_mix(0.0f, 1);
#endif
        if (!SKIP_EVEN) even_mix(1.0f, 0);
#if DUP_FFN
        FFN_BLOCK(le, 1, 2, 0.0f);
#endif
        FFN_BLOCK(le, 1, 2, 0.5f);
#if DUP_FFN
        FFN_BLOCK(lod, 0, 0, 0.0f);
#endif
        FFN_BLOCK(lod, 0, 0, 0.5f);
        auto odd_mix = [&](float cf) __attribute__((always_inline)) {
            const int o = p;
            PH_IF { phase_norm_mod(C, C.in[I_NG] + (lod * 3 + 1) * 2048, MOD + (size_t)lod * MODL, 1); } PH_NEXT;
            PH_IF { pg8::Gemm g{(const bf16*)(C.ws + WS_WINO) + (size_t)o * 6144 * 2048, (const bf16*)(C.ws + WS_H), 6144, MT, 2048}; pg8::StaticOrder S; S.init(6144, MT, C.G, C.bx);
                pg8::EpiZT E{(float*)(C.ws + WS_Z), (float*)(C.ws + WS_Z + ZT_S_OFF)}; pg8::gemm_phase<pg8::EpiZT, pg8::StaticOrder, false, true>(ring, g, S, E, C.wave); } PH_NEXT;
#if DUP_O == 1
            PH_IF { phase_hyena_conv(C, o); } PH_NEXT;
#endif
#if DUP_O == 2
            PH_IF { phase_hyena_conv<1>(C, o); } PH_NEXT;
#endif
            PH_IF {
#ifndef NO_HYENA
 phase_hyena_conv(C, o);
#endif
 } PH_NEXT;
            PH_IF { pg8::Gemm g{(const bf16*)(C.ws + WS_MIX), (const bf16*)(C.ws + WS_WOUTO) + (size_t)o * 2048 * 2048, MT, 2048, 2048}; pg8::StaticOrder S; S.init(MT, 2048, C.G, C.bx);
                pg8::EpiRes E{X, MOD + (size_t)lod * MODL + (3 * 1 + 2) * 2048, cf}; pg8::gemm_phase<pg8::EpiRes, pg8::StaticOrder, false, true>(ring, g, S, E, C.wave); } PH_NEXT;
        };
#if DUP_ODD
        odd_mix(0.0f);
#endif
        if (!SKIP_ODD) odd_mix(1.0f);
#if DUP_FFN
        FFN_BLOCK(lod, 1, 2, 0.0f);
#endif
        FFN_BLOCK(lod, 1, 2, 0.5f);
    };
    layer_pair(IntC<0>{}); layer_pair(IntC<1>{});
    PH_IF { phase_final_norm(C); } PH_NEXT;
#undef MOD
#undef X
#undef ring
}

extern "C" void kernel_launch(void* const* d_in, const int* in_sizes, int n_in, void* d_out, int out_size, void* d_ws, size_t ws_size, hipStream_t stream) {
    static int grid = 0;
    if (grid == 0) {
        if (n_in != 42 || (size_t)out_size != OUT_END || ws_size < WS_END) { fprintf(stderr, "kernel_launch: unexpected sizes n_in %d out %d ws %zu (need %zu)\n", n_in, out_size, ws_size, (size_t)WS_END); grid = -1; return; }
        int dev = 0, cus = 0, per_cu = 0;
        if (hipGetDevice(&dev) != hipSuccess || hipDeviceGetAttribute(&cus, hipDeviceAttributeMultiprocessorCount, dev) != hipSuccess) { grid = -1; return; }
        if (hipFuncSetAttribute((const void*)mega_fwd, hipFuncAttributeMaxDynamicSharedMemorySize, LDS_BYTES) != hipSuccess) { fprintf(stderr, "kernel_launch: hipFuncSetAttribute failed\n"); grid = -1; return; }
        if (hipOccupancyMaxActiveBlocksPerMultiprocessor(&per_cu, (const void*)mega_fwd, 512, LDS_BYTES) != hipSuccess || per_cu < 1) fprintf(stderr, "kernel_launch: occupancy query says %d\n", per_cu);
        (void)hipGetLastError();
        grid = cus;
    }
    if (grid < 0) return;
    (void)hipMemsetAsync((char*)d_ws + WS_CTL, 0, CTL_ZERO_BYTES, stream);
    KArgs a{};
    for (int i = 0; i < 42; ++i) a.in[i] = (const float*)d_in[i];
    a.out = (float*)d_out; a.ws = (unsigned char*)d_ws;
#if ONE_LAUNCH
    a.ph_lo = 0; a.ph_hi = 1 << 20;
    hipLaunchKernelGGL(mega_fwd, dim3(grid), dim3(512), LDS_BYTES, stream, a);
#else
    for (int i = 0; i < NPH_MAX; ++i) { a.ph_lo = i; a.ph_hi = i + 1; hipLaunchKernelGGL(mega_fwd, dim3(grid), dim3(512), LDS_BYTES, stream, a); }
#endif
}
```

```cpp
#include <hip/hip_runtime.h>
#include <cstdio>
#include <cstdint>
#include <utility>
#define DI __device__ __forceinline__
#define GAS __attribute__((address_space(1)))
#define LAS __attribute__((address_space(3)))
#define CAS __attribute__((address_space(4)))
typedef unsigned short bf16;
typedef unsigned v4u __attribute__((ext_vector_type(4)));
typedef unsigned v2u __attribute__((ext_vector_type(2)));
typedef float f32x4v __attribute__((ext_vector_type(4)));
typedef float f32x2v __attribute__((ext_vector_type(2)));
typedef float f32x16v __attribute__((ext_vector_type(16)));
typedef short s16x8v __attribute__((ext_vector_type(8)));
typedef short s16x4v __attribute__((ext_vector_type(4)));

constexpr int D = 2048, MP = 4096, MS = 8192, MT = 12288, MKV = 12800;
constexpr int DFF = 5632, NFF1 = 11264;
constexpr int ZE_N = 4192, ZE_P = 4352;
constexpr int SCAN_P = 9 * 1024;
constexpr int NCH = 32, CHL = 4096 / NCH;
constexpr int MODL = 3 * 18432;

DI int lane_id_v() { int l; asm volatile("v_mbcnt_lo_u32_b32 %0, -1, 0\n\tv_mbcnt_hi_u32_b32 %0, -1, %0" : "=v"(l)); return l; }
DI unsigned f2bf(float f) { unsigned u = __builtin_bit_cast(unsigned, f); return (u + 0x7fffu + ((u >> 16) & 1u)) >> 16; }
DI unsigned pk2(float lo, float hi) { unsigned r; asm("v_cvt_pk_bf16_f32 %0, %1, %2" : "=v"(r) : "v"(lo), "v"(hi)); return r; }
DI float bf2f(unsigned short b) { return __builtin_bit_cast(float, ((unsigned)b) << 16); }
DI float h2f(unsigned short h) { return (float)__builtin_bit_cast(_Float16, h); }
DI unsigned pkh(float a, float b) { return (unsigned)__builtin_bit_cast(unsigned short, (_Float16)a) | ((unsigned)__builtin_bit_cast(unsigned short, (_Float16)b) << 16); }
DI f32x4v h4_unpack(v2u w) { return (f32x4v){h2f((unsigned short)(w.x & 0xffffu)), h2f((unsigned short)(w.x >> 16)), h2f((unsigned short)(w.y & 0xffffu)), h2f((unsigned short)(w.y >> 16))}; }
DI v2u h4_pack(f32x4v v) { v2u w; w.x = pkh(v.x, v.y); w.y = pkh(v.z, v.w); return w; }
template <int CTRL> DI float dpp_f(float v) { return __builtin_bit_cast(float, __builtin_amdgcn_update_dpp(0, __builtin_bit_cast(int, v), CTRL, 0xf, 0xf, true)); }
DI float shfl_idx(float v, int src) { return __builtin_bit_cast(float, __builtin_amdgcn_ds_bpermute(src << 2, __builtin_bit_cast(int, v))); }
DI float wave_sum(float v) {
    v += dpp_f<0xB1>(v); v += dpp_f<0x4E>(v); v += dpp_f<0x141>(v); v += dpp_f<0x140>(v);
    v += __builtin_bit_cast(float, __builtin_amdgcn_ds_swizzle(__builtin_bit_cast(int, v), 0x401F));
    return __builtin_bit_cast(float, __builtin_amdgcn_readlane(__builtin_bit_cast(int, v), 0)) + __builtin_bit_cast(float, __builtin_amdgcn_readlane(__builtin_bit_cast(int, v), 32));
}
DI float sigmoid_f(float x) { return __builtin_amdgcn_rcpf(1.f + __expf(-x)); }
DI float silu_f(float x) { return x * sigmoid_f(x); }
DI int scan_perm(int j) { return 4 * (j & 15) + (j >> 4); }
DI int row_mod_j(int row) { return row < MP ? 0 : 1 + ((row - MP) >> 12); }
namespace pg8 {
#define PG8_LAS __attribute__((address_space(3)))
typedef unsigned short bf16_t;
typedef short bf16x8 __attribute__((ext_vector_type(8)));
typedef float f32x4 __attribute__((ext_vector_type(4)));
typedef unsigned u32x4 __attribute__((ext_vector_type(4)));
constexpr int BM = 256, BK = 64, HALF = 128, HTB = HALF * BK * 2  , STAGE_BYTES = 8 * HTB, NXCD = 8, WGM = 8;

__host__ __device__ __forceinline__ int lds_byte(int r, int c) { const int st = (r >> 4) * 2 + (c >> 5), rr = r & 15, cc = c & 31, ob = rr * 64 + cc * 2; return st * 1024 + (ob ^ (((ob >> 9) & 1) << 5)); }
__host__ __device__ __forceinline__ void stage_rc(int b, int& R, int& C) { const int st = b / 1024, sb = b % 1024, swz = sb ^ (((sb >> 9) & 1) << 5); R = (st >> 1) * 16 + swz / 64; C = (st & 1) * 32 + (swz % 64) / 2; }
__host__ __device__ __forceinline__ int perm32(int rho) { const int n = rho >> 4, i = rho & 15; return 8 * (i >> 2) + 4 * n + (i & 3); }

struct Unit { int pm, pn; int kt0, nkt, mode, slot; };
struct Gemm { const bf16_t* A; const bf16_t* Bt; int M, N, K; };
struct StaticOrder {
    static constexpr int SPLITK = 0;
    int nM, nN, nwg, G, c;
    __host__ __device__ __forceinline__ void init(int M, int N, int G_, int c_) { nM = M / BM; nN = N / BM; nwg = nM * nN; G = G_; c = c_; }
    __host__ __device__ __forceinline__ bool next(int i, Unit& u) const {
        const long L = (long)i * G + c; if (L >= nwg) return false;
        int wgid = (int)L; { const int q = nwg / NXCD, r = nwg % NXCD, xcd = wgid % NXCD, off = wgid / NXCD; wgid = (xcd < r ? xcd * (q + 1) : r * (q + 1) + (xcd - r) * q) + off; }
        const int nig = WGM * nN, gid = wgid / nig, fm = gid * WGM, gsz = (nM - fm) < WGM ? (nM - fm) : WGM;
        u.pm = fm + ((wgid % nig) % gsz); u.pn = (wgid % nig) / gsz; u.kt0 = 0; u.nkt = 0; u.mode = 0; u.slot = 0; return true;
    }
    __device__ __forceinline__ void a_ready(const Unit&) const {}
    __device__ __forceinline__ void done(const Unit&) const {}
    __device__ __forceinline__ void publish(const f32x4 (&)[2][2][4][2], const Unit&, int, int) const {}
    __device__ __forceinline__ void consume(f32x4 (&)[2][2][4][2], const Unit&, int, int) const {}
};

template <int PART> struct PairOrder {
    static constexpr int SPLITK = PART;
    StaticOrder so; int R, rem, nt; bool paired;
    float* scratch; unsigned* flags; unsigned target;
    __device__ __forceinline__ void init(int M, int N, int K, int G_, int c_, float* scr, unsigned* fl, unsigned tgt) { so.init(M, N, G_, 0); so.c = 0; so.G = 1; R = so.nwg / G_; rem = so.nwg % G_; nt = K / BK;
        paired = (2 * rem == G_) && ((nt / 2) % 2 == 0); c = c_; G = G_; scratch = scr; flags = fl; target = tgt; }
    int c, G;
    __device__ __forceinline__ bool tile(int t, Unit& u) const { return so.next(t, u); }
    __device__ __forceinline__ bool next(int i, Unit& u) const {
        int t = -1, kt0 = 0, nk = nt, mode = 0, slot = 0;
        if (!paired) { if (PART == 1) { const long L = (long)i * G + c; if (L < so.nwg) t = (int)L; } }
        else if (PART == 1) {
            if (c < rem) { if (i == 0) { t = R * G + c; nk = nt / 2; mode = 1; slot = c; } else if (i <= R) t = (i - 1) * G + c; }
            else if (i < R) t = i * G + c;
        }
        else if (c >= rem && i == 0) { t = R * G + (c - rem); kt0 = nt / 2; nk = nt - nt / 2; mode = 2; slot = c - rem; }
        if (t < 0) return false;
        tile(t, u); u.kt0 = kt0; u.nkt = nk; u.mode = mode; u.slot = slot; return true;
    }
    __device__ __forceinline__ void a_ready(const Unit&) const {}
    __device__ __forceinline__ void done(const Unit&) const {}
    __device__ __forceinline__ void publish(const f32x4 (&acc)[2][2][4][2], const Unit& u, int wid, int lane) const {
        const __amdgpu_buffer_rsrc_t rs = __builtin_amdgcn_make_buffer_rsrc((void*)scratch, 0, 0x7fffffff, 0x00020000);
        const int so_ = __builtin_amdgcn_readfirstlane(u.slot * 262144 + wid * 32768), vo = lane * 16;
#pragma unroll
        for (int ai = 0; ai < 2; ++ai)
#pragma unroll
            for (int bj = 0; bj < 2; ++bj)
#pragma unroll
                for (int m = 0; m < 4; ++m)
#pragma unroll
                    for (int n = 0; n < 2; ++n) { const int r = ((ai * 2 + bj) * 4 + m) * 2 + n;
                        __builtin_amdgcn_raw_buffer_store_b128(__builtin_bit_cast(u32x4, acc[ai][bj][m][n]), rs, vo, so_ + r * 1024, 16); }
        asm volatile("s_waitcnt vmcnt(0)" ::: "memory");
        if (lane == 0) __hip_atomic_fetch_add(flags + 64 * u.slot, 1u, __ATOMIC_RELAXED, __HIP_MEMORY_SCOPE_AGENT);
    }
    __device__ __forceinline__ void consume(f32x4 (&acc)[2][2][4][2], const Unit& u, int wid, int lane) const {
        unsigned spins = 0;
        while ((unsigned)__builtin_amdgcn_readfirstlane((int)__hip_atomic_load(flags + 64 * u.slot, __ATOMIC_RELAXED, __HIP_MEMORY_SCOPE_AGENT)) < target) { __builtin_amdgcn_s_sleep(2); if (++spins > (1u << 22)) break; }
        __builtin_amdgcn_fence(__ATOMIC_ACQUIRE, "agent");
        asm volatile("s_waitcnt vmcnt(0)" ::: "memory");
        const __amdgpu_buffer_rsrc_t rs = __builtin_amdgcn_make_buffer_rsrc((void*)scratch, 0, 0x7fffffff, 0x00020000);
        const int so_ = __builtin_amdgcn_readfirstlane(u.slot * 262144 + wid * 32768), vo = lane * 16;
#pragma unroll
        for (int ai = 0; ai < 2; ++ai)
#pragma unroll
            for (int bj = 0; bj < 2; ++bj)
#pragma unroll
                for (int mh = 0; mh < 2; ++mh) {
                    f32x4 t[4];
#pragma unroll
                    for (int q = 0; q < 4; ++q) { const int m = mh * 2 + (q >> 1), n = q & 1; const int r = ((ai * 2 + bj) * 4 + m) * 2 + n; t[q] = __builtin_bit_cast(f32x4, __builtin_amdgcn_raw_buffer_load_b128(rs, vo, so_ + r * 1024, 16)); }
#pragma unroll
                    for (int q = 0; q < 4; ++q) { const int m = mh * 2 + (q >> 1), n = q & 1; acc[ai][bj][m][n] += t[q]; }
                    asm volatile("" ::: "memory");
                }
    }
};
__device__ __forceinline__ unsigned cvt_pk_bf16(float lo, float hi) { unsigned r; asm volatile("v_cvt_pk_bf16_f32 %0, %1, %2" : "=v"(r) : "v"(lo), "v"(hi)); return r; }
typedef float f32x2 __attribute__((ext_vector_type(2)));
#define EPI_LOOP_AIM _Pragma("unroll") for (int ai = 0; ai < 2; ++ai) _Pragma("unroll") for (int m = 0; m < 4; ++m)
#define EPI_LOOP_BJN _Pragma("unroll") for (int bj = 0; bj < 2; ++bj) _Pragma("unroll") for (int n = 0; n < 2; ++n)
struct EpiF32 {
    static constexpr bool PERM = false, AFTER_DRAIN = false;
    float* C; int ldc;
    __device__ __forceinline__ void operator()(const f32x4 (&acc)[2][2][4][2], const Unit& u, int wr, int wc, int fr, int fq) const {
        const int row0 = u.pm * BM + wr * 64 + fr, col0 = u.pn * BM + wc * 32 + 4 * fq;
        EPI_LOOP_AIM { float* rowp = C + (size_t)(row0 + ai * HALF + m * 16) * ldc + col0;
            EPI_LOOP_BJN *(f32x4*)(rowp + bj * HALF + n * 16) = acc[ai][bj][m][n]; }
    }
};
struct EpiBf16Plain {
    static constexpr bool PERM = true, AFTER_DRAIN = false;
    bf16_t* O; int ldc;
    __device__ __forceinline__ void operator()(const f32x4 (&acc)[2][2][4][2], const Unit& u, int wr, int wc, int fr, int fq) const {
        const int row0 = u.pm * BM + wr * 64 + fr, col0 = u.pn * BM + wc * 32 + 8 * fq;
        EPI_LOOP_AIM { bf16_t* rowp = O + (size_t)(row0 + ai * HALF + m * 16) * ldc + col0;
#pragma unroll
            for (int bj = 0; bj < 2; ++bj) { const f32x4 v0 = acc[ai][bj][m][0], v1 = acc[ai][bj][m][1];
                u32x4 w; w.x = cvt_pk_bf16(v0[0], v0[1]); w.y = cvt_pk_bf16(v0[2], v0[3]); w.z = cvt_pk_bf16(v1[0], v1[1]); w.w = cvt_pk_bf16(v1[2], v1[3]);
                *(u32x4*)(rowp + bj * HALF) = w; } }
    }
};
struct EpiSwiGLU {
    static constexpr bool PERM = true, AFTER_DRAIN = false;
    bf16_t* O; int ldc;
    __device__ __forceinline__ void operator()(const f32x4 (&acc)[2][2][4][2], const Unit& u, int wr, int wc, int fr, int fq) const {
        const int row0 = u.pm * BM + wr * 64 + fr, col0 = u.pn * HALF + wc * 32 + 8 * fq;
        EPI_LOOP_AIM { bf16_t* rowp = O + (size_t)(row0 + ai * HALF + m * 16) * ldc + col0;
            float o[8];
#pragma unroll
            for (int n = 0; n < 2; ++n)
#pragma unroll
                for (int i = 0; i < 4; ++i) { const float g = acc[ai][0][m][n][i], up = acc[ai][1][m][n][i]; o[n * 4 + i] = g * __builtin_amdgcn_rcpf(1.f + __expf(-g)) * up; }
            u32x4 w; w.x = cvt_pk_bf16(o[0], o[1]); w.y = cvt_pk_bf16(o[2], o[3]); w.z = cvt_pk_bf16(o[4], o[5]); w.w = cvt_pk_bf16(o[6], o[7]);
            *(u32x4*)rowp = w; }
    }
};
struct EpiRes {
    static constexpr bool PERM = true, AFTER_DRAIN = false;
    unsigned short* X; const float* gate; float coef;
    __device__ __forceinline__ void operator()(const f32x4 (&acc)[2][2][4][2], const Unit& u, int wr, int wc, int fr, int fq) const {
        const int row0 = u.pm * BM + wr * 64 + fr, col0 = u.pn * BM + wc * 32 + 8 * fq;
        const int rt = u.pm * BM; const int j = rt < 4096 ? 0 : 1 + ((rt - 4096) >> 12);
        const float* g = gate + j * 18432 + col0;
        f32x4 gv[2][2];
        EPI_LOOP_BJN gv[bj][n] = *(const f32x4*)(g + bj * HALF + n * 4) * coef;
        EPI_LOOP_AIM { unsigned short* rowp = X + (size_t)(row0 + ai * HALF + m * 16) * 2048 + col0;
#pragma unroll
            for (int bj = 0; bj < 2; ++bj) { const u32x4 w = *(const u32x4*)(rowp + bj * HALF);
                const f32x4 d0 = gv[bj][0] * acc[ai][bj][m][0], d1 = gv[bj][1] * acc[ai][bj][m][1];
                u32x4 o;
                o.x = pkh(h2f((unsigned short)(w.x & 0xffffu)) + d0[0], h2f((unsigned short)(w.x >> 16)) + d0[1]); o.y = pkh(h2f((unsigned short)(w.y & 0xffffu)) + d0[2], h2f((unsigned short)(w.y >> 16)) + d0[3]);
                o.z = pkh(h2f((unsigned short)(w.z & 0xffffu)) + d1[0], h2f((unsigned short)(w.z >> 16)) + d1[1]); o.w = pkh(h2f((unsigned short)(w.w & 0xffffu)) + d1[2], h2f((unsigned short)(w.w >> 16)) + d1[3]);
                *(u32x4*)(rowp + bj * HALF) = o; }
            asm volatile("" ::: "memory"); }
    }
};
struct EpiZT {
    static constexpr bool PERM = false, AFTER_DRAIN = false;
    float* ZTp; float* ZTs;
    __device__ __forceinline__ void operator()(const f32x4 (&acc)[2][2][4][2], const Unit& u, int wr, int wc, int fr, int fq) const {
        const int ch0 = u.pm * BM + wr * 64 + fr, tok0 = u.pn * BM;
        float* base; int pitch, toff;
        if (tok0 < 4096) { base = ZTp + (size_t)(tok0 >> 8) * 6144 * 256; pitch = 256; toff = 0; }
        else { const int tk = tok0 - 4096; base = ZTs + (size_t)(tk >> 12) * 6144 * 4096; pitch = 4096; toff = tk & 4095; }
        const int c0 = toff + wc * 32 + 4 * fq;
        EPI_LOOP_AIM { float* rowp = base + (size_t)(ch0 + ai * HALF + m * 16) * pitch + c0;
            EPI_LOOP_BJN *(f32x4*)(rowp + bj * HALF + n * 16) = acc[ai][bj][m][n]; }
    }
};
struct EpiVT {
    static constexpr bool PERM = true, AFTER_DRAIN = false;
    bf16_t* VTp; size_t s_off;
    __device__ __forceinline__ void operator()(const f32x4 (&acc)[2][2][4][2], const Unit& u, int wr, int wc, int fr, int fq) const {
        const int ch0 = u.pm * BM + wr * 64 + fr, tok0 = u.pn * BM;
        bf16_t* base; int pitch, toff; bf16_t* VTs = VTp + s_off;
        if (tok0 < 4096) { base = VTp + (size_t)(tok0 >> 8) * 1024 * 256; pitch = 256; toff = 0; }
        else if (tok0 < 12288) { const int tk = tok0 - 4096; base = VTs + (size_t)(tk >> 12) * 1024 * 4352; pitch = 4352; toff = tk & 4095; }
        else { const int tk = tok0 - 12288; base = VTs + (size_t)(tk >> 8) * 1024 * 4352; pitch = 4352; toff = 4096; }
        const int c0 = toff + wc * 32 + 8 * fq;
        EPI_LOOP_AIM { bf16_t* rowp = base + (size_t)(ch0 + ai * HALF + m * 16) * pitch + c0;
#pragma unroll
            for (int bj = 0; bj < 2; ++bj) { const f32x4 v0 = acc[ai][bj][m][0], v1 = acc[ai][bj][m][1];
                u32x4 w; w.x = cvt_pk_bf16(v0[0], v0[1]); w.y = cvt_pk_bf16(v0[2], v0[3]); w.z = cvt_pk_bf16(v1[0], v1[1]); w.w = cvt_pk_bf16(v1[2], v1[3]);
                *(u32x4*)(rowp + bj * HALF) = w; } }
    }
};
struct EpiQ {
    static constexpr bool PERM = true, AFTER_DRAIN = false;
    bf16_t* Q; const float* rope; float qs;
    __device__ __forceinline__ void operator()(const f32x4 (&acc)[2][2][4][2], const Unit& u, int wr, int wc, int fr, int fq) const {
        const int row0 = u.pm * BM + wr * 64 + fr;
        EPI_LOOP_AIM { const int row = row0 + ai * HALF + m * 16; const bool smp = row >= 4096; const int t = (row - 4096) & 4095;
#pragma unroll
            for (int bj = 0; bj < 2; ++bj) { const int c0 = u.pn * BM + bj * HALF + wc * 32 + 8 * fq; const int within = c0 % 192;
                float o[8];
#pragma unroll
                for (int n = 0; n < 2; ++n)
#pragma unroll
                    for (int i = 0; i < 4; ++i) o[n * 4 + i] = acc[ai][bj][m][n][i];
                if (within >= 128 && smp) { const int ri = within - 128;
#pragma unroll
                    for (int q = 0; q < 4; ++q) { const int idx = ri + 2 * q, hf = idx >> 5, j = (idx & 31) >> 1; const int pos = hf ? (t & 63) : (t >> 6);
                        const float2 cs = *(const float2*)(rope + (pos * 16 + j) * 2); const float x1 = o[2 * q], x2 = o[2 * q + 1];
                        o[2 * q] = x1 * cs.x - x2 * cs.y; o[2 * q + 1] = x2 * cs.x + x1 * cs.y; } }
                u32x4 w; w.x = cvt_pk_bf16(o[0] * qs, o[1] * qs); w.y = cvt_pk_bf16(o[2] * qs, o[3] * qs); w.z = cvt_pk_bf16(o[4] * qs, o[5] * qs); w.w = cvt_pk_bf16(o[6] * qs, o[7] * qs);
                *(u32x4*)(Q + (size_t)row * 1536 + c0) = w; } }
    }
};
struct EpiLora {
    static constexpr bool PERM = false, AFTER_DRAIN = false;
    unsigned char* wsb; const float* w0; const float* a0; const float* ka; size_t off_sc, off_kb, off_gb;
    __device__ __forceinline__ void operator()(const f32x4 (&acc)[2][2][4][2], const Unit& u, int wr, int wc, int fr, int fq) const {
        const int row0 = u.pm * BM + wr * 64 + fr; const int seg = u.pn >> 2; const int cb = (u.pn & 3) * BM + wc * 32 + 4 * fq;
        float* SC = (float*)(wsb + off_sc); const float* KB = (const float*)(wsb + off_kb); float* GB = (float*)(wsb + off_gb);
        EPI_LOOP_AIM { const int row = row0 + ai * HALF + m * 16; float* sc = SC + (size_t)row * 9216;
            EPI_LOOP_BJN { const int c = cb + bj * HALF + n * 16; const f32x4 a = acc[ai][bj][m][n];
                if (seg < 2) { const f32x4 wv = *(const f32x4*)(w0 + seg * 1024 + c); f32x4 o;
#pragma unroll
                    for (int i = 0; i < 4; ++i) { const float x = wv[i] + a[i]; const float sp = __logf(1.f + __expf(-x)); o[i] = __expf(-__expf(-sp - 0.5f)); }
                    *(f32x4*)(sc + (3 + seg) * 1024 + c) = o; }
                else if (seg < 4) { const int d = seg - 2; const f32x4 av = *(const f32x4*)(a0 + d * 1024 + c), kav = *(const f32x4*)(ka + c);
                    const f32x4 kk = *(const f32x4*)(sc + 2 * 1024 + c), kr = *(const f32x4*)(KB + (size_t)row * 1024 + c); f32x4 o1, o2;
#pragma unroll
                    for (int i = 0; i < 4; ++i) { const float s = __builtin_amdgcn_rcpf(1.f + __expf(-(av[i] + a[i]))); o1[i] = kk[i] * s; o2[i] = kr[i] * (1.f + (s - 1.f) * kav[i]); }
                    *(f32x4*)(sc + (5 + d) * 1024 + c) = o1; *(f32x4*)(sc + (7 + d) * 1024 + c) = o2; }
                else *(f32x4*)(GB + (size_t)row * 1024 + c) = a; }
            asm volatile("" ::: "memory"); }
    }
};
template <class Epi, class Sched, bool ALIGN_EPI = false, bool SP2 = false>
__device__ __forceinline__ void gemm_phase(PG8_LAS unsigned char* lds, const Gemm g, const Sched& S, const Epi& E, int wave_id) {
    const int tid_l_ = wave_id * 64 + lane_id_v();
    const int tid = tid_l_, wid = __builtin_amdgcn_readfirstlane(tid >> 6), lane = tid & 63, wr = wid >> 2, wc = wid & 3, fr = lane & 15, fq = lane >> 4;
    const int K = g.K, nt = K / BK;
    unsigned voffA[2], voffB[2];
#pragma unroll
    for (int i = 0; i < 2; ++i) { int R, C; stage_rc(tid * 16 + i * 8192, R, C); const int Rb = Epi::PERM ? ((R & ~31) + perm32(R & 31)) : R;
        voffA[i] = (unsigned)(R * K + C) * 2u; voffB[i] = (unsigned)(Rb * K + C) * 2u; }
    const size_t kstep = (size_t)(BK * 2);
    const size_t hstep = (size_t)HALF * K * 2;
    const size_t tstep = 2 * hstep;
    const unsigned ldsw = (unsigned)wid * 1024u;
    const int aoff = lds_byte(wr * 64 + fr, fq * 8), boff = lds_byte(wc * 32 + fr, fq * 8);
#define PG8_SA(b, h) (((b) * 2 + (h)) * HTB)
#define PG8_SB(b, h) ((4 + (b) * 2 + (h)) * HTB)
#define PG8_STAGE(bufoff, gbase, voff) do { _Pragma("unroll") for (int _i = 0; _i < 2; ++_i) \
        __builtin_amdgcn_global_load_lds((const unsigned*)((const char*)(gbase) + (voff)[_i]), (PG8_LAS unsigned*)(lds + (bufoff) + ldsw + _i * 8192), 16, 0, 0); } while (0)
#define PG8_LDA(dst, b, h) do { _Pragma("unroll") for (int m = 0; m < 4; ++m) _Pragma("unroll") for (int k = 0; k < 2; ++k) dst[m][k] = *(const PG8_LAS bf16x8*)(lds + PG8_SA(b, h) + aoff + m * 2048 + k * 1024); } while (0)
#define PG8_LDB(dst, b, h) do { _Pragma("unroll") for (int n = 0; n < 2; ++n) _Pragma("unroll") for (int k = 0; k < 2; ++k) dst[n][k] = *(const PG8_LAS bf16x8*)(lds + PG8_SB(b, h) + boff + n * 2048 + k * 1024); } while (0)
#define PG8_MMA(ai, bj, At, Bt) do { __builtin_amdgcn_s_setprio(1); _Pragma("unroll") for (int m = 0; m < 4; ++m) _Pragma("unroll") for (int n = 0; n < 2; ++n) _Pragma("unroll") for (int k = 0; k < 2; ++k) \
        acc[ai][bj][m][n] = __builtin_amdgcn_mfma_f32_16x16x32_bf16(Bt[n][k], At[m][k], acc[ai][bj][m][n], 0, 0, 0); __builtin_amdgcn_s_setprio(0); } while (0)
#define PG8_WAIT_V(n) asm volatile("s_waitcnt vmcnt(" #n ")" ::: "memory")
#define PG8_WAIT_L(n) asm volatile("s_waitcnt lgkmcnt(" #n ")" ::: "memory")
#define PG8_BAR __builtin_amdgcn_s_barrier()
#define PG8_SCHED __builtin_amdgcn_sched_barrier(0)
    Unit cur, nxt; int ui = 0;
    if (!S.next(0, cur)) return;
    f32x4 acc[2][2][4][2];
#pragma unroll
    for (int a = 0; a < 2; ++a)
#pragma unroll
        for (int b = 0; b < 2; ++b)
#pragma unroll
            for (int m = 0; m < 4; ++m)
#pragma unroll
                for (int n = 0; n < 2; ++n) acc[a][b][m][n] = (f32x4){0.f, 0.f, 0.f, 0.f};
    bf16x8 At[4][2], B0[2][2], B1[2][2];
    const char* cA = (const char*)g.A + (size_t)cur.pm * tstep; const char* cB = (const char*)g.Bt + (size_t)cur.pn * tstep;
    if constexpr (Sched::SPLITK != 0) { cA += (size_t)cur.kt0 * kstep; cB += (size_t)cur.kt0 * kstep; }
    S.a_ready(cur);
    if constexpr (SP2) {
        PG8_STAGE(PG8_SB(0, 0), cB, voffB); PG8_STAGE(PG8_SB(0, 1), cB + hstep, voffB); PG8_STAGE(PG8_SA(0, 0), cA, voffA); PG8_STAGE(PG8_SA(0, 1), cA + hstep, voffA);
        if (wr == 1) PG8_BAR;
        PG8_WAIT_V(2); PG8_BAR;
        PG8_STAGE(PG8_SB(1, 0), cB + kstep, voffB); PG8_STAGE(PG8_SA(1, 0), cA + kstep, voffA); PG8_STAGE(PG8_SB(1, 1), cB + hstep + kstep, voffB);
        PG8_WAIT_V(6); PG8_BAR;
    } else {
        PG8_STAGE(PG8_SB(0, 0), cB, voffB); PG8_STAGE(PG8_SA(0, 0), cA, voffA); PG8_STAGE(PG8_SB(0, 1), cB + hstep, voffB); PG8_STAGE(PG8_SA(0, 1), cA + hstep, voffA);
        if (wr == 1) PG8_BAR;
        PG8_WAIT_V(4); PG8_BAR;
        PG8_STAGE(PG8_SB(1, 0), cB + kstep, voffB); PG8_STAGE(PG8_SA(1, 0), cA + kstep, voffA); PG8_STAGE(PG8_SB(1, 1), cB + hstep + kstep, voffB);
        PG8_WAIT_V(6); PG8_BAR;
    }
    for (;;) {
        const bool has_next = S.next(ui + 1, nxt);
        const char* nA = has_next ? (const char*)g.A + (size_t)nxt.pm * tstep : cA; const char* nB = has_next ? (const char*)g.Bt + (size_t)nxt.pn * tstep : cB;
        if constexpr (Sched::SPLITK != 0) { if (has_next) { nA += (size_t)nxt.kt0 * kstep; nB += (size_t)nxt.kt0 * kstep; } }
        const int cnt = Sched::SPLITK != 0 ? cur.nkt : nt;
        for (int t = 0; t < cnt; t += 2) {
            const bool last = (t == cnt - 2);
            const char* a1 = cA + (size_t)(t + 1) * kstep;
            const char* a2 = last ? nA : cA + (size_t)(t + 2) * kstep; const char* b2 = last ? nB : cB + (size_t)(t + 2) * kstep;
            const char* a3 = a2 + kstep; const char* b3 = b2 + kstep;
            if (last && has_next) S.a_ready(nxt);
            if constexpr (SP2) {
            PG8_LDB(B0, 0, 0); PG8_LDB(B1, 0, 1); PG8_SCHED; PG8_LDA(At, 0, 0); PG8_STAGE(PG8_SA(1, 1), a1 + hstep, voffA);
            PG8_WAIT_V(8); PG8_WAIT_L(0); PG8_BAR; PG8_MMA(0, 0, At, B0); PG8_MMA(0, 1, At, B1); PG8_BAR; PG8_SCHED;
            PG8_LDA(At, 0, 1); PG8_STAGE(PG8_SB(0, 0), b2, voffB); PG8_STAGE(PG8_SB(0, 1), b2 + hstep, voffB); PG8_STAGE(PG8_SA(0, 0), a2, voffA);
            PG8_WAIT_V(8); PG8_WAIT_L(0); PG8_BAR; PG8_MMA(1, 0, At, B0); PG8_MMA(1, 1, At, B1); PG8_BAR; PG8_SCHED;
            PG8_LDB(B0, 1, 0); PG8_LDB(B1, 1, 1); PG8_SCHED; PG8_LDA(At, 1, 0); PG8_STAGE(PG8_SA(0, 1), a2 + hstep, voffA);
            PG8_WAIT_V(8); PG8_WAIT_L(0); PG8_BAR; PG8_MMA(0, 0, At, B0); PG8_MMA(0, 1, At, B1); PG8_BAR; PG8_SCHED;
            PG8_LDA(At, 1, 1); PG8_STAGE(PG8_SB(1, 0), b3, voffB); PG8_STAGE(PG8_SB(1, 1), b3 + hstep, voffB); PG8_STAGE(PG8_SA(1, 0), a3, voffA);
            PG8_WAIT_V(8); PG8_WAIT_L(0); PG8_BAR; PG8_MMA(1, 0, At, B0); PG8_MMA(1, 1, At, B1); PG8_BAR; PG8_SCHED;
            } else {
            PG8_LDB(B0, 0, 0); PG8_SCHED; PG8_LDA(At, 0, 0); PG8_STAGE(PG8_SA(1, 1), a1 + hstep, voffA);
            PG8_WAIT_L(8); PG8_BAR; PG8_WAIT_L(0); PG8_MMA(0, 0, At, B0); PG8_BAR; PG8_SCHED;
            PG8_LDB(B1, 0, 1); PG8_STAGE(PG8_SB(0, 0), b2, voffB);
            PG8_BAR; PG8_WAIT_L(0); PG8_MMA(0, 1, At, B1); PG8_BAR;
            PG8_LDA(At, 0, 1); PG8_STAGE(PG8_SA(0, 0), a2, voffA);
            PG8_BAR; PG8_WAIT_L(0); PG8_MMA(1, 0, At, B0); PG8_BAR; PG8_SCHED;
            PG8_STAGE(PG8_SB(0, 1), b2 + hstep, voffB);
            PG8_WAIT_V(6); PG8_BAR; PG8_MMA(1, 1, At, B1); PG8_BAR;
            PG8_LDB(B0, 1, 0); PG8_SCHED; PG8_LDA(At, 1, 0); PG8_STAGE(PG8_SA(0, 1), a2 + hstep, voffA);
            PG8_WAIT_L(8); PG8_BAR; PG8_WAIT_L(0); PG8_MMA(0, 0, At, B0); PG8_BAR; PG8_SCHED;
            PG8_LDB(B1, 1, 1); PG8_STAGE(PG8_SB(1, 0), b3, voffB);
            PG8_BAR; PG8_WAIT_L(0); PG8_MMA(0, 1, At, B1); PG8_BAR;
            PG8_LDA(At, 1, 1); PG8_STAGE(PG8_SA(1, 0), a3, voffA);
            PG8_BAR; PG8_WAIT_L(0); PG8_MMA(1, 0, At, B0); PG8_BAR; PG8_SCHED;
            PG8_STAGE(PG8_SB(1, 1), b3 + hstep, voffB);
            PG8_WAIT_V(6); PG8_BAR; PG8_MMA(1, 1, At, B1); PG8_BAR;
            }
        }
        if constexpr (ALIGN_EPI) { if (wr == 0) PG8_BAR; }
        if constexpr (Sched::SPLITK == 1) { if (cur.mode == 1) S.publish(acc, cur, wid, lane); else E(acc, cur, wr, wc, fr, fq); S.done(cur); }
        else if constexpr (Sched::SPLITK == 2) { S.consume(acc, cur, wid, lane); E(acc, cur, wr, wc, fr, fq); S.done(cur); }
        else if constexpr (!Epi::AFTER_DRAIN) { E(acc, cur, wr, wc, fr, fq); S.done(cur); }
        if (!has_next) break;
#pragma unroll
        for (int a = 0; a < 2; ++a)
#pragma unroll
            for (int b = 0; b < 2; ++b)
#pragma unroll
                for (int m = 0; m < 4; ++m)
#pragma unroll
                    for (int n = 0; n < 2; ++n) acc[a][b][m][n] = (f32x4){0.f, 0.f, 0.f, 0.f};
        cur = nxt; cA = nA; cB = nB; ++ui;
        if constexpr (ALIGN_EPI) { if (wr == 1) PG8_BAR; }
    }
    PG8_WAIT_V(0);
    if constexpr (!ALIGN_EPI) { if (wr == 0) PG8_BAR; }
    PG8_BAR;
    if constexpr (Epi::AFTER_DRAIN) { E.fused(acc, cur, wr, wc, fr, fq, lds, wid, lane); S.done(cur); }
#undef PG8_SA
#undef PG8_SB
#undef PG8_STAGE
#undef PG8_LDA
#undef PG8_LDB
#undef PG8_MMA
#undef PG8_WAIT_V
#undef PG8_WAIT_L
#undef PG8_BAR
#undef PG8_SCHED
}
}
#define XB_TMO      128
#define XB_XCNT(j)  (256  + 64 * (j))
#define XB_XSUB(j)  (1280 + 64 * (j))
#define XB_XGEN(j)  (2304 + 64 * (j))
#define XB_TOP      3328
#define XB_TOPGEN   3392
#define XCD_BAR_WORDS 3456
#define XB_SPIN_CAP (1u << 18)

__device__ __forceinline__ unsigned xb_ld(unsigned* p)              { return __hip_atomic_load(p, __ATOMIC_RELAXED, __HIP_MEMORY_SCOPE_AGENT); }
__device__ __forceinline__ unsigned xb_add(unsigned* p, unsigned v) { return __hip_atomic_fetch_add(p, v, __ATOMIC_RELAXED, __HIP_MEMORY_SCOPE_AGENT); }
__device__ __forceinline__ unsigned xb_xcc_id() { return (unsigned)__builtin_amdgcn_s_getreg((3 << 11) | 20) & 0xFu; }
#define XB_SPIN(cond, bar) do { unsigned _sp = 0; while (cond) { __builtin_amdgcn_s_sleep(1); \
    if ((++_sp & 255u) == 0u) { if (xb_ld(&(bar)[XB_TMO])) break; if (_sp > XB_SPIN_CAP) { atomicAdd(&(bar)[XB_TMO], 1u); break; } } } } while (0)

struct XcdBarrier {
    unsigned* bar; unsigned x;
    volatile LAS unsigned* st;
};

__device__ __forceinline__ XcdBarrier xcd_barrier_post(unsigned* bar, volatile LAS unsigned* st, int tid_) {
    XcdBarrier b; b.bar = bar; b.x = xb_xcc_id(); b.st = st;
    if (tid_ == 0) (void)xb_add(&bar[XB_XCNT(b.x)], 1u);
    return b;
}
__device__ __forceinline__ void xcd_barrier_complete(unsigned* bar, unsigned x, unsigned& nloc, unsigned& nx) {
    const unsigned G = gridDim.x * gridDim.y * gridDim.z;
    unsigned sum, cnt, mine, sp = 0u;
    for (;;) {
        sum = 0u; cnt = 0u; mine = 0u;
#pragma unroll
        for (unsigned j = 0; j < 16; ++j) { const unsigned c = xb_ld(&bar[XB_XCNT(j)]); sum += c; cnt += (c > 0u) ? 1u : 0u; mine = (j == x) ? c : mine; }
        if (sum == G) break;
        __builtin_amdgcn_s_sleep(1);
        if ((++sp & 255u) == 0u) { if (xb_ld(&bar[XB_TMO])) break; if (sp > XB_SPIN_CAP) { atomicAdd(&bar[XB_TMO], 1u); break; } }
    }
    nloc = mine > 0u ? mine : 1u; nx = cnt > 0u ? cnt : 1u;
}

__device__ __forceinline__ void xcd_barrier(const XcdBarrier& b, int tid_) {
    asm volatile("s_waitcnt vmcnt(0)" ::: "memory");
    __syncthreads();
    if (tid_ == 0) {
        unsigned* bar = b.bar;
        __builtin_amdgcn_s_waitcnt(0);
        unsigned nloc = b.st[0], nx = b.st[1];
        if (nloc == 0u) { xcd_barrier_complete(bar, b.x, nloc, nx); b.st[0] = nloc; b.st[1] = nx; }
        const unsigned old = xb_add(&bar[XB_XSUB(b.x)], 1u);
        const unsigned gen = old / nloc;
        if (old + 1u == (gen + 1u) * nloc) {
            __builtin_amdgcn_fence(__ATOMIC_RELEASE, "agent");
            asm volatile("s_waitcnt vmcnt(0)" ::: "memory");
            const unsigned og = xb_add(&bar[XB_TOP], 1u);
            const unsigned tg = og / nx;
            if (og + 1u == (tg + 1u) * nx) xb_add(&bar[XB_TOPGEN], 1u);
            else XB_SPIN(xb_ld(&bar[XB_TOPGEN]) == tg, bar);
            __builtin_amdgcn_fence(__ATOMIC_ACQUIRE, "agent");
            xb_add(&bar[XB_XGEN(b.x)], 1u);
            asm volatile("s_waitcnt vmcnt(0)" ::: "memory");
        } else {
            XB_SPIN(xb_ld(&bar[XB_XGEN(b.x)]) == gen, bar);
            __builtin_amdgcn_fence(__ATOMIC_ACQUIRE, "agent");
            asm volatile("s_waitcnt vmcnt(0)" ::: "memory");
        }
    }
    __syncthreads();
}

constexpr size_t MiB = 1u << 20;
constexpr size_t WS_CTL = 0, CTL_ZERO_BYTES = 2 * MiB;
constexpr size_t WS_MOD = 2 * MiB;
constexpr size_t WS_PMOD = WS_MOD + 2 * MiB;
constexpr size_t WS_ROPE = WS_PMOD + 8 * MiB;
constexpr size_t WS_W1T = WS_ROPE + 2 * MiB;
constexpr size_t WS_W2T = WS_W1T + 352 * MiB;
constexpr size_t WS_WINE = WS_W2T + 176 * MiB;
constexpr size_t WS_WOUTE = WS_WINE + 34 * MiB;
constexpr size_t WS_WINO = WS_WOUTE + 16 * MiB;
constexpr size_t WS_WOUTO = WS_WINO + 48 * MiB;
constexpr size_t WS_WQ = WS_WOUTO + 16 * MiB;
constexpr size_t WS_WKN = WS_WQ + 4 * MiB;
constexpr size_t WS_WV = WS_WKN + 2 * MiB;
constexpr size_t WS_WLORA = WS_WV + 2 * MiB;
constexpr size_t WS_W3T = WS_WLORA + 8 * MiB;
constexpr size_t WS_H2 = WS_W3T + 8 * MiB;
constexpr size_t WS_X = WS_H2 + 4 * MiB;
constexpr size_t WS_H = WS_X + 96 * MiB;
constexpr size_t WS_ACT = WS_H + 48 * MiB;
constexpr size_t WS_Z = WS_ACT + 132 * MiB;
constexpr size_t WS_SCAN = WS_Z + 288 * MiB;
constexpr size_t SCAN_BYTES = 432 * MiB;
constexpr size_t WS_KBUF = WS_SCAN + 2 * SCAN_BYTES;
constexpr size_t WS_LA = WS_KBUF + 48 * MiB;
constexpr size_t WS_GB = WS_LA + 10 * MiB;
constexpr size_t WS_CQ = WS_GB + 48 * MiB;
constexpr size_t WS_CKV = WS_CQ + 12 * MiB;
constexpr size_t WS_KR = WS_CKV + 8 * MiB;
constexpr size_t WS_Q = WS_KR + 2 * MiB;
constexpr size_t WS_KN = WS_Q + 36 * MiB;
constexpr size_t WS_VT = WS_KN + 26 * MiB;
constexpr size_t WS_YSC = WS_VT + 26 * MiB;
constexpr size_t WS_PQ = WS_ACT;
constexpr size_t WS_SST = WS_ACT + 64 * MiB;
constexpr size_t WS_PST = WS_ACT + 96 * MiB;
constexpr size_t WS_MIX = WS_YSC + 96 * MiB;
constexpr size_t WS_KSS = WS_MIX + 48 * MiB;
constexpr size_t WS_KSP = WS_KSS + 258 * MiB;
constexpr size_t WS_END = WS_KSP + 18 * MiB;
static_assert((size_t)NCH * 64 * 2 * 16384 <= 64 * MiB && (size_t)NCH * 64 * 16384 <= 32 * MiB, "PQ / SST inside the ACT region");
constexpr size_t ZT_S_OFF = (size_t)16 * 6144 * 256 * 4;
constexpr size_t VT_S_OFF = (size_t)16 * 1024 * 256 * 2;

constexpr size_t OUT_YS = (size_t)MP * D, OUT_CKV = (size_t)MT * D, OUT_KR = OUT_CKV + 16 * 2 * 256 * 256, OUT_ST = OUT_KR + 16 * 2 * 256 * 64, OUT_END = OUT_ST + (size_t)16 * 2 * 2 * 16 * 64 * 64;

constexpr int LDS_RING = 131072, LDS_BYTES = 147456, LDS_CTL = LDS_BYTES - 512;

struct KArgs { const float* in[42]; float* out; unsigned char* ws; int ph_lo, ph_hi; };
enum { I_XP = 0, I_XS, I_CCKV, I_CKR, I_ST, I_C, I_CCTX, I_WMOD, I_BMOD, I_NG, I_WFI, I_WFO, I_FNG, I_WINE, I_MUP, I_MUN, I_W0, I_W2, I_A0, I_A2, I_G2, I_KK, I_KA, I_RK, I_GNW, I_GNB,
       I_QN, I_KVN, I_WQB, I_WKVB, I_WOE, I_WINO, I_CW, I_CB, I_FW1, I_FB1, I_FW2, I_FB2, I_FW3, I_FFR, I_HB, I_WOO };

struct Ctx {
    LAS unsigned char* lds; unsigned char* ws; const float* const* in; float* out;
    int tid, lane, wave, G, gw, NGW, vb, bx, zs;
};

DI void tr_item(const float* W, int ldw, int K, bf16* WT, int dstrow0, int srccol0, int k0, LAS float* scr, int lane) {
    float v[32];
#pragma unroll
    for (int i = 0; i < 32; ++i) v[i] = W[(size_t)(k0 + 2 * i + (lane >> 5)) * ldw + srccol0 + (lane & 31)];
#pragma unroll
    for (int i = 0; i < 32; ++i) scr[(2 * i + (lane >> 5)) * 33 + (lane & 31)] = v[i];
    asm volatile("s_waitcnt lgkmcnt(0)" ::: "memory");
    const int c = lane & 7;
#pragma unroll
    for (int j = 0; j < 4; ++j) { const int n = (lane >> 3) + 8 * j; const LAS float* s = scr + (8 * c) * 33 + n;
        v4u o; o.x = pk2(s[0 * 33], s[1 * 33]); o.y = pk2(s[2 * 33], s[3 * 33]); o.z = pk2(s[4 * 33], s[5 * 33]); o.w = pk2(s[6 * 33], s[7 * 33]);
        *(v4u*)(WT + (size_t)(dstrow0 + n) * K + k0 + 8 * c) = o; }
    asm volatile("s_waitcnt lgkmcnt(0)" ::: "memory");
}
template <int MODE> DI void tr_matrix(Ctx& C, const float* W, int ldw, int K, bf16* WT, int ndst, int nsrc, int gw, int NGW) {
    LAS float* scr = (LAS float*)(C.lds + C.wave * 8704);
    const int nkb = K / 64, nnb = ndst / 32, nit = nkb * nnb;
    for (int it = gw; it < nit; it += NGW) {
        const int kb = it / nnb, nb = it % nnb, dr = nb * 32;
        int sc = dr;
        if (MODE == 1) { const int p = dr >> 8, sg = (dr >> 7) & 1, j = dr & 127; sc = sg * 5632 + 128 * p + j; }
        if (MODE == 2 && dr >= nsrc) {
            const int c = C.lane & 7;
#pragma unroll
            for (int j = 0; j < 4; ++j) { const int n = (C.lane >> 3) + 8 * j; *(v4u*)(WT + (size_t)(dr + n) * K + kb * 64 + 8 * c) = (v4u){0u, 0u, 0u, 0u}; }
            continue;
        }
        tr_item(W, ldw, K, WT, dr, sc, kb * 64, scr, C.lane);
    }
}
template <class Fn> DI void cvt_small(Ctx& C, bf16* dst, int N, int K, Fn f) {
    const int total = N * (K / 8);
    for (int idx = C.bx * 512 + C.tid; idx < total; idx += C.G * 512) {
        const int n = idx % N, k8 = idx / N; float v[8];
#pragma unroll
        for (int i = 0; i < 8; ++i) v[i] = f(n, k8 * 8 + i);
        v4u o; o.x = pk2(v[0], v[1]); o.y = pk2(v[2], v[3]); o.z = pk2(v[4], v[5]); o.w = pk2(v[6], v[7]);
        *(v4u*)(dst + (size_t)n * K + k8 * 8) = o;
    }
}

DI void phase_prologue(Ctx& C) {
    const float* const* in = C.in; unsigned char* ws = C.ws;
    tr_matrix<1>(C, in[I_WFI], NFF1, 2048, (bf16*)(ws + WS_W1T), NFF1, NFF1, C.gw, C.NGW);
    tr_matrix<0>(C, in[I_WFO], 2048, DFF, (bf16*)(ws + WS_W2T), 2048, 2048, C.gw, C.NGW);
    for (int i = 0; i < 2; ++i) tr_matrix<2>(C, in[I_WINE] + (size_t)i * 2048 * ZE_N, ZE_N, 2048, (bf16*)(ws + WS_WINE) + (size_t)i * ZE_P * 2048, ZE_P, ZE_N, C.gw, C.NGW);
    for (int i = 0; i < 2; ++i) tr_matrix<0>(C, in[I_WOE] + (size_t)i * 2048 * 2048, 2048, 2048, (bf16*)(ws + WS_WOUTE) + (size_t)i * 2048 * 2048, 2048, 2048, C.gw, C.NGW);
    for (int i = 0; i < 2; ++i) tr_matrix<0>(C, in[I_WINO] + (size_t)i * 2048 * 6144, 6144, 2048, (bf16*)(ws + WS_WINO) + (size_t)i * 6144 * 2048, 6144, 6144, C.gw, C.NGW);
    for (int i = 0; i < 2; ++i) tr_matrix<0>(C, in[I_WOO] + (size_t)i * 2048 * 2048, 2048, 2048, (bf16*)(ws + WS_WOUTO) + (size_t)i * 2048 * 2048, 2048, 2048, C.gw, C.NGW);
    for (int e = 0; e < 2; ++e) {
        const float* wqb = in[I_WQB] + (size_t)e * 512 * 1536;
        cvt_small(C, (bf16*)(ws + WS_WQ) + (size_t)e * 1536 * 512, 1536, 512, [=](int n, int k) { const int hd = n / 192, wi = n % 192; int sc;
            if (wi < 128) sc = wi; else { const int idx = wi - 128, hf = idx >> 5, r = idx & 31; sc = 128 + 32 * hf + 16 * (r & 1) + (r >> 1); }
            return wqb[(size_t)k * 1536 + hd * 192 + sc]; });
        const float* wkv = in[I_WKVB] + (size_t)e * 256 * 2048;
        cvt_small(C, (bf16*)(ws + WS_WKN) + (size_t)e * 1024 * 256, 1024, 256, [=](int n, int k) { return wkv[(size_t)k * 2048 + (n >> 7) * 256 + (n & 127)]; });
        cvt_small(C, (bf16*)(ws + WS_WV) + (size_t)e * 1024 * 256, 1024, 256, [=](int n, int k) { return wkv[(size_t)k * 2048 + (n >> 7) * 256 + 128 + (n & 127)]; });
        const float* w2 = in[I_W2] + (size_t)e * 2 * 64 * 1024; const float* a2 = in[I_A2] + (size_t)e * 2 * 64 * 1024; const float* g2 = in[I_G2] + (size_t)e * 160 * 1024;
        cvt_small(C, (bf16*)(ws + WS_WLORA) + (size_t)e * 5120 * 384, 5120, 384, [=](int n, int k) { const int seg = n >> 10, c = n & 1023; float v = 0.f;
            if (seg < 2) { if (k < 64) v = w2[((size_t)seg * 64 + k) * 1024 + c]; }
            else if (seg < 4) { if (k >= 64 && k < 128) v = a2[((size_t)(seg - 2) * 64 + (k - 64)) * 1024 + c]; }
            else { if (k >= 128 && k < 288) v = g2[(size_t)(k - 128) * 1024 + c]; }
            return v; });
    }
    { const float* w3 = in[I_FW3];
      cvt_small(C, (bf16*)(ws + WS_W3T), 16384, 256, [=](int n, int k) { const int o = n >> 13, col = n & 8191; float v = 0.f; if ((k >> 6) == o) v = w3[((size_t)o * 64 + (k & 63)) * 8192 + col]; return v; }); }
    { LAS float* sl = (LAS float*)(C.lds + 8 * 8704);
      for (int it = C.bx; it < 4 * 8 * 9; it += C.G) {
          const int l = it / 72, kc = (it / 9) % 8, cc = it % 9;
          __syncthreads();
          for (int i = C.tid; i < 768; i += 512) { const int j = i >> 8, k = kc * 256 + (i & 255); const float cv = j == 0 ? in[I_CCTX][k] : in[I_C][(j - 1) * 2048 + k]; sl[i] = silu_f(cv); }
          __syncthreads();
          const int col = cc * 2048 + 4 * C.tid; const float* wp = in[I_WMOD] + ((size_t)l * 2048 + kc * 256) * 18432 + col;
          f32x4v a0 = {0.f, 0.f, 0.f, 0.f}, a1 = a0, a2 = a0;
#pragma unroll 4
          for (int k = 0; k < 256; ++k) { const f32x4v w = *(const f32x4v*)(wp + (size_t)k * 18432); a0 += w * sl[k]; a1 += w * sl[256 + k]; a2 += w * sl[512 + k]; }
          float* pm = (float*)(ws + WS_PMOD) + ((size_t)(kc * 4 + l) * 3) * 18432 + col;
          *(f32x4v*)(pm) = a0; *(f32x4v*)(pm + 18432) = a1; *(f32x4v*)(pm + 2 * 18432) = a2;
      }
      __syncthreads(); }
    { const f32x4v* s0 = (const f32x4v*)in[I_XP]; const f32x4v* s1 = (const f32x4v*)in[I_XS]; v2u* x = (v2u*)(ws + WS_X);
      const size_t n0 = (size_t)MP * D / 4, n1 = (size_t)MS * D / 4;
      for (size_t i = (size_t)C.bx * 512 + C.tid; i < n0 + n1; i += (size_t)C.G * 512) x[i] = h4_pack(i < n0 ? s0[i] : s1[i - n0]); }
    if (C.bx == 0) for (int i = C.tid; i < 1024; i += 512) { const int pos = i >> 4, j = i & 15; const float inv = 1.0f / powf(10000.0f, (float)(2 * j) / 32.0f); const float a = (float)pos * inv;
        float* r = (float*)(ws + WS_ROPE) + i * 2; r[0] = cosf(a); r[1] = sinf(a); }
    { bf16* H2 = (bf16*)(ws + WS_H2);
      for (int it = C.gw; it < 2 * 4352; it += C.NGW) {
          const int o = it / 4352, rr = it % 4352; const int L = rr < 256 ? 256 : 4096, t = rr < 256 ? rr : rr - 256; const int lane = C.lane;
          float zf = 0.f;
          if (lane == 0) zf = (float)t / (float)(L - 1);
          else if (lane < 33) { const int b = (lane - 1) & 15; const float fr = 1e-4f + (15.0f - 1e-4f) * ((float)b / 15.0f); const float ang = ((float)(2.0 * 3.14159265358979323846 / (double)L) * (float)t) * fr; zf = lane < 17 ? cosf(ang) : -sinf(ang); }
          const float* w1 = in[I_FW1] + (size_t)o * 33 * 64; const float* w2 = in[I_FW2] + (size_t)o * 64 * 64;
          float s = in[I_FB1][o * 64 + lane];
          for (int i = 0; i < 33; ++i) s += shfl_idx(zf, i) * w1[i * 64 + lane];
          const float h1 = sinf(in[I_FFR][(o * 2 + 0) * 64 + lane] * s);
          float s2 = in[I_FB2][o * 64 + lane];
          for (int i = 0; i < 64; ++i) s2 += shfl_idx(h1, i) * w2[i * 64 + lane];
          const float h2 = sinf(in[I_FFR][(o * 2 + 1) * 64 + lane] * s2);
          H2[(size_t)rr * 256 + o * 64 + lane] = (bf16)f2bf(h2);
          if (o == 0) { H2[(size_t)rr * 256 + 128 + lane] = 0; H2[(size_t)rr * 256 + 192 + lane] = 0; }
      } }
}
DI void phase_mod_reduce(Ctx& C) {
    const float* pm = (const float*)(C.ws + WS_PMOD); float* mod = (float*)(C.ws + WS_MOD); const float* bm = C.in[I_BMOD];
    for (int i = C.bx * 512 + C.tid; i < 4 * 3 * 18432; i += C.G * 512) { const int l = i / MODL, n = i % 18432; float s = bm[l * 18432 + n];
#pragma unroll
        for (int kc = 0; kc < 8; ++kc) s += pm[(size_t)kc * 4 * MODL + i];
        mod[i] = s; }
}
DI void phase_norm_mod(Ctx& C, const float* g, const float* modl, int s) {
    const unsigned short* X = (const unsigned short*)(C.ws + WS_X); bf16* H = (bf16*)(C.ws + WS_H);
    for (int row = C.gw; row < MT; row += C.NGW) {
        const float* sh = modl + row_mod_j(row) * 18432 + (3 * s) * 2048; const float* scl = sh + 2048;
        const v2u* xr = (const v2u*)(X + (size_t)row * D) + C.lane; f32x4v v[8]; float ss = 0.f;
#pragma unroll
        for (int i = 0; i < 8; ++i) { v[i] = h4_unpack(xr[64 * i]); ss += (v[i].x * v[i].x + v[i].y * v[i].y) + (v[i].z * v[i].z + v[i].w * v[i].w); }
        const float rstd = 1.0f / sqrtf(wave_sum(ss) * (1.0f / D) + 1e-6f);
        v2u* o = (v2u*)(H + (size_t)row * D) + C.lane;
#pragma unroll
        for (int i = 0; i < 8; ++i) { const int c = 4 * C.lane + 256 * i; const f32x4v gg = *(const f32x4v*)(g + c), sc = *(const f32x4v*)(scl + c), sf = *(const f32x4v*)(sh + c);
            const f32x4v y = (v[i] * rstd * gg) * (sc + 1.0f) + sf; v2u w; w.x = pk2(y.x, y.y); w.y = pk2(y.z, y.w); o[64 * i] = w; }
    }
}
DI void phase_final_norm(Ctx& C) {
    const unsigned short* X = (const unsigned short*)(C.ws + WS_X); const float* g = C.in[I_FNG];
    for (int row = C.gw; row < MT; row += C.NGW) {
        const v2u* xr = (const v2u*)(X + (size_t)row * D) + C.lane; f32x4v v[8]; float ss = 0.f;
#pragma unroll
        for (int i = 0; i < 8; ++i) { v[i] = h4_unpack(xr[64 * i]); ss += (v[i].x * v[i].x + v[i].y * v[i].y) + (v[i].z * v[i].z + v[i].w * v[i].w); }
        const float rstd = 1.0f / sqrtf(wave_sum(ss) * (1.0f / D) + 1e-6f);
        f32x4v* o = (f32x4v*)(C.out + (size_t)row * D) + C.lane;
#pragma unroll
        for (int i = 0; i < 8; ++i) { const f32x4v gg = *(const f32x4v*)(g + 4 * C.lane + 256 * i); o[64 * i] = v[i] * rstd * gg; }
    }
}

DI int rope_src(int p) { const int hf = p >> 5, r = p & 31; return 32 * hf + 16 * (r & 1) + (r >> 1); }
DI void phase_even_prep(Ctx& C, int e) {
    const float* const* in = C.in; unsigned char* ws = C.ws; const int lane = C.lane;
    const float* Z = (const float*)(ws + WS_Z); float* SC = (float*)(ws + WS_SCAN + (size_t)e * SCAN_BYTES); float* KB = (float*)(ws + WS_KBUF); bf16* LA = (bf16*)(ws + WS_LA);
    bf16* CQ = (bf16*)(ws + WS_CQ); bf16* CKV = (bf16*)(ws + WS_CKV); bf16* KR = (bf16*)(ws + WS_KR); const float* rope = (const float*)(ws + WS_ROPE);
    const float* mup = in[I_MUP] + e * 3360; const float* mun = in[I_MUN] + e * 3360; const float* kkw = in[I_KK] + e * 1024;
    const float* qn = in[I_QN] + e * 512; const float* kvn = in[I_KVN] + e * 256;
    for (int row = C.gw; row < MKV; row += C.NGW) {
        if (row >= MT) {
            const int rr = row - MT, b = rr >> 8, p = rr & 255;
            const float* cs = in[I_CCKV] + ((size_t)(b * 2 + e) * 256 + p) * 256;
#pragma unroll
            for (int i = 0; i < 4; ++i) CKV[(size_t)row * 256 + 64 * i + lane] = (bf16)f2bf(cs[64 * i + lane]);
            KR[(size_t)row * 64 + lane] = (bf16)f2bf(in[I_CKR][((size_t)(b * 2 + e) * 256 + p) * 64 + rope_src(lane)]);
            continue;
        }
        const bool smp = row >= MP; const int T = smp ? 4096 : 256; const int t = smp ? ((row - MP) & 4095) : (row & 255);
        const float* z = Z + (size_t)row * ZE_P; const bool hp = t > 0, hn = t < T - 1;
        float* sc = SC + (size_t)row * SCAN_P;
#define ZMIX4(c) ({ const f32x4v zc_ = *(const f32x4v*)(z + (c)); const f32x4v zp_ = hp ? *(const f32x4v*)(z + (c) - ZE_P) : (f32x4v){0.f, 0.f, 0.f, 0.f}; const f32x4v zn_ = hn ? *(const f32x4v*)(z + (c) + ZE_P) : (f32x4v){0.f, 0.f, 0.f, 0.f}; \
            zc_ + *(const f32x4v*)(mup + (c)) * (zp_ - zc_) + *(const f32x4v*)(mun + (c)) * (zn_ - zc_); })
#define ZMIX(c) ({ const float zc_ = z[c]; const float zp_ = hp ? z[(c) - ZE_P] : 0.f; const float zn_ = hn ? z[(c) + ZE_P] : 0.f; zc_ + mup[c] * (zp_ - zc_) + mun[c] * (zn_ - zc_); })
#pragma unroll
        for (int i = 0; i < 4; ++i) { const int c = 256 * i + 4 * lane;
            *(f32x4v*)(sc + c) = ZMIX4(c);
            *(f32x4v*)(sc + 1024 + c) = ZMIX4(2048 + c);
            const f32x4v k = ZMIX4(1024 + c); *(f32x4v*)(KB + (size_t)row * 1024 + c) = k;
            const f32x4v kk = k * *(const f32x4v*)(kkw + c); float ss = (kk.x * kk.x + kk.y * kk.y) + (kk.z * kk.z + kk.w * kk.w);
            ss += dpp_f<0xB1>(ss); ss += dpp_f<0x4E>(ss); ss += dpp_f<0x141>(ss); ss += dpp_f<0x140>(ss);
            *(f32x4v*)(sc + 2048 + c) = kk * (1.0f / fmaxf(sqrtf(ss), 1e-12f)); }
        bf16* la = LA + (size_t)row * 384;
        la[lane] = (bf16)f2bf(tanhf(ZMIX(3072 + lane)));
        la[64 + lane] = (bf16)f2bf(ZMIX(3136 + lane));
        la[128 + lane] = (bf16)f2bf(sigmoid_f(ZMIX(3200 + lane)));
        la[192 + lane] = (bf16)f2bf(sigmoid_f(ZMIX(3264 + lane)));
        { float xg = 0.f; if (lane < 32) xg = sigmoid_f(ZMIX(3328 + lane)); la[256 + lane] = (bf16)(lane < 32 ? f2bf(xg) : 0u); la[320 + lane] = 0; }
#undef ZMIX4
#undef ZMIX
        float cq[8], ss = 0.f;
#pragma unroll
        for (int i = 0; i < 8; ++i) { cq[i] = z[3360 + 64 * i + lane]; ss += cq[i] * cq[i]; }
        float rstd = 1.0f / sqrtf(wave_sum(ss) * (1.0f / 512.0f) + 1e-6f);
#pragma unroll
        for (int i = 0; i < 8; ++i) CQ[(size_t)row * 512 + 64 * i + lane] = (bf16)f2bf(cq[i] * rstd * qn[64 * i + lane]);
        float ck[4]; ss = 0.f;
#pragma unroll
        for (int i = 0; i < 4; ++i) { ck[i] = z[3872 + 64 * i + lane]; ss += ck[i] * ck[i]; }
        rstd = 1.0f / sqrtf(wave_sum(ss) * (1.0f / 256.0f) + 1e-6f);
#pragma unroll
        for (int i = 0; i < 4; ++i) { const float y = ck[i] * rstd * kvn[64 * i + lane]; CKV[(size_t)row * 256 + 64 * i + lane] = (bf16)f2bf(y);
            if (!smp) C.out[OUT_CKV + ((size_t)((row >> 8) * 2 + e) * 256 + t) * 256 + 64 * i + lane] = y; }
        const float kr = z[4128 + lane];
        if (!smp) { C.out[OUT_KR + ((size_t)((row >> 8) * 2 + e) * 256 + t) * 64 + lane] = kr; KR[(size_t)row * 64 + lane] = (bf16)f2bf(shfl_idx(kr, rope_src(lane))); }
        else { const int hf = lane >> 5, jj = lane & 15, e2 = (lane >> 4) & 1; const int pos = hf ? (t & 63) : (t >> 6);
            const float xo = shfl_idx(kr, lane ^ 16); const float2 cs = *(const float2*)(rope + (pos * 16 + jj) * 2);
            const float rot = e2 == 0 ? kr * cs.x - xo * cs.y : kr * cs.x + xo * cs.y;
            KR[(size_t)row * 64 + lane] = (bf16)f2bf(shfl_idx(rot, rope_src(lane))); }
    }
}

template <int N> DI float fmac_bc(float acc, float op, float s) { asm("v_fmac_f32_dpp %0, %1, %2 row_newbcast:%3 row_mask:0xf bank_mask:0xf" : "+v"(acc) : "v"(op), "v"(s), "n"(N)); return acc; }
template <int N> DI float mul_bc(float op, float s) { float r; asm("v_mul_f32_dpp %0, %1, %2 row_newbcast:%3 row_mask:0xf bank_mask:0xf" : "=v"(r) : "v"(op), "v"(s), "n"(N)); return r; }
struct ScanOps { f32x4v kk, w, kka, kd, r; float vv; };
typedef __attribute__((__vector_size__(4 * sizeof(int)))) int rsrc_t;
DI f32x4v bl128(__amdgpu_buffer_rsrc_t r, unsigned vo, unsigned so) { return __builtin_bit_cast(f32x4v, __builtin_amdgcn_raw_buffer_load_b128(r, (int)vo, (int)so, 0)); }
DI float bl32(__amdgpu_buffer_rsrc_t r, unsigned vo, unsigned so) { return __builtin_bit_cast(float, __builtin_amdgcn_raw_buffer_load_b32(r, (int)vo, (int)so, 0)); }
template <int MODE> DI ScanOps scan_load(__amdgpu_buffer_rsrc_t rs, unsigned so, unsigned lo, unsigned lv, int d) {
    ScanOps o;
    o.kk = bl128(rs, lo + 2u * 4096u, so); o.w = bl128(rs, lo + (3u + (unsigned)d) * 4096u, so); o.kka = bl128(rs, lo + (5u + (unsigned)d) * 4096u, so);
    if (MODE != 0) { o.kd = bl128(rs, lo + (7u + (unsigned)d) * 4096u, so); o.vv = bl32(rs, lv + 4096u, so); } else { o.kd = (f32x4v){0.f, 0.f, 0.f, 0.f}; o.vv = 0.f; }
    if (MODE == 2) o.r = bl128(rs, lo, so); else o.r = (f32x4v){0.f, 0.f, 0.f, 0.f};
    return o;
}
template <int MODE, int J> DI void scan_col_a(const ScanOps& o, const float (&S)[64], float (&sa)[4]) { sa[J & 3] = fmac_bc<(J >> 2)>(sa[J & 3], o.kk[J & 3], S[J]); }
template <int MODE, int J> DI void scan_col_b(const ScanOps& o, float (&S)[64], float sa, float (&y)[4]) {
    float t = mul_bc<(J >> 2)>(o.w[J & 3], S[J]);
    t = fmac_bc<(J >> 2)>(t, o.kka[J & 3], sa);
    if (MODE != 0) t = fmac_bc<(J >> 2)>(t, o.kd[J & 3], o.vv);
    S[J] = t;
    if (MODE == 2) y[J & 3] = fmac_bc<(J >> 2)>(y[J & 3], o.r[J & 3], t);
}
template <int MODE, int... Js> DI float scan_step(const ScanOps& o, float (&S)[64], std::integer_sequence<int, Js...>) {
    float sa[4] = {0.f, 0.f, 0.f, 0.f}, y[4] = {0.f, 0.f, 0.f, 0.f};
    (scan_col_a<MODE, Js>(o, S, sa), ...);
    const float sat = -((sa[0] + sa[1]) + (sa[2] + sa[3]));
    (scan_col_b<MODE, Js>(o, S, sat, y), ...);
    return (y[0] + y[1]) + (y[2] + y[3]);
}
template <int MODE> DI void scan_wave(const float* SCp, int row0, int rstep, int nsteps, int h, int d, float (&S)[64], float* yout, int lane) {
    const __amdgpu_buffer_rsrc_t rs = __builtin_amdgcn_make_buffer_rsrc((void*)SCp, 0, (int)((size_t)MT * SCAN_P * 4), 0x00020000);
    const __amdgpu_buffer_rsrc_t ry = __builtin_amdgcn_make_buffer_rsrc((void*)yout, 0, (int)((size_t)MT * 1024 * 4), 0x00020000);
    const int so0 = (row0 * SCAN_P + h * 64) * 4, sstep = rstep * SCAN_P * 4, last = nsteps - 1;
    int yo = (row0 * 1024 + h * 64) * 4; const int ystep = rstep * 4096;
    const unsigned lo = 16u * (unsigned)(lane & 15), lv = 4u * (unsigned)lane;
#define SC_LD(s_) scan_load<MODE>(rs, (unsigned)(so0 + ((s_) < last ? (s_) : last) * sstep), lo, lv, d)
#define SC_ST(o_) do { const float y_ = scan_step<MODE>(o_, S, std::make_integer_sequence<int, 64>{}); if (MODE == 2) __builtin_amdgcn_raw_buffer_store_b32(__builtin_bit_cast(unsigned, y_), ry, (int)lv, yo, 0); yo += ystep; } while (0)
    ScanOps o0 = SC_LD(0), o1 = SC_LD(1), o2 = SC_LD(2), o3;
    for (int s = 0; s < nsteps; s += 4) {
        o3 = SC_LD(s + 3); SC_ST(o0);
        o0 = SC_LD(s + 4); SC_ST(o1);
        o1 = SC_LD(s + 5); SC_ST(o2);
        o2 = SC_LD(s + 6); SC_ST(o3);
    }
#undef SC_LD
#undef SC_ST
}
DI void phase_scan1(Ctx& C, int e, int qslot) {
    const float* SCp = (const float*)(C.ws + WS_SCAN + (size_t)e * SCAN_BYTES); float* PQ = (float*)(C.ws + WS_PQ); float* Y = (float*)(C.ws + WS_YSC);
    const int nit = 512 + 64 * (NCH - 1) * 2;
    unsigned* qctr = (unsigned*)(C.ws + WS_CTL) + 8192 + 64 * (e + 2 * qslot);
    for (;;) {
        unsigned itu = 0; if (C.lane == 0) itu = __hip_atomic_fetch_add(qctr, 1u, __ATOMIC_RELAXED, __HIP_MEMORY_SCOPE_AGENT);
        const int it = __builtin_amdgcn_readfirstlane((int)itu); if (it >= nit) break;
        int lane = C.lane; asm volatile("" : "+v"(lane));
        float S[64];
        if (it >= 512) { const int si = it - 512;
            const int kind = si & 1, c = (si >> 1) % (NCH - 1), sidx = (si >> 1) / (NCH - 1);        const int d = sidx & 1, h = (sidx >> 1) & 15, b = sidx >> 5;
            const int t0 = d ? 4095 - c * CHL : c * CHL; const int row0 = MP + b * 4096 + t0;
            float fl = (float)lane; asm volatile("" : "+v"(fl)); const float kf = kind == 0 ? 1.f : 0.f;
#pragma unroll
            for (int j = 0; j < 64; ++j) { S[j] = kf * fmaxf(0.f, 1.f - fabsf(fl - (float)j)); }
            if (kind == 0) scan_wave<0>(SCp, row0, d ? -1 : 1, CHL, h, d, S, nullptr, lane); else scan_wave<1>(SCp, row0, d ? -1 : 1, CHL, h, d, S, nullptr, lane);
            float* dst = PQ + (((size_t)sidx * NCH + c) * 2 + kind) * 4096 + lane * 64;
#pragma unroll
            for (int j = 0; j < 16; ++j) *(f32x4v*)(dst + 4 * j) = (f32x4v){S[4 * j], S[4 * j + 1], S[4 * j + 2], S[4 * j + 3]};
        } else {
            const int pi = it; const int d = pi & 1, h = (pi >> 1) & 15, b = pi >> 5;
#pragma unroll
            for (int j = 0; j < 64; ++j) S[j] = 0.f;
            scan_wave<2>(SCp, b * 256 + (d ? 255 : 0), d ? -1 : 1, 128, h, d, S, Y + (size_t)d * MT * 1024, lane);
            float* dst = (float*)(C.ws + WS_PST) + (size_t)pi * 4096 + lane * 64;
#pragma unroll
            for (int j = 0; j < 16; ++j) *(f32x4v*)(dst + 4 * j) = (f32x4v){S[4 * j], S[4 * j + 1], S[4 * j + 2], S[4 * j + 3]};
        }
    }
}
DI void phase_scan_carry(Ctx& C, int e, int nsw) {
    const float* PQ = (const float*)(C.ws + WS_PQ); float* SST = (float*)(C.ws + WS_SST);
    LAS float* Ss = (LAS float*)C.lds;
    LAS float* Ps = (LAS float*)(C.lds + 64 * 65 * 4 + 64);
    for (int sidx = C.bx; sidx < 64; sidx += C.G) {
        const int d = sidx & 1, h = (sidx >> 1) & 15, b = sidx >> 5; const int row = C.tid & 63, cg = C.wave;
        const float* s0 = C.in[I_ST] + ((((size_t)b * 2 + e) * 2 + d) * 16 + h) * 4096;
        __syncthreads();
        for (int i = C.tid; i < 4096; i += 512) { const float v = s0[i]; Ss[(i >> 6) * 65 + (i & 63)] = v; SST[((size_t)sidx * NCH) * 4096 + i] = v; }
        const float* PQs = PQ + (size_t)sidx * NCH * 2 * 4096;
        f32x4v pp0 = *(const f32x4v*)(PQs + 4 * C.tid), pp1 = *(const f32x4v*)(PQs + 2048 + 4 * C.tid);
        f32x4v qq0 = *(const f32x4v*)(PQs + 4096 + row * 64 + cg * 8), qq1 = *(const f32x4v*)(PQs + 4096 + row * 64 + cg * 8 + 4);
        for (int c = 0; c + 1 < NCH; ++c) {
            __syncthreads();
            *(LAS f32x4v*)(Ps + 4 * C.tid) = pp0; *(LAS f32x4v*)(Ps + 2048 + 4 * C.tid) = pp1;
            float o[8] = {qq0.x, qq0.y, qq0.z, qq0.w, qq1.x, qq1.y, qq1.z, qq1.w};
            if (c + 2 < NCH) { const float* nx = PQs + (size_t)(c + 1) * 2 * 4096;
                pp0 = *(const f32x4v*)(nx + 4 * C.tid); pp1 = *(const f32x4v*)(nx + 2048 + 4 * C.tid);
                qq0 = *(const f32x4v*)(nx + 4096 + row * 64 + cg * 8); qq1 = *(const f32x4v*)(nx + 4096 + row * 64 + cg * 8 + 4); }
            __syncthreads();
            for (int k = 0; k < 64; ++k) { const float sv = Ss[row * 65 + k]; const f32x4v p0 = *(const LAS f32x4v*)(Ps + k * 64 + cg * 8), p1 = *(const LAS f32x4v*)(Ps + k * 64 + cg * 8 + 4);
                o[0] += sv * p0.x; o[1] += sv * p0.y; o[2] += sv * p0.z; o[3] += sv * p0.w; o[4] += sv * p1.x; o[5] += sv * p1.y; o[6] += sv * p1.z; o[7] += sv * p1.w; }
            __syncthreads();
            float* dst = SST + ((size_t)sidx * NCH + c + 1) * 4096 + row * 64 + cg * 8;
#pragma unroll
            for (int i = 0; i < 8; ++i) Ss[row * 65 + cg * 8 + i] = o[i];
            *(f32x4v*)dst = (f32x4v){o[0], o[1], o[2], o[3]}; *(f32x4v*)(dst + 4) = (f32x4v){o[4], o[5], o[6], o[7]};
        }
    }
    {
        const int nb0 = C.G > 64 ? 64 : 0; const float* SCp = (const float*)(C.ws + WS_SCAN + (size_t)e * SCAN_BYTES); float* Y = (float*)(C.ws + WS_YSC);
        if (C.bx >= nb0 && C.wave < nsw) for (int pi = (C.bx - nb0) * nsw + C.wave; pi < 512; pi += (C.G - nb0) * nsw) {
            int lane = C.lane; asm volatile("" : "+v"(lane));
            const int d = pi & 1, h = (pi >> 1) & 15, b = pi >> 5;
            float S[64]; const float* src = (const float*)(C.ws + WS_PST) + (size_t)pi * 4096 + lane * 64;
#pragma unroll
            for (int j = 0; j < 16; ++j) { const f32x4v t = *(const f32x4v*)(src + 4 * j); S[4 * j] = t.x; S[4 * j + 1] = t.y; S[4 * j + 2] = t.z; S[4 * j + 3] = t.w; }
            scan_wave<2>(SCp, b * 256 + (d ? 127 : 128), d ? -1 : 1, 128, h, d, S, Y + (size_t)d * MT * 1024, lane);
            float* dst = C.out + OUT_ST + ((((size_t)b * 2 + e) * 2 + d) * 16 + h) * 4096 + lane * 64;
#pragma unroll
            for (int j = 0; j < 16; ++j) *(f32x4v*)(dst + 4 * j) = (f32x4v){S[4 * j], S[4 * j + 1], S[4 * j + 2], S[4 * j + 3]};
        }
    }
}
DI void phase_scan3(Ctx& C, int e) {
    const float* SCp = (const float*)(C.ws + WS_SCAN + (size_t)e * SCAN_BYTES); const float* SST = (const float*)(C.ws + WS_SST); float* Y = (float*)(C.ws + WS_YSC);
    for (int it = C.gw; it < 64 * NCH; it += C.NGW) {
        int lane = C.lane; asm volatile("" : "+v"(lane));
        const int c = it % NCH, sidx = it / NCH; const int d = sidx & 1, h = (sidx >> 1) & 15, b = sidx >> 5;
        const int t0 = d ? 4095 - c * CHL : c * CHL; const int row0 = MP + b * 4096 + t0;
        float S[64]; const float* src = SST + ((size_t)sidx * NCH + c) * 4096 + lane * 64;
#pragma unroll
        for (int j = 0; j < 16; ++j) { const f32x4v t = *(const f32x4v*)(src + 4 * j); S[4 * j] = t.x; S[4 * j + 1] = t.y; S[4 * j + 2] = t.z; S[4 * j + 3] = t.w; }
        scan_wave<2>(SCp, row0, d ? -1 : 1, CHL, h, d, S, Y + (size_t)d * MT * 1024, lane);
    }
}
DI float row16_sum(float v) { v += dpp_f<0xB1>(v); v += dpp_f<0x4E>(v); v += dpp_f<0x141>(v); v += dpp_f<0x140>(v); return v; }
DI void phase_rwkv_post(Ctx& C, int e) {
    const float* SCp = (const float*)(C.ws + WS_SCAN + (size_t)e * SCAN_BYTES); const float* Y = (const float*)(C.ws + WS_YSC); const float* GB = (const float*)(C.ws + WS_GB); bf16* MIX = (bf16*)(C.ws + WS_MIX);
    const float* rk = C.in[I_RK] + e * 1024; const float* gw = C.in[I_GNW] + e * 1024; const float* gb = C.in[I_GNB] + e * 1024; const int lane = C.lane;
    for (int row = C.gw; row < MT; row += C.NGW) {
        const float* sc = SCp + (size_t)row * SCAN_P;
#pragma unroll
        for (int i = 0; i < 4; ++i) { const int c = 256 * i + 4 * lane;
            const f32x4v y = *(const f32x4v*)(Y + (size_t)row * 1024 + c) + *(const f32x4v*)(Y + ((size_t)MT + row) * 1024 + c);
            const float mu = row16_sum((y.x + y.y) + (y.z + y.w)) * (1.0f / 64.0f); const f32x4v dl = y - mu;
            const float var = row16_sum((dl.x * dl.x + dl.y * dl.y) + (dl.z * dl.z + dl.w * dl.w)) * (1.0f / 64.0f);
            const f32x4v yn = dl * (1.0f / sqrtf(var + 64e-5f));
            const f32x4v rr = *(const f32x4v*)(sc + c), kd = *(const f32x4v*)(sc + 7 * 1024 + c) + *(const f32x4v*)(sc + 8 * 1024 + c), rkv = *(const f32x4v*)(rk + c); const f32x4v pb = rr * kd * rkv;
            const float bs = row16_sum((pb.x + pb.y) + (pb.z + pb.w));
            const f32x4v o = (yn * *(const f32x4v*)(gw + c) + *(const f32x4v*)(gb + c) + *(const f32x4v*)(sc + 1024 + c) * bs) * *(const f32x4v*)(GB + (size_t)row * 1024 + c);
            v2u w; w.x = pk2(o.x, o.y); w.y = pk2(o.z, o.w); *(v2u*)(MIX + (size_t)row * 2048 + c) = w; }
    }
}

constexpr int AT_KP = 200, AT_VP = 72, AT_KB = 64 * AT_KP * 2, AT_VB = 128 * AT_VP * 2, AT_BUF = AT_KB + AT_VB;
DI void attn_unit(Ctx& C, const bf16* Qb, const bf16* KN, const bf16* KRb, const bf16* VTh  , int vpitch, bf16* MIX, int qrow0, int h, int krow0, int nlat, int crow0, int ntile) {
    int tid = C.tid; asm volatile("" : "+v"(tid)); const int lane = tid & 63, r = lane & 31, hh = lane >> 5;
    LAS unsigned char* lds = C.lds;
    s16x8v qf[12];
    { const bf16* qp = Qb + (size_t)(qrow0 + C.wave * 32 + r) * 1536 + h * 192 + 8 * hh;
#pragma unroll
      for (int s = 0; s < 12; ++s) qf[s] = *(const s16x8v*)(qp + 16 * s); }
    f32x16v o[4];
#pragma unroll
    for (int vb = 0; vb < 4; ++vb)
#pragma unroll
        for (int i = 0; i < 16; ++i) o[vb][i] = 0.f;
    float mrun = -INFINITY, lsum = 0.f;
    v4u pre[5];
    auto issue = [&](int j) {
        const int k0 = 64 * j; const int rbase = k0 < nlat ? krow0 + k0 : crow0 + (k0 - nlat);
#pragma unroll
        for (int i = 0; i < 3; ++i) { const int p = tid + 512 * i, key = p / 24, pc = p % 24; const size_t rw = (size_t)(rbase + key);
            pre[i] = pc < 16 ? *(const v4u*)(KN + rw * 1024 + h * 128 + pc * 8) : *(const v4u*)(KRb + rw * 64 + (pc - 16) * 8); }
#pragma unroll
        for (int i = 0; i < 2; ++i) { const int p = tid + 512 * i, dv = p >> 3, pc = p & 7; pre[3 + i] = *(const v4u*)(VTh + (size_t)dv * vpitch + k0 + pc * 8); }
    };
    auto commit = [&](int buf) {
        LAS unsigned char* kb = lds + buf * AT_BUF; LAS unsigned char* vbp = kb + AT_KB;
#pragma unroll
        for (int i = 0; i < 3; ++i) { const int p = tid + 512 * i, key = p / 24, pc = p % 24; *(LAS v4u*)(kb + key * (AT_KP * 2) + pc * 16) = pre[i]; }
#pragma unroll
        for (int i = 0; i < 2; ++i) { const int p = tid + 512 * i, dv = p >> 3, pc = p & 7; *(LAS v4u*)(vbp + dv * (AT_VP * 2) + pc * 16) = pre[3 + i]; }
    };
    __syncthreads();
    issue(0); commit(0); __syncthreads();
    for (int j = 0; j < ntile; ++j) {
        if (j + 1 < ntile) issue(j + 1);
        const LAS unsigned char* kb = lds + (j & 1) * AT_BUF; const LAS unsigned char* vbp = kb + AT_KB;
        f32x16v st[2];
        __builtin_amdgcn_s_setprio(1);
#pragma unroll
        for (int kbk = 0; kbk < 2; ++kbk) {
#pragma unroll
            for (int i = 0; i < 16; ++i) st[kbk][i] = 0.f;
#pragma unroll
            for (int s = 0; s < 12; ++s) { const s16x8v a = *(const LAS s16x8v*)(kb + (32 * kbk + r) * (AT_KP * 2) + (16 * s + 8 * hh) * 2);
                st[kbk] = __builtin_amdgcn_mfma_f32_32x32x16_bf16(a, qf[s], st[kbk], 0, 0, 0); }
        }
        __builtin_amdgcn_s_setprio(0);
        float mx = st[0][0];
#pragma unroll
        for (int i = 1; i < 16; ++i) mx = fmaxf(mx, st[0][i]);
#pragma unroll
        for (int i = 0; i < 16; ++i) mx = fmaxf(mx, st[1][i]);
        mx = fmaxf(mx, shfl_idx(mx, lane ^ 32));
        const float mnew = fmaxf(mrun, mx); const float alpha = __builtin_amdgcn_exp2f(mrun - mnew); mrun = mnew;
        float ps = 0.f;
#pragma unroll
        for (int kbk = 0; kbk < 2; ++kbk)
#pragma unroll
            for (int i = 0; i < 16; ++i) { const float p = __builtin_amdgcn_exp2f(st[kbk][i] - mnew); st[kbk][i] = p; ps += p; }
        lsum = lsum * alpha + ps;
        if (__builtin_amdgcn_ballot_w64(alpha != 1.0f) != 0ull) {
#pragma unroll
            for (int vb = 0; vb < 4; ++vb)
#pragma unroll
                for (int i = 0; i < 16; ++i) o[vb][i] *= alpha; }
        __builtin_amdgcn_s_setprio(1);
#pragma unroll
        for (int kbk = 0; kbk < 2; ++kbk)
#pragma unroll
            for (int s2 = 0; s2 < 2; ++s2) {
                v4u pw; pw.x = pg8::cvt_pk_bf16(st[kbk][8 * s2 + 0], st[kbk][8 * s2 + 1]); pw.y = pg8::cvt_pk_bf16(st[kbk][8 * s2 + 2], st[kbk][8 * s2 + 3]); pw.z = pg8::cvt_pk_bf16(st[kbk][8 * s2 + 4], st[kbk][8 * s2 + 5]); pw.w = pg8::cvt_pk_bf16(st[kbk][8 * s2 + 6], st[kbk][8 * s2 + 7]);
                const s16x8v pf = __builtin_bit_cast(s16x8v, pw);
#pragma unroll
                for (int vb = 0; vb < 4; ++vb) { const LAS unsigned char* vp = vbp + (32 * vb + r) * (AT_VP * 2) + (32 * kbk + 16 * s2 + 4 * hh) * 2;
                    const v2u lo = *(const LAS v2u*)vp, hi = *(const LAS v2u*)(vp + 16); const v4u av = {lo.x, lo.y, hi.x, hi.y};
                    o[vb] = __builtin_amdgcn_mfma_f32_32x32x16_bf16(__builtin_bit_cast(s16x8v, av), pf, o[vb], 0, 0, 0); }
            }
        __builtin_amdgcn_s_setprio(0);
        if (j + 1 < ntile) commit((j + 1) & 1);
        __syncthreads();
    }
    const float inv = 1.0f / (lsum + shfl_idx(lsum, lane ^ 32));
    bf16* op = MIX + (size_t)(qrow0 + C.wave * 32 + r) * 2048 + 1024 + h * 128 + 4 * hh;
#pragma unroll
    for (int vb = 0; vb < 4; ++vb)
#pragma unroll
        for (int g = 0; g < 4; ++g) { v2u w; w.x = pk2(o[vb][4 * g] * inv, o[vb][4 * g + 1] * inv); w.y = pk2(o[vb][4 * g + 2] * inv, o[vb][4 * g + 3] * inv);
            *(v2u*)(op + 32 * vb + 8 * g) = w; }
}
DI void phase_attention(Ctx& C) {
    unsigned char* ws = C.ws; const bf16* Qb = (const bf16*)(ws + WS_Q); const bf16* KN = (const bf16*)(ws + WS_KN); const bf16* KRb = (const bf16*)(ws + WS_KR); bf16* MIX = (bf16*)(ws + WS_MIX);
    const bf16* VTp = (const bf16*)(ws + WS_VT); const bf16* VTs = (const bf16*)(ws + WS_VT + VT_S_OFF);
    for (int u = C.bx; u < 256 + 128; u += C.G) {
        if (u < 256) { const int qb = u & 15, h = (u >> 4) & 7, b = u >> 7;
            attn_unit(C, Qb, KN, KRb, VTs + ((size_t)b * 1024 + h * 128) * 4352, 4352, MIX, MP + b * 4096 + qb * 256, h, MP + b * 4096, 4096, MT + b * 256, 68); }
        else { const int v = u - 256, h = v & 7, b = v >> 3;
            attn_unit(C, Qb, KN, KRb, VTp + ((size_t)b * 1024 + h * 128) * 256, 256, MIX, b * 256, h, b * 256, 256, 0, 4); }
    }
    __syncthreads();
}

DI f32x2v mk2(float a, float b) { return (f32x2v){a, b}; }
DI f32x2v cmul(f32x2v a, f32x2v b) { const f32x2v t = {-b.y, b.x}; return a.x * b + a.y * t; }
DI f32x2v cmulc(f32x2v a, f32x2v b) { const f32x2v t = {b.y, -b.x}; return a.x * b + a.y * t; }
DI f32x2v mul_mi(f32x2v a) { return mk2(a.y, -a.x); }
DI f32x2v mul_pi(f32x2v a) { return mk2(-a.y, a.x); }
DI f32x2v twid(int p, int den) { const float fr = (float)p / (float)den; return mk2(__builtin_amdgcn_cosf(fr), __builtin_amdgcn_sinf(fr)); }
DI int PD(int i) { return i + ((i >> 5) << 1); }
constexpr int FFT_BS = 8192 + 512, FFT_BUF_BYTES = FFT_BS * 8;
DI void bf4_fwd(f32x2v& x0, f32x2v& x1, f32x2v& x2, f32x2v& x3, f32x2v w0, f32x2v wm) {
    const f32x2v a0 = x0 + x2, a2 = cmul(x0 - x2, w0), a1 = x1 + x3, a3 = cmul(x1 - x3, mul_mi(w0));
    x0 = a0 + a1; x1 = cmul(a0 - a1, wm); x2 = a2 + a3; x3 = cmul(a2 - a3, wm);
}
DI void bf4_inv(f32x2v& x0, f32x2v& x1, f32x2v& x2, f32x2v& x3, f32x2v wa, f32x2v w) {
    const f32x2v t1 = cmul(x1, w), t3 = cmul(x3, w);
    const f32x2v a0 = x0 + t1, a1 = x0 - t1, a2 = x2 + t3, a3 = x2 - t3;
    const f32x2v t2 = cmul(a2, wa), t3b = cmul(a3, mul_pi(wa));
    x0 = a0 + t2; x1 = a1 + t3b; x2 = a0 - t2; x3 = a1 - t3b;
}
template <int N, int M, int NI = 1> DI void fft_fwd_pass(LAS f32x2v* buf, int tid) {
    constexpr int S = M / 8;
    const int tr = tid / (N / 16), u = tid % (N / 16), g = u / S, p = u % S; const int base = tr * N + g * 2 * M + p;
    f32x2v e[NI][16];
#pragma unroll
    for (int j = 0; j < NI; ++j)
#pragma unroll
        for (int k = 0; k < 16; ++k) e[j][k] = buf[j * FFT_BS + PD(base + k * S)];
    const f32x2v bc = twid(p, 2 * M); const f32x2v b1 = mk2(bc.x, -bc.y), b2 = cmul(b1, b1), b4 = cmul(b2, b2), b8 = cmul(b4, b4);
    constexpr float C1 = 0.92387953251128674f, S1 = 0.38268343236508977f, R2 = 0.70710678118654752f;
    const f32x2v w1a = cmul(b1, mk2(C1, -S1)), w1b = cmul(b2, mk2(R2, -R2)), w2a = cmul(b1, mk2(R2, -R2)), w2b = mul_mi(b2), w3a = cmul(b1, mk2(S1, -C1)), w3b = cmul(b2, mk2(-R2, -R2));
#pragma unroll
    for (int j = 0; j < NI; ++j) {
        bf4_fwd(e[j][0], e[j][4], e[j][8], e[j][12], b1, b2);
        bf4_fwd(e[j][1], e[j][5], e[j][9], e[j][13], w1a, w1b);
        bf4_fwd(e[j][2], e[j][6], e[j][10], e[j][14], w2a, w2b);
        bf4_fwd(e[j][3], e[j][7], e[j][11], e[j][15], w3a, w3b);
#pragma unroll
        for (int q = 0; q < 4; ++q) bf4_fwd(e[j][4 * q], e[j][4 * q + 1], e[j][4 * q + 2], e[j][4 * q + 3], b4, b8);
#pragma unroll
        for (int k = 0; k < 16; ++k) buf[j * FFT_BS + PD(base + k * S)] = e[j][k];
    }
    __syncthreads();
    if constexpr (M / 16 >= 32) fft_fwd_pass<N, M / 16, NI>(buf, tid);
}
constexpr float c32q(int k) { return k == 0 ? 1.f : k == 1 ? 0.98078528040323043f : k == 2 ? 0.92387953251128674f : k == 3 ? 0.83146961230254524f : k == 4 ? 0.70710678118654752f : k == 5 ? 0.55557023301960218f : k == 6 ? 0.38268343236508977f : k == 7 ? 0.19509032201612825f : 0.f; }
constexpr float c32(int k) { return k <= 8 ? c32q(k) : -c32q(16 - k); }
constexpr float s32(int k) { return k <= 8 ? c32q(8 - k) : c32q(k - 8); }
DI void bf4_fwd_t(f32x2v& x0, f32x2v& x1, f32x2v& x2, f32x2v& x3) {
    const f32x2v a0 = x0 + x2, a2 = x0 - x2, a1 = x1 + x3, a3 = mul_mi(x1 - x3);
    x0 = a0 + a1; x1 = a0 - a1; x2 = a2 + a3; x3 = a2 - a3;
}
DI void bf4_fwd_b1(f32x2v& x0, f32x2v& x1, f32x2v& x2, f32x2v& x3) {
    constexpr float R2 = 0.70710678118654752f;
    const f32x2v a0 = x0 + x2, a2 = cmul(x0 - x2, mk2(R2, -R2)), a1 = x1 + x3, a3 = cmul(x1 - x3, mk2(-R2, -R2));
    x0 = a0 + a1; x1 = mul_mi(a0 - a1); x2 = a2 + a3; x3 = mul_mi(a2 - a3);
}
DI void bf4_inv_t(f32x2v& x0, f32x2v& x1, f32x2v& x2, f32x2v& x3) {
    const f32x2v a0 = x0 + x1, a1 = x0 - x1, a2 = x2 + x3, a3 = x2 - x3; const f32x2v t3b = mul_pi(a3);
    x0 = a0 + a2; x1 = a1 + t3b; x2 = a0 - a2; x3 = a1 - t3b;
}
DI void bf4_inv_b1(f32x2v& x0, f32x2v& x1, f32x2v& x2, f32x2v& x3) {
    constexpr float R2 = 0.70710678118654752f;
    const f32x2v t1 = mul_pi(x1), t3 = mul_pi(x3); const f32x2v a0 = x0 + t1, a1 = x0 - t1, a2 = x2 + t3, a3 = x2 - t3;
    const f32x2v t2 = cmul(a2, mk2(R2, R2)), t3b = cmul(a3, mk2(-R2, R2));
    x0 = a0 + t2; x1 = a1 + t3b; x2 = a0 - t2; x3 = a1 - t3b;
}
template <int NI> DI void fft_r32_fwd(LAS f32x2v* buf, int tid) {
    const int img = tid >> 8, g = tid & 255;
    if (img < NI) {
        LAS f32x4v* p = (LAS f32x4v*)(buf + img * FFT_BS + 34 * g);
        f32x2v r[32];
#pragma unroll
        for (int m = 0; m < 16; ++m) { const f32x4v v = p[m]; r[2 * m] = mk2(v.x, v.y); r[2 * m + 1] = mk2(v.z, v.w); }
        bf4_fwd_t(r[0], r[8], r[16], r[24]);
#pragma unroll
        for (int j = 1; j < 8; ++j) bf4_fwd(r[j], r[j + 8], r[j + 16], r[j + 24], mk2(c32(j), -s32(j)), mk2(c32(2 * j), -s32(2 * j)));
#pragma unroll
        for (int q = 0; q < 4; ++q) { bf4_fwd_t(r[8 * q], r[8 * q + 2], r[8 * q + 4], r[8 * q + 6]); bf4_fwd_b1(r[8 * q + 1], r[8 * q + 3], r[8 * q + 5], r[8 * q + 7]); }
#pragma unroll
        for (int m = 0; m < 16; ++m) { const f32x2v a = r[2 * m] + r[2 * m + 1], b = r[2 * m] - r[2 * m + 1]; p[m] = (f32x4v){a.x, a.y, b.x, b.y}; }
    }
    __syncthreads();
}
template <int NI> DI void fft_r32_inv(LAS f32x2v* buf, int tid) {
    const int img = tid >> 8, g = tid & 255;
    if (img < NI) {
        LAS f32x4v* p = (LAS f32x4v*)(buf + img * FFT_BS + 34 * g);
        f32x2v r[32];
#pragma unroll
        for (int m = 0; m < 16; ++m) { const f32x4v v = p[m]; r[2 * m] = mk2(v.x + v.z, v.y + v.w); r[2 * m + 1] = mk2(v.x - v.z, v.y - v.w); }
#pragma unroll
        for (int q = 0; q < 4; ++q) { bf4_inv_t(r[8 * q], r[8 * q + 2], r[8 * q + 4], r[8 * q + 6]); bf4_inv_b1(r[8 * q + 1], r[8 * q + 3], r[8 * q + 5], r[8 * q + 7]); }
        bf4_inv_t(r[0], r[8], r[16], r[24]);
#pragma unroll
        for (int j = 1; j < 8; ++j) bf4_inv(r[j], r[j + 8], r[j + 16], r[j + 24], mk2(c32(j), s32(j)), mk2(c32(2 * j), s32(2 * j)));
#pragma unroll
        for (int m = 0; m < 16; ++m) p[m] = (f32x4v){r[2 * m].x, r[2 * m].y, r[2 * m + 1].x, r[2 * m + 1].y};
    }
    __syncthreads();
}
template <int N, int NI = 1> DI void fft_fwd(LAS f32x2v* buf, int tid) {
    asm volatile("" : "+v"(tid));
    fft_fwd_pass<N, N / 2, NI>(buf, tid);
    fft_r32_fwd<NI>(buf, tid);
}
template <int N, int M, int NI = 1, bool REC = true> DI void fft_inv_pass(LAS f32x2v* buf, int tid) {
    const int tr = tid / (N / 16), u = tid % (N / 16), g = u / M, p = u % M; const int base = tr * N + g * 16 * M + p;
    f32x2v e[NI][16];
#pragma unroll
    for (int j = 0; j < NI; ++j)
#pragma unroll
        for (int k = 0; k < 16; ++k) e[j][k] = buf[j * FFT_BS + PD(base + k * M)];
    const f32x2v a1 = twid(p, 16 * M), a2 = cmul(a1, a1), a4 = cmul(a2, a2), a8 = cmul(a4, a4);
    constexpr float C1 = 0.92387953251128674f, S1 = 0.38268343236508977f, R2 = 0.70710678118654752f;
    const f32x2v v1a = cmul(a1, mk2(C1, S1)), v1b = cmul(a2, mk2(R2, R2)), v2a = cmul(a1, mk2(R2, R2)), v2b = mul_pi(a2), v3a = cmul(a1, mk2(S1, C1)), v3b = cmul(a2, mk2(-R2, R2));
#pragma unroll
    for (int j = 0; j < NI; ++j) {
#pragma unroll
        for (int q = 0; q < 4; ++q) bf4_inv(e[j][4 * q], e[j][4 * q + 1], e[j][4 * q + 2], e[j][4 * q + 3], a4, a8);
        bf4_inv(e[j][0], e[j][4], e[j][8], e[j][12], a1, a2);
        bf4_inv(e[j][1], e[j][5], e[j][9], e[j][13], v1a, v1b);
        bf4_inv(e[j][2], e[j][6], e[j][10], e[j][14], v2a, v2b);
        bf4_inv(e[j][3], e[j][7], e[j][11], e[j][15], v3a, v3b);
#pragma unroll
        for (int k = 0; k < 16; ++k) buf[j * FFT_BS + PD(base + k * M)] = e[j][k];
    }
    __syncthreads();
    if constexpr (REC && 16 * M < N) fft_inv_pass<N, 16 * M, NI>(buf, tid);
}
template <int N, int NI = 1> DI void fft_inv(LAS f32x2v* buf, int tid) {
    asm volatile("" : "+v"(tid));
    fft_r32_inv<NI>(buf, tid);
    fft_inv_pass<N, 32, NI>(buf, tid);
}
DI v2u ks_pack(float a, float b, float cc, float d) { v2u w; w.x = __builtin_bit_cast(unsigned, __builtin_amdgcn_cvt_pkrtz(a, b)); w.y = __builtin_bit_cast(unsigned, __builtin_amdgcn_cvt_pkrtz(cc, d)); return w; }
DI f32x4v ks_unpack(v2u w) { return (f32x4v){h2f((unsigned short)(w.x & 0xffffu)), h2f((unsigned short)(w.x >> 16)), h2f((unsigned short)(w.y & 0xffffu)), h2f((unsigned short)(w.y >> 16))}; }
template <int N> DI int ks_perm(int e) { if constexpr (N == 8192) return e < 4096 ? (((e & 63) << 6) | (e >> 6)) : e; else return e; }
template <int N, int NI> DI void fft_pairmul_pre(LAS f32x2v* buf, const v2u (&ksr)[8], const v2u* KS, int tid) {
    asm volatile("" : "+v"(tid));
    constexpr int LOG = (N == 8192) ? 13 : 9, NB = 8192 / N, NK = N / 2 + 1;
#pragma unroll
    for (int r = 0; r < 9; ++r) {
        const int idx = tid + 512 * r;
        if (r == 8 && idx >= NB * NK) break;
        v2u kw; if (r < 8) kw = ksr[r]; else kw = KS[idx]; const f32x4v ks = ks_unpack(kw);
        const int tr = idx / NK, k = ks_perm<N>(idx % NK);
        const int pk = PD(tr * N + (int)(__brev((unsigned)k) >> (32 - LOG))), pn = PD(tr * N + (int)(__brev((unsigned)((N - k) & (N - 1))) >> (32 - LOG)));
#pragma unroll
        for (int j = 0; j < NI; ++j) {
            const f32x2v zk = buf[j * FFT_BS + pk], zn = buf[j * FFT_BS + pn];
            constexpr float hn_ = 0.5f / (float)N; const f32x2v u1 = mk2(hn_ * (zk.x + zn.x), hn_ * (zk.y - zn.y)), u2 = mk2(hn_ * (zk.y + zn.y), -hn_ * (zk.x - zn.x));
            const f32x2v y1 = cmul(u1, mk2(ks.x, ks.y)), y2 = cmul(u2, mk2(ks.z, ks.w));
            buf[j * FFT_BS + pk] = mk2(y1.x - y2.y, y1.y + y2.x);
            if (pn != pk) buf[j * FFT_BS + pn] = mk2(y1.x + y2.y, -y1.y + y2.x);
        }
    }
}
template <int N, int NI> DI void fft_fwd_first(LAS f32x2v* buf, int tid, const float (&u0)[NI][8], const float (&u1)[NI][8]) {
    asm volatile("" : "+v"(tid));
    constexpr int M = N / 2, S = M / 8;
    const int tr = tid / (N / 16), p = tid % (N / 16); const int base = tr * N + p;
    const f32x2v bc = twid(p, 2 * M); const f32x2v b1 = mk2(bc.x, -bc.y), b2 = cmul(b1, b1), b4 = cmul(b2, b2), b8 = cmul(b4, b4);
    constexpr float C1 = 0.92387953251128674f, S1 = 0.38268343236508977f, R2 = 0.70710678118654752f;
    const f32x2v w1a = cmul(b1, mk2(C1, -S1)), w1b = cmul(b2, mk2(R2, -R2)), w2a = cmul(b1, mk2(R2, -R2)), w2b = mul_mi(b2), w3a = cmul(b1, mk2(S1, -C1)), w3b = cmul(b2, mk2(-R2, -R2));
    __syncthreads();
#pragma unroll
    for (int j = 0; j < NI; ++j) {
        f32x2v e[16];
#define FFT_HALF_FWD(i, w0, wm) { const f32x2v x0 = mk2(u0[j][i], u1[j][i]), x1 = mk2(u0[j][i + 4], u1[j][i + 4]); const f32x2v a2 = cmul(x0, w0), a3 = cmul(x1, mul_mi(w0)); \
            e[i] = x0 + x1; e[i + 4] = cmul(x0 - x1, wm); e[i + 8] = a2 + a3; e[i + 12] = cmul(a2 - a3, wm); }
        FFT_HALF_FWD(0, b1, b2) FFT_HALF_FWD(1, w1a, w1b) FFT_HALF_FWD(2, w2a, w2b) FFT_HALF_FWD(3, w3a, w3b)
#undef FFT_HALF_FWD
#pragma unroll
        for (int q = 0; q < 4; ++q) bf4_fwd(e[4 * q], e[4 * q + 1], e[4 * q + 2], e[4 * q + 3], b4, b8);
#pragma unroll
        for (int k = 0; k < 16; ++k) buf[j * FFT_BS + PD(base + k * S)] = e[k];
    }
    __syncthreads();
}
template <int N, int NI> DI void fft_inv_last(LAS f32x2v* buf, int tid, f32x2v (&out)[NI][8]) {
    asm volatile("" : "+v"(tid));
    constexpr int M = N / 16;
    const int tr = tid / (N / 16), p = tid % (N / 16); const int base = tr * N + p;
    const f32x2v a1 = twid(p, 16 * M), a2 = cmul(a1, a1), a4 = cmul(a2, a2), a8 = cmul(a4, a4);
    constexpr float C1 = 0.92387953251128674f, S1 = 0.38268343236508977f, R2 = 0.70710678118654752f;
    const f32x2v v1a = cmul(a1, mk2(C1, S1)), v1b = cmul(a2, mk2(R2, R2)), v2a = cmul(a1, mk2(R2, R2)), v2b = mul_pi(a2), v3a = cmul(a1, mk2(S1, C1)), v3b = cmul(a2, mk2(-R2, R2));
#pragma unroll
    for (int j = 0; j < NI; ++j) {
        f32x2v e[16];
#pragma unroll
        for (int k = 0; k < 16; ++k) e[k] = buf[j * FFT_BS + PD(base + k * M)];
#pragma unroll
        for (int q = 0; q < 4; ++q) bf4_inv(e[4 * q], e[4 * q + 1], e[4 * q + 2], e[4 * q + 3], a4, a8);
#define FFT_HALF_INV(i, wa, w) { const f32x2v t1 = cmul(e[i + 4], w), t3 = cmul(e[i + 12], w); const f32x2v a0 = e[i] + t1, a1_ = e[i] - t1, a2_ = e[i + 8] + t3, a3 = e[i + 8] - t3; \
            out[j][i] = a0 + cmul(a2_, wa); out[j][i + 4] = a1_ + cmul(a3, mul_pi(wa)); }
        FFT_HALF_INV(0, a1, a2) FFT_HALF_INV(1, v1a, v1b) FFT_HALF_INV(2, v2a, v2b) FFT_HALF_INV(3, v3a, v3b)
#undef FFT_HALF_INV
    }
}
template <int N, int NI = 1, bool SH = false> DI void fft_pairmul(LAS f32x2v* buf, const v2u* const (&KS)[NI]  , int tid) {
    asm volatile("" : "+v"(tid));
    constexpr int LOG = (N == 8192) ? 13 : 9, NB = 8192 / N, NK = N / 2 + 1;
    for (int idx = tid; idx < NB * NK; idx += 512) {
        const int tr = idx / NK, k = ks_perm<N>(idx % NK);
        const int pk = PD(tr * N + (int)(__brev((unsigned)k) >> (32 - LOG))), pn = PD(tr * N + (int)(__brev((unsigned)((N - k) & (N - 1))) >> (32 - LOG)));
        f32x4v ks0 = {0.f, 0.f, 0.f, 0.f}; if (SH) ks0 = ks_unpack(KS[0][idx]);
#pragma unroll
        for (int j = 0; j < NI; ++j) {
            const f32x2v zk = buf[j * FFT_BS + pk], zn = buf[j * FFT_BS + pn]; const f32x4v ks = SH ? ks0 : ks_unpack(KS[j][idx]);
            constexpr float hn_ = 0.5f / (float)N; const f32x2v u1 = mk2(hn_ * (zk.x + zn.x), hn_ * (zk.y - zn.y)), u2 = mk2(hn_ * (zk.y + zn.y), -hn_ * (zk.x - zn.x));
            const f32x2v y1 = cmul(u1, mk2(ks.x, ks.y)), y2 = cmul(u2, mk2(ks.z, ks.w));
            buf[j * FFT_BS + pk] = mk2(y1.x - y2.y, y1.y + y2.x);
            if (pn != pk) buf[j * FFT_BS + pn] = mk2(y1.x + y2.y, -y1.y + y2.x);
        }
    }
}
template <int T> DI void hyena_filter_item(Ctx& C, int o, int n, int pair0) {
    constexpr int N = 2 * T, NB = 4096 / T, LOG = (N == 8192) ? 13 : 9, NK = N / 2 + 1;
    const bf16* KT = (const bf16*)(C.ws + WS_SCAN); LAS f32x2v* buf = (LAS f32x2v*)C.lds; LAS float* red = (LAS float*)(C.lds + FFT_BUF_BYTES + 1024);
    int tid = C.tid; asm volatile("" : "+v"(tid)); const int toff = T == 256 ? 0 : 256;
    const float dmin = 4.605170185988092f / 1.5f, dmax = 4.605170185988092f / 0.3f;
    __syncthreads();
    if (tid < 2 * NB) red[tid] = 0.f;
    __syncthreads();
    float k0[16], k1[16];
#pragma unroll
    for (int i = 0; i < 16; ++i) { const int idx = tid + 512 * i, tr = idx / N, pos = idx % N; const int c = 2 * (pair0 + tr);
        float a = 0.f, b = 0.f;
        if (pos != T) { const int side = pos > T ? 1 : 0, tt = pos > T ? N - pos : pos; const float tn = (float)tt / (float)(T - 1);
            const bf16* kr = KT + ((size_t)o * 8192 + (n * 2 + side) * 2048 + c) * 4352 + toff + tt;
            const float d0 = dmin + (dmax - dmin) * ((float)c / 2047.0f), d1 = dmin + (dmax - dmin) * ((float)(c + 1) / 2047.0f);
            a = bf2f(kr[0]) * expf(-tn * d0); b = bf2f(kr[4352]) * expf(-tn * d1); }
        k0[i] = a; k1[i] = b;
        const float sa = wave_sum(fabsf(a)), sb = wave_sum(fabsf(b));
        if (C.lane == 0) { __hip_atomic_fetch_add(&red[2 * tr], sa, __ATOMIC_RELAXED, __HIP_MEMORY_SCOPE_WORKGROUP); __hip_atomic_fetch_add(&red[2 * tr + 1], sb, __ATOMIC_RELAXED, __HIP_MEMORY_SCOPE_WORKGROUP); } }
    __syncthreads();
    int tl = tid; asm volatile("" : "+v"(tl));
#pragma unroll
    for (int i = 0; i < 16; ++i) { const int idx = tl + 512 * i, tr = idx / N; f32x2v kv = mk2(k0[i] / red[2 * tr], k1[i] / red[2 * tr + 1]);
        if (idx % N == 0) { const float* hb = C.in[I_HB] + (size_t)(o * 2 + n) * 2048 + 2 * (pair0 + tr); kv.x += hb[0]; kv.y += hb[1]; }
        buf[PD(idx)] = kv; }
    __syncthreads();
    fft_fwd<N>(buf, tid);
    v2u* KS = (v2u*)(C.ws + (T == 256 ? WS_KSP : WS_KSS)) + ((size_t)(o * 2 + n) * 1024 + pair0) * NK;
    for (int idx = tid; idx < NB * NK; idx += 512) { const int tr = idx / NK, k = ks_perm<N>(idx % NK);
        const int pk = tr * N + (int)(__brev((unsigned)k) >> (32 - LOG)), pn = tr * N + (int)(__brev((unsigned)((N - k) & (N - 1))) >> (32 - LOG));
        const f32x2v zk = buf[PD(pk)], zn = buf[PD(pn)];
        KS[idx] = ks_pack(0.5f * (zk.x + zn.x), 0.5f * (zk.y - zn.y), 0.5f * (zk.y + zn.y), -0.5f * (zk.x - zn.x)); }
}
DI void phase_hyena_filters(Ctx& C) {
    for (int it = C.vb; it < 4 * 1024 + 4 * 64; it += C.G) {
        if (it < 4096) hyena_filter_item<4096>(C, it >> 11, (it >> 10) & 1, it & 1023);
        else { const int v = it - 4096; hyena_filter_item<256>(C, v >> 7, (v >> 6) & 1, (v & 63) * 16); }
    }
    __syncthreads();
}
template <int T, int NI, int PROBE = 0, bool SH = false> DI void hyena_conv_item(Ctx& C, int o, const int (&seq)[NI], const int (&pair0)[NI]) {
    constexpr int N = 2 * T, NB = 4096 / T, NK = N / 2 + 1;
    LAS f32x2v* buf = (LAS f32x2v*)C.lds; const int tid = C.tid;
    const float* cw = C.in[I_CW] + (size_t)o * 3 * 6144; const float* cb = C.in[I_CB] + (size_t)o * 6144;
    bf16* Y = (bf16*)(C.ws + WS_MIX);
    const float* ZT[NI]; const v2u* KS0[NI]; const v2u* KS1[NI]; int rowbase[NI];
#pragma unroll
    for (int j = 0; j < NI; ++j) { ZT[j] = (const float*)(C.ws + WS_Z + (T == 256 ? 0 : ZT_S_OFF)) + (size_t)seq[j] * 6144 * T;
        KS0[j] = (const v2u*)(C.ws + (T == 256 ? WS_KSP : WS_KSS)) + ((size_t)(o * 2 + 0) * 1024 + pair0[j]) * NK; KS1[j] = KS0[j] + (size_t)1024 * NK;
        rowbase[j] = T == 256 ? seq[j] * 256 : MP + seq[j] * 4096; }
    constexpr int NQ = SH ? 1 : NI;
    float wq[NQ][6][4];
    if constexpr (T == 4096) {
        auto sg = [](float v) { return __builtin_bit_cast(float, __builtin_amdgcn_readfirstlane(__builtin_bit_cast(int, v))); };
#pragma unroll
        for (int j = 0; j < NQ; ++j) {
#pragma unroll
            for (int gq = 0; gq < 6; ++gq) { const int ch = (gq >> 1) * 2048 + 2 * pair0[j] + (gq & 1); wq[j][gq][0] = sg(cw[ch]); wq[j][gq][1] = sg(cw[6144 + ch]); wq[j][gq][2] = sg(cw[2 * 6144 + ch]); wq[j][gq][3] = sg(cb[ch]); }
        }
    }
    auto ld3 = [&](int j, int grp, int jj, int c, int t, float (&z)[3]) __attribute__((always_inline)) { const int ch = grp * 2048 + c + jj; const float* zr = ZT[j] + (size_t)ch * T + t; z[0] = zr[-1]; z[1] = zr[0]; z[2] = zr[1]; };
    auto ap3 = [&](int j, int grp, int jj, int c, int t, const float (&z)[3]) __attribute__((always_inline)) { const int ch = grp * 2048 + c + jj; const float zp = t > 0 ? z[0] : 0.f, zn = t < T - 1 ? z[2] : 0.f;
        if constexpr (T == 4096) { const int jq = SH ? 0 : j; return wq[jq][grp * 2 + jj][0] * zp + wq[jq][grp * 2 + jj][1] * z[1] + wq[jq][grp * 2 + jj][2] * zn + wq[jq][grp * 2 + jj][3]; }
        else return cw[ch] * zp + cw[6144 + ch] * z[1] + cw[2 * 6144 + ch] * zn + cb[ch]; };
    float gz[NI][8][2][3]; constexpr int NPRE = (T == 4096) ? NI : 1;
    float u0[NI][8], u1[NI][8]; f32x2v cv[NI][8];
    int tl = tid; asm volatile("" : "+v"(tl));
#pragma unroll
    for (int j = 0; j < NI; ++j)
#pragma unroll
        for (int i = 0; i < 8; ++i) { const int tr = tl / (N / 16), t = tl % (N / 16) + (N / 16) * i, c = 2 * (pair0[j] + tr);
            float z0[3], z1[3]; ld3(j, 2, 0, c, t, z0); ld3(j, 2, 1, c, t, z1); u0[j][i] = ap3(j, 2, 0, c, t, z0); u1[j][i] = ap3(j, 2, 1, c, t, z1); }
    v2u ksr[8];
    if constexpr (SH) {
#pragma unroll
        for (int r = 0; r < 8; ++r) ksr[r] = KS0[0][tl + 512 * r]; }
    fft_fwd_first<N, NI>(buf, tid, u0, u1);
    if constexpr (N == 8192) { int tf = tid; asm volatile("" : "+v"(tf)); fft_fwd_pass<N, 256, NI>(buf, tf); }
    { int tf = tid; asm volatile("" : "+v"(tf)); fft_r32_fwd<NI>(buf, tf); }
    if constexpr (SH) fft_pairmul_pre<N, NI>(buf, ksr, KS0[0], tid); else fft_pairmul<N, NI, SH>(buf, KS0, tid);
    __syncthreads();
    { int tf = tid; asm volatile("" : "+v"(tf)); fft_r32_inv<NI>(buf, tf); }
    if constexpr (N == 8192) { int tf = tid; asm volatile("" : "+v"(tf)); fft_inv_pass<N, 32, NI, false>(buf, tf); }
    tl = tid; asm volatile("" : "+v"(tl));
#pragma unroll
    for (int j = 0; j < NPRE; ++j)
#pragma unroll
        for (int i = 0; i < 8; ++i) { const int tr = tl / (N / 16), t = tl % (N / 16) + (N / 16) * i, c = 2 * (pair0[j] + tr); ld3(j, 0, 0, c, t, gz[j][i][0]); ld3(j, 0, 1, c, t, gz[j][i][1]); }
    fft_inv_last<N, NI>(buf, tid, cv);
#pragma unroll
    for (int j = NPRE; j < NI; ++j)
#pragma unroll
        for (int i = 0; i < 8; ++i) { const int tr = tl / (N / 16), t = tl % (N / 16) + (N / 16) * i, c = 2 * (pair0[j] + tr); ld3(j, 0, 0, c, t, gz[j][i][0]); ld3(j, 0, 1, c, t, gz[j][i][1]); }
#pragma unroll
    for (int j = 0; j < NI; ++j)
#pragma unroll
        for (int i = 0; i < 8; ++i) { const int tr = tl / (N / 16), t = tl % (N / 16) + (N / 16) * i, c = 2 * (pair0[j] + tr);
            u0[j][i] = ap3(j, 0, 0, c, t, gz[j][i][0]) * cv[j][i].x; u1[j][i] = ap3(j, 0, 1, c, t, gz[j][i][1]) * cv[j][i].y; }
    if constexpr (SH) {
#pragma unroll
        for (int r = 0; r < 8; ++r) ksr[r] = KS1[0][tl + 512 * r]; }
    fft_fwd_first<N, NI>(buf, tid, u0, u1);
    if constexpr (N == 8192) { int tf = tid; asm volatile("" : "+v"(tf)); fft_fwd_pass<N, 256, NI>(buf, tf); }
    { int tf = tid; asm volatile("" : "+v"(tf)); fft_r32_fwd<NI>(buf, tf); }
    if constexpr (SH) fft_pairmul_pre<N, NI>(buf, ksr, KS1[0], tid); else fft_pairmul<N, NI, SH>(buf, KS1, tid);
    __syncthreads();
    { int tf = tid; asm volatile("" : "+v"(tf)); fft_r32_inv<NI>(buf, tf); }
    if constexpr (N == 8192) { int tf = tid; asm volatile("" : "+v"(tf)); fft_inv_pass<N, 32, NI, false>(buf, tf); }
    tl = tid; asm volatile("" : "+v"(tl));
#pragma unroll
    for (int j = 0; j < NPRE; ++j)
#pragma unroll
        for (int i = 0; i < 8; ++i) { const int tr = tl / (N / 16), t = tl % (N / 16) + (N / 16) * i, c = 2 * (pair0[j] + tr); ld3(j, 1, 0, c, t, gz[j][i][0]); ld3(j, 1, 1, c, t, gz[j][i][1]); }
    fft_inv_last<N, NI>(buf, tid, cv);
#pragma unroll
    for (int j = NPRE; j < NI; ++j)
#pragma unroll
        for (int i = 0; i < 8; ++i) { const int tr = tl / (N / 16), t = tl % (N / 16) + (N / 16) * i, c = 2 * (pair0[j] + tr); ld3(j, 1, 0, c, t, gz[j][i][0]); ld3(j, 1, 1, c, t, gz[j][i][1]); }
#pragma unroll
    for (int j = 0; j < NI; ++j)
#pragma unroll
        for (int i = 0; i < 8; ++i) { const int tr = tl / (N / 16), t = tl % (N / 16) + (N / 16) * i, c = 2 * (pair0[j] + tr);
            const float y0 = ap3(j, 1, 0, c, t, gz[j][i][0]) * cv[j][i].x, y1 = ap3(j, 1, 1, c, t, gz[j][i][1]) * cv[j][i].y;
            *(unsigned*)(Y + (size_t)(rowbase[j] + t) * 2048 + c) = pk2(y0, y1); }
}
template <int PROBE = 0> DI void phase_hyena_conv(Ctx& C, int o) {
    if (C.G == 256) {
        for (int it = C.vb; it < 1024 + 512; it += C.G) {
            if (it < 1024) { const int sq[2] = {0, 1}, pr[2] = {it, it}; hyena_conv_item<4096, 2, PROBE, true>(C, o, sq, pr); }
            else { const int v = it - 1024; const int sq[2] = {2 * (v >> 6), 2 * (v >> 6) + 1}, pr[2] = {(v & 63) * 16, (v & 63) * 16}; hyena_conv_item<256, 2, PROBE, true>(C, o, sq, pr); }
        }
    } else {
        for (int it = C.vb; it < 2048 + 1024; it += C.G) {
            if (it < 2048) { const int sq[1] = {it >> 10}, pr[1] = {it & 1023}; hyena_conv_item<4096, 1, PROBE>(C, o, sq, pr); }
            else { const int v = it - 2048; const int sq[1] = {v >> 6}, pr[1] = {(v & 63) * 16}; hyena_conv_item<256, 1, PROBE>(C, o, sq, pr); }
        }
    }
    __syncthreads();
}

#ifndef ONE_LAUNCH
#define ONE_LAUNCH 1
#endif
#ifndef SKIP_FFN
#define SKIP_FFN 0
#endif
#ifndef SKIP_EVEN
#define SKIP_EVEN 0
#endif
#ifndef SKIP_ODD
#define SKIP_ODD 0
#endif
#ifndef DUP_FFN
#define DUP_FFN 0
#endif
#ifndef DUP_EVEN
#define DUP_EVEN 0
#endif
#ifndef DUP_ODD
#define DUP_ODD 0
#endif
#ifndef DUP_PRO
#define DUP_PRO 0
#endif
#ifndef DUP_E
#define DUP_E 0
#endif
#ifndef DUP_O
#define DUP_O 0
#endif
constexpr int NPH_MAX = 96;
template <int V> struct IntC { static constexpr int value = V; };
DI void launder(Ctx& C, const KArgs& a) { const int t = lane_id_v(); C.lane = t; C.tid = C.wave * 64 + t;
    int z = 0; asm volatile("" : "+v"(z)); const int zs = __builtin_amdgcn_readfirstlane(z);
    C.ws = a.ws + zs; C.in = a.in + zs; C.out = a.out + zs;
    C.zs = zs; C.G = (int)gridDim.x + zs; C.bx = (int)blockIdx.x + zs; C.gw = C.bx * 8 + C.wave; C.NGW = C.G * 8; C.vb = (C.G % 8 == 0) ? (C.bx % 8) * (C.G / 8) + C.bx / 8 : C.bx; }
__global__ void __launch_bounds__(512, 2) mega_fwd(KArgs args) {
    extern __shared__ __attribute__((aligned(16))) unsigned char lds_raw[];
    Ctx C;
    C.lds = (LAS unsigned char*)lds_raw; C.ws = args.ws; C.in = args.in; C.out = args.out;
    C.wave = __builtin_amdgcn_readfirstlane((int)threadIdx.x >> 6); C.lane = lane_id_v(); C.tid = C.wave * 64 + C.lane;
    C.zs = 0; C.G = 0; C.bx = 0; C.gw = 0; C.NGW = 0; C.vb = 0;
    for (int u = C.tid; u < (LDS_BYTES - LDS_CTL) / 4; u += 512) ((LAS unsigned*)(C.lds + LDS_CTL))[u] = 0u;
    __syncthreads();
    (void)xcd_barrier_post((unsigned*)(args.ws + WS_CTL) + 4096, (volatile LAS unsigned*)(C.lds + LDS_CTL + 64), C.tid);
#if ONE_LAUNCH
    constexpr int lo = 0, hi = 1 << 20; int ph = 0;
#else
    const int lo = args.ph_lo, hi = args.ph_hi; int ph = 0;
#endif
#define PH_IF if (ph >= lo && ph < hi) if (launder(C, args), true)
#define PH_NEXT do { const bool both_ = (ph >= lo) && (ph + 1 < hi); ++ph; if (both_) { launder(C, args); XcdBarrier b_; b_.bar = (unsigned*)(C.ws + WS_CTL) + 4096; b_.x = xb_xcc_id() + (unsigned)C.zs; b_.st = (volatile LAS unsigned*)(C.lds + LDS_CTL + 64); xcd_barrier(b_, C.tid); } } while (0)
#define ring C.lds
#define MOD ((const float*)(C.ws + WS_MOD))
#define X ((unsigned short*)(C.ws + WS_X))

#if DUP_PRO == 1
    PH_IF { phase_prologue(C); } PH_NEXT;
#endif
    PH_IF {
#ifndef NO_PROLOGUE
 phase_prologue(C);
#endif
 } PH_NEXT;
    PH_IF { phase_mod_reduce(C);
        pg8::Gemm g{(const bf16*)(C.ws + WS_W3T), (const bf16*)(C.ws + WS_H2), 16384, 4352, 256}; pg8::StaticOrder S; S.init(16384, 4352, C.G, C.bx);
        pg8::EpiBf16Plain E{(bf16*)(C.ws + WS_SCAN), 4352};
        pg8::gemm_phase<pg8::EpiBf16Plain, pg8::StaticOrder, false, false>(ring, g, S, E, C.wave); } PH_NEXT;
#if DUP_PRO == 2
    PH_IF { phase_hyena_filters(C); } PH_NEXT;
#endif
    PH_IF {
#ifndef NO_HYENA
 phase_hyena_filters(C);
#endif
 } PH_NEXT;

#define FFN_BLOCK(l, fi, s, cf) do { \
    if (!SKIP_FFN) { \
    PH_IF { phase_norm_mod(C, C.in[I_NG] + ((l) * 3 + (s)) * 2048, MOD + (size_t)(l) * MODL, (s)); } PH_NEXT; \
    PH_IF { pg8::Gemm g{(const bf16*)(C.ws + WS_H), (const bf16*)(C.ws + WS_W1T) + (size_t)((l) * 2 + (fi)) * NFF1 * 2048, MT, NFF1, 2048}; pg8::StaticOrder S; S.init(MT, NFF1, C.G, C.bx); \
        pg8::EpiSwiGLU E{(bf16*)(C.ws + WS_ACT), DFF}; pg8::gemm_phase<pg8::EpiSwiGLU, pg8::StaticOrder, false, true>(ring, g, S, E, C.wave); \
        { const int nf_ = (l) * 2 + (fi) + 1, idle0_ = (MT / 256) * (NFF1 / 256) % C.G; if ((cf) != 0.0f && nf_ < 8 && C.bx >= idle0_) { launder(C, args); \
            tr_matrix<0>(C, C.in[I_WFO] + (size_t)nf_ * DFF * 2048, 2048, DFF, (bf16*)(C.ws + WS_W2T) + (size_t)nf_ * 2048 * DFF, 2048, 2048, (C.bx - idle0_) * 8 + C.wave, (C.G - idle0_) * 8); } } } PH_NEXT; \
    PH_IF { pg8::Gemm g{(const bf16*)(C.ws + WS_ACT), (const bf16*)(C.ws + WS_W2T) + (size_t)((l) * 2 + (fi)) * 2048 * DFF, MT, 2048, DFF}; \
        pg8::EpiRes E{X, MOD + (size_t)(l) * MODL + (3 * (s) + 2) * 2048, (cf)}; \
        { pg8::PairOrder<1> S; S.init(MT, 2048, DFF, C.G, C.bx, (float*)(C.ws + WS_Z), (unsigned*)(C.ws + WS_CTL) + 16384, (DUP_FFN ? 8u * (unsigned)(2 * ((l) * 2 + (fi)) + ((cf) != 0.0f ? 2 : 1)) : 8u * (unsigned)((l) * 2 + (fi) + 1))); \
          pg8::gemm_phase<pg8::EpiRes, pg8::PairOrder<1>, false, true>(ring, g, S, E, C.wave); } \
        { launder(C, args); pg8::PairOrder<2> S; S.init(MT, 2048, DFF, C.G, C.bx, (float*)(C.ws + WS_Z), (unsigned*)(C.ws + WS_CTL) + 16384, (DUP_FFN ? 8u * (unsigned)(2 * ((l) * 2 + (fi)) + ((cf) != 0.0f ? 2 : 1)) : 8u * (unsigned)((l) * 2 + (fi) + 1))); \
          pg8::Gemm g2{(const bf16*)(C.ws + WS_ACT), (const bf16*)(C.ws + WS_W2T) + (size_t)((l) * 2 + (fi)) * 2048 * DFF, MT, 2048, DFF}; pg8::EpiRes E2{X, MOD + (size_t)(l) * MODL + (3 * (s) + 2) * 2048, (cf)}; \
          pg8::gemm_phase<pg8::EpiRes, pg8::PairOrder<2>, true, true>(ring, g2, S, E2, C.wave); } \
        { const int nf_ = (l) * 2 + (fi) + 1; if ((cf) != 0.0f && nf_ < 8 && !(C.G >= 235 && !SKIP_EVEN && ((l) & 1) == 0 && (fi) == 0) && !(C.G == 256 && !SKIP_EVEN && ((l) & 1) == 0 && (fi) == 1)) { launder(C, args); \
            tr_matrix<1>(C, C.in[I_WFI] + (size_t)nf_ * 2048 * NFF1, NFF1, 2048, (bf16*)(C.ws + WS_W1T) + (size_t)nf_ * NFF1 * 2048, NFF1, NFF1, C.gw, C.NGW); } } } PH_NEXT; \
    } } while (0)

    auto layer_pair = [&](auto PC) __attribute__((always_inline)) {
        constexpr int p = decltype(PC)::value; constexpr int le = 2 * p, lod = 2 * p + 1;
#if DUP_FFN
        FFN_BLOCK(le, 0, 0, 0.0f);
#endif
        FFN_BLOCK(le, 0, 0, 0.5f);
        auto even_mix = [&](float cf, int qslot) __attribute__((always_inline)) {
            const int e = p;
            PH_IF { phase_norm_mod(C, C.in[I_NG] + (le * 3 + 1) * 2048, MOD + (size_t)le * MODL, 1); } PH_NEXT;
            PH_IF { pg8::Gemm g{(const bf16*)(C.ws + WS_H), (const bf16*)(C.ws + WS_WINE) + (size_t)e * ZE_P * 2048, MT, ZE_P, 2048}; pg8::StaticOrder S; S.init(MT, ZE_P, C.G, C.bx);
                pg8::EpiF32 E{(float*)(C.ws + WS_Z), ZE_P}; pg8::gemm_phase<pg8::EpiF32, pg8::StaticOrder, true, true>(ring, g, S, E, C.wave);
                { const int nf_ = le * 2 + 2, idle0_ = (MT / 256) * (ZE_P / 256) % C.G;
                  if (cf != 0.0f && C.G == 256 && C.bx >= idle0_) { launder(C, args);
                    tr_matrix<1>(C, C.in[I_WFI] + (size_t)nf_ * 2048 * NFF1, NFF1, 2048, (bf16*)(C.ws + WS_W1T) + (size_t)nf_ * NFF1 * 2048, NFF1, NFF1, (C.bx - idle0_) * 8 + C.wave, (C.G - idle0_) * 8); } } } PH_NEXT;
#if DUP_E == 5
            PH_IF { phase_even_prep(C, e); } PH_NEXT;
#endif
            PH_IF { phase_even_prep(C, e); } PH_NEXT;
#if DUP_E == 7
            PH_IF {
                { pg8::Gemm g{(const bf16*)(C.ws + WS_LA), (const bf16*)(C.ws + WS_WLORA) + (size_t)e * 5120 * 384, MT, 5120, 384}; pg8::StaticOrder S; S.init(MT, 5120, C.G, C.bx);
                  pg8::EpiLora E{C.ws, C.in[I_W0] + e * 2048, C.in[I_A0] + e * 2048, C.in[I_KA] + e * 1024, WS_SCAN + (size_t)e * SCAN_BYTES, WS_KBUF, WS_GB};
                  pg8::gemm_phase<pg8::EpiLora, pg8::StaticOrder, true, true>(ring, g, S, E, C.wave); }
                launder(C, args);
                { pg8::Gemm g{(const bf16*)(C.ws + WS_CQ), (const bf16*)(C.ws + WS_WQ) + (size_t)e * 1536 * 512, MT, 1536, 512}; pg8::StaticOrder S; S.init(MT, 1536, C.G, C.bx);
                  pg8::EpiQ E{(bf16*)(C.ws + WS_Q), (const float*)(C.ws + WS_ROPE), 0.07216878364870322f * 1.4426950408889634f};
                  pg8::gemm_phase<pg8::EpiQ, pg8::StaticOrder, true, true>(ring, g, S, E, C.wave); }
                launder(C, args);
                { pg8::Gemm g{(const bf16*)(C.ws + WS_CKV), (const bf16*)(C.ws + WS_WKN) + (size_t)e * 1024 * 256, MKV, 1024, 256}; pg8::StaticOrder S; S.init(MKV, 1024, C.G, C.bx);
                  pg8::EpiBf16Plain E{(bf16*)(C.ws + WS_KN), 1024};
                  pg8::gemm_phase<pg8::EpiBf16Plain, pg8::StaticOrder, false, false>(ring, g, S, E, C.wave); }
                launder(C, args);
                { pg8::Gemm g{(const bf16*)(C.ws + WS_WV) + (size_t)e * 1024 * 256, (const bf16*)(C.ws + WS_CKV), 1024, MKV, 256}; pg8::StaticOrder S; S.init(1024, MKV, C.G, C.bx);
                  pg8::EpiVT E{(bf16*)(C.ws + WS_VT), VT_S_OFF / 2};
                  pg8::gemm_phase<pg8::EpiVT, pg8::StaticOrder, false, false>(ring, g, S, E, C.wave); }
            } PH_NEXT;
#endif
            PH_IF {
                { pg8::Gemm g{(const bf16*)(C.ws + WS_LA), (const bf16*)(C.ws + WS_WLORA) + (size_t)e * 5120 * 384, MT, 5120, 384}; pg8::StaticOrder S; S.init(MT, 5120, C.G, C.bx);
                  pg8::EpiLora E{C.ws, C.in[I_W0] + e * 2048, C.in[I_A0] + e * 2048, C.in[I_KA] + e * 1024, WS_SCAN + (size_t)e * SCAN_BYTES, WS_KBUF, WS_GB};
                  pg8::gemm_phase<pg8::EpiLora, pg8::StaticOrder, true, true>(ring, g, S, E, C.wave); }
                launder(C, args);
                { pg8::Gemm g{(const bf16*)(C.ws + WS_CQ), (const bf16*)(C.ws + WS_WQ) + (size_t)e * 1536 * 512, MT, 1536, 512}; pg8::StaticOrder S; S.init(MT, 1536, C.G, (C.bx + 64) % C.G);
                  pg8::EpiQ E{(bf16*)(C.ws + WS_Q), (const float*)(C.ws + WS_ROPE), 0.07216878364870322f * 1.4426950408889634f};
                  pg8::gemm_phase<pg8::EpiQ, pg8::StaticOrder, true, true>(ring, g, S, E, C.wave); }
                launder(C, args);
                { pg8::Gemm g{(const bf16*)(C.ws + WS_CKV), (const bf16*)(C.ws + WS_WKN) + (size_t)e * 1024 * 256, MKV, 1024, 256}; pg8::StaticOrder S; S.init(MKV, 1024, C.G, (C.bx + 32) % C.G);
                  pg8::EpiBf16Plain E{(bf16*)(C.ws + WS_KN), 1024};
                  pg8::gemm_phase<pg8::EpiBf16Plain, pg8::StaticOrder, false, false>(ring, g, S, E, C.wave); }
                launder(C, args);
                { pg8::Gemm g{(const bf16*)(C.ws + WS_WV) + (size_t)e * 1024 * 256, (const bf16*)(C.ws + WS_CKV), 1024, MKV, 256}; pg8::StaticOrder S; S.init(1024, MKV, C.G, (C.bx + 88) % C.G);
                  pg8::EpiVT E{(bf16*)(C.ws + WS_VT), VT_S_OFF / 2};
                  pg8::gemm_phase<pg8::EpiVT, pg8::StaticOrder, false, false>(ring, g, S, E, C.wave); }
            } PH_NEXT;
#if DUP_E == 1
            PH_IF { phase_scan1(C, e, 2); } PH_NEXT;
#endif
            PH_IF {
#ifndef NO_SCAN
 phase_scan1(C, e, qslot);
#endif
 } PH_NEXT;
#if DUP_E == 2
            PH_IF { phase_scan_carry(C, e, 8); __syncthreads(); } PH_NEXT;
#endif
            PH_IF { const bool host_ = cf != 0.0f && C.G >= 235; phase_scan_carry(C, e, host_ ? 3 : 8);
                if (host_ && C.bx >= 64 && C.wave >= 3) { launder(C, args); const int nf_ = le * 2 + 1;
                    tr_matrix<1>(C, C.in[I_WFI] + (size_t)nf_ * 2048 * NFF1, NFF1, 2048, (bf16*)(C.ws + WS_W1T) + (size_t)nf_ * NFF1 * 2048, NFF1, NFF1, (C.bx - 64) * 5 + C.wave - 3, (C.G - 64) * 5); }
                __syncthreads(); } PH_NEXT;
#if DUP_E == 3
            PH_IF { phase_scan3(C, e); } PH_NEXT;
#endif
#if DUP_E == 4
            PH_IF { phase_attention(C); } PH_NEXT;
#endif
            PH_IF {
#ifndef NO_SCAN
 phase_scan3(C, e);
#endif
#ifndef NO_ATTN
 phase_attention(C);
#endif
 } PH_NEXT;
#if DUP_E == 6
            PH_IF { phase_rwkv_post(C, e); } PH_NEXT;
#endif
            PH_IF { phase_rwkv_post(C, e); } PH_NEXT;
            PH_IF { pg8::Gemm g{(const bf16*)(C.ws + WS_MIX), (const bf16*)(C.ws + WS_WOUTE) + (size_t)e * 2048 * 2048, MT, 2048, 2048}; pg8::StaticOrder S; S.init(MT, 2048, C.G, C.bx);
                pg8::EpiRes E{X, MOD + (size_t)le * MODL + (3 * 1 + 2) * 2048, cf}; pg8::gemm_phase<pg8::EpiRes, pg8::StaticOrder, false, true>(ring, g, S, E, C.wave); } PH_NEXT;
        };
#if DUP_EVEN
        even_mix(0.0f, 1);
#endif
        if (!SKIP_EVEN) even_mix(1.0f, 0);
#if DUP_FFN
        FFN_BLOCK(le, 1, 2, 0.0f);
#endif
        FFN_BLOCK(le, 1, 2, 0.5f);
#if DUP_FFN
        FFN_BLOCK(lod, 0, 0, 0.0f);
#endif
        FFN_BLOCK(lod, 0, 0, 0.5f);
        auto odd_mix = [&](float cf) __attribute__((always_inline)) {
            const int o = p;
            PH_IF { phase_norm_mod(C, C.in[I_NG] + (lod * 3 + 1) * 2048, MOD + (size_t)lod * MODL, 1); } PH_NEXT;
            PH_IF { pg8::Gemm g{(const bf16*)(C.ws + WS_WINO) + (size_t)o * 6144 * 2048, (const bf16*)(C.ws + WS_H), 6144, MT, 2048}; pg8::StaticOrder S; S.init(6144, MT, C.G, C.bx);
                pg8::EpiZT E{(float*)(C.ws + WS_Z), (float*)(C.ws + WS_Z + ZT_S_OFF)}; pg8::gemm_phase<pg8::EpiZT, pg8::StaticOrder, false, true>(ring, g, S, E, C.wave); } PH_NEXT;
#if DUP_O == 1
            PH_IF { phase_hyena_conv(C, o); } PH_NEXT;
#endif
#if DUP_O == 2
            PH_IF { phase_hyena_conv<1>(C, o); } PH_NEXT;
#endif
            PH_IF {
#ifndef NO_HYENA
 phase_hyena_conv(C, o);
#endif
 } PH_NEXT;
            PH_IF { pg8::Gemm g{(const bf16*)(C.ws + WS_MIX), (const bf16*)(C.ws + WS_WOUTO) + (size_t)o * 2048 * 2048, MT, 2048, 2048}; pg8::StaticOrder S; S.init(MT, 2048, C.G, C.bx);
                pg8::EpiRes E{X, MOD + (size_t)lod * MODL + (3 * 1 + 2) * 2048, cf}; pg8::gemm_phase<pg8::EpiRes, pg8::StaticOrder, false, true>(ring, g, S, E, C.wave); } PH_NEXT;
        };
#if DUP_ODD
        odd_mix(0.0f);
#endif
        if (!SKIP_ODD) odd_mix(1.0f);
#if DUP_FFN
        FFN_BLOCK(lod, 1, 2, 0.0f);
#endif
        FFN_BLOCK(lod, 1, 2, 0.5f);
    };
    layer_pair(IntC<0>{}); layer_pair(IntC<1>{});
    PH_IF { phase_final_norm(C); } PH_NEXT;
#undef MOD
#undef X
#undef ring
}

extern "C" void kernel_launch(void* const* d_in, const int* in_sizes, int n_in, void* d_out, int out_size, void* d_ws, size_t ws_size, hipStream_t stream) {
    static int grid = 0;
    if (grid == 0) {
        if (n_in != 42 || (size_t)out_size != OUT_END || ws_size < WS_END) { fprintf(stderr, "kernel_launch: unexpected sizes n_in %d out %d ws %zu (need %zu)\n", n_in, out_size, ws_size, (size_t)WS_END); grid = -1; return; }
        int dev = 0, cus = 0, per_cu = 0;
        if (hipGetDevice(&dev) != hipSuccess || hipDeviceGetAttribute(&cus, hipDeviceAttributeMultiprocessorCount, dev) != hipSuccess) { grid = -1; return; }
        if (hipFuncSetAttribute((const void*)mega_fwd, hipFuncAttributeMaxDynamicSharedMemorySize, LDS_BYTES) != hipSuccess) { fprintf(stderr, "kernel_launch: hipFuncSetAttribute failed\n"); grid = -1; return; }
        if (hipOccupancyMaxActiveBlocksPerMultiprocessor(&per_cu, (const void*)mega_fwd, 512, LDS_BYTES) != hipSuccess || per_cu < 1) fprintf(stderr, "kernel_launch: occupancy query says %d\n", per_cu);
        (void)hipGetLastError();
        grid = cus;
    }
    if (grid < 0) return;
    (void)hipMemsetAsync((char*)d_ws + WS_CTL, 0, CTL_ZERO_BYTES, stream);
    KArgs a{};
    for (int i = 0; i < 42; ++i) a.in[i] = (const float*)d_in[i];
    a.out = (float*)d_out; a.ws = (unsigned char*)d_ws;
#if ONE_LAUNCH
    a.ph_lo = 0; a.ph_hi = 1 << 20;
    hipLaunchKernelGGL(mega_fwd, dim3(grid), dim3(512), LDS_BYTES, stream, a);
#else
    for (int i = 0; i < NPH_MAX; ++i) { a.ph_lo = i; a.ph_hi = i + 1; hipLaunchKernelGGL(mega_fwd, dim3(grid), dim3(512), LDS_BYTES, stream, a); }
#endif
}
```

```cpp
#include <hip/hip_runtime.h>
#include <cstdio>
#include <cstdint>
#include <utility>
#define DI __device__ __forceinline__
#define GAS __attribute__((address_space(1)))
#define LAS __attribute__((address_space(3)))
#define CAS __attribute__((address_space(4)))
typedef unsigned short bf16;
typedef unsigned v4u __attribute__((ext_vector_type(4)));
typedef unsigned v2u __attribute__((ext_vector_type(2)));
typedef float f32x4v __attribute__((ext_vector_type(4)));
typedef float f32x2v __attribute__((ext_vector_type(2)));
typedef float f32x16v __attribute__((ext_vector_type(16)));
typedef short s16x8v __attribute__((ext_vector_type(8)));
typedef short s16x4v __attribute__((ext_vector_type(4)));

constexpr int D = 2048, MP = 4096, MS = 8192, MT = 12288, MKV = 12800;
constexpr int DFF = 5632, NFF1 = 11264;
constexpr int ZE_N = 4192, ZE_P = 4352;
constexpr int SCAN_P = 9 * 1024;
constexpr int NCH = 32, CHL = 4096 / NCH;
constexpr int MODL = 3 * 18432;

DI int lane_id_v() { int l; asm volatile("v_mbcnt_lo_u32_b32 %0, -1, 0\n\tv_mbcnt_hi_u32_b32 %0, -1, %0" : "=v"(l)); return l; }
DI unsigned f2bf(float f) { unsigned u = __builtin_bit_cast(unsigned, f); return (u + 0x7fffu + ((u >> 16) & 1u)) >> 16; }
DI unsigned pk2(float lo, float hi) { unsigned r; asm("v_cvt_pk_bf16_f32 %0, %1, %2" : "=v"(r) : "v"(lo), "v"(hi)); return r; }
DI float bf2f(unsigned short b) { return __builtin_bit_cast(float, ((unsigned)b) << 16); }
DI float h2f(unsigned short h) { return (float)__builtin_bit_cast(_Float16, h); }
DI unsigned pkh(float a, float b) { return (unsigned)__builtin_bit_cast(unsigned short, (_Float16)a) | ((unsigned)__builtin_bit_cast(unsigned short, (_Float16)b) << 16); }
DI f32x4v h4_unpack(v2u w) { return (f32x4v){h2f((unsigned short)(w.x & 0xffffu)), h2f((unsigned short)(w.x >> 16)), h2f((unsigned short)(w.y & 0xffffu)), h2f((unsigned short)(w.y >> 16))}; }
DI v2u h4_pack(f32x4v v) { v2u w; w.x = pkh(v.x, v.y); w.y = pkh(v.z, v.w); return w; }
template <int CTRL> DI float dpp_f(float v) { return __builtin_bit_cast(float, __builtin_amdgcn_update_dpp(0, __builtin_bit_cast(int, v), CTRL, 0xf, 0xf, true)); }
DI float shfl_idx(float v, int src) { return __builtin_bit_cast(float, __builtin_amdgcn_ds_bpermute(src << 2, __builtin_bit_cast(int, v))); }
DI float wave_sum(float v) {
    v += dpp_f<0xB1>(v); v += dpp_f<0x4E>(v); v += dpp_f<0x141>(v); v += dpp_f<0x140>(v);
    v += __builtin_bit_cast(float, __builtin_amdgcn_ds_swizzle(__builtin_bit_cast(int, v), 0x401F));
    return __builtin_bit_cast(float, __builtin_amdgcn_readlane(__builtin_bit_cast(int, v), 0)) + __builtin_bit_cast(float, __builtin_amdgcn_readlane(__builtin_bit_cast(int, v), 32));
}
DI float sigmoid_f(float x) { return __builtin_amdgcn_rcpf(1.f + __expf(-x)); }
DI float silu_f(float x) { return x * sigmoid_f(x); }
DI int scan_perm(int j) { return 4 * (j & 15) + (j >> 4); }
DI int row_mod_j(int row) { return row < MP ? 0 : 1 + ((row - MP) >> 12); }
namespace pg8 {
#define PG8_LAS __attribute__((address_space(3)))
typedef unsigned short bf16_t;
typedef short bf16x8 __attribute__((ext_vector_type(8)));
typedef float f32x4 __attribute__((ext_vector_type(4)));
typedef unsigned u32x4 __attribute__((ext_vector_type(4)));
constexpr int BM = 256, BK = 64, HALF = 128, HTB = HALF * BK * 2  , STAGE_BYTES = 8 * HTB, NXCD = 8, WGM = 8;

__host__ __device__ __forceinline__ int lds_byte(int r, int c) { const int st = (r >> 4) * 2 + (c >> 5), rr = r & 15, cc = c & 31, ob = rr * 64 + cc * 2; return st * 1024 + (ob ^ (((ob >> 9) & 1) << 5)); }
__host__ __device__ __forceinline__ void stage_rc(int b, int& R, int& C) { const int st = b / 1024, sb = b % 1024, swz = sb ^ (((sb >> 9) & 1) << 5); R = (st >> 1) * 16 + swz / 64; C = (st & 1) * 32 + (swz % 64) / 2; }
__host__ __device__ __forceinline__ int perm32(int rho) { const int n = rho >> 4, i = rho & 15; return 8 * (i >> 2) + 4 * n + (i & 3); }

struct Unit { int pm, pn; int kt0, nkt, mode, slot; };
struct Gemm { const bf16_t* A; const bf16_t* Bt; int M, N, K; };
struct StaticOrder {
    static constexpr int SPLITK = 0;
    int nM, nN, nwg, G, c;
    __host__ __device__ __forceinline__ void init(int M, int N, int G_, int c_) { nM = M / BM; nN = N / BM; nwg = nM * nN; G = G_; c = c_; }
    __host__ __device__ __forceinline__ bool next(int i, Unit& u) const {
        const long L = (long)i * G + c; if (L >= nwg) return false;
        int wgid = (int)L; { const int q = nwg / NXCD, r = nwg % NXCD, xcd = wgid % NXCD, off = wgid / NXCD; wgid = (xcd < r ? xcd * (q + 1) : r * (q + 1) + (xcd - r) * q) + off; }
        const int nig = WGM * nN, gid = wgid / nig, fm = gid * WGM, gsz = (nM - fm) < WGM ? (nM - fm) : WGM;
        u.pm = fm + ((wgid % nig) % gsz); u.pn = (wgid % nig) / gsz; u.kt0 = 0; u.nkt = 0; u.mode = 0; u.slot = 0; return true;
    }
    __device__ __forceinline__ void a_ready(const Unit&) const {}
    __device__ __forceinline__ void done(const Unit&) const {}
    __device__ __forceinline__ void publish(const f32x4 (&)[2][2][4][2], const Unit&, int, int) const {}
    __device__ __forceinline__ void consume(f32x4 (&)[2][2][4][2], const Unit&, int, int) const {}
};

template <int PART> struct PairOrder {
    static constexpr int SPLITK = PART;
    StaticOrder so; int R, rem, nt; bool paired;
    float* scratch; unsigned* flags; unsigned target;
    __device__ __forceinline__ void init(int M, int N, int K, int G_, int c_, float* scr, unsigned* fl, unsigned tgt) { so.init(M, N, G_, 0); so.c = 0; so.G = 1; R = so.nwg / G_; rem = so.nwg % G_; nt = K / BK;
        paired = (2 * rem == G_) && ((nt / 2) % 2 == 0); c = c_; G = G_; scratch = scr; flags = fl; target = tgt; }
    int c, G;
    __device__ __forceinline__ bool tile(int t, Unit& u) const { return so.next(t, u); }
    __device__ __forceinline__ bool next(int i, Unit& u) const {
        int t = -1, kt0 = 0, nk = nt, mode = 0, slot = 0;
        if (!paired) { if (PART == 1) { const long L = (long)i * G + c; if (L < so.nwg) t = (int)L; } }
        else if (PART == 1) {
            if (c < rem) { if (i == 0) { t = R * G + c; nk = nt / 2; mode = 1; slot = c; } else if (i <= R) t = (i - 1) * G + c; }
            else if (i < R) t = i * G + c;
        }
        else if (c >= rem && i == 0) { t = R * G + (c - rem); kt0 = nt / 2; nk = nt - nt / 2; mode = 2; slot = c - rem; }
        if (t < 0) return false;
        tile(t, u); u.kt0 = kt0; u.nkt = nk; u.mode = mode; u.slot = slot; return true;
    }
    __device__ __forceinline__ void a_ready(const Unit&) const {}
    __device__ __forceinline__ void done(const Unit&) const {}
    __device__ __forceinline__ void publish(const f32x4 (&acc)[2][2][4][2], const Unit& u, int wid, int lane) const {
        const __amdgpu_buffer_rsrc_t rs = __builtin_amdgcn_make_buffer_rsrc((void*)scratch, 0, 0x7fffffff, 0x00020000);
        const int so_ = __builtin_amdgcn_readfirstlane(u.slot * 262144 + wid * 32768), vo = lane * 16;
#pragma unroll
        for (int ai = 0; ai < 2; ++ai)
#pragma unroll
            for (int bj = 0; bj < 2; ++bj)
#pragma unroll
                for (int m = 0; m < 4; ++m)
#pragma unroll
                    for (int n = 0; n < 2; ++n) { const int r = ((ai * 2 + bj) * 4 + m) * 2 + n;
                        __builtin_amdgcn_raw_buffer_store_b128(__builtin_bit_cast(u32x4, acc[ai][bj][m][n]), rs, vo, so_ + r * 1024, 16); }
        asm volatile("s_waitcnt vmcnt(0)" ::: "memory");
        if (lane == 0) __hip_atomic_fetch_add(flags + 64 * u.slot, 1u, __ATOMIC_RELAXED, __HIP_MEMORY_SCOPE_AGENT);
    }
    __device__ __forceinline__ void consume(f32x4 (&acc)[2][2][4][2], const Unit& u, int wid, int lane) const {
        unsigned spins = 0;
        while ((unsigned)__builtin_amdgcn_readfirstlane((int)__hip_atomic_load(flags + 64 * u.slot, __ATOMIC_RELAXED, __HIP_MEMORY_SCOPE_AGENT)) < target) { __builtin_amdgcn_s_sleep(2); if (++spins > (1u << 22)) break; }
        __builtin_amdgcn_fence(__ATOMIC_ACQUIRE, "agent");
        asm volatile("s_waitcnt vmcnt(0)" ::: "memory");
        const __amdgpu_buffer_rsrc_t rs = __builtin_amdgcn_make_buffer_rsrc((void*)scratch, 0, 0x7fffffff, 0x00020000);
        const int so_ = __builtin_amdgcn_readfirstlane(u.slot * 262144 + wid * 32768), vo = lane * 16;
#pragma unroll
        for (int ai = 0; ai < 2; ++ai)
#pragma unroll
            for (int bj = 0; bj < 2; ++bj)
#pragma unroll
                for (int mh = 0; mh < 2; ++mh) {
                    f32x4 t[4];
#pragma unroll
                    for (int q = 0; q < 4; ++q) { const int m = mh * 2 + (q >> 1), n = q & 1; const int r = ((ai * 2 + bj) * 4 + m) * 2 + n; t[q] = __builtin_bit_cast(f32x4, __builtin_amdgcn_raw_buffer_load_b128(rs, vo, so_ + r * 1024, 16)); }
#pragma unroll
                    for (int q = 0; q < 4; ++q) { const int m = mh * 2 + (q >> 1), n = q & 1; acc[ai][bj][m][n] += t[q]; }
                    asm volatile("" ::: "memory");
                }
    }
};
__device__ __forceinline__ unsigned cvt_pk_bf16(float lo, float hi) { unsigned r; asm volatile("v_cvt_pk_bf16_f32 %0, %1, %2" : "=v"(r) : "v"(lo), "v"(hi)); return r; }
typedef float f32x2 __attribute__((ext_vector_type(2)));
#define EPI_LOOP_AIM _Pragma("unroll") for (int ai = 0; ai < 2; ++ai) _Pragma("unroll") for (int m = 0; m < 4; ++m)
#define EPI_LOOP_BJN _Pragma("unroll") for (int bj = 0; bj < 2; ++bj) _Pragma("unroll") for (int n = 0; n < 2; ++n)
struct EpiF32 {
    static constexpr bool PERM = false, AFTER_DRAIN = false;
    float* C; int ldc;
    __device__ __forceinline__ void operator()(const f32x4 (&acc)[2][2][4][2], const Unit& u, int wr, int wc, int fr, int fq) const {
        const int row0 = u.pm * BM + wr * 64 + fr, col0 = u.pn * BM + wc * 32 + 4 * fq;
        EPI_LOOP_AIM { float* rowp = C + (size_t)(row0 + ai * HALF + m * 16) * ldc + col0;
            EPI_LOOP_BJN *(f32x4*)(rowp + bj * HALF + n * 16) = acc[ai][bj][m][n]; }
    }
};
struct EpiBf16Plain {
    static constexpr bool PERM = true, AFTER_DRAIN = false;
    bf16_t* O; int ldc;
    __device__ __forceinline__ void operator()(const f32x4 (&acc)[2][2][4][2], const Unit& u, int wr, int wc, int fr, int fq) const {
        const int row0 = u.pm * BM + wr * 64 + fr, col0 = u.pn * BM + wc * 32 + 8 * fq;
        EPI_LOOP_AIM { bf16_t* rowp = O + (size_t)(row0 + ai * HALF + m * 16) * ldc + col0;
#pragma unroll
            for (int bj = 0; bj < 2; ++bj) { const f32x4 v0 = acc[ai][bj][m][0], v1 = acc[ai][bj][m][1];
                u32x4 w; w.x = cvt_pk_bf16(v0[0], v0[1]); w.y = cvt_pk_bf16(v0[2], v0[3]); w.z = cvt_pk_bf16(v1[0], v1[1]); w.w = cvt_pk_bf16(v1[2], v1[3]);
                *(u32x4*)(rowp + bj * HALF) = w; } }
    }
};
struct EpiSwiGLU {
    static constexpr bool PERM = true, AFTER_DRAIN = false;
    bf16_t* O; int ldc;
    __device__ __forceinline__ void operator()(const f32x4 (&acc)[2][2][4][2], const Unit& u, int wr, int wc, int fr, int fq) const {
        const int row0 = u.pm * BM + wr * 64 + fr, col0 = u.pn * HALF + wc * 32 + 8 * fq;
        EPI_LOOP_AIM { bf16_t* rowp = O + (size_t)(row0 + ai * HALF + m * 16) * ldc + col0;
            float o[8];
#pragma unroll
            for (int n = 0; n < 2; ++n)
#pragma unroll
                for (int i = 0; i < 4; ++i) { const float g = acc[ai][0][m][n][i], up = acc[ai][1][m][n][i]; o[n * 4 + i] = g * __builtin_amdgcn_rcpf(1.f + __expf(-g)) * up; }
            u32x4 w; w.x = cvt_pk_bf16(o[0], o[1]); w.y = cvt_pk_bf16(o[2], o[3]); w.z = cvt_pk_bf16(o[4], o[5]); w.w = cvt_pk_bf16(o[6], o[7]);
            *(u32x4*)rowp = w; }
    }
};
struct EpiRes {
    static constexpr bool PERM = true, AFTER_DRAIN = false;
    unsigned short* X; const float* gate; float coef;
    __device__ __forceinline__ void operator()(const f32x4 (&acc)[2][2][4][2], const Unit& u, int wr, int wc, int fr, int fq) const {
        const int row0 = u.pm * BM + wr * 64 + fr, col0 = u.pn * BM + wc * 32 + 8 * fq;
        const int rt = u.pm * BM; const int j = rt < 4096 ? 0 : 1 + ((rt - 4096) >> 12);
        const float* g = gate + j * 18432 + col0;
        f32x4 gv[2][2];
        EPI_LOOP_BJN gv[bj][n] = *(const f32x4*)(g + bj * HALF + n * 4) * coef;
        EPI_LOOP_AIM { unsigned short* rowp = X + (size_t)(row0 + ai * HALF + m * 16) * 2048 + col0;
#pragma unroll
            for (int bj = 0; bj < 2; ++bj) { const u32x4 w = *(const u32x4*)(rowp + bj * HALF);
                const f32x4 d0 = gv[bj][0] * acc[ai][bj][m][0], d1 = gv[bj][1] * acc[ai][bj][m][1];
                u32x4 o;
                o.x = pkh(h2f((unsigned short)(w.x & 0xffffu)) + d0[0], h2f((unsigned short)(w.x >> 16)) + d0[1]); o.y = pkh(h2f((unsigned short)(w.y & 0xffffu)) + d0[2], h2f((unsigned short)(w.y >> 16)) + d0[3]);
                o.z = pkh(h2f((unsigned short)(w.z & 0xffffu)) + d1[0], h2f((unsigned short)(w.z >> 16)) + d1[1]); o.w = pkh(h2f((unsigned short)(w.w & 0xffffu)) + d1[2], h2f((unsigned short)(w.w >> 16)) + d1[3]);
                *(u32x4*)(rowp + bj * HALF) = o; }
            asm volatile("" ::: "memory"); }
    }
};
struct EpiZT {
    static constexpr bool PERM = false, AFTER_DRAIN = false;
    float* ZTp; float* ZTs;
    __device__ __forceinline__ void operator()(const f32x4 (&acc)[2][2][4][2], const Unit& u, int wr, int wc, int fr, int fq) const {
        const int ch0 = u.pm * BM + wr * 64 + fr, tok0 = u.pn * BM;
        float* base; int pitch, toff;
        if (tok0 < 4096) { base = ZTp + (size_t)(tok0 >> 8) * 6144 * 256; pitch = 256; toff = 0; }
        else { const int tk = tok0 - 4096; base = ZTs + (size_t)(tk >> 12) * 6144 * 4096; pitch = 4096; toff = tk & 4095; }
        const int c0 = toff + wc * 32 + 4 * fq;
        EPI_LOOP_AIM { float* rowp = base + (size_t)(ch0 + ai * HALF + m * 16) * pitch + c0;
            EPI_LOOP_BJN *(f32x4*)(rowp + bj * HALF + n * 16) = acc[ai][bj][m][n]; }
    }
};
struct EpiVT {
    static constexpr bool PERM = true, AFTER_DRAIN = false;
    bf16_t* VTp; size_t s_off;
    __device__ __forceinline__ void operator()(const f32x4 (&acc)[2][2][4][2], const Unit& u, int wr, int wc, int fr, int fq) const {
        const int ch0 = u.pm * BM + wr * 64 + fr, tok0 = u.pn * BM;
        bf16_t* base; int pitch, toff; bf16_t* VTs = VTp + s_off;
        if (tok0 < 4096) { base = VTp + (size_t)(tok0 >> 8) * 1024 * 256; pitch = 256; toff = 0; }
        else if (tok0 < 12288) { const int tk = tok0 - 4096; base = VTs + (size_t)(tk >> 12) * 1024 * 4352; pitch = 4352; toff = tk & 4095; }
        else { const int tk = tok0 - 12288; base = VTs + (size_t)(tk >> 8) * 1024 * 4352; pitch = 4352; toff = 4096; }
        const int c0 = toff + wc * 32 + 8 * fq;
        EPI_LOOP_AIM { bf16_t* rowp = base + (size_t)(ch0 + ai * HALF + m * 16) * pitch + c0;
#pragma unroll
            for (int bj = 0; bj < 2; ++bj) { const f32x4 v0 = acc[ai][bj][m][0], v1 = acc[ai][bj][m][1];
                u32x4 w; w.x = cvt_pk_bf16(v0[0], v0[1]); w.y = cvt_pk_bf16(v0[2], v0[3]); w.z = cvt_pk_bf16(v1[0], v1[1]); w.w = cvt_pk_bf16(v1[2], v1[3]);
                *(u32x4*)(rowp + bj * HALF) = w; } }
    }
};
struct EpiQ {
    static constexpr bool PERM = true, AFTER_DRAIN = false;
    bf16_t* Q; const float* rope; float qs;
    __device__ __forceinline__ void operator()(const f32x4 (&acc)[2][2][4][2], const Unit& u, int wr, int wc, int fr, int fq) const {
        const int row0 = u.pm * BM + wr * 64 + fr;
        EPI_LOOP_AIM { const int row = row0 + ai * HALF + m * 16; const bool smp = row >= 4096; const int t = (row - 4096) & 4095;
#pragma unroll
            for (int bj = 0; bj < 2; ++bj) { const int c0 = u.pn * BM + bj * HALF + wc * 32 + 8 * fq; const int within = c0 % 192;
                float o[8];
#pragma unroll
                for (int n = 0; n < 2; ++n)
#pragma unroll
                    for (int i = 0; i < 4; ++i) o[n * 4 + i] = acc[ai][bj][m][n][i];
                if (within >= 128 && smp) { const int ri = within - 128;
#pragma unroll
                    for (int q = 0; q < 4; ++q) { const int idx = ri + 2 * q, hf = idx >> 5, j = (idx & 31) >> 1; const int pos = hf ? (t & 63) : (t >> 6);
                        const float2 cs = *(const float2*)(rope + (pos * 16 + j) * 2); const float x1 = o[2 * q], x2 = o[2 * q + 1];
                        o[2 * q] = x1 * cs.x - x2 * cs.y; o[2 * q + 1] = x2 * cs.x + x1 * cs.y; } }
                u32x4 w; w.x = cvt_pk_bf16(o[0] * qs, o[1] * qs); w.y = cvt_pk_bf16(o[2] * qs, o[3] * qs); w.z = cvt_pk_bf16(o[4] * qs, o[5] * qs); w.w = cvt_pk_bf16(o[6] * qs, o[7] * qs);
                *(u32x4*)(Q + (size_t)row * 1536 + c0) = w; } }
    }
};
struct EpiLora {
    static constexpr bool PERM = false, AFTER_DRAIN = false;
    unsigned char* wsb; const float* w0; const float* a0; const float* ka; size_t off_sc, off_kb, off_gb;
    __device__ __forceinline__ void operator()(const f32x4 (&acc)[2][2][4][2], const Unit& u, int wr, int wc, int fr, int fq) const {
        const int row0 = u.pm * BM + wr * 64 + fr; const int seg = u.pn >> 2; const int cb = (u.pn & 3) * BM + wc * 32 + 4 * fq;
        float* SC = (float*)(wsb + off_sc); const float* KB = (const float*)(wsb + off_kb); float* GB = (float*)(wsb + off_gb);
        EPI_LOOP_AIM { const int row = row0 + ai * HALF + m * 16; float* sc = SC + (size_t)row * 9216;
            EPI_LOOP_BJN { const int c = cb + bj * HALF + n * 16; const f32x4 a = acc[ai][bj][m][n];
                if (seg < 2) { const f32x4 wv = *(const f32x4*)(w0 + seg * 1024 + c); f32x4 o;
#pragma unroll
                    for (int i = 0; i < 4; ++i) { const float x = wv[i] + a[i]; const float sp = __logf(1.f + __expf(-x)); o[i] = __expf(-__expf(-sp - 0.5f)); }
                    *(f32x4*)(sc + (3 + seg) * 1024 + c) = o; }
                else if (seg < 4) { const int d = seg - 2; const f32x4 av = *(const f32x4*)(a0 + d * 1024 + c), kav = *(const f32x4*)(ka + c);
                    const f32x4 kk = *(const f32x4*)(sc + 2 * 1024 + c), kr = *(const f32x4*)(KB + (size_t)row * 1024 + c); f32x4 o1, o2;
#pragma unroll
                    for (int i = 0; i < 4; ++i) { const float s = __builtin_amdgcn_rcpf(1.f + __expf(-(av[i] + a[i]))); o1[i] = kk[i] * s; o2[i] = kr[i] * (1.f + (s - 1.f) * kav[i]); }
                    *(f32x4*)(sc + (5 + d) * 1024 + c) = o1; *(f32x4*)(sc + (7 + d) * 1024 + c) = o2; }
                else *(f32x4*)(GB + (size_t)row * 1024 + c) = a; }
            asm volatile("" ::: "memory"); }
    }
};
template <class Epi, class Sched, bool ALIGN_EPI = false, bool SP2 = false>
__device__ __forceinline__ void gemm_phase(PG8_LAS unsigned char* lds, const Gemm g, const Sched& S, const Epi& E, int wave_id) {
    const int tid_l_ = wave_id * 64 + lane_id_v();
    const int tid = tid_l_, wid = __builtin_amdgcn_readfirstlane(tid >> 6), lane = tid & 63, wr = wid >> 2, wc = wid & 3, fr = lane & 15, fq = lane >> 4;
    const int K = g.K, nt = K / BK;
    unsigned voffA[2], voffB[2];
#pragma unroll
    for (int i = 0; i < 2; ++i) { int R, C; stage_rc(tid * 16 + i * 8192, R, C); const int Rb = Epi::PERM ? ((R & ~31) + perm32(R & 31)) : R;
        voffA[i] = (unsigned)(R * K + C) * 2u; voffB[i] = (unsigned)(Rb * K + C) * 2u; }
    const size_t kstep = (size_t)(BK * 2);
    const size_t hstep = (size_t)HALF * K * 2;
    const size_t tstep = 2 * hstep;
    const unsigned ldsw = (unsigned)wid * 1024u;
    const int aoff = lds_byte(wr * 64 + fr, fq * 8), boff = lds_byte(wc * 32 + fr, fq * 8);
#define PG8_SA(b, h) (((b) * 2 + (h)) * HTB)
#define PG8_SB(b, h) ((4 + (b) * 2 + (h)) * HTB)
#define PG8_STAGE(bufoff, gbase, voff) do { _Pragma("unroll") for (int _i = 0; _i < 2; ++_i) \
        __builtin_amdgcn_global_load_lds((const unsigned*)((const char*)(gbase) + (voff)[_i]), (PG8_LAS unsigned*)(lds + (bufoff) + ldsw + _i * 8192), 16, 0, 0); } while (0)
#define PG8_LDA(dst, b, h) do { _Pragma("unroll") for (int m = 0; m < 4; ++m) _Pragma("unroll") for (int k = 0; k < 2; ++k) dst[m][k] = *(const PG8_LAS bf16x8*)(lds + PG8_SA(b, h) + aoff + m * 2048 + k * 1024); } while (0)
#define PG8_LDB(dst, b, h) do { _Pragma("unroll") for (int n = 0; n < 2; ++n) _Pragma("unroll") for (int k = 0; k < 2; ++k) dst[n][k] = *(const PG8_LAS bf16x8*)(lds + PG8_SB(b, h) + boff + n * 2048 + k * 1024); } while (0)
#define PG8_MMA(ai, bj, At, Bt) do { __builtin_amdgcn_s_setprio(1); _Pragma("unroll") for (int m = 0; m < 4; ++m) _Pragma("unroll") for (int n = 0; n < 2; ++n) _Pragma("unroll") for (int k = 0; k < 2; ++k) \
        acc[ai][bj][m][n] = __builtin_amdgcn_mfma_f32_16x16x32_bf16(Bt[n][k], At[m][k], acc[ai][bj][m][n], 0, 0, 0); __builtin_amdgcn_s_setprio(0); } while (0)
#define PG8_WAIT_V(n) asm volatile("s_waitcnt vmcnt(" #n ")" ::: "memory")
#define PG8_WAIT_L(n) asm volatile("s_waitcnt lgkmcnt(" #n ")" ::: "memory")
#define PG8_BAR __builtin_amdgcn_s_barrier()
#define PG8_SCHED __builtin_amdgcn_sched_barrier(0)
    Unit cur, nxt; int ui = 0;
    if (!S.next(0, cur)) return;
    f32x4 acc[2][2][4][2];
#pragma unroll
    for (int a = 0; a < 2; ++a)
#pragma unroll
        for (int b = 0; b < 2; ++b)
#pragma unroll
            for (int m = 0; m < 4; ++m)
#pragma unroll
                for (int n = 0; n < 2; ++n) acc[a][b][m][n] = (f32x4){0.f, 0.f, 0.f, 0.f};
    bf16x8 At[4][2], B0[2][2], B1[2][2];
    const char* cA = (const char*)g.A + (size_t)cur.pm * tstep; const char* cB = (const char*)g.Bt + (size_t)cur.pn * tstep;
    if constexpr (Sched::SPLITK != 0) { cA += (size_t)cur.kt0 * kstep; cB += (size_t)cur.kt0 * kstep; }
    S.a_ready(cur);
    if constexpr (SP2) {
        PG8_STAGE(PG8_SB(0, 0), cB, voffB); PG8_STAGE(PG8_SB(0, 1), cB + hstep, voffB); PG8_STAGE(PG8_SA(0, 0), cA, voffA); PG8_STAGE(PG8_SA(0, 1), cA + hstep, voffA);
        if (wr == 1) PG8_BAR;
        PG8_WAIT_V(2); PG8_BAR;
        PG8_STAGE(PG8_SB(1, 0), cB + kstep, voffB); PG8_STAGE(PG8_SA(1, 0), cA + kstep, voffA); PG8_STAGE(PG8_SB(1, 1), cB + hstep + kstep, voffB);
        PG8_WAIT_V(6); PG8_BAR;
    } else {
        PG8_STAGE(PG8_SB(0, 0), cB, voffB); PG8_STAGE(PG8_SA(0, 0), cA, voffA); PG8_STAGE(PG8_SB(0, 1), cB + hstep, voffB); PG8_STAGE(PG8_SA(0, 1), cA + hstep, voffA);
        if (wr == 1) PG8_BAR;
        PG8_WAIT_V(4); PG8_BAR;
        PG8_STAGE(PG8_SB(1, 0), cB + kstep, voffB); PG8_STAGE(PG8_SA(1, 0), cA + kstep, voffA); PG8_STAGE(PG8_SB(1, 1), cB + hstep + kstep, voffB);
        PG8_WAIT_V(6); PG8_BAR;
    }
    for (;;) {
        const bool has_next = S.next(ui + 1, nxt);
        const char* nA = has_next ? (const char*)g.A + (size_t)nxt.pm * tstep : cA; const char* nB = has_next ? (const char*)g.Bt + (size_t)nxt.pn * tstep : cB;
        if constexpr (Sched::SPLITK != 0) { if (has_next) { nA += (size_t)nxt.kt0 * kstep; nB += (size_t)nxt.kt0 * kstep; } }
        const int cnt = Sched::SPLITK != 0 ? cur.nkt : nt;
        for (int t = 0; t < cnt; t += 2) {
            const bool last = (t == cnt - 2);
            const char* a1 = cA + (size_t)(t + 1) * kstep;
            const char* a2 = last ? nA : cA + (size_t)(t + 2) * kstep; const char* b2 = last ? nB : cB + (size_t)(t + 2) * kstep;
            const char* a3 = a2 + kstep; const char* b3 = b2 + kstep;
            if (last && has_next) S.a_ready(nxt);
            if constexpr (SP2) {
            PG8_LDB(B0, 0, 0); PG8_LDB(B1, 0, 1); PG8_SCHED; PG8_LDA(At, 0, 0); PG8_STAGE(PG8_SA(1, 1), a1 + hstep, voffA);
            PG8_WAIT_V(8); PG8_WAIT_L(0); PG8_BAR; PG8_MMA(0, 0, At, B0); PG8_MMA(0, 1, At, B1); PG8_BAR; PG8_SCHED;
            PG8_LDA(At, 0, 1); PG8_STAGE(PG8_SB(0, 0), b2, voffB); PG8_STAGE(PG8_SB(0, 1), b2 + hstep, voffB); PG8_STAGE(PG8_SA(0, 0), a2, voffA);
            PG8_WAIT_V(8); PG8_WAIT_L(0); PG8_BAR; PG8_MMA(1, 0, At, B0); PG8_MMA(1, 1, At, B1); PG8_BAR; PG8_SCHED;
            PG8_LDB(B0, 1, 0); PG8_LDB(B1, 1, 1); PG8_SCHED; PG8_LDA(At, 1, 0); PG8_STAGE(PG8_SA(0, 1), a2 + hstep, voffA);
            PG8_WAIT_V(8); PG8_WAIT_L(0); PG8_BAR; PG8_MMA(0, 0, At, B0); PG8_MMA(0, 1, At, B1); PG8_BAR; PG8_SCHED;
            PG8_LDA(At, 1, 1); PG8_STAGE(PG8_SB(1, 0), b3, voffB); PG8_STAGE(PG8_SB(1, 1), b3 + hstep, voffB); PG8_STAGE(PG8_SA(1, 0), a3, voffA);
            PG8_WAIT_V(8); PG8_WAIT_L(0); PG8_BAR; PG8_MMA(1, 0, At, B0); PG8_MMA(1, 1, At, B1); PG8_BAR; PG8_SCHED;
            } else {
            PG8_LDB(B0, 0, 0); PG8_SCHED; PG8_LDA(At, 0, 0); PG8_STAGE(PG8_SA(1, 1), a1 + hstep, voffA);
            PG8_WAIT_L(8); PG8_BAR; PG8_WAIT_L(0); PG8_MMA(0, 0, At, B0); PG8_BAR; PG8_SCHED;
            PG8_LDB(B1, 0, 1); PG8_STAGE(PG8_SB(0, 0), b2, voffB);
            PG8_BAR; PG8_WAIT_L(0); PG8_MMA(0, 1, At, B1); PG8_BAR;
            PG8_LDA(At, 0, 1); PG8_STAGE(PG8_SA(0, 0), a2, voffA);
            PG8_BAR; PG8_WAIT_L(0); PG8_MMA(1, 0, At, B0); PG8_BAR; PG8_SCHED;
            PG8_STAGE(PG8_SB(0, 1), b2 + hstep, voffB);
            PG8_WAIT_V(6); PG8_BAR; PG8_MMA(1, 1, At, B1); PG8_BAR;
            PG8_LDB(B0, 1, 0); PG8_SCHED; PG8_LDA(At, 1, 0); PG8_STAGE(PG8_SA(0, 1), a2 + hstep, voffA);
            PG8_WAIT_L(8); PG8_BAR; PG8_WAIT_L(0); PG8_MMA(0, 0, At, B0); PG8_BAR; PG8_SCHED;
            PG8_LDB(B1, 1, 1); PG8_STAGE(PG8_SB(1, 0), b3, voffB);
            PG8_BAR; PG8_WAIT_L(0); PG8_MMA(0, 1, At, B1); PG8_BAR;
            PG8_LDA(At, 1, 1); PG8_STAGE(PG8_SA(1, 0), a3, voffA);
            PG8_BAR; PG8_WAIT_L(0); PG8_MMA(1, 0, At, B0); PG8_BAR; PG8_SCHED;
            PG8_STAGE(PG8_SB(1, 1), b3 + hstep, voffB);
            PG8_WAIT_V(6); PG8_BAR; PG8_MMA(1, 1, At, B1); PG8_BAR;
            }
        }
        if constexpr (ALIGN_EPI) { if (wr == 0) PG8_BAR; }
        if constexpr (Sched::SPLITK == 1) { if (cur.mode == 1) S.publish(acc, cur, wid, lane); else E(acc, cur, wr, wc, fr, fq); S.done(cur); }
        else if constexpr (Sched::SPLITK == 2) { S.consume(acc, cur, wid, lane); E(acc, cur, wr, wc, fr, fq); S.done(cur); }
        else if constexpr (!Epi::AFTER_DRAIN) { E(acc, cur, wr, wc, fr, fq); S.done(cur); }
        if (!has_next) break;
#pragma unroll
        for (int a = 0; a < 2; ++a)
#pragma unroll
            for (int b = 0; b < 2; ++b)
#pragma unroll
                for (int m = 0; m < 4; ++m)
#pragma unroll
                    for (int n = 0; n < 2; ++n) acc[a][b][m][n] = (f32x4){0.f, 0.f, 0.f, 0.f};
        cur = nxt; cA = nA; cB = nB; ++ui;
        if constexpr (ALIGN_EPI) { if (wr == 1) PG8_BAR; }
    }
    PG8_WAIT_V(0);
    if constexpr (!ALIGN_EPI) { if (wr == 0) PG8_BAR; }
    PG8_BAR;
    if constexpr (Epi::AFTER_DRAIN) { E.fused(acc, cur, wr, wc, fr, fq, lds, wid, lane); S.done(cur); }
#undef PG8_SA
#undef PG8_SB
#undef PG8_STAGE
#undef PG8_LDA
#undef PG8_LDB
#undef PG8_MMA
#undef PG8_WAIT_V
#undef PG8_WAIT_L
#undef PG8_BAR
#undef PG8_SCHED
}
}
#define XB_TMO      128
#define XB_XCNT(j)  (256  + 64 * (j))
#define XB_XSUB(j)  (1280 + 64 * (j))
#define XB_XGEN(j)  (2304 + 64 * (j))
#define XB_TOP      3328
#define XB_TOPGEN   3392
#define XCD_BAR_WORDS 3456
#define XB_SPIN_CAP (1u << 18)

__device__ __forceinline__ unsigned xb_ld(unsigned* p)              { return __hip_atomic_load(p, __ATOMIC_RELAXED, __HIP_MEMORY_SCOPE_AGENT); }
__device__ __forceinline__ unsigned xb_add(unsigned* p, unsigned v) { return __hip_atomic_fetch_add(p, v, __ATOMIC_RELAXED, __HIP_MEMORY_SCOPE_AGENT); }
__device__ __forceinline__ unsigned xb_xcc_id() { return (unsigned)__builtin_amdgcn_s_getreg((3 << 11) | 20) & 0xFu; }
#define XB_SPIN(cond, bar) do { unsigned _sp = 0; while (cond) { __builtin_amdgcn_s_sleep(1); \
    if ((++_sp & 255u) == 0u) { if (xb_ld(&(bar)[XB_TMO])) break; if (_sp > XB_SPIN_CAP) { atomicAdd(&(bar)[XB_TMO], 1u); break; } } } } while (0)

struct XcdBarrier {
    unsigned* bar; unsigned x;
    volatile LAS unsigned* st;
};

__device__ __forceinline__ XcdBarrier xcd_barrier_post(unsigned* bar, volatile LAS unsigned* st, int tid_) {
    XcdBarrier b; b.bar = bar; b.x = xb_xcc_id(); b.st = st;
    if (tid_ == 0) (void)xb_add(&bar[XB_XCNT(b.x)], 1u);
    return b;
}
__device__ __forceinline__ void xcd_barrier_complete(unsigned* bar, unsigned x, unsigned& nloc, unsigned& nx) {
    const unsigned G = gridDim.x * gridDim.y * gridDim.z;
    unsigned sum, cnt, mine, sp = 0u;
    for (;;) {
        sum = 0u; cnt = 0u; mine = 0u;
#pragma unroll
        for (unsigned j = 0; j < 16; ++j) { const unsigned c = xb_ld(&bar[XB_XCNT(j)]); sum += c; cnt += (c > 0u) ? 1u : 0u; mine = (j == x) ? c : mine; }
        if (sum == G) break;
        __builtin_amdgcn_s_sleep(1);
        if ((++sp & 255u) == 0u) { if (xb_ld(&bar[XB_TMO])) break; if (sp > XB_SPIN_CAP) { atomicAdd(&bar[XB_TMO], 1u); break; } }
    }
    nloc = mine > 0u ? mine : 1u; nx = cnt > 0u ? cnt : 1u;
}

__device__ __forceinline__ void xcd_barrier(const XcdBarrier& b, int tid_) {
    asm volatile("s_waitcnt vmcnt(0)" ::: "memory");
    __syncthreads();
    if (tid_ == 0) {
        unsigned* bar = b.bar;
        __builtin_amdgcn_s_waitcnt(0);
        unsigned nloc = b.st[0], nx = b.st[1];
        if (nloc == 0u) { xcd_barrier_complete(bar, b.x, nloc, nx); b.st[0] = nloc; b.st[1] = nx; }
        const unsigned old = xb_add(&bar[XB_XSUB(b.x)], 1u);
        const unsigned gen = old / nloc;
        if (old + 1u == (gen + 1u) * nloc) {
            __builtin_amdgcn_fence(__ATOMIC_RELEASE, "agent");
            asm volatile("s_waitcnt vmcnt(0)" ::: "memory");
            const unsigned og = xb_add(&bar[XB_TOP], 1u);
            const unsigned tg = og / nx;
            if (og + 1u == (tg + 1u) * nx) xb_add(&bar[XB_TOPGEN], 1u);
            else XB_SPIN(xb_ld(&bar[XB_TOPGEN]) == tg, bar);
            __builtin_amdgcn_fence(__ATOMIC_ACQUIRE, "agent");
            xb_add(&bar[XB_XGEN(b.x)], 1u);
            asm volatile("s_waitcnt vmcnt(0)" ::: "memory");
        } else {
            XB_SPIN(xb_ld(&bar[XB_XGEN(b.x)]) == gen, bar);
            __builtin_amdgcn_fence(__ATOMIC_ACQUIRE, "agent");
            asm volatile("s_waitcnt vmcnt(0)" ::: "memory");
        }
    }
    __syncthreads();
}

constexpr size_t MiB = 1u << 20;
constexpr size_t WS_CTL = 0, CTL_ZERO_BYTES = 2 * MiB;
constexpr size_t WS_MOD = 2 * MiB;
constexpr size_t WS_PMOD = WS_MOD + 2 * MiB;
constexpr size_t WS_ROPE = WS_PMOD + 8 * MiB;
constexpr size_t WS_W1T = WS_ROPE + 2 * MiB;
constexpr size_t WS_W2T = WS_W1T + 352 * MiB;
constexpr size_t WS_WINE = WS_W2T + 176 * MiB;
constexpr size_t WS_WOUTE = WS_WINE + 34 * MiB;
constexpr size_t WS_WINO = WS_WOUTE + 16 * MiB;
constexpr size_t WS_WOUTO = WS_WINO + 48 * MiB;
constexpr size_t WS_WQ = WS_WOUTO + 16 * MiB;
constexpr size_t WS_WKN = WS_WQ + 4 * MiB;
constexpr size_t WS_WV = WS_WKN + 2 * MiB;
constexpr size_t WS_WLORA = WS_WV + 2 * MiB;
constexpr size_t WS_W3T = WS_WLORA + 8 * MiB;
constexpr size_t WS_H2 = WS_W3T + 8 * MiB;
constexpr size_t WS_X = WS_H2 + 4 * MiB;
constexpr size_t WS_H = WS_X + 96 * MiB;
constexpr size_t WS_ACT = WS_H + 48 * MiB;
constexpr size_t WS_Z = WS_ACT + 132 * MiB;
constexpr size_t WS_SCAN = WS_Z + 288 * MiB;
constexpr size_t SCAN_BYTES = 432 * MiB;
constexpr size_t WS_KBUF = WS_SCAN + 2 * SCAN_BYTES;
constexpr size_t WS_LA = WS_KBUF + 48 * MiB;
constexpr size_t WS_GB = WS_LA + 10 * MiB;
constexpr size_t WS_CQ = WS_GB + 48 * MiB;
constexpr size_t WS_CKV = WS_CQ + 12 * MiB;
constexpr size_t WS_KR = WS_CKV + 8 * MiB;
constexpr size_t WS_Q = WS_KR + 2 * MiB;
constexpr size_t WS_KN = WS_Q + 36 * MiB;
constexpr size_t WS_VT = WS_KN + 26 * MiB;
constexpr size_t WS_YSC = WS_VT + 26 * MiB;
constexpr size_t WS_PQ = WS_ACT;
constexpr size_t WS_SST = WS_ACT + 64 * MiB;
constexpr size_t WS_PST = WS_ACT + 96 * MiB;
constexpr size_t WS_MIX = WS_YSC + 96 * MiB;
constexpr size_t WS_KSS = WS_MIX + 48 * MiB;
constexpr size_t WS_KSP = WS_KSS + 258 * MiB;
constexpr size_t WS_END = WS_KSP + 18 * MiB;
static_assert((size_t)NCH * 64 * 2 * 16384 <= 64 * MiB && (size_t)NCH * 64 * 16384 <= 32 * MiB, "PQ / SST inside the ACT region");
constexpr size_t ZT_S_OFF = (size_t)16 * 6144 * 256 * 4;
constexpr size_t VT_S_OFF = (size_t)16 * 1024 * 256 * 2;

constexpr size_t OUT_YS = (size_t)MP * D, OUT_CKV = (size_t)MT * D, OUT_KR = OUT_CKV + 16 * 2 * 256 * 256, OUT_ST = OUT_KR + 16 * 2 * 256 * 64, OUT_END = OUT_ST + (size_t)16 * 2 * 2 * 16 * 64 * 64;

constexpr int LDS_RING = 131072, LDS_BYTES = 147456, LDS_CTL = LDS_BYTES - 512;

struct KArgs { const float* in[42]; float* out; unsigned char* ws; int ph_lo, ph_hi; };
enum { I_XP = 0, I_XS, I_CCKV, I_CKR, I_ST, I_C, I_CCTX, I_WMOD, I_BMOD, I_NG, I_WFI, I_WFO, I_FNG, I_WINE, I_MUP, I_MUN, I_W0, I_W2, I_A0, I_A2, I_G2, I_KK, I_KA, I_RK, I_GNW, I_GNB,
       I_QN, I_KVN, I_WQB, I_WKVB, I_WOE, I_WINO, I_CW, I_CB, I_FW1, I_FB1, I_FW2, I_FB2, I_FW3, I_FFR, I_HB, I_WOO };

struct Ctx {
    LAS unsigned char* lds; unsigned char* ws; const float* const* in; float* out;
    int tid, lane, wave, G, gw, NGW, vb, bx, zs;
};

DI void tr_item(const float* W, int ldw, int K, bf16* WT, int dstrow0, int srccol0, int k0, LAS float* scr, int lane) {
    float v[32];
#pragma unroll
    for (int i = 0; i < 32; ++i) v[i] = W[(size_t)(k0 + 2 * i + (lane >> 5)) * ldw + srccol0 + (lane & 31)];
#pragma unroll
    for (int i = 0; i < 32; ++i) scr[(2 * i + (lane >> 5)) * 33 + (lane & 31)] = v[i];
    asm volatile("s_waitcnt lgkmcnt(0)" ::: "memory");
    const int c = lane & 7;
#pragma unroll
    for (int j = 0; j < 4; ++j) { const int n = (lane >> 3) + 8 * j; const LAS float* s = scr + (8 * c) * 33 + n;
        v4u o; o.x = pk2(s[0 * 33], s[1 * 33]); o.y = pk2(s[2 * 33], s[3 * 33]); o.z = pk2(s[4 * 33], s[5 * 33]); o.w = pk2(s[6 * 33], s[7 * 33]);
        *(v4u*)(WT + (size_t)(dstrow0 + n) * K + k0 + 8 * c) = o; }
    asm volatile("s_waitcnt lgkmcnt(0)" ::: "memory");
}
template <int MODE> DI void tr_matrix(Ctx& C, const float* W, int ldw, int K, bf16* WT, int ndst, int nsrc, int gw, int NGW) {
    LAS float* scr = (LAS float*)(C.lds + C.wave * 8704);
    const int nkb = K / 64, nnb = ndst / 32, nit = nkb * nnb;
    for (int it = gw; it < nit; it += NGW) {
        const int kb = it / nnb, nb = it % nnb, dr = nb * 32;
        int sc = dr;
        if (MODE == 1) { const int p = dr >> 8, sg = (dr >> 7) & 1, j = dr & 127; sc = sg * 5632 + 128 * p + j; }
        if (MODE == 2 && dr >= nsrc) {
            const int c = C.lane & 7;
#pragma unroll
            for (int j = 0; j < 4; ++j) { const int n = (C.lane >> 3) + 8 * j; *(v4u*)(WT + (size_t)(dr + n) * K + kb * 64 + 8 * c) = (v4u){0u, 0u, 0u, 0u}; }
            continue;
        }
        tr_item(W, ldw, K, WT, dr, sc, kb * 64, scr, C.lane);
    }
}
template <class Fn> DI void cvt_small(Ctx& C, bf16* dst, int N, int K, Fn f) {
    const int total = N * (K / 8);
    for (int idx = C.bx * 512 + C.tid; idx < total; idx += C.G * 512) {
        const int n = idx % N, k8 = idx / N; float v[8];
#pragma unroll
        for (int i = 0; i < 8; ++i) v[i] = f(n, k8 * 8 + i);
        v4u o; o.x = pk2(v[0], v[1]); o.y = pk2(v[2], v[3]); o.z = pk2(v[4], v[5]); o.w = pk2(v[6], v[7]);
        *(v4u*)(dst + (size_t)n * K + k8 * 8) = o;
    }
}

DI void phase_prologue(Ctx& C) {
    const float* const* in = C.in; unsigned char* ws = C.ws;
    tr_matrix<1>(C, in[I_WFI], NFF1, 2048, (bf16*)(ws + WS_W1T), NFF1, NFF1, C.gw, C.NGW);
    tr_matrix<0>(C, in[I_WFO], 2048, DFF, (bf16*)(ws + WS_W2T), 2048, 2048, C.gw, C.NGW);
    for (int i = 0; i < 2; ++i) tr_matrix<2>(C, in[I_WINE] + (size_t)i * 2048 * ZE_N, ZE_N, 2048, (bf16*)(ws + WS_WINE) + (size_t)i * ZE_P * 2048, ZE_P, ZE_N, C.gw, C.NGW);
    for (int i = 0; i < 2; ++i) tr_matrix<0>(C, in[I_WOE] + (size_t)i * 2048 * 2048, 2048, 2048, (bf16*)(ws + WS_WOUTE) + (size_t)i * 2048 * 2048, 2048, 2048, C.gw, C.NGW);
    for (int i = 0; i < 2; ++i) tr_matrix<0>(C, in[I_WINO] + (size_t)i * 2048 * 6144, 6144, 2048, (bf16*)(ws + WS_WINO) + (size_t)i * 6144 * 2048, 6144, 6144, C.gw, C.NGW);
    for (int i = 0; i < 2; ++i) tr_matrix<0>(C, in[I_WOO] + (size_t)i * 2048 * 2048, 2048, 2048, (bf16*)(ws + WS_WOUTO) + (size_t)i * 2048 * 2048, 2048, 2048, C.gw, C.NGW);
    for (int e = 0; e < 2; ++e) {
        const float* wqb = in[I_WQB] + (size_t)e * 512 * 1536;
        cvt_small(C, (bf16*)(ws + WS_WQ) + (size_t)e * 1536 * 512, 1536, 512, [=](int n, int k) { const int hd = n / 192, wi = n % 192; int sc;
            if (wi < 128) sc = wi; else { const int idx = wi - 128, hf = idx >> 5, r = idx & 31; sc = 128 + 32 * hf + 16 * (r & 1) + (r >> 1); }
            return wqb[(size_t)k * 1536 + hd * 192 + sc]; });
        const float* wkv = in[I_WKVB] + (size_t)e * 256 * 2048;
        cvt_small(C, (bf16*)(ws + WS_WKN) + (size_t)e * 1024 * 256, 1024, 256, [=](int n, int k) { return wkv[(size_t)k * 2048 + (n >> 7) * 256 + (n & 127)]; });
        cvt_small(C, (bf16*)(ws + WS_WV) + (size_t)e * 1024 * 256, 1024, 256, [=](int n, int k) { return wkv[(size_t)k * 2048 + (n >> 7) * 256 + 128 + (n & 127)]; });
        const float* w2 = in[I_W2] + (size_t)e * 2 * 64 * 1024; const float* a2 = in[I_A2] + (size_t)e * 2 * 64 * 1024; const float* g2 = in[I_G2] + (size_t)e * 160 * 1024;
        cvt_small(C, (bf16*)(ws + WS_WLORA) + (size_t)e * 5120 * 384, 5120, 384, [=](int n, int k) { const int seg = n >> 10, c = n & 1023; float v = 0.f;
            if (seg < 2) { if (k < 64) v = w2[((size_t)seg * 64 + k) * 1024 + c]; }
            else if (seg < 4) { if (k >= 64 && k < 128) v = a2[((size_t)(seg - 2) * 64 + (k - 64)) * 1024 + c]; }
            else { if (k >= 128 && k < 288) v = g2[(size_t)(k - 128) * 1024 + c]; }
            return v; });
    }
    { const float* w3 = in[I_FW3];
      cvt_small(C, (bf16*)(ws + WS_W3T), 16384, 256, [=](int n, int k) { const int o = n >> 13, col = n & 8191; float v = 0.f; if ((k >> 6) == o) v = w3[((size_t)o * 64 + (k & 63)) * 8192 + col]; return v; }); }
    { LAS float* sl = (LAS float*)(C.lds + 8 * 8704);
      for (int it = C.bx; it < 4 * 8 * 9; it += C.G) {
          const int l = it / 72, kc = (it / 9) % 8, cc = it % 9;
          __syncthreads();
          for (int i = C.tid; i < 768; i += 512) { const int j = i >> 8, k = kc * 256 + (i & 255); const float cv = j == 0 ? in[I_CCTX][k] : in[I_C][(j - 1) * 2048 + k]; sl[i] = silu_f(cv); }
          __syncthreads();
          const int col = cc * 2048 + 4 * C.tid; const float* wp = in[I_WMOD] + ((size_t)l * 2048 + kc * 256) * 18432 + col;
          f32x4v a0 = {0.f, 0.f, 0.f, 0.f}, a1 = a0, a2 = a0;
#pragma unroll 4
          for (int k = 0; k < 256; ++k) { const f32x4v w = *(const f32x4v*)(wp + (size_t)k * 18432); a0 += w * sl[k]; a1 += w * sl[256 + k]; a2 += w * sl[512 + k]; }
          float* pm = (float*)(ws + WS_PMOD) + ((size_t)(kc * 4 + l) * 3) * 18432 + col;
          *(f32x4v*)(pm) = a0; *(f32x4v*)(pm + 18432) = a1; *(f32x4v*)(pm + 2 * 18432) = a2;
      }
      __syncthreads(); }
    { const f32x4v* s0 = (const f32x4v*)in[I_XP]; const f32x4v* s1 = (const f32x4v*)in[I_XS]; v2u* x = (v2u*)(ws + WS_X);
      const size_t n0 = (size_t)MP * D / 4, n1 = (size_t)MS * D / 4;
      for (size_t i = (size_t)C.bx * 512 + C.tid; i < n0 + n1; i += (size_t)C.G * 512) x[i] = h4_pack(i < n0 ? s0[i] : s1[i - n0]); }
    if (C.bx == 0) for (int i = C.tid; i < 1024; i += 512) { const int pos = i >> 4, j = i & 15; const float inv = 1.0f / powf(10000.0f, (float)(2 * j) / 32.0f); const float a = (float)pos * inv;
        float* r = (float*)(ws + WS_ROPE) + i * 2; r[0] = cosf(a); r[1] = sinf(a); }
    { bf16* H2 = (bf16*)(ws + WS_H2);
      for (int it = C.gw; it < 2 * 4352; it += C.NGW) {
          const int o = it / 4352, rr = it % 4352; const int L = rr < 256 ? 256 : 4096, t = rr < 256 ? rr : rr - 256; const int lane = C.lane;
          float zf = 0.f;
          if (lane == 0) zf = (float)t / (float)(L - 1);
          else if (lane < 33) { const int b = (lane - 1) & 15; const float fr = 1e-4f + (15.0f - 1e-4f) * ((float)b / 15.0f); const float ang = ((float)(2.0 * 3.14159265358979323846 / (double)L) * (float)t) * fr; zf = lane < 17 ? cosf(ang) : -sinf(ang); }
          const float* w1 = in[I_FW1] + (size_t)o * 33 * 64; const float* w2 = in[I_FW2] + (size_t)o * 64 * 64;
          float s = in[I_FB1][o * 64 + lane];
          for (int i = 0; i < 33; ++i) s += shfl_idx(zf, i) * w1[i * 64 + lane];
          const float h1 = sinf(in[I_FFR][(o * 2 + 0) * 64 + lane] * s);
          float s2 = in[I_FB2][o * 64 + lane];
          for (int i = 0; i < 64; ++i) s2 += shfl_idx(h1, i) * w2[i * 64 + lane];
          const float h2 = sinf(in[I_FFR][(o * 2 + 1) * 64 + lane] * s2);
          H2[(size_t)rr * 256 + o * 64 + lane] = (bf16)f2bf(h2);
          if (o == 0) { H2[(size_t)rr * 256 + 128 + lane] = 0; H2[(size_t)rr * 256 + 192 + lane] = 0; }
      } }
}
DI void phase_mod_reduce(Ctx& C) {
    const float* pm = (const float*)(C.ws + WS_PMOD); float* mod = (float*)(C.ws + WS_MOD); const float* bm = C.in[I_BMOD];
    for (int i = C.bx * 512 + C.tid; i < 4 * 3 * 18432; i += C.G * 512) { const int l = i / MODL, n = i % 18432; float s = bm[l * 18432 + n];
#pragma unroll
        for (int kc = 0; kc < 8; ++kc) s += pm[(size_t)kc * 4 * MODL + i];
        mod[i] = s; }
}
DI void phase_norm_mod(Ctx& C, const float* g, const float* modl, int s) {
    const unsigned short* X = (const unsigned short*)(C.ws + WS_X); bf16* H = (bf16*)(C.ws + WS_H);
    for (int row = C.gw; row < MT; row += C.NGW) {
        const float* sh = modl + row_mod_j(row) * 18432 + (3 * s) * 2048; const float* scl = sh + 2048;
        const v4u* xr = (const v4u*)(X + (size_t)row * D) + C.lane; f32x4v v[8]; float ss = 0.f;
#pragma unroll
        for (int i = 0; i < 4; ++i) { const v4u w = xr[64 * i]; v[2 * i] = h4_unpack((v2u){w.x, w.y}); v[2 * i + 1] = h4_unpack((v2u){w.z, w.w}); }
#pragma unroll
        for (int i = 0; i < 8; ++i) ss += (v[i].x * v[i].x + v[i].y * v[i].y) + (v[i].z * v[i].z + v[i].w * v[i].w);
        const float rstd = 1.0f / sqrtf(wave_sum(ss) * (1.0f / D) + 1e-6f);
        v4u* o = (v4u*)(H + (size_t)row * D) + C.lane;
#pragma unroll
        for (int i = 0; i < 4; ++i) { v4u w;
#pragma unroll
            for (int hh = 0; hh < 2; ++hh) { const int c = 8 * C.lane + 512 * i + 4 * hh; const f32x4v gg = *(const f32x4v*)(g + c), sc = *(const f32x4v*)(scl + c), sf = *(const f32x4v*)(sh + c);
                const f32x4v y = (v[2 * i + hh] * rstd * gg) * (sc + 1.0f) + sf; if (hh == 0) { w.x = pk2(y.x, y.y); w.y = pk2(y.z, y.w); } else { w.z = pk2(y.x, y.y); w.w = pk2(y.z, y.w); } }
            o[64 * i] = w; }
    }
}
DI void phase_final_norm(Ctx& C) {
    const unsigned short* X = (const unsigned short*)(C.ws + WS_X); const float* g = C.in[I_FNG];
    for (int row = C.gw; row < MT; row += C.NGW) {
        const v2u* xr = (const v2u*)(X + (size_t)row * D) + C.lane; f32x4v v[8]; float ss = 0.f;
#pragma unroll
        for (int i = 0; i < 8; ++i) { v[i] = h4_unpack(xr[64 * i]); ss += (v[i].x * v[i].x + v[i].y * v[i].y) + (v[i].z * v[i].z + v[i].w * v[i].w); }
        const float rstd = 1.0f / sqrtf(wave_sum(ss) * (1.0f / D) + 1e-6f);
        f32x4v* o = (f32x4v*)(C.out + (size_t)row * D) + C.lane;
#pragma unroll
        for (int i = 0; i < 8; ++i) { const f32x4v gg = *(const f32x4v*)(g + 4 * C.lane + 256 * i); o[64 * i] = v[i] * rstd * gg; }
    }
}

DI int rope_src(int p) { const int hf = p >> 5, r = p & 31; return 32 * hf + 16 * (r & 1) + (r >> 1); }
DI void phase_even_prep(Ctx& C, int e) {
    const float* const* in = C.in; unsigned char* ws = C.ws; const int lane = C.lane;
    const float* Z = (const float*)(ws + WS_Z); float* SC = (float*)(ws + WS_SCAN + (size_t)e * SCAN_BYTES); float* KB = (float*)(ws + WS_KBUF); bf16* LA = (bf16*)(ws + WS_LA);
    bf16* CQ = (bf16*)(ws + WS_CQ); bf16* CKV = (bf16*)(ws + WS_CKV); bf16* KR = (bf16*)(ws + WS_KR); const float* rope = (const float*)(ws + WS_ROPE);
    const float* mup = in[I_MUP] + e * 3360; const float* mun = in[I_MUN] + e * 3360; const float* kkw = in[I_KK] + e * 1024;
    const float* qn = in[I_QN] + e * 512; const float* kvn = in[I_KVN] + e * 256;
    for (int row = C.gw; row < MKV; row += C.NGW) {
        if (row >= MT) {
            const int rr = row - MT, b = rr >> 8, p = rr & 255;
            const float* cs = in[I_CCKV] + ((size_t)(b * 2 + e) * 256 + p) * 256;
#pragma unroll
            for (int i = 0; i < 4; ++i) CKV[(size_t)row * 256 + 64 * i + lane] = (bf16)f2bf(cs[64 * i + lane]);
            KR[(size_t)row * 64 + lane] = (bf16)f2bf(in[I_CKR][((size_t)(b * 2 + e) * 256 + p) * 64 + rope_src(lane)]);
            continue;
        }
        const bool smp = row >= MP; const int T = smp ? 4096 : 256; const int t = smp ? ((row - MP) & 4095) : (row & 255);
        const float* z = Z + (size_t)row * ZE_P; const bool hp = t > 0, hn = t < T - 1;
        float* sc = SC + (size_t)row * SCAN_P;
#define ZMIX4(c) ({ const f32x4v zc_ = *(const f32x4v*)(z + (c)); const f32x4v zp_ = hp ? *(const f32x4v*)(z + (c) - ZE_P) : (f32x4v){0.f, 0.f, 0.f, 0.f}; const f32x4v zn_ = hn ? *(const f32x4v*)(z + (c) + ZE_P) : (f32x4v){0.f, 0.f, 0.f, 0.f}; \
            zc_ + *(const f32x4v*)(mup + (c)) * (zp_ - zc_) + *(const f32x4v*)(mun + (c)) * (zn_ - zc_); })
#define ZMIX(c) ({ const float zc_ = z[c]; const float zp_ = hp ? z[(c) - ZE_P] : 0.f; const float zn_ = hn ? z[(c) + ZE_P] : 0.f; zc_ + mup[c] * (zp_ - zc_) + mun[c] * (zn_ - zc_); })
#pragma unroll
        for (int i = 0; i < 4; ++i) { const int c = 256 * i + 4 * lane;
            *(f32x4v*)(sc + c) = ZMIX4(c);
            *(f32x4v*)(sc + 1024 + c) = ZMIX4(2048 + c);
            const f32x4v k = ZMIX4(1024 + c); *(f32x4v*)(KB + (size_t)row * 1024 + c) = k;
            const f32x4v kk = k * *(const f32x4v*)(kkw + c); float ss = (kk.x * kk.x + kk.y * kk.y) + (kk.z * kk.z + kk.w * kk.w);
            ss += dpp_f<0xB1>(ss); ss += dpp_f<0x4E>(ss); ss += dpp_f<0x141>(ss); ss += dpp_f<0x140>(ss);
            *(f32x4v*)(sc + 2048 + c) = kk * (1.0f / fmaxf(sqrtf(ss), 1e-12f)); }
        bf16* la = LA + (size_t)row * 384;
        la[lane] = (bf16)f2bf(tanhf(ZMIX(3072 + lane)));
        la[64 + lane] = (bf16)f2bf(ZMIX(3136 + lane));
        la[128 + lane] = (bf16)f2bf(sigmoid_f(ZMIX(3200 + lane)));
        la[192 + lane] = (bf16)f2bf(sigmoid_f(ZMIX(3264 + lane)));
        { float xg = 0.f; if (lane < 32) xg = sigmoid_f(ZMIX(3328 + lane)); la[256 + lane] = (bf16)(lane < 32 ? f2bf(xg) : 0u); la[320 + lane] = 0; }
#undef ZMIX4
#undef ZMIX
        float cq[8], ss = 0.f;
#pragma unroll
        for (int i = 0; i < 8; ++i) { cq[i] = z[3360 + 64 * i + lane]; ss += cq[i] * cq[i]; }
        float rstd = 1.0f / sqrtf(wave_sum(ss) * (1.0f / 512.0f) + 1e-6f);
#pragma unroll
        for (int i = 0; i < 8; ++i) CQ[(size_t)row * 512 + 64 * i + lane] = (bf16)f2bf(cq[i] * rstd * qn[64 * i + lane]);
        float ck[4]; ss = 0.f;
#pragma unroll
        for (int i = 0; i < 4; ++i) { ck[i] = z[3872 + 64 * i + lane]; ss += ck[i] * ck[i]; }
        rstd = 1.0f / sqrtf(wave_sum(ss) * (1.0f / 256.0f) + 1e-6f);
#pragma unroll
        for (int i = 0; i < 4; ++i) { const float y = ck[i] * rstd * kvn[64 * i + lane]; CKV[(size_t)row * 256 + 64 * i + lane] = (bf16)f2bf(y);
            if (!smp) C.out[OUT_CKV + ((size_t)((row >> 8) * 2 + e) * 256 + t) * 256 + 64 * i + lane] = y; }
        const float kr = z[4128 + lane];
        if (!smp) { C.out[OUT_KR + ((size_t)((row >> 8) * 2 + e) * 256 + t) * 64 + lane] = kr; KR[(size_t)row * 64 + lane] = (bf16)f2bf(shfl_idx(kr, rope_src(lane))); }
        else { const int hf = lane >> 5, jj = lane & 15, e2 = (lane >> 4) & 1; const int pos = hf ? (t & 63) : (t >> 6);
            const float xo = shfl_idx(kr, lane ^ 16); const float2 cs = *(const float2*)(rope + (pos * 16 + jj) * 2);
            const float rot = e2 == 0 ? kr * cs.x - xo * cs.y : kr * cs.x + xo * cs.y;
            KR[(size_t)row * 64 + lane] = (bf16)f2bf(shfl_idx(rot, rope_src(lane))); }
    }
}

template <int N> DI float fmac_bc(float acc, float op, float s) { asm("v_fmac_f32_dpp %0, %1, %2 row_newbcast:%3 row_mask:0xf bank_mask:0xf" : "+v"(acc) : "v"(op), "v"(s), "n"(N)); return acc; }
template <int N> DI float mul_bc(float op, float s) { float r; asm("v_mul_f32_dpp %0, %1, %2 row_newbcast:%3 row_mask:0xf bank_mask:0xf" : "=v"(r) : "v"(op), "v"(s), "n"(N)); return r; }
struct ScanOps { f32x4v kk, w, kka, kd, r; float vv; };
typedef __attribute__((__vector_size__(4 * sizeof(int)))) int rsrc_t;
DI f32x4v bl128(__amdgpu_buffer_rsrc_t r, unsigned vo, unsigned so) { return __builtin_bit_cast(f32x4v, __builtin_amdgcn_raw_buffer_load_b128(r, (int)vo, (int)so, 0)); }
DI float bl32(__amdgpu_buffer_rsrc_t r, unsigned vo, unsigned so) { return __builtin_bit_cast(float, __builtin_amdgcn_raw_buffer_load_b32(r, (int)vo, (int)so, 0)); }
template <int MODE> DI ScanOps scan_load(__amdgpu_buffer_rsrc_t rs, unsigned so, unsigned lo, unsigned lv, int d) {
    ScanOps o;
    o.kk = bl128(rs, lo + 2u * 4096u, so); o.w = bl128(rs, lo + (3u + (unsigned)d) * 4096u, so); o.kka = bl128(rs, lo + (5u + (unsigned)d) * 4096u, so);
    if (MODE != 0) { o.kd = bl128(rs, lo + (7u + (unsigned)d) * 4096u, so); o.vv = bl32(rs, lv + 4096u, so); } else { o.kd = (f32x4v){0.f, 0.f, 0.f, 0.f}; o.vv = 0.f; }
    if (MODE == 2) o.r = bl128(rs, lo, so); else o.r = (f32x4v){0.f, 0.f, 0.f, 0.f};
    return o;
}
template <int MODE, int J> DI void scan_col_a(const ScanOps& o, const float (&S)[64], float (&sa)[4]) { sa[J & 3] = fmac_bc<(J >> 2)>(sa[J & 3], o.kk[J & 3], S[J]); }
template <int MODE, int J> DI void scan_col_b(const ScanOps& o, float (&S)[64], float sa, float (&y)[4]) {
    float t = mul_bc<(J >> 2)>(o.w[J & 3], S[J]);
    t = fmac_bc<(J >> 2)>(t, o.kka[J & 3], sa);
    if (MODE != 0) t = fmac_bc<(J >> 2)>(t, o.kd[J & 3], o.vv);
    S[J] = t;
    if (MODE == 2) y[J & 3] = fmac_bc<(J >> 2)>(y[J & 3], o.r[J & 3], t);
}
template <int MODE, int... Js> DI float scan_step(const ScanOps& o, float (&S)[64], std::integer_sequence<int, Js...>) {
    float sa[4] = {0.f, 0.f, 0.f, 0.f}, y[4] = {0.f, 0.f, 0.f, 0.f};
    (scan_col_a<MODE, Js>(o, S, sa), ...);
    const float sat = -((sa[0] + sa[1]) + (sa[2] + sa[3]));
    (scan_col_b<MODE, Js>(o, S, sat, y), ...);
    return (y[0] + y[1]) + (y[2] + y[3]);
}
template <int MODE> DI void scan_wave(const float* SCp, int row0, int rstep, int nsteps, int h, int d, float (&S)[64], float* yout, int lane) {
    const __amdgpu_buffer_rsrc_t rs = __builtin_amdgcn_make_buffer_rsrc((void*)SCp, 0, (int)((size_t)MT * SCAN_P * 4), 0x00020000);
    const __amdgpu_buffer_rsrc_t ry = __builtin_amdgcn_make_buffer_rsrc((void*)yout, 0, (int)((size_t)MT * 1024 * 4), 0x00020000);
    const int so0 = (row0 * SCAN_P + h * 64) * 4, sstep = rstep * SCAN_P * 4, last = nsteps - 1;
    int yo = (row0 * 1024 + h * 64) * 4; const int ystep = rstep * 4096;
    const unsigned lo = 16u * (unsigned)(lane & 15), lv = 4u * (unsigned)lane;
#define SC_LD(s_) scan_load<MODE>(rs, (unsigned)(so0 + ((s_) < last ? (s_) : last) * sstep), lo, lv, d)
#define SC_ST(o_) do { const float y_ = scan_step<MODE>(o_, S, std::make_integer_sequence<int, 64>{}); if (MODE == 2) __builtin_amdgcn_raw_buffer_store_b32(__builtin_bit_cast(unsigned, y_), ry, (int)lv, yo, 0); yo += ystep; } while (0)
    ScanOps o0 = SC_LD(0), o1 = SC_LD(1), o2 = SC_LD(2), o3;
    for (int s = 0; s < nsteps; s += 4) {
        o3 = SC_LD(s + 3); SC_ST(o0);
        o0 = SC_LD(s + 4); SC_ST(o1);
        o1 = SC_LD(s + 5); SC_ST(o2);
        o2 = SC_LD(s + 6); SC_ST(o3);
    }
#undef SC_LD
#undef SC_ST
}
DI void phase_scan1(Ctx& C, int e, int qslot) {
    const float* SCp = (const float*)(C.ws + WS_SCAN + (size_t)e * SCAN_BYTES); float* PQ = (float*)(C.ws + WS_PQ); float* Y = (float*)(C.ws + WS_YSC);
    const int nit = 512 + 64 * (NCH - 1) * 2;
    unsigned* qctr = (unsigned*)(C.ws + WS_CTL) + 8192 + 64 * (e + 2 * qslot);
    for (;;) {
        unsigned itu = 0; if (C.lane == 0) itu = __hip_atomic_fetch_add(qctr, 1u, __ATOMIC_RELAXED, __HIP_MEMORY_SCOPE_AGENT);
        const int it = __builtin_amdgcn_readfirstlane((int)itu); if (it >= nit) break;
        int lane = C.lane; asm volatile("" : "+v"(lane));
        float S[64];
        if (it >= 512) { const int si = it - 512;
            const int kind = si & 1, c = (si >> 1) % (NCH - 1), sidx = (si >> 1) / (NCH - 1);        const int d = sidx & 1, h = (sidx >> 1) & 15, b = sidx >> 5;
            const int t0 = d ? 4095 - c * CHL : c * CHL; const int row0 = MP + b * 4096 + t0;
            float fl = (float)lane; asm volatile("" : "+v"(fl)); const float kf = kind == 0 ? 1.f : 0.f;
#pragma unroll
            for (int j = 0; j < 64; ++j) { S[j] = kf * fmaxf(0.f, 1.f - fabsf(fl - (float)j)); }
            if (kind == 0) scan_wave<0>(SCp, row0, d ? -1 : 1, CHL, h, d, S, nullptr, lane); else scan_wave<1>(SCp, row0, d ? -1 : 1, CHL, h, d, S, nullptr, lane);
            float* dst = PQ + (((size_t)sidx * NCH + c) * 2 + kind) * 4096 + lane * 64;
#pragma unroll
            for (int j = 0; j < 16; ++j) *(f32x4v*)(dst + 4 * j) = (f32x4v){S[4 * j], S[4 * j + 1], S[4 * j + 2], S[4 * j + 3]};
        } else {
            const int pi = it; const int d = pi & 1, h = (pi >> 1) & 15, b = pi >> 5;
#pragma unroll
            for (int j = 0; j < 64; ++j) S[j] = 0.f;
            scan_wave<2>(SCp, b * 256 + (d ? 255 : 0), d ? -1 : 1, 128, h, d, S, Y + (size_t)d * MT * 1024, lane);
            float* dst = (float*)(C.ws + WS_PST) + (size_t)pi * 4096 + lane * 64;
#pragma unroll
            for (int j = 0; j < 16; ++j) *(f32x4v*)(dst + 4 * j) = (f32x4v){S[4 * j], S[4 * j + 1], S[4 * j + 2], S[4 * j + 3]};
        }
    }
}
DI void phase_scan_carry(Ctx& C, int e, int nsw) {
    const float* PQ = (const float*)(C.ws + WS_PQ); float* SST = (float*)(C.ws + WS_SST);
    LAS float* Ss = (LAS float*)C.lds;
    LAS float* Ps = (LAS float*)(C.lds + 64 * 65 * 4 + 64);
    for (int sidx = C.bx; sidx < 64; sidx += C.G) {
        const int d = sidx & 1, h = (sidx >> 1) & 15, b = sidx >> 5; const int row = C.tid & 63, cg = C.wave;
        const float* s0 = C.in[I_ST] + ((((size_t)b * 2 + e) * 2 + d) * 16 + h) * 4096;
        __syncthreads();
        for (int i = C.tid; i < 4096; i += 512) { const float v = s0[i]; Ss[(i >> 6) * 65 + (i & 63)] = v; SST[((size_t)sidx * NCH) * 4096 + i] = v; }
        const float* PQs = PQ + (size_t)sidx * NCH * 2 * 4096;
        f32x4v pp0 = *(const f32x4v*)(PQs + 4 * C.tid), pp1 = *(const f32x4v*)(PQs + 2048 + 4 * C.tid);
        f32x4v qq0 = *(const f32x4v*)(PQs + 4096 + row * 64 + cg * 8), qq1 = *(const f32x4v*)(PQs + 4096 + row * 64 + cg * 8 + 4);
        for (int c = 0; c + 1 < NCH; ++c) {
            __syncthreads();
            *(LAS f32x4v*)(Ps + 4 * C.tid) = pp0; *(LAS f32x4v*)(Ps + 2048 + 4 * C.tid) = pp1;
            float o[8] = {qq0.x, qq0.y, qq0.z, qq0.w, qq1.x, qq1.y, qq1.z, qq1.w};
            if (c + 2 < NCH) { const float* nx = PQs + (size_t)(c + 1) * 2 * 4096;
                pp0 = *(const f32x4v*)(nx + 4 * C.tid); pp1 = *(const f32x4v*)(nx + 2048 + 4 * C.tid);
                qq0 = *(const f32x4v*)(nx + 4096 + row * 64 + cg * 8); qq1 = *(const f32x4v*)(nx + 4096 + row * 64 + cg * 8 + 4); }
            __syncthreads();
            for (int k = 0; k < 64; ++k) { const float sv = Ss[row * 65 + k]; const f32x4v p0 = *(const LAS f32x4v*)(Ps + k * 64 + cg * 8), p1 = *(const LAS f32x4v*)(Ps + k * 64 + cg * 8 + 4);
                o[0] += sv * p0.x; o[1] += sv * p0.y; o[2] += sv * p0.z; o[3] += sv * p0.w; o[4] += sv * p1.x; o[5] += sv * p1.y; o[6] += sv * p1.z; o[7] += sv * p1.w; }
            __syncthreads();
            float* dst = SST + ((size_t)sidx * NCH + c + 1) * 4096 + row * 64 + cg * 8;
#pragma unroll
            for (int i = 0; i < 8; ++i) Ss[row * 65 + cg * 8 + i] = o[i];
            *(f32x4v*)dst = (f32x4v){o[0], o[1], o[2], o[3]}; *(f32x4v*)(dst + 4) = (f32x4v){o[4], o[5], o[6], o[7]};
        }
    }
    {
        const int nb0 = C.G > 64 ? 64 : 0; const float* SCp = (const float*)(C.ws + WS_SCAN + (size_t)e * SCAN_BYTES); float* Y = (float*)(C.ws + WS_YSC);
        if (C.bx >= nb0 && C.wave < nsw) for (int pi = (C.bx - nb0) * nsw + C.wave; pi < 512; pi += (C.G - nb0) * nsw) {
            int lane = C.lane; asm volatile("" : "+v"(lane));
            const int d = pi & 1, h = (pi >> 1) & 15, b = pi >> 5;
            float S[64]; const float* src = (const float*)(C.ws + WS_PST) + (size_t)pi * 4096 + lane * 64;
#pragma unroll
            for (int j = 0; j < 16; ++j) { const f32x4v t = *(const f32x4v*)(src + 4 * j); S[4 * j] = t.x; S[4 * j + 1] = t.y; S[4 * j + 2] = t.z; S[4 * j + 3] = t.w; }
            scan_wave<2>(SCp, b * 256 + (d ? 127 : 128), d ? -1 : 1, 128, h, d, S, Y + (size_t)d * MT * 1024, lane);
            float* dst = C.out + OUT_ST + ((((size_t)b * 2 + e) * 2 + d) * 16 + h) * 4096 + lane * 64;
#pragma unroll
            for (int j = 0; j < 16; ++j) *(f32x4v*)(dst + 4 * j) = (f32x4v){S[4 * j], S[4 * j + 1], S[4 * j + 2], S[4 * j + 3]};
        }
    }
}
DI void phase_scan3(Ctx& C, int e) {
    const float* SCp = (const float*)(C.ws + WS_SCAN + (size_t)e * SCAN_BYTES); const float* SST = (const float*)(C.ws + WS_SST); float* Y = (float*)(C.ws + WS_YSC);
    for (int it = C.gw; it < 64 * NCH; it += C.NGW) {
        int lane = C.lane; asm volatile("" : "+v"(lane));
        const int c = it % NCH, sidx = it / NCH; const int d = sidx & 1, h = (sidx >> 1) & 15, b = sidx >> 5;
        const int t0 = d ? 4095 - c * CHL : c * CHL; const int row0 = MP + b * 4096 + t0;
        float S[64]; const float* src = SST + ((size_t)sidx * NCH + c) * 4096 + lane * 64;
#pragma unroll
        for (int j = 0; j < 16; ++j) { const f32x4v t = *(const f32x4v*)(src + 4 * j); S[4 * j] = t.x; S[4 * j + 1] = t.y; S[4 * j + 2] = t.z; S[4 * j + 3] = t.w; }
        scan_wave<2>(SCp, row0, d ? -1 : 1, CHL, h, d, S, Y + (size_t)d * MT * 1024, lane);
    }
}
DI float row16_sum(float v) { v += dpp_f<0xB1>(v); v += dpp_f<0x4E>(v); v += dpp_f<0x141>(v); v += dpp_f<0x140>(v); return v; }
DI void phase_rwkv_post(Ctx& C, int e) {
    const float* SCp = (const float*)(C.ws + WS_SCAN + (size_t)e * SCAN_BYTES); const float* Y = (const float*)(C.ws + WS_YSC); const float* GB = (const float*)(C.ws + WS_GB); bf16* MIX = (bf16*)(C.ws + WS_MIX);
    const float* rk = C.in[I_RK] + e * 1024; const float* gw = C.in[I_GNW] + e * 1024; const float* gb = C.in[I_GNB] + e * 1024; const int lane = C.lane;
    for (int row = C.gw; row < MT; row += C.NGW) {
        const float* sc = SCp + (size_t)row * SCAN_P;
#pragma unroll
        for (int i = 0; i < 4; ++i) { const int c = 256 * i + 4 * lane;
            const f32x4v y = *(const f32x4v*)(Y + (size_t)row * 1024 + c) + *(const f32x4v*)(Y + ((size_t)MT + row) * 1024 + c);
            const float mu = row16_sum((y.x + y.y) + (y.z + y.w)) * (1.0f / 64.0f); const f32x4v dl = y - mu;
            const float var = row16_sum((dl.x * dl.x + dl.y * dl.y) + (dl.z * dl.z + dl.w * dl.w)) * (1.0f / 64.0f);
            const f32x4v yn = dl * (1.0f / sqrtf(var + 64e-5f));
            const f32x4v rr = *(const f32x4v*)(sc + c), kd = *(const f32x4v*)(sc + 7 * 1024 + c) + *(const f32x4v*)(sc + 8 * 1024 + c), rkv = *(const f32x4v*)(rk + c); const f32x4v pb = rr * kd * rkv;
            const float bs = row16_sum((pb.x + pb.y) + (pb.z + pb.w));
            const f32x4v o = (yn * *(const f32x4v*)(gw + c) + *(const f32x4v*)(gb + c) + *(const f32x4v*)(sc + 1024 + c) * bs) * *(const f32x4v*)(GB + (size_t)row * 1024 + c);
            v2u w; w.x = pk2(o.x, o.y); w.y = pk2(o.z, o.w); *(v2u*)(MIX + (size_t)row * 2048 + c) = w; }
    }
}

constexpr int AT_KP = 200, AT_VP = 72, AT_KB = 64 * AT_KP * 2, AT_VB = 128 * AT_VP * 2, AT_BUF = AT_KB + AT_VB;
DI void attn_unit(Ctx& C, const bf16* Qb, const bf16* KN, const bf16* KRb, const bf16* VTh  , int vpitch, bf16* MIX, int qrow0, int h, int krow0, int nlat, int crow0, int ntile) {
    int tid = C.tid; asm volatile("" : "+v"(tid)); const int lane = tid & 63, r = lane & 31, hh = lane >> 5;
    LAS unsigned char* lds = C.lds;
    s16x8v qf[12];
    { const bf16* qp = Qb + (size_t)(qrow0 + C.wave * 32 + r) * 1536 + h * 192 + 8 * hh;
#pragma unroll
      for (int s = 0; s < 12; ++s) qf[s] = *(const s16x8v*)(qp + 16 * s); }
    f32x16v o[4];
#pragma unroll
    for (int vb = 0; vb < 4; ++vb)
#pragma unroll
        for (int i = 0; i < 16; ++i) o[vb][i] = 0.f;
    float mrun = -INFINITY, lsum = 0.f;
    v4u pre[5];
    auto issue = [&](int j) {
        const int k0 = 64 * j; const int rbase = k0 < nlat ? krow0 + k0 : crow0 + (k0 - nlat);
#pragma unroll
        for (int i = 0; i < 3; ++i) { const int p = tid + 512 * i, key = p / 24, pc = p % 24; const size_t rw = (size_t)(rbase + key);
            pre[i] = pc < 16 ? *(const v4u*)(KN + rw * 1024 + h * 128 + pc * 8) : *(const v4u*)(KRb + rw * 64 + (pc - 16) * 8); }
#pragma unroll
        for (int i = 0; i < 2; ++i) { const int p = tid + 512 * i, dv = p >> 3, pc = p & 7; pre[3 + i] = *(const v4u*)(VTh + (size_t)dv * vpitch + k0 + pc * 8); }
    };
    auto commit = [&](int buf) {
        LAS unsigned char* kb = lds + buf * AT_BUF; LAS unsigned char* vbp = kb + AT_KB;
#pragma unroll
        for (int i = 0; i < 3; ++i) { const int p = tid + 512 * i, key = p / 24, pc = p % 24; *(LAS v4u*)(kb + key * (AT_KP * 2) + pc * 16) = pre[i]; }
#pragma unroll
        for (int i = 0; i < 2; ++i) { const int p = tid + 512 * i, dv = p >> 3, pc = p & 7; *(LAS v4u*)(vbp + dv * (AT_VP * 2) + pc * 16) = pre[3 + i]; }
    };
    __syncthreads();
    issue(0); commit(0); __syncthreads();
    for (int j = 0; j < ntile; ++j) {
        if (j + 1 < ntile) issue(j + 1);
        const LAS unsigned char* kb = lds + (j & 1) * AT_BUF; const LAS unsigned char* vbp = kb + AT_KB;
        f32x16v st[2];
        __builtin_amdgcn_s_setprio(1);
#pragma unroll
        for (int kbk = 0; kbk < 2; ++kbk) {
#pragma unroll
            for (int i = 0; i < 16; ++i) st[kbk][i] = 0.f;
#pragma unroll
            for (int s = 0; s < 12; ++s) { const s16x8v a = *(const LAS s16x8v*)(kb + (32 * kbk + r) * (AT_KP * 2) + (16 * s + 8 * hh) * 2);
                st[kbk] = __builtin_amdgcn_mfma_f32_32x32x16_bf16(a, qf[s], st[kbk], 0, 0, 0); }
        }
        __builtin_amdgcn_s_setprio(0);
        float mx = st[0][0];
#pragma unroll
        for (int i = 1; i < 16; ++i) mx = fmaxf(mx, st[0][i]);
#pragma unroll
        for (int i = 0; i < 16; ++i) mx = fmaxf(mx, st[1][i]);
        mx = fmaxf(mx, shfl_idx(mx, lane ^ 32));
        const float mnew = fmaxf(mrun, mx); const float alpha = __builtin_amdgcn_exp2f(mrun - mnew); mrun = mnew;
        float ps = 0.f;
#pragma unroll
        for (int kbk = 0; kbk < 2; ++kbk)
#pragma unroll
            for (int i = 0; i < 16; ++i) { const float p = __builtin_amdgcn_exp2f(st[kbk][i] - mnew); st[kbk][i] = p; ps += p; }
        lsum = lsum * alpha + ps;
        if (__builtin_amdgcn_ballot_w64(alpha != 1.0f) != 0ull) {
#pragma unroll
            for (int vb = 0; vb < 4; ++vb)
#pragma unroll
                for (int i = 0; i < 16; ++i) o[vb][i] *= alpha; }
        __builtin_amdgcn_s_setprio(1);
#pragma unroll
        for (int kbk = 0; kbk < 2; ++kbk)
#pragma unroll
            for (int s2 = 0; s2 < 2; ++s2) {
                v4u pw; pw.x = pg8::cvt_pk_bf16(st[kbk][8 * s2 + 0], st[kbk][8 * s2 + 1]); pw.y = pg8::cvt_pk_bf16(st[kbk][8 * s2 + 2], st[kbk][8 * s2 + 3]); pw.z = pg8::cvt_pk_bf16(st[kbk][8 * s2 + 4], st[kbk][8 * s2 + 5]); pw.w = pg8::cvt_pk_bf16(st[kbk][8 * s2 + 6], st[kbk][8 * s2 + 7]);
                const s16x8v pf = __builtin_bit_cast(s16x8v, pw);
#pragma unroll
                for (int vb = 0; vb < 4; ++vb) { const LAS unsigned char* vp = vbp + (32 * vb + r) * (AT_VP * 2) + (32 * kbk + 16 * s2 + 4 * hh) * 2;
                    const v2u lo = *(const LAS v2u*)vp, hi = *(const LAS v2u*)(vp + 16); const v4u av = {lo.x, lo.y, hi.x, hi.y};
                    o[vb] = __builtin_amdgcn_mfma_f32_32x32x16_bf16(__builtin_bit_cast(s16x8v, av), pf, o[vb], 0, 0, 0); }
            }
        __builtin_amdgcn_s_setprio(0);
        if (j + 1 < ntile) commit((j + 1) & 1);
        __syncthreads();
    }
    const float inv = 1.0f / (lsum + shfl_idx(lsum, lane ^ 32));
    bf16* op = MIX + (size_t)(qrow0 + C.wave * 32 + r) * 2048 + 1024 + h * 128 + 4 * hh;
#pragma unroll
    for (int vb = 0; vb < 4; ++vb)
#pragma unroll
        for (int g = 0; g < 4; ++g) { v2u w; w.x = pk2(o[vb][4 * g] * inv, o[vb][4 * g + 1] * inv); w.y = pk2(o[vb][4 * g + 2] * inv, o[vb][4 * g + 3] * inv);
            *(v2u*)(op + 32 * vb + 8 * g) = w; }
}
DI void phase_attention(Ctx& C) {
    unsigned char* ws = C.ws; const bf16* Qb = (const bf16*)(ws + WS_Q); const bf16* KN = (const bf16*)(ws + WS_KN); const bf16* KRb = (const bf16*)(ws + WS_KR); bf16* MIX = (bf16*)(ws + WS_MIX);
    const bf16* VTp = (const bf16*)(ws + WS_VT); const bf16* VTs = (const bf16*)(ws + WS_VT + VT_S_OFF);
    for (int u = C.bx; u < 256 + 128; u += C.G) {
        if (u < 256) { const int qb = u & 15, h = (u >> 4) & 7, b = u >> 7;
            attn_unit(C, Qb, KN, KRb, VTs + ((size_t)b * 1024 + h * 128) * 4352, 4352, MIX, MP + b * 4096 + qb * 256, h, MP + b * 4096, 4096, MT + b * 256, 68); }
        else { const int v = u - 256, h = v & 7, b = v >> 3;
            attn_unit(C, Qb, KN, KRb, VTp + ((size_t)b * 1024 + h * 128) * 256, 256, MIX, b * 256, h, b * 256, 256, 0, 4); }
    }
    __syncthreads();
}

DI f32x2v mk2(float a, float b) { return (f32x2v){a, b}; }
DI f32x2v cmul(f32x2v a, f32x2v b) { const f32x2v t = {-b.y, b.x}; return a.x * b + a.y * t; }
DI f32x2v cmulc(f32x2v a, f32x2v b) { const f32x2v t = {b.y, -b.x}; return a.x * b + a.y * t; }
DI f32x2v mul_mi(f32x2v a) { return mk2(a.y, -a.x); }
DI f32x2v mul_pi(f32x2v a) { return mk2(-a.y, a.x); }
DI f32x2v twid(int p, int den) { const float fr = (float)p / (float)den; return mk2(__builtin_amdgcn_cosf(fr), __builtin_amdgcn_sinf(fr)); }
DI int PD(int i) { return i + ((i >> 5) << 1); }
constexpr int FFT_BS = 8192 + 512, FFT_BUF_BYTES = FFT_BS * 8;
DI void bf4_fwd(f32x2v& x0, f32x2v& x1, f32x2v& x2, f32x2v& x3, f32x2v w0, f32x2v wm) {
    const f32x2v a0 = x0 + x2, a2 = cmul(x0 - x2, w0), a1 = x1 + x3, a3 = cmul(x1 - x3, mul_mi(w0));
    x0 = a0 + a1; x1 = cmul(a0 - a1, wm); x2 = a2 + a3; x3 = cmul(a2 - a3, wm);
}
DI void bf4_inv(f32x2v& x0, f32x2v& x1, f32x2v& x2, f32x2v& x3, f32x2v wa, f32x2v w) {
    const f32x2v t1 = cmul(x1, w), t3 = cmul(x3, w);
    const f32x2v a0 = x0 + t1, a1 = x0 - t1, a2 = x2 + t3, a3 = x2 - t3;
    const f32x2v t2 = cmul(a2, wa), t3b = cmul(a3, mul_pi(wa));
    x0 = a0 + t2; x1 = a1 + t3b; x2 = a0 - t2; x3 = a1 - t3b;
}
template <int N, int M, int NI = 1> DI void fft_fwd_pass(LAS f32x2v* buf, int tid) {
    constexpr int S = M / 8;
    const int tr = tid / (N / 16), u = tid % (N / 16), g = u / S, p = u % S; const int base = tr * N + g * 2 * M + p;
    f32x2v e[NI][16];
#pragma unroll
    for (int j = 0; j < NI; ++j)
#pragma unroll
        for (int k = 0; k < 16; ++k) e[j][k] = buf[j * FFT_BS + PD(base + k * S)];
    const f32x2v bc = twid(p, 2 * M); const f32x2v b1 = mk2(bc.x, -bc.y), b2 = cmul(b1, b1), b4 = cmul(b2, b2), b8 = cmul(b4, b4);
    constexpr float C1 = 0.92387953251128674f, S1 = 0.38268343236508977f, R2 = 0.70710678118654752f;
    const f32x2v w1a = cmul(b1, mk2(C1, -S1)), w1b = cmul(b2, mk2(R2, -R2)), w2a = cmul(b1, mk2(R2, -R2)), w2b = mul_mi(b2), w3a = cmul(b1, mk2(S1, -C1)), w3b = cmul(b2, mk2(-R2, -R2));
#pragma unroll
    for (int j = 0; j < NI; ++j) {
        bf4_fwd(e[j][0], e[j][4], e[j][8], e[j][12], b1, b2);
        bf4_fwd(e[j][1], e[j][5], e[j][9], e[j][13], w1a, w1b);
        bf4_fwd(e[j][2], e[j][6], e[j][10], e[j][14], w2a, w2b);
        bf4_fwd(e[j][3], e[j][7], e[j][11], e[j][15], w3a, w3b);
#pragma unroll
        for (int q = 0; q < 4; ++q) bf4_fwd(e[j][4 * q], e[j][4 * q + 1], e[j][4 * q + 2], e[j][4 * q + 3], b4, b8);
#pragma unroll
        for (int k = 0; k < 16; ++k) buf[j * FFT_BS + PD(base + k * S)] = e[j][k];
    }
    __syncthreads();
    if constexpr (M / 16 >= 32) fft_fwd_pass<N, M / 16, NI>(buf, tid);
}
constexpr float c32q(int k) { return k == 0 ? 1.f : k == 1 ? 0.98078528040323043f : k == 2 ? 0.92387953251128674f : k == 3 ? 0.83146961230254524f : k == 4 ? 0.70710678118654752f : k == 5 ? 0.55557023301960218f : k == 6 ? 0.38268343236508977f : k == 7 ? 0.19509032201612825f : 0.f; }
constexpr float c32(int k) { return k <= 8 ? c32q(k) : -c32q(16 - k); }
constexpr float s32(int k) { return k <= 8 ? c32q(8 - k) : c32q(k - 8); }
DI void bf4_fwd_t(f32x2v& x0, f32x2v& x1, f32x2v& x2, f32x2v& x3) {
    const f32x2v a0 = x0 + x2, a2 = x0 - x2, a1 = x1 + x3, a3 = mul_mi(x1 - x3);
    x0 = a0 + a1; x1 = a0 - a1; x2 = a2 + a3; x3 = a2 - a3;
}
DI void bf4_fwd_b1(f32x2v& x0, f32x2v& x1, f32x2v& x2, f32x2v& x3) {
    constexpr float R2 = 0.70710678118654752f;
    const f32x2v a0 = x0 + x2, a2 = cmul(x0 - x2, mk2(R2, -R2)), a1 = x1 + x3, a3 = cmul(x1 - x3, mk2(-R2, -R2));
    x0 = a0 + a1; x1 = mul_mi(a0 - a1); x2 = a2 + a3; x3 = mul_mi(a2 - a3);
}
DI void bf4_inv_t(f32x2v& x0, f32x2v& x1, f32x2v& x2, f32x2v& x3) {
    const f32x2v a0 = x0 + x1, a1 = x0 - x1, a2 = x2 + x3, a3 = x2 - x3; const f32x2v t3b = mul_pi(a3);
    x0 = a0 + a2; x1 = a1 + t3b; x2 = a0 - a2; x3 = a1 - t3b;
}
DI void bf4_inv_b1(f32x2v& x0, f32x2v& x1, f32x2v& x2, f32x2v& x3) {
    constexpr float R2 = 0.70710678118654752f;
    const f32x2v t1 = mul_pi(x1), t3 = mul_pi(x3); const f32x2v a0 = x0 + t1, a1 = x0 - t1, a2 = x2 + t3, a3 = x2 - t3;
    const f32x2v t2 = cmul(a2, mk2(R2, R2)), t3b = cmul(a3, mk2(-R2, R2));
    x0 = a0 + t2; x1 = a1 + t3b; x2 = a0 - t2; x3 = a1 - t3b;
}
template <int NI> DI void fft_r32_fwd(LAS f32x2v* buf, int tid) {
    const int img = tid >> 8, g = tid & 255;
    if (img < NI) {
        LAS f32x4v* p = (LAS f32x4v*)(buf + img * FFT_BS + 34 * g);
        f32x2v r[32];
#pragma unroll
        for (int m = 0; m < 16; ++m) { const f32x4v v = p[m]; r[2 * m] = mk2(v.x, v.y); r[2 * m + 1] = mk2(v.z, v.w); }
        bf4_fwd_t(r[0], r[8], r[16], r[24]);
#pragma unroll
        for (int j = 1; j < 8; ++j) bf4_fwd(r[j], r[j + 8], r[j + 16], r[j + 24], mk2(c32(j), -s32(j)), mk2(c32(2 * j), -s32(2 * j)));
#pragma unroll
        for (int q = 0; q < 4; ++q) { bf4_fwd_t(r[8 * q], r[8 * q + 2], r[8 * q + 4], r[8 * q + 6]); bf4_fwd_b1(r[8 * q + 1], r[8 * q + 3], r[8 * q + 5], r[8 * q + 7]); }
#pragma unroll
        for (int m = 0; m < 16; ++m) { const f32x2v a = r[2 * m] + r[2 * m + 1], b = r[2 * m] - r[2 * m + 1]; p[m] = (f32x4v){a.x, a.y, b.x, b.y}; }
    }
    __syncthreads();
}
template <int NI> DI void fft_r32_inv(LAS f32x2v* buf, int tid) {
    const int img = tid >> 8, g = tid & 255;
    if (img < NI) {
        LAS f32x4v* p = (LAS f32x4v*)(buf + img * FFT_BS + 34 * g);
        f32x2v r[32];
#pragma unroll
        for (int m = 0; m < 16; ++m) { const f32x4v v = p[m]; r[2 * m] = mk2(v.x + v.z, v.y + v.w); r[2 * m + 1] = mk2(v.x - v.z, v.y - v.w); }
#pragma unroll
        for (int q = 0; q < 4; ++q) { bf4_inv_t(r[8 * q], r[8 * q + 2], r[8 * q + 4], r[8 * q + 6]); bf4_inv_b1(r[8 * q + 1], r[8 * q + 3], r[8 * q + 5], r[8 * q + 7]); }
        bf4_inv_t(r[0], r[8], r[16], r[24]);
#pragma unroll
        for (int j = 1; j < 8; ++j) bf4_inv(r[j], r[j + 8], r[j + 16], r[j + 24], mk2(c32(j), s32(j)), mk2(c32(2 * j), s32(2 * j)));
#pragma unroll
        for (int m = 0; m < 16; ++m) p[m] = (f32x4v){r[2 * m].x, r[2 * m].y, r[2 * m + 1].x, r[2 * m + 1].y};
    }
    __syncthreads();
}
template <int N, int NI = 1> DI void fft_fwd(LAS f32x2v* buf, int tid) {
    asm volatile("" : "+v"(tid));
    fft_fwd_pass<N, N / 2, NI>(buf, tid);
    fft_r32_fwd<NI>(buf, tid);
}
template <int N, int M, int NI = 1, bool REC = true> DI void fft_inv_pass(LAS f32x2v* buf, int tid) {
    const int tr = tid / (N / 16), u = tid % (N / 16), g = u / M, p = u % M; const int base = tr * N + g * 16 * M + p;
    f32x2v e[NI][16];
#pragma unroll
    for (int j = 0; j < NI; ++j)
#pragma unroll
        for (int k = 0; k < 16; ++k) e[j][k] = buf[j * FFT_BS + PD(base + k * M)];
    const f32x2v a1 = twid(p, 16 * M), a2 = cmul(a1, a1), a4 = cmul(a2, a2), a8 = cmul(a4, a4);
    constexpr float C1 = 0.92387953251128674f, S1 = 0.38268343236508977f, R2 = 0.70710678118654752f;
    const f32x2v v1a = cmul(a1, mk2(C1, S1)), v1b = cmul(a2, mk2(R2, R2)), v2a = cmul(a1, mk2(R2, R2)), v2b = mul_pi(a2), v3a = cmul(a1, mk2(S1, C1)), v3b = cmul(a2, mk2(-R2, R2));
#pragma unroll
    for (int j = 0; j < NI; ++j) {
#pragma unroll
        for (int q = 0; q < 4; ++q) bf4_inv(e[j][4 * q], e[j][4 * q + 1], e[j][4 * q + 2], e[j][4 * q + 3], a4, a8);
        bf4_inv(e[j][0], e[j][4], e[j][8], e[j][12], a1, a2);
        bf4_inv(e[j][1], e[j][5], e[j][9], e[j][13], v1a, v1b);
        bf4_inv(e[j][2], e[j][6], e[j][10], e[j][14], v2a, v2b);
        bf4_inv(e[j][3], e[j][7], e[j][11], e[j][15], v3a, v3b);
#pragma unroll
        for (int k = 0; k < 16; ++k) buf[j * FFT_BS + PD(base + k * M)] = e[j][k];
    }
    __syncthreads();
    if constexpr (REC && 16 * M < N) fft_inv_pass<N, 16 * M, NI>(buf, tid);
}
template <int N, int NI = 1> DI void fft_inv(LAS f32x2v* buf, int tid) {
    asm volatile("" : "+v"(tid));
    fft_r32_inv<NI>(buf, tid);
    fft_inv_pass<N, 32, NI>(buf, tid);
}
DI v2u ks_pack(float a, float b, float cc, float d) { v2u w; w.x = __builtin_bit_cast(unsigned, __builtin_amdgcn_cvt_pkrtz(a, b)); w.y = __builtin_bit_cast(unsigned, __builtin_amdgcn_cvt_pkrtz(cc, d)); return w; }
DI f32x4v ks_unpack(v2u w) { return (f32x4v){h2f((unsigned short)(w.x & 0xffffu)), h2f((unsigned short)(w.x >> 16)), h2f((unsigned short)(w.y & 0xffffu)), h2f((unsigned short)(w.y >> 16))}; }
template <int N> DI int ks_perm(int e) { if constexpr (N == 8192) return e < 4096 ? (((e & 63) << 6) | (e >> 6)) : e; else return e; }
template <int N, int NI> DI void fft_pairmul_pre(LAS f32x2v* buf, const v2u (&ksr)[8], const v2u* KS, int tid) {
    asm volatile("" : "+v"(tid));
    constexpr int LOG = (N == 8192) ? 13 : 9, NB = 8192 / N, NK = N / 2 + 1;
#pragma unroll
    for (int r = 0; r < 9; ++r) {
        const int idx = tid + 512 * r;
        if (r == 8 && idx >= NB * NK) break;
        v2u kw; if (r < 8) kw = ksr[r]; else kw = KS[idx]; const f32x4v ks = ks_unpack(kw);
        const int tr = idx / NK, k = ks_perm<N>(idx % NK);
        const int pk = PD(tr * N + (int)(__brev((unsigned)k) >> (32 - LOG))), pn = PD(tr * N + (int)(__brev((unsigned)((N - k) & (N - 1))) >> (32 - LOG)));
#pragma unroll
        for (int j = 0; j < NI; ++j) {
            const f32x2v zk = buf[j * FFT_BS + pk], zn = buf[j * FFT_BS + pn];
            constexpr float hn_ = 0.5f / (float)N; const f32x2v u1 = mk2(hn_ * (zk.x + zn.x), hn_ * (zk.y - zn.y)), u2 = mk2(hn_ * (zk.y + zn.y), -hn_ * (zk.x - zn.x));
            const f32x2v y1 = cmul(u1, mk2(ks.x, ks.y)), y2 = cmul(u2, mk2(ks.z, ks.w));
            buf[j * FFT_BS + pk] = mk2(y1.x - y2.y, y1.y + y2.x);
            if (pn != pk) buf[j * FFT_BS + pn] = mk2(y1.x + y2.y, -y1.y + y2.x);
        }
    }
}
template <int N, int NI> DI void fft_fwd_first(LAS f32x2v* buf, int tid, const float (&u0)[NI][8], const float (&u1)[NI][8]) {
    asm volatile("" : "+v"(tid));
    constexpr int M = N / 2, S = M / 8;
    const int tr = tid / (N / 16), p = tid % (N / 16); const int base = tr * N + p;
    const f32x2v bc = twid(p, 2 * M); const f32x2v b1 = mk2(bc.x, -bc.y), b2 = cmul(b1, b1), b4 = cmul(b2, b2), b8 = cmul(b4, b4);
    constexpr float C1 = 0.92387953251128674f, S1 = 0.38268343236508977f, R2 = 0.70710678118654752f;
    const f32x2v w1a = cmul(b1, mk2(C1, -S1)), w1b = cmul(b2, mk2(R2, -R2)), w2a = cmul(b1, mk2(R2, -R2)), w2b = mul_mi(b2), w3a = cmul(b1, mk2(S1, -C1)), w3b = cmul(b2, mk2(-R2, -R2));
    __syncthreads();
#pragma unroll
    for (int j = 0; j < NI; ++j) {
        f32x2v e[16];
#define FFT_HALF_FWD(i, w0, wm) { const f32x2v x0 = mk2(u0[j][i], u1[j][i]), x1 = mk2(u0[j][i + 4], u1[j][i + 4]); const f32x2v a2 = cmul(x0, w0), a3 = cmul(x1, mul_mi(w0)); \
            e[i] = x0 + x1; e[i + 4] = cmul(x0 - x1, wm); e[i + 8] = a2 + a3; e[i + 12] = cmul(a2 - a3, wm); }
        FFT_HALF_FWD(0, b1, b2) FFT_HALF_FWD(1, w1a, w1b) FFT_HALF_FWD(2, w2a, w2b) FFT_HALF_FWD(3, w3a, w3b)
#undef FFT_HALF_FWD
#pragma unroll
        for (int q = 0; q < 4; ++q) bf4_fwd(e[4 * q], e[4 * q + 1], e[4 * q + 2], e[4 * q + 3], b4, b8);
#pragma unroll
        for (int k = 0; k < 16; ++k) buf[j * FFT_BS + PD(base + k * S)] = e[k];
    }
    __syncthreads();
}
template <int N, int NI> DI void fft_inv_last(LAS f32x2v* buf, int tid, f32x2v (&out)[NI][8]) {
    asm volatile("" : "+v"(tid));
    constexpr int M = N / 16;
    const int tr = tid / (N / 16), p = tid % (N / 16); const int base = tr * N + p;
    const f32x2v a1 = twid(p, 16 * M), a2 = cmul(a1, a1), a4 = cmul(a2, a2), a8 = cmul(a4, a4);
    constexpr float C1 = 0.92387953251128674f, S1 = 0.38268343236508977f, R2 = 0.70710678118654752f;
    const f32x2v v1a = cmul(a1, mk2(C1, S1)), v1b = cmul(a2, mk2(R2, R2)), v2a = cmul(a1, mk2(R2, R2)), v2b = mul_pi(a2), v3a = cmul(a1, mk2(S1, C1)), v3b = cmul(a2, mk2(-R2, R2));
#pragma unroll
    for (int j = 0; j < NI; ++j) {
        f32x2v e[16];
#pragma unroll
        for (int k = 0; k < 16; ++k) e[k] = buf[j * FFT_BS + PD(base + k * M)];
#pragma unroll
        for (int q = 0; q < 4; ++q) bf4_inv(e[4 * q], e[4 * q + 1], e[4 * q + 2], e[4 * q + 3], a4, a8);
#define FFT_HALF_INV(i, wa, w) { const f32x2v t1 = cmul(e[i + 4], w), t3 = cmul(e[i + 12], w); const f32x2v a0 = e[i] + t1, a1_ = e[i] - t1, a2_ = e[i + 8] + t3, a3 = e[i + 8] - t3; \
            out[j][i] = a0 + cmul(a2_, wa); out[j][i + 4] = a1_ + cmul(a3, mul_pi(wa)); }
        FFT_HALF_INV(0, a1, a2) FFT_HALF_INV(1, v1a, v1b) FFT_HALF_INV(2, v2a, v2b) FFT_HALF_INV(3, v3a, v3b)
#undef FFT_HALF_INV
    }
}
template <int N, int NI = 1, bool SH = false> DI void fft_pairmul(LAS f32x2v* buf, const v2u* const (&KS)[NI]  , int tid) {
    asm volatile("" : "+v"(tid));
    constexpr int LOG = (N == 8192) ? 13 : 9, NB = 8192 / N, NK = N / 2 + 1;
    for (int idx = tid; idx < NB * NK; idx += 512) {
        const int tr = idx / NK, k = ks_perm<N>(idx % NK);
        const int pk = PD(tr * N + (int)(__brev((unsigned)k) >> (32 - LOG))), pn = PD(tr * N + (int)(__brev((unsigned)((N - k) & (N - 1))) >> (32 - LOG)));
        f32x4v ks0 = {0.f, 0.f, 0.f, 0.f}; if (SH) ks0 = ks_unpack(KS[0][idx]);
#pragma unroll
        for (int j = 0; j < NI; ++j) {
            const f32x2v zk = buf[j * FFT_BS + pk], zn = buf[j * FFT_BS + pn]; const f32x4v ks = SH ? ks0 : ks_unpack(KS[j][idx]);
            constexpr float hn_ = 0.5f / (float)N; const f32x2v u1 = mk2(hn_ * (zk.x + zn.x), hn_ * (zk.y - zn.y)), u2 = mk2(hn_ * (zk.y + zn.y), -hn_ * (zk.x - zn.x));
            const f32x2v y1 = cmul(u1, mk2(ks.x, ks.y)), y2 = cmul(u2, mk2(ks.z, ks.w));
            buf[j * FFT_BS + pk] = mk2(y1.x - y2.y, y1.y + y2.x);
            if (pn != pk) buf[j * FFT_BS + pn] = mk2(y1.x + y2.y, -y1.y + y2.x);
        }
    }
}
template <int T> DI void hyena_filter_item(Ctx& C, int o, int n, int pair0) {
    constexpr int N = 2 * T, NB = 4096 / T, LOG = (N == 8192) ? 13 : 9, NK = N / 2 + 1;
    const bf16* KT = (const bf16*)(C.ws + WS_SCAN); LAS f32x2v* buf = (LAS f32x2v*)C.lds; LAS float* red = (LAS float*)(C.lds + FFT_BUF_BYTES + 1024);
    int tid = C.tid; asm volatile("" : "+v"(tid)); const int toff = T == 256 ? 0 : 256;
    const float dmin = 4.605170185988092f / 1.5f, dmax = 4.605170185988092f / 0.3f;
    __syncthreads();
    if (tid < 2 * NB) red[tid] = 0.f;
    __syncthreads();
    float k0[16], k1[16];
#pragma unroll
    for (int i = 0; i < 16; ++i) { const int idx = tid + 512 * i, tr = idx / N, pos = idx % N; const int c = 2 * (pair0 + tr);
        float a = 0.f, b = 0.f;
        if (pos != T) { const int side = pos > T ? 1 : 0, tt = pos > T ? N - pos : pos; const float tn = (float)tt / (float)(T - 1);
            const bf16* kr = KT + ((size_t)o * 8192 + (n * 2 + side) * 2048 + c) * 4352 + toff + tt;
            const float d0 = dmin + (dmax - dmin) * ((float)c / 2047.0f), d1 = dmin + (dmax - dmin) * ((float)(c + 1) / 2047.0f);
            a = bf2f(kr[0]) * expf(-tn * d0); b = bf2f(kr[4352]) * expf(-tn * d1); }
        k0[i] = a; k1[i] = b;
        const float sa = wave_sum(fabsf(a)), sb = wave_sum(fabsf(b));
        if (C.lane == 0) { __hip_atomic_fetch_add(&red[2 * tr], sa, __ATOMIC_RELAXED, __HIP_MEMORY_SCOPE_WORKGROUP); __hip_atomic_fetch_add(&red[2 * tr + 1], sb, __ATOMIC_RELAXED, __HIP_MEMORY_SCOPE_WORKGROUP); } }
    __syncthreads();
    int tl = tid; asm volatile("" : "+v"(tl));
#pragma unroll
    for (int i = 0; i < 16; ++i) { const int idx = tl + 512 * i, tr = idx / N; f32x2v kv = mk2(k0[i] / red[2 * tr], k1[i] / red[2 * tr + 1]);
        if (idx % N == 0) { const float* hb = C.in[I_HB] + (size_t)(o * 2 + n) * 2048 + 2 * (pair0 + tr); kv.x += hb[0]; kv.y += hb[1]; }
        buf[PD(idx)] = kv; }
    __syncthreads();
    fft_fwd<N>(buf, tid);
    v2u* KS = (v2u*)(C.ws + (T == 256 ? WS_KSP : WS_KSS)) + ((size_t)(o * 2 + n) * 1024 + pair0) * NK;
    for (int idx = tid; idx < NB * NK; idx += 512) { const int tr = idx / NK, k = ks_perm<N>(idx % NK);
        const int pk = tr * N + (int)(__brev((unsigned)k) >> (32 - LOG)), pn = tr * N + (int)(__brev((unsigned)((N - k) & (N - 1))) >> (32 - LOG));
        const f32x2v zk = buf[PD(pk)], zn = buf[PD(pn)];
        KS[idx] = ks_pack(0.5f * (zk.x + zn.x), 0.5f * (zk.y - zn.y), 0.5f * (zk.y + zn.y), -0.5f * (zk.x - zn.x)); }
}
DI void phase_hyena_filters(Ctx& C) {
    for (int it = C.vb; it < 4 * 1024 + 4 * 64; it += C.G) {
        if (it < 4096) hyena_filter_item<4096>(C, it >> 11, (it >> 10) & 1, it & 1023);
        else { const int v = it - 4096; hyena_filter_item<256>(C, v >> 7, (v >> 6) & 1, (v & 63) * 16); }
    }
    __syncthreads();
}
template <int T, int NI, int PROBE = 0, bool SH = false> DI void hyena_conv_item(Ctx& C, int o, const int (&seq)[NI], const int (&pair0)[NI]) {
    constexpr int N = 2 * T, NB = 4096 / T, NK = N / 2 + 1;
    LAS f32x2v* buf = (LAS f32x2v*)C.lds; const int tid = C.tid;
    const float* cw = C.in[I_CW] + (size_t)o * 3 * 6144; const float* cb = C.in[I_CB] + (size_t)o * 6144;
    bf16* Y = (bf16*)(C.ws + WS_MIX);
    const float* ZT[NI]; const v2u* KS0[NI]; const v2u* KS1[NI]; int rowbase[NI];
#pragma unroll
    for (int j = 0; j < NI; ++j) { ZT[j] = (const float*)(C.ws + WS_Z + (T == 256 ? 0 : ZT_S_OFF)) + (size_t)seq[j] * 6144 * T;
        KS0[j] = (const v2u*)(C.ws + (T == 256 ? WS_KSP : WS_KSS)) + ((size_t)(o * 2 + 0) * 1024 + pair0[j]) * NK; KS1[j] = KS0[j] + (size_t)1024 * NK;
        rowbase[j] = T == 256 ? seq[j] * 256 : MP + seq[j] * 4096; }
    constexpr int NQ = SH ? 1 : NI;
    float wq[NQ][6][4];
    if constexpr (T == 4096) {
        auto sg = [](float v) { return __builtin_bit_cast(float, __builtin_amdgcn_readfirstlane(__builtin_bit_cast(int, v))); };
#pragma unroll
        for (int j = 0; j < NQ; ++j) {
#pragma unroll
            for (int gq = 0; gq < 6; ++gq) { const int ch = (gq >> 1) * 2048 + 2 * pair0[j] + (gq & 1); wq[j][gq][0] = sg(cw[ch]); wq[j][gq][1] = sg(cw[6144 + ch]); wq[j][gq][2] = sg(cw[2 * 6144 + ch]); wq[j][gq][3] = sg(cb[ch]); }
        }
    }
    auto ld3 = [&](int j, int grp, int jj, int c, int t, float (&z)[3]) __attribute__((always_inline)) { const int ch = grp * 2048 + c + jj; const float* zr = ZT[j] + (size_t)ch * T + t; z[0] = zr[-1]; z[1] = zr[0]; z[2] = zr[1]; };
    auto ap3 = [&](int j, int grp, int jj, int c, int t, const float (&z)[3]) __attribute__((always_inline)) { const int ch = grp * 2048 + c + jj; const float zp = t > 0 ? z[0] : 0.f, zn = t < T - 1 ? z[2] : 0.f;
        if constexpr (T == 4096) { const int jq = SH ? 0 : j; return wq[jq][grp * 2 + jj][0] * zp + wq[jq][grp * 2 + jj][1] * z[1] + wq[jq][grp * 2 + jj][2] * zn + wq[jq][grp * 2 + jj][3]; }
        else return cw[ch] * zp + cw[6144 + ch] * z[1] + cw[2 * 6144 + ch] * zn + cb[ch]; };
    float gz[NI][8][2][3]; constexpr int NPRE = (T == 4096) ? NI : 1;
    float u0[NI][8], u1[NI][8]; f32x2v cv[NI][8];
    int tl = tid; asm volatile("" : "+v"(tl));
#pragma unroll
    for (int j = 0; j < NI; ++j)
#pragma unroll
        for (int i = 0; i < 8; ++i) { const int tr = tl / (N / 16), t = tl % (N / 16) + (N / 16) * i, c = 2 * (pair0[j] + tr);
            float z0[3], z1[3]; ld3(j, 2, 0, c, t, z0); ld3(j, 2, 1, c, t, z1); u0[j][i] = ap3(j, 2, 0, c, t, z0); u1[j][i] = ap3(j, 2, 1, c, t, z1); }
    v2u ksr[8];
    if constexpr (SH) {
#pragma unroll
        for (int r = 0; r < 8; ++r) ksr[r] = KS0[0][tl + 512 * r]; }
    fft_fwd_first<N, NI>(buf, tid, u0, u1);
    if constexpr (N == 8192) { int tf = tid; asm volatile("" : "+v"(tf)); fft_fwd_pass<N, 256, NI>(buf, tf); }
    { int tf = tid; asm volatile("" : "+v"(tf)); fft_r32_fwd<NI>(buf, tf); }
    if constexpr (SH) fft_pairmul_pre<N, NI>(buf, ksr, KS0[0], tid); else fft_pairmul<N, NI, SH>(buf, KS0, tid);
    __syncthreads();
    { int tf = tid; asm volatile("" : "+v"(tf)); fft_r32_inv<NI>(buf, tf); }
    if constexpr (N == 8192) { int tf = tid; asm volatile("" : "+v"(tf)); fft_inv_pass<N, 32, NI, false>(buf, tf); }
    tl = tid; asm volatile("" : "+v"(tl));
#pragma unroll
    for (int j = 0; j < NPRE; ++j)
#pragma unroll
        for (int i = 0; i < 8; ++i) { const int tr = tl / (N / 16), t = tl % (N / 16) + (N / 16) * i, c = 2 * (pair0[j] + tr); ld3(j, 0, 0, c, t, gz[j][i][0]); ld3(j, 0, 1, c, t, gz[j][i][1]); }
    fft_inv_last<N, NI>(buf, tid, cv);
#pragma unroll
    for (int j = NPRE; j < NI; ++j)
#pragma unroll
        for (int i = 0; i < 8; ++i) { const int tr = tl / (N / 16), t = tl % (N / 16) + (N / 16) * i, c = 2 * (pair0[j] + tr); ld3(j, 0, 0, c, t, gz[j][i][0]); ld3(j, 0, 1, c, t, gz[j][i][1]); }
#pragma unroll
    for (int j = 0; j < NI; ++j)
#pragma unroll
        for (int i = 0; i < 8; ++i) { const int tr = tl / (N / 16), t = tl % (N / 16) + (N / 16) * i, c = 2 * (pair0[j] + tr);
            u0[j][i] = ap3(j, 0, 0, c, t, gz[j][i][0]) * cv[j][i].x; u1[j][i] = ap3(j, 0, 1, c, t, gz[j][i][1]) * cv[j][i].y; }
    if constexpr (SH) {
#pragma unroll
        for (int r = 0; r < 8; ++r) ksr[r] = KS1[0][tl + 512 * r]; }
    fft_fwd_first<N, NI>(buf, tid, u0, u1);
    if constexpr (N == 8192) { int tf = tid; asm volatile("" : "+v"(tf)); fft_fwd_pass<N, 256, NI>(buf, tf); }
    { int tf = tid; asm volatile("" : "+v"(tf)); fft_r32_fwd<NI>(buf, tf); }
    if constexpr (SH) fft_pairmul_pre<N, NI>(buf, ksr, KS1[0], tid); else fft_pairmul<N, NI, SH>(buf, KS1, tid);
    __syncthreads();
    { int tf = tid; asm volatile("" : "+v"(tf)); fft_r32_inv<NI>(buf, tf); }
    if constexpr (N == 8192) { int tf = tid; asm volatile("" : "+v"(tf)); fft_inv_pass<N, 32, NI, false>(buf, tf); }
    tl = tid; asm volatile("" : "+v"(tl));
#pragma unroll
    for (int j = 0; j < NPRE; ++j)
#pragma unroll
        for (int i = 0; i < 8; ++i) { const int tr = tl / (N / 16), t = tl % (N / 16) + (N / 16) * i, c = 2 * (pair0[j] + tr); ld3(j, 1, 0, c, t, gz[j][i][0]); ld3(j, 1, 1, c, t, gz[j][i][1]); }
    fft_inv_last<N, NI>(buf, tid, cv);
#pragma unroll
    for (int j = NPRE; j < NI; ++j)
#pragma unroll
        for (int i = 0; i < 8; ++i) { const int tr = tl / (N / 16), t = tl % (N / 16) + (N / 16) * i, c = 2 * (pair0[j] + tr); ld3(j, 1, 0, c, t, gz[j][i][0]); ld3(j, 1, 1, c, t, gz[j][i][1]); }
#pragma unroll
    for (int j = 0; j < NI; ++j)
#pragma unroll
        for (int i = 0; i < 8; ++i) { const int tr = tl / (N / 16), t = tl % (N / 16) + (N / 16) * i, c = 2 * (pair0[j] + tr);
            const float y0 = ap3(j, 1, 0, c, t, gz[j][i][0]) * cv[j][i].x, y1 = ap3(j, 1, 1, c, t, gz[j][i][1]) * cv[j][i].y;
            *(unsigned*)(Y + (size_t)(rowbase[j] + t) * 2048 + c) = pk2(y0, y1); }
}
template <int PROBE = 0> DI void phase_hyena_conv(Ctx& C, int o) {
    if (C.G == 256) {
        for (int it = C.vb; it < 1024 + 512; it += C.G) {
            if (it < 1024) { const int sq[2] = {0, 1}, pr[2] = {it, it}; hyena_conv_item<4096, 2, PROBE, true>(C, o, sq, pr); }
            else { const int v = it - 1024; const int sq[2] = {2 * (v >> 6), 2 * (v >> 6) + 1}, pr[2] = {(v & 63) * 16, (v & 63) * 16}; hyena_conv_item<256, 2, PROBE, true>(C, o, sq, pr); }
        }
    } else {
        for (int it = C.vb; it < 2048 + 1024; it += C.G) {
            if (it < 2048) { const int sq[1] = {it >> 10}, pr[1] = {it & 1023}; hyena_conv_item<4096, 1, PROBE>(C, o, sq, pr); }
            else { const int v = it - 2048; const int sq[1] = {v >> 6}, pr[1] = {(v & 63) * 16}; hyena_conv_item<256, 1, PROBE>(C, o, sq, pr); }
        }
    }
    __syncthreads();
}

#ifndef ONE_LAUNCH
#define ONE_LAUNCH 1
#endif
#ifndef SKIP_FFN
#define SKIP_FFN 0
#endif
#ifndef SKIP_EVEN
#define SKIP_EVEN 0
#endif
#ifndef SKIP_ODD
#define SKIP_ODD 0
#endif
#ifndef DUP_FFN
#define DUP_FFN 0
#endif
#ifndef DUP_EVEN
#define DUP_EVEN 0
#endif
#ifndef DUP_ODD
#define DUP_ODD 0
#endif
#ifndef DUP_PRO
#define DUP_PRO 0
#endif
#ifndef DUP_E
#define DUP_E 0
#endif
#ifndef DUP_O
#define DUP_O 0
#endif
constexpr int NPH_MAX = 96;
template <int V> struct IntC { static constexpr int value = V; };
DI void launder(Ctx& C, const KArgs& a) { const int t = lane_id_v(); C.lane = t; C.tid = C.wave * 64 + t;
    int z = 0; asm volatile("" : "+v"(z)); const int zs = __builtin_amdgcn_readfirstlane(z);
    C.ws = a.ws + zs; C.in = a.in + zs; C.out = a.out + zs;
    C.zs = zs; C.G = (int)gridDim.x + zs; C.bx = (int)blockIdx.x + zs; C.gw = C.bx * 8 + C.wave; C.NGW = C.G * 8; C.vb = (C.G % 8 == 0) ? (C.bx % 8) * (C.G / 8) + C.bx / 8 : C.bx; }
__global__ void __launch_bounds__(512, 2) mega_fwd(KArgs args) {
    extern __shared__ __attribute__((aligned(16))) unsigned char lds_raw[];
    Ctx C;
    C.lds = (LAS unsigned char*)lds_raw; C.ws = args.ws; C.in = args.in; C.out = args.out;
    C.wave = __builtin_amdgcn_readfirstlane((int)threadIdx.x >> 6); C.lane = lane_id_v(); C.tid = C.wave * 64 + C.lane;
    C.zs = 0; C.G = 0; C.bx = 0; C.gw = 0; C.NGW = 0; C.vb = 0;
    for (int u = C.tid; u < (LDS_BYTES - LDS_CTL) / 4; u += 512) ((LAS unsigned*)(C.lds + LDS_CTL))[u] = 0u;
    __syncthreads();
    (void)xcd_barrier_post((unsigned*)(args.ws + WS_CTL) + 4096, (volatile LAS unsigned*)(C.lds + LDS_CTL + 64), C.tid);
#if ONE_LAUNCH
    constexpr int lo = 0, hi = 1 << 20; int ph = 0;
#else
    const int lo = args.ph_lo, hi = args.ph_hi; int ph = 0;
#endif
#define PH_IF if (ph >= lo && ph < hi) if (launder(C, args), true)
#define PH_NEXT do { const bool both_ = (ph >= lo) && (ph + 1 < hi); ++ph; if (both_) { launder(C, args); XcdBarrier b_; b_.bar = (unsigned*)(C.ws + WS_CTL) + 4096; b_.x = xb_xcc_id() + (unsigned)C.zs; b_.st = (volatile LAS unsigned*)(C.lds + LDS_CTL + 64); xcd_barrier(b_, C.tid); } } while (0)
#define ring C.lds
#define MOD ((const float*)(C.ws + WS_MOD))
#define X ((unsigned short*)(C.ws + WS_X))

#if DUP_PRO == 1
    PH_IF { phase_prologue(C); } PH_NEXT;
#endif
    PH_IF {
#ifndef NO_PROLOGUE
 phase_prologue(C);
#endif
 } PH_NEXT;
    PH_IF { phase_mod_reduce(C);
        pg8::Gemm g{(const bf16*)(C.ws + WS_W3T), (const bf16*)(C.ws + WS_H2), 16384, 4352, 256}; pg8::StaticOrder S; S.init(16384, 4352, C.G, C.bx);
        pg8::EpiBf16Plain E{(bf16*)(C.ws + WS_SCAN), 4352};
        pg8::gemm_phase<pg8::EpiBf16Plain, pg8::StaticOrder, false, false>(ring, g, S, E, C.wave); } PH_NEXT;
#if DUP_PRO == 2
    PH_IF { phase_hyena_filters(C); } PH_NEXT;
#endif
    PH_IF {
#ifndef NO_HYENA
 phase_hyena_filters(C);
#endif
 } PH_NEXT;

#define FFN_BLOCK(l, fi, s, cf) do { \
    if (!SKIP_FFN) { \
    PH_IF { phase_norm_mod(C, C.in[I_NG] + ((l) * 3 + (s)) * 2048, MOD + (size_t)(l) * MODL, (s)); } PH_NEXT; \
    PH_IF { pg8::Gemm g{(const bf16*)(C.ws + WS_H), (const bf16*)(C.ws + WS_W1T) + (size_t)((l) * 2 + (fi)) * NFF1 * 2048, MT, NFF1, 2048}; pg8::StaticOrder S; S.init(MT, NFF1, C.G, C.bx); \
        pg8::EpiSwiGLU E{(bf16*)(C.ws + WS_ACT), DFF}; pg8::gemm_phase<pg8::EpiSwiGLU, pg8::StaticOrder, false, true>(ring, g, S, E, C.wave); \
        { const int nf_ = (l) * 2 + (fi) + 1, idle0_ = (MT / 256) * (NFF1 / 256) % C.G; if ((cf) != 0.0f && nf_ < 8 && C.bx >= idle0_) { launder(C, args); \
            tr_matrix<0>(C, C.in[I_WFO] + (size_t)nf_ * DFF * 2048, 2048, DFF, (bf16*)(C.ws + WS_W2T) + (size_t)nf_ * 2048 * DFF, 2048, 2048, (C.bx - idle0_) * 8 + C.wave, (C.G - idle0_) * 8); } } } PH_NEXT; \
    PH_IF { pg8::Gemm g{(const bf16*)(C.ws + WS_ACT), (const bf16*)(C.ws + WS_W2T) + (size_t)((l) * 2 + (fi)) * 2048 * DFF, MT, 2048, DFF}; \
        pg8::EpiRes E{X, MOD + (size_t)(l) * MODL + (3 * (s) + 2) * 2048, (cf)}; \
        { pg8::PairOrder<1> S; S.init(MT, 2048, DFF, C.G, C.bx, (float*)(C.ws + WS_Z), (unsigned*)(C.ws + WS_CTL) + 16384, (DUP_FFN ? 8u * (unsigned)(2 * ((l) * 2 + (fi)) + ((cf) != 0.0f ? 2 : 1)) : 8u * (unsigned)((l) * 2 + (fi) + 1))); \
          pg8::gemm_phase<pg8::EpiRes, pg8::PairOrder<1>, false, true>(ring, g, S, E, C.wave); } \
        { launder(C, args); pg8::PairOrder<2> S; S.init(MT, 2048, DFF, C.G, C.bx, (float*)(C.ws + WS_Z), (unsigned*)(C.ws + WS_CTL) + 16384, (DUP_FFN ? 8u * (unsigned)(2 * ((l) * 2 + (fi)) + ((cf) != 0.0f ? 2 : 1)) : 8u * (unsigned)((l) * 2 + (fi) + 1))); \
          pg8::Gemm g2{(const bf16*)(C.ws + WS_ACT), (const bf16*)(C.ws + WS_W2T) + (size_t)((l) * 2 + (fi)) * 2048 * DFF, MT, 2048, DFF}; pg8::EpiRes E2{X, MOD + (size_t)(l) * MODL + (3 * (s) + 2) * 2048, (cf)}; \
          pg8::gemm_phase<pg8::EpiRes, pg8::PairOrder<2>, true, true>(ring, g2, S, E2, C.wave); } \
        { const int nf_ = (l) * 2 + (fi) + 1; if ((cf) != 0.0f && nf_ < 8 && !(C.G >= 235 && !SKIP_EVEN && ((l) & 1) == 0 && (fi) == 0) && !(C.G == 256 && !SKIP_EVEN && ((l) & 1) == 0 && (fi) == 1)) { launder(C, args); \
            tr_matrix<1>(C, C.in[I_WFI] + (size_t)nf_ * 2048 * NFF1, NFF1, 2048, (bf16*)(C.ws + WS_W1T) + (size_t)nf_ * NFF1 * 2048, NFF1, NFF1, C.gw, C.NGW); } } } PH_NEXT; \
    } } while (0)

    auto layer_pair = [&](auto PC) __attribute__((always_inline)) {
        constexpr int p = decltype(PC)::value; constexpr int le = 2 * p, lod = 2 * p + 1;
#if DUP_FFN
        FFN_BLOCK(le, 0, 0, 0.0f);
#endif
        FFN_BLOCK(le, 0, 0, 0.5f);
        auto even_mix = [&](float cf, int qslot) __attribute__((always_inline)) {
            const int e = p;
            PH_IF { phase_norm_mod(C, C.in[I_NG] + (le * 3 + 1) * 2048, MOD + (size_t)le * MODL, 1); } PH_NEXT;
            PH_IF { pg8::Gemm g{(const bf16*)(C.ws + WS_H), (const bf16*)(C.ws + WS_WINE) + (size_t)e * ZE_P * 2048, MT, ZE_P, 2048}; pg8::StaticOrder S; S.init(MT, ZE_P, C.G, C.bx);
                pg8::EpiF32 E{(float*)(C.ws + WS_Z), ZE_P}; pg8::gemm_phase<pg8::EpiF32, pg8::StaticOrder, true, true>(ring, g, S, E, C.wave);
                { const int nf_ = le * 2 + 2, idle0_ = (MT / 256) * (ZE_P / 256) % C.G;
                  if (cf != 0.0f && C.G == 256 && C.bx >= idle0_) { launder(C, args);
                    tr_matrix<1>(C, C.in[I_WFI] + (size_t)nf_ * 2048 * NFF1, NFF1, 2048, (bf16*)(C.ws + WS_W1T) + (size_t)nf_ * NFF1 * 2048, NFF1, NFF1, (C.bx - idle0_) * 8 + C.wave, (C.G - idle0_) * 8); } } } PH_NEXT;
#if DUP_E == 5
            PH_IF { phase_even_prep(C, e); } PH_NEXT;
#endif
            PH_IF { phase_even_prep(C, e); } PH_NEXT;
#if DUP_E == 7
            PH_IF {
                { pg8::Gemm g{(const bf16*)(C.ws + WS_LA), (const bf16*)(C.ws + WS_WLORA) + (size_t)e * 5120 * 384, MT, 5120, 384}; pg8::StaticOrder S; S.init(MT, 5120, C.G, C.bx);
                  pg8::EpiLora E{C.ws, C.in[I_W0] + e * 2048, C.in[I_A0] + e * 2048, C.in[I_KA] + e * 1024, WS_SCAN + (size_t)e * SCAN_BYTES, WS_KBUF, WS_GB};
                  pg8::gemm_phase<pg8::EpiLora, pg8::StaticOrder, true, true>(ring, g, S, E, C.wave); }
                launder(C, args);
                { pg8::Gemm g{(const bf16*)(C.ws + WS_CQ), (const bf16*)(C.ws + WS_WQ) + (size_t)e * 1536 * 512, MT, 1536, 512}; pg8::StaticOrder S; S.init(MT, 1536, C.G, C.bx);
                  pg8::EpiQ E{(bf16*)(C.ws + WS_Q), (const float*)(C.ws + WS_ROPE), 0.07216878364870322f * 1.4426950408889634f};
                  pg8::gemm_phase<pg8::EpiQ, pg8::StaticOrder, true, true>(ring, g, S, E, C.wave); }
                launder(C, args);
                { pg8::Gemm g{(const bf16*)(C.ws + WS_CKV), (const bf16*)(C.ws + WS_WKN) + (size_t)e * 1024 * 256, MKV, 1024, 256}; pg8::StaticOrder S; S.init(MKV, 1024, C.G, C.bx);
                  pg8::EpiBf16Plain E{(bf16*)(C.ws + WS_KN), 1024};
                  pg8::gemm_phase<pg8::EpiBf16Plain, pg8::StaticOrder, false, false>(ring, g, S, E, C.wave); }
                launder(C, args);
                { pg8::Gemm g{(const bf16*)(C.ws + WS_WV) + (size_t)e * 1024 * 256, (const bf16*)(C.ws + WS_CKV), 1024, MKV, 256}; pg8::StaticOrder S; S.init(1024, MKV, C.G, C.bx);
                  pg8::EpiVT E{(bf16*)(C.ws + WS_VT), VT_S_OFF / 2};
                  pg8::gemm_phase<pg8::EpiVT, pg8::StaticOrder, false, false>(ring, g, S, E, C.wave); }
            } PH_NEXT;
#endif
            PH_IF {
                { pg8::Gemm g{(const bf16*)(C.ws + WS_LA), (const bf16*)(C.ws + WS_WLORA) + (size_t)e * 5120 * 384, MT, 5120, 384}; pg8::StaticOrder S; S.init(MT, 5120, C.G, C.bx);
                  pg8::EpiLora E{C.ws, C.in[I_W0] + e * 2048, C.in[I_A0] + e * 2048, C.in[I_KA] + e * 1024, WS_SCAN + (size_t)e * SCAN_BYTES, WS_KBUF, WS_GB};
                  pg8::gemm_phase<pg8::EpiLora, pg8::StaticOrder, true, true>(ring, g, S, E, C.wave); }
                launder(C, args);
                { pg8::Gemm g{(const bf16*)(C.ws + WS_CQ), (const bf16*)(C.ws + WS_WQ) + (size_t)e * 1536 * 512, MT, 1536, 512}; pg8::StaticOrder S; S.init(MT, 1536, C.G, (C.bx + 64) % C.G);
                  pg8::EpiQ E{(bf16*)(C.ws + WS_Q), (const float*)(C.ws + WS_ROPE), 0.07216878364870322f * 1.4426950408889634f};
                  pg8::gemm_phase<pg8::EpiQ, pg8::StaticOrder, true, true>(ring, g, S, E, C.wave); }
                launder(C, args);
                { pg8::Gemm g{(const bf16*)(C.ws + WS_CKV), (const bf16*)(C.ws + WS_WKN) + (size_t)e * 1024 * 256, MKV, 1024, 256}; pg8::StaticOrder S; S.init(MKV, 1024, C.G, (C.bx + 32) % C.G);
                  pg8::EpiBf16Plain E{(bf16*)(C.ws + WS_KN), 1024};
                  pg8::gemm_phase<pg8::EpiBf16Plain, pg8::StaticOrder, false, false>(ring, g, S, E, C.wave); }
                launder(C, args);
                { pg8::Gemm g{(const bf16*)(C.ws + WS_WV) + (size_t)e * 1024 * 256, (const bf16*)(C.ws + WS_CKV), 1024, MKV, 256}; pg8::StaticOrder S; S.init(1024, MKV, C.G, (C.bx + 88) % C.G);
                  pg8::EpiVT E{(bf16*)(C.ws + WS_VT), VT_S_OFF / 2};
                  pg8::gemm_phase<pg8::EpiVT, pg8::StaticOrder, false, false>(ring, g, S, E, C.wave); }
            } PH_NEXT;
#if DUP_E == 1
            PH_IF { phase_scan1(C, e, 2); } PH_NEXT;
#endif
            PH_IF {
#ifndef NO_SCAN
 phase_scan1(C, e, qslot);
#endif
 } PH_NEXT;
#if DUP_E == 2
            PH_IF { phase_scan_carry(C, e, 8); __syncthreads(); } PH_NEXT;
#endif
            PH_IF { const bool host_ = cf != 0.0f && C.G >= 235; phase_scan_carry(C, e, host_ ? 3 : 8);
                if (host_ && C.bx >= 64 && C.wave >= 3) { launder(C, args); const int nf_ = le * 2 + 1;
                    tr_matrix<1>(C, C.in[I_WFI] + (size_t)nf_ * 2048 * NFF1, NFF1, 2048, (bf16*)(C.ws + WS_W1T) + (size_t)nf_ * NFF1 * 2048, NFF1, NFF1, (C.bx - 64) * 5 + C.wave - 3, (C.G - 64) * 5); }
                __syncthreads(); } PH_NEXT;
#if DUP_E == 3
            PH_IF { phase_scan3(C, e); } PH_NEXT;
#endif
#if DUP_E == 4
            PH_IF { phase_attention(C); } PH_NEXT;
#endif
            PH_IF {
#ifndef NO_SCAN
 phase_scan3(C, e);
#endif
#ifndef NO_ATTN
 phase_attention(C);
#endif
 } PH_NEXT;
#if DUP_E == 6
            PH_IF { phase_rwkv_post(C, e); } PH_NEXT;
#endif
            PH_IF { phase_rwkv_post(C, e); } PH_NEXT;
            PH_IF { pg8::Gemm g{(const bf16*)(C.ws + WS_MIX), (const bf16*)(C.ws + WS_WOUTE) + (size_t)e * 2048 * 2048, MT, 2048, 2048}; pg8::StaticOrder S; S.init(MT, 2048, C.G, C.bx);
                pg8::EpiRes E{X, MOD + (size_t)le * MODL + (3 * 1 + 2) * 2048, cf}; pg8::gemm_phase<pg8::EpiRes, pg8::StaticOrder, false, true>(ring, g, S, E, C.wave); } PH_NEXT;
        };
#if DUP_EVEN
        even_mix(0.0f, 1);
#endif
        if (!SKIP_EVEN) even_mix(1.0f, 0);
#if DUP_FFN
        FFN_BLOCK(le, 1, 2, 0.0f);
#endif
        FFN_BLOCK(le, 1, 2, 0.5f);
#if DUP_FFN
        FFN_BLOCK(lod, 0, 0, 0.0f);
#endif
        FFN_BLOCK(lod, 0, 0, 0.5f);
        auto odd_mix = [&](float cf) __attribute__((always_inline)) {
            const int o = p;
            PH_IF { phase_norm_mod(C, C.in[I_NG] + (lod * 3 + 1) * 2048, MOD + (size_t)lod * MODL, 1); } PH_NEXT;
            PH_IF { pg8::Gemm g{(const bf16*)(C.ws + WS_WINO) + (size_t)o * 6144 * 2048, (const bf16*)(C.ws + WS_H), 6144, MT, 2048}; pg8::StaticOrder S; S.init(6144, MT, C.G, C.bx);
                pg8::EpiZT E{(float*)(C.ws + WS_Z), (float*)(C.ws + WS_Z + ZT_S_OFF)}; pg8::gemm_phase<pg8::EpiZT, pg8::StaticOrder, false, true>(ring, g, S, E, C.wave); } PH_NEXT;
#if DUP_O == 1
            PH_IF { phase_hyena_conv(C, o); } PH_NEXT;
#endif
#if DUP_O == 2
            PH_IF { phase_hyena_conv<1>(C, o); } PH_NEXT;
#endif
            PH_IF {
#ifndef NO_HYENA
 phase_hyena_conv(C, o);
#endif
 } PH_NEXT;
            PH_IF { pg8::Gemm g{(const bf16*)(C.ws + WS_MIX), (const bf16*)(C.ws + WS_WOUTO) + (size_t)o * 2048 * 2048, MT, 2048, 2048}; pg8::StaticOrder S; S.init(MT, 2048, C.G, C.bx);
                pg8::EpiRes E{X, MOD + (size_t)lod * MODL + (3 * 1 + 2) * 2048, cf}; pg8::gemm_phase<pg8::EpiRes, pg8::StaticOrder, false, true>(ring, g, S, E, C.wave); } PH_NEXT;
        };
#if DUP_ODD
        odd_mix(0.0f);
#endif
        if (!SKIP_ODD) odd_mix(1.0f);
#if DUP_FFN
        FFN_BLOCK(lod, 1, 2, 0.0f);
#endif
        FFN_BLOCK(lod, 1, 2, 0.5f);
    };
    layer_pair(IntC<0>{}); layer_pair(IntC<1>{});
    PH_IF { phase_final_norm(C); } PH_NEXT;
#undef MOD
#undef X
#undef ring
}

extern "C" void kernel_launch(void* const* d_in, const int* in_sizes, int n_in, void* d_out, int out_size, void* d_ws, size_t ws_size, hipStream_t stream) {
    static int grid = 0;
    if (grid == 0) {
        if (n_in != 42 || (size_t)out_size != OUT_END || ws_size < WS_END) { fprintf(stderr, "kernel_launch: unexpected sizes n_in %d out %d ws %zu (need %zu)\n", n_in, out_size, ws_size, (size_t)WS_END); grid = -1; return; }
        int dev = 0, cus = 0, per_cu = 0;
        if (hipGetDevice(&dev) != hipSuccess || hipDeviceGetAttribute(&cus, hipDeviceAttributeMultiprocessorCount, dev) != hipSuccess) { grid = -1; return; }
        if (hipFuncSetAttribute((const void*)mega_fwd, hipFuncAttributeMaxDynamicSharedMemorySize, LDS_BYTES) != hipSuccess) { fprintf(stderr, "kernel_launch: hipFuncSetAttribute failed\n"); grid = -1; return; }
        if (hipOccupancyMaxActiveBlocksPerMultiprocessor(&per_cu, (const void*)mega_fwd, 512, LDS_BYTES) != hipSuccess || per_cu < 1) fprintf(stderr, "kernel_launch: occupancy query says %d\n", per_cu);
        (void)hipGetLastError();
        grid = cus;
    }
    if (grid < 0) return;
    (void)hipMemsetAsync((char*)d_ws + WS_CTL, 0, CTL_ZERO_BYTES, stream);
    KArgs a{};
    for (int i = 0; i < 42; ++i) a.in[i] = (const float*)d_in[i];
    a.out = (float*)d_out; a.ws = (unsigned char*)d_ws;
#if ONE_LAUNCH
    a.ph_lo = 0; a.ph_hi = 1 << 20;
    hipLaunchKernelGGL(mega_fwd, dim3(grid), dim3(512), LDS_BYTES, stream, a);
#else
    for (int i = 0; i < NPH_MAX; ++i) { a.ph_lo = i; a.ph_hi = i + 1; hipLaunchKernelGGL(mega_fwd, dim3(grid), dim3(512), LDS_BYTES, stream, a); }
#endif
}
```
